# Optimizing an MI355X kernel written in HIP

```python
import math
import jax, jax.numpy as jnp
from jax import lax
import numpy as np

D_MODEL = 1024
BATCH = 8
SEQ = 4096
DEPTH = 1

MEM_TOKENS = 256
RMS_EPS = 1e-5

D_MIX = D_MODEL
HEAD_DIM = 64
ATTN_WIDTH = D_MIX // 2
N_Q_HEADS = ATTN_WIDTH // HEAD_DIM
N_KV_HEADS = 2
Q_PER_KV = N_Q_HEADS // N_KV_HEADS
WINDOW = 128
ATTN_BLOCK = 128
ROT_DIM = HEAD_DIM // 4
ROPE_THETA = 500000.0
MAX_POS_OFFSET = 2048

SSD_WIDTH = D_MIX - ATTN_WIDTH
SSD_HEAD_DIM = 64
SSD_HEADS = SSD_WIDTH // SSD_HEAD_DIM
SSD_GROUPS = 2
SSD_HEADS_PER_GROUP = SSD_HEADS // SSD_GROUPS
SSD_STATE = 128
SSD_CONV = 4
SSD_CHUNK = 128
SSD_CONV_DIM = SSD_WIDTH + 2 * SSD_GROUPS * SSD_STATE
DT_MIN = 0.001
DT_MAX = 0.1

SPLIT_POINTS = (
    ATTN_WIDTH,
    ATTN_WIDTH + N_KV_HEADS * HEAD_DIM,
    ATTN_WIDTH + 2 * N_KV_HEADS * HEAD_DIM,
    ATTN_WIDTH + 2 * N_KV_HEADS * HEAD_DIM + SSD_WIDTH,
    ATTN_WIDTH + 2 * N_KV_HEADS * HEAD_DIM + SSD_WIDTH + SSD_CONV_DIM,
)
IN_PROJ_DIM = SPLIT_POINTS[-1] + SSD_HEADS

XATTN_HEADS = 4
XATTN_HEAD_DIM = 128
XATTN_WIDTH = XATTN_HEADS * XATTN_HEAD_DIM

N_GROUPS = 4
EXPERTS_PER_GROUP = 8
N_EXPERTS = N_GROUPS * EXPERTS_PER_GROUP
TOP_K = 2
EXPERT_FF = D_MODEL // 4

kernel_name = 'hybrid_swa_ssd_hier_moe_block'


def rms_norm(x, w):
    xf = x.astype(jnp.float32)
    y = xf * lax.rsqrt(jnp.mean(xf * xf, axis=-1, keepdims=True) + RMS_EPS)
    return (y * w.astype(jnp.float32)).astype(x.dtype)


def partial_rope(t, positions):
    half = ROT_DIM // 2
    inv_freq = jnp.float32(ROPE_THETA) ** (-jnp.arange(0, ROT_DIM, 2, dtype=jnp.float32) / ROT_DIM)
    ang = positions.astype(jnp.float32)[..., None] * inv_freq
    cos = jnp.cos(ang)[:, :, None, :]
    sin = jnp.sin(ang)[:, :, None, :]
    tf = t.astype(jnp.float32)
    x1, x2, rest = tf[..., :half], tf[..., half:ROT_DIM], tf[..., ROT_DIM:]
    out = jnp.concatenate([x1 * cos - x2 * sin, x2 * cos + x1 * sin, rest], axis=-1)
    return out.astype(t.dtype)


def sliding_window_attention(q, k, v, sinks):
    b, s = q.shape[0], q.shape[1]
    nb = s // ATTN_BLOCK
    qb = q.reshape(b, nb, ATTN_BLOCK, N_KV_HEADS, Q_PER_KV, HEAD_DIM)

    def band(t):
        tb = t.reshape(b, nb, ATTN_BLOCK, N_KV_HEADS, HEAD_DIM)
        prev = jnp.pad(tb[:, :-1], ((0, 0), (1, 0), (0, 0), (0, 0), (0, 0)))
        return jnp.concatenate([prev, tb], axis=2)

    kb, vb = band(k), band(v)
    scores = jnp.einsum('bnqhgd,bnkhd->bnhgqk', qb, kb,
                        preferred_element_type=jnp.float32) * (HEAD_DIM ** -0.5)
    q_idx = jnp.arange(ATTN_BLOCK)[:, None] + ATTN_BLOCK
    k_idx = jnp.arange(2 * ATTN_BLOCK)[None, :]
    rel = q_idx - k_idx
    local = (rel >= 0) & (rel < WINDOW)
    valid_prev = (jnp.arange(nb)[:, None, None] > 0) | (k_idx[None] >= ATTN_BLOCK)
    mask = local[None] & valid_prev
    scores = jnp.where(mask[None, :, None, None], scores, -jnp.inf)
    sink = sinks.astype(jnp.float32).reshape(N_KV_HEADS, Q_PER_KV)[None, None, :, :, None, None]
    m = jnp.maximum(jnp.max(scores, axis=-1, keepdims=True), sink)
    p = jnp.exp(scores - m)
    probs = p / (jnp.sum(p, axis=-1, keepdims=True) + jnp.exp(sink - m))
    out = jnp.einsum('bnhgqk,bnkhd->bnqhgd', probs.astype(v.dtype), vb)
    return out.reshape(b, s, N_Q_HEADS * HEAD_DIM)


def causal_depthwise_conv(t, w, bias):
    c = t.shape[-1]
    out = lax.conv_general_dilated(t, w[:, None, :], window_strides=(1,),
                                   padding=[(SSD_CONV - 1, 0)],
                                   dimension_numbers=('NWC', 'WIO', 'NWC'),
                                   feature_group_count=c)
    return out + bias


def ssd_chunked(xs, dt, a, bm, cm):
    b, s = xs.shape[0], xs.shape[1]
    nc = s // SSD_CHUNK
    G, R, P, L = SSD_GROUPS, SSD_HEADS_PER_GROUP, SSD_HEAD_DIM, SSD_CHUNK
    xc = (xs * dt[..., None]).reshape(b, nc, L, G, R, P)
    da = (dt * a).reshape(b, nc, L, G, R)
    da_cum = jnp.cumsum(da, axis=2)
    bc = bm.reshape(b, nc, L, G, SSD_STATE)
    cc = cm.reshape(b, nc, L, G, SSD_STATE)
    seg = da_cum[:, :, :, None] - da_cum[:, :, None, :]
    causal = jnp.tril(jnp.ones((L, L), dtype=bool))
    decay = jnp.exp(jnp.where(causal[:, :, None, None], seg, -jnp.inf))
    cb = jnp.einsum('bclgn,bcsgn->bclsg', cc, bc)
    y_diag = jnp.einsum('bclsgr,bcsgrp->bclgrp', cb[..., None] * decay, xc)
    decay_to_end = jnp.exp(da_cum[:, :, -1:] - da_cum)
    chunk_states = jnp.einsum('bclgn,bclgrp->bcgrpn', bc, xc * decay_to_end[..., None])
    chunk_decay = jnp.exp(da_cum[:, :, -1])

    def step(state, inp):
        st_c, dec_c = inp
        return state * dec_c[..., None, None] + st_c, state

    init = jnp.zeros((b, G, R, P, SSD_STATE), jnp.float32)
    _, start_states = lax.scan(step, init, (jnp.moveaxis(chunk_states, 1, 0),
                                            jnp.moveaxis(chunk_decay, 1, 0)))
    start_states = jnp.moveaxis(start_states, 0, 1)
    y_off = jnp.einsum('bclgn,bcgrpn->bclgrp', cc, start_states) * jnp.exp(da_cum)[..., None]
    return (y_diag + y_off).reshape(b, s, SSD_HEADS, P)


def gated_group_rms_norm(y, z, w):
    b, s, _ = y.shape
    g = (y * jax.nn.silu(z.astype(jnp.float32))).reshape(b, s, SSD_GROUPS, -1)
    g = g * lax.rsqrt(jnp.mean(g * g, axis=-1, keepdims=True) + RMS_EPS)
    return g.reshape(b, s, SSD_WIDTH) * w.astype(jnp.float32)


def hybrid_mixer(h, positions, w_in, sinks, conv_w, conv_b, dt_bias, a_log, d_skip,
                 attn_out_norm_w, ssd_out_norm_w, w_out):
    b, s, _ = h.shape
    proj = h @ w_in
    q, k, v, z, xbc, dt_raw = jnp.split(proj, SPLIT_POINTS, axis=-1)
    q = partial_rope(q.reshape(b, s, N_Q_HEADS, HEAD_DIM), positions)
    k = partial_rope(k.reshape(b, s, N_KV_HEADS, HEAD_DIM), positions)
    v = v.reshape(b, s, N_KV_HEADS, HEAD_DIM)
    attn = rms_norm(sliding_window_attention(q, k, v, sinks), attn_out_norm_w)
    xbc = jax.nn.silu(causal_depthwise_conv(xbc, conv_w, conv_b))
    xs, bm, cm = jnp.split(xbc, (SSD_WIDTH, SSD_WIDTH + SSD_GROUPS * SSD_STATE), axis=-1)
    xs = xs.reshape(b, s, SSD_HEADS, SSD_HEAD_DIM).astype(jnp.float32)
    dt = jax.nn.softplus(dt_raw.astype(jnp.float32) + dt_bias.astype(jnp.float32))
    a = -jnp.exp(a_log.astype(jnp.float32))
    y = ssd_chunked(xs, dt, a,
                    bm.reshape(b, s, SSD_GROUPS, SSD_STATE).astype(jnp.float32),
                    cm.reshape(b, s, SSD_GROUPS, SSD_STATE).astype(jnp.float32))
    y = y + d_skip.astype(jnp.float32)[:, None] * xs
    ssd = gated_group_rms_norm(y.reshape(b, s, SSD_WIDTH), z, ssd_out_norm_w).astype(h.dtype)
    return jnp.concatenate([attn, ssd], axis=-1) @ w_out


def memory_cross_attention(h, mem_h, w_q, w_kv, w_o):
    b, s, _ = h.shape
    m = mem_h.shape[1]
    q = (h @ w_q).reshape(b, s, XATTN_HEADS, XATTN_HEAD_DIM)
    kv = (mem_h @ w_kv).reshape(b, m, 2, XATTN_HEADS, XATTN_HEAD_DIM)
    k, v = kv[:, :, 0], kv[:, :, 1]
    scores = jnp.einsum('bshd,bmhd->bhsm', q, k,
                        preferred_element_type=jnp.float32) * (XATTN_HEAD_DIM ** -0.5)
    probs = jax.nn.softmax(scores, axis=-1).astype(v.dtype)
    out = jnp.einsum('bhsm,bmhd->bshd', probs, v).reshape(b, s, XATTN_WIDTH)
    return out @ w_o


def hierarchical_moe(h, wg, bg, we, be, w_gate, w_up, w_down):
    b, s, d = h.shape
    t = h.reshape(b * s, d)
    g_prob = jax.nn.softmax((t @ wg).astype(jnp.float32) + bg.astype(jnp.float32), axis=-1)
    g_gate, g_idx = lax.top_k(g_prob, 1)
    e_logits = ((t @ we).astype(jnp.float32) + be.astype(jnp.float32)).reshape(-1, N_GROUPS, EXPERTS_PER_GROUP)
    e_sel = jnp.take_along_axis(e_logits, g_idx[:, :, None], axis=1)[:, 0]
    top_vals, top_idx = lax.top_k(e_sel, TOP_K)
    top_w = jax.nn.softmax(top_vals, axis=-1) * g_gate
    expert_id = g_idx * EXPERTS_PER_GROUP + top_idx
    gates = jnp.sum(jax.nn.one_hot(expert_id, N_EXPERTS, dtype=jnp.float32) * top_w[..., None], axis=1)
    gates = gates.astype(t.dtype)
    y = jnp.zeros_like(t)
    for e in range(N_EXPERTS):
        hid = jax.nn.silu(t @ w_gate[e]) * (t @ w_up[e])
        y = y + gates[:, e:e + 1] * (hid @ w_down[e])
    return y.reshape(b, s, d)


def _normal(k, shape, scale):
    return scale * jax.random.normal(k, shape, jnp.float32)


def _gain(k, shape):
    return 1.0 + 0.02 * jax.random.normal(k, shape, jnp.float32)


def setup_inputs(seed: int = 0) -> dict:
    key = jax.random.key(seed)
    ks = jax.random.split(key, 28)
    L = DEPTH
    x = _normal(ks[0], (BATCH, SEQ, D_MODEL), 1.0)
    mem = _normal(ks[1], (BATCH, MEM_TOKENS, D_MODEL), 1.0)
    start = jax.random.randint(ks[2], (BATCH, 1), 0, MAX_POS_OFFSET, dtype=jnp.int32)
    positions = start + jnp.arange(SEQ, dtype=jnp.int32)[None, :]
    mix_norm_w = _gain(ks[3], (L, D_MODEL))
    w_in = _normal(ks[4], (L, D_MODEL, IN_PROJ_DIM), D_MODEL ** -0.5)
    attn_sinks = _normal(ks[5], (L, N_Q_HEADS), 0.5)
    ssd_conv_w = _normal(ks[6], (L, SSD_CONV, SSD_CONV_DIM), SSD_CONV ** -0.5)
    ssd_conv_b = _normal(ks[7], (L, SSD_CONV_DIM), 0.02)
    dt0 = jnp.exp(jax.random.uniform(ks[8], (L, SSD_HEADS), jnp.float32,
                                     minval=math.log(DT_MIN), maxval=math.log(DT_MAX)))
    ssd_dt_bias = dt0 + jnp.log(-jnp.expm1(-dt0))
    ssd_a_log = jnp.log(jax.random.uniform(ks[9], (L, SSD_HEADS), jnp.float32, minval=1.0, maxval=16.0))
    ssd_d = 1.0 + 0.1 * jax.random.normal(ks[10], (L, SSD_HEADS), jnp.float32)
    attn_out_norm_w = _gain(ks[11], (L, ATTN_WIDTH))
    ssd_out_norm_w = _gain(ks[12], (L, SSD_WIDTH))
    w_out = _normal(ks[13], (L, D_MIX, D_MODEL), D_MIX ** -0.5)
    xattn_norm_w = _gain(ks[14], (L, D_MODEL))
    mem_norm_w = _gain(ks[15], (L, D_MODEL))
    xattn_w_q = _normal(ks[16], (L, D_MODEL, XATTN_WIDTH), D_MODEL ** -0.5)
    xattn_w_kv = _normal(ks[17], (L, D_MODEL, 2 * XATTN_WIDTH), D_MODEL ** -0.5)
    xattn_w_o = _normal(ks[18], (L, XATTN_WIDTH, D_MODEL), XATTN_WIDTH ** -0.5)
    ffn_norm_w = _gain(ks[19], (L, D_MODEL))
    router_group_w = _normal(ks[20], (L, D_MODEL, N_GROUPS), D_MODEL ** -0.5)
    router_group_b = _normal(ks[21], (L, N_GROUPS), 0.01)
    router_expert_w = _normal(ks[22], (L, D_MODEL, N_EXPERTS), D_MODEL ** -0.5)
    router_expert_b = _normal(ks[23], (L, N_EXPERTS), 0.01)
    expert_w_gate = _normal(ks[24], (L, N_EXPERTS, D_MODEL, EXPERT_FF), D_MODEL ** -0.5)
    expert_w_up = _normal(ks[25], (L, N_EXPERTS, D_MODEL, EXPERT_FF), D_MODEL ** -0.5)
    expert_w_down = _normal(ks[26], (L, N_EXPERTS, EXPERT_FF, D_MODEL), EXPERT_FF ** -0.5)
    final_norm_w = _gain(ks[27], (D_MODEL,))
    return {
        'x': x, 'mem': mem, 'positions': positions,
        'mix_norm_w': mix_norm_w, 'w_in': w_in, 'attn_sinks': attn_sinks,
        'ssd_conv_w': ssd_conv_w, 'ssd_conv_b': ssd_conv_b, 'ssd_dt_bias': ssd_dt_bias,
        'ssd_a_log': ssd_a_log, 'ssd_d': ssd_d, 'attn_out_norm_w': attn_out_norm_w,
        'ssd_out_norm_w': ssd_out_norm_w, 'w_out': w_out,
        'xattn_norm_w': xattn_norm_w, 'mem_norm_w': mem_norm_w, 'xattn_w_q': xattn_w_q,
        'xattn_w_kv': xattn_w_kv, 'xattn_w_o': xattn_w_o,
        'ffn_norm_w': ffn_norm_w, 'router_group_w': router_group_w, 'router_group_b': router_group_b,
        'router_expert_w': router_expert_w, 'router_expert_b': router_expert_b,
        'expert_w_gate': expert_w_gate, 'expert_w_up': expert_w_up, 'expert_w_down': expert_w_down,
        'final_norm_w': final_norm_w,
    }


def reference(x, mem, positions, mix_norm_w, w_in, attn_sinks, ssd_conv_w, ssd_conv_b,
              ssd_dt_bias, ssd_a_log, ssd_d, attn_out_norm_w, ssd_out_norm_w, w_out,
              xattn_norm_w, mem_norm_w, xattn_w_q, xattn_w_kv, xattn_w_o,
              ffn_norm_w, router_group_w, router_group_b, router_expert_w, router_expert_b,
              expert_w_gate, expert_w_up, expert_w_down, final_norm_w):
    for l in range(DEPTH):
        x = x + hybrid_mixer(rms_norm(x, mix_norm_w[l]), positions, w_in[l], attn_sinks[l],
                             ssd_conv_w[l], ssd_conv_b[l], ssd_dt_bias[l], ssd_a_log[l], ssd_d[l],
                             attn_out_norm_w[l], ssd_out_norm_w[l], w_out[l])
        x = x + memory_cross_attention(rms_norm(x, xattn_norm_w[l]), rms_norm(mem, mem_norm_w[l]),
                                       xattn_w_q[l], xattn_w_kv[l], xattn_w_o[l])
        x = x + hierarchical_moe(rms_norm(x, ffn_norm_w[l]), router_group_w[l], router_group_b[l],
                                 router_expert_w[l], router_expert_b[l],
                                 expert_w_gate[l], expert_w_up[l], expert_w_down[l])
    return rms_norm(x, final_norm_w)
```

```cpp
#include <hip/hip_runtime.h>
#include <hip/hip_cooperative_groups.h>
#include <cstdio>
#include <cmath>
namespace cg = cooperative_groups;

#ifndef MK_ONE_LAUNCH
#define MK_ONE_LAUNCH 0
#endif

typedef unsigned short bf16_t;
typedef short bf16x8 __attribute__((ext_vector_type(8)));
typedef float f32x4 __attribute__((ext_vector_type(4)));
typedef float f32x16 __attribute__((ext_vector_type(16)));
typedef unsigned u32x4 __attribute__((ext_vector_type(4)));
typedef unsigned u32x2 __attribute__((ext_vector_type(2)));

constexpr int NB = 8, SEQ = 4096, DM = 1024, NT = NB * SEQ;
constexpr int NPROJ = 2304, LDWIN = 2312;
constexpr int C_K = 512, C_V = 640, C_Z = 768, C_X = 1280, C_B = 1792, C_C = 2048;
constexpr int MEMT = 256, NMEM = NB * MEMT;
constexpr int NEXP = 32, EFF = 256;
constexpr int NCH = SEQ / 128;
constexpr float EPS = 1e-5f;
constexpr int NTHREADS = 512, NWAVES = 8;
constexpr int LDS_BYTES = 147456;

constexpr size_t MiB = (size_t)1 << 20;
constexpr size_t WS_CTL = 0;
constexpr size_t WS_WIN = 1 * MiB, WS_WOUT = 6 * MiB, WS_WQ = 8 * MiB, WS_WKV = 9 * MiB, WS_WO = 11 * MiB, WS_WR = 12 * MiB;
constexpr size_t WS_WGU = 16 * MiB, WS_WD = 48 * MiB;
constexpr size_t WS_MEMH = 64 * MiB, WS_KMEM = 68 * MiB, WS_VMEMT = 70 * MiB, WS_DTRAW = 72 * MiB, WS_CDEC = 73 * MiB, WS_ROUTE = 74 * MiB;
constexpr size_t WS_LIST = 76 * MiB, WS_SSQ = 80 * MiB;
constexpr size_t WS_PROJ = 96 * MiB, WS_A2 = 240 * MiB, WS_STATES = 304 * MiB, WS_START = 368 * MiB;
constexpr size_t WS_X1 = 96 * MiB, WS_XB = 304 * MiB, WS_Q2 = 368 * MiB, WS_XO = 224 * MiB, WS_HID = 256 * MiB, WS_Y = 368 * MiB;
constexpr size_t WS_NEED = 512 * MiB;

struct Params {
    const float* in[28];
    float* out;
    unsigned char* ws;
    float inv_freq[8];
    int ph_lo, ph_hi;
};

__device__ __forceinline__ unsigned f2bf(float f) { unsigned u = __float_as_uint(f); return (u + 0x7fffu + ((u >> 16) & 1u)) >> 16; }
__device__ __forceinline__ float bf2f(unsigned h) { return __uint_as_float(h << 16); }
__device__ __forceinline__ unsigned pk2(float lo, float hi) { return f2bf(lo) | (f2bf(hi) << 16); }
__device__ __forceinline__ float bflo(unsigned u) { return __uint_as_float(u << 16); }
__device__ __forceinline__ float bfhi(unsigned u) { return __uint_as_float(u & 0xffff0000u); }
__device__ __forceinline__ float wave_sum(float v) {
#pragma unroll
    for (int o = 32; o >= 1; o >>= 1) v += __shfl_xor(v, o);
    return v;
}
#define LDS_WAIT() asm volatile("s_waitcnt lgkmcnt(0)" ::: "memory")
__device__ __forceinline__ int opaque_tid() { int t = threadIdx.x; asm volatile("" : "+v"(t)); return t; }
__device__ __forceinline__ float siluf(float v) { return v / (1.f + __expf(-v)); }
__device__ __forceinline__ f32x16 mfma32(bf16x8 a, bf16x8 b, f32x16 c) { return __builtin_amdgcn_mfma_f32_32x32x16_bf16(a, b, c, 0, 0, 0); }
__device__ __forceinline__ f32x16 zero16() { f32x16 z;
#pragma unroll
    for (int i = 0; i < 16; ++i) z[i] = 0.f;
    return z; }
__device__ __forceinline__ int crow(int i, int h) { return (i & 3) + 8 * (i >> 2) + 4 * h; }

__device__ __forceinline__ void gemm128(unsigned char* lds, const bf16_t* arow, const bf16_t* brow, int K, f32x16& acc0, f32x16& acc1) {
    const int tid = opaque_tid(), lane = tid & 63, w = tid >> 6;
    bf16_t* sA = (bf16_t*)lds;
    bf16_t* sB = sA + 128 * 72;
    const int srow = tid >> 2, skc = (tid & 3) * 16;
    const bf16_t* ap = arow + skc;
    const bf16_t* bp = brow + skc;
    const int wm = w >> 1, wn = w & 1, r = lane & 31, h = lane >> 5;
    acc0 = zero16(); acc1 = zero16();
    for (int k0 = 0; k0 < K; k0 += 64) {
        const u32x4 a0 = *(const u32x4*)(ap + k0), a1 = *(const u32x4*)(ap + k0 + 8);
        const u32x4 b0 = *(const u32x4*)(bp + k0), b1 = *(const u32x4*)(bp + k0 + 8);
        __syncthreads();
        *(u32x4*)(sA + srow * 72 + skc) = a0; *(u32x4*)(sA + srow * 72 + skc + 8) = a1;
        *(u32x4*)(sB + srow * 72 + skc) = b0; *(u32x4*)(sB + srow * 72 + skc + 8) = b1;
        __syncthreads();
#pragma unroll
        for (int kk = 0; kk < 64; kk += 16) {
            const bf16x8 a = *(const bf16x8*)(sA + (wm * 32 + r) * 72 + kk + 8 * h);
            const bf16x8 bA = *(const bf16x8*)(sB + (wn * 64 + r) * 72 + kk + 8 * h);
            const bf16x8 bB = *(const bf16x8*)(sB + (wn * 64 + 32 + r) * 72 + kk + 8 * h);
            acc0 = mfma32(a, bA, acc0); acc1 = mfma32(a, bB, acc1);
        }
    }
    __syncthreads();
}

__device__ __forceinline__ void p0_transpose_item(const float* W, int ldw, int K, int nblk, const float* scale, bf16_t* WT, int row_off, int row_mul, float* scr, int item, int lane) {
    const int kb = item / nblk, nb = item % nblk, k0 = 64 * kb, n0 = 32 * nb;
#pragma unroll 8
    for (int i = 0; i < 32; ++i) { const int kk = 2 * i + (lane >> 5); float v = W[(size_t)(k0 + kk) * ldw + n0 + (lane & 31)]; if (scale) v *= scale[k0 + kk]; scr[kk * 33 + (lane & 31)] = v; }
    LDS_WAIT();
    const int c = lane & 7;
#pragma unroll
    for (int j = 0; j < 4; ++j) { const int n = (lane >> 3) + 8 * j; const float* s = scr + (8 * c) * 33 + n;
        u32x4 o; o.x = pk2(s[0 * 33], s[1 * 33]); o.y = pk2(s[2 * 33], s[3 * 33]); o.z = pk2(s[4 * 33], s[5 * 33]); o.w = pk2(s[6 * 33], s[7 * 33]);
        *(u32x4*)(WT + (size_t)(row_off + (n0 + n) * row_mul) * K + k0 + 8 * c) = o; }
    LDS_WAIT();
}

__device__ __forceinline__ void phase0(const Params& p, unsigned char* lds) {
    const int tid = opaque_tid(), lane = tid & 63, w = tid >> 6;
    unsigned char* ws = p.ws;
    const int gw = blockIdx.x * NWAVES + w, NGW = gridDim.x * NWAVES;
    if (blockIdx.x == 0 && tid < 64) ((int*)(ws + WS_CTL))[tid] = 0;
    {
        float* WR = (float*)(ws + WS_WR);
        const float* w3 = p.in[19]; const float* wg = p.in[20]; const float* we = p.in[22];
        for (int i = blockIdx.x * NTHREADS + tid; i < 36 * 1024; i += gridDim.x * NTHREADS) {
            const int n = i >> 10, k = i & 1023;
            const float v = (n < 4) ? wg[k * 4 + n] : we[k * 32 + (n - 4)];
            WR[i] = v * w3[k];
        }
    }
    {
        float* scr = (float*)(lds + 32768) + w * (64 * 33 + 16);
        constexpr int I_IN = 16 * 72, I_OUT = 16 * 32, I_Q = 16 * 16, I_KV = 16 * 32, I_O = 8 * 32, I_G = 32 * 16 * 8, I_D = 32 * 4 * 32;
        constexpr int NITEMS = I_IN + I_OUT + I_Q + I_KV + I_O + 2 * I_G + I_D;
        for (int it = gw; it < NITEMS; it += NGW) {
            int r = it;
            if (r < I_IN) { p0_transpose_item(p.in[4], LDWIN, 1024, 72, nullptr, (bf16_t*)(ws + WS_WIN), 0, 1, scr, r, lane); continue; } r -= I_IN;
            if (r < I_OUT) { p0_transpose_item(p.in[13], 1024, 1024, 32, nullptr, (bf16_t*)(ws + WS_WOUT), 0, 1, scr, r, lane); continue; } r -= I_OUT;
            if (r < I_Q) { p0_transpose_item(p.in[16], 512, 1024, 16, p.in[14], (bf16_t*)(ws + WS_WQ), 0, 1, scr, r, lane); continue; } r -= I_Q;
            if (r < I_KV) { p0_transpose_item(p.in[17], 1024, 1024, 32, nullptr, (bf16_t*)(ws + WS_WKV), 0, 1, scr, r, lane); continue; } r -= I_KV;
            if (r < I_O) { p0_transpose_item(p.in[18], 1024, 512, 32, nullptr, (bf16_t*)(ws + WS_WO), 0, 1, scr, r, lane); continue; } r -= I_O;
            if (r < I_G) { const int e = r / 128, ri = r % 128; p0_transpose_item(p.in[24] + (size_t)e * 1024 * 256, 256, 1024, 8, p.in[19], (bf16_t*)(ws + WS_WGU) + (size_t)e * 512 * 1024, 0, 2, scr, ri, lane); continue; } r -= I_G;
            if (r < I_G) { const int e = r / 128, ri = r % 128; p0_transpose_item(p.in[25] + (size_t)e * 1024 * 256, 256, 1024, 8, p.in[19], (bf16_t*)(ws + WS_WGU) + (size_t)e * 512 * 1024, 1, 2, scr, ri, lane); continue; } r -= I_G;
            { const int e = r / 128, ri = r % 128; p0_transpose_item(p.in[26] + (size_t)e * 256 * 1024, 1024, 256, 32, nullptr, (bf16_t*)(ws + WS_WD) + (size_t)e * 1024 * 256, 0, 1, scr, ri, lane); }
        }
    }
    float* wdt = (float*)lds;
    {
        const float* win = p.in[4]; const float* w1 = p.in[3];
        for (int i = tid; i < 8192; i += NTHREADS) { const int k = i >> 3, n = i & 7; wdt[n * 1024 + k] = win[(size_t)k * LDWIN + 2304 + n] * w1[k]; }
    }
    __syncthreads();
    {
        const float* x = p.in[0]; const float* w1 = p.in[3];
        bf16_t* h1 = (bf16_t*)p.out; float* dtraw = (float*)(ws + WS_DTRAW);
        f32x4 wv[4];
#pragma unroll
        for (int j = 0; j < 4; ++j) wv[j] = *(const f32x4*)(w1 + 4 * lane + 256 * j);
        for (int m = gw; m < NT; m += NGW) {
            const f32x4* xr = (const f32x4*)(x + (size_t)m * DM) + lane;
            f32x4 v[4]; float s = 0.f;
#pragma unroll
            for (int j = 0; j < 4; ++j) { v[j] = xr[64 * j]; s += (v[j].x * v[j].x + v[j].y * v[j].y) + (v[j].z * v[j].z + v[j].w * v[j].w); }
            const float rstd = 1.f / sqrtf(wave_sum(s) * (1.f / DM) + EPS);
            float d[8];
#pragma unroll
            for (int n = 0; n < 8; ++n) { float a = 0.f;
#pragma unroll
                for (int j = 0; j < 4; ++j) { const f32x4 ww = *(const f32x4*)(wdt + n * 1024 + 4 * lane + 256 * j); a += (v[j].x * ww.x + v[j].y * ww.y) + (v[j].z * ww.z + v[j].w * ww.w); }
                d[n] = wave_sum(a) * rstd; }
            if (lane == 0) { *(f32x4*)(dtraw + (size_t)m * 8) = (f32x4){d[0], d[1], d[2], d[3]}; *(f32x4*)(dtraw + (size_t)m * 8 + 4) = (f32x4){d[4], d[5], d[6], d[7]}; }
            u32x2* o8 = (u32x2*)(h1 + (size_t)m * DM) + lane;
#pragma unroll
            for (int j = 0; j < 4; ++j) { u32x2 o; o.x = pk2(v[j].x * rstd * wv[j].x, v[j].y * rstd * wv[j].y); o.y = pk2(v[j].z * rstd * wv[j].z, v[j].w * rstd * wv[j].w); o8[64 * j] = o; }
        }
    }
    {
        const float* mem = p.in[1]; const float* wm = p.in[15];
        bf16_t* memh = (bf16_t*)(ws + WS_MEMH);
        f32x4 wv[4];
#pragma unroll
        for (int j = 0; j < 4; ++j) wv[j] = *(const f32x4*)(wm + 4 * lane + 256 * j);
        for (int m = gw; m < NMEM; m += NGW) {
            const f32x4* xr = (const f32x4*)(mem + (size_t)m * DM) + lane;
            f32x4 v[4]; float s = 0.f;
#pragma unroll
            for (int j = 0; j < 4; ++j) { v[j] = xr[64 * j]; s += (v[j].x * v[j].x + v[j].y * v[j].y) + (v[j].z * v[j].z + v[j].w * v[j].w); }
            const float rstd = 1.f / sqrtf(wave_sum(s) * (1.f / DM) + EPS);
            u32x2* o8 = (u32x2*)(memh + (size_t)m * DM) + lane;
#pragma unroll
            for (int j = 0; j < 4; ++j) { u32x2 o; o.x = pk2(v[j].x * rstd * wv[j].x, v[j].y * rstd * wv[j].y); o.y = pk2(v[j].z * rstd * wv[j].z, v[j].w * rstd * wv[j].w); o8[64 * j] = o; }
        }
    }
    __syncthreads();
}

__device__ __forceinline__ void phase1(const Params& p, unsigned char* lds) {
    const int tid = opaque_tid(), lane = tid & 63, w = tid >> 6, wm = w >> 1, wn = w & 1, r = lane & 31, h = lane >> 5;
    unsigned char* ws = p.ws;
    const bf16_t* h1 = (const bf16_t*)p.out; const bf16_t* WinT = (const bf16_t*)(ws + WS_WIN);
    bf16_t* proj = (bf16_t*)(ws + WS_PROJ);
    constexpr int NT1 = (NT / 128) * (NPROJ / 128);
    constexpr int NT2 = (NMEM / 128) * (1024 / 128);
    for (int t = blockIdx.x; t < NT1 + NT2; t += gridDim.x) {
        f32x16 acc0, acc1;
        if (t < NT1) {
            const int mt = t / 18, nt = t % 18, m0 = mt * 128, n0 = nt * 128;
            gemm128(lds, h1 + (size_t)(m0 + (tid >> 2)) * DM, WinT + (size_t)(n0 + (tid >> 2)) * DM, DM, acc0, acc1);
#pragma unroll
            for (int i = 0; i < 16; ++i) { const size_t row = m0 + wm * 32 + crow(i, h); const int col = n0 + wn * 64 + r;
                proj[row * NPROJ + col] = (bf16_t)f2bf(acc0[i]); proj[row * NPROJ + col + 32] = (bf16_t)f2bf(acc1[i]); }
        } else {
            const int t2 = t - NT1, mt = t2 / 8, nt = t2 % 8, m0 = mt * 128, n0 = nt * 128;
            const bf16_t* memh = (const bf16_t*)(ws + WS_MEMH); const bf16_t* WkvT = (const bf16_t*)(ws + WS_WKV);
            bf16_t* kmem = (bf16_t*)(ws + WS_KMEM); bf16_t* vmemT = (bf16_t*)(ws + WS_VMEMT);
            gemm128(lds, memh + (size_t)(m0 + (tid >> 2)) * DM, WkvT + (size_t)(n0 + (tid >> 2)) * DM, DM, acc0, acc1);
#pragma unroll
            for (int i = 0; i < 16; ++i) { const int row = m0 + wm * 32 + crow(i, h);
#pragma unroll
                for (int j = 0; j < 2; ++j) { const int col = n0 + wn * 64 + r + 32 * j; const float v = j ? acc1[i] : acc0[i];
                    if (col < 512) kmem[(size_t)row * 512 + col] = (bf16_t)f2bf(v);
                    else { const int c2 = col - 512, hx = c2 >> 7, d = c2 & 127, b = row >> 8, key = row & 255; vmemT[(((size_t)b * 4 + hx) * 128 + d) * 256 + key] = (bf16_t)f2bf(v); } } }
        }
    }
}

__device__ __forceinline__ float bfel(const u32x4& v, int ci) { const unsigned wv = (ci >> 1) == 0 ? v.x : (ci >> 1) == 1 ? v.y : (ci >> 1) == 2 ? v.z : v.w; return (ci & 1) ? bfhi(wv) : bflo(wv); }
template <bool TRANS>
__device__ __forceinline__ void conv8x8(const Params& p, int b, int c, int l0, int ch0, const float (&f)[8], u32x4 (&res)[8]) {
    const bf16_t* proj = (const bf16_t*)(p.ws + WS_PROJ);
    const float* cw = p.in[6]; const float* cb = p.in[7];
    float wgt[4][8], bias[8];
#pragma unroll
    for (int j = 0; j < 4; ++j) { const f32x4 a = *(const f32x4*)(cw + j * 1024 + ch0), b2 = *(const f32x4*)(cw + j * 1024 + ch0 + 4);
        wgt[j][0] = a.x; wgt[j][1] = a.y; wgt[j][2] = a.z; wgt[j][3] = a.w; wgt[j][4] = b2.x; wgt[j][5] = b2.y; wgt[j][6] = b2.z; wgt[j][7] = b2.w; }
    { const f32x4 a = *(const f32x4*)(cb + ch0), b2 = *(const f32x4*)(cb + ch0 + 4); bias[0] = a.x; bias[1] = a.y; bias[2] = a.z; bias[3] = a.w; bias[4] = b2.x; bias[5] = b2.y; bias[6] = b2.z; bias[7] = b2.w; }
    u32x4 in[11];
    const int t0 = c * 128 + l0 - 3;
#pragma unroll
    for (int i = 0; i < 11; ++i) {
        const int t = t0 + i;
        in[i] = (u32x4){0u, 0u, 0u, 0u};
        if (t >= 0) in[i] = *(const u32x4*)(proj + (size_t)(b * SEQ + t) * NPROJ + C_X + ch0);
    }
    if (TRANS) {
#pragma unroll
        for (int ci = 0; ci < 8; ++ci) {
            float o[8];
#pragma unroll
            for (int li = 0; li < 8; ++li) { float a = bias[ci];
#pragma unroll
                for (int j = 0; j < 4; ++j) a += wgt[j][ci] * bfel(in[li + j], ci);
                o[li] = siluf(a) * f[li]; }
            res[ci] = (u32x4){pk2(o[0], o[1]), pk2(o[2], o[3]), pk2(o[4], o[5]), pk2(o[6], o[7])};
        }
    } else {
#pragma unroll
        for (int li = 0; li < 8; ++li) {
            float o[8];
#pragma unroll
            for (int ci = 0; ci < 8; ++ci) { float a = bias[ci];
#pragma unroll
                for (int j = 0; j < 4; ++j) a += wgt[j][ci] * bfel(in[li + j], ci);
                o[ci] = siluf(a) * f[li]; }
            res[li] = (u32x4){pk2(o[0], o[1]), pk2(o[2], o[3]), pk2(o[4], o[5]), pk2(o[6], o[7])};
        }
    }
}

__device__ __forceinline__ void ssd_dt_cum(const Params& p, int b, int c, float* dts, float* cums) {
    const int tid = opaque_tid(), lane = tid & 63, w = tid >> 6;
    const float* dtraw = (const float*)(p.ws + WS_DTRAW);
    const float bias = p.in[8][w], a = -__expf(p.in[9][w]);
    const size_t row0 = (size_t)b * SEQ + c * 128;
    float x0 = dtraw[(row0 + 2 * lane) * 8 + w] + bias, x1 = dtraw[(row0 + 2 * lane + 1) * 8 + w] + bias;
    const float d0 = fmaxf(x0, 0.f) + log1pf(__expf(-fabsf(x0))), d1 = fmaxf(x1, 0.f) + log1pf(__expf(-fabsf(x1)));
    const float a0 = d0 * a, a1 = d1 * a;
    float s = a0 + a1;
#pragma unroll
    for (int o = 1; o < 64; o <<= 1) { const float t = __shfl_up(s, o); if (lane >= o) s += t; }
    dts[w * 128 + 2 * lane] = d0; dts[w * 128 + 2 * lane + 1] = d1;
    cums[w * 128 + 2 * lane] = s - a1; cums[w * 128 + 2 * lane + 1] = s;
}

__device__ __forceinline__ void phase2_attn(const Params& p, unsigned char* lds, int b, int blk) {
    const int tid = opaque_tid(), lane = tid & 63, w = tid >> 6, r = lane & 31, h = lane >> 5;
    const bf16_t* proj = (const bf16_t*)(p.ws + WS_PROJ);
    const int* positions = (const int*)p.in[2];
    float* cs = (float*)lds;
    float* sn = cs + 2048;
    float* ssq = sn + 2048;
    bf16_t* sK = (bf16_t*)(lds + 20480);
    bf16_t* sVT = sK + 256 * 72;
    bf16_t* sP = sVT + 64 * 264;
    bf16_t* sQ = sP + 8 * 32 * 40;
    bf16_t* myP = sP + w * 32 * 40;
    bf16_t* myQ = sQ + w * 32 * 64;
    const int tband0 = blk * 128 - 128;
    for (int i = tid; i < 2048; i += NTHREADS) {
        const int kb = i >> 3, f = i & 7, t = tband0 + kb;
        float c = 1.f, s = 0.f;
        if (t >= 0) { const float ang = (float)positions[b * SEQ + t] * p.inv_freq[f]; const double rev = (double)ang * 0.15915494309189535; const float fr = (float)(rev - floor(rev));
            c = __builtin_amdgcn_cosf(fr); s = __builtin_amdgcn_sinf(fr); }
        cs[i] = c; sn[i] = s;
    }
    __syncthreads();
    float* otmp = p.out + (size_t)16 * 1024 * 1024;
#pragma unroll 1
    for (int g = 0; g < 2; ++g) {
        {
            const int key = tid >> 1, half = tid & 1, t = tband0 + key;
            u32x4 kv[4], vv[4];
#pragma unroll
            for (int q = 0; q < 4; ++q) { kv[q] = (u32x4){0u, 0u, 0u, 0u}; vv[q] = (u32x4){0u, 0u, 0u, 0u}; }
            if (t >= 0) {
                const bf16_t* kp = proj + (size_t)(b * SEQ + t) * NPROJ + C_K + g * 64 + half * 32;
                const bf16_t* vp = proj + (size_t)(b * SEQ + t) * NPROJ + C_V + g * 64 + half * 32;
#pragma unroll
                for (int q = 0; q < 4; ++q) { kv[q] = *(const u32x4*)(kp + 8 * q); vv[q] = *(const u32x4*)(vp + 8 * q); }
            }
            if (half == 0) {
                float x1[8], x2[8];
                x1[0] = bflo(kv[0].x); x1[1] = bfhi(kv[0].x); x1[2] = bflo(kv[0].y); x1[3] = bfhi(kv[0].y); x1[4] = bflo(kv[0].z); x1[5] = bfhi(kv[0].z); x1[6] = bflo(kv[0].w); x1[7] = bfhi(kv[0].w);
                x2[0] = bflo(kv[1].x); x2[1] = bfhi(kv[1].x); x2[2] = bflo(kv[1].y); x2[3] = bfhi(kv[1].y); x2[4] = bflo(kv[1].z); x2[5] = bfhi(kv[1].z); x2[6] = bflo(kv[1].w); x2[7] = bfhi(kv[1].w);
                float o1[8], o2[8];
#pragma unroll
                for (int f = 0; f < 8; ++f) { const float c = cs[key * 8 + f], s = sn[key * 8 + f]; o1[f] = x1[f] * c - x2[f] * s; o2[f] = x2[f] * c + x1[f] * s; }
                kv[0] = (u32x4){pk2(o1[0], o1[1]), pk2(o1[2], o1[3]), pk2(o1[4], o1[5]), pk2(o1[6], o1[7])};
                kv[1] = (u32x4){pk2(o2[0], o2[1]), pk2(o2[2], o2[3]), pk2(o2[4], o2[5]), pk2(o2[6], o2[7])};
            }
#pragma unroll
            for (int q = 0; q < 4; ++q) *(u32x4*)(sK + key * 72 + half * 32 + 8 * q) = kv[q];
#pragma unroll
            for (int q = 0; q < 4; ++q) {
                const int d0 = half * 32 + 8 * q;
                sVT[(d0 + 0) * 264 + key] = (bf16_t)(vv[q].x & 0xffffu); sVT[(d0 + 1) * 264 + key] = (bf16_t)(vv[q].x >> 16);
                sVT[(d0 + 2) * 264 + key] = (bf16_t)(vv[q].y & 0xffffu); sVT[(d0 + 3) * 264 + key] = (bf16_t)(vv[q].y >> 16);
                sVT[(d0 + 4) * 264 + key] = (bf16_t)(vv[q].z & 0xffffu); sVT[(d0 + 5) * 264 + key] = (bf16_t)(vv[q].z >> 16);
                sVT[(d0 + 6) * 264 + key] = (bf16_t)(vv[q].w & 0xffffu); sVT[(d0 + 7) * 264 + key] = (bf16_t)(vv[q].w >> 16);
            }
        }
        __syncthreads();
#pragma unroll 1
        for (int uu = 0; uu < 2; ++uu) {
            const int u = w + 8 * uu, hq = g * 4 + (u >> 2), rg = u & 3, r0 = rg * 32;
            {
                const int qr = lane >> 1, half = lane & 1, t = blk * 128 + r0 + qr;
                const bf16_t* qp = proj + (size_t)(b * SEQ + t) * NPROJ + hq * 64 + half * 32;
                u32x4 qv[4];
#pragma unroll
                for (int q = 0; q < 4; ++q) qv[q] = *(const u32x4*)(qp + 8 * q);
                if (half == 0) {
                    float x1[8], x2[8];
                    x1[0] = bflo(qv[0].x); x1[1] = bfhi(qv[0].x); x1[2] = bflo(qv[0].y); x1[3] = bfhi(qv[0].y); x1[4] = bflo(qv[0].z); x1[5] = bfhi(qv[0].z); x1[6] = bflo(qv[0].w); x1[7] = bfhi(qv[0].w);
                    x2[0] = bflo(qv[1].x); x2[1] = bfhi(qv[1].x); x2[2] = bflo(qv[1].y); x2[3] = bfhi(qv[1].y); x2[4] = bflo(qv[1].z); x2[5] = bfhi(qv[1].z); x2[6] = bflo(qv[1].w); x2[7] = bfhi(qv[1].w);
                    float o1[8], o2[8];
                    const int kb = 128 + r0 + qr;
#pragma unroll
                    for (int f = 0; f < 8; ++f) { const float c = cs[kb * 8 + f], s = sn[kb * 8 + f]; o1[f] = x1[f] * c - x2[f] * s; o2[f] = x2[f] * c + x1[f] * s; }
                    qv[0] = (u32x4){pk2(o1[0], o1[1]), pk2(o1[2], o1[3]), pk2(o1[4], o1[5]), pk2(o1[6], o1[7])};
                    qv[1] = (u32x4){pk2(o2[0], o2[1]), pk2(o2[2], o2[3]), pk2(o2[4], o2[5]), pk2(o2[6], o2[7])};
                }
#pragma unroll
                for (int q = 0; q < 4; ++q) *(u32x4*)(myQ + qr * 64 + half * 32 + 8 * q) = qv[q];
            }
            LDS_WAIT();
            f32x16 S[5];
#pragma unroll
            for (int jt = 0; jt < 5; ++jt) S[jt] = zero16();
#pragma unroll
            for (int kk = 0; kk < 64; kk += 16) {
                const bf16x8 a = *(const bf16x8*)(myQ + r * 64 + kk + 8 * h);
#pragma unroll
                for (int jt = 0; jt < 5; ++jt) { const bf16x8 bb = *(const bf16x8*)(sK + ((rg + jt) * 32 + r) * 72 + kk + 8 * h); S[jt] = mfma32(a, bb, S[jt]); }
            }
            const float sink = p.in[5][hq];
            float sm[16];
#pragma unroll
            for (int i = 0; i < 16; ++i) {
                const int qb = 128 + r0 + crow(i, h);
                float m = -INFINITY;
#pragma unroll
                for (int jt = 0; jt < 5; ++jt) { const int kbx = (rg + jt) * 32 + r; const int rel = qb - kbx; const bool ok = (rel >= 0) && (rel < 128) && (tband0 + kbx >= 0);
                    const float v = ok ? S[jt][i] * 0.125f : -INFINITY; S[jt][i] = v; m = fmaxf(m, v); }
#pragma unroll
                for (int o = 16; o >= 1; o >>= 1) m = fmaxf(m, __shfl_xor(m, o));
                m = fmaxf(m, sink);
                float s = 0.f;
#pragma unroll
                for (int jt = 0; jt < 5; ++jt) { const float e = __expf(S[jt][i] - m); S[jt][i] = e; s += e; }
#pragma unroll
                for (int o = 16; o >= 1; o >>= 1) s += __shfl_xor(s, o);
                sm[i] = s + __expf(sink - m);
            }
            f32x16 O0 = zero16(), O1 = zero16();
#pragma unroll
            for (int jt = 0; jt < 5; ++jt) {
#pragma unroll
                for (int i = 0; i < 16; ++i) myP[crow(i, h) * 40 + r] = (bf16_t)f2bf(S[jt][i]);
                LDS_WAIT();
#pragma unroll
                for (int kk = 0; kk < 32; kk += 16) {
                    const bf16x8 a = *(const bf16x8*)(myP + r * 40 + kk + 8 * h);
                    const bf16x8 b0 = *(const bf16x8*)(sVT + r * 264 + (rg + jt) * 32 + kk + 8 * h);
                    const bf16x8 b1 = *(const bf16x8*)(sVT + (32 + r) * 264 + (rg + jt) * 32 + kk + 8 * h);
                    O0 = mfma32(a, b0, O0); O1 = mfma32(a, b1, O1);
                }
                LDS_WAIT();
            }
            int qlb = r0 + 4 * h;
            asm volatile("" : "+v"(qlb));
            float* opb = otmp + (size_t)(b * SEQ + blk * 128 + qlb) * 512 + hq * 64 + r;
#pragma unroll
            for (int i = 0; i < 16; ++i) {
                const int dl = (i & 3) + 8 * (i >> 2);
                const int ql = qlb + dl;
                const float inv = 1.f / sm[i];
                const float v0 = O0[i] * inv, v1 = O1[i] * inv;
                opb[dl * 512] = v0; opb[dl * 512 + 32] = v1;
                float q = v0 * v0 + v1 * v1;
#pragma unroll
                for (int o = 16; o >= 1; o >>= 1) q += __shfl_xor(q, o);
                if (r == 0) ssq[ql * 8 + hq] = q;
            }
        }
        __syncthreads();
    }
    {
        bf16_t* A2 = (bf16_t*)(p.ws + WS_A2);
        const float* wa = p.in[11];
        for (int i = tid; i < 128 * 64; i += NTHREADS) {
            const int ql = i >> 6, c8 = (i & 63) * 8;
            float s = 0.f;
#pragma unroll
            for (int q = 0; q < 8; ++q) s += ssq[ql * 8 + q];
            const float rstd = 1.f / sqrtf(s * (1.f / 512.f) + EPS);
            const size_t row = (size_t)b * SEQ + blk * 128 + ql;
            const f32x4 a = *(const f32x4*)(otmp + row * 512 + c8), bq = *(const f32x4*)(otmp + row * 512 + c8 + 4);
            const f32x4 w0 = *(const f32x4*)(wa + c8), w1 = *(const f32x4*)(wa + c8 + 4);
            u32x4 o; o.x = pk2(a.x * rstd * w0.x, a.y * rstd * w0.y); o.y = pk2(a.z * rstd * w0.z, a.w * rstd * w0.w); o.z = pk2(bq.x * rstd * w1.x, bq.y * rstd * w1.y); o.w = pk2(bq.z * rstd * w1.z, bq.w * rstd * w1.w);
            *(u32x4*)(A2 + row * 1024 + c8) = o;
        }
    }
    __syncthreads();
}

__device__ __forceinline__ void phase2_states(const Params& p, unsigned char* lds, int b, int c) {
    const int tid = opaque_tid(), lane = tid & 63, w = tid >> 6, r = lane & 31, h = lane >> 5;
    float* dts = (float*)lds;
    float* cums = dts + 1024;
    bf16_t* sBT = (bf16_t*)(lds + 8192);
    bf16_t* sXT = sBT + 128 * 136;
    ssd_dt_cum(p, b, c, dts, cums);
    __syncthreads();
    float* states = (float*)(p.ws + WS_STATES);
    if (tid < 8) ((float*)(p.ws + WS_CDEC))[(b * NCH + c) * 8 + tid] = __expf(cums[tid * 128 + 127]);
#pragma unroll 1
    for (int g = 0; g < 2; ++g) {
        if (tid < 256) {
            const int cg8 = tid & 15, lr = tid >> 4;
            const float one[8] = {1.f, 1.f, 1.f, 1.f, 1.f, 1.f, 1.f, 1.f};
            u32x4 res[8];
            conv8x8<true>(p, b, c, lr * 8, 512 + g * 128 + cg8 * 8, one, res);
#pragma unroll
            for (int ci = 0; ci < 8; ++ci) *(u32x4*)(sBT + (cg8 * 8 + ci) * 136 + lr * 8) = res[ci];
        }
        {
            const int cg8 = tid & 31, lr = tid >> 5, hh = cg8 >> 3, hd = g * 4 + hh;
            float f[8];
            const float cl = cums[hd * 128 + 127];
#pragma unroll
            for (int li = 0; li < 8; ++li) f[li] = dts[hd * 128 + lr * 8 + li] * __expf(cl - cums[hd * 128 + lr * 8 + li]);
            u32x4 res[8];
            conv8x8<true>(p, b, c, lr * 8, g * 256 + cg8 * 8, f, res);
#pragma unroll
            for (int ci = 0; ci < 8; ++ci) *(u32x4*)(sXT + (cg8 * 8 + ci) * 136 + lr * 8) = res[ci];
        }
        __syncthreads();
        {
            f32x16 acc[4];
#pragma unroll
            for (int j = 0; j < 4; ++j) acc[j] = zero16();
#pragma unroll
            for (int kk = 0; kk < 128; kk += 16) {
                const bf16x8 a = *(const bf16x8*)(sXT + (w * 32 + r) * 136 + kk + 8 * h);
#pragma unroll
                for (int j = 0; j < 4; ++j) { const bf16x8 bb = *(const bf16x8*)(sBT + (j * 32 + r) * 136 + kk + 8 * h); acc[j] = mfma32(a, bb, acc[j]); }
            }
            const int hd = g * 4 + (w >> 1), p0 = (w & 1) * 32;
            float* sp = states + ((size_t)((b * NCH + c) * 8 + hd) * 64) * 128;
#pragma unroll
            for (int j = 0; j < 4; ++j)
#pragma unroll
                for (int i = 0; i < 16; ++i) sp[(size_t)(p0 + crow(i, h)) * 128 + j * 32 + r] = acc[j][i];
        }
        __syncthreads();
    }
}

__device__ __forceinline__ void phase3(const Params& p) {
    const float* states = (const float*)(p.ws + WS_STATES);
    const float* cdec = (const float*)(p.ws + WS_CDEC);
    bf16_t* start = (bf16_t*)(p.ws + WS_START);
    for (int u = blockIdx.x * NTHREADS + threadIdx.x; u < 131072; u += gridDim.x * NTHREADS) {
        const int n4 = u & 31, pp = (u >> 5) & 63, hd = (u >> 11) & 7, b = u >> 14;
        f32x4 s = (f32x4){0.f, 0.f, 0.f, 0.f};
        for (int c = 0; c < NCH; ++c) {
            const size_t off = ((size_t)((b * NCH + c) * 8 + hd) * 64 + pp) * 128 + n4 * 4;
            u32x2 o; o.x = pk2(s.x, s.y); o.y = pk2(s.z, s.w);
            *(u32x2*)(start + off) = o;
            const f32x4 st = *(const f32x4*)(states + off);
            const float d = cdec[(b * NCH + c) * 8 + hd];
            s = s * d + st;
        }
    }
}

__device__ __forceinline__ void phase4(const Params& p, unsigned char* lds, int b, int c) {
    const int tid = opaque_tid(), lane = tid & 63, w = tid >> 6, r = lane & 31, h = lane >> 5;
    float* dts = (float*)lds;
    float* cums = dts + 1024;
    float* gsq = cums + 1024;
    bf16_t* sC = (bf16_t*)(lds + 12288);
    bf16_t* sB = sC + 128 * 136;
    bf16_t* sM = sB + 128 * 136;
    bf16_t* sXT = sM + 128 * 136;
    const bf16_t* proj = (const bf16_t*)(p.ws + WS_PROJ);
    const bf16_t* start = (const bf16_t*)(p.ws + WS_START);
    float* gtmp = p.out;
    bf16_t* A2 = (bf16_t*)(p.ws + WS_A2);
    ssd_dt_cum(p, b, c, dts, cums);
    __syncthreads();
    const size_t row0 = (size_t)b * SEQ + c * 128;
#pragma unroll 1
    for (int g = 0; g < 2; ++g) {
        {
            const int which = tid >> 8, cg8 = tid & 15, lr = (tid >> 4) & 15;
            const float one[8] = {1.f, 1.f, 1.f, 1.f, 1.f, 1.f, 1.f, 1.f};
            u32x4 res[8];
            conv8x8<false>(p, b, c, lr * 8, (which ? 768 : 512) + g * 128 + cg8 * 8, one, res);
            bf16_t* dst = which ? sC : sB;
#pragma unroll
            for (int li = 0; li < 8; ++li) *(u32x4*)(dst + (lr * 8 + li) * 136 + cg8 * 8) = res[li];
        }
        __syncthreads();
        f32x16 cb0 = zero16(), cb1 = zero16();
        const int lt = w >> 1, st0 = 2 * (w & 1);
#pragma unroll 2
        for (int kk = 0; kk < 128; kk += 16) {
            const bf16x8 a = *(const bf16x8*)(sC + (lt * 32 + r) * 136 + kk + 8 * h);
            const bf16x8 b0 = *(const bf16x8*)(sB + (st0 * 32 + r) * 136 + kk + 8 * h);
            const bf16x8 b1 = *(const bf16x8*)(sB + ((st0 + 1) * 32 + r) * 136 + kk + 8 * h);
            cb0 = mfma32(a, b0, cb0); cb1 = mfma32(a, b1, cb1);
        }
#pragma unroll 1
        for (int hh = 0; hh < 4; ++hh) {
            const int hd = g * 4 + hh;
#pragma unroll
            for (int i = 0; i < 16; ++i) {
                const int l = lt * 32 + crow(i, h);
                const float cl = cums[hd * 128 + l];
                { const int s = st0 * 32 + r; const float v = (s <= l) ? cb0[i] * __expf(cl - cums[hd * 128 + s]) * dts[hd * 128 + s] : 0.f; sM[l * 136 + s] = (bf16_t)f2bf(v); }
                { const int s = (st0 + 1) * 32 + r; const float v = (s <= l) ? cb1[i] * __expf(cl - cums[hd * 128 + s]) * dts[hd * 128 + s] : 0.f; sM[l * 136 + s] = (bf16_t)f2bf(v); }
            }
            if (tid < 128) {
                const int cg8 = tid & 7, lr = tid >> 3;
                const float one[8] = {1.f, 1.f, 1.f, 1.f, 1.f, 1.f, 1.f, 1.f};
                u32x4 res[8];
                conv8x8<true>(p, b, c, lr * 8, hd * 64 + cg8 * 8, one, res);
#pragma unroll
                for (int ci = 0; ci < 8; ++ci) *(u32x4*)(sXT + (cg8 * 8 + ci) * 136 + lr * 8) = res[ci];
            }
            __syncthreads();
            {
                const int lt2 = w >> 1, pt = w & 1;
                f32x16 yd = zero16(), yo = zero16();
#pragma unroll 2
                for (int kk = 0; kk < 128; kk += 16) {
                    const bf16x8 a = *(const bf16x8*)(sM + (lt2 * 32 + r) * 136 + kk + 8 * h);
                    const bf16x8 bb = *(const bf16x8*)(sXT + (pt * 32 + r) * 136 + kk + 8 * h);
                    yd = mfma32(a, bb, yd);
                }
                const bf16_t* stp = start + ((size_t)((b * NCH + c) * 8 + hd) * 64 + pt * 32 + r) * 128;
#pragma unroll 2
                for (int kk = 0; kk < 128; kk += 16) {
                    const bf16x8 a = *(const bf16x8*)(sC + (lt2 * 32 + r) * 136 + kk + 8 * h);
                    const bf16x8 bb = *(const bf16x8*)(stp + kk + 8 * h);
                    yo = mfma32(a, bb, yo);
                }
                const float dsk = p.in[10][hd];
                const int pcol = pt * 32 + r;
                int lb = lt2 * 32 + 4 * h;
                asm volatile("" : "+v"(lb));
                const bf16_t* zp = proj + (row0 + lb) * NPROJ + C_Z + hd * 64 + pcol;
                float* gp = gtmp + (row0 + lb) * 512 + hd * 64 + pcol;
#pragma unroll
                for (int i = 0; i < 16; ++i) {
                    const int dl = (i & 3) + 8 * (i >> 2);
                    const int l = lb + dl;
                    const float xs = bf2f((unsigned)sXT[pcol * 136 + l]);
                    const float y = yd[i] + __expf(cums[hd * 128 + l]) * yo[i] + dsk * xs;
                    const float z = bf2f((unsigned)zp[(size_t)dl * NPROJ]);
                    const float gv = y * siluf(z);
                    gp[dl * 512] = gv;
                    float q = gv * gv;
#pragma unroll
                    for (int o = 16; o >= 1; o >>= 1) q += __shfl_xor(q, o);
                    if (r == 0) gsq[l * 8 + hh * 2 + pt] = q;
                }
            }
            __syncthreads();
        }
        {
            const float* wsn = p.in[12];
            for (int i = tid; i < 128 * 32; i += NTHREADS) {
                const int l = i >> 5, c8 = (i & 31) * 8;
                float s = 0.f;
#pragma unroll
                for (int q = 0; q < 8; ++q) s += gsq[l * 8 + q];
                const float rstd = 1.f / sqrtf(s * (1.f / 256.f) + EPS);
                const f32x4 a = *(const f32x4*)(gtmp + (row0 + l) * 512 + g * 256 + c8), bq = *(const f32x4*)(gtmp + (row0 + l) * 512 + g * 256 + c8 + 4);
                const f32x4 w0 = *(const f32x4*)(wsn + g * 256 + c8), w1 = *(const f32x4*)(wsn + g * 256 + c8 + 4);
                u32x4 o; o.x = pk2(a.x * rstd * w0.x, a.y * rstd * w0.y); o.y = pk2(a.z * rstd * w0.z, a.w * rstd * w0.w); o.z = pk2(bq.x * rstd * w1.x, bq.y * rstd * w1.y); o.w = pk2(bq.z * rstd * w1.z, bq.w * rstd * w1.w);
                *(u32x4*)(A2 + (row0 + l) * 1024 + 512 + g * 256 + c8) = o;
            }
        }
        __syncthreads();
    }
}

__device__ __forceinline__ void phase_resid_gemm(const Params& p, unsigned char* lds, const bf16_t* A, int K, const bf16_t* Bt, const float* xin, float* xout, bf16_t* xb, float* ssq) {
    const int tid = opaque_tid(), lane = tid & 63, w = tid >> 6, wm = w >> 1, wn = w & 1, r = lane & 31, h = lane >> 5;
    for (int t = blockIdx.x; t < (NT / 128) * 8; t += gridDim.x) {
        const int mt = t >> 3, nt = t & 7, m0 = mt * 128, n0 = nt * 128;
        f32x16 acc0, acc1;
        gemm128(lds, A + (size_t)(m0 + (tid >> 2)) * K, Bt + (size_t)(n0 + (tid >> 2)) * K, K, acc0, acc1);
#pragma unroll
        for (int i = 0; i < 16; ++i) {
            const size_t row = m0 + wm * 32 + crow(i, h); const int col = n0 + wn * 64 + r;
            const float v0 = xin[row * DM + col] + acc0[i], v1 = xin[row * DM + col + 32] + acc1[i];
            xout[row * DM + col] = v0; xout[row * DM + col + 32] = v1;
            xb[row * DM + col] = (bf16_t)f2bf(v0); xb[row * DM + col + 32] = (bf16_t)f2bf(v1);
            float q = v0 * v0 + v1 * v1;
#pragma unroll
            for (int o = 16; o >= 1; o >>= 1) q += __shfl_xor(q, o);
            if (r == 0) ssq[row * 16 + nt * 2 + wn] = q;
        }
    }
}

__device__ __forceinline__ void phase6(const Params& p, unsigned char* lds) {
    const int tid = opaque_tid(), lane = tid & 63, w = tid >> 6, wm = w >> 1, wn = w & 1, r = lane & 31, h = lane >> 5;
    const bf16_t* xb = (const bf16_t*)(p.ws + WS_XB); const bf16_t* WqT = (const bf16_t*)(p.ws + WS_WQ);
    const float* ssq = (const float*)(p.ws + WS_SSQ);
    bf16_t* q2 = (bf16_t*)(p.ws + WS_Q2);
    for (int t = blockIdx.x; t < (NT / 128) * 4; t += gridDim.x) {
        const int mt = t >> 2, nt = t & 3, m0 = mt * 128, n0 = nt * 128;
        f32x16 acc0, acc1;
        gemm128(lds, xb + (size_t)(m0 + (tid >> 2)) * DM, WqT + (size_t)(n0 + (tid >> 2)) * DM, DM, acc0, acc1);
#pragma unroll
        for (int i = 0; i < 16; ++i) {
            const size_t row = m0 + wm * 32 + crow(i, h); const int col = n0 + wn * 64 + r;
            const f32x4* sp = (const f32x4*)(ssq + row * 16);
            const f32x4 s0 = sp[0], s1 = sp[1], s2 = sp[2], s3 = sp[3];
            const float s = ((s0.x + s0.y) + (s0.z + s0.w)) + ((s1.x + s1.y) + (s1.z + s1.w)) + ((s2.x + s2.y) + (s2.z + s2.w)) + ((s3.x + s3.y) + (s3.z + s3.w));
            const float rstd = 1.f / sqrtf(s * (1.f / DM) + EPS);
            q2[row * 512 + col] = (bf16_t)f2bf(acc0[i] * rstd); q2[row * 512 + col + 32] = (bf16_t)f2bf(acc1[i] * rstd);
        }
    }
}

__device__ __forceinline__ void phase7(const Params& p, unsigned char* lds) {
    const int tid = opaque_tid(), lane = tid & 63, w = tid >> 6, r = lane & 31, h = lane >> 5;
    const bf16_t* q2 = (const bf16_t*)(p.ws + WS_Q2); const bf16_t* kmem = (const bf16_t*)(p.ws + WS_KMEM); const bf16_t* vmemT = (const bf16_t*)(p.ws + WS_VMEMT);
    bf16_t* xo = (bf16_t*)(p.ws + WS_XO);
    bf16_t* myP = (bf16_t*)lds + w * 32 * 264;
    const float scale = 0.08838834764831845f;
    for (int it = blockIdx.x; it < 512; it += gridDim.x) {
        const int rb = it >> 2, hx = it & 3, b = rb >> 4;
        const size_t row0 = (size_t)rb * 256 + w * 32;
        f32x16 S[8];
#pragma unroll
        for (int j = 0; j < 8; ++j) S[j] = zero16();
        const bf16_t* qp = q2 + (row0 + r) * 512 + hx * 128 + 8 * h;
        const bf16_t* kp = kmem + ((size_t)b * 256 + r) * 512 + hx * 128 + 8 * h;
#pragma unroll
        for (int kk = 0; kk < 128; kk += 16) {
            const bf16x8 a = *(const bf16x8*)(qp + kk);
#pragma unroll
            for (int j = 0; j < 8; ++j) { const bf16x8 bb = *(const bf16x8*)(kp + (size_t)j * 32 * 512 + kk); S[j] = mfma32(a, bb, S[j]); }
        }
        float inv[16];
#pragma unroll
        for (int i = 0; i < 16; ++i) {
            float m = -INFINITY;
#pragma unroll
            for (int j = 0; j < 8; ++j) { const float v = S[j][i] * scale; S[j][i] = v; m = fmaxf(m, v); }
#pragma unroll
            for (int o = 16; o >= 1; o >>= 1) m = fmaxf(m, __shfl_xor(m, o));
            float s = 0.f;
#pragma unroll
            for (int j = 0; j < 8; ++j) { const float e = __expf(S[j][i] - m); S[j][i] = e; s += e; }
#pragma unroll
            for (int o = 16; o >= 1; o >>= 1) s += __shfl_xor(s, o);
            inv[i] = 1.f / s;
        }
#pragma unroll
        for (int j = 0; j < 8; ++j)
#pragma unroll
            for (int i = 0; i < 16; ++i) myP[crow(i, h) * 264 + j * 32 + r] = (bf16_t)f2bf(S[j][i]);
        LDS_WAIT();
        f32x16 O[4];
#pragma unroll
        for (int j = 0; j < 4; ++j) O[j] = zero16();
        const bf16_t* vp = vmemT + (((size_t)b * 4 + hx) * 128 + r) * 256 + 8 * h;
#pragma unroll
        for (int kk = 0; kk < 256; kk += 16) {
            const bf16x8 a = *(const bf16x8*)(myP + r * 264 + kk + 8 * h);
#pragma unroll
            for (int j = 0; j < 4; ++j) { const bf16x8 bb = *(const bf16x8*)(vp + (size_t)j * 32 * 256 + kk); O[j] = mfma32(a, bb, O[j]); }
        }
#pragma unroll
        for (int j = 0; j < 4; ++j)
#pragma unroll
            for (int i = 0; i < 16; ++i) xo[(row0 + crow(i, h)) * 512 + hx * 128 + j * 32 + r] = (bf16_t)f2bf(O[j][i] * inv[i]);
        LDS_WAIT();
    }
}

__device__ __forceinline__ void phase9(const Params& p) {
    const int tid = opaque_tid(), lane = tid & 63, w = tid >> 6;
    const int gw = blockIdx.x * NWAVES + w, NGW = gridDim.x * NWAVES;
    const float* x2 = (const float*)(p.ws + WS_X1);
    const float* WR = (const float*)(p.ws + WS_WR);
    int* cnt = (int*)(p.ws + WS_CTL);
    int* list = (int*)(p.ws + WS_LIST);
    float* route = (float*)(p.ws + WS_ROUTE);
    const float* bg = p.in[21]; const float* be = p.in[23];
    for (int m = gw; m < NT; m += NGW) {
        const f32x4* xr = (const f32x4*)(x2 + (size_t)m * DM) + lane;
        f32x4 v[4]; float s = 0.f;
#pragma unroll
        for (int j = 0; j < 4; ++j) { v[j] = xr[64 * j]; s += (v[j].x * v[j].x + v[j].y * v[j].y) + (v[j].z * v[j].z + v[j].w * v[j].w); }
        const float rstd = 1.f / sqrtf(wave_sum(s) * (1.f / DM) + EPS);
        float mine = 0.f;
#pragma unroll 4
        for (int n = 0; n < 36; ++n) {
            float a = 0.f;
#pragma unroll
            for (int j = 0; j < 4; ++j) { const f32x4 ww = *(const f32x4*)(WR + n * 1024 + 4 * lane + 256 * j); a += (v[j].x * ww.x + v[j].y * ww.y) + (v[j].z * ww.z + v[j].w * ww.w); }
            a = wave_sum(a) * rstd;
            if (lane == n) mine = a;
        }
        if (lane < 4) mine += bg[lane]; else if (lane < 36) mine += be[lane - 4];
        const float g0 = __shfl(mine, 0), g1 = __shfl(mine, 1), g2 = __shfl(mine, 2), g3 = __shfl(mine, 3);
        int gi = 0; float gm = g0;
        if (g1 > gm) { gm = g1; gi = 1; }
        if (g2 > gm) { gm = g2; gi = 2; }
        if (g3 > gm) { gm = g3; gi = 3; }
        const float gden = __expf(g0 - gm) + __expf(g1 - gm) + __expf(g2 - gm) + __expf(g3 - gm);
        const float ggate = 1.f / gden;
        float ev[8];
#pragma unroll
        for (int j = 0; j < 8; ++j) ev[j] = __shfl(mine, 4 + gi * 8 + j);
        int i1 = 0; float v1 = ev[0];
#pragma unroll
        for (int j = 1; j < 8; ++j) if (ev[j] > v1) { v1 = ev[j]; i1 = j; }
        int i2 = -1; float v2 = -INFINITY;
#pragma unroll
        for (int j = 0; j < 8; ++j) if (j != i1 && ev[j] > v2) { v2 = ev[j]; i2 = j; }
        const float e2 = __expf(v2 - v1);
        const float w1 = ggate / (1.f + e2), w2 = ggate * e2 / (1.f + e2);
        if (lane == 0) {
            const int ea = gi * 8 + i1, eb = gi * 8 + i2;
            const int pa = atomicAdd(cnt + ea, 1), pb = atomicAdd(cnt + eb, 1);
            list[ea * NT + pa] = m; list[eb * NT + pb] = m;
            int* ri = (int*)(route + (size_t)m * 8);
            ri[0] = ea; ri[1] = eb; ri[2] = pa; ri[3] = pb;
            route[(size_t)m * 8 + 4] = w1; route[(size_t)m * 8 + 5] = w2; route[(size_t)m * 8 + 6] = rstd; route[(size_t)m * 8 + 7] = 0.f;
        }
    }
}

__device__ __forceinline__ void moe_offsets(const Params& p, int* off) {
    const int* cnt = (const int*)(p.ws + WS_CTL);
    if (threadIdx.x == 0) { int a = 0; for (int e = 0; e < NEXP; ++e) { off[e] = a; a += ((cnt[e] + 255) >> 8) << 8; } off[NEXP] = a; }
    if (threadIdx.x < NEXP) off[40 + threadIdx.x] = cnt[threadIdx.x];
    __syncthreads();
}

__device__ __forceinline__ void phase11(const Params& p, unsigned char* lds) {
    const int tid = opaque_tid(), lane = tid & 63, w = tid >> 6, wm = w >> 1, wn = w & 1, r = lane & 31, h = lane >> 5;
    int* off = (int*)(lds + 40960);
    moe_offsets(p, off);
    const bf16_t* xb = (const bf16_t*)(p.ws + WS_XB); const bf16_t* WguT = (const bf16_t*)(p.ws + WS_WGU);
    const int* list = (const int*)(p.ws + WS_LIST); const float* route = (const float*)(p.ws + WS_ROUTE);
    bf16_t* hid = (bf16_t*)(p.ws + WS_HID);
    const int nrt = off[NEXP] >> 7;
    for (int t = blockIdx.x; t < nrt * 4; t += gridDim.x) {
        const int rt = t >> 2, nt = t & 3, s0 = rt * 128, n0 = nt * 128;
        int e = 0;
        for (int q = 1; q < NEXP; ++q) if (off[q] <= s0) e = q;
        const int cnt_e = off[40 + e], pos0 = s0 - off[e];
        const int prow = pos0 + (tid >> 2);
        const int tok = (prow < cnt_e) ? list[e * NT + prow] : 0;
        f32x16 acc0, acc1;
        gemm128(lds, xb + (size_t)tok * DM, WguT + ((size_t)e * 512 + n0 + (tid >> 2)) * DM, DM, acc0, acc1);
#pragma unroll
        for (int i = 0; i < 16; ++i) {
            const int lr = wm * 32 + crow(i, h), pr = pos0 + lr;
            float rs = 0.f;
            if (pr < cnt_e) rs = route[(size_t)list[e * NT + pr] * 8 + 6];
            const float a0 = acc0[i] * rs, a1 = acc1[i] * rs;
            const float b0 = __shfl_xor(a0, 1), b1 = __shfl_xor(a1, 1);
            if ((r & 1) == 0) {
                const int j0 = (n0 + wn * 64 + r) >> 1;
                hid[(size_t)(s0 + lr) * EFF + j0] = (bf16_t)f2bf(siluf(a0) * b0);
                hid[(size_t)(s0 + lr) * EFF + j0 + 16] = (bf16_t)f2bf(siluf(a1) * b1);
            }
        }
    }
}

__device__ __forceinline__ void phase12(const Params& p, unsigned char* lds) {
    const int tid = opaque_tid(), lane = tid & 63, w = tid >> 6, wm = w >> 1, wn = w & 1, r = lane & 31, h = lane >> 5;
    int* off = (int*)(lds + 40960);
    moe_offsets(p, off);
    const bf16_t* hid = (const bf16_t*)(p.ws + WS_HID); const bf16_t* WdT = (const bf16_t*)(p.ws + WS_WD);
    bf16_t* yb = (bf16_t*)(p.ws + WS_Y);
    const int nrt = off[NEXP] >> 7;
    for (int t = blockIdx.x; t < nrt * 8; t += gridDim.x) {
        const int rt = t >> 3, nt = t & 7, s0 = rt * 128, n0 = nt * 128;
        int e = 0;
        for (int q = 1; q < NEXP; ++q) if (off[q] <= s0) e = q;
        f32x16 acc0, acc1;
        gemm128(lds, hid + (size_t)(s0 + (tid >> 2)) * EFF, WdT + ((size_t)e * 1024 + n0 + (tid >> 2)) * EFF, EFF, acc0, acc1);
#pragma unroll
        for (int i = 0; i < 16; ++i) {
            const size_t row = s0 + wm * 32 + crow(i, h); const int col = n0 + wn * 64 + r;
            yb[row * DM + col] = (bf16_t)f2bf(acc0[i]); yb[row * DM + col + 32] = (bf16_t)f2bf(acc1[i]);
        }
    }
}

__device__ __forceinline__ void phase13(const Params& p, unsigned char* lds) {
    const int tid = opaque_tid(), lane = tid & 63, w = tid >> 6;
    int* off = (int*)(lds + 40960);
    moe_offsets(p, off);
    const int gw = blockIdx.x * NWAVES + w, NGW = gridDim.x * NWAVES;
    const float* x2 = (const float*)(p.ws + WS_X1); const bf16_t* yb = (const bf16_t*)(p.ws + WS_Y);
    const float* route = (const float*)(p.ws + WS_ROUTE); const float* wf = p.in[27];
    f32x4 wv[4];
#pragma unroll
    for (int j = 0; j < 4; ++j) wv[j] = *(const f32x4*)(wf + 4 * lane + 256 * j);
    for (int m = gw; m < NT; m += NGW) {
        const int* ri = (const int*)(route + (size_t)m * 8);
        const int ea = ri[0], eb = ri[1], pa = ri[2], pb = ri[3];
        const float w1 = route[(size_t)m * 8 + 4], w2 = route[(size_t)m * 8 + 5];
        const size_t sa = (size_t)off[ea] + pa, sb = (size_t)off[eb] + pb;
        const f32x4* xr = (const f32x4*)(x2 + (size_t)m * DM) + lane;
        const u32x2* ya = (const u32x2*)(yb + sa * DM) + lane; const u32x2* ybp = (const u32x2*)(yb + sb * DM) + lane;
        f32x4 v[4]; float s = 0.f;
#pragma unroll
        for (int j = 0; j < 4; ++j) {
            v[j] = xr[64 * j]; const u32x2 a = ya[64 * j], bq = ybp[64 * j];
            v[j].x += w1 * bflo(a.x) + w2 * bflo(bq.x); v[j].y += w1 * bfhi(a.x) + w2 * bfhi(bq.x);
            v[j].z += w1 * bflo(a.y) + w2 * bflo(bq.y); v[j].w += w1 * bfhi(a.y) + w2 * bfhi(bq.y);
            s += (v[j].x * v[j].x + v[j].y * v[j].y) + (v[j].z * v[j].z + v[j].w * v[j].w);
        }
        const float rstd = 1.f / sqrtf(wave_sum(s) * (1.f / DM) + EPS);
        f32x4* o = (f32x4*)(p.out + (size_t)m * DM) + lane;
#pragma unroll
        for (int j = 0; j < 4; ++j) o[64 * j] = v[j] * rstd * wv[j];
    }
}

constexpr int NPHASE = 13;
__global__ void __launch_bounds__(NTHREADS, 2) fwd_kernel(Params p) {
    extern __shared__ __attribute__((aligned(16))) unsigned char lds[];
#if MK_ONE_LAUNCH
    cg::grid_group grid = cg::this_grid();
#define SEAM(k) do { if (p.ph_lo <= (k) && (k) + 1 < p.ph_hi) grid.sync(); } while (0)
#else
#define SEAM(k) do { } while (0)
#endif
#define IN(k) (p.ph_lo <= (k) && (k) < p.ph_hi)
    unsigned char* ws = p.ws;
    if (IN(0)) { phase0(p, lds); } SEAM(0);
    if (IN(1)) { phase1(p, lds); } SEAM(1);
    if (IN(2)) { for (int it = blockIdx.x; it < NB * NCH; it += gridDim.x) { const int b = it / NCH, c = it % NCH; phase2_attn(p, lds, b, c); phase2_states(p, lds, b, c); } } SEAM(2);
    if (IN(3)) { phase3(p); } SEAM(3);
    if (IN(4)) { for (int it = blockIdx.x; it < NB * NCH; it += gridDim.x) { const int b = it / NCH, c = it % NCH; phase4(p, lds, b, c); } } SEAM(4);
    if (IN(5)) { phase_resid_gemm(p, lds, (const bf16_t*)(ws + WS_A2), DM, (const bf16_t*)(ws + WS_WOUT), p.in[0], (float*)(ws + WS_X1), (bf16_t*)(ws + WS_XB), (float*)(ws + WS_SSQ)); } SEAM(5);
    if (IN(6)) { phase6(p, lds); } SEAM(6);
    if (IN(7)) { phase7(p, lds); } SEAM(7);
    if (IN(8)) { phase_resid_gemm(p, lds, (const bf16_t*)(ws + WS_XO), 512, (const bf16_t*)(ws + WS_WO), (const float*)(ws + WS_X1), (float*)(ws + WS_X1), (bf16_t*)(ws + WS_XB), (float*)(ws + WS_SSQ)); } SEAM(8);
    if (IN(9)) { phase9(p); } SEAM(9);
    if (IN(10)) { phase11(p, lds); } SEAM(10);
    if (IN(11)) { phase12(p, lds); } SEAM(11);
    if (IN(12)) { phase13(p, lds); }
#undef IN
#undef SEAM
}

extern "C" void kernel_launch(void* const* d_in, const int* in_sizes, int n_in, void* d_out, int out_size, void* d_ws, size_t ws_size, hipStream_t stream) {
    static int grid = 0;
    if (grid == 0) {
        if (n_in != 28 || out_size != NT * DM || ws_size < WS_NEED) { fprintf(stderr, "kernel_launch: unexpected sizes n_in %d out %d ws %zu\n", n_in, out_size, ws_size); grid = -1; return; }
        int dev = 0, cus = 0, per_cu = 0;
        hipGetDevice(&dev);
        hipDeviceGetAttribute(&cus, hipDeviceAttributeMultiprocessorCount, dev);
        if (hipFuncSetAttribute((const void*)fwd_kernel, hipFuncAttributeMaxDynamicSharedMemorySize, LDS_BYTES) != hipSuccess) { fprintf(stderr, "kernel_launch: hipFuncSetAttribute failed\n"); grid = -1; return; }
        if (hipOccupancyMaxActiveBlocksPerMultiprocessor(&per_cu, (const void*)fwd_kernel, NTHREADS, LDS_BYTES) != hipSuccess || per_cu < 1) { fprintf(stderr, "kernel_launch: occupancy query says %d\n", per_cu); per_cu = 1; }
        (void)hipGetLastError();
        grid = cus;
    }
    if (grid < 0) return;
    Params prm{};
    for (int i = 0; i < 28; ++i) prm.in[i] = (const float*)d_in[i];
    prm.out = (float*)d_out; prm.ws = (unsigned char*)d_ws;
    for (int i = 0; i < 8; ++i) prm.inv_freq[i] = powf(500000.0f, -(float)(2 * i) / 16.0f);
#if MK_ONE_LAUNCH
    prm.ph_lo = 0; prm.ph_hi = NPHASE;
    void* args[] = {&prm};
    hipError_t e = hipLaunchCooperativeKernel((const void*)fwd_kernel, dim3(grid), dim3(NTHREADS), args, LDS_BYTES, stream);
    if (e != hipSuccess) fprintf(stderr, "cooperative launch failed: %s (grid %d)\n", hipGetErrorString(e), grid);
#else
    for (int ph = 0; ph < NPHASE; ++ph) {
        prm.ph_lo = ph; prm.ph_hi = ph + 1;
        hipLaunchKernelGGL(fwd_kernel, dim3(grid), dim3(NTHREADS), LDS_BYTES, stream, prm);
    }
#endif
}
```

```cpp
#include <hip/hip_runtime.h>
#include <hip/hip_cooperative_groups.h>
#include <cstdio>
#include <cmath>
namespace cg = cooperative_groups;

#ifndef MK_ONE_LAUNCH
#define MK_ONE_LAUNCH 1
#endif

typedef unsigned short bf16_t;
typedef short bf16x8 __attribute__((ext_vector_type(8)));
typedef float f32x4 __attribute__((ext_vector_type(4)));
typedef float f32x16 __attribute__((ext_vector_type(16)));
typedef unsigned u32x4 __attribute__((ext_vector_type(4)));
typedef unsigned u32x2 __attribute__((ext_vector_type(2)));

constexpr int NB = 8, SEQ = 4096, DM = 1024, NT = NB * SEQ;
constexpr int NPROJ = 2304, LDWIN = 2312;
constexpr int C_K = 512, C_V = 640, C_Z = 768, C_X = 1280, C_B = 1792, C_C = 2048;
constexpr int MEMT = 256, NMEM = NB * MEMT;
constexpr int NEXP = 32, EFF = 256;
constexpr int NCH = SEQ / 128;
constexpr float EPS = 1e-5f;
constexpr int NTHREADS = 512, NWAVES = 8;
constexpr int LDS_BYTES = 147456;

constexpr size_t MiB = (size_t)1 << 20;
constexpr size_t WS_CTL = 0;
constexpr size_t WS_WIN = 1 * MiB, WS_WOUT = 6 * MiB, WS_WQ = 8 * MiB, WS_WKV = 9 * MiB, WS_WO = 11 * MiB, WS_WR = 12 * MiB;
constexpr size_t WS_WGU = 16 * MiB, WS_WD = 48 * MiB;
constexpr size_t WS_MEMH = 64 * MiB, WS_KMEM = 68 * MiB, WS_VMEMT = 70 * MiB, WS_DTRAW = 72 * MiB, WS_CDEC = 73 * MiB, WS_ROUTE = 74 * MiB;
constexpr size_t WS_LIST = 76 * MiB, WS_SSQ = 80 * MiB;
constexpr size_t WS_PROJ = 96 * MiB, WS_A2 = 240 * MiB, WS_STATES = 304 * MiB, WS_START = 368 * MiB;
constexpr size_t WS_X1 = 96 * MiB, WS_XB = 304 * MiB, WS_Q2 = 368 * MiB, WS_XO = 224 * MiB, WS_HID = 256 * MiB, WS_Y = 368 * MiB;
constexpr size_t WS_NEED = 512 * MiB;

struct Params {
    const float* in[28];
    float* out;
    unsigned char* ws;
    float inv_freq[8];
    int ph_lo, ph_hi;
};

__device__ __forceinline__ unsigned f2bf(float f) { unsigned u = __float_as_uint(f); return (u + 0x7fffu + ((u >> 16) & 1u)) >> 16; }
__device__ __forceinline__ float bf2f(unsigned h) { return __uint_as_float(h << 16); }
__device__ __forceinline__ unsigned pk2(float lo, float hi) { return f2bf(lo) | (f2bf(hi) << 16); }
__device__ __forceinline__ float bflo(unsigned u) { return __uint_as_float(u << 16); }
__device__ __forceinline__ float bfhi(unsigned u) { return __uint_as_float(u & 0xffff0000u); }
__device__ __forceinline__ float wave_sum(float v) {
#pragma unroll
    for (int o = 32; o >= 1; o >>= 1) v += __shfl_xor(v, o);
    return v;
}
#define LDS_WAIT() asm volatile("s_waitcnt lgkmcnt(0)" ::: "memory")
__device__ __forceinline__ int opaque_tid() { int t = threadIdx.x; asm volatile("" : "+v"(t)); return t; }
__device__ __forceinline__ float siluf(float v) { return v / (1.f + __expf(-v)); }
__device__ __forceinline__ f32x16 mfma32(bf16x8 a, bf16x8 b, f32x16 c) { return __builtin_amdgcn_mfma_f32_32x32x16_bf16(a, b, c, 0, 0, 0); }
__device__ __forceinline__ f32x16 zero16() { f32x16 z;
#pragma unroll
    for (int i = 0; i < 16; ++i) z[i] = 0.f;
    return z; }
__device__ __forceinline__ int crow(int i, int h) { return (i & 3) + 8 * (i >> 2) + 4 * h; }

__device__ __forceinline__ void gemm128(unsigned char* lds, const bf16_t* arow, const bf16_t* brow, int K, f32x16& acc0, f32x16& acc1) {
    const int tid = opaque_tid(), lane = tid & 63, w = tid >> 6;
    bf16_t* sA = (bf16_t*)lds;
    bf16_t* sB = sA + 128 * 72;
    const int srow = tid >> 2, skc = (tid & 3) * 16;
    const bf16_t* ap = arow + skc;
    const bf16_t* bp = brow + skc;
    const int wm = w >> 1, wn = w & 1, r = lane & 31, h = lane >> 5;
    acc0 = zero16(); acc1 = zero16();
    for (int k0 = 0; k0 < K; k0 += 64) {
        const u32x4 a0 = *(const u32x4*)(ap + k0), a1 = *(const u32x4*)(ap + k0 + 8);
        const u32x4 b0 = *(const u32x4*)(bp + k0), b1 = *(const u32x4*)(bp + k0 + 8);
        __syncthreads();
        *(u32x4*)(sA + srow * 72 + skc) = a0; *(u32x4*)(sA + srow * 72 + skc + 8) = a1;
        *(u32x4*)(sB + srow * 72 + skc) = b0; *(u32x4*)(sB + srow * 72 + skc + 8) = b1;
        __syncthreads();
#pragma unroll
        for (int kk = 0; kk < 64; kk += 16) {
            const bf16x8 a = *(const bf16x8*)(sA + (wm * 32 + r) * 72 + kk + 8 * h);
            const bf16x8 bA = *(const bf16x8*)(sB + (wn * 64 + r) * 72 + kk + 8 * h);
            const bf16x8 bB = *(const bf16x8*)(sB + (wn * 64 + 32 + r) * 72 + kk + 8 * h);
            acc0 = mfma32(a, bA, acc0); acc1 = mfma32(a, bB, acc1);
        }
    }
    __syncthreads();
}

__device__ __forceinline__ void p0_transpose_item(const float* W, int ldw, int K, int nblk, const float* scale, bf16_t* WT, int row_off, int row_mul, float* scr, int item, int lane) {
    const int kb = item / nblk, nb = item % nblk, k0 = 64 * kb, n0 = 32 * nb;
#pragma unroll 8
    for (int i = 0; i < 32; ++i) { const int kk = 2 * i + (lane >> 5); float v = W[(size_t)(k0 + kk) * ldw + n0 + (lane & 31)]; if (scale) v *= scale[k0 + kk]; scr[kk * 33 + (lane & 31)] = v; }
    LDS_WAIT();
    const int c = lane & 7;
#pragma unroll
    for (int j = 0; j < 4; ++j) { const int n = (lane >> 3) + 8 * j; const float* s = scr + (8 * c) * 33 + n;
        u32x4 o; o.x = pk2(s[0 * 33], s[1 * 33]); o.y = pk2(s[2 * 33], s[3 * 33]); o.z = pk2(s[4 * 33], s[5 * 33]); o.w = pk2(s[6 * 33], s[7 * 33]);
        *(u32x4*)(WT + (size_t)(row_off + (n0 + n) * row_mul) * K + k0 + 8 * c) = o; }
    LDS_WAIT();
}

__device__ __forceinline__ void phase0(const Params& p, unsigned char* lds) {
    const int tid = opaque_tid(), lane = tid & 63, w = tid >> 6;
    unsigned char* ws = p.ws;
    const int gw = blockIdx.x * NWAVES + w, NGW = gridDim.x * NWAVES;
    if (blockIdx.x == 0 && tid < 64) ((int*)(ws + WS_CTL))[tid] = 0;
    {
        float* WR = (float*)(ws + WS_WR);
        const float* w3 = p.in[19]; const float* wg = p.in[20]; const float* we = p.in[22];
        for (int i = blockIdx.x * NTHREADS + tid; i < 36 * 1024; i += gridDim.x * NTHREADS) {
            const int n = i >> 10, k = i & 1023;
            const float v = (n < 4) ? wg[k * 4 + n] : we[k * 32 + (n - 4)];
            WR[i] = v * w3[k];
        }
    }
    {
        float* scr = (float*)(lds + 32768) + w * (64 * 33 + 16);
        constexpr int I_IN = 16 * 72, I_OUT = 16 * 32, I_Q = 16 * 16, I_KV = 16 * 32, I_O = 8 * 32, I_G = 32 * 16 * 8, I_D = 32 * 4 * 32;
        constexpr int NITEMS = I_IN + I_OUT + I_Q + I_KV + I_O + 2 * I_G + I_D;
        for (int it = gw; it < NITEMS; it += NGW) {
            int r = it;
            if (r < I_IN) { p0_transpose_item(p.in[4], LDWIN, 1024, 72, nullptr, (bf16_t*)(ws + WS_WIN), 0, 1, scr, r, lane); continue; } r -= I_IN;
            if (r < I_OUT) { p0_transpose_item(p.in[13], 1024, 1024, 32, nullptr, (bf16_t*)(ws + WS_WOUT), 0, 1, scr, r, lane); continue; } r -= I_OUT;
            if (r < I_Q) { p0_transpose_item(p.in[16], 512, 1024, 16, p.in[14], (bf16_t*)(ws + WS_WQ), 0, 1, scr, r, lane); continue; } r -= I_Q;
            if (r < I_KV) { p0_transpose_item(p.in[17], 1024, 1024, 32, nullptr, (bf16_t*)(ws + WS_WKV), 0, 1, scr, r, lane); continue; } r -= I_KV;
            if (r < I_O) { p0_transpose_item(p.in[18], 1024, 512, 32, nullptr, (bf16_t*)(ws + WS_WO), 0, 1, scr, r, lane); continue; } r -= I_O;
            if (r < I_G) { const int e = r / 128, ri = r % 128; p0_transpose_item(p.in[24] + (size_t)e * 1024 * 256, 256, 1024, 8, p.in[19], (bf16_t*)(ws + WS_WGU) + (size_t)e * 512 * 1024, 0, 2, scr, ri, lane); continue; } r -= I_G;
            if (r < I_G) { const int e = r / 128, ri = r % 128; p0_transpose_item(p.in[25] + (size_t)e * 1024 * 256, 256, 1024, 8, p.in[19], (bf16_t*)(ws + WS_WGU) + (size_t)e * 512 * 1024, 1, 2, scr, ri, lane); continue; } r -= I_G;
            { const int e = r / 128, ri = r % 128; p0_transpose_item(p.in[26] + (size_t)e * 256 * 1024, 1024, 256, 32, nullptr, (bf16_t*)(ws + WS_WD) + (size_t)e * 1024 * 256, 0, 1, scr, ri, lane); }
        }
    }
    float* wdt = (float*)lds;
    {
        const float* win = p.in[4]; const float* w1 = p.in[3];
        for (int i = tid; i < 8192; i += NTHREADS) { const int k = i >> 3, n = i & 7; wdt[n * 1024 + k] = win[(size_t)k * LDWIN + 2304 + n] * w1[k]; }
    }
    __syncthreads();
    {
        const float* x = p.in[0]; const float* w1 = p.in[3];
        bf16_t* h1 = (bf16_t*)p.out; float* dtraw = (float*)(ws + WS_DTRAW);
        f32x4 wv[4];
#pragma unroll
        for (int j = 0; j < 4; ++j) wv[j] = *(const f32x4*)(w1 + 4 * lane + 256 * j);
        for (int m = gw; m < NT; m += NGW) {
            const f32x4* xr = (const f32x4*)(x + (size_t)m * DM) + lane;
            f32x4 v[4]; float s = 0.f;
#pragma unroll
            for (int j = 0; j < 4; ++j) { v[j] = xr[64 * j]; s += (v[j].x * v[j].x + v[j].y * v[j].y) + (v[j].z * v[j].z + v[j].w * v[j].w); }
            const float rstd = 1.f / sqrtf(wave_sum(s) * (1.f / DM) + EPS);
            float d[8];
#pragma unroll
            for (int n = 0; n < 8; ++n) { float a = 0.f;
#pragma unroll
                for (int j = 0; j < 4; ++j) { const f32x4 ww = *(const f32x4*)(wdt + n * 1024 + 4 * lane + 256 * j); a += (v[j].x * ww.x + v[j].y * ww.y) + (v[j].z * ww.z + v[j].w * ww.w); }
                d[n] = wave_sum(a) * rstd; }
            if (lane == 0) { *(f32x4*)(dtraw + (size_t)m * 8) = (f32x4){d[0], d[1], d[2], d[3]}; *(f32x4*)(dtraw + (size_t)m * 8 + 4) = (f32x4){d[4], d[5], d[6], d[7]}; }
            u32x2* o8 = (u32x2*)(h1 + (size_t)m * DM) + lane;
#pragma unroll
            for (int j = 0; j < 4; ++j) { u32x2 o; o.x = pk2(v[j].x * rstd * wv[j].x, v[j].y * rstd * wv[j].y); o.y = pk2(v[j].z * rstd * wv[j].z, v[j].w * rstd * wv[j].w); o8[64 * j] = o; }
        }
    }
    {
        const float* mem = p.in[1]; const float* wm = p.in[15];
        bf16_t* memh = (bf16_t*)(ws + WS_MEMH);
        f32x4 wv[4];
#pragma unroll
        for (int j = 0; j < 4; ++j) wv[j] = *(const f32x4*)(wm + 4 * lane + 256 * j);
        for (int m = gw; m < NMEM; m += NGW) {
            const f32x4* xr = (const f32x4*)(mem + (size_t)m * DM) + lane;
            f32x4 v[4]; float s = 0.f;
#pragma unroll
            for (int j = 0; j < 4; ++j) { v[j] = xr[64 * j]; s += (v[j].x * v[j].x + v[j].y * v[j].y) + (v[j].z * v[j].z + v[j].w * v[j].w); }
            const float rstd = 1.f / sqrtf(wave_sum(s) * (1.f / DM) + EPS);
            u32x2* o8 = (u32x2*)(memh + (size_t)m * DM) + lane;
#pragma unroll
            for (int j = 0; j < 4; ++j) { u32x2 o; o.x = pk2(v[j].x * rstd * wv[j].x, v[j].y * rstd * wv[j].y); o.y = pk2(v[j].z * rstd * wv[j].z, v[j].w * rstd * wv[j].w); o8[64 * j] = o; }
        }
    }
    __syncthreads();
}

__device__ __forceinline__ void phase1(const Params& p, unsigned char* lds) {
    const int tid = opaque_tid(), lane = tid & 63, w = tid >> 6, wm = w >> 1, wn = w & 1, r = lane & 31, h = lane >> 5;
    unsigned char* ws = p.ws;
    const bf16_t* h1 = (const bf16_t*)p.out; const bf16_t* WinT = (const bf16_t*)(ws + WS_WIN);
    bf16_t* proj = (bf16_t*)(ws + WS_PROJ);
    constexpr int NT1 = (NT / 128) * (NPROJ / 128);
    constexpr int NT2 = (NMEM / 128) * (1024 / 128);
    for (int t = blockIdx.x; t < NT1 + NT2; t += gridDim.x) {
        f32x16 acc0, acc1;
        if (t < NT1) {
            const int mt = t / 18, nt = t % 18, m0 = mt * 128, n0 = nt * 128;
            gemm128(lds, h1 + (size_t)(m0 + (tid >> 2)) * DM, WinT + (size_t)(n0 + (tid >> 2)) * DM, DM, acc0, acc1);
#pragma unroll
            for (int i = 0; i < 16; ++i) { const size_t row = m0 + wm * 32 + crow(i, h); const int col = n0 + wn * 64 + r;
                proj[row * NPROJ + col] = (bf16_t)f2bf(acc0[i]); proj[row * NPROJ + col + 32] = (bf16_t)f2bf(acc1[i]); }
        } else {
            const int t2 = t - NT1, mt = t2 / 8, nt = t2 % 8, m0 = mt * 128, n0 = nt * 128;
            const bf16_t* memh = (const bf16_t*)(ws + WS_MEMH); const bf16_t* WkvT = (const bf16_t*)(ws + WS_WKV);
            bf16_t* kmem = (bf16_t*)(ws + WS_KMEM); bf16_t* vmemT = (bf16_t*)(ws + WS_VMEMT);
            gemm128(lds, memh + (size_t)(m0 + (tid >> 2)) * DM, WkvT + (size_t)(n0 + (tid >> 2)) * DM, DM, acc0, acc1);
#pragma unroll
            for (int i = 0; i < 16; ++i) { const int row = m0 + wm * 32 + crow(i, h);
#pragma unroll
                for (int j = 0; j < 2; ++j) { const int col = n0 + wn * 64 + r + 32 * j; const float v = j ? acc1[i] : acc0[i];
                    if (col < 512) kmem[(size_t)row * 512 + col] = (bf16_t)f2bf(v);
                    else { const int c2 = col - 512, hx = c2 >> 7, d = c2 & 127, b = row >> 8, key = row & 255; vmemT[(((size_t)b * 4 + hx) * 128 + d) * 256 + key] = (bf16_t)f2bf(v); } } }
        }
    }
}

__device__ __forceinline__ float bfel(const u32x4& v, int ci) { const unsigned wv = (ci >> 1) == 0 ? v.x : (ci >> 1) == 1 ? v.y : (ci >> 1) == 2 ? v.z : v.w; return (ci & 1) ? bfhi(wv) : bflo(wv); }
template <bool TRANS>
__device__ __forceinline__ void conv8x8(const Params& p, int b, int c, int l0, int ch0, const float (&f)[8], u32x4 (&res)[8]) {
    const bf16_t* proj = (const bf16_t*)(p.ws + WS_PROJ);
    const float* cw = p.in[6]; const float* cb = p.in[7];
    float wgt[4][8], bias[8];
#pragma unroll
    for (int j = 0; j < 4; ++j) { const f32x4 a = *(const f32x4*)(cw + j * 1024 + ch0), b2 = *(const f32x4*)(cw + j * 1024 + ch0 + 4);
        wgt[j][0] = a.x; wgt[j][1] = a.y; wgt[j][2] = a.z; wgt[j][3] = a.w; wgt[j][4] = b2.x; wgt[j][5] = b2.y; wgt[j][6] = b2.z; wgt[j][7] = b2.w; }
    { const f32x4 a = *(const f32x4*)(cb + ch0), b2 = *(const f32x4*)(cb + ch0 + 4); bias[0] = a.x; bias[1] = a.y; bias[2] = a.z; bias[3] = a.w; bias[4] = b2.x; bias[5] = b2.y; bias[6] = b2.z; bias[7] = b2.w; }
    u32x4 in[11];
    const int t0 = c * 128 + l0 - 3;
    const bf16_t* rp = proj + ((long)(b * SEQ) + t0) * NPROJ + C_X + ch0;
    asm volatile("" : "+v"(rp));
#pragma unroll
    for (int i = 0; i < 11; ++i) {
        const int t = t0 + i;
        in[i] = (u32x4){0u, 0u, 0u, 0u};
        if (t >= 0) in[i] = *(const u32x4*)(rp + (size_t)i * NPROJ);
    }
    if (TRANS) {
#pragma unroll
        for (int ci = 0; ci < 8; ++ci) {
            float o[8];
#pragma unroll
            for (int li = 0; li < 8; ++li) { float a = bias[ci];
#pragma unroll
                for (int j = 0; j < 4; ++j) a += wgt[j][ci] * bfel(in[li + j], ci);
                o[li] = siluf(a) * f[li]; }
            res[ci] = (u32x4){pk2(o[0], o[1]), pk2(o[2], o[3]), pk2(o[4], o[5]), pk2(o[6], o[7])};
        }
    } else {
#pragma unroll
        for (int li = 0; li < 8; ++li) {
            float o[8];
#pragma unroll
            for (int ci = 0; ci < 8; ++ci) { float a = bias[ci];
#pragma unroll
                for (int j = 0; j < 4; ++j) a += wgt[j][ci] * bfel(in[li + j], ci);
                o[ci] = siluf(a) * f[li]; }
            res[li] = (u32x4){pk2(o[0], o[1]), pk2(o[2], o[3]), pk2(o[4], o[5]), pk2(o[6], o[7])};
        }
    }
}

__device__ __forceinline__ void conv2x8T(const Params& p, int b, int c, int l0, int ch0, u32x4 (&res)[2]) {
    const bf16_t* proj = (const bf16_t*)(p.ws + WS_PROJ);
    const float* cw = p.in[6]; const float* cb = p.in[7];
    float wgt[4][2], bias[2];
#pragma unroll
    for (int j = 0; j < 4; ++j) { wgt[j][0] = cw[j * 1024 + ch0]; wgt[j][1] = cw[j * 1024 + ch0 + 1]; }
    bias[0] = cb[ch0]; bias[1] = cb[ch0 + 1];
    unsigned in[11];
    const int t0 = c * 128 + l0 - 3;
    const bf16_t* rp = proj + ((long)(b * SEQ) + t0) * NPROJ + C_X + ch0;
    asm volatile("" : "+v"(rp));
#pragma unroll
    for (int i = 0; i < 11; ++i) { const int t = t0 + i; in[i] = 0u; if (t >= 0) in[i] = *(const unsigned*)(rp + (size_t)i * NPROJ); }
#pragma unroll
    for (int ci = 0; ci < 2; ++ci) {
        float o[8];
#pragma unroll
        for (int li = 0; li < 8; ++li) { float a = bias[ci];
#pragma unroll
            for (int j = 0; j < 4; ++j) a += wgt[j][ci] * (ci ? bfhi(in[li + j]) : bflo(in[li + j]));
            o[li] = siluf(a); }
        res[ci] = (u32x4){pk2(o[0], o[1]), pk2(o[2], o[3]), pk2(o[4], o[5]), pk2(o[6], o[7])};
    }
}

__device__ __forceinline__ void ssd_dt_cum(const Params& p, int b, int c, float* dts, float* cums) {
    const int tid = opaque_tid(), lane = tid & 63, w = tid >> 6;
    const float* dtraw = (const float*)(p.ws + WS_DTRAW);
    const float bias = p.in[8][w], a = -__expf(p.in[9][w]);
    const size_t row0 = (size_t)b * SEQ + c * 128;
    float x0 = dtraw[(row0 + 2 * lane) * 8 + w] + bias, x1 = dtraw[(row0 + 2 * lane + 1) * 8 + w] + bias;
    const float d0 = fmaxf(x0, 0.f) + log1pf(__expf(-fabsf(x0))), d1 = fmaxf(x1, 0.f) + log1pf(__expf(-fabsf(x1)));
    const float a0 = d0 * a, a1 = d1 * a;
    float s = a0 + a1;
#pragma unroll
    for (int o = 1; o < 64; o <<= 1) { const float t = __shfl_up(s, o); if (lane >= o) s += t; }
    dts[w * 128 + 2 * lane] = d0; dts[w * 128 + 2 * lane + 1] = d1;
    cums[w * 128 + 2 * lane] = s - a1; cums[w * 128 + 2 * lane + 1] = s;
}

__device__ __forceinline__ void phase2_attn(const Params& p, unsigned char* lds, int b, int blk) {
    const int tid = opaque_tid(), lane = tid & 63, w = tid >> 6, r = lane & 31, h = lane >> 5;
    const bf16_t* proj = (const bf16_t*)(p.ws + WS_PROJ);
    const int* positions = (const int*)p.in[2];
    float* cs = (float*)lds;
    float* sn = cs + 2048;
    float* ssq = sn + 2048;
    bf16_t* sK = (bf16_t*)(lds + 20480);
    bf16_t* sVT = sK + 256 * 72;
    bf16_t* sP = sVT + 64 * 264;
    bf16_t* sQ = sP + 8 * 32 * 40;
    bf16_t* myP = sP + w * 32 * 40;
    bf16_t* myQ = sQ + w * 32 * 64;
    const int tband0 = blk * 128 - 128;
    for (int i = tid; i < 2048; i += NTHREADS) {
        const int kb = i >> 3, f = i & 7, t = tband0 + kb;
        float c = 1.f, s = 0.f;
        if (t >= 0) { const float ang = (float)positions[b * SEQ + t] * p.inv_freq[f]; const double rev = (double)ang * 0.15915494309189535; const float fr = (float)(rev - floor(rev));
            c = __builtin_amdgcn_cosf(fr); s = __builtin_amdgcn_sinf(fr); }
        cs[i] = c; sn[i] = s;
    }
    __syncthreads();
    float* otmp = p.out + (size_t)16 * 1024 * 1024;
#pragma unroll 1
    for (int g = 0; g < 2; ++g) {
        {
            const int key = tid >> 1, half = tid & 1, t = tband0 + key;
            u32x4 kv[4], vv[4];
#pragma unroll
            for (int q = 0; q < 4; ++q) { kv[q] = (u32x4){0u, 0u, 0u, 0u}; vv[q] = (u32x4){0u, 0u, 0u, 0u}; }
            if (t >= 0) {
                const bf16_t* kp = proj + (size_t)(b * SEQ + t) * NPROJ + C_K + g * 64 + half * 32;
                const bf16_t* vp = proj + (size_t)(b * SEQ + t) * NPROJ + C_V + g * 64 + half * 32;
#pragma unroll
                for (int q = 0; q < 4; ++q) { kv[q] = *(const u32x4*)(kp + 8 * q); vv[q] = *(const u32x4*)(vp + 8 * q); }
            }
            if (half == 0) {
                float x1[8], x2[8];
                x1[0] = bflo(kv[0].x); x1[1] = bfhi(kv[0].x); x1[2] = bflo(kv[0].y); x1[3] = bfhi(kv[0].y); x1[4] = bflo(kv[0].z); x1[5] = bfhi(kv[0].z); x1[6] = bflo(kv[0].w); x1[7] = bfhi(kv[0].w);
                x2[0] = bflo(kv[1].x); x2[1] = bfhi(kv[1].x); x2[2] = bflo(kv[1].y); x2[3] = bfhi(kv[1].y); x2[4] = bflo(kv[1].z); x2[5] = bfhi(kv[1].z); x2[6] = bflo(kv[1].w); x2[7] = bfhi(kv[1].w);
                float o1[8], o2[8];
#pragma unroll
                for (int f = 0; f < 8; ++f) { const float c = cs[key * 8 + f], s = sn[key * 8 + f]; o1[f] = x1[f] * c - x2[f] * s; o2[f] = x2[f] * c + x1[f] * s; }
                kv[0] = (u32x4){pk2(o1[0], o1[1]), pk2(o1[2], o1[3]), pk2(o1[4], o1[5]), pk2(o1[6], o1[7])};
                kv[1] = (u32x4){pk2(o2[0], o2[1]), pk2(o2[2], o2[3]), pk2(o2[4], o2[5]), pk2(o2[6], o2[7])};
            }
#pragma unroll
            for (int q = 0; q < 4; ++q) *(u32x4*)(sK + key * 72 + half * 32 + 8 * q) = kv[q];
#pragma unroll
            for (int q = 0; q < 4; ++q) {
                const int d0 = half * 32 + 8 * q;
                sVT[(d0 + 0) * 264 + key] = (bf16_t)(vv[q].x & 0xffffu); sVT[(d0 + 1) * 264 + key] = (bf16_t)(vv[q].x >> 16);
                sVT[(d0 + 2) * 264 + key] = (bf16_t)(vv[q].y & 0xffffu); sVT[(d0 + 3) * 264 + key] = (bf16_t)(vv[q].y >> 16);
                sVT[(d0 + 4) * 264 + key] = (bf16_t)(vv[q].z & 0xffffu); sVT[(d0 + 5) * 264 + key] = (bf16_t)(vv[q].z >> 16);
                sVT[(d0 + 6) * 264 + key] = (bf16_t)(vv[q].w & 0xffffu); sVT[(d0 + 7) * 264 + key] = (bf16_t)(vv[q].w >> 16);
            }
        }
        __syncthreads();
#pragma unroll 1
        for (int uu = 0; uu < 2; ++uu) {
            const int u = w + 8 * uu, hq = g * 4 + (u >> 2), rg = u & 3, r0 = rg * 32;
            {
                const int qr = lane >> 1, half = lane & 1, t = blk * 128 + r0 + qr;
                const bf16_t* qp = proj + (size_t)(b * SEQ + t) * NPROJ + hq * 64 + half * 32;
                u32x4 qv[4];
#pragma unroll
                for (int q = 0; q < 4; ++q) qv[q] = *(const u32x4*)(qp + 8 * q);
                if (half == 0) {
                    float x1[8], x2[8];
                    x1[0] = bflo(qv[0].x); x1[1] = bfhi(qv[0].x); x1[2] = bflo(qv[0].y); x1[3] = bfhi(qv[0].y); x1[4] = bflo(qv[0].z); x1[5] = bfhi(qv[0].z); x1[6] = bflo(qv[0].w); x1[7] = bfhi(qv[0].w);
                    x2[0] = bflo(qv[1].x); x2[1] = bfhi(qv[1].x); x2[2] = bflo(qv[1].y); x2[3] = bfhi(qv[1].y); x2[4] = bflo(qv[1].z); x2[5] = bfhi(qv[1].z); x2[6] = bflo(qv[1].w); x2[7] = bfhi(qv[1].w);
                    float o1[8], o2[8];
                    const int kb = 128 + r0 + qr;
#pragma unroll
                    for (int f = 0; f < 8; ++f) { const float c = cs[kb * 8 + f], s = sn[kb * 8 + f]; o1[f] = x1[f] * c - x2[f] * s; o2[f] = x2[f] * c + x1[f] * s; }
                    qv[0] = (u32x4){pk2(o1[0], o1[1]), pk2(o1[2], o1[3]), pk2(o1[4], o1[5]), pk2(o1[6], o1[7])};
                    qv[1] = (u32x4){pk2(o2[0], o2[1]), pk2(o2[2], o2[3]), pk2(o2[4], o2[5]), pk2(o2[6], o2[7])};
                }
#pragma unroll
                for (int q = 0; q < 4; ++q) *(u32x4*)(myQ + qr * 64 + half * 32 + 8 * q) = qv[q];
            }
            LDS_WAIT();
            f32x16 S[5];
#pragma unroll
            for (int jt = 0; jt < 5; ++jt) S[jt] = zero16();
#pragma unroll
            for (int kk = 0; kk < 64; kk += 16) {
                const bf16x8 a = *(const bf16x8*)(myQ + r * 64 + kk + 8 * h);
#pragma unroll
                for (int jt = 0; jt < 5; ++jt) { const bf16x8 bb = *(const bf16x8*)(sK + ((rg + jt) * 32 + r) * 72 + kk + 8 * h); S[jt] = mfma32(a, bb, S[jt]); }
            }
            const float sink = p.in[5][hq];
            float sm[16];
#pragma unroll
            for (int i = 0; i < 16; ++i) {
                const int qb = 128 + r0 + crow(i, h);
                float m = -INFINITY;
#pragma unroll
                for (int jt = 0; jt < 5; ++jt) { const int kbx = (rg + jt) * 32 + r; const int rel = qb - kbx; const bool ok = (rel >= 0) && (rel < 128) && (tband0 + kbx >= 0);
                    const float v = ok ? S[jt][i] * 0.125f : -INFINITY; S[jt][i] = v; m = fmaxf(m, v); }
#pragma unroll
                for (int o = 16; o >= 1; o >>= 1) m = fmaxf(m, __shfl_xor(m, o));
                m = fmaxf(m, sink);
                float s = 0.f;
#pragma unroll
                for (int jt = 0; jt < 5; ++jt) { const float e = __expf(S[jt][i] - m); S[jt][i] = e; s += e; }
#pragma unroll
                for (int o = 16; o >= 1; o >>= 1) s += __shfl_xor(s, o);
                sm[i] = s + __expf(sink - m);
            }
            f32x16 O0 = zero16(), O1 = zero16();
#pragma unroll
            for (int jt = 0; jt < 5; ++jt) {
#pragma unroll
                for (int i = 0; i < 16; ++i) myP[crow(i, h) * 40 + r] = (bf16_t)f2bf(S[jt][i]);
                LDS_WAIT();
#pragma unroll
                for (int kk = 0; kk < 32; kk += 16) {
                    const bf16x8 a = *(const bf16x8*)(myP + r * 40 + kk + 8 * h);
                    const bf16x8 b0 = *(const bf16x8*)(sVT + r * 264 + (rg + jt) * 32 + kk + 8 * h);
                    const bf16x8 b1 = *(const bf16x8*)(sVT + (32 + r) * 264 + (rg + jt) * 32 + kk + 8 * h);
                    O0 = mfma32(a, b0, O0); O1 = mfma32(a, b1, O1);
                }
                LDS_WAIT();
            }
            int qlb = r0 + 4 * h;
            asm volatile("" : "+v"(qlb));
            float* opb = otmp + (size_t)(b * SEQ + blk * 128 + qlb) * 512 + hq * 64 + r;
#pragma unroll
            for (int i = 0; i < 16; ++i) {
                const int dl = (i & 3) + 8 * (i >> 2);
                const int ql = qlb + dl;
                const float inv = 1.f / sm[i];
                const float v0 = O0[i] * inv, v1 = O1[i] * inv;
                opb[dl * 512] = v0; opb[dl * 512 + 32] = v1;
                float q = v0 * v0 + v1 * v1;
#pragma unroll
                for (int o = 16; o >= 1; o >>= 1) q += __shfl_xor(q, o);
                if (r == 0) ssq[ql * 8 + hq] = q;
            }
        }
        __syncthreads();
    }
    {
        bf16_t* A2 = (bf16_t*)(p.ws + WS_A2);
        const float* wa = p.in[11];
        for (int i = tid; i < 128 * 64; i += NTHREADS) {
            const int ql = i >> 6, c8 = (i & 63) * 8;
            float s = 0.f;
#pragma unroll
            for (int q = 0; q < 8; ++q) s += ssq[ql * 8 + q];
            const float rstd = 1.f / sqrtf(s * (1.f / 512.f) + EPS);
            const size_t row = (size_t)b * SEQ + blk * 128 + ql;
            const f32x4 a = *(const f32x4*)(otmp + row * 512 + c8), bq = *(const f32x4*)(otmp + row * 512 + c8 + 4);
            const f32x4 w0 = *(const f32x4*)(wa + c8), w1 = *(const f32x4*)(wa + c8 + 4);
            u32x4 o; o.x = pk2(a.x * rstd * w0.x, a.y * rstd * w0.y); o.y = pk2(a.z * rstd * w0.z, a.w * rstd * w0.w); o.z = pk2(bq.x * rstd * w1.x, bq.y * rstd * w1.y); o.w = pk2(bq.z * rstd * w1.z, bq.w * rstd * w1.w);
            *(u32x4*)(A2 + row * 1024 + c8) = o;
        }
    }
    __syncthreads();
}

__device__ __forceinline__ void phase2_states(const Params& p, unsigned char* lds, int b, int c) {
    const int tid = opaque_tid(), lane = tid & 63, w = tid >> 6, r = lane & 31, h = lane >> 5;
    float* dts = (float*)lds;
    float* cums = dts + 1024;
    bf16_t* sBT = (bf16_t*)(lds + 8192);
    bf16_t* sXT = sBT + 128 * 136;
    ssd_dt_cum(p, b, c, dts, cums);
    __syncthreads();
    float* states = (float*)(p.ws + WS_STATES);
    if (tid < 8) ((float*)(p.ws + WS_CDEC))[(b * NCH + c) * 8 + tid] = __expf(cums[tid * 128 + 127]);
#pragma unroll 1
    for (int g = 0; g < 2; ++g) {
        if (tid < 256) {
            const int cg8 = tid & 15, lr = tid >> 4;
            const float one[8] = {1.f, 1.f, 1.f, 1.f, 1.f, 1.f, 1.f, 1.f};
            u32x4 res[8];
            conv8x8<true>(p, b, c, lr * 8, 512 + g * 128 + cg8 * 8, one, res);
#pragma unroll
            for (int ci = 0; ci < 8; ++ci) *(u32x4*)(sBT + (cg8 * 8 + ci) * 136 + lr * 8) = res[ci];
        }
        {
            const int cg8 = tid & 31, lr = tid >> 5, hh = cg8 >> 3, hd = g * 4 + hh;
            float f[8];
            const float cl = cums[hd * 128 + 127];
#pragma unroll
            for (int li = 0; li < 8; ++li) f[li] = dts[hd * 128 + lr * 8 + li] * __expf(cl - cums[hd * 128 + lr * 8 + li]);
            u32x4 res[8];
            conv8x8<true>(p, b, c, lr * 8, g * 256 + cg8 * 8, f, res);
#pragma unroll
            for (int ci = 0; ci < 8; ++ci) *(u32x4*)(sXT + (cg8 * 8 + ci) * 136 + lr * 8) = res[ci];
        }
        __syncthreads();
        {
            f32x16 acc[4];
#pragma unroll
            for (int j = 0; j < 4; ++j) acc[j] = zero16();
#pragma unroll
            for (int kk = 0; kk < 128; kk += 16) {
                const bf16x8 a = *(const bf16x8*)(sXT + (w * 32 + r) * 136 + kk + 8 * h);
#pragma unroll
                for (int j = 0; j < 4; ++j) { const bf16x8 bb = *(const bf16x8*)(sBT + (j * 32 + r) * 136 + kk + 8 * h); acc[j] = mfma32(a, bb, acc[j]); }
            }
            const int hd = g * 4 + (w >> 1), p0 = (w & 1) * 32;
            float* sp = states + ((size_t)((b * NCH + c) * 8 + hd) * 64) * 128;
#pragma unroll
            for (int j = 0; j < 4; ++j)
#pragma unroll
                for (int i = 0; i < 16; ++i) sp[(size_t)(p0 + crow(i, h)) * 128 + j * 32 + r] = acc[j][i];
        }
        __syncthreads();
    }
}

__device__ __forceinline__ void phase3(const Params& p) {
    const float* states = (const float*)(p.ws + WS_STATES);
    const float* cdec = (const float*)(p.ws + WS_CDEC);
    bf16_t* start = (bf16_t*)(p.ws + WS_START);
    for (int u = blockIdx.x * NTHREADS + threadIdx.x; u < 131072; u += gridDim.x * NTHREADS) {
        const int n4 = u & 31, pp = (u >> 5) & 63, hd = (u >> 11) & 7, b = u >> 14;
        f32x4 s = (f32x4){0.f, 0.f, 0.f, 0.f};
        for (int c = 0; c < NCH; ++c) {
            const size_t off = ((size_t)((b * NCH + c) * 8 + hd) * 64 + pp) * 128 + n4 * 4;
            u32x2 o; o.x = pk2(s.x, s.y); o.y = pk2(s.z, s.w);
            *(u32x2*)(start + off) = o;
            const f32x4 st = *(const f32x4*)(states + off);
            const float d = cdec[(b * NCH + c) * 8 + hd];
            s = s * d + st;
        }
    }
}

__device__ __forceinline__ void phase4(const Params& p, unsigned char* lds, int b, int c) {
    const int tid = opaque_tid(), lane = tid & 63, w = tid >> 6, r = lane & 31, h = lane >> 5;
    float* dts = (float*)lds;
    float* cums = dts + 1024;
    float* gsq = cums + 1024;
    bf16_t* sC = (bf16_t*)(lds + 12288);
    bf16_t* sB = sC + 128 * 136;
    bf16_t* sM = sB + 128 * 136;
    bf16_t* sXT = sM + 128 * 136;
    const bf16_t* proj = (const bf16_t*)(p.ws + WS_PROJ);
    const bf16_t* start = (const bf16_t*)(p.ws + WS_START);
    float* gtmp = p.out;
    bf16_t* A2 = (bf16_t*)(p.ws + WS_A2);
    ssd_dt_cum(p, b, c, dts, cums);
    __syncthreads();
    const size_t row0 = (size_t)b * SEQ + c * 128;
#pragma unroll 1
    for (int g = 0; g < 2; ++g) {
        {
            const int which = tid >> 8, cg8 = tid & 15, lr = (tid >> 4) & 15;
            const float one[8] = {1.f, 1.f, 1.f, 1.f, 1.f, 1.f, 1.f, 1.f};
            u32x4 res[8];
            conv8x8<false>(p, b, c, lr * 8, (which ? 768 : 512) + g * 128 + cg8 * 8, one, res);
            bf16_t* dst = which ? sC : sB;
#pragma unroll
            for (int li = 0; li < 8; ++li) *(u32x4*)(dst + (lr * 8 + li) * 136 + cg8 * 8) = res[li];
        }
        __syncthreads();
        f32x16 cb0 = zero16(), cb1 = zero16();
        const int lt = w >> 1, st0 = 2 * (w & 1);
#pragma unroll 2
        for (int kk = 0; kk < 128; kk += 16) {
            const bf16x8 a = *(const bf16x8*)(sC + (lt * 32 + r) * 136 + kk + 8 * h);
            const bf16x8 b0 = *(const bf16x8*)(sB + (st0 * 32 + r) * 136 + kk + 8 * h);
            const bf16x8 b1 = *(const bf16x8*)(sB + ((st0 + 1) * 32 + r) * 136 + kk + 8 * h);
            cb0 = mfma32(a, b0, cb0); cb1 = mfma32(a, b1, cb1);
        }
#pragma unroll 1
        for (int hh = 0; hh < 4; ++hh) {
            const int hd = g * 4 + hh;
#pragma unroll
            for (int i = 0; i < 16; ++i) {
                const int l = lt * 32 + crow(i, h);
                const float cl = cums[hd * 128 + l];
                { const int s = st0 * 32 + r; const float v = (s <= l) ? cb0[i] * __expf(cl - cums[hd * 128 + s]) * dts[hd * 128 + s] : 0.f; sM[l * 136 + s] = (bf16_t)f2bf(v); }
                { const int s = (st0 + 1) * 32 + r; const float v = (s <= l) ? cb1[i] * __expf(cl - cums[hd * 128 + s]) * dts[hd * 128 + s] : 0.f; sM[l * 136 + s] = (bf16_t)f2bf(v); }
            }
            __builtin_amdgcn_sched_barrier(0);
            {
                const int cp = tid & 31, lr = tid >> 5;
                u32x4 res[2];
                conv2x8T(p, b, c, lr * 8, hd * 64 + cp * 2, res);
                *(u32x4*)(sXT + (cp * 2) * 136 + lr * 8) = res[0];
                *(u32x4*)(sXT + (cp * 2 + 1) * 136 + lr * 8) = res[1];
            }
            __syncthreads();
            {
                const int lt2 = w >> 1, pt = w & 1;
                f32x16 yd = zero16(), yo = zero16();
#pragma unroll 2
                for (int kk = 0; kk < 128; kk += 16) {
                    const bf16x8 a = *(const bf16x8*)(sM + (lt2 * 32 + r) * 136 + kk + 8 * h);
                    const bf16x8 bb = *(const bf16x8*)(sXT + (pt * 32 + r) * 136 + kk + 8 * h);
                    yd = mfma32(a, bb, yd);
                }
                const bf16_t* stp = start + ((size_t)((b * NCH + c) * 8 + hd) * 64 + pt * 32 + r) * 128;
#pragma unroll 2
                for (int kk = 0; kk < 128; kk += 16) {
                    const bf16x8 a = *(const bf16x8*)(sC + (lt2 * 32 + r) * 136 + kk + 8 * h);
                    const bf16x8 bb = *(const bf16x8*)(stp + kk + 8 * h);
                    yo = mfma32(a, bb, yo);
                }
                const float dsk = p.in[10][hd];
                const int pcol = pt * 32 + r;
                int lb = lt2 * 32 + 4 * h;
                asm volatile("" : "+v"(lb));
                const bf16_t* zp = proj + (row0 + lb) * NPROJ + C_Z + hd * 64 + pcol;
                float* gp = gtmp + (row0 + lb) * 512 + hd * 64 + pcol;
#pragma unroll
                for (int i = 0; i < 16; ++i) {
                    const int dl = (i & 3) + 8 * (i >> 2);
                    const int l = lb + dl;
                    const float xs = bf2f((unsigned)sXT[pcol * 136 + l]);
                    const float y = yd[i] + __expf(cums[hd * 128 + l]) * yo[i] + dsk * xs;
                    const float z = bf2f((unsigned)zp[(size_t)dl * NPROJ]);
                    const float gv = y * siluf(z);
                    gp[dl * 512] = gv;
                    float q = gv * gv;
#pragma unroll
                    for (int o = 16; o >= 1; o >>= 1) q += __shfl_xor(q, o);
                    if (r == 0) gsq[l * 8 + hh * 2 + pt] = q;
                }
            }
            __syncthreads();
        }
        {
            const float* wsn = p.in[12];
            for (int i = tid; i < 128 * 32; i += NTHREADS) {
                const int l = i >> 5, c8 = (i & 31) * 8;
                float s = 0.f;
#pragma unroll
                for (int q = 0; q < 8; ++q) s += gsq[l * 8 + q];
                const float rstd = 1.f / sqrtf(s * (1.f / 256.f) + EPS);
                const f32x4 a = *(const f32x4*)(gtmp + (row0 + l) * 512 + g * 256 + c8), bq = *(const f32x4*)(gtmp + (row0 + l) * 512 + g * 256 + c8 + 4);
                const f32x4 w0 = *(const f32x4*)(wsn + g * 256 + c8), w1 = *(const f32x4*)(wsn + g * 256 + c8 + 4);
                u32x4 o; o.x = pk2(a.x * rstd * w0.x, a.y * rstd * w0.y); o.y = pk2(a.z * rstd * w0.z, a.w * rstd * w0.w); o.z = pk2(bq.x * rstd * w1.x, bq.y * rstd * w1.y); o.w = pk2(bq.z * rstd * w1.z, bq.w * rstd * w1.w);
                *(u32x4*)(A2 + (row0 + l) * 1024 + 512 + g * 256 + c8) = o;
            }
        }
        __syncthreads();
    }
}

__device__ __forceinline__ void phase_resid_gemm(const Params& p, unsigned char* lds, const bf16_t* A, int K, const bf16_t* Bt, const float* xin, float* xout, bf16_t* xb, float* ssq) {
    const int tid = opaque_tid(), lane = tid & 63, w = tid >> 6, wm = w >> 1, wn = w & 1, r = lane & 31, h = lane >> 5;
    for (int t = blockIdx.x; t < (NT / 128) * 8; t += gridDim.x) {
        const int mt = t >> 3, nt = t & 7, m0 = mt * 128, n0 = nt * 128;
        f32x16 acc0, acc1;
        gemm128(lds, A + (size_t)(m0 + (tid >> 2)) * K, Bt + (size_t)(n0 + (tid >> 2)) * K, K, acc0, acc1);
#pragma unroll
        for (int i = 0; i < 16; ++i) {
            const size_t row = m0 + wm * 32 + crow(i, h); const int col = n0 + wn * 64 + r;
            const float v0 = xin[row * DM + col] + acc0[i], v1 = xin[row * DM + col + 32] + acc1[i];
            xout[row * DM + col] = v0; xout[row * DM + col + 32] = v1;
            xb[row * DM + col] = (bf16_t)f2bf(v0); xb[row * DM + col + 32] = (bf16_t)f2bf(v1);
            float q = v0 * v0 + v1 * v1;
#pragma unroll
            for (int o = 16; o >= 1; o >>= 1) q += __shfl_xor(q, o);
            if (r == 0) ssq[row * 16 + nt * 2 + wn] = q;
        }
    }
}

__device__ __forceinline__ void phase6(const Params& p, unsigned char* lds) {
    const int tid = opaque_tid(), lane = tid & 63, w = tid >> 6, wm = w >> 1, wn = w & 1, r = lane & 31, h = lane >> 5;
    const bf16_t* xb = (const bf16_t*)(p.ws + WS_XB); const bf16_t* WqT = (const bf16_t*)(p.ws + WS_WQ);
    const float* ssq = (const float*)(p.ws + WS_SSQ);
    bf16_t* q2 = (bf16_t*)(p.ws + WS_Q2);
    for (int t = blockIdx.x; t < (NT / 128) * 4; t += gridDim.x) {
        const int mt = t >> 2, nt = t & 3, m0 = mt * 128, n0 = nt * 128;
        f32x16 acc0, acc1;
        gemm128(lds, xb + (size_t)(m0 + (tid >> 2)) * DM, WqT + (size_t)(n0 + (tid >> 2)) * DM, DM, acc0, acc1);
#pragma unroll
        for (int i = 0; i < 16; ++i) {
            const size_t row = m0 + wm * 32 + crow(i, h); const int col = n0 + wn * 64 + r;
            const f32x4* sp = (const f32x4*)(ssq + row * 16);
            const f32x4 s0 = sp[0], s1 = sp[1], s2 = sp[2], s3 = sp[3];
            const float s = ((s0.x + s0.y) + (s0.z + s0.w)) + ((s1.x + s1.y) + (s1.z + s1.w)) + ((s2.x + s2.y) + (s2.z + s2.w)) + ((s3.x + s3.y) + (s3.z + s3.w));
            const float rstd = 1.f / sqrtf(s * (1.f / DM) + EPS);
            q2[row * 512 + col] = (bf16_t)f2bf(acc0[i] * rstd); q2[row * 512 + col + 32] = (bf16_t)f2bf(acc1[i] * rstd);
        }
    }
}

__device__ __forceinline__ void phase7(const Params& p, unsigned char* lds) {
    const int tid = opaque_tid(), lane = tid & 63, w = tid >> 6, r = lane & 31, h = lane >> 5;
    const bf16_t* q2 = (const bf16_t*)(p.ws + WS_Q2); const bf16_t* kmem = (const bf16_t*)(p.ws + WS_KMEM); const bf16_t* vmemT = (const bf16_t*)(p.ws + WS_VMEMT);
    bf16_t* xo = (bf16_t*)(p.ws + WS_XO);
    bf16_t* myP = (bf16_t*)lds + w * 32 * 264;
    const float scale = 0.08838834764831845f;
    for (int it = blockIdx.x; it < 512; it += gridDim.x) {
        const int rb = it >> 2, hx = it & 3, b = rb >> 4;
        const size_t row0 = (size_t)rb * 256 + w * 32;
        f32x16 S[8];
#pragma unroll
        for (int j = 0; j < 8; ++j) S[j] = zero16();
        const bf16_t* qp = q2 + (row0 + r) * 512 + hx * 128 + 8 * h;
        const bf16_t* kp = kmem + ((size_t)b * 256 + r) * 512 + hx * 128 + 8 * h;
#pragma unroll
        for (int kk = 0; kk < 128; kk += 16) {
            const bf16x8 a = *(const bf16x8*)(qp + kk);
#pragma unroll
            for (int j = 0; j < 8; ++j) { const bf16x8 bb = *(const bf16x8*)(kp + (size_t)j * 32 * 512 + kk); S[j] = mfma32(a, bb, S[j]); }
        }
        float inv[16];
#pragma unroll
        for (int i = 0; i < 16; ++i) {
            float m = -INFINITY;
#pragma unroll
            for (int j = 0; j < 8; ++j) { const float v = S[j][i] * scale; S[j][i] = v; m = fmaxf(m, v); }
#pragma unroll
            for (int o = 16; o >= 1; o >>= 1) m = fmaxf(m, __shfl_xor(m, o));
            float s = 0.f;
#pragma unroll
            for (int j = 0; j < 8; ++j) { const float e = __expf(S[j][i] - m); S[j][i] = e; s += e; }
#pragma unroll
            for (int o = 16; o >= 1; o >>= 1) s += __shfl_xor(s, o);
            inv[i] = 1.f / s;
        }
#pragma unroll
        for (int j = 0; j < 8; ++j)
#pragma unroll
            for (int i = 0; i < 16; ++i) myP[crow(i, h) * 264 + j * 32 + r] = (bf16_t)f2bf(S[j][i]);
        LDS_WAIT();
        f32x16 O[4];
#pragma unroll
        for (int j = 0; j < 4; ++j) O[j] = zero16();
        const bf16_t* vp = vmemT + (((size_t)b * 4 + hx) * 128 + r) * 256 + 8 * h;
#pragma unroll
        for (int kk = 0; kk < 256; kk += 16) {
            const bf16x8 a = *(const bf16x8*)(myP + r * 264 + kk + 8 * h);
#pragma unroll
            for (int j = 0; j < 4; ++j) { const bf16x8 bb = *(const bf16x8*)(vp + (size_t)j * 32 * 256 + kk); O[j] = mfma32(a, bb, O[j]); }
        }
#pragma unroll
        for (int j = 0; j < 4; ++j)
#pragma unroll
            for (int i = 0; i < 16; ++i) xo[(row0 + crow(i, h)) * 512 + hx * 128 + j * 32 + r] = (bf16_t)f2bf(O[j][i] * inv[i]);
        LDS_WAIT();
    }
}

__device__ __forceinline__ void phase9(const Params& p) {
    const int tid = opaque_tid(), lane = tid & 63, w = tid >> 6;
    const int gw = blockIdx.x * NWAVES + w, NGW = gridDim.x * NWAVES;
    const float* x2 = (const float*)(p.ws + WS_X1);
    const float* WR = (const float*)(p.ws + WS_WR);
    int* cnt = (int*)(p.ws + WS_CTL);
    int* list = (int*)(p.ws + WS_LIST);
    float* route = (float*)(p.ws + WS_ROUTE);
    const float* bg = p.in[21]; const float* be = p.in[23];
    for (int m = gw; m < NT; m += NGW) {
        const f32x4* xr = (const f32x4*)(x2 + (size_t)m * DM) + lane;
        f32x4 v[4]; float s = 0.f;
#pragma unroll
        for (int j = 0; j < 4; ++j) { v[j] = xr[64 * j]; s += (v[j].x * v[j].x + v[j].y * v[j].y) + (v[j].z * v[j].z + v[j].w * v[j].w); }
        const float rstd = 1.f / sqrtf(wave_sum(s) * (1.f / DM) + EPS);
        float mine = 0.f;
#pragma unroll 4
        for (int n = 0; n < 36; ++n) {
            float a = 0.f;
#pragma unroll
            for (int j = 0; j < 4; ++j) { const f32x4 ww = *(const f32x4*)(WR + n * 1024 + 4 * lane + 256 * j); a += (v[j].x * ww.x + v[j].y * ww.y) + (v[j].z * ww.z + v[j].w * ww.w); }
            a = wave_sum(a) * rstd;
            if (lane == n) mine = a;
        }
        if (lane < 4) mine += bg[lane]; else if (lane < 36) mine += be[lane - 4];
        const float g0 = __shfl(mine, 0), g1 = __shfl(mine, 1), g2 = __shfl(mine, 2), g3 = __shfl(mine, 3);
        int gi = 0; float gm = g0;
        if (g1 > gm) { gm = g1; gi = 1; }
        if (g2 > gm) { gm = g2; gi = 2; }
        if (g3 > gm) { gm = g3; gi = 3; }
        const float gden = __expf(g0 - gm) + __expf(g1 - gm) + __expf(g2 - gm) + __expf(g3 - gm);
        const float ggate = 1.f / gden;
        float ev[8];
#pragma unroll
        for (int j = 0; j < 8; ++j) ev[j] = __shfl(mine, 4 + gi * 8 + j);
        int i1 = 0; float v1 = ev[0];
#pragma unroll
        for (int j = 1; j < 8; ++j) if (ev[j] > v1) { v1 = ev[j]; i1 = j; }
        int i2 = -1; float v2 = -INFINITY;
#pragma unroll
        for (int j = 0; j < 8; ++j) if (j != i1 && ev[j] > v2) { v2 = ev[j]; i2 = j; }
        const float e2 = __expf(v2 - v1);
        const float w1 = ggate / (1.f + e2), w2 = ggate * e2 / (1.f + e2);
        if (lane == 0) {
            const int ea = gi * 8 + i1, eb = gi * 8 + i2;
            const int pa = atomicAdd(cnt + ea, 1), pb = atomicAdd(cnt + eb, 1);
            list[ea * NT + pa] = m; list[eb * NT + pb] = m;
            int* ri = (int*)(route + (size_t)m * 8);
            ri[0] = ea; ri[1] = eb; ri[2] = pa; ri[3] = pb;
            route[(size_t)m * 8 + 4] = w1; route[(size_t)m * 8 + 5] = w2; route[(size_t)m * 8 + 6] = rstd; route[(size_t)m * 8 + 7] = 0.f;
        }
    }
}

__device__ __forceinline__ void moe_offsets(const Params& p, int* off) {
    const int* cnt = (const int*)(p.ws + WS_CTL);
    if (threadIdx.x == 0) { int a = 0; for (int e = 0; e < NEXP; ++e) { off[e] = a; a += ((cnt[e] + 255) >> 8) << 8; } off[NEXP] = a; }
    if (threadIdx.x < NEXP) off[40 + threadIdx.x] = cnt[threadIdx.x];
    __syncthreads();
}

__device__ __forceinline__ void phase11(const Params& p, unsigned char* lds) {
    const int tid = opaque_tid(), lane = tid & 63, w = tid >> 6, wm = w >> 1, wn = w & 1, r = lane & 31, h = lane >> 5;
    int* off = (int*)(lds + 40960);
    moe_offsets(p, off);
    const bf16_t* xb = (const bf16_t*)(p.ws + WS_XB); const bf16_t* WguT = (const bf16_t*)(p.ws + WS_WGU);
    const int* list = (const int*)(p.ws + WS_LIST); const float* route = (const float*)(p.ws + WS_ROUTE);
    bf16_t* hid = (bf16_t*)(p.ws + WS_HID);
    const int nrt = off[NEXP] >> 7;
    for (int t = blockIdx.x; t < nrt * 4; t += gridDim.x) {
        const int rt = t >> 2, nt = t & 3, s0 = rt * 128, n0 = nt * 128;
        int e = 0;
        for (int q = 1; q < NEXP; ++q) if (off[q] <= s0) e = q;
        const int cnt_e = off[40 + e], pos0 = s0 - off[e];
        const int prow = pos0 + (tid >> 2);
        const int tok = (prow < cnt_e) ? list[e * NT + prow] : 0;
        f32x16 acc0, acc1;
        gemm128(lds, xb + (size_t)tok * DM, WguT + ((size_t)e * 512 + n0 + (tid >> 2)) * DM, DM, acc0, acc1);
#pragma unroll
        for (int i = 0; i < 16; ++i) {
            const int lr = wm * 32 + crow(i, h), pr = pos0 + lr;
            float rs = 0.f;
            if (pr < cnt_e) rs = route[(size_t)list[e * NT + pr] * 8 + 6];
            const float a0 = acc0[i] * rs, a1 = acc1[i] * rs;
            const float b0 = __shfl_xor(a0, 1), b1 = __shfl_xor(a1, 1);
            if ((r & 1) == 0) {
                const int j0 = (n0 + wn * 64 + r) >> 1;
                hid[(size_t)(s0 + lr) * EFF + j0] = (bf16_t)f2bf(siluf(a0) * b0);
                hid[(size_t)(s0 + lr) * EFF + j0 + 16] = (bf16_t)f2bf(siluf(a1) * b1);
            }
        }
    }
}

__device__ __forceinline__ void phase12(const Params& p, unsigned char* lds) {
    const int tid = opaque_tid(), lane = tid & 63, w = tid >> 6, wm = w >> 1, wn = w & 1, r = lane & 31, h = lane >> 5;
    int* off = (int*)(lds + 40960);
    moe_offsets(p, off);
    const bf16_t* hid = (const bf16_t*)(p.ws + WS_HID); const bf16_t* WdT = (const bf16_t*)(p.ws + WS_WD);
    bf16_t* yb = (bf16_t*)(p.ws + WS_Y);
    const int nrt = off[NEXP] >> 7;
    for (int t = blockIdx.x; t < nrt * 8; t += gridDim.x) {
        const int rt = t >> 3, nt = t & 7, s0 = rt * 128, n0 = nt * 128;
        int e = 0;
        for (int q = 1; q < NEXP; ++q) if (off[q] <= s0) e = q;
        f32x16 acc0, acc1;
        gemm128(lds, hid + (size_t)(s0 + (tid >> 2)) * EFF, WdT + ((size_t)e * 1024 + n0 + (tid >> 2)) * EFF, EFF, acc0, acc1);
#pragma unroll
        for (int i = 0; i < 16; ++i) {
            const size_t row = s0 + wm * 32 + crow(i, h); const int col = n0 + wn * 64 + r;
            yb[row * DM + col] = (bf16_t)f2bf(acc0[i]); yb[row * DM + col + 32] = (bf16_t)f2bf(acc1[i]);
        }
    }
}

__device__ __forceinline__ void phase13(const Params& p, unsigned char* lds) {
    const int tid = opaque_tid(), lane = tid & 63, w = tid >> 6;
    int* off = (int*)(lds + 40960);
    moe_offsets(p, off);
    const int gw = blockIdx.x * NWAVES + w, NGW = gridDim.x * NWAVES;
    const float* x2 = (const float*)(p.ws + WS_X1); const bf16_t* yb = (const bf16_t*)(p.ws + WS_Y);
    const float* route = (const float*)(p.ws + WS_ROUTE); const float* wf = p.in[27];
    f32x4 wv[4];
#pragma unroll
    for (int j = 0; j < 4; ++j) wv[j] = *(const f32x4*)(wf + 4 * lane + 256 * j);
    for (int m = gw; m < NT; m += NGW) {
        const int* ri = (const int*)(route + (size_t)m * 8);
        const int ea = ri[0], eb = ri[1], pa = ri[2], pb = ri[3];
        const float w1 = route[(size_t)m * 8 + 4], w2 = route[(size_t)m * 8 + 5];
        const size_t sa = (size_t)off[ea] + pa, sb = (size_t)off[eb] + pb;
        const f32x4* xr = (const f32x4*)(x2 + (size_t)m * DM) + lane;
        const u32x2* ya = (const u32x2*)(yb + sa * DM) + lane; const u32x2* ybp = (const u32x2*)(yb + sb * DM) + lane;
        f32x4 v[4]; float s = 0.f;
#pragma unroll
        for (int j = 0; j < 4; ++j) {
            v[j] = xr[64 * j]; const u32x2 a = ya[64 * j], bq = ybp[64 * j];
            v[j].x += w1 * bflo(a.x) + w2 * bflo(bq.x); v[j].y += w1 * bfhi(a.x) + w2 * bfhi(bq.x);
            v[j].z += w1 * bflo(a.y) + w2 * bflo(bq.y); v[j].w += w1 * bfhi(a.y) + w2 * bfhi(bq.y);
            s += (v[j].x * v[j].x + v[j].y * v[j].y) + (v[j].z * v[j].z + v[j].w * v[j].w);
        }
        const float rstd = 1.f / sqrtf(wave_sum(s) * (1.f / DM) + EPS);
        f32x4* o = (f32x4*)(p.out + (size_t)m * DM) + lane;
#pragma unroll
        for (int j = 0; j < 4; ++j) o[64 * j] = v[j] * rstd * wv[j];
    }
}

constexpr int NPHASE = 13;
__global__ void __launch_bounds__(NTHREADS, 2) fwd_kernel(Params p) {
    extern __shared__ __attribute__((aligned(16))) unsigned char lds[];
#if MK_ONE_LAUNCH
    cg::grid_group grid = cg::this_grid();
#define SEAM(k) do { if (p.ph_lo <= (k) && (k) + 1 < p.ph_hi) grid.sync(); } while (0)
#else
#define SEAM(k) do { } while (0)
#endif
#define IN(k) (p.ph_lo <= (k) && (k) < p.ph_hi)
    unsigned char* ws = p.ws;
    if (IN(0)) { phase0(p, lds); } SEAM(0);
    if (IN(1)) { phase1(p, lds); } SEAM(1);
    if (IN(2)) { for (int it = blockIdx.x; it < NB * NCH; it += gridDim.x) { const int b = it / NCH, c = it % NCH; phase2_attn(p, lds, b, c); phase2_states(p, lds, b, c); } } SEAM(2);
    if (IN(3)) { phase3(p); } SEAM(3);
    if (IN(4)) { for (int it = blockIdx.x; it < NB * NCH; it += gridDim.x) { const int b = it / NCH, c = it % NCH; phase4(p, lds, b, c); } } SEAM(4);
    if (IN(5)) { phase_resid_gemm(p, lds, (const bf16_t*)(ws + WS_A2), DM, (const bf16_t*)(ws + WS_WOUT), p.in[0], (float*)(ws + WS_X1), (bf16_t*)(ws + WS_XB), (float*)(ws + WS_SSQ)); } SEAM(5);
    if (IN(6)) { phase6(p, lds); } SEAM(6);
    if (IN(7)) { phase7(p, lds); } SEAM(7);
    if (IN(8)) { phase_resid_gemm(p, lds, (const bf16_t*)(ws + WS_XO), 512, (const bf16_t*)(ws + WS_WO), (const float*)(ws + WS_X1), (float*)(ws + WS_X1), (bf16_t*)(ws + WS_XB), (float*)(ws + WS_SSQ)); } SEAM(8);
    if (IN(9)) { phase9(p); } SEAM(9);
    if (IN(10)) { phase11(p, lds); } SEAM(10);
    if (IN(11)) { phase12(p, lds); } SEAM(11);
    if (IN(12)) { phase13(p, lds); }
#undef IN
#undef SEAM
}

extern "C" void kernel_launch(void* const* d_in, const int* in_sizes, int n_in, void* d_out, int out_size, void* d_ws, size_t ws_size, hipStream_t stream) {
    static int grid = 0;
    if (grid == 0) {
        if (n_in != 28 || out_size != NT * DM || ws_size < WS_NEED) { fprintf(stderr, "kernel_launch: unexpected sizes n_in %d out %d ws %zu\n", n_in, out_size, ws_size); grid = -1; return; }
        int dev = 0, cus = 0, per_cu = 0;
        hipGetDevice(&dev);
        hipDeviceGetAttribute(&cus, hipDeviceAttributeMultiprocessorCount, dev);
        if (hipFuncSetAttribute((const void*)fwd_kernel, hipFuncAttributeMaxDynamicSharedMemorySize, LDS_BYTES) != hipSuccess) { fprintf(stderr, "kernel_launch: hipFuncSetAttribute failed\n"); grid = -1; return; }
        if (hipOccupancyMaxActiveBlocksPerMultiprocessor(&per_cu, (const void*)fwd_kernel, NTHREADS, LDS_BYTES) != hipSuccess || per_cu < 1) { fprintf(stderr, "kernel_launch: occupancy query says %d\n", per_cu); per_cu = 1; }
        (void)hipGetLastError();
        grid = cus;
    }
    if (grid < 0) return;
    Params prm{};
    for (int i = 0; i < 28; ++i) prm.in[i] = (const float*)d_in[i];
    prm.out = (float*)d_out; prm.ws = (unsigned char*)d_ws;
    for (int i = 0; i < 8; ++i) prm.inv_freq[i] = powf(500000.0f, -(float)(2 * i) / 16.0f);
#if MK_ONE_LAUNCH
    prm.ph_lo = 0; prm.ph_hi = NPHASE;
    void* args[] = {&prm};
    hipError_t e = hipLaunchCooperativeKernel((const void*)fwd_kernel, dim3(grid), dim3(NTHREADS), args, LDS_BYTES, stream);
    if (e != hipSuccess) fprintf(stderr, "cooperative launch failed: %s (grid %d)\n", hipGetErrorString(e), grid);
#else
    for (int ph = 0; ph < NPHASE; ++ph) {
        prm.ph_lo = ph; prm.ph_hi = ph + 1;
        hipLaunchKernelGGL(fwd_kernel, dim3(grid), dim3(NTHREADS), LDS_BYTES, stream, prm);
    }
#endif
}
```

```cpp
#include <hip/hip_runtime.h>
#include <hip/hip_cooperative_groups.h>
#include <cstdio>
#include <cmath>
namespace cg = cooperative_groups;

#ifndef MK_ONE_LAUNCH
#define MK_ONE_LAUNCH 1
#endif

typedef unsigned short bf16_t;
typedef short bf16x8 __attribute__((ext_vector_type(8)));
typedef float f32x4 __attribute__((ext_vector_type(4)));
typedef float f32x16 __attribute__((ext_vector_type(16)));
typedef unsigned u32x4 __attribute__((ext_vector_type(4)));
typedef unsigned u32x2 __attribute__((ext_vector_type(2)));

constexpr int NB = 8, SEQ = 4096, DM = 1024, NT = NB * SEQ;
constexpr int NPROJ = 2304, LDWIN = 2312;
constexpr int C_K = 512, C_V = 640, C_Z = 768, C_X = 1280, C_B = 1792, C_C = 2048;
constexpr int MEMT = 256, NMEM = NB * MEMT;
constexpr int NEXP = 32, EFF = 256;
constexpr int NCH = SEQ / 128;
constexpr float EPS = 1e-5f;
constexpr int NTHREADS = 512, NWAVES = 8;
constexpr int LDS_BYTES = 147456;

constexpr size_t MiB = (size_t)1 << 20;
constexpr size_t WS_CTL = 0;
constexpr size_t WS_WIN = 1 * MiB, WS_WOUT = 6 * MiB, WS_WQ = 8 * MiB, WS_WKV = 9 * MiB, WS_WO = 11 * MiB, WS_WR = 12 * MiB;
constexpr size_t WS_WGU = 16 * MiB, WS_WD = 48 * MiB;
constexpr size_t WS_MEMH = 64 * MiB, WS_KMEM = 68 * MiB, WS_VMEMT = 70 * MiB, WS_DTRAW = 72 * MiB, WS_CDEC = 73 * MiB, WS_ROUTE = 74 * MiB;
constexpr size_t WS_LIST = 76 * MiB, WS_SSQ = 80 * MiB;
constexpr size_t WS_PROJ = 96 * MiB, WS_A2 = 240 * MiB, WS_STATES = 304 * MiB, WS_START = 368 * MiB;
constexpr size_t WS_X1 = 96 * MiB, WS_XB = 304 * MiB, WS_Q2 = 368 * MiB, WS_XO = 224 * MiB, WS_XG = 224 * MiB, WS_HID = 368 * MiB, WS_Y = 224 * MiB;
constexpr size_t WS_NEED = 512 * MiB;

struct Params {
    const float* in[28];
    float* out;
    unsigned char* ws;
    float inv_freq[8];
    int ph_lo, ph_hi;
};

__device__ __forceinline__ unsigned f2bf(float f) { unsigned u = __float_as_uint(f); return (u + 0x7fffu + ((u >> 16) & 1u)) >> 16; }
__device__ __forceinline__ float bf2f(unsigned h) { return __uint_as_float(h << 16); }
__device__ __forceinline__ unsigned pk2(float lo, float hi) { return f2bf(lo) | (f2bf(hi) << 16); }
__device__ __forceinline__ float bflo(unsigned u) { return __uint_as_float(u << 16); }
__device__ __forceinline__ float bfhi(unsigned u) { return __uint_as_float(u & 0xffff0000u); }
__device__ __forceinline__ float wave_sum(float v) {
#pragma unroll
    for (int o = 32; o >= 1; o >>= 1) v += __shfl_xor(v, o);
    return v;
}
#define LDS_WAIT() asm volatile("s_waitcnt lgkmcnt(0)" ::: "memory")
__device__ __forceinline__ int opaque_tid() { int t = threadIdx.x; asm volatile("" : "+v"(t)); return t; }
__device__ __forceinline__ float siluf(float v) { return v / (1.f + __expf(-v)); }
__device__ __forceinline__ f32x16 mfma32(bf16x8 a, bf16x8 b, f32x16 c) { return __builtin_amdgcn_mfma_f32_32x32x16_bf16(a, b, c, 0, 0, 0); }
__device__ __forceinline__ f32x16 zero16() { f32x16 z;
#pragma unroll
    for (int i = 0; i < 16; ++i) z[i] = 0.f;
    return z; }
__device__ __forceinline__ int crow(int i, int h) { return (i & 3) + 8 * (i >> 2) + 4 * h; }

namespace pg8 {
#define PG8_LAS __attribute__((address_space(3)))
typedef unsigned short bf16_t;
typedef short bf16x8 __attribute__((ext_vector_type(8)));
typedef float f32x4 __attribute__((ext_vector_type(4)));
typedef unsigned u32x4 __attribute__((ext_vector_type(4)));
constexpr int BM = 256, BK = 64, HALF = 128, HTB = HALF * BK * 2  , STAGE_BYTES = 8 * HTB, NXCD = 8, WGM = 8;

__host__ __device__ __forceinline__ int lds_byte(int r, int c) { const int st = (r >> 4) * 2 + (c >> 5), rr = r & 15, cc = c & 31, ob = rr * 64 + cc * 2; return st * 1024 + (ob ^ (((ob >> 9) & 1) << 5)); }
__host__ __device__ __forceinline__ void stage_rc(int b, int& R, int& C) { const int st = b / 1024, sb = b % 1024, swz = sb ^ (((sb >> 9) & 1) << 5); R = (st >> 1) * 16 + swz / 64; C = (st & 1) * 32 + (swz % 64) / 2; }
__host__ __device__ __forceinline__ int perm32(int rho) { const int n = rho >> 4, i = rho & 15; return 8 * (i >> 2) + 4 * n + (i & 3); }

struct Unit { int pm, pn; };
struct Gemm { const bf16_t* A; const bf16_t* Bt; int M, N, K; };

struct StaticOrder {
    int nM, nN, nwg, G, c;
    __host__ __device__ void init(int M, int N, int G_, int c_) { nM = M / BM; nN = N / BM; nwg = nM * nN; G = G_; c = c_; }
    __host__ __device__ bool next(int i, Unit& u) const {
        const long L = (long)i * G + c; if (L >= nwg) return false;
        int wgid = (int)L; { const int q = nwg / NXCD, r = nwg % NXCD, xcd = wgid % NXCD, off = wgid / NXCD; wgid = (xcd < r ? xcd * (q + 1) : r * (q + 1) + (xcd - r) * q) + off; }
        const int nig = WGM * nN, gid = wgid / nig, fm = gid * WGM, gsz = (nM - fm) < WGM ? (nM - fm) : WGM;
        u.pm = fm + ((wgid % nig) % gsz); u.pn = (wgid % nig) / gsz; return true;
    }
    __device__ __forceinline__ void a_ready(const Unit&) const {}
    __device__ __forceinline__ void done(const Unit&) const {}
};
__device__ __forceinline__ unsigned cvt_pk_bf16(float lo, float hi) { unsigned r; asm volatile("v_cvt_pk_bf16_f32 %0, %1, %2" : "=v"(r) : "v"(lo), "v"(hi)); return r; }
typedef float f32x2 __attribute__((ext_vector_type(2)));
template <class Epi, class Sched, bool ALIGN_EPI = false, bool SP2 = false>
__device__ __forceinline__ void gemm_phase(PG8_LAS unsigned char* lds, const Gemm g, const Sched& S, const Epi& E) {
    const int tid = threadIdx.x, wid = __builtin_amdgcn_readfirstlane(tid >> 6), lane = tid & 63, wr = wid >> 2, wc = wid & 3, fr = lane & 15, fq = lane >> 4;
    const int K = g.K, nt = K / BK;
    unsigned voffA[2], voffB[2];
#pragma unroll
    for (int i = 0; i < 2; ++i) { int R, C; stage_rc(tid * 16 + i * 8192, R, C); const int Rb = Epi::PERM ? ((R & ~31) + perm32(R & 31)) : R;
        voffA[i] = (unsigned)(R * K + C) * 2u; voffB[i] = (unsigned)(Rb * K + C) * 2u; }
    const size_t kstep = (size_t)(BK * 2);
    const size_t hstep = (size_t)HALF * K * 2;
    const size_t tstep = 2 * hstep;
    const unsigned ldsw = (unsigned)wid * 1024u;
    const int aoff = lds_byte(wr * 64 + fr, fq * 8), boff = lds_byte(wc * 32 + fr, fq * 8);
#define PG8_SA(b, h) (((b) * 2 + (h)) * HTB)
#define PG8_SB(b, h) ((4 + (b) * 2 + (h)) * HTB)
#define PG8_STAGE(bufoff, gbase, voff) do { _Pragma("unroll") for (int _i = 0; _i < 2; ++_i) \
        __builtin_amdgcn_global_load_lds((const unsigned*)((const char*)(gbase) + (voff)[_i]), (PG8_LAS unsigned*)(lds + (bufoff) + ldsw + _i * 8192), 16, 0, 0); } while (0)
#define PG8_LDA(dst, b, h) do { _Pragma("unroll") for (int m = 0; m < 4; ++m) _Pragma("unroll") for (int k = 0; k < 2; ++k) dst[m][k] = *(const PG8_LAS bf16x8*)(lds + PG8_SA(b, h) + aoff + m * 2048 + k * 1024); } while (0)
#define PG8_LDB(dst, b, h) do { _Pragma("unroll") for (int n = 0; n < 2; ++n) _Pragma("unroll") for (int k = 0; k < 2; ++k) dst[n][k] = *(const PG8_LAS bf16x8*)(lds + PG8_SB(b, h) + boff + n * 2048 + k * 1024); } while (0)
#define PG8_MMA(ai, bj, At, Bt) do { __builtin_amdgcn_s_setprio(1); _Pragma("unroll") for (int m = 0; m < 4; ++m) _Pragma("unroll") for (int n = 0; n < 2; ++n) _Pragma("unroll") for (int k = 0; k < 2; ++k) \
        acc[ai][bj][m][n] = __builtin_amdgcn_mfma_f32_16x16x32_bf16(Bt[n][k], At[m][k], acc[ai][bj][m][n], 0, 0, 0); __builtin_amdgcn_s_setprio(0); } while (0)
#define PG8_WAIT_V(n) asm volatile("s_waitcnt vmcnt(" #n ")" ::: "memory")
#define PG8_WAIT_L(n) asm volatile("s_waitcnt lgkmcnt(" #n ")" ::: "memory")
#define PG8_BAR __builtin_amdgcn_s_barrier()
#define PG8_SCHED __builtin_amdgcn_sched_barrier(0)
    Unit cur, nxt; int ui = 0;
    if (!S.next(0, cur)) return;
    f32x4 acc[2][2][4][2];
#pragma unroll
    for (int a = 0; a < 2; ++a)
#pragma unroll
        for (int b = 0; b < 2; ++b)
#pragma unroll
            for (int m = 0; m < 4; ++m)
#pragma unroll
                for (int n = 0; n < 2; ++n) acc[a][b][m][n] = (f32x4){0.f, 0.f, 0.f, 0.f};
    bf16x8 At[4][2], B0[2][2], B1[2][2];
    const char* cA = (const char*)g.A + (size_t)cur.pm * tstep; const char* cB = (const char*)g.Bt + (size_t)cur.pn * tstep;
    S.a_ready(cur);
    if constexpr (SP2) {
        PG8_STAGE(PG8_SB(0, 0), cB, voffB); PG8_STAGE(PG8_SB(0, 1), cB + hstep, voffB); PG8_STAGE(PG8_SA(0, 0), cA, voffA); PG8_STAGE(PG8_SA(0, 1), cA + hstep, voffA);
        if (wr == 1) PG8_BAR;
        PG8_WAIT_V(2); PG8_BAR;
        PG8_STAGE(PG8_SB(1, 0), cB + kstep, voffB); PG8_STAGE(PG8_SA(1, 0), cA + kstep, voffA); PG8_STAGE(PG8_SB(1, 1), cB + hstep + kstep, voffB);
        PG8_WAIT_V(6); PG8_BAR;
    } else {
        PG8_STAGE(PG8_SB(0, 0), cB, voffB); PG8_STAGE(PG8_SA(0, 0), cA, voffA); PG8_STAGE(PG8_SB(0, 1), cB + hstep, voffB); PG8_STAGE(PG8_SA(0, 1), cA + hstep, voffA);
        if (wr == 1) PG8_BAR;
        PG8_WAIT_V(4); PG8_BAR;
        PG8_STAGE(PG8_SB(1, 0), cB + kstep, voffB); PG8_STAGE(PG8_SA(1, 0), cA + kstep, voffA); PG8_STAGE(PG8_SB(1, 1), cB + hstep + kstep, voffB);
        PG8_WAIT_V(6); PG8_BAR;
    }
    for (;;) {
        const bool has_next = S.next(ui + 1, nxt);
        const char* nA = has_next ? (const char*)g.A + (size_t)nxt.pm * tstep : cA; const char* nB = has_next ? (const char*)g.Bt + (size_t)nxt.pn * tstep : cB;
        for (int t = 0; t < nt; t += 2) {
            const bool last = (t == nt - 2);
            const char* a1 = cA + (size_t)(t + 1) * kstep;
            const char* a2 = last ? nA : cA + (size_t)(t + 2) * kstep; const char* b2 = last ? nB : cB + (size_t)(t + 2) * kstep;
            const char* a3 = a2 + kstep; const char* b3 = b2 + kstep;
            if (last && has_next) S.a_ready(nxt);
            if constexpr (SP2) {
            PG8_LDB(B0, 0, 0); PG8_LDB(B1, 0, 1); PG8_SCHED; PG8_LDA(At, 0, 0); PG8_STAGE(PG8_SA(1, 1), a1 + hstep, voffA);
            PG8_WAIT_V(8); PG8_WAIT_L(0); PG8_BAR; PG8_MMA(0, 0, At, B0); PG8_MMA(0, 1, At, B1); PG8_BAR; PG8_SCHED;
            PG8_LDA(At, 0, 1); PG8_STAGE(PG8_SB(0, 0), b2, voffB); PG8_STAGE(PG8_SB(0, 1), b2 + hstep, voffB); PG8_STAGE(PG8_SA(0, 0), a2, voffA);
            PG8_WAIT_V(8); PG8_WAIT_L(0); PG8_BAR; PG8_MMA(1, 0, At, B0); PG8_MMA(1, 1, At, B1); PG8_BAR; PG8_SCHED;
            PG8_LDB(B0, 1, 0); PG8_LDB(B1, 1, 1); PG8_SCHED; PG8_LDA(At, 1, 0); PG8_STAGE(PG8_SA(0, 1), a2 + hstep, voffA);
            PG8_WAIT_V(8); PG8_WAIT_L(0); PG8_BAR; PG8_MMA(0, 0, At, B0); PG8_MMA(0, 1, At, B1); PG8_BAR; PG8_SCHED;
            PG8_LDA(At, 1, 1); PG8_STAGE(PG8_SB(1, 0), b3, voffB); PG8_STAGE(PG8_SB(1, 1), b3 + hstep, voffB); PG8_STAGE(PG8_SA(1, 0), a3, voffA);
            PG8_WAIT_V(8); PG8_WAIT_L(0); PG8_BAR; PG8_MMA(1, 0, At, B0); PG8_MMA(1, 1, At, B1); PG8_BAR; PG8_SCHED;
            } else {
            PG8_LDB(B0, 0, 0); PG8_SCHED; PG8_LDA(At, 0, 0); PG8_STAGE(PG8_SA(1, 1), a1 + hstep, voffA);
            PG8_WAIT_L(8); PG8_BAR; PG8_WAIT_L(0); PG8_MMA(0, 0, At, B0); PG8_BAR; PG8_SCHED;
            PG8_LDB(B1, 0, 1); PG8_STAGE(PG8_SB(0, 0), b2, voffB);
            PG8_BAR; PG8_WAIT_L(0); PG8_MMA(0, 1, At, B1); PG8_BAR;
            PG8_LDA(At, 0, 1); PG8_STAGE(PG8_SA(0, 0), a2, voffA);
            PG8_BAR; PG8_WAIT_L(0); PG8_MMA(1, 0, At, B0); PG8_BAR; PG8_SCHED;
            PG8_STAGE(PG8_SB(0, 1), b2 + hstep, voffB);
            PG8_WAIT_V(6); PG8_BAR; PG8_MMA(1, 1, At, B1); PG8_BAR;
            PG8_LDB(B0, 1, 0); PG8_SCHED; PG8_LDA(At, 1, 0); PG8_STAGE(PG8_SA(0, 1), a2 + hstep, voffA);
            PG8_WAIT_L(8); PG8_BAR; PG8_WAIT_L(0); PG8_MMA(0, 0, At, B0); PG8_BAR; PG8_SCHED;
            PG8_LDB(B1, 1, 1); PG8_STAGE(PG8_SB(1, 0), b3, voffB);
            PG8_BAR; PG8_WAIT_L(0); PG8_MMA(0, 1, At, B1); PG8_BAR;
            PG8_LDA(At, 1, 1); PG8_STAGE(PG8_SA(1, 0), a3, voffA);
            PG8_BAR; PG8_WAIT_L(0); PG8_MMA(1, 0, At, B0); PG8_BAR; PG8_SCHED;
            PG8_STAGE(PG8_SB(1, 1), b3 + hstep, voffB);
            PG8_WAIT_V(6); PG8_BAR; PG8_MMA(1, 1, At, B1); PG8_BAR;
            }
        }
        if constexpr (ALIGN_EPI) { if (wr == 0) PG8_BAR; }
        if constexpr (!Epi::AFTER_DRAIN) { E(acc, cur, wr, wc, fr, fq); S.done(cur); }
        if (!has_next) break;
#pragma unroll
        for (int a = 0; a < 2; ++a)
#pragma unroll
            for (int b = 0; b < 2; ++b)
#pragma unroll
                for (int m = 0; m < 4; ++m)
#pragma unroll
                    for (int n = 0; n < 2; ++n) acc[a][b][m][n] = (f32x4){0.f, 0.f, 0.f, 0.f};
        cur = nxt; cA = nA; cB = nB; ++ui;
        if constexpr (ALIGN_EPI) { if (wr == 1) PG8_BAR; }
    }
    PG8_WAIT_V(0);
    if constexpr (!ALIGN_EPI) { if (wr == 0) PG8_BAR; }
    PG8_BAR;
    if constexpr (Epi::AFTER_DRAIN) { E.fused(acc, cur, wr, wc, fr, fq, lds, wid, lane); S.done(cur); }
#undef PG8_SA
#undef PG8_SB
#undef PG8_STAGE
#undef PG8_LDA
#undef PG8_LDB
#undef PG8_MMA
#undef PG8_WAIT_V
#undef PG8_WAIT_L
#undef PG8_BAR
#undef PG8_SCHED
}

struct EpiBf16 {
    static constexpr bool PERM = true, AFTER_DRAIN = false;
    bf16_t* O; int ldc; int npn;
    __device__ __forceinline__ void operator()(const f32x4 (&acc)[2][2][4][2], const Unit& u, int wr, int wc, int fr, int fq) const {
        const int row0 = u.pm * BM + wr * 64 + fr, col0 = (u.pn % npn) * BM + wc * 32 + 8 * fq;
#pragma unroll
        for (int ai = 0; ai < 2; ++ai)
#pragma unroll
            for (int m = 0; m < 4; ++m) { bf16_t* rowp = O + (size_t)(row0 + ai * HALF + m * 16) * ldc + col0;
#pragma unroll
                for (int bj = 0; bj < 2; ++bj) { const f32x4 v0 = acc[ai][bj][m][0], v1 = acc[ai][bj][m][1];
                    u32x4 w; w.x = cvt_pk_bf16(v0[0], v0[1]); w.y = cvt_pk_bf16(v0[2], v0[3]); w.z = cvt_pk_bf16(v1[0], v1[1]); w.w = cvt_pk_bf16(v1[2], v1[3]);
                    *(u32x4*)(rowp + bj * HALF) = w; } }
    }
};
struct EpiKV {
    static constexpr bool PERM = true, AFTER_DRAIN = false;
    bf16_t* kmem; bf16_t* vmemT;
    __device__ __forceinline__ void operator()(const f32x4 (&acc)[2][2][4][2], const Unit& u, int wr, int wc, int fr, int fq) const {
        const int row0 = u.pm * BM + wr * 64 + fr, col0 = u.pn * BM + wc * 32 + 8 * fq;
#pragma unroll
        for (int ai = 0; ai < 2; ++ai)
#pragma unroll
            for (int m = 0; m < 4; ++m) { const int row = row0 + ai * HALF + m * 16;
#pragma unroll
                for (int bj = 0; bj < 2; ++bj) { const f32x4 v0 = acc[ai][bj][m][0], v1 = acc[ai][bj][m][1]; const int col = col0 + bj * HALF;
                    if (col < 512) { u32x4 w; w.x = cvt_pk_bf16(v0[0], v0[1]); w.y = cvt_pk_bf16(v0[2], v0[3]); w.z = cvt_pk_bf16(v1[0], v1[1]); w.w = cvt_pk_bf16(v1[2], v1[3]);
                        *(u32x4*)(kmem + (size_t)row * 512 + col) = w; }
                    else { const int c2 = col - 512, hx = c2 >> 7, d = c2 & 127, b = row >> 8, key = row & 255;
                        bf16_t* vp = vmemT + (((size_t)b * 4 + hx) * 128 + d) * 256 + key;
                        const unsigned w0 = cvt_pk_bf16(v0[0], v0[1]), w1 = cvt_pk_bf16(v0[2], v0[3]), w2 = cvt_pk_bf16(v1[0], v1[1]), w3 = cvt_pk_bf16(v1[2], v1[3]);
                        vp[0 * 256] = (bf16_t)(w0 & 0xffffu); vp[1 * 256] = (bf16_t)(w0 >> 16); vp[2 * 256] = (bf16_t)(w1 & 0xffffu); vp[3 * 256] = (bf16_t)(w1 >> 16);
                        vp[4 * 256] = (bf16_t)(w2 & 0xffffu); vp[5 * 256] = (bf16_t)(w2 >> 16); vp[6 * 256] = (bf16_t)(w3 & 0xffffu); vp[7 * 256] = (bf16_t)(w3 >> 16); } } }
    }
};
template <bool STATS> struct EpiResid {
    static constexpr bool PERM = false, AFTER_DRAIN = false;
    const float* xin; float* xout; bf16_t* xb; float* ssq;
    __device__ __forceinline__ void operator()(const f32x4 (&acc)[2][2][4][2], const Unit& u, int wr, int wc, int fr, int fq) const {
        const int col0 = u.pn * BM + wc * 32 + 4 * fq;
#pragma unroll
        for (int ai = 0; ai < 2; ++ai)
#pragma unroll
            for (int m = 0; m < 4; ++m) { const size_t row = (size_t)(u.pm * BM + ai * HALF + wr * 64 + m * 16 + fr); const size_t off = row * 1024 + col0;
                float q = 0.f;
#pragma unroll
                for (int bj = 0; bj < 2; ++bj)
#pragma unroll
                    for (int n = 0; n < 2; ++n) { const f32x4 bs = *(const f32x4*)(xin + off + bj * HALF + n * 16); const f32x4 o = bs + acc[ai][bj][m][n];
                        *(f32x4*)(xout + off + bj * HALF + n * 16) = o;
                        if (STATS) { typedef unsigned u32x2v __attribute__((ext_vector_type(2))); u32x2v w; w.x = cvt_pk_bf16(o[0], o[1]); w.y = cvt_pk_bf16(o[2], o[3]); *(u32x2v*)(xb + off + bj * HALF + n * 16) = w;
                            q += (o[0] * o[0] + o[1] * o[1]) + (o[2] * o[2] + o[3] * o[3]); } }
                if (STATS) { q += __shfl_xor(q, 16); q += __shfl_xor(q, 32); if (fq == 0) ssq[row * 16 + u.pn * 4 + wc] = q; }
                asm volatile("" ::: "memory"); }
    }
};
struct EpiQ {
    static constexpr bool PERM = true, AFTER_DRAIN = false;
    bf16_t* O; const float* ssq;
    __device__ __forceinline__ void operator()(const f32x4 (&acc)[2][2][4][2], const Unit& u, int wr, int wc, int fr, int fq) const {
        const int row0 = u.pm * BM + wr * 64 + fr, col0 = u.pn * BM + wc * 32 + 8 * fq;
#pragma unroll
        for (int ai = 0; ai < 2; ++ai)
#pragma unroll
            for (int m = 0; m < 4; ++m) { const size_t row = (size_t)(row0 + ai * HALF + m * 16);
                const f32x4* sp = (const f32x4*)(ssq + row * 16); const f32x4 s0 = sp[0], s1 = sp[1], s2 = sp[2], s3 = sp[3];
                const float s = ((s0[0] + s0[1]) + (s0[2] + s0[3])) + ((s1[0] + s1[1]) + (s1[2] + s1[3])) + ((s2[0] + s2[1]) + (s2[2] + s2[3])) + ((s3[0] + s3[1]) + (s3[2] + s3[3]));
                const float rs = 1.f / sqrtf(s * (1.f / 1024.f) + 1e-5f);
                bf16_t* rowp = O + row * 512 + col0;
#pragma unroll
                for (int bj = 0; bj < 2; ++bj) { const f32x4 v0 = acc[ai][bj][m][0] * rs, v1 = acc[ai][bj][m][1] * rs;
                    u32x4 w; w.x = cvt_pk_bf16(v0[0], v0[1]); w.y = cvt_pk_bf16(v0[2], v0[3]); w.z = cvt_pk_bf16(v1[0], v1[1]); w.w = cvt_pk_bf16(v1[2], v1[3]);
                    *(u32x4*)(rowp + bj * HALF) = w; } }
    }
};
struct EpiGU {
    static constexpr bool PERM = true, AFTER_DRAIN = false;
    bf16_t* hid;
    __device__ __forceinline__ void operator()(const f32x4 (&acc)[2][2][4][2], const Unit& u, int wr, int wc, int fr, int fq) const {
        const int row0 = u.pm * BM + wr * 64 + fr, j0 = (u.pn & 1) * 128 + wc * 16 + 4 * fq;
#pragma unroll
        for (int ai = 0; ai < 2; ++ai)
#pragma unroll
            for (int m = 0; m < 4; ++m) { bf16_t* rowp = hid + (size_t)(row0 + ai * HALF + m * 16) * 256 + j0;
#pragma unroll
                for (int bj = 0; bj < 2; ++bj) { const f32x4 v0 = acc[ai][bj][m][0], v1 = acc[ai][bj][m][1];
                    const float h0 = v0[0] / (1.f + __expf(-v0[0])) * v0[1], h1 = v0[2] / (1.f + __expf(-v0[2])) * v0[3];
                    const float h2 = v1[0] / (1.f + __expf(-v1[0])) * v1[1], h3 = v1[2] / (1.f + __expf(-v1[2])) * v1[3];
                    typedef unsigned u32x2v __attribute__((ext_vector_type(2))); u32x2v w; w.x = cvt_pk_bf16(h0, h1); w.y = cvt_pk_bf16(h2, h3);
                    *(u32x2v*)(rowp + bj * 64) = w; } }
    }
};
struct SubOrder {
    int nM, nN, nwg, span, c;
    __device__ void init(int M, int N, int span_, int c_) { nM = M / BM; nN = N / BM; nwg = nM * nN; span = span_; c = c_; }
    __device__ bool next(int i, Unit& u) const { if (c < 0 || c >= span) return false; const int L = i * span + c; if (L >= nwg) return false; u.pm = L / nN; u.pn = L % nN; return true; }
    __device__ __forceinline__ void a_ready(const Unit&) const {}
    __device__ __forceinline__ void done(const Unit&) const {}
};
struct MoeOrder {
    const PG8_LAS int* tile_e; int nrt, npn, G, c;
    __device__ bool next(int i, Unit& u) const { const int L = i * G + c; if (L >= nrt * npn) return false; const int rt = L / npn, pnl = L % npn; u.pm = rt; u.pn = tile_e[rt] * npn + pnl; return true; }
    __device__ __forceinline__ void a_ready(const Unit&) const {}
    __device__ __forceinline__ void done(const Unit&) const {}
};
}

__device__ __forceinline__ void gemm128(unsigned char* lds, const bf16_t* arow, const bf16_t* brow, int K, f32x16& acc0, f32x16& acc1) {
    const int tid = opaque_tid(), lane = tid & 63, w = tid >> 6;
    bf16_t* sA = (bf16_t*)lds;
    bf16_t* sB = sA + 128 * 72;
    const int srow = tid >> 2, skc = (tid & 3) * 16;
    const bf16_t* ap = arow + skc;
    const bf16_t* bp = brow + skc;
    const int wm = w >> 1, wn = w & 1, r = lane & 31, h = lane >> 5;
    acc0 = zero16(); acc1 = zero16();
    for (int k0 = 0; k0 < K; k0 += 64) {
        const u32x4 a0 = *(const u32x4*)(ap + k0), a1 = *(const u32x4*)(ap + k0 + 8);
        const u32x4 b0 = *(const u32x4*)(bp + k0), b1 = *(const u32x4*)(bp + k0 + 8);
        __syncthreads();
        *(u32x4*)(sA + srow * 72 + skc) = a0; *(u32x4*)(sA + srow * 72 + skc + 8) = a1;
        *(u32x4*)(sB + srow * 72 + skc) = b0; *(u32x4*)(sB + srow * 72 + skc + 8) = b1;
        __syncthreads();
#pragma unroll
        for (int kk = 0; kk < 64; kk += 16) {
            const bf16x8 a = *(const bf16x8*)(sA + (wm * 32 + r) * 72 + kk + 8 * h);
            const bf16x8 bA = *(const bf16x8*)(sB + (wn * 64 + r) * 72 + kk + 8 * h);
            const bf16x8 bB = *(const bf16x8*)(sB + (wn * 64 + 32 + r) * 72 + kk + 8 * h);
            acc0 = mfma32(a, bA, acc0); acc1 = mfma32(a, bB, acc1);
        }
    }
    __syncthreads();
}

__device__ __forceinline__ void p0_transpose_item(const float* W, int ldw, int K, int nblk, const float* scale, bf16_t* WT, int row_off, int row_mul, float* scr, int item, int lane) {
    const int kb = item / nblk, nb = item % nblk, k0 = 64 * kb, n0 = 32 * nb;
#pragma unroll 8
    for (int i = 0; i < 32; ++i) { const int kk = 2 * i + (lane >> 5); float v = W[(size_t)(k0 + kk) * ldw + n0 + (lane & 31)]; if (scale) v *= scale[k0 + kk]; scr[kk * 33 + (lane & 31)] = v; }
    LDS_WAIT();
    const int c = lane & 7;
#pragma unroll
    for (int j = 0; j < 4; ++j) { const int n = (lane >> 3) + 8 * j; const float* s = scr + (8 * c) * 33 + n;
        u32x4 o; o.x = pk2(s[0 * 33], s[1 * 33]); o.y = pk2(s[2 * 33], s[3 * 33]); o.z = pk2(s[4 * 33], s[5 * 33]); o.w = pk2(s[6 * 33], s[7 * 33]);
        *(u32x4*)(WT + (size_t)(row_off + (n0 + n) * row_mul) * K + k0 + 8 * c) = o; }
    LDS_WAIT();
}

__device__ __forceinline__ void phase0(const Params& p, unsigned char* lds) {
    const int tid = opaque_tid(), lane = tid & 63, w = tid >> 6;
    unsigned char* ws = p.ws;
    const int gw = blockIdx.x * NWAVES + w, NGW = gridDim.x * NWAVES;
    if (blockIdx.x == 0 && tid < 64) ((int*)(ws + WS_CTL))[tid] = 0;
    {
        float* WR = (float*)(ws + WS_WR);
        const float* w3 = p.in[19]; const float* wg = p.in[20]; const float* we = p.in[22];
        for (int i = blockIdx.x * NTHREADS + tid; i < 36 * 1024; i += gridDim.x * NTHREADS) {
            const int n = i >> 10, k = i & 1023;
            const float v = (n < 4) ? wg[k * 4 + n] : we[k * 32 + (n - 4)];
            WR[i] = v * w3[k];
        }
    }
    {
        float* scr = (float*)(lds + 32768) + w * (64 * 33 + 16);
        constexpr int I_IN = 16 * 72, I_OUT = 16 * 32, I_Q = 16 * 16, I_KV = 16 * 32, I_O = 8 * 32, I_G = 32 * 16 * 8, I_D = 32 * 4 * 32;
        constexpr int NITEMS = I_IN + I_OUT + I_Q + I_KV + I_O + 2 * I_G + I_D;
        for (int it = gw; it < NITEMS; it += NGW) {
            int r = it;
            if (r < I_IN) { p0_transpose_item(p.in[4], LDWIN, 1024, 72, nullptr, (bf16_t*)(ws + WS_WIN), 0, 1, scr, r, lane); continue; } r -= I_IN;
            if (r < I_OUT) { p0_transpose_item(p.in[13], 1024, 1024, 32, nullptr, (bf16_t*)(ws + WS_WOUT), 0, 1, scr, r, lane); continue; } r -= I_OUT;
            if (r < I_Q) { p0_transpose_item(p.in[16], 512, 1024, 16, p.in[14], (bf16_t*)(ws + WS_WQ), 0, 1, scr, r, lane); continue; } r -= I_Q;
            if (r < I_KV) { p0_transpose_item(p.in[17], 1024, 1024, 32, nullptr, (bf16_t*)(ws + WS_WKV), 0, 1, scr, r, lane); continue; } r -= I_KV;
            if (r < I_O) { p0_transpose_item(p.in[18], 1024, 512, 32, nullptr, (bf16_t*)(ws + WS_WO), 0, 1, scr, r, lane); continue; } r -= I_O;
            if (r < I_G) { const int e = r / 128, ri = r % 128; p0_transpose_item(p.in[24] + (size_t)e * 1024 * 256, 256, 1024, 8, p.in[19], (bf16_t*)(ws + WS_WGU) + (size_t)e * 512 * 1024, 0, 2, scr, ri, lane); continue; } r -= I_G;
            if (r < I_G) { const int e = r / 128, ri = r % 128; p0_transpose_item(p.in[25] + (size_t)e * 1024 * 256, 256, 1024, 8, p.in[19], (bf16_t*)(ws + WS_WGU) + (size_t)e * 512 * 1024, 1, 2, scr, ri, lane); continue; } r -= I_G;
            { const int e = r / 128, ri = r % 128; p0_transpose_item(p.in[26] + (size_t)e * 256 * 1024, 1024, 256, 32, nullptr, (bf16_t*)(ws + WS_WD) + (size_t)e * 1024 * 256, 0, 1, scr, ri, lane); }
        }
    }
    float* wdt = (float*)lds;
    {
        const float* win = p.in[4]; const float* w1 = p.in[3];
        for (int i = tid; i < 8192; i += NTHREADS) { const int k = i >> 3, n = i & 7; wdt[n * 1024 + k] = win[(size_t)k * LDWIN + 2304 + n] * w1[k]; }
    }
    __syncthreads();
    {
        const float* x = p.in[0]; const float* w1 = p.in[3];
        bf16_t* h1 = (bf16_t*)p.out; float* dtraw = (float*)(ws + WS_DTRAW);
        f32x4 wv[4];
#pragma unroll
        for (int j = 0; j < 4; ++j) wv[j] = *(const f32x4*)(w1 + 4 * lane + 256 * j);
        for (int m = gw; m < NT; m += NGW) {
            const f32x4* xr = (const f32x4*)(x + (size_t)m * DM) + lane;
            f32x4 v[4]; float s = 0.f;
#pragma unroll
            for (int j = 0; j < 4; ++j) { v[j] = xr[64 * j]; s += (v[j].x * v[j].x + v[j].y * v[j].y) + (v[j].z * v[j].z + v[j].w * v[j].w); }
            const float rstd = 1.f / sqrtf(wave_sum(s) * (1.f / DM) + EPS);
            float d[8];
#pragma unroll
            for (int n = 0; n < 8; ++n) { float a = 0.f;
#pragma unroll
                for (int j = 0; j < 4; ++j) { const f32x4 ww = *(const f32x4*)(wdt + n * 1024 + 4 * lane + 256 * j); a += (v[j].x * ww.x + v[j].y * ww.y) + (v[j].z * ww.z + v[j].w * ww.w); }
                d[n] = wave_sum(a) * rstd; }
            if (lane == 0) { *(f32x4*)(dtraw + (size_t)m * 8) = (f32x4){d[0], d[1], d[2], d[3]}; *(f32x4*)(dtraw + (size_t)m * 8 + 4) = (f32x4){d[4], d[5], d[6], d[7]}; }
            u32x2* o8 = (u32x2*)(h1 + (size_t)m * DM) + lane;
#pragma unroll
            for (int j = 0; j < 4; ++j) { u32x2 o; o.x = pk2(v[j].x * rstd * wv[j].x, v[j].y * rstd * wv[j].y); o.y = pk2(v[j].z * rstd * wv[j].z, v[j].w * rstd * wv[j].w); o8[64 * j] = o; }
        }
    }
    {
        const float* mem = p.in[1]; const float* wm = p.in[15];
        bf16_t* memh = (bf16_t*)(ws + WS_MEMH);
        f32x4 wv[4];
#pragma unroll
        for (int j = 0; j < 4; ++j) wv[j] = *(const f32x4*)(wm + 4 * lane + 256 * j);
        for (int m = gw; m < NMEM; m += NGW) {
            const f32x4* xr = (const f32x4*)(mem + (size_t)m * DM) + lane;
            f32x4 v[4]; float s = 0.f;
#pragma unroll
            for (int j = 0; j < 4; ++j) { v[j] = xr[64 * j]; s += (v[j].x * v[j].x + v[j].y * v[j].y) + (v[j].z * v[j].z + v[j].w * v[j].w); }
            const float rstd = 1.f / sqrtf(wave_sum(s) * (1.f / DM) + EPS);
            u32x2* o8 = (u32x2*)(memh + (size_t)m * DM) + lane;
#pragma unroll
            for (int j = 0; j < 4; ++j) { u32x2 o; o.x = pk2(v[j].x * rstd * wv[j].x, v[j].y * rstd * wv[j].y); o.y = pk2(v[j].z * rstd * wv[j].z, v[j].w * rstd * wv[j].w); o8[64 * j] = o; }
        }
    }
    __syncthreads();
}

#define LDS3(p) ((__attribute__((address_space(3))) unsigned char*)(p))
__device__ __forceinline__ void phase1(const Params& p, unsigned char* lds) {
    unsigned char* ws = p.ws;
    {
        pg8::Gemm g{(const bf16_t*)p.out, (const bf16_t*)(ws + WS_WIN), NT, NPROJ, DM};
        pg8::StaticOrder S; S.init(NT, NPROJ, (int)gridDim.x, (int)blockIdx.x);
        pg8::EpiBf16 E{(bf16_t*)(ws + WS_PROJ), NPROJ, NPROJ / 256};
        pg8::gemm_phase<pg8::EpiBf16, pg8::StaticOrder, true, true>(LDS3(lds), g, S, E);
    }
    {
        pg8::Gemm g{(const bf16_t*)(ws + WS_MEMH), (const bf16_t*)(ws + WS_WKV), NMEM, 1024, DM};
        pg8::SubOrder S; S.init(NMEM, 1024, 128, (int)blockIdx.x - 128);
        pg8::EpiKV E{(bf16_t*)(ws + WS_KMEM), (bf16_t*)(ws + WS_VMEMT)};
        pg8::gemm_phase<pg8::EpiKV, pg8::SubOrder, true, true>(LDS3(lds), g, S, E);
    }
}

__device__ __forceinline__ float bfel(const u32x4& v, int ci) { const unsigned wv = (ci >> 1) == 0 ? v.x : (ci >> 1) == 1 ? v.y : (ci >> 1) == 2 ? v.z : v.w; return (ci & 1) ? bfhi(wv) : bflo(wv); }
template <bool TRANS>
__device__ __forceinline__ void conv8x8(const Params& p, int b, int c, int l0, int ch0, const float (&f)[8], u32x4 (&res)[8]) {
    const bf16_t* proj = (const bf16_t*)(p.ws + WS_PROJ);
    const float* cw = p.in[6]; const float* cb = p.in[7];
    float wgt[4][8], bias[8];
#pragma unroll
    for (int j = 0; j < 4; ++j) { const f32x4 a = *(const f32x4*)(cw + j * 1024 + ch0), b2 = *(const f32x4*)(cw + j * 1024 + ch0 + 4);
        wgt[j][0] = a.x; wgt[j][1] = a.y; wgt[j][2] = a.z; wgt[j][3] = a.w; wgt[j][4] = b2.x; wgt[j][5] = b2.y; wgt[j][6] = b2.z; wgt[j][7] = b2.w; }
    { const f32x4 a = *(const f32x4*)(cb + ch0), b2 = *(const f32x4*)(cb + ch0 + 4); bias[0] = a.x; bias[1] = a.y; bias[2] = a.z; bias[3] = a.w; bias[4] = b2.x; bias[5] = b2.y; bias[6] = b2.z; bias[7] = b2.w; }
    u32x4 in[11];
    const int t0 = c * 128 + l0 - 3;
    const bf16_t* rp = proj + ((long)(b * SEQ) + t0) * NPROJ + C_X + ch0;
    asm volatile("" : "+v"(rp));
#pragma unroll
    for (int i = 0; i < 11; ++i) {
        const int t = t0 + i;
        in[i] = (u32x4){0u, 0u, 0u, 0u};
        if (t >= 0) in[i] = *(const u32x4*)(rp + (size_t)i * NPROJ);
    }
    if (TRANS) {
#pragma unroll
        for (int ci = 0; ci < 8; ++ci) {
            float o[8];
#pragma unroll
            for (int li = 0; li < 8; ++li) { float a = bias[ci];
#pragma unroll
                for (int j = 0; j < 4; ++j) a += wgt[j][ci] * bfel(in[li + j], ci);
                o[li] = siluf(a) * f[li]; }
            res[ci] = (u32x4){pk2(o[0], o[1]), pk2(o[2], o[3]), pk2(o[4], o[5]), pk2(o[6], o[7])};
        }
    } else {
#pragma unroll
        for (int li = 0; li < 8; ++li) {
            float o[8];
#pragma unroll
            for (int ci = 0; ci < 8; ++ci) { float a = bias[ci];
#pragma unroll
                for (int j = 0; j < 4; ++j) a += wgt[j][ci] * bfel(in[li + j], ci);
                o[ci] = siluf(a) * f[li]; }
            res[li] = (u32x4){pk2(o[0], o[1]), pk2(o[2], o[3]), pk2(o[4], o[5]), pk2(o[6], o[7])};
        }
    }
}

__device__ __forceinline__ void conv2x8T(const Params& p, int b, int c, int l0, int ch0, u32x4 (&res)[2]) {
    const bf16_t* proj = (const bf16_t*)(p.ws + WS_PROJ);
    const float* cw = p.in[6]; const float* cb = p.in[7];
    float wgt[4][2], bias[2];
#pragma unroll
    for (int j = 0; j < 4; ++j) { wgt[j][0] = cw[j * 1024 + ch0]; wgt[j][1] = cw[j * 1024 + ch0 + 1]; }
    bias[0] = cb[ch0]; bias[1] = cb[ch0 + 1];
    unsigned in[11];
    const int t0 = c * 128 + l0 - 3;
    const bf16_t* rp = proj + ((long)(b * SEQ) + t0) * NPROJ + C_X + ch0;
    asm volatile("" : "+v"(rp));
#pragma unroll
    for (int i = 0; i < 11; ++i) { const int t = t0 + i; in[i] = 0u; if (t >= 0) in[i] = *(const unsigned*)(rp + (size_t)i * NPROJ); }
#pragma unroll
    for (int ci = 0; ci < 2; ++ci) {
        float o[8];
#pragma unroll
        for (int li = 0; li < 8; ++li) { float a = bias[ci];
#pragma unroll
            for (int j = 0; j < 4; ++j) a += wgt[j][ci] * (ci ? bfhi(in[li + j]) : bflo(in[li + j]));
            o[li] = siluf(a); }
        res[ci] = (u32x4){pk2(o[0], o[1]), pk2(o[2], o[3]), pk2(o[4], o[5]), pk2(o[6], o[7])};
    }
}

__device__ __forceinline__ void ssd_dt_cum(const Params& p, int b, int c, float* dts, float* cums) {
    const int tid = opaque_tid(), lane = tid & 63, w = tid >> 6;
    const float* dtraw = (const float*)(p.ws + WS_DTRAW);
    const float bias = p.in[8][w], a = -__expf(p.in[9][w]);
    const size_t row0 = (size_t)b * SEQ + c * 128;
    float x0 = dtraw[(row0 + 2 * lane) * 8 + w] + bias, x1 = dtraw[(row0 + 2 * lane + 1) * 8 + w] + bias;
    const float d0 = fmaxf(x0, 0.f) + log1pf(__expf(-fabsf(x0))), d1 = fmaxf(x1, 0.f) + log1pf(__expf(-fabsf(x1)));
    const float a0 = d0 * a, a1 = d1 * a;
    float s = a0 + a1;
#pragma unroll
    for (int o = 1; o < 64; o <<= 1) { const float t = __shfl_up(s, o); if (lane >= o) s += t; }
    dts[w * 128 + 2 * lane] = d0; dts[w * 128 + 2 * lane + 1] = d1;
    cums[w * 128 + 2 * lane] = s - a1; cums[w * 128 + 2 * lane + 1] = s;
}

__device__ __forceinline__ void phase2_attn(const Params& p, unsigned char* lds, int b, int blk) {
    const int tid = opaque_tid(), lane = tid & 63, w = tid >> 6, r = lane & 31, h = lane >> 5;
    const bf16_t* proj = (const bf16_t*)(p.ws + WS_PROJ);
    const int* positions = (const int*)p.in[2];
    float* cs = (float*)lds;
    float* sn = cs + 2048;
    float* ssq = sn + 2048;
    bf16_t* sK = (bf16_t*)(lds + 20480);
    bf16_t* sVT = sK + 256 * 72;
    bf16_t* sP = sVT + 64 * 264;
    bf16_t* sQ = sP + 8 * 32 * 40;
    bf16_t* myP = sP + w * 32 * 40;
    bf16_t* myQ = sQ + w * 32 * 64;
    const int tband0 = blk * 128 - 128;
    for (int i = tid; i < 2048; i += NTHREADS) {
        const int kb = i >> 3, f = i & 7, t = tband0 + kb;
        float c = 1.f, s = 0.f;
        if (t >= 0) { const float ang = (float)positions[b * SEQ + t] * p.inv_freq[f]; const double rev = (double)ang * 0.15915494309189535; const float fr = (float)(rev - floor(rev));
            c = __builtin_amdgcn_cosf(fr); s = __builtin_amdgcn_sinf(fr); }
        cs[i] = c; sn[i] = s;
    }
    __syncthreads();
    float* otmp = p.out + (size_t)16 * 1024 * 1024;
#pragma unroll 1
    for (int g = 0; g < 2; ++g) {
        {
            const int key = tid >> 1, half = tid & 1, t = tband0 + key;
            u32x4 kv[4], vv[4];
#pragma unroll
            for (int q = 0; q < 4; ++q) { kv[q] = (u32x4){0u, 0u, 0u, 0u}; vv[q] = (u32x4){0u, 0u, 0u, 0u}; }
            if (t >= 0) {
                const bf16_t* kp = proj + (size_t)(b * SEQ + t) * NPROJ + C_K + g * 64 + half * 32;
                const bf16_t* vp = proj + (size_t)(b * SEQ + t) * NPROJ + C_V + g * 64 + half * 32;
#pragma unroll
                for (int q = 0; q < 4; ++q) { kv[q] = *(const u32x4*)(kp + 8 * q); vv[q] = *(const u32x4*)(vp + 8 * q); }
            }
            if (half == 0) {
                float x1[8], x2[8];
                x1[0] = bflo(kv[0].x); x1[1] = bfhi(kv[0].x); x1[2] = bflo(kv[0].y); x1[3] = bfhi(kv[0].y); x1[4] = bflo(kv[0].z); x1[5] = bfhi(kv[0].z); x1[6] = bflo(kv[0].w); x1[7] = bfhi(kv[0].w);
                x2[0] = bflo(kv[1].x); x2[1] = bfhi(kv[1].x); x2[2] = bflo(kv[1].y); x2[3] = bfhi(kv[1].y); x2[4] = bflo(kv[1].z); x2[5] = bfhi(kv[1].z); x2[6] = bflo(kv[1].w); x2[7] = bfhi(kv[1].w);
                float o1[8], o2[8];
#pragma unroll
                for (int f = 0; f < 8; ++f) { const float c = cs[key * 8 + f], s = sn[key * 8 + f]; o1[f] = x1[f] * c - x2[f] * s; o2[f] = x2[f] * c + x1[f] * s; }
                kv[0] = (u32x4){pk2(o1[0], o1[1]), pk2(o1[2], o1[3]), pk2(o1[4], o1[5]), pk2(o1[6], o1[7])};
                kv[1] = (u32x4){pk2(o2[0], o2[1]), pk2(o2[2], o2[3]), pk2(o2[4], o2[5]), pk2(o2[6], o2[7])};
            }
#pragma unroll
            for (int q = 0; q < 4; ++q) *(u32x4*)(sK + key * 72 + half * 32 + 8 * q) = kv[q];
#pragma unroll
            for (int q = 0; q < 4; ++q) {
                const int d0 = half * 32 + 8 * q;
                sVT[(d0 + 0) * 264 + key] = (bf16_t)(vv[q].x & 0xffffu); sVT[(d0 + 1) * 264 + key] = (bf16_t)(vv[q].x >> 16);
                sVT[(d0 + 2) * 264 + key] = (bf16_t)(vv[q].y & 0xffffu); sVT[(d0 + 3) * 264 + key] = (bf16_t)(vv[q].y >> 16);
                sVT[(d0 + 4) * 264 + key] = (bf16_t)(vv[q].z & 0xffffu); sVT[(d0 + 5) * 264 + key] = (bf16_t)(vv[q].z >> 16);
                sVT[(d0 + 6) * 264 + key] = (bf16_t)(vv[q].w & 0xffffu); sVT[(d0 + 7) * 264 + key] = (bf16_t)(vv[q].w >> 16);
            }
        }
        __syncthreads();
#pragma unroll 1
        for (int uu = 0; uu < 2; ++uu) {
            const int u = w + 8 * uu, hq = g * 4 + (u >> 2), rg = u & 3, r0 = rg * 32;
            {
                const int qr = lane >> 1, half = lane & 1, t = blk * 128 + r0 + qr;
                const bf16_t* qp = proj + (size_t)(b * SEQ + t) * NPROJ + hq * 64 + half * 32;
                u32x4 qv[4];
#pragma unroll
                for (int q = 0; q < 4; ++q) qv[q] = *(const u32x4*)(qp + 8 * q);
                if (half == 0) {
                    float x1[8], x2[8];
                    x1[0] = bflo(qv[0].x); x1[1] = bfhi(qv[0].x); x1[2] = bflo(qv[0].y); x1[3] = bfhi(qv[0].y); x1[4] = bflo(qv[0].z); x1[5] = bfhi(qv[0].z); x1[6] = bflo(qv[0].w); x1[7] = bfhi(qv[0].w);
                    x2[0] = bflo(qv[1].x); x2[1] = bfhi(qv[1].x); x2[2] = bflo(qv[1].y); x2[3] = bfhi(qv[1].y); x2[4] = bflo(qv[1].z); x2[5] = bfhi(qv[1].z); x2[6] = bflo(qv[1].w); x2[7] = bfhi(qv[1].w);
                    float o1[8], o2[8];
                    const int kb = 128 + r0 + qr;
#pragma unroll
                    for (int f = 0; f < 8; ++f) { const float c = cs[kb * 8 + f], s = sn[kb * 8 + f]; o1[f] = x1[f] * c - x2[f] * s; o2[f] = x2[f] * c + x1[f] * s; }
                    qv[0] = (u32x4){pk2(o1[0], o1[1]), pk2(o1[2], o1[3]), pk2(o1[4], o1[5]), pk2(o1[6], o1[7])};
                    qv[1] = (u32x4){pk2(o2[0], o2[1]), pk2(o2[2], o2[3]), pk2(o2[4], o2[5]), pk2(o2[6], o2[7])};
                }
#pragma unroll
                for (int q = 0; q < 4; ++q) *(u32x4*)(myQ + qr * 64 + half * 32 + 8 * q) = qv[q];
            }
            LDS_WAIT();
            f32x16 S[5];
#pragma unroll
            for (int jt = 0; jt < 5; ++jt) S[jt] = zero16();
#pragma unroll
            for (int kk = 0; kk < 64; kk += 16) {
                const bf16x8 a = *(const bf16x8*)(myQ + r * 64 + kk + 8 * h);
#pragma unroll
                for (int jt = 0; jt < 5; ++jt) { const bf16x8 bb = *(const bf16x8*)(sK + ((rg + jt) * 32 + r) * 72 + kk + 8 * h); S[jt] = mfma32(a, bb, S[jt]); }
            }
            const float sink = p.in[5][hq];
            float sm[16];
#pragma unroll
            for (int i = 0; i < 16; ++i) {
                const int qb = 128 + r0 + crow(i, h);
                float m = -INFINITY;
#pragma unroll
                for (int jt = 0; jt < 5; ++jt) { const int kbx = (rg + jt) * 32 + r; const int rel = qb - kbx; const bool ok = (rel >= 0) && (rel < 128) && (tband0 + kbx >= 0);
                    const float v = ok ? S[jt][i] * 0.125f : -INFINITY; S[jt][i] = v; m = fmaxf(m, v); }
#pragma unroll
                for (int o = 16; o >= 1; o >>= 1) m = fmaxf(m, __shfl_xor(m, o));
                m = fmaxf(m, sink);
                float s = 0.f;
#pragma unroll
                for (int jt = 0; jt < 5; ++jt) { const float e = __expf(S[jt][i] - m); S[jt][i] = e; s += e; }
#pragma unroll
                for (int o = 16; o >= 1; o >>= 1) s += __shfl_xor(s, o);
                sm[i] = s + __expf(sink - m);
            }
            f32x16 O0 = zero16(), O1 = zero16();
#pragma unroll
            for (int jt = 0; jt < 5; ++jt) {
#pragma unroll
                for (int i = 0; i < 16; ++i) myP[crow(i, h) * 40 + r] = (bf16_t)f2bf(S[jt][i]);
                LDS_WAIT();
#pragma unroll
                for (int kk = 0; kk < 32; kk += 16) {
                    const bf16x8 a = *(const bf16x8*)(myP + r * 40 + kk + 8 * h);
                    const bf16x8 b0 = *(const bf16x8*)(sVT + r * 264 + (rg + jt) * 32 + kk + 8 * h);
                    const bf16x8 b1 = *(const bf16x8*)(sVT + (32 + r) * 264 + (rg + jt) * 32 + kk + 8 * h);
                    O0 = mfma32(a, b0, O0); O1 = mfma32(a, b1, O1);
                }
                LDS_WAIT();
            }
            int qlb = r0 + 4 * h;
            asm volatile("" : "+v"(qlb));
            float* opb = otmp + (size_t)(b * SEQ + blk * 128 + qlb) * 512 + hq * 64 + r;
#pragma unroll
            for (int i = 0; i < 16; ++i) {
                const int dl = (i & 3) + 8 * (i >> 2);
                const int ql = qlb + dl;
                const float inv = 1.f / sm[i];
                const float v0 = O0[i] * inv, v1 = O1[i] * inv;
                opb[dl * 512] = v0; opb[dl * 512 + 32] = v1;
                float q = v0 * v0 + v1 * v1;
#pragma unroll
                for (int o = 16; o >= 1; o >>= 1) q += __shfl_xor(q, o);
                if (r == 0) ssq[ql * 8 + hq] = q;
            }
        }
        __syncthreads();
    }
    {
        bf16_t* A2 = (bf16_t*)(p.ws + WS_A2);
        const float* wa = p.in[11];
        for (int i = tid; i < 128 * 64; i += NTHREADS) {
            const int ql = i >> 6, c8 = (i & 63) * 8;
            float s = 0.f;
#pragma unroll
            for (int q = 0; q < 8; ++q) s += ssq[ql * 8 + q];
            const float rstd = 1.f / sqrtf(s * (1.f / 512.f) + EPS);
            const size_t row = (size_t)b * SEQ + blk * 128 + ql;
            const f32x4 a = *(const f32x4*)(otmp + row * 512 + c8), bq = *(const f32x4*)(otmp + row * 512 + c8 + 4);
            const f32x4 w0 = *(const f32x4*)(wa + c8), w1 = *(const f32x4*)(wa + c8 + 4);
            u32x4 o; o.x = pk2(a.x * rstd * w0.x, a.y * rstd * w0.y); o.y = pk2(a.z * rstd * w0.z, a.w * rstd * w0.w); o.z = pk2(bq.x * rstd * w1.x, bq.y * rstd * w1.y); o.w = pk2(bq.z * rstd * w1.z, bq.w * rstd * w1.w);
            *(u32x4*)(A2 + row * 1024 + c8) = o;
        }
    }
    __syncthreads();
}

__device__ __forceinline__ void phase2_states(const Params& p, unsigned char* lds, int b, int c) {
    const int tid = opaque_tid(), lane = tid & 63, w = tid >> 6, r = lane & 31, h = lane >> 5;
    float* dts = (float*)lds;
    float* cums = dts + 1024;
    bf16_t* sBT = (bf16_t*)(lds + 8192);
    bf16_t* sXT = sBT + 128 * 136;
    ssd_dt_cum(p, b, c, dts, cums);
    __syncthreads();
    float* states = (float*)(p.ws + WS_STATES);
    if (tid < 8) ((float*)(p.ws + WS_CDEC))[(b * NCH + c) * 8 + tid] = __expf(cums[tid * 128 + 127]);
#pragma unroll 1
    for (int g = 0; g < 2; ++g) {
        if (tid < 256) {
            const int cg8 = tid & 15, lr = tid >> 4;
            const float one[8] = {1.f, 1.f, 1.f, 1.f, 1.f, 1.f, 1.f, 1.f};
            u32x4 res[8];
            conv8x8<true>(p, b, c, lr * 8, 512 + g * 128 + cg8 * 8, one, res);
#pragma unroll
            for (int ci = 0; ci < 8; ++ci) *(u32x4*)(sBT + (cg8 * 8 + ci) * 136 + lr * 8) = res[ci];
        }
        {
            const int cg8 = tid & 31, lr = tid >> 5, hh = cg8 >> 3, hd = g * 4 + hh;
            float f[8];
            const float cl = cums[hd * 128 + 127];
#pragma unroll
            for (int li = 0; li < 8; ++li) f[li] = dts[hd * 128 + lr * 8 + li] * __expf(cl - cums[hd * 128 + lr * 8 + li]);
            u32x4 res[8];
            conv8x8<true>(p, b, c, lr * 8, g * 256 + cg8 * 8, f, res);
#pragma unroll
            for (int ci = 0; ci < 8; ++ci) *(u32x4*)(sXT + (cg8 * 8 + ci) * 136 + lr * 8) = res[ci];
        }
        __syncthreads();
        {
            f32x16 acc[4];
#pragma unroll
            for (int j = 0; j < 4; ++j) acc[j] = zero16();
#pragma unroll
            for (int kk = 0; kk < 128; kk += 16) {
                const bf16x8 a = *(const bf16x8*)(sXT + (w * 32 + r) * 136 + kk + 8 * h);
#pragma unroll
                for (int j = 0; j < 4; ++j) { const bf16x8 bb = *(const bf16x8*)(sBT + (j * 32 + r) * 136 + kk + 8 * h); acc[j] = mfma32(a, bb, acc[j]); }
            }
            const int hd = g * 4 + (w >> 1), p0 = (w & 1) * 32;
            float* sp = states + ((size_t)((b * NCH + c) * 8 + hd) * 64) * 128;
#pragma unroll
            for (int j = 0; j < 4; ++j)
#pragma unroll
                for (int i = 0; i < 16; ++i) sp[(size_t)(p0 + crow(i, h)) * 128 + j * 32 + r] = acc[j][i];
        }
        __syncthreads();
    }
}

__device__ __forceinline__ void phase3(const Params& p) {
    const float* states = (const float*)(p.ws + WS_STATES);
    const float* cdec = (const float*)(p.ws + WS_CDEC);
    bf16_t* start = (bf16_t*)(p.ws + WS_START);
    for (int u = blockIdx.x * NTHREADS + threadIdx.x; u < 131072; u += gridDim.x * NTHREADS) {
        const int n4 = u & 31, pp = (u >> 5) & 63, hd = (u >> 11) & 7, b = u >> 14;
        f32x4 s = (f32x4){0.f, 0.f, 0.f, 0.f};
        for (int c = 0; c < NCH; ++c) {
            const size_t off = ((size_t)((b * NCH + c) * 8 + hd) * 64 + pp) * 128 + n4 * 4;
            u32x2 o; o.x = pk2(s.x, s.y); o.y = pk2(s.z, s.w);
            *(u32x2*)(start + off) = o;
            const f32x4 st = *(const f32x4*)(states + off);
            const float d = cdec[(b * NCH + c) * 8 + hd];
            s = s * d + st;
        }
    }
}

__device__ __forceinline__ void phase4(const Params& p, unsigned char* lds, int b, int c) {
    const int tid = opaque_tid(), lane = tid & 63, w = tid >> 6, r = lane & 31, h = lane >> 5;
    float* dts = (float*)lds;
    float* cums = dts + 1024;
    float* gsq = cums + 1024;
    bf16_t* sC = (bf16_t*)(lds + 12288);
    bf16_t* sB = sC + 128 * 136;
    bf16_t* sM = sB + 128 * 136;
    bf16_t* sXT = sM + 128 * 136;
    const bf16_t* proj = (const bf16_t*)(p.ws + WS_PROJ);
    const bf16_t* start = (const bf16_t*)(p.ws + WS_START);
    float* gtmp = p.out;
    bf16_t* A2 = (bf16_t*)(p.ws + WS_A2);
    ssd_dt_cum(p, b, c, dts, cums);
    __syncthreads();
    const size_t row0 = (size_t)b * SEQ + c * 128;
#pragma unroll 1
    for (int g = 0; g < 2; ++g) {
        {
            const int which = tid >> 8, cg8 = tid & 15, lr = (tid >> 4) & 15;
            const float one[8] = {1.f, 1.f, 1.f, 1.f, 1.f, 1.f, 1.f, 1.f};
            u32x4 res[8];
            conv8x8<false>(p, b, c, lr * 8, (which ? 768 : 512) + g * 128 + cg8 * 8, one, res);
            bf16_t* dst = which ? sC : sB;
#pragma unroll
            for (int li = 0; li < 8; ++li) *(u32x4*)(dst + (lr * 8 + li) * 136 + cg8 * 8) = res[li];
        }
        __syncthreads();
        f32x16 cb0 = zero16(), cb1 = zero16();
        const int lt = w >> 1, st0 = 2 * (w & 1);
#pragma unroll 2
        for (int kk = 0; kk < 128; kk += 16) {
            const bf16x8 a = *(const bf16x8*)(sC + (lt * 32 + r) * 136 + kk + 8 * h);
            const bf16x8 b0 = *(const bf16x8*)(sB + (st0 * 32 + r) * 136 + kk + 8 * h);
            const bf16x8 b1 = *(const bf16x8*)(sB + ((st0 + 1) * 32 + r) * 136 + kk + 8 * h);
            cb0 = mfma32(a, b0, cb0); cb1 = mfma32(a, b1, cb1);
        }
#pragma unroll 1
        for (int hh = 0; hh < 4; ++hh) {
            const int hd = g * 4 + hh;
#pragma unroll
            for (int i = 0; i < 16; ++i) {
                const int l = lt * 32 + crow(i, h);
                const float cl = cums[hd * 128 + l];
                { const int s = st0 * 32 + r; const float v = (s <= l) ? cb0[i] * __expf(cl - cums[hd * 128 + s]) * dts[hd * 128 + s] : 0.f; sM[l * 136 + s] = (bf16_t)f2bf(v); }
                { const int s = (st0 + 1) * 32 + r; const float v = (s <= l) ? cb1[i] * __expf(cl - cums[hd * 128 + s]) * dts[hd * 128 + s] : 0.f; sM[l * 136 + s] = (bf16_t)f2bf(v); }
            }
            __builtin_amdgcn_sched_barrier(0);
            {
                const int cp = tid & 31, lr = tid >> 5;
                u32x4 res[2];
                conv2x8T(p, b, c, lr * 8, hd * 64 + cp * 2, res);
                *(u32x4*)(sXT + (cp * 2) * 136 + lr * 8) = res[0];
                *(u32x4*)(sXT + (cp * 2 + 1) * 136 + lr * 8) = res[1];
            }
            __syncthreads();
            {
                const int lt2 = w >> 1, pt = w & 1;
                f32x16 yd = zero16(), yo = zero16();
#pragma unroll 2
                for (int kk = 0; kk < 128; kk += 16) {
                    const bf16x8 a = *(const bf16x8*)(sM + (lt2 * 32 + r) * 136 + kk + 8 * h);
                    const bf16x8 bb = *(const bf16x8*)(sXT + (pt * 32 + r) * 136 + kk + 8 * h);
                    yd = mfma32(a, bb, yd);
                }
                const bf16_t* stp = start + ((size_t)((b * NCH + c) * 8 + hd) * 64 + pt * 32 + r) * 128;
#pragma unroll 2
                for (int kk = 0; kk < 128; kk += 16) {
                    const bf16x8 a = *(const bf16x8*)(sC + (lt2 * 32 + r) * 136 + kk + 8 * h);
                    const bf16x8 bb = *(const bf16x8*)(stp + kk + 8 * h);
                    yo = mfma32(a, bb, yo);
                }
                const float dsk = p.in[10][hd];
                const int pcol = pt * 32 + r;
                int lb = lt2 * 32 + 4 * h;
                asm volatile("" : "+v"(lb));
                const bf16_t* zp = proj + (row0 + lb) * NPROJ + C_Z + hd * 64 + pcol;
                float* gp = gtmp + (row0 + lb) * 512 + hd * 64 + pcol;
#pragma unroll
                for (int i = 0; i < 16; ++i) {
                    const int dl = (i & 3) + 8 * (i >> 2);
                    const int l = lb + dl;
                    const float xs = bf2f((unsigned)sXT[pcol * 136 + l]);
                    const float y = yd[i] + __expf(cums[hd * 128 + l]) * yo[i] + dsk * xs;
                    const float z = bf2f((unsigned)zp[(size_t)dl * NPROJ]);
                    const float gv = y * siluf(z);
                    gp[dl * 512] = gv;
                    float q = gv * gv;
#pragma unroll
                    for (int o = 16; o >= 1; o >>= 1) q += __shfl_xor(q, o);
                    if (r == 0) gsq[l * 8 + hh * 2 + pt] = q;
                }
            }
            __syncthreads();
        }
        {
            const float* wsn = p.in[12];
            for (int i = tid; i < 128 * 32; i += NTHREADS) {
                const int l = i >> 5, c8 = (i & 31) * 8;
                float s = 0.f;
#pragma unroll
                for (int q = 0; q < 8; ++q) s += gsq[l * 8 + q];
                const float rstd = 1.f / sqrtf(s * (1.f / 256.f) + EPS);
                const f32x4 a = *(const f32x4*)(gtmp + (row0 + l) * 512 + g * 256 + c8), bq = *(const f32x4*)(gtmp + (row0 + l) * 512 + g * 256 + c8 + 4);
                const f32x4 w0 = *(const f32x4*)(wsn + g * 256 + c8), w1 = *(const f32x4*)(wsn + g * 256 + c8 + 4);
                u32x4 o; o.x = pk2(a.x * rstd * w0.x, a.y * rstd * w0.y); o.y = pk2(a.z * rstd * w0.z, a.w * rstd * w0.w); o.z = pk2(bq.x * rstd * w1.x, bq.y * rstd * w1.y); o.w = pk2(bq.z * rstd * w1.z, bq.w * rstd * w1.w);
                *(u32x4*)(A2 + (row0 + l) * 1024 + 512 + g * 256 + c8) = o;
            }
        }
        __syncthreads();
    }
}

__device__ __forceinline__ void phase5(const Params& p, unsigned char* lds) {
    unsigned char* ws = p.ws;
    pg8::Gemm g{(const bf16_t*)(ws + WS_A2), (const bf16_t*)(ws + WS_WOUT), NT, DM, DM};
    pg8::StaticOrder S; S.init(NT, DM, (int)gridDim.x, (int)blockIdx.x);
    pg8::EpiResid<true> E{p.in[0], (float*)(ws + WS_X1), (bf16_t*)(ws + WS_XB), (float*)(ws + WS_SSQ)};
    pg8::gemm_phase<pg8::EpiResid<true>, pg8::StaticOrder, true, true>(LDS3(lds), g, S, E);
}
__device__ __forceinline__ void phase6(const Params& p, unsigned char* lds) {
    unsigned char* ws = p.ws;
    pg8::Gemm g{(const bf16_t*)(ws + WS_XB), (const bf16_t*)(ws + WS_WQ), NT, 512, DM};
    pg8::StaticOrder S; S.init(NT, 512, (int)gridDim.x, (int)blockIdx.x);
    pg8::EpiQ E{(bf16_t*)(ws + WS_Q2), (const float*)(ws + WS_SSQ)};
    pg8::gemm_phase<pg8::EpiQ, pg8::StaticOrder, true, true>(LDS3(lds), g, S, E);
}
__device__ __forceinline__ void phase8(const Params& p, unsigned char* lds) {
    unsigned char* ws = p.ws;
    pg8::Gemm g{(const bf16_t*)(ws + WS_XO), (const bf16_t*)(ws + WS_WO), NT, DM, 512};
    pg8::StaticOrder S; S.init(NT, DM, (int)gridDim.x, (int)blockIdx.x);
    pg8::EpiResid<false> E{(const float*)(ws + WS_X1), (float*)(ws + WS_X1), nullptr, nullptr};
    pg8::gemm_phase<pg8::EpiResid<false>, pg8::StaticOrder, true, true>(LDS3(lds), g, S, E);
}

__device__ __forceinline__ void phase7(const Params& p, unsigned char* lds) {
    const int tid = opaque_tid(), lane = tid & 63, w = tid >> 6, r = lane & 31, h = lane >> 5;
    const bf16_t* q2 = (const bf16_t*)(p.ws + WS_Q2); const bf16_t* kmem = (const bf16_t*)(p.ws + WS_KMEM); const bf16_t* vmemT = (const bf16_t*)(p.ws + WS_VMEMT);
    bf16_t* xo = (bf16_t*)(p.ws + WS_XO);
    bf16_t* myP = (bf16_t*)lds + w * 32 * 264;
    const float scale = 0.08838834764831845f;
    for (int it = blockIdx.x; it < 512; it += gridDim.x) {
        const int rb = it >> 2, hx = it & 3, b = rb >> 4;
        const size_t row0 = (size_t)rb * 256 + w * 32;
        f32x16 S[8];
#pragma unroll
        for (int j = 0; j < 8; ++j) S[j] = zero16();
        const bf16_t* qp = q2 + (row0 + r) * 512 + hx * 128 + 8 * h;
        const bf16_t* kp = kmem + ((size_t)b * 256 + r) * 512 + hx * 128 + 8 * h;
#pragma unroll
        for (int kk = 0; kk < 128; kk += 16) {
            const bf16x8 a = *(const bf16x8*)(qp + kk);
#pragma unroll
            for (int j = 0; j < 8; ++j) { const bf16x8 bb = *(const bf16x8*)(kp + (size_t)j * 32 * 512 + kk); S[j] = mfma32(a, bb, S[j]); }
        }
        float inv[16];
#pragma unroll
        for (int i = 0; i < 16; ++i) {
            float m = -INFINITY;
#pragma unroll
            for (int j = 0; j < 8; ++j) { const float v = S[j][i] * scale; S[j][i] = v; m = fmaxf(m, v); }
#pragma unroll
            for (int o = 16; o >= 1; o >>= 1) m = fmaxf(m, __shfl_xor(m, o));
            float s = 0.f;
#pragma unroll
            for (int j = 0; j < 8; ++j) { const float e = __expf(S[j][i] - m); S[j][i] = e; s += e; }
#pragma unroll
            for (int o = 16; o >= 1; o >>= 1) s += __shfl_xor(s, o);
            inv[i] = 1.f / s;
        }
#pragma unroll
        for (int j = 0; j < 8; ++j)
#pragma unroll
            for (int i = 0; i < 16; ++i) myP[crow(i, h) * 264 + j * 32 + r] = (bf16_t)f2bf(S[j][i]);
        LDS_WAIT();
        f32x16 O[4];
#pragma unroll
        for (int j = 0; j < 4; ++j) O[j] = zero16();
        const bf16_t* vp = vmemT + (((size_t)b * 4 + hx) * 128 + r) * 256 + 8 * h;
#pragma unroll
        for (int kk = 0; kk < 256; kk += 16) {
            const bf16x8 a = *(const bf16x8*)(myP + r * 264 + kk + 8 * h);
#pragma unroll
            for (int j = 0; j < 4; ++j) { const bf16x8 bb = *(const bf16x8*)(vp + (size_t)j * 32 * 256 + kk); O[j] = mfma32(a, bb, O[j]); }
        }
#pragma unroll
        for (int j = 0; j < 4; ++j)
#pragma unroll
            for (int i = 0; i < 16; ++i) xo[(row0 + crow(i, h)) * 512 + hx * 128 + j * 32 + r] = (bf16_t)f2bf(O[j][i] * inv[i]);
        LDS_WAIT();
    }
}

__device__ __forceinline__ void phase9(const Params& p) {
    const int tid = opaque_tid(), lane = tid & 63, w = tid >> 6;
    const int gw = blockIdx.x * NWAVES + w, NGW = gridDim.x * NWAVES;
    const float* x2 = (const float*)(p.ws + WS_X1);
    const float* WR = (const float*)(p.ws + WS_WR);
    int* cnt = (int*)(p.ws + WS_CTL);
    int* list = (int*)(p.ws + WS_LIST);
    float* route = (float*)(p.ws + WS_ROUTE);
    const float* bg = p.in[21]; const float* be = p.in[23];
    for (int m = gw; m < NT; m += NGW) {
        const f32x4* xr = (const f32x4*)(x2 + (size_t)m * DM) + lane;
        f32x4 v[4]; float s = 0.f;
#pragma unroll
        for (int j = 0; j < 4; ++j) { v[j] = xr[64 * j]; s += (v[j].x * v[j].x + v[j].y * v[j].y) + (v[j].z * v[j].z + v[j].w * v[j].w); }
        const float rstd = 1.f / sqrtf(wave_sum(s) * (1.f / DM) + EPS);
        float mine = 0.f;
#pragma unroll 4
        for (int n = 0; n < 36; ++n) {
            float a = 0.f;
#pragma unroll
            for (int j = 0; j < 4; ++j) { const f32x4 ww = *(const f32x4*)(WR + n * 1024 + 4 * lane + 256 * j); a += (v[j].x * ww.x + v[j].y * ww.y) + (v[j].z * ww.z + v[j].w * ww.w); }
            a = wave_sum(a) * rstd;
            if (lane == n) mine = a;
        }
        if (lane < 4) mine += bg[lane]; else if (lane < 36) mine += be[lane - 4];
        const float g0 = __shfl(mine, 0), g1 = __shfl(mine, 1), g2 = __shfl(mine, 2), g3 = __shfl(mine, 3);
        int gi = 0; float gm = g0;
        if (g1 > gm) { gm = g1; gi = 1; }
        if (g2 > gm) { gm = g2; gi = 2; }
        if (g3 > gm) { gm = g3; gi = 3; }
        const float gden = __expf(g0 - gm) + __expf(g1 - gm) + __expf(g2 - gm) + __expf(g3 - gm);
        const float ggate = 1.f / gden;
        float ev[8];
#pragma unroll
        for (int j = 0; j < 8; ++j) ev[j] = __shfl(mine, 4 + gi * 8 + j);
        int i1 = 0; float v1 = ev[0];
#pragma unroll
        for (int j = 1; j < 8; ++j) if (ev[j] > v1) { v1 = ev[j]; i1 = j; }
        int i2 = -1; float v2 = -INFINITY;
#pragma unroll
        for (int j = 0; j < 8; ++j) if (j != i1 && ev[j] > v2) { v2 = ev[j]; i2 = j; }
        const float e2 = __expf(v2 - v1);
        const float w1 = ggate / (1.f + e2), w2 = ggate * e2 / (1.f + e2);
        if (lane == 0) {
            const int ea = gi * 8 + i1, eb = gi * 8 + i2;
            const int pa = atomicAdd(cnt + ea, 1), pb = atomicAdd(cnt + eb, 1);
            list[ea * NT + pa] = m; list[eb * NT + pb] = m;
            int* ri = (int*)(route + (size_t)m * 8);
            ri[0] = ea; ri[1] = eb; ri[2] = pa; ri[3] = pb;
            route[(size_t)m * 8 + 4] = w1; route[(size_t)m * 8 + 5] = w2; route[(size_t)m * 8 + 6] = rstd; route[(size_t)m * 8 + 7] = 0.f;
        }
    }
}

__device__ __forceinline__ int* moe_tables(const Params& p, unsigned char* lds) {
    int* off = (int*)(lds + 131072);
    const int* cnt = (const int*)(p.ws + WS_CTL);
    if (threadIdx.x == 0) { int a = 0; for (int e = 0; e < NEXP; ++e) { off[e] = a; a += ((cnt[e] + 255) >> 8) << 8; } off[NEXP] = a; }
    if (threadIdx.x < NEXP) off[40 + threadIdx.x] = cnt[threadIdx.x];
    __syncthreads();
    const int nrt = off[NEXP] >> 8;
    for (int rt = threadIdx.x; rt < nrt; rt += NTHREADS) { int e = 0; for (int q = 1; q < NEXP; ++q) if (off[q] <= rt * 256) e = q; off[128 + rt] = e; }
    __syncthreads();
    return off;
}

__device__ __forceinline__ void phase10(const Params& p, unsigned char* lds) {
    const int tid = opaque_tid(), lane = tid & 63, w = tid >> 6;
    const int* off = moe_tables(p, lds);
    const int gw = blockIdx.x * NWAVES + w, NGW = gridDim.x * NWAVES;
    const float* x2 = (const float*)(p.ws + WS_X1); const float* route = (const float*)(p.ws + WS_ROUTE);
    bf16_t* xg = (bf16_t*)(p.ws + WS_XG);
    for (int m = gw; m < NT; m += NGW) {
        const int* ri = (const int*)(route + (size_t)m * 8);
        const int ea = ri[0], eb = ri[1], pa = ri[2], pb = ri[3];
        const float rs = route[(size_t)m * 8 + 6];
        const size_t sa = (size_t)off[ea] + pa, sb = (size_t)off[eb] + pb;
        const f32x4* xr = (const f32x4*)(x2 + (size_t)m * DM) + lane;
        u32x2* oa = (u32x2*)(xg + sa * DM) + lane; u32x2* ob = (u32x2*)(xg + sb * DM) + lane;
#pragma unroll
        for (int j = 0; j < 4; ++j) { const f32x4 v = xr[64 * j]; u32x2 o; o.x = pk2(v.x * rs, v.y * rs); o.y = pk2(v.z * rs, v.w * rs); oa[64 * j] = o; ob[64 * j] = o; }
    }
}

__device__ __forceinline__ void phase11(const Params& p, unsigned char* lds) {
    const int* off = moe_tables(p, lds);
    pg8::Gemm g{(const bf16_t*)(p.ws + WS_XG), (const bf16_t*)(p.ws + WS_WGU), 0, 0, DM};
    pg8::MoeOrder S{(const __attribute__((address_space(3))) int*)(off + 128), off[NEXP] >> 8, 2, (int)gridDim.x, (int)blockIdx.x};
    pg8::EpiGU E{(bf16_t*)(p.ws + WS_HID)};
    pg8::gemm_phase<pg8::EpiGU, pg8::MoeOrder, true, true>(LDS3(lds), g, S, E);
}
__device__ __forceinline__ void phase12(const Params& p, unsigned char* lds) {
    const int* off = moe_tables(p, lds);
    int kdim = EFF; asm volatile("" : "+s"(kdim));
    pg8::Gemm g{(const bf16_t*)(p.ws + WS_HID), (const bf16_t*)(p.ws + WS_WD), 0, 0, kdim};
    pg8::MoeOrder S{(const __attribute__((address_space(3))) int*)(off + 128), off[NEXP] >> 8, 4, (int)gridDim.x, (int)blockIdx.x};
    pg8::EpiBf16 E{(bf16_t*)(p.ws + WS_Y), DM, 4};
    pg8::gemm_phase<pg8::EpiBf16, pg8::MoeOrder, true, true>(LDS3(lds), g, S, E);
}

__device__ __forceinline__ void phase13(const Params& p, unsigned char* lds) {
    const int tid = opaque_tid(), lane = tid & 63, w = tid >> 6;
    const int* off = moe_tables(p, lds);
    const int gw = blockIdx.x * NWAVES + w, NGW = gridDim.x * NWAVES;
    const float* x2 = (const float*)(p.ws + WS_X1); const bf16_t* yb = (const bf16_t*)(p.ws + WS_Y);
    const float* route = (const float*)(p.ws + WS_ROUTE); const float* wf = p.in[27];
    f32x4 wv[4];
#pragma unroll
    for (int j = 0; j < 4; ++j) wv[j] = *(const f32x4*)(wf + 4 * lane + 256 * j);
    for (int m = gw; m < NT; m += NGW) {
        const int* ri = (const int*)(route + (size_t)m * 8);
        const int ea = ri[0], eb = ri[1], pa = ri[2], pb = ri[3];
        const float w1 = route[(size_t)m * 8 + 4], w2 = route[(size_t)m * 8 + 5];
        const size_t sa = (size_t)off[ea] + pa, sb = (size_t)off[eb] + pb;
        const f32x4* xr = (const f32x4*)(x2 + (size_t)m * DM) + lane;
        const u32x2* ya = (const u32x2*)(yb + sa * DM) + lane; const u32x2* ybp = (const u32x2*)(yb + sb * DM) + lane;
        f32x4 v[4]; float s = 0.f;
#pragma unroll
        for (int j = 0; j < 4; ++j) {
            v[j] = xr[64 * j]; const u32x2 a = ya[64 * j], bq = ybp[64 * j];
            v[j].x += w1 * bflo(a.x) + w2 * bflo(bq.x); v[j].y += w1 * bfhi(a.x) + w2 * bfhi(bq.x);
            v[j].z += w1 * bflo(a.y) + w2 * bflo(bq.y); v[j].w += w1 * bfhi(a.y) + w2 * bfhi(bq.y);
            s += (v[j].x * v[j].x + v[j].y * v[j].y) + (v[j].z * v[j].z + v[j].w * v[j].w);
        }
        const float rstd = 1.f / sqrtf(wave_sum(s) * (1.f / DM) + EPS);
        f32x4* o = (f32x4*)(p.out + (size_t)m * DM) + lane;
#pragma unroll
        for (int j = 0; j < 4; ++j) o[64 * j] = v[j] * rstd * wv[j];
    }
}

constexpr int NPHASE = 14;
__global__ void __launch_bounds__(NTHREADS, 2) fwd_kernel(Params p) {
    extern __shared__ __attribute__((aligned(16))) unsigned char lds[];
#if MK_ONE_LAUNCH
    cg::grid_group grid = cg::this_grid();
#define SEAM(k) do { if (p.ph_lo <= (k) && (k) + 1 < p.ph_hi) grid.sync(); } while (0)
#else
#define SEAM(k) do { } while (0)
#endif
#define IN(k) (p.ph_lo <= (k) && (k) < p.ph_hi)
    if (IN(0)) { phase0(p, lds); } SEAM(0);
    if (IN(1)) { phase1(p, lds); } SEAM(1);
    if (IN(2)) { for (int it = blockIdx.x; it < NB * NCH; it += gridDim.x) { const int b = it / NCH, c = it % NCH; phase2_attn(p, lds, b, c); phase2_states(p, lds, b, c); } } SEAM(2);
    if (IN(3)) { phase3(p); } SEAM(3);
    if (IN(4)) { for (int it = blockIdx.x; it < NB * NCH; it += gridDim.x) { const int b = it / NCH, c = it % NCH; phase4(p, lds, b, c); } } SEAM(4);
    if (IN(5)) { phase5(p, lds); } SEAM(5);
    if (IN(6)) { phase6(p, lds); } SEAM(6);
    if (IN(7)) { phase7(p, lds); } SEAM(7);
    if (IN(8)) { phase8(p, lds); } SEAM(8);
    if (IN(9)) { phase9(p); } SEAM(9);
    if (IN(10)) { phase10(p, lds); } SEAM(10);
    if (IN(11)) { phase11(p, lds); } SEAM(11);
    if (IN(12)) { phase12(p, lds); } SEAM(12);
    if (IN(13)) { phase13(p, lds); }
#undef IN
#undef SEAM
}

extern "C" void kernel_launch(void* const* d_in, const int* in_sizes, int n_in, void* d_out, int out_size, void* d_ws, size_t ws_size, hipStream_t stream) {
    static int grid = 0;
    if (grid == 0) {
        if (n_in != 28 || out_size != NT * DM || ws_size < WS_NEED) { fprintf(stderr, "kernel_launch: unexpected sizes n_in %d out %d ws %zu\n", n_in, out_size, ws_size); grid = -1; return; }
        int dev = 0, cus = 0, per_cu = 0;
        hipGetDevice(&dev);
        hipDeviceGetAttribute(&cus, hipDeviceAttributeMultiprocessorCount, dev);
        if (hipFuncSetAttribute((const void*)fwd_kernel, hipFuncAttributeMaxDynamicSharedMemorySize, LDS_BYTES) != hipSuccess) { fprintf(stderr, "kernel_launch: hipFuncSetAttribute failed\n"); grid = -1; return; }
        if (hipOccupancyMaxActiveBlocksPerMultiprocessor(&per_cu, (const void*)fwd_kernel, NTHREADS, LDS_BYTES) != hipSuccess || per_cu < 1) { fprintf(stderr, "kernel_launch: occupancy query says %d\n", per_cu); per_cu = 1; }
        (void)hipGetLastError();
        grid = cus;
    }
    if (grid < 0) return;
    Params prm{};
    for (int i = 0; i < 28; ++i) prm.in[i] = (const float*)d_in[i];
    prm.out = (float*)d_out; prm.ws = (unsigned char*)d_ws;
    for (int i = 0; i < 8; ++i) prm.inv_freq[i] = powf(500000.0f, -(float)(2 * i) / 16.0f);
#if MK_ONE_LAUNCH
    prm.ph_lo = 0; prm.ph_hi = NPHASE;
    void* args[] = {&prm};
    hipError_t e = hipLaunchCooperativeKernel((const void*)fwd_kernel, dim3(grid), dim3(NTHREADS), args, LDS_BYTES, stream);
    if (e != hipSuccess) fprintf(stderr, "cooperative launch failed: %s (grid %d)\n", hipGetErrorString(e), grid);
#else
    for (int ph = 0; ph < NPHASE; ++ph) {
        prm.ph_lo = ph; prm.ph_hi = ph + 1;
        hipLaunchKernelGGL(fwd_kernel, dim3(grid), dim3(NTHREADS), LDS_BYTES, stream, prm);
    }
#endif
}
```

```cpp
#include <hip/hip_runtime.h>
#include <hip/hip_cooperative_groups.h>
#include <cstdio>
#include <cmath>
namespace cg = cooperative_groups;

#ifndef MK_ONE_LAUNCH
#define MK_ONE_LAUNCH 1
#endif

typedef unsigned short bf16_t;
typedef short bf16x8 __attribute__((ext_vector_type(8)));
typedef float f32x4 __attribute__((ext_vector_type(4)));
typedef float f32x16 __attribute__((ext_vector_type(16)));
typedef unsigned u32x4 __attribute__((ext_vector_type(4)));
typedef unsigned u32x2 __attribute__((ext_vector_type(2)));

constexpr int NB = 8, SEQ = 4096, DM = 1024, NT = NB * SEQ;
constexpr int NPROJ = 2304, LDWIN = 2312;
constexpr int C_K = 512, C_V = 640, C_Z = 768, C_X = 1280, C_B = 1792, C_C = 2048;
constexpr int MEMT = 256, NMEM = NB * MEMT;
constexpr int NEXP = 32, EFF = 256;
constexpr int NCH = SEQ / 128;
constexpr float EPS = 1e-5f;
constexpr int NTHREADS = 512, NWAVES = 8;
constexpr int LDS_BYTES = 147456;

constexpr size_t MiB = (size_t)1 << 20;
constexpr size_t WS_CTL = 0, WS_BAR = 65536, CTL_ZERO_BYTES = 131072;
constexpr size_t WS_WIN = 1 * MiB, WS_WOUT = 6 * MiB, WS_WQ = 8 * MiB, WS_WKV = 9 * MiB, WS_WO = 11 * MiB, WS_WR = 12 * MiB;
constexpr size_t WS_WGU = 16 * MiB, WS_WD = 48 * MiB;
constexpr size_t WS_MEMH = 64 * MiB, WS_KMEM = 68 * MiB, WS_VMEMT = 70 * MiB, WS_DTRAW = 72 * MiB, WS_CDEC = 73 * MiB, WS_ROUTE = 74 * MiB;
constexpr size_t WS_LIST = 76 * MiB, WS_SSQ = 80 * MiB;
constexpr size_t WS_PROJ = 96 * MiB, WS_A2 = 240 * MiB, WS_STATES = 304 * MiB, WS_START = 368 * MiB;
constexpr size_t WS_X1 = 96 * MiB, WS_XB = 304 * MiB, WS_Q2 = 368 * MiB, WS_XO = 224 * MiB, WS_XG = 96 * MiB, WS_HID = 368 * MiB, WS_Y = 96 * MiB;
constexpr size_t WS_NEED = 512 * MiB;

struct Params {
    const float* in[28];
    float* out;
    unsigned char* ws;
    float inv_freq[8];
    int ph_lo, ph_hi;
};

__device__ __forceinline__ unsigned f2bf(float f) { unsigned u = __float_as_uint(f); return (u + 0x7fffu + ((u >> 16) & 1u)) >> 16; }
__device__ __forceinline__ float bf2f(unsigned h) { return __uint_as_float(h << 16); }
__device__ __forceinline__ unsigned pk2(float lo, float hi) { return f2bf(lo) | (f2bf(hi) << 16); }
__device__ __forceinline__ float bflo(unsigned u) { return __uint_as_float(u << 16); }
__device__ __forceinline__ float bfhi(unsigned u) { return __uint_as_float(u & 0xffff0000u); }
__device__ __forceinline__ float wave_sum(float v) {
#pragma unroll
    for (int o = 32; o >= 1; o >>= 1) v += __shfl_xor(v, o);
    return v;
}
#define LDS_WAIT() asm volatile("s_waitcnt lgkmcnt(0)" ::: "memory")
__device__ __forceinline__ int opaque_tid() { int t = threadIdx.x; asm volatile("" : "+v"(t)); return t; }
__device__ __forceinline__ float siluf(float v) { return v / (1.f + __expf(-v)); }
__device__ __forceinline__ f32x16 mfma32(bf16x8 a, bf16x8 b, f32x16 c) { return __builtin_amdgcn_mfma_f32_32x32x16_bf16(a, b, c, 0, 0, 0); }
__device__ __forceinline__ f32x16 zero16() { f32x16 z;
#pragma unroll
    for (int i = 0; i < 16; ++i) z[i] = 0.f;
    return z; }
__device__ __forceinline__ int crow(int i, int h) { return (i & 3) + 8 * (i >> 2) + 4 * h; }

namespace pg8 {
#define PG8_LAS __attribute__((address_space(3)))
typedef unsigned short bf16_t;
typedef short bf16x8 __attribute__((ext_vector_type(8)));
typedef float f32x4 __attribute__((ext_vector_type(4)));
typedef unsigned u32x4 __attribute__((ext_vector_type(4)));
constexpr int BM = 256, BK = 64, HALF = 128, HTB = HALF * BK * 2  , STAGE_BYTES = 8 * HTB, NXCD = 8, WGM = 8;

__host__ __device__ __forceinline__ int lds_byte(int r, int c) { const int st = (r >> 4) * 2 + (c >> 5), rr = r & 15, cc = c & 31, ob = rr * 64 + cc * 2; return st * 1024 + (ob ^ (((ob >> 9) & 1) << 5)); }
__host__ __device__ __forceinline__ void stage_rc(int b, int& R, int& C) { const int st = b / 1024, sb = b % 1024, swz = sb ^ (((sb >> 9) & 1) << 5); R = (st >> 1) * 16 + swz / 64; C = (st & 1) * 32 + (swz % 64) / 2; }
__host__ __device__ __forceinline__ int perm32(int rho) { const int n = rho >> 4, i = rho & 15; return 8 * (i >> 2) + 4 * n + (i & 3); }

struct Unit { int pm, pn; };
struct Gemm { const bf16_t* A; const bf16_t* Bt; int M, N, K; };

struct StaticOrder {
    int nM, nN, nwg, G, c;
    __host__ __device__ void init(int M, int N, int G_, int c_) { nM = M / BM; nN = N / BM; nwg = nM * nN; G = G_; c = c_; }
    __host__ __device__ bool next(int i, Unit& u) const {
        const long L = (long)i * G + c; if (L >= nwg) return false;
        int wgid = (int)L; { const int q = nwg / NXCD, r = nwg % NXCD, xcd = wgid % NXCD, off = wgid / NXCD; wgid = (xcd < r ? xcd * (q + 1) : r * (q + 1) + (xcd - r) * q) + off; }
        const int nig = WGM * nN, gid = wgid / nig, fm = gid * WGM, gsz = (nM - fm) < WGM ? (nM - fm) : WGM;
        u.pm = fm + ((wgid % nig) % gsz); u.pn = (wgid % nig) / gsz; return true;
    }
    __device__ __forceinline__ void a_ready(const Unit&) const {}
    __device__ __forceinline__ void done(const Unit&) const {}
};
__device__ __forceinline__ unsigned cvt_pk_bf16(float lo, float hi) { unsigned r; asm volatile("v_cvt_pk_bf16_f32 %0, %1, %2" : "=v"(r) : "v"(lo), "v"(hi)); return r; }
typedef float f32x2 __attribute__((ext_vector_type(2)));
template <class Epi, class Sched, bool ALIGN_EPI = false, bool SP2 = false>
__device__ __forceinline__ void gemm_phase(PG8_LAS unsigned char* lds, const Gemm g, const Sched& S, const Epi& E) {
    const int tid = threadIdx.x, wid = __builtin_amdgcn_readfirstlane(tid >> 6), lane = tid & 63, wr = wid >> 2, wc = wid & 3, fr = lane & 15, fq = lane >> 4;
    const int K = g.K, nt = K / BK;
    unsigned voffA[2], voffB[2];
#pragma unroll
    for (int i = 0; i < 2; ++i) { int R, C; stage_rc(tid * 16 + i * 8192, R, C); const int Rb = Epi::PERM ? ((R & ~31) + perm32(R & 31)) : R;
        voffA[i] = (unsigned)(R * K + C) * 2u; voffB[i] = (unsigned)(Rb * K + C) * 2u; }
    const size_t kstep = (size_t)(BK * 2);
    const size_t hstep = (size_t)HALF * K * 2;
    const size_t tstep = 2 * hstep;
    const unsigned ldsw = (unsigned)wid * 1024u;
    const int aoff = lds_byte(wr * 64 + fr, fq * 8), boff = lds_byte(wc * 32 + fr, fq * 8);
#define PG8_SA(b, h) (((b) * 2 + (h)) * HTB)
#define PG8_SB(b, h) ((4 + (b) * 2 + (h)) * HTB)
#define PG8_STAGE(bufoff, gbase, voff) do { _Pragma("unroll") for (int _i = 0; _i < 2; ++_i) \
        __builtin_amdgcn_global_load_lds((const unsigned*)((const char*)(gbase) + (voff)[_i]), (PG8_LAS unsigned*)(lds + (bufoff) + ldsw + _i * 8192), 16, 0, 0); } while (0)
#define PG8_LDA(dst, b, h) do { _Pragma("unroll") for (int m = 0; m < 4; ++m) _Pragma("unroll") for (int k = 0; k < 2; ++k) dst[m][k] = *(const PG8_LAS bf16x8*)(lds + PG8_SA(b, h) + aoff + m * 2048 + k * 1024); } while (0)
#define PG8_LDB(dst, b, h) do { _Pragma("unroll") for (int n = 0; n < 2; ++n) _Pragma("unroll") for (int k = 0; k < 2; ++k) dst[n][k] = *(const PG8_LAS bf16x8*)(lds + PG8_SB(b, h) + boff + n * 2048 + k * 1024); } while (0)
#define PG8_MMA(ai, bj, At, Bt) do { __builtin_amdgcn_s_setprio(1); _Pragma("unroll") for (int m = 0; m < 4; ++m) _Pragma("unroll") for (int n = 0; n < 2; ++n) _Pragma("unroll") for (int k = 0; k < 2; ++k) \
        acc[ai][bj][m][n] = __builtin_amdgcn_mfma_f32_16x16x32_bf16(Bt[n][k], At[m][k], acc[ai][bj][m][n], 0, 0, 0); __builtin_amdgcn_s_setprio(0); } while (0)
#define PG8_WAIT_V(n) asm volatile("s_waitcnt vmcnt(" #n ")" ::: "memory")
#define PG8_WAIT_L(n) asm volatile("s_waitcnt lgkmcnt(" #n ")" ::: "memory")
#define PG8_BAR __builtin_amdgcn_s_barrier()
#define PG8_SCHED __builtin_amdgcn_sched_barrier(0)
    Unit cur, nxt; int ui = 0;
    if (!S.next(0, cur)) return;
    f32x4 acc[2][2][4][2];
#pragma unroll
    for (int a = 0; a < 2; ++a)
#pragma unroll
        for (int b = 0; b < 2; ++b)
#pragma unroll
            for (int m = 0; m < 4; ++m)
#pragma unroll
                for (int n = 0; n < 2; ++n) acc[a][b][m][n] = (f32x4){0.f, 0.f, 0.f, 0.f};
    bf16x8 At[4][2], B0[2][2], B1[2][2];
    const char* cA = (const char*)g.A + (size_t)cur.pm * tstep; const char* cB = (const char*)g.Bt + (size_t)cur.pn * tstep;
    S.a_ready(cur);
    if constexpr (SP2) {
        PG8_STAGE(PG8_SB(0, 0), cB, voffB); PG8_STAGE(PG8_SB(0, 1), cB + hstep, voffB); PG8_STAGE(PG8_SA(0, 0), cA, voffA); PG8_STAGE(PG8_SA(0, 1), cA + hstep, voffA);
        if (wr == 1) PG8_BAR;
        PG8_WAIT_V(2); PG8_BAR;
        PG8_STAGE(PG8_SB(1, 0), cB + kstep, voffB); PG8_STAGE(PG8_SA(1, 0), cA + kstep, voffA); PG8_STAGE(PG8_SB(1, 1), cB + hstep + kstep, voffB);
        PG8_WAIT_V(6); PG8_BAR;
    } else {
        PG8_STAGE(PG8_SB(0, 0), cB, voffB); PG8_STAGE(PG8_SA(0, 0), cA, voffA); PG8_STAGE(PG8_SB(0, 1), cB + hstep, voffB); PG8_STAGE(PG8_SA(0, 1), cA + hstep, voffA);
        if (wr == 1) PG8_BAR;
        PG8_WAIT_V(4); PG8_BAR;
        PG8_STAGE(PG8_SB(1, 0), cB + kstep, voffB); PG8_STAGE(PG8_SA(1, 0), cA + kstep, voffA); PG8_STAGE(PG8_SB(1, 1), cB + hstep + kstep, voffB);
        PG8_WAIT_V(6); PG8_BAR;
    }
    for (;;) {
        const bool has_next = S.next(ui + 1, nxt);
        const char* nA = has_next ? (const char*)g.A + (size_t)nxt.pm * tstep : cA; const char* nB = has_next ? (const char*)g.Bt + (size_t)nxt.pn * tstep : cB;
        for (int t = 0; t < nt; t += 2) {
            const bool last = (t == nt - 2);
            const char* a1 = cA + (size_t)(t + 1) * kstep;
            const char* a2 = last ? nA : cA + (size_t)(t + 2) * kstep; const char* b2 = last ? nB : cB + (size_t)(t + 2) * kstep;
            const char* a3 = a2 + kstep; const char* b3 = b2 + kstep;
            if (last && has_next) S.a_ready(nxt);
            if constexpr (SP2) {
            PG8_LDB(B0, 0, 0); PG8_LDB(B1, 0, 1); PG8_SCHED; PG8_LDA(At, 0, 0); PG8_STAGE(PG8_SA(1, 1), a1 + hstep, voffA);
            PG8_WAIT_V(8); PG8_WAIT_L(0); PG8_BAR; PG8_MMA(0, 0, At, B0); PG8_MMA(0, 1, At, B1); PG8_BAR; PG8_SCHED;
            PG8_LDA(At, 0, 1); PG8_STAGE(PG8_SB(0, 0), b2, voffB); PG8_STAGE(PG8_SB(0, 1), b2 + hstep, voffB); PG8_STAGE(PG8_SA(0, 0), a2, voffA);
            PG8_WAIT_V(8); PG8_WAIT_L(0); PG8_BAR; PG8_MMA(1, 0, At, B0); PG8_MMA(1, 1, At, B1); PG8_BAR; PG8_SCHED;
            PG8_LDB(B0, 1, 0); PG8_LDB(B1, 1, 1); PG8_SCHED; PG8_LDA(At, 1, 0); PG8_STAGE(PG8_SA(0, 1), a2 + hstep, voffA);
            PG8_WAIT_V(8); PG8_WAIT_L(0); PG8_BAR; PG8_MMA(0, 0, At, B0); PG8_MMA(0, 1, At, B1); PG8_BAR; PG8_SCHED;
            PG8_LDA(At, 1, 1); PG8_STAGE(PG8_SB(1, 0), b3, voffB); PG8_STAGE(PG8_SB(1, 1), b3 + hstep, voffB); PG8_STAGE(PG8_SA(1, 0), a3, voffA);
            PG8_WAIT_V(8); PG8_WAIT_L(0); PG8_BAR; PG8_MMA(1, 0, At, B0); PG8_MMA(1, 1, At, B1); PG8_BAR; PG8_SCHED;
            } else {
            PG8_LDB(B0, 0, 0); PG8_SCHED; PG8_LDA(At, 0, 0); PG8_STAGE(PG8_SA(1, 1), a1 + hstep, voffA);
            PG8_WAIT_L(8); PG8_BAR; PG8_WAIT_L(0); PG8_MMA(0, 0, At, B0); PG8_BAR; PG8_SCHED;
            PG8_LDB(B1, 0, 1); PG8_STAGE(PG8_SB(0, 0), b2, voffB);
            PG8_BAR; PG8_WAIT_L(0); PG8_MMA(0, 1, At, B1); PG8_BAR;
            PG8_LDA(At, 0, 1); PG8_STAGE(PG8_SA(0, 0), a2, voffA);
            PG8_BAR; PG8_WAIT_L(0); PG8_MMA(1, 0, At, B0); PG8_BAR; PG8_SCHED;
            PG8_STAGE(PG8_SB(0, 1), b2 + hstep, voffB);
            PG8_WAIT_V(6); PG8_BAR; PG8_MMA(1, 1, At, B1); PG8_BAR;
            PG8_LDB(B0, 1, 0); PG8_SCHED; PG8_LDA(At, 1, 0); PG8_STAGE(PG8_SA(0, 1), a2 + hstep, voffA);
            PG8_WAIT_L(8); PG8_BAR; PG8_WAIT_L(0); PG8_MMA(0, 0, At, B0); PG8_BAR; PG8_SCHED;
            PG8_LDB(B1, 1, 1); PG8_STAGE(PG8_SB(1, 0), b3, voffB);
            PG8_BAR; PG8_WAIT_L(0); PG8_MMA(0, 1, At, B1); PG8_BAR;
            PG8_LDA(At, 1, 1); PG8_STAGE(PG8_SA(1, 0), a3, voffA);
            PG8_BAR; PG8_WAIT_L(0); PG8_MMA(1, 0, At, B0); PG8_BAR; PG8_SCHED;
            PG8_STAGE(PG8_SB(1, 1), b3 + hstep, voffB);
            PG8_WAIT_V(6); PG8_BAR; PG8_MMA(1, 1, At, B1); PG8_BAR;
            }
        }
        if constexpr (ALIGN_EPI) { if (wr == 0) PG8_BAR; }
        if constexpr (!Epi::AFTER_DRAIN) { E(acc, cur, wr, wc, fr, fq); S.done(cur); }
        if (!has_next) break;
#pragma unroll
        for (int a = 0; a < 2; ++a)
#pragma unroll
            for (int b = 0; b < 2; ++b)
#pragma unroll
                for (int m = 0; m < 4; ++m)
#pragma unroll
                    for (int n = 0; n < 2; ++n) acc[a][b][m][n] = (f32x4){0.f, 0.f, 0.f, 0.f};
        cur = nxt; cA = nA; cB = nB; ++ui;
        if constexpr (ALIGN_EPI) { if (wr == 1) PG8_BAR; }
    }
    PG8_WAIT_V(0);
    if constexpr (!ALIGN_EPI) { if (wr == 0) PG8_BAR; }
    PG8_BAR;
    if constexpr (Epi::AFTER_DRAIN) { E.fused(acc, cur, wr, wc, fr, fq, lds, wid, lane); S.done(cur); }
#undef PG8_SA
#undef PG8_SB
#undef PG8_STAGE
#undef PG8_LDA
#undef PG8_LDB
#undef PG8_MMA
#undef PG8_WAIT_V
#undef PG8_WAIT_L
#undef PG8_BAR
#undef PG8_SCHED
}

struct EpiBf16 {
    static constexpr bool PERM = true, AFTER_DRAIN = false;
    bf16_t* O; int ldc; int npn;
    __device__ __forceinline__ void operator()(const f32x4 (&acc)[2][2][4][2], const Unit& u, int wr, int wc, int fr, int fq) const {
        const int row0 = u.pm * BM + wr * 64 + fr, col0 = (u.pn % npn) * BM + wc * 32 + 8 * fq;
#pragma unroll
        for (int ai = 0; ai < 2; ++ai)
#pragma unroll
            for (int m = 0; m < 4; ++m) { bf16_t* rowp = O + (size_t)(row0 + ai * HALF + m * 16) * ldc + col0;
#pragma unroll
                for (int bj = 0; bj < 2; ++bj) { const f32x4 v0 = acc[ai][bj][m][0], v1 = acc[ai][bj][m][1];
                    u32x4 w; w.x = cvt_pk_bf16(v0[0], v0[1]); w.y = cvt_pk_bf16(v0[2], v0[3]); w.z = cvt_pk_bf16(v1[0], v1[1]); w.w = cvt_pk_bf16(v1[2], v1[3]);
                    *(u32x4*)(rowp + bj * HALF) = w; } }
    }
};
struct EpiKV {
    static constexpr bool PERM = true, AFTER_DRAIN = false;
    bf16_t* kmem; bf16_t* vmemT;
    __device__ __forceinline__ void operator()(const f32x4 (&acc)[2][2][4][2], const Unit& u, int wr, int wc, int fr, int fq) const {
        const int row0 = u.pm * BM + wr * 64 + fr, col0 = u.pn * BM + wc * 32 + 8 * fq;
#pragma unroll
        for (int ai = 0; ai < 2; ++ai)
#pragma unroll
            for (int m = 0; m < 4; ++m) { const int row = row0 + ai * HALF + m * 16;
#pragma unroll
                for (int bj = 0; bj < 2; ++bj) { const f32x4 v0 = acc[ai][bj][m][0], v1 = acc[ai][bj][m][1]; const int col = col0 + bj * HALF;
                    if (col < 512) { u32x4 w; w.x = cvt_pk_bf16(v0[0], v0[1]); w.y = cvt_pk_bf16(v0[2], v0[3]); w.z = cvt_pk_bf16(v1[0], v1[1]); w.w = cvt_pk_bf16(v1[2], v1[3]);
                        *(u32x4*)(kmem + (size_t)row * 512 + col) = w; }
                    else { const int c2 = col - 512, hx = c2 >> 7, d = c2 & 127, b = row >> 8, key = row & 255;
                        bf16_t* vp = vmemT + (((size_t)b * 4 + hx) * 128 + d) * 256 + key;
                        const unsigned w0 = cvt_pk_bf16(v0[0], v0[1]), w1 = cvt_pk_bf16(v0[2], v0[3]), w2 = cvt_pk_bf16(v1[0], v1[1]), w3 = cvt_pk_bf16(v1[2], v1[3]);
                        vp[0 * 256] = (bf16_t)(w0 & 0xffffu); vp[1 * 256] = (bf16_t)(w0 >> 16); vp[2 * 256] = (bf16_t)(w1 & 0xffffu); vp[3 * 256] = (bf16_t)(w1 >> 16);
                        vp[4 * 256] = (bf16_t)(w2 & 0xffffu); vp[5 * 256] = (bf16_t)(w2 >> 16); vp[6 * 256] = (bf16_t)(w3 & 0xffffu); vp[7 * 256] = (bf16_t)(w3 >> 16); } } }
    }
};
template <bool XF32, bool STATS> struct EpiResid {
    static constexpr bool PERM = false, AFTER_DRAIN = false;
    const void* xin; bf16_t* xb; float* ssq;
    __device__ __forceinline__ void operator()(const f32x4 (&acc)[2][2][4][2], const Unit& u, int wr, int wc, int fr, int fq) const {
        typedef unsigned u32x2v __attribute__((ext_vector_type(2)));
        const int col0 = u.pn * BM + wc * 32 + 4 * fq;
#pragma unroll
        for (int ai = 0; ai < 2; ++ai)
#pragma unroll
            for (int m = 0; m < 4; ++m) { const size_t row = (size_t)(u.pm * BM + ai * HALF + wr * 64 + m * 16 + fr); const size_t off = row * 1024 + col0;
                float q = 0.f;
#pragma unroll
                for (int bj = 0; bj < 2; ++bj)
#pragma unroll
                    for (int n = 0; n < 2; ++n) {
                        f32x4 bs;
                        if (XF32) bs = *(const f32x4*)((const float*)xin + off + bj * HALF + n * 16);
                        else { const u32x2v t = *(const u32x2v*)((const bf16_t*)xin + off + bj * HALF + n * 16);
                            bs[0] = __uint_as_float(t.x << 16); bs[1] = __uint_as_float(t.x & 0xffff0000u); bs[2] = __uint_as_float(t.y << 16); bs[3] = __uint_as_float(t.y & 0xffff0000u); }
                        const f32x4 o = bs + acc[ai][bj][m][n];
                        u32x2v w; w.x = cvt_pk_bf16(o[0], o[1]); w.y = cvt_pk_bf16(o[2], o[3]); *(u32x2v*)(xb + off + bj * HALF + n * 16) = w;
                        if (STATS) q += (o[0] * o[0] + o[1] * o[1]) + (o[2] * o[2] + o[3] * o[3]); }
                if (STATS) { q += __shfl_xor(q, 16); q += __shfl_xor(q, 32); if (fq == 0) ssq[row * 16 + u.pn * 4 + wc] = q; }
                asm volatile("" ::: "memory"); }
    }
};
struct EpiQ {
    static constexpr bool PERM = true, AFTER_DRAIN = false;
    bf16_t* O; const float* ssq;
    __device__ __forceinline__ void operator()(const f32x4 (&acc)[2][2][4][2], const Unit& u, int wr, int wc, int fr, int fq) const {
        const int row0 = u.pm * BM + wr * 64 + fr, col0 = u.pn * BM + wc * 32 + 8 * fq;
#pragma unroll
        for (int ai = 0; ai < 2; ++ai)
#pragma unroll
            for (int m = 0; m < 4; ++m) { const size_t row = (size_t)(row0 + ai * HALF + m * 16);
                const f32x4* sp = (const f32x4*)(ssq + row * 16); const f32x4 s0 = sp[0], s1 = sp[1], s2 = sp[2], s3 = sp[3];
                const float s = ((s0[0] + s0[1]) + (s0[2] + s0[3])) + ((s1[0] + s1[1]) + (s1[2] + s1[3])) + ((s2[0] + s2[1]) + (s2[2] + s2[3])) + ((s3[0] + s3[1]) + (s3[2] + s3[3]));
                const float rs = 1.f / sqrtf(s * (1.f / 1024.f) + 1e-5f);
                bf16_t* rowp = O + row * 512 + col0;
#pragma unroll
                for (int bj = 0; bj < 2; ++bj) { const f32x4 v0 = acc[ai][bj][m][0] * rs, v1 = acc[ai][bj][m][1] * rs;
                    u32x4 w; w.x = cvt_pk_bf16(v0[0], v0[1]); w.y = cvt_pk_bf16(v0[2], v0[3]); w.z = cvt_pk_bf16(v1[0], v1[1]); w.w = cvt_pk_bf16(v1[2], v1[3]);
                    *(u32x4*)(rowp + bj * HALF) = w; } }
    }
};
struct EpiGU {
    static constexpr bool PERM = true, AFTER_DRAIN = false;
    bf16_t* hid;
    __device__ __forceinline__ void operator()(const f32x4 (&acc)[2][2][4][2], const Unit& u, int wr, int wc, int fr, int fq) const {
        const int row0 = u.pm * BM + wr * 64 + fr, j0 = (u.pn & 1) * 128 + wc * 16 + 4 * fq;
#pragma unroll
        for (int ai = 0; ai < 2; ++ai)
#pragma unroll
            for (int m = 0; m < 4; ++m) { bf16_t* rowp = hid + (size_t)(row0 + ai * HALF + m * 16) * 256 + j0;
#pragma unroll
                for (int bj = 0; bj < 2; ++bj) { const f32x4 v0 = acc[ai][bj][m][0], v1 = acc[ai][bj][m][1];
                    const float h0 = v0[0] / (1.f + __expf(-v0[0])) * v0[1], h1 = v0[2] / (1.f + __expf(-v0[2])) * v0[3];
                    const float h2 = v1[0] / (1.f + __expf(-v1[0])) * v1[1], h3 = v1[2] / (1.f + __expf(-v1[2])) * v1[3];
                    typedef unsigned u32x2v __attribute__((ext_vector_type(2))); u32x2v w; w.x = cvt_pk_bf16(h0, h1); w.y = cvt_pk_bf16(h2, h3);
                    *(u32x2v*)(rowp + bj * 64) = w; } }
    }
};
struct SubOrder {
    int nM, nN, nwg, span, c;
    __device__ void init(int M, int N, int span_, int c_) { nM = M / BM; nN = N / BM; nwg = nM * nN; span = span_; c = c_; }
    __device__ bool next(int i, Unit& u) const { if (c < 0 || c >= span) return false; const int L = i * span + c; if (L >= nwg) return false; u.pm = L / nN; u.pn = L % nN; return true; }
    __device__ __forceinline__ void a_ready(const Unit&) const {}
    __device__ __forceinline__ void done(const Unit&) const {}
};
struct MoeOrder {
    const PG8_LAS int* tile_e; int nrt, npn, G, c;
    __device__ bool next(int i, Unit& u) const { const int L = i * G + c; if (L >= nrt * npn) return false; const int rt = L / npn, pnl = L % npn; u.pm = rt; u.pn = tile_e[rt] * npn + pnl; return true; }
    __device__ __forceinline__ void a_ready(const Unit&) const {}
    __device__ __forceinline__ void done(const Unit&) const {}
};
}

#define LAS __attribute__((address_space(3)))
#define XB_TMO      128
#define XB_XCNT(j)  (256  + 64 * (j))
#define XB_XSUB(j)  (1280 + 64 * (j))
#define XB_XGEN(j)  (2304 + 64 * (j))
#define XB_TOP      3328
#define XB_TOPGEN   3392
#define XCD_BAR_WORDS 3456
#define XB_SPIN_CAP (1u << 18)

__device__ __forceinline__ unsigned xb_ld(unsigned* p)              { return __hip_atomic_load(p, __ATOMIC_RELAXED, __HIP_MEMORY_SCOPE_AGENT); }
__device__ __forceinline__ unsigned xb_add(unsigned* p, unsigned v) { return __hip_atomic_fetch_add(p, v, __ATOMIC_RELAXED, __HIP_MEMORY_SCOPE_AGENT); }
__device__ __forceinline__ unsigned xb_xcc_id() { return (unsigned)__builtin_amdgcn_s_getreg((3 << 11) | 20) & 0xFu; }
#define XB_SPIN(cond, bar) do { unsigned _sp = 0; while (cond) { __builtin_amdgcn_s_sleep(1); \
    if ((++_sp & 255u) == 0u) { if (xb_ld(&(bar)[XB_TMO])) break; if (_sp > XB_SPIN_CAP) { atomicAdd(&(bar)[XB_TMO], 1u); break; } } } } while (0)

struct XcdBarrier {
    unsigned* bar; unsigned x;
    volatile LAS unsigned* st;
};

__device__ __forceinline__ XcdBarrier xcd_barrier_post(unsigned* bar, volatile LAS unsigned* st) {
    XcdBarrier b; b.bar = bar; b.x = xb_xcc_id(); b.st = st;
    if (threadIdx.x == 0) (void)xb_add(&bar[XB_XCNT(b.x)], 1u);
    return b;
}
__device__ __forceinline__ void xcd_barrier_complete(unsigned* bar, unsigned x, unsigned& nloc, unsigned& nx) {
    const unsigned G = gridDim.x * gridDim.y * gridDim.z;
    unsigned sum, cnt, mine, sp = 0u;
    for (;;) {
        sum = 0u; cnt = 0u; mine = 0u;
#pragma unroll
        for (unsigned j = 0; j < 16; ++j) { const unsigned c = xb_ld(&bar[XB_XCNT(j)]); sum += c; cnt += (c > 0u) ? 1u : 0u; mine = (j == x) ? c : mine; }
        if (sum == G) break;
        __builtin_amdgcn_s_sleep(1);
        if ((++sp & 255u) == 0u) { if (xb_ld(&bar[XB_TMO])) break; if (sp > XB_SPIN_CAP) { atomicAdd(&bar[XB_TMO], 1u); break; } }
    }
    nloc = mine > 0u ? mine : 1u; nx = cnt > 0u ? cnt : 1u;
}

__device__ __forceinline__ void xcd_barrier(const XcdBarrier& b) {
    asm volatile("s_waitcnt vmcnt(0)" ::: "memory");
    __syncthreads();
    if (threadIdx.x == 0) {
        unsigned* bar = b.bar;
        __builtin_amdgcn_s_waitcnt(0);
        unsigned nloc = b.st[0], nx = b.st[1];
        if (nloc == 0u) { xcd_barrier_complete(bar, b.x, nloc, nx); b.st[0] = nloc; b.st[1] = nx; }
        const unsigned old = xb_add(&bar[XB_XSUB(b.x)], 1u);
        const unsigned gen = old / nloc;
        if (old + 1u == (gen + 1u) * nloc) {
            __builtin_amdgcn_fence(__ATOMIC_RELEASE, "agent");
            asm volatile("s_waitcnt vmcnt(0)" ::: "memory");
            const unsigned og = xb_add(&bar[XB_TOP], 1u);
            const unsigned tg = og / nx;
            if (og + 1u == (tg + 1u) * nx) xb_add(&bar[XB_TOPGEN], 1u);
            else XB_SPIN(xb_ld(&bar[XB_TOPGEN]) == tg, bar);
            __builtin_amdgcn_fence(__ATOMIC_ACQUIRE, "agent");
            xb_add(&bar[XB_XGEN(b.x)], 1u);
            asm volatile("s_waitcnt vmcnt(0)" ::: "memory");
        } else {
            XB_SPIN(xb_ld(&bar[XB_XGEN(b.x)]) == gen, bar);
            __builtin_amdgcn_fence(__ATOMIC_ACQUIRE, "agent");
            asm volatile("s_waitcnt vmcnt(0)" ::: "memory");
        }
    }
    __syncthreads();
}

__device__ __forceinline__ void gemm128(unsigned char* lds, const bf16_t* arow, const bf16_t* brow, int K, f32x16& acc0, f32x16& acc1) {
    const int tid = opaque_tid(), lane = tid & 63, w = tid >> 6;
    bf16_t* sA = (bf16_t*)lds;
    bf16_t* sB = sA + 128 * 72;
    const int srow = tid >> 2, skc = (tid & 3) * 16;
    const bf16_t* ap = arow + skc;
    const bf16_t* bp = brow + skc;
    const int wm = w >> 1, wn = w & 1, r = lane & 31, h = lane >> 5;
    acc0 = zero16(); acc1 = zero16();
    for (int k0 = 0; k0 < K; k0 += 64) {
        const u32x4 a0 = *(const u32x4*)(ap + k0), a1 = *(const u32x4*)(ap + k0 + 8);
        const u32x4 b0 = *(const u32x4*)(bp + k0), b1 = *(const u32x4*)(bp + k0 + 8);
        __syncthreads();
        *(u32x4*)(sA + srow * 72 + skc) = a0; *(u32x4*)(sA + srow * 72 + skc + 8) = a1;
        *(u32x4*)(sB + srow * 72 + skc) = b0; *(u32x4*)(sB + srow * 72 + skc + 8) = b1;
        __syncthreads();
#pragma unroll
        for (int kk = 0; kk < 64; kk += 16) {
            const bf16x8 a = *(const bf16x8*)(sA + (wm * 32 + r) * 72 + kk + 8 * h);
            const bf16x8 bA = *(const bf16x8*)(sB + (wn * 64 + r) * 72 + kk + 8 * h);
            const bf16x8 bB = *(const bf16x8*)(sB + (wn * 64 + 32 + r) * 72 + kk + 8 * h);
            acc0 = mfma32(a, bA, acc0); acc1 = mfma32(a, bB, acc1);
        }
    }
    __syncthreads();
}

__device__ __forceinline__ void p0_transpose_item(const float* W, int ldw, int K, int nblk, const float* scale, bf16_t* WT, int row_off, int row_mul, float* scr, int item, int lane) {
    const int kb = item / nblk, nb = item % nblk, k0 = 64 * kb, n0 = 32 * nb;
#pragma unroll 8
    for (int i = 0; i < 32; ++i) { const int kk = 2 * i + (lane >> 5); float v = W[(size_t)(k0 + kk) * ldw + n0 + (lane & 31)]; if (scale) v *= scale[k0 + kk]; scr[kk * 33 + (lane & 31)] = v; }
    LDS_WAIT();
    const int c = lane & 7;
#pragma unroll
    for (int j = 0; j < 4; ++j) { const int n = (lane >> 3) + 8 * j; const float* s = scr + (8 * c) * 33 + n;
        u32x4 o; o.x = pk2(s[0 * 33], s[1 * 33]); o.y = pk2(s[2 * 33], s[3 * 33]); o.z = pk2(s[4 * 33], s[5 * 33]); o.w = pk2(s[6 * 33], s[7 * 33]);
        *(u32x4*)(WT + (size_t)(row_off + (n0 + n) * row_mul) * K + k0 + 8 * c) = o; }
    LDS_WAIT();
}

__device__ __forceinline__ void phase0(const Params& p, unsigned char* lds) {
    const int tid = opaque_tid(), lane = tid & 63, w = tid >> 6;
    unsigned char* ws = p.ws;
    const int gw = blockIdx.x * NWAVES + w, NGW = gridDim.x * NWAVES;
    {
        float* WR = (float*)(ws + WS_WR);
        const float* w3 = p.in[19]; const float* wg = p.in[20]; const float* we = p.in[22];
        for (int i = blockIdx.x * NTHREADS + tid; i < 36 * 1024; i += gridDim.x * NTHREADS) {
            const int n = i >> 10, k = i & 1023;
            const float v = (n < 4) ? wg[k * 4 + n] : we[k * 32 + (n - 4)];
            WR[i] = v * w3[k];
        }
    }
    {
        float* scr = (float*)(lds + 32768) + w * (64 * 33 + 16);
        constexpr int I_IN = 16 * 72, I_OUT = 16 * 32, I_Q = 16 * 16, I_KV = 16 * 32, I_O = 8 * 32, I_G = 32 * 16 * 8, I_D = 32 * 4 * 32;
        constexpr int NITEMS = I_IN + I_OUT + I_Q + I_KV + I_O + 2 * I_G + I_D;
        for (int it = gw; it < NITEMS; it += NGW) {
            int r = it;
            if (r < I_IN) { p0_transpose_item(p.in[4], LDWIN, 1024, 72, nullptr, (bf16_t*)(ws + WS_WIN), 0, 1, scr, r, lane); continue; } r -= I_IN;
            if (r < I_OUT) { p0_transpose_item(p.in[13], 1024, 1024, 32, nullptr, (bf16_t*)(ws + WS_WOUT), 0, 1, scr, r, lane); continue; } r -= I_OUT;
            if (r < I_Q) { p0_transpose_item(p.in[16], 512, 1024, 16, p.in[14], (bf16_t*)(ws + WS_WQ), 0, 1, scr, r, lane); continue; } r -= I_Q;
            if (r < I_KV) { p0_transpose_item(p.in[17], 1024, 1024, 32, nullptr, (bf16_t*)(ws + WS_WKV), 0, 1, scr, r, lane); continue; } r -= I_KV;
            if (r < I_O) { p0_transpose_item(p.in[18], 1024, 512, 32, nullptr, (bf16_t*)(ws + WS_WO), 0, 1, scr, r, lane); continue; } r -= I_O;
            if (r < I_G) { const int e = r / 128, ri = r % 128; p0_transpose_item(p.in[24] + (size_t)e * 1024 * 256, 256, 1024, 8, p.in[19], (bf16_t*)(ws + WS_WGU) + (size_t)e * 512 * 1024, 0, 2, scr, ri, lane); continue; } r -= I_G;
            if (r < I_G) { const int e = r / 128, ri = r % 128; p0_transpose_item(p.in[25] + (size_t)e * 1024 * 256, 256, 1024, 8, p.in[19], (bf16_t*)(ws + WS_WGU) + (size_t)e * 512 * 1024, 1, 2, scr, ri, lane); continue; } r -= I_G;
            { const int e = r / 128, ri = r % 128; p0_transpose_item(p.in[26] + (size_t)e * 256 * 1024, 1024, 256, 32, nullptr, (bf16_t*)(ws + WS_WD) + (size_t)e * 1024 * 256, 0, 1, scr, ri, lane); }
        }
    }
    float* wdt = (float*)lds;
    {
        const float* win = p.in[4]; const float* w1 = p.in[3];
        for (int i = tid; i < 8192; i += NTHREADS) { const int k = i >> 3, n = i & 7; wdt[n * 1024 + k] = win[(size_t)k * LDWIN + 2304 + n] * w1[k]; }
    }
    __syncthreads();
    {
        const float* x = p.in[0]; const float* w1 = p.in[3];
        bf16_t* h1 = (bf16_t*)p.out; float* dtraw = (float*)(ws + WS_DTRAW);
        f32x4 wv[4];
#pragma unroll
        for (int j = 0; j < 4; ++j) wv[j] = *(const f32x4*)(w1 + 4 * lane + 256 * j);
        for (int m = gw; m < NT; m += NGW) {
            const f32x4* xr = (const f32x4*)(x + (size_t)m * DM) + lane;
            f32x4 v[4]; float s = 0.f;
#pragma unroll
            for (int j = 0; j < 4; ++j) { v[j] = xr[64 * j]; s += (v[j].x * v[j].x + v[j].y * v[j].y) + (v[j].z * v[j].z + v[j].w * v[j].w); }
            const float rstd = 1.f / sqrtf(wave_sum(s) * (1.f / DM) + EPS);
            float d[8];
#pragma unroll
            for (int n = 0; n < 8; ++n) { float a = 0.f;
#pragma unroll
                for (int j = 0; j < 4; ++j) { const f32x4 ww = *(const f32x4*)(wdt + n * 1024 + 4 * lane + 256 * j); a += (v[j].x * ww.x + v[j].y * ww.y) + (v[j].z * ww.z + v[j].w * ww.w); }
                d[n] = wave_sum(a) * rstd; }
            if (lane == 0) { *(f32x4*)(dtraw + (size_t)m * 8) = (f32x4){d[0], d[1], d[2], d[3]}; *(f32x4*)(dtraw + (size_t)m * 8 + 4) = (f32x4){d[4], d[5], d[6], d[7]}; }
            u32x2* o8 = (u32x2*)(h1 + (size_t)m * DM) + lane;
#pragma unroll
            for (int j = 0; j < 4; ++j) { u32x2 o; o.x = pk2(v[j].x * rstd * wv[j].x, v[j].y * rstd * wv[j].y); o.y = pk2(v[j].z * rstd * wv[j].z, v[j].w * rstd * wv[j].w); o8[64 * j] = o; }
        }
    }
    {
        const float* mem = p.in[1]; const float* wm = p.in[15];
        bf16_t* memh = (bf16_t*)(ws + WS_MEMH);
        f32x4 wv[4];
#pragma unroll
        for (int j = 0; j < 4; ++j) wv[j] = *(const f32x4*)(wm + 4 * lane + 256 * j);
        for (int m = gw; m < NMEM; m += NGW) {
            const f32x4* xr = (const f32x4*)(mem + (size_t)m * DM) + lane;
            f32x4 v[4]; float s = 0.f;
#pragma unroll
            for (int j = 0; j < 4; ++j) { v[j] = xr[64 * j]; s += (v[j].x * v[j].x + v[j].y * v[j].y) + (v[j].z * v[j].z + v[j].w * v[j].w); }
            const float rstd = 1.f / sqrtf(wave_sum(s) * (1.f / DM) + EPS);
            u32x2* o8 = (u32x2*)(memh + (size_t)m * DM) + lane;
#pragma unroll
            for (int j = 0; j < 4; ++j) { u32x2 o; o.x = pk2(v[j].x * rstd * wv[j].x, v[j].y * rstd * wv[j].y); o.y = pk2(v[j].z * rstd * wv[j].z, v[j].w * rstd * wv[j].w); o8[64 * j] = o; }
        }
    }
    __syncthreads();
}

#define LDS3(p) ((__attribute__((address_space(3))) unsigned char*)(p))
__device__ __forceinline__ void phase1(const Params& p, unsigned char* lds) {
    unsigned char* ws = p.ws;
#ifdef PROBE_PHASE
    _Pragma("unroll 1") for (int rep = 0; rep < ((PROBE_PHASE == 101) ? 2 : 1); ++rep)
#endif
    {
        pg8::Gemm g{(const bf16_t*)p.out, (const bf16_t*)(ws + WS_WIN), NT, NPROJ, DM};
        pg8::StaticOrder S; S.init(NT, NPROJ, (int)gridDim.x, (int)blockIdx.x);
        pg8::EpiBf16 E{(bf16_t*)(ws + WS_PROJ), NPROJ, NPROJ / 256};
        pg8::gemm_phase<pg8::EpiBf16, pg8::StaticOrder, true, true>(LDS3(lds), g, S, E);
    }
    {
        pg8::Gemm g{(const bf16_t*)(ws + WS_MEMH), (const bf16_t*)(ws + WS_WKV), NMEM, 1024, DM};
        pg8::SubOrder S; S.init(NMEM, 1024, 128, (int)blockIdx.x - 128);
        pg8::EpiKV E{(bf16_t*)(ws + WS_KMEM), (bf16_t*)(ws + WS_VMEMT)};
        pg8::gemm_phase<pg8::EpiKV, pg8::SubOrder, true, true>(LDS3(lds), g, S, E);
    }
}

__device__ __forceinline__ float bfel(const u32x4& v, int ci) { const unsigned wv = (ci >> 1) == 0 ? v.x : (ci >> 1) == 1 ? v.y : (ci >> 1) == 2 ? v.z : v.w; return (ci & 1) ? bfhi(wv) : bflo(wv); }
template <bool TRANS>
__device__ __forceinline__ void conv8x8(const Params& p, int b, int c, int l0, int ch0, const float (&f)[8], u32x4 (&res)[8]) {
    const bf16_t* proj = (const bf16_t*)(p.ws + WS_PROJ);
    const float* cw = p.in[6]; const float* cb = p.in[7];
    float wgt[4][8], bias[8];
#pragma unroll
    for (int j = 0; j < 4; ++j) { const f32x4 a = *(const f32x4*)(cw + j * 1024 + ch0), b2 = *(const f32x4*)(cw + j * 1024 + ch0 + 4);
        wgt[j][0] = a.x; wgt[j][1] = a.y; wgt[j][2] = a.z; wgt[j][3] = a.w; wgt[j][4] = b2.x; wgt[j][5] = b2.y; wgt[j][6] = b2.z; wgt[j][7] = b2.w; }
    { const f32x4 a = *(const f32x4*)(cb + ch0), b2 = *(const f32x4*)(cb + ch0 + 4); bias[0] = a.x; bias[1] = a.y; bias[2] = a.z; bias[3] = a.w; bias[4] = b2.x; bias[5] = b2.y; bias[6] = b2.z; bias[7] = b2.w; }
    u32x4 in[11];
    const int t0 = c * 128 + l0 - 3;
    const bf16_t* rp = proj + ((long)(b * SEQ) + t0) * NPROJ + C_X + ch0;
    asm volatile("" : "+v"(rp));
#pragma unroll
    for (int i = 0; i < 11; ++i) {
        const int t = t0 + i;
        in[i] = (u32x4){0u, 0u, 0u, 0u};
        if (t >= 0) in[i] = *(const u32x4*)(rp + (size_t)i * NPROJ);
    }
    if (TRANS) {
#pragma unroll
        for (int ci = 0; ci < 8; ++ci) {
            float o[8];
#pragma unroll
            for (int li = 0; li < 8; ++li) { float a = bias[ci];
#pragma unroll
                for (int j = 0; j < 4; ++j) a += wgt[j][ci] * bfel(in[li + j], ci);
                o[li] = siluf(a) * f[li]; }
            res[ci] = (u32x4){pk2(o[0], o[1]), pk2(o[2], o[3]), pk2(o[4], o[5]), pk2(o[6], o[7])};
        }
    } else {
#pragma unroll
        for (int li = 0; li < 8; ++li) {
            float o[8];
#pragma unroll
            for (int ci = 0; ci < 8; ++ci) { float a = bias[ci];
#pragma unroll
                for (int j = 0; j < 4; ++j) a += wgt[j][ci] * bfel(in[li + j], ci);
                o[ci] = siluf(a) * f[li]; }
            res[li] = (u32x4){pk2(o[0], o[1]), pk2(o[2], o[3]), pk2(o[4], o[5]), pk2(o[6], o[7])};
        }
    }
}

__device__ __forceinline__ void conv2x8T(const Params& p, int b, int c, int l0, int ch0, u32x4 (&res)[2]) {
    const bf16_t* proj = (const bf16_t*)(p.ws + WS_PROJ);
    const float* cw = p.in[6]; const float* cb = p.in[7];
    float wgt[4][2], bias[2];
#pragma unroll
    for (int j = 0; j < 4; ++j) { wgt[j][0] = cw[j * 1024 + ch0]; wgt[j][1] = cw[j * 1024 + ch0 + 1]; }
    bias[0] = cb[ch0]; bias[1] = cb[ch0 + 1];
    unsigned in[11];
    const int t0 = c * 128 + l0 - 3;
    const bf16_t* rp = proj + ((long)(b * SEQ) + t0) * NPROJ + C_X + ch0;
    asm volatile("" : "+v"(rp));
#pragma unroll
    for (int i = 0; i < 11; ++i) { const int t = t0 + i; in[i] = 0u; if (t >= 0) in[i] = *(const unsigned*)(rp + (size_t)i * NPROJ); }
#pragma unroll
    for (int ci = 0; ci < 2; ++ci) {
        float o[8];
#pragma unroll
        for (int li = 0; li < 8; ++li) { float a = bias[ci];
#pragma unroll
            for (int j = 0; j < 4; ++j) a += wgt[j][ci] * (ci ? bfhi(in[li + j]) : bflo(in[li + j]));
            o[li] = siluf(a); }
        res[ci] = (u32x4){pk2(o[0], o[1]), pk2(o[2], o[3]), pk2(o[4], o[5]), pk2(o[6], o[7])};
    }
}

__device__ __forceinline__ void ssd_dt_cum(const Params& p, int b, int c, float* dts, float* cums) {
    const int tid = opaque_tid(), lane = tid & 63, w = tid >> 6;
    const float* dtraw = (const float*)(p.ws + WS_DTRAW);
    const float bias = p.in[8][w], a = -__expf(p.in[9][w]);
    const size_t row0 = (size_t)b * SEQ + c * 128;
    float x0 = dtraw[(row0 + 2 * lane) * 8 + w] + bias, x1 = dtraw[(row0 + 2 * lane + 1) * 8 + w] + bias;
    const float d0 = fmaxf(x0, 0.f) + log1pf(__expf(-fabsf(x0))), d1 = fmaxf(x1, 0.f) + log1pf(__expf(-fabsf(x1)));
    const float a0 = d0 * a, a1 = d1 * a;
    float s = a0 + a1;
#pragma unroll
    for (int o = 1; o < 64; o <<= 1) { const float t = __shfl_up(s, o); if (lane >= o) s += t; }
    dts[w * 128 + 2 * lane] = d0; dts[w * 128 + 2 * lane + 1] = d1;
    cums[w * 128 + 2 * lane] = s - a1; cums[w * 128 + 2 * lane + 1] = s;
}

__device__ __forceinline__ void phase2_attn(const Params& p, unsigned char* lds, int b, int blk) {
    const int tid = opaque_tid(), lane = tid & 63, w = tid >> 6, r = lane & 31, h = lane >> 5;
    const bf16_t* proj = (const bf16_t*)(p.ws + WS_PROJ);
    const int* positions = (const int*)p.in[2];
    float* cs = (float*)lds;
    float* sn = cs + 2048;
    float* ssq = sn + 2048;
    bf16_t* sK = (bf16_t*)(lds + 20480);
    bf16_t* sVT = sK + 256 * 72;
    bf16_t* sP = sVT + 64 * 264;
    bf16_t* sQ = sP + 8 * 32 * 40;
    bf16_t* myP = sP + w * 32 * 40;
    bf16_t* myQ = sQ + w * 32 * 64;
    const int tband0 = blk * 128 - 128;
    for (int i = tid; i < 2048; i += NTHREADS) {
        const int kb = i >> 3, f = i & 7, t = tband0 + kb;
        float c = 1.f, s = 0.f;
        if (t >= 0) { const float ang = (float)positions[b * SEQ + t] * p.inv_freq[f]; const double rev = (double)ang * 0.15915494309189535; const float fr = (float)(rev - floor(rev));
            c = __builtin_amdgcn_cosf(fr); s = __builtin_amdgcn_sinf(fr); }
        cs[i] = c; sn[i] = s;
    }
    __syncthreads();
    bf16_t* A2 = (bf16_t*)(p.ws + WS_A2);
#pragma unroll 1
    for (int g = 0; g < 2; ++g) {
        {
            const int key = tid >> 1, half = tid & 1, t = tband0 + key;
            u32x4 kv[4], vv[4];
#pragma unroll
            for (int q = 0; q < 4; ++q) { kv[q] = (u32x4){0u, 0u, 0u, 0u}; vv[q] = (u32x4){0u, 0u, 0u, 0u}; }
            if (t >= 0) {
                const bf16_t* kp = proj + (size_t)(b * SEQ + t) * NPROJ + C_K + g * 64 + half * 32;
                const bf16_t* vp = proj + (size_t)(b * SEQ + t) * NPROJ + C_V + g * 64 + half * 32;
#pragma unroll
                for (int q = 0; q < 4; ++q) { kv[q] = *(const u32x4*)(kp + 8 * q); vv[q] = *(const u32x4*)(vp + 8 * q); }
            }
            if (half == 0) {
                float x1[8], x2[8];
                x1[0] = bflo(kv[0].x); x1[1] = bfhi(kv[0].x); x1[2] = bflo(kv[0].y); x1[3] = bfhi(kv[0].y); x1[4] = bflo(kv[0].z); x1[5] = bfhi(kv[0].z); x1[6] = bflo(kv[0].w); x1[7] = bfhi(kv[0].w);
                x2[0] = bflo(kv[1].x); x2[1] = bfhi(kv[1].x); x2[2] = bflo(kv[1].y); x2[3] = bfhi(kv[1].y); x2[4] = bflo(kv[1].z); x2[5] = bfhi(kv[1].z); x2[6] = bflo(kv[1].w); x2[7] = bfhi(kv[1].w);
                float o1[8], o2[8];
#pragma unroll
                for (int f = 0; f < 8; ++f) { const float c = cs[key * 8 + f], s = sn[key * 8 + f]; o1[f] = x1[f] * c - x2[f] * s; o2[f] = x2[f] * c + x1[f] * s; }
                kv[0] = (u32x4){pk2(o1[0], o1[1]), pk2(o1[2], o1[3]), pk2(o1[4], o1[5]), pk2(o1[6], o1[7])};
                kv[1] = (u32x4){pk2(o2[0], o2[1]), pk2(o2[2], o2[3]), pk2(o2[4], o2[5]), pk2(o2[6], o2[7])};
            }
#pragma unroll
            for (int q = 0; q < 4; ++q) *(u32x4*)(sK + key * 72 + half * 32 + 8 * q) = kv[q];
#pragma unroll
            for (int q = 0; q < 4; ++q) {
                const int d0 = half * 32 + 8 * q;
                sVT[(d0 + 0) * 264 + key] = (bf16_t)(vv[q].x & 0xffffu); sVT[(d0 + 1) * 264 + key] = (bf16_t)(vv[q].x >> 16);
                sVT[(d0 + 2) * 264 + key] = (bf16_t)(vv[q].y & 0xffffu); sVT[(d0 + 3) * 264 + key] = (bf16_t)(vv[q].y >> 16);
                sVT[(d0 + 4) * 264 + key] = (bf16_t)(vv[q].z & 0xffffu); sVT[(d0 + 5) * 264 + key] = (bf16_t)(vv[q].z >> 16);
                sVT[(d0 + 6) * 264 + key] = (bf16_t)(vv[q].w & 0xffffu); sVT[(d0 + 7) * 264 + key] = (bf16_t)(vv[q].w >> 16);
            }
        }
        __syncthreads();
#pragma unroll 1
        for (int uu = 0; uu < 2; ++uu) {
            const int u = w + 8 * uu, hq = g * 4 + (u >> 2), rg = u & 3, r0 = rg * 32;
            {
                const int qr = lane >> 1, half = lane & 1, t = blk * 128 + r0 + qr;
                const bf16_t* qp = proj + (size_t)(b * SEQ + t) * NPROJ + hq * 64 + half * 32;
                u32x4 qv[4];
#pragma unroll
                for (int q = 0; q < 4; ++q) qv[q] = *(const u32x4*)(qp + 8 * q);
                if (half == 0) {
                    float x1[8], x2[8];
                    x1[0] = bflo(qv[0].x); x1[1] = bfhi(qv[0].x); x1[2] = bflo(qv[0].y); x1[3] = bfhi(qv[0].y); x1[4] = bflo(qv[0].z); x1[5] = bfhi(qv[0].z); x1[6] = bflo(qv[0].w); x1[7] = bfhi(qv[0].w);
                    x2[0] = bflo(qv[1].x); x2[1] = bfhi(qv[1].x); x2[2] = bflo(qv[1].y); x2[3] = bfhi(qv[1].y); x2[4] = bflo(qv[1].z); x2[5] = bfhi(qv[1].z); x2[6] = bflo(qv[1].w); x2[7] = bfhi(qv[1].w);
                    float o1[8], o2[8];
                    const int kb = 128 + r0 + qr;
#pragma unroll
                    for (int f = 0; f < 8; ++f) { const float c = cs[kb * 8 + f], s = sn[kb * 8 + f]; o1[f] = x1[f] * c - x2[f] * s; o2[f] = x2[f] * c + x1[f] * s; }
                    qv[0] = (u32x4){pk2(o1[0], o1[1]), pk2(o1[2], o1[3]), pk2(o1[4], o1[5]), pk2(o1[6], o1[7])};
                    qv[1] = (u32x4){pk2(o2[0], o2[1]), pk2(o2[2], o2[3]), pk2(o2[4], o2[5]), pk2(o2[6], o2[7])};
                }
#pragma unroll
                for (int q = 0; q < 4; ++q) *(u32x4*)(myQ + qr * 64 + half * 32 + 8 * q) = qv[q];
            }
            LDS_WAIT();
            f32x16 S[5];
#pragma unroll
            for (int jt = 0; jt < 5; ++jt) S[jt] = zero16();
#pragma unroll
            for (int kk = 0; kk < 64; kk += 16) {
                const bf16x8 a = *(const bf16x8*)(myQ + r * 64 + kk + 8 * h);
#pragma unroll
                for (int jt = 0; jt < 5; ++jt) { const bf16x8 bb = *(const bf16x8*)(sK + ((rg + jt) * 32 + r) * 72 + kk + 8 * h); S[jt] = mfma32(a, bb, S[jt]); }
            }
            const float sink = p.in[5][hq];
            float sm[16];
#pragma unroll
            for (int i = 0; i < 16; ++i) {
                const int qb = 128 + r0 + crow(i, h);
                float m = -INFINITY;
#pragma unroll
                for (int jt = 0; jt < 5; ++jt) { const int kbx = (rg + jt) * 32 + r; const int rel = qb - kbx; const bool ok = (rel >= 0) && (rel < 128) && (tband0 + kbx >= 0);
                    const float v = ok ? S[jt][i] * 0.125f : -INFINITY; S[jt][i] = v; m = fmaxf(m, v); }
#pragma unroll
                for (int o = 16; o >= 1; o >>= 1) m = fmaxf(m, __shfl_xor(m, o));
                m = fmaxf(m, sink);
                float s = 0.f;
#pragma unroll
                for (int jt = 0; jt < 5; ++jt) { const float e = __expf(S[jt][i] - m); S[jt][i] = e; s += e; }
#pragma unroll
                for (int o = 16; o >= 1; o >>= 1) s += __shfl_xor(s, o);
                sm[i] = s + __expf(sink - m);
            }
            f32x16 O0 = zero16(), O1 = zero16();
#pragma unroll
            for (int jt = 0; jt < 5; ++jt) {
#pragma unroll
                for (int i = 0; i < 16; ++i) myP[crow(i, h) * 40 + r] = (bf16_t)f2bf(S[jt][i]);
                LDS_WAIT();
#pragma unroll
                for (int kk = 0; kk < 32; kk += 16) {
                    const bf16x8 a = *(const bf16x8*)(myP + r * 40 + kk + 8 * h);
                    const bf16x8 b0 = *(const bf16x8*)(sVT + r * 264 + (rg + jt) * 32 + kk + 8 * h);
                    const bf16x8 b1 = *(const bf16x8*)(sVT + (32 + r) * 264 + (rg + jt) * 32 + kk + 8 * h);
                    O0 = mfma32(a, b0, O0); O1 = mfma32(a, b1, O1);
                }
                LDS_WAIT();
            }
            int qlb = r0 + 4 * h;
            asm volatile("" : "+v"(qlb));
            bf16_t* opb = A2 + (size_t)(b * SEQ + blk * 128 + qlb) * 1024 + hq * 64 + r;
#pragma unroll
            for (int i = 0; i < 16; ++i) {
                const int dl = (i & 3) + 8 * (i >> 2);
                const int ql = qlb + dl;
                const float inv = 1.f / sm[i];
                const unsigned h0 = f2bf(O0[i] * inv), h1 = f2bf(O1[i] * inv);
                opb[dl * 1024] = (bf16_t)h0; opb[dl * 1024 + 32] = (bf16_t)h1;
                const float v0 = bf2f(h0), v1 = bf2f(h1);
                float q = v0 * v0 + v1 * v1;
#pragma unroll
                for (int o = 16; o >= 1; o >>= 1) q += __shfl_xor(q, o);
                if (r == 0) ssq[ql * 8 + hq] = q;
            }
        }
        __syncthreads();
    }
    {
        const float* wa = p.in[11];
        for (int i = tid; i < 128 * 64; i += NTHREADS) {
            const int ql = i >> 6, c8 = (i & 63) * 8;
            float s = 0.f;
#pragma unroll
            for (int q = 0; q < 8; ++q) s += ssq[ql * 8 + q];
            const float rstd = 1.f / sqrtf(s * (1.f / 512.f) + EPS);
            const size_t row = (size_t)b * SEQ + blk * 128 + ql;
            const u32x4 t = *(const u32x4*)(A2 + row * 1024 + c8);
            const f32x4 w0 = *(const f32x4*)(wa + c8), w1 = *(const f32x4*)(wa + c8 + 4);
            u32x4 o; o.x = pk2(bflo(t.x) * rstd * w0.x, bfhi(t.x) * rstd * w0.y); o.y = pk2(bflo(t.y) * rstd * w0.z, bfhi(t.y) * rstd * w0.w); o.z = pk2(bflo(t.z) * rstd * w1.x, bfhi(t.z) * rstd * w1.y); o.w = pk2(bflo(t.w) * rstd * w1.z, bfhi(t.w) * rstd * w1.w);
            *(u32x4*)(A2 + row * 1024 + c8) = o;
        }
    }
    __syncthreads();
}

__device__ __forceinline__ void phase2_states(const Params& p, unsigned char* lds, int b, int c) {
    const int tid = opaque_tid(), lane = tid & 63, w = tid >> 6, r = lane & 31, h = lane >> 5;
    float* dts = (float*)lds;
    float* cums = dts + 1024;
    bf16_t* sBT = (bf16_t*)(lds + 8192);
    bf16_t* sXT = sBT + 128 * 136;
    ssd_dt_cum(p, b, c, dts, cums);
    __syncthreads();
    bf16_t* states = (bf16_t*)(p.ws + WS_START);
    if (tid < 8) ((float*)(p.ws + WS_CDEC))[(b * NCH + c) * 8 + tid] = __expf(cums[tid * 128 + 127]);
#pragma unroll 1
    for (int g = 0; g < 2; ++g) {
        if (tid < 256) {
            const int cg8 = tid & 15, lr = tid >> 4;
            const float one[8] = {1.f, 1.f, 1.f, 1.f, 1.f, 1.f, 1.f, 1.f};
            u32x4 res[8];
            conv8x8<true>(p, b, c, lr * 8, 512 + g * 128 + cg8 * 8, one, res);
#pragma unroll
            for (int ci = 0; ci < 8; ++ci) *(u32x4*)(sBT + (cg8 * 8 + ci) * 136 + lr * 8) = res[ci];
        }
        {
            const int cg8 = tid & 31, lr = tid >> 5, hh = cg8 >> 3, hd = g * 4 + hh;
            float f[8];
            const float cl = cums[hd * 128 + 127];
#pragma unroll
            for (int li = 0; li < 8; ++li) f[li] = dts[hd * 128 + lr * 8 + li] * __expf(cl - cums[hd * 128 + lr * 8 + li]);
            u32x4 res[8];
            conv8x8<true>(p, b, c, lr * 8, g * 256 + cg8 * 8, f, res);
#pragma unroll
            for (int ci = 0; ci < 8; ++ci) *(u32x4*)(sXT + (cg8 * 8 + ci) * 136 + lr * 8) = res[ci];
        }
        __syncthreads();
        {
            f32x16 acc[4];
#pragma unroll
            for (int j = 0; j < 4; ++j) acc[j] = zero16();
#pragma unroll
            for (int kk = 0; kk < 128; kk += 16) {
                const bf16x8 a = *(const bf16x8*)(sXT + (w * 32 + r) * 136 + kk + 8 * h);
#pragma unroll
                for (int j = 0; j < 4; ++j) { const bf16x8 bb = *(const bf16x8*)(sBT + (j * 32 + r) * 136 + kk + 8 * h); acc[j] = mfma32(a, bb, acc[j]); }
            }
            const int hd = g * 4 + (w >> 1), p0 = (w & 1) * 32;
            bf16_t* sp = states + ((size_t)((b * NCH + c) * 8 + hd) * 64) * 128;
#pragma unroll
            for (int j = 0; j < 4; ++j)
#pragma unroll
                for (int i = 0; i < 16; ++i) sp[(size_t)(p0 + crow(i, h)) * 128 + j * 32 + r] = (bf16_t)f2bf(acc[j][i]);
        }
        __syncthreads();
    }
}

__device__ __forceinline__ void phase3(const Params& p) {
    const float* cdec = (const float*)(p.ws + WS_CDEC);
    bf16_t* start = (bf16_t*)(p.ws + WS_START);
    for (int u = blockIdx.x * NTHREADS + threadIdx.x; u < 131072; u += gridDim.x * NTHREADS) {
        const int n4 = u & 31, pp = (u >> 5) & 63, hd = (u >> 11) & 7, b = u >> 14;
        f32x4 s = (f32x4){0.f, 0.f, 0.f, 0.f};
        for (int c = 0; c < NCH; ++c) {
            const size_t off = ((size_t)((b * NCH + c) * 8 + hd) * 64 + pp) * 128 + n4 * 4;
            const u32x2 t = *(const u32x2*)(start + off);
            u32x2 o; o.x = pk2(s.x, s.y); o.y = pk2(s.z, s.w);
            *(u32x2*)(start + off) = o;
            const f32x4 st = (f32x4){bflo(t.x), bfhi(t.x), bflo(t.y), bfhi(t.y)};
            const float d = cdec[(b * NCH + c) * 8 + hd];
            s = s * d + st;
        }
    }
}

__device__ __forceinline__ void phase4(const Params& p, unsigned char* lds, int b, int c) {
    const int tid = opaque_tid(), lane = tid & 63, w = tid >> 6, r = lane & 31, h = lane >> 5;
    float* dts = (float*)lds;
    float* cums = dts + 1024;
    float* gsq = cums + 1024;
    bf16_t* sC = (bf16_t*)(lds + 12288);
    bf16_t* sB = sC + 128 * 136;
    bf16_t* sM = sB + 128 * 136;
    bf16_t* sXT = sM + 128 * 136;
    const bf16_t* proj = (const bf16_t*)(p.ws + WS_PROJ);
    const bf16_t* start = (const bf16_t*)(p.ws + WS_START);
    bf16_t* A2 = (bf16_t*)(p.ws + WS_A2);
    ssd_dt_cum(p, b, c, dts, cums);
    __syncthreads();
    const size_t row0 = (size_t)b * SEQ + c * 128;
#pragma unroll 1
    for (int g = 0; g < 2; ++g) {
        {
            const int which = tid >> 8, cg8 = tid & 15, lr = (tid >> 4) & 15;
            const float one[8] = {1.f, 1.f, 1.f, 1.f, 1.f, 1.f, 1.f, 1.f};
            u32x4 res[8];
            conv8x8<false>(p, b, c, lr * 8, (which ? 768 : 512) + g * 128 + cg8 * 8, one, res);
            bf16_t* dst = which ? sC : sB;
#pragma unroll
            for (int li = 0; li < 8; ++li) *(u32x4*)(dst + (lr * 8 + li) * 136 + cg8 * 8) = res[li];
        }
        __syncthreads();
        f32x16 cb0 = zero16(), cb1 = zero16();
        const int lt = w >> 1, st0 = 2 * (w & 1);
#pragma unroll 2
        for (int kk = 0; kk < 128; kk += 16) {
            const bf16x8 a = *(const bf16x8*)(sC + (lt * 32 + r) * 136 + kk + 8 * h);
            const bf16x8 b0 = *(const bf16x8*)(sB + (st0 * 32 + r) * 136 + kk + 8 * h);
            const bf16x8 b1 = *(const bf16x8*)(sB + ((st0 + 1) * 32 + r) * 136 + kk + 8 * h);
            cb0 = mfma32(a, b0, cb0); cb1 = mfma32(a, b1, cb1);
        }
#pragma unroll 1
        for (int hh = 0; hh < 4; ++hh) {
            const int hd = g * 4 + hh;
#pragma unroll
            for (int i = 0; i < 16; ++i) {
                const int l = lt * 32 + crow(i, h);
                const float cl = cums[hd * 128 + l];
                { const int s = st0 * 32 + r; const float v = (s <= l) ? cb0[i] * __expf(cl - cums[hd * 128 + s]) * dts[hd * 128 + s] : 0.f; sM[l * 136 + s] = (bf16_t)f2bf(v); }
                { const int s = (st0 + 1) * 32 + r; const float v = (s <= l) ? cb1[i] * __expf(cl - cums[hd * 128 + s]) * dts[hd * 128 + s] : 0.f; sM[l * 136 + s] = (bf16_t)f2bf(v); }
            }
            __builtin_amdgcn_sched_barrier(0);
            {
                const int cp = tid & 31, lr = tid >> 5;
                u32x4 res[2];
                conv2x8T(p, b, c, lr * 8, hd * 64 + cp * 2, res);
                *(u32x4*)(sXT + (cp * 2) * 136 + lr * 8) = res[0];
                *(u32x4*)(sXT + (cp * 2 + 1) * 136 + lr * 8) = res[1];
            }
            __syncthreads();
            {
                const int lt2 = w >> 1, pt = w & 1;
                f32x16 yd = zero16(), yo = zero16();
#pragma unroll 2
                for (int kk = 0; kk < 128; kk += 16) {
                    const bf16x8 a = *(const bf16x8*)(sM + (lt2 * 32 + r) * 136 + kk + 8 * h);
                    const bf16x8 bb = *(const bf16x8*)(sXT + (pt * 32 + r) * 136 + kk + 8 * h);
                    yd = mfma32(a, bb, yd);
                }
                const bf16_t* stp = start + ((size_t)((b * NCH + c) * 8 + hd) * 64 + pt * 32 + r) * 128;
#pragma unroll 2
                for (int kk = 0; kk < 128; kk += 16) {
                    const bf16x8 a = *(const bf16x8*)(sC + (lt2 * 32 + r) * 136 + kk + 8 * h);
                    const bf16x8 bb = *(const bf16x8*)(stp + kk + 8 * h);
                    yo = mfma32(a, bb, yo);
                }
                const float dsk = p.in[10][hd];
                const int pcol = pt * 32 + r;
                int lb = lt2 * 32 + 4 * h;
                asm volatile("" : "+v"(lb));
                const bf16_t* zp = proj + (row0 + lb) * NPROJ + C_Z + hd * 64 + pcol;
                bf16_t* gp = A2 + (row0 + lb) * 1024 + 512 + hd * 64 + pcol;
#pragma unroll
                for (int i = 0; i < 16; ++i) {
                    const int dl = (i & 3) + 8 * (i >> 2);
                    const int l = lb + dl;
                    const float xs = bf2f((unsigned)sXT[pcol * 136 + l]);
                    const float y = yd[i] + __expf(cums[hd * 128 + l]) * yo[i] + dsk * xs;
                    const float z = bf2f((unsigned)zp[(size_t)dl * NPROJ]);
                    const unsigned gh = f2bf(y * siluf(z));
                    gp[dl * 1024] = (bf16_t)gh;
                    const float gv = bf2f(gh);
                    float q = gv * gv;
#pragma unroll
                    for (int o = 16; o >= 1; o >>= 1) q += __shfl_xor(q, o);
                    if (r == 0) gsq[l * 8 + hh * 2 + pt] = q;
                }
            }
            __syncthreads();
        }
        {
            const float* wsn = p.in[12];
            for (int i = tid; i < 128 * 32; i += NTHREADS) {
                const int l = i >> 5, c8 = (i & 31) * 8;
                float s = 0.f;
#pragma unroll
                for (int q = 0; q < 8; ++q) s += gsq[l * 8 + q];
                const float rstd = 1.f / sqrtf(s * (1.f / 256.f) + EPS);
                const u32x4 t = *(const u32x4*)(A2 + (row0 + l) * 1024 + 512 + g * 256 + c8);
                const f32x4 w0 = *(const f32x4*)(wsn + g * 256 + c8), w1 = *(const f32x4*)(wsn + g * 256 + c8 + 4);
                u32x4 o; o.x = pk2(bflo(t.x) * rstd * w0.x, bfhi(t.x) * rstd * w0.y); o.y = pk2(bflo(t.y) * rstd * w0.z, bfhi(t.y) * rstd * w0.w); o.z = pk2(bflo(t.z) * rstd * w1.x, bfhi(t.z) * rstd * w1.y); o.w = pk2(bflo(t.w) * rstd * w1.z, bfhi(t.w) * rstd * w1.w);
                *(u32x4*)(A2 + (row0 + l) * 1024 + 512 + g * 256 + c8) = o;
            }
        }
        __syncthreads();
    }
}

__device__ __forceinline__ void phase5(const Params& p, unsigned char* lds) {
    unsigned char* ws = p.ws;
    pg8::Gemm g{(const bf16_t*)(ws + WS_A2), (const bf16_t*)(ws + WS_WOUT), NT, DM, DM};
    pg8::StaticOrder S; S.init(NT, DM, (int)gridDim.x, (int)blockIdx.x);
    pg8::EpiResid<true, true> E{p.in[0], (bf16_t*)(ws + WS_XB), (float*)(ws + WS_SSQ)};
    pg8::gemm_phase<pg8::EpiResid<true, true>, pg8::StaticOrder, true, true>(LDS3(lds), g, S, E);
}
__device__ __forceinline__ void phase6(const Params& p, unsigned char* lds) {
    unsigned char* ws = p.ws;
    pg8::Gemm g{(const bf16_t*)(ws + WS_XB), (const bf16_t*)(ws + WS_WQ), NT, 512, DM};
    pg8::StaticOrder S; S.init(NT, 512, (int)gridDim.x, (int)blockIdx.x);
    pg8::EpiQ E{(bf16_t*)(ws + WS_Q2), (const float*)(ws + WS_SSQ)};
    pg8::gemm_phase<pg8::EpiQ, pg8::StaticOrder, true, true>(LDS3(lds), g, S, E);
}
__device__ __forceinline__ void phase8(const Params& p, unsigned char* lds) {
    unsigned char* ws = p.ws;
    pg8::Gemm g{(const bf16_t*)(ws + WS_XO), (const bf16_t*)(ws + WS_WO), NT, DM, 512};
    pg8::StaticOrder S; S.init(NT, DM, (int)gridDim.x, (int)blockIdx.x);
    pg8::EpiResid<false, false> E{(const void*)(ws + WS_XB), (bf16_t*)(ws + WS_XB), nullptr};
    pg8::gemm_phase<pg8::EpiResid<false, false>, pg8::StaticOrder, true, true>(LDS3(lds), g, S, E);
}

__device__ __forceinline__ void phase7(const Params& p, unsigned char* lds) {
    const int tid = opaque_tid(), lane = tid & 63, w = tid >> 6, r = lane & 31, h = lane >> 5;
    const bf16_t* q2 = (const bf16_t*)(p.ws + WS_Q2); const bf16_t* kmem = (const bf16_t*)(p.ws + WS_KMEM); const bf16_t* vmemT = (const bf16_t*)(p.ws + WS_VMEMT);
    bf16_t* xo = (bf16_t*)(p.ws + WS_XO);
    bf16_t* myP = (bf16_t*)lds + w * 32 * 264;
    const float scale = 0.08838834764831845f;
    for (int it = blockIdx.x; it < 512; it += gridDim.x) {
        const int rb = it >> 2, hx = it & 3, b = rb >> 4;
        const size_t row0 = (size_t)rb * 256 + w * 32;
        f32x16 S[8];
#pragma unroll
        for (int j = 0; j < 8; ++j) S[j] = zero16();
        const bf16_t* qp = q2 + (row0 + r) * 512 + hx * 128 + 8 * h;
        const bf16_t* kp = kmem + ((size_t)b * 256 + r) * 512 + hx * 128 + 8 * h;
#pragma unroll
        for (int kk = 0; kk < 128; kk += 16) {
            const bf16x8 a = *(const bf16x8*)(qp + kk);
#pragma unroll
            for (int j = 0; j < 8; ++j) { const bf16x8 bb = *(const bf16x8*)(kp + (size_t)j * 32 * 512 + kk); S[j] = mfma32(a, bb, S[j]); }
        }
        float inv[16];
#pragma unroll
        for (int i = 0; i < 16; ++i) {
            float m = -INFINITY;
#pragma unroll
            for (int j = 0; j < 8; ++j) { const float v = S[j][i] * scale; S[j][i] = v; m = fmaxf(m, v); }
#pragma unroll
            for (int o = 16; o >= 1; o >>= 1) m = fmaxf(m, __shfl_xor(m, o));
            float s = 0.f;
#pragma unroll
            for (int j = 0; j < 8; ++j) { const float e = __expf(S[j][i] - m); S[j][i] = e; s += e; }
#pragma unroll
            for (int o = 16; o >= 1; o >>= 1) s += __shfl_xor(s, o);
            inv[i] = 1.f / s;
        }
#pragma unroll
        for (int j = 0; j < 8; ++j)
#pragma unroll
            for (int i = 0; i < 16; ++i) myP[crow(i, h) * 264 + j * 32 + r] = (bf16_t)f2bf(S[j][i]);
        LDS_WAIT();
        f32x16 O[4];
#pragma unroll
        for (int j = 0; j < 4; ++j) O[j] = zero16();
        const bf16_t* vp = vmemT + (((size_t)b * 4 + hx) * 128 + r) * 256 + 8 * h;
#pragma unroll
        for (int kk = 0; kk < 256; kk += 16) {
            const bf16x8 a = *(const bf16x8*)(myP + r * 264 + kk + 8 * h);
#pragma unroll
            for (int j = 0; j < 4; ++j) { const bf16x8 bb = *(const bf16x8*)(vp + (size_t)j * 32 * 256 + kk); O[j] = mfma32(a, bb, O[j]); }
        }
#pragma unroll
        for (int j = 0; j < 4; ++j)
#pragma unroll
            for (int i = 0; i < 16; ++i) xo[(row0 + crow(i, h)) * 512 + hx * 128 + j * 32 + r] = (bf16_t)f2bf(O[j][i] * inv[i]);
        LDS_WAIT();
    }
}

__device__ __forceinline__ void phase9(const Params& p) {
    const int tid = opaque_tid(), lane = tid & 63, w = tid >> 6;
    const int gw = blockIdx.x * NWAVES + w, NGW = gridDim.x * NWAVES;
    const bf16_t* x2 = (const bf16_t*)(p.ws + WS_XB);
    const float* WR = (const float*)(p.ws + WS_WR);
    int* cnt = (int*)(p.ws + WS_CTL);
    int* list = (int*)(p.ws + WS_LIST);
    float* route = (float*)(p.ws + WS_ROUTE);
    const float* bg = p.in[21]; const float* be = p.in[23];
    for (int m = gw; m < NT; m += NGW) {
        const u32x2* xr = (const u32x2*)(x2 + (size_t)m * DM) + lane;
        f32x4 v[4]; float s = 0.f;
#pragma unroll
        for (int j = 0; j < 4; ++j) { const u32x2 t = xr[64 * j]; v[j] = (f32x4){bflo(t.x), bfhi(t.x), bflo(t.y), bfhi(t.y)}; s += (v[j].x * v[j].x + v[j].y * v[j].y) + (v[j].z * v[j].z + v[j].w * v[j].w); }
        const float rstd = 1.f / sqrtf(wave_sum(s) * (1.f / DM) + EPS);
        float mine = 0.f;
#ifdef PROBE_PHASE
        if (PROBE_PHASE == 9) {
#pragma unroll 4
        for (int n = 0; n < 36; ++n) {
            float a = 0.f;
#pragma unroll
            for (int j = 0; j < 4; ++j) { const f32x4 ww = *(const f32x4*)(WR + n * 1024 + 4 * lane + 256 * j); a += (v[j].x * ww.x + v[j].y * ww.y) + (v[j].z * ww.z + v[j].w * ww.w); }
            a = wave_sum(a) * rstd;
            if (lane == n) mine = a;
        }
        asm volatile("" : "+v"(mine));
        mine = 0.f;
        }
#endif
#pragma unroll 4
        for (int n = 0; n < 36; ++n) {
            float a = 0.f;
#pragma unroll
            for (int j = 0; j < 4; ++j) { const f32x4 ww = *(const f32x4*)(WR + n * 1024 + 4 * lane + 256 * j); a += (v[j].x * ww.x + v[j].y * ww.y) + (v[j].z * ww.z + v[j].w * ww.w); }
            a = wave_sum(a) * rstd;
            if (lane == n) mine = a;
        }
        if (lane < 4) mine += bg[lane]; else if (lane < 36) mine += be[lane - 4];
        const float g0 = __shfl(mine, 0), g1 = __shfl(mine, 1), g2 = __shfl(mine, 2), g3 = __shfl(mine, 3);
        int gi = 0; float gm = g0;
        if (g1 > gm) { gm = g1; gi = 1; }
        if (g2 > gm) { gm = g2; gi = 2; }
        if (g3 > gm) { gm = g3; gi = 3; }
        const float gden = __expf(g0 - gm) + __expf(g1 - gm) + __expf(g2 - gm) + __expf(g3 - gm);
        const float ggate = 1.f / gden;
        float ev[8];
#pragma unroll
        for (int j = 0; j < 8; ++j) ev[j] = __shfl(mine, 4 + gi * 8 + j);
        int i1 = 0; float v1 = ev[0];
#pragma unroll
        for (int j = 1; j < 8; ++j) if (ev[j] > v1) { v1 = ev[j]; i1 = j; }
        int i2 = -1; float v2 = -INFINITY;
#pragma unroll
        for (int j = 0; j < 8; ++j) if (j != i1 && ev[j] > v2) { v2 = ev[j]; i2 = j; }
        const float e2 = __expf(v2 - v1);
        const float w1 = ggate / (1.f + e2), w2 = ggate * e2 / (1.f + e2);
        if (lane == 0) {
            const int ea = gi * 8 + i1, eb = gi * 8 + i2;
            const int pa = atomicAdd(cnt + ea, 1), pb = atomicAdd(cnt + eb, 1);
            list[ea * NT + pa] = m; list[eb * NT + pb] = m;
            int* ri = (int*)(route + (size_t)m * 8);
            ri[0] = ea; ri[1] = eb; ri[2] = pa; ri[3] = pb;
            route[(size_t)m * 8 + 4] = w1; route[(size_t)m * 8 + 5] = w2; route[(size_t)m * 8 + 6] = rstd; route[(size_t)m * 8 + 7] = 0.f;
        }
    }
}

__device__ __forceinline__ int* moe_tables(const Params& p, unsigned char* lds) {
    int* off = (int*)(lds + 131072);
    const int* cnt = (const int*)(p.ws + WS_CTL);
    if (threadIdx.x == 0) { int a = 0; for (int e = 0; e < NEXP; ++e) { off[e] = a; a += ((cnt[e] + 255) >> 8) << 8; } off[NEXP] = a; }
    if (threadIdx.x < NEXP) off[40 + threadIdx.x] = cnt[threadIdx.x];
    __syncthreads();
    const int nrt = off[NEXP] >> 8;
    for (int rt = threadIdx.x; rt < nrt; rt += NTHREADS) { int e = 0; for (int q = 1; q < NEXP; ++q) if (off[q] <= rt * 256) e = q; off[128 + rt] = e; }
    __syncthreads();
    return off;
}

__device__ __forceinline__ void phase10(const Params& p, unsigned char* lds) {
    const int tid = opaque_tid(), lane = tid & 63, w = tid >> 6;
    const int* off = moe_tables(p, lds);
    const int gw = blockIdx.x * NWAVES + w, NGW = gridDim.x * NWAVES;
    const bf16_t* x2 = (const bf16_t*)(p.ws + WS_XB); const float* route = (const float*)(p.ws + WS_ROUTE);
    bf16_t* xg = (bf16_t*)(p.ws + WS_XG);
    for (int m = gw; m < NT; m += NGW) {
        const int* ri = (const int*)(route + (size_t)m * 8);
        const int ea = ri[0], eb = ri[1], pa = ri[2], pb = ri[3];
        const float rs = route[(size_t)m * 8 + 6];
        const size_t sa = (size_t)off[ea] + pa, sb = (size_t)off[eb] + pb;
        const u32x2* xr = (const u32x2*)(x2 + (size_t)m * DM) + lane;
        u32x2* oa = (u32x2*)(xg + sa * DM) + lane; u32x2* ob = (u32x2*)(xg + sb * DM) + lane;
#pragma unroll
        for (int j = 0; j < 4; ++j) { const u32x2 t = xr[64 * j]; u32x2 o; o.x = pk2(bflo(t.x) * rs, bfhi(t.x) * rs); o.y = pk2(bflo(t.y) * rs, bfhi(t.y) * rs); oa[64 * j] = o; ob[64 * j] = o; }
    }
}

__device__ __forceinline__ void phase11(const Params& p, unsigned char* lds) {
    const int* off = moe_tables(p, lds);
    pg8::Gemm g{(const bf16_t*)(p.ws + WS_XG), (const bf16_t*)(p.ws + WS_WGU), 0, 0, DM};
    pg8::MoeOrder S{(const __attribute__((address_space(3))) int*)(off + 128), off[NEXP] >> 8, 2, (int)gridDim.x, (int)blockIdx.x};
    pg8::EpiGU E{(bf16_t*)(p.ws + WS_HID)};
    pg8::gemm_phase<pg8::EpiGU, pg8::MoeOrder, true, true>(LDS3(lds), g, S, E);
}
__device__ __forceinline__ void phase12(const Params& p, unsigned char* lds) {
    const int* off = moe_tables(p, lds);
    int kdim = EFF; asm volatile("" : "+s"(kdim));
    pg8::Gemm g{(const bf16_t*)(p.ws + WS_HID), (const bf16_t*)(p.ws + WS_WD), 0, 0, kdim};
    pg8::MoeOrder S{(const __attribute__((address_space(3))) int*)(off + 128), off[NEXP] >> 8, 4, (int)gridDim.x, (int)blockIdx.x};
    pg8::EpiBf16 E{(bf16_t*)(p.ws + WS_Y), DM, 4};
    pg8::gemm_phase<pg8::EpiBf16, pg8::MoeOrder, true, true>(LDS3(lds), g, S, E);
}

__device__ __forceinline__ void phase13(const Params& p, unsigned char* lds) {
    const int tid = opaque_tid(), lane = tid & 63, w = tid >> 6;
    const int* off = moe_tables(p, lds);
    const int gw = blockIdx.x * NWAVES + w, NGW = gridDim.x * NWAVES;
    const bf16_t* x2 = (const bf16_t*)(p.ws + WS_XB); const bf16_t* yb = (const bf16_t*)(p.ws + WS_Y);
    const float* route = (const float*)(p.ws + WS_ROUTE); const float* wf = p.in[27];
    f32x4 wv[4];
#pragma unroll
    for (int j = 0; j < 4; ++j) wv[j] = *(const f32x4*)(wf + 4 * lane + 256 * j);
    for (int m = gw; m < NT; m += NGW) {
        const int* ri = (const int*)(route + (size_t)m * 8);
        const int ea = ri[0], eb = ri[1], pa = ri[2], pb = ri[3];
        const float w1 = route[(size_t)m * 8 + 4], w2 = route[(size_t)m * 8 + 5];
        const size_t sa = (size_t)off[ea] + pa, sb = (size_t)off[eb] + pb;
        const u32x2* xr = (const u32x2*)(x2 + (size_t)m * DM) + lane;
        const u32x2* ya = (const u32x2*)(yb + sa * DM) + lane; const u32x2* ybp = (const u32x2*)(yb + sb * DM) + lane;
        f32x4 v[4]; float s = 0.f;
#pragma unroll
        for (int j = 0; j < 4; ++j) {
            const u32x2 t = xr[64 * j]; v[j] = (f32x4){bflo(t.x), bfhi(t.x), bflo(t.y), bfhi(t.y)}; const u32x2 a = ya[64 * j], bq = ybp[64 * j];
            v[j].x += w1 * bflo(a.x) + w2 * bflo(bq.x); v[j].y += w1 * bfhi(a.x) + w2 * bfhi(bq.x);
            v[j].z += w1 * bflo(a.y) + w2 * bflo(bq.y); v[j].w += w1 * bfhi(a.y) + w2 * bfhi(bq.y);
            s += (v[j].x * v[j].x + v[j].y * v[j].y) + (v[j].z * v[j].z + v[j].w * v[j].w);
        }
        const float rstd = 1.f / sqrtf(wave_sum(s) * (1.f / DM) + EPS);
        f32x4* o = (f32x4*)(p.out + (size_t)m * DM) + lane;
#pragma unroll
        for (int j = 0; j < 4; ++j) o[64 * j] = v[j] * rstd * wv[j];
    }
}

constexpr int NPHASE = 14;
__global__ void __launch_bounds__(NTHREADS, 2) fwd_kernel(Params p) {
    extern __shared__ __attribute__((aligned(16))) unsigned char lds[];
#if MK_ONE_LAUNCH
    cg::grid_group grid = cg::this_grid();
    volatile LAS unsigned* bst = (volatile LAS unsigned*)(LDS3(lds) + LDS_BYTES - 16);
    if (threadIdx.x < 2) bst[threadIdx.x] = 0u;
    __syncthreads();
    const XcdBarrier xbar = xcd_barrier_post((unsigned*)(p.ws + WS_BAR), bst);
#define SEAM(k) do { if (p.ph_lo <= (k) && (k) + 1 < p.ph_hi) { if ((k) == 0) grid.sync(); else xcd_barrier(xbar); } } while (0)
#else
#define SEAM(k) do { } while (0)
#endif
#ifndef PROBE_PHASE
#define PROBE_PHASE -1
#endif
#define IN(k) (p.ph_lo <= (k) && (k) < p.ph_hi)
#define REPS(k) (((k) == PROBE_PHASE) ? 2 : 1)
    if (IN(0)) { _Pragma("unroll 1") for (int rep = 0; rep < REPS(0); ++rep) { phase0(p, lds); } } SEAM(0);
    if (IN(1)) { _Pragma("unroll 1") for (int rep = 0; rep < REPS(1); ++rep) { phase1(p, lds); } } SEAM(1);
    if (IN(2)) { _Pragma("unroll 1") for (int rep = 0; rep < REPS(2); ++rep) for (int it = blockIdx.x; it < NB * NCH; it += gridDim.x) { const int b = it / NCH, c = it % NCH; phase2_attn(p, lds, b, c); phase2_states(p, lds, b, c); } } SEAM(2);
    if (IN(3)) { _Pragma("unroll 1") for (int rep = 0; rep < REPS(3); ++rep) { phase3(p); } } SEAM(3);
    if (IN(4)) { _Pragma("unroll 1") for (int rep = 0; rep < REPS(4); ++rep) for (int it = blockIdx.x; it < NB * NCH; it += gridDim.x) { const int b = it / NCH, c = it % NCH; phase4(p, lds, b, c); } } SEAM(4);
    if (IN(5)) { _Pragma("unroll 1") for (int rep = 0; rep < REPS(5); ++rep) { phase5(p, lds); } } SEAM(5);
    if (IN(6)) { _Pragma("unroll 1") for (int rep = 0; rep < REPS(6); ++rep) { phase6(p, lds); } } SEAM(6);
    if (IN(7)) { _Pragma("unroll 1") for (int rep = 0; rep < REPS(7); ++rep) { phase7(p, lds); } } SEAM(7);
    if (IN(8)) { phase8(p, lds); } SEAM(8);
    if (IN(9)) { phase9(p); } SEAM(9);
    if (IN(10)) { _Pragma("unroll 1") for (int rep = 0; rep < REPS(10); ++rep) { phase10(p, lds); } } SEAM(10);
    if (IN(11)) { _Pragma("unroll 1") for (int rep = 0; rep < REPS(11); ++rep) { phase11(p, lds); } } SEAM(11);
    if (IN(12)) { _Pragma("unroll 1") for (int rep = 0; rep < REPS(12); ++rep) { phase12(p, lds); } } SEAM(12);
    if (IN(13)) { _Pragma("unroll 1") for (int rep = 0; rep < REPS(13); ++rep) { phase13(p, lds); } }
#undef IN
#undef SEAM
}

extern "C" void kernel_launch(void* const* d_in, const int* in_sizes, int n_in, void* d_out, int out_size, void* d_ws, size_t ws_size, hipStream_t stream) {
    static int grid = 0;
    if (grid == 0) {
        if (n_in != 28 || out_size != NT * DM || ws_size < WS_NEED) { fprintf(stderr, "kernel_launch: unexpected sizes n_in %d out %d ws %zu\n", n_in, out_size, ws_size); grid = -1; return; }
        int dev = 0, cus = 0, per_cu = 0;
        hipGetDevice(&dev);
        hipDeviceGetAttribute(&cus, hipDeviceAttributeMultiprocessorCount, dev);
        if (hipFuncSetAttribute((const void*)fwd_kernel, hipFuncAttributeMaxDynamicSharedMemorySize, LDS_BYTES) != hipSuccess) { fprintf(stderr, "kernel_launch: hipFuncSetAttribute failed\n"); grid = -1; return; }
        if (hipOccupancyMaxActiveBlocksPerMultiprocessor(&per_cu, (const void*)fwd_kernel, NTHREADS, LDS_BYTES) != hipSuccess || per_cu < 1) { fprintf(stderr, "kernel_launch: occupancy query says %d\n", per_cu); per_cu = 1; }
        (void)hipGetLastError();
        grid = cus;
    }
    if (grid < 0) return;
    Params prm{};
    for (int i = 0; i < 28; ++i) prm.in[i] = (const float*)d_in[i];
    prm.out = (float*)d_out; prm.ws = (unsigned char*)d_ws;
    for (int i = 0; i < 8; ++i) prm.inv_freq[i] = powf(500000.0f, -(float)(2 * i) / 16.0f);
    if (hipMemsetAsync((char*)d_ws + WS_CTL, 0, CTL_ZERO_BYTES, stream) != hipSuccess) { fprintf(stderr, "kernel_launch: memset failed\n"); return; }
#if MK_ONE_LAUNCH
    prm.ph_lo = 0; prm.ph_hi = NPHASE;
    void* args[] = {&prm};
    hipError_t e = hipLaunchCooperativeKernel((const void*)fwd_kernel, dim3(grid), dim3(NTHREADS), args, LDS_BYTES, stream);
    if (e != hipSuccess) fprintf(stderr, "cooperative launch failed: %s (grid %d)\n", hipGetErrorString(e), grid);
#else
#ifndef PROBE_DUP
#define PROBE_DUP -1
#endif
    for (int ph = 0; ph < NPHASE; ++ph) {
        prm.ph_lo = ph; prm.ph_hi = ph + 1;
        hipLaunchKernelGGL(fwd_kernel, dim3(grid), dim3(NTHREADS), LDS_BYTES, stream, prm);
        if (ph == PROBE_DUP) hipLaunchKernelGGL(fwd_kernel, dim3(grid), dim3(NTHREADS), LDS_BYTES, stream, prm);
    }
#endif
}
```

```cpp
#include <hip/hip_runtime.h>
#include <hip/hip_cooperative_groups.h>
#include <cstdio>
#include <cmath>
namespace cg = cooperative_groups;

#ifndef MK_ONE_LAUNCH
#define MK_ONE_LAUNCH 1
#endif

typedef unsigned short bf16_t;
typedef short bf16x8 __attribute__((ext_vector_type(8)));
typedef float f32x4 __attribute__((ext_vector_type(4)));
typedef float f32x16 __attribute__((ext_vector_type(16)));
typedef unsigned u32x4 __attribute__((ext_vector_type(4)));
typedef unsigned u32x2 __attribute__((ext_vector_type(2)));

constexpr int NB = 8, SEQ = 4096, DM = 1024, NT = NB * SEQ;
constexpr int NPROJ = 2304, LDWIN = 2312;
constexpr int C_K = 512, C_V = 640, C_Z = 768, C_X = 1280, C_B = 1792, C_C = 2048;
constexpr int MEMT = 256, NMEM = NB * MEMT;
constexpr int NEXP = 32, EFF = 256;
constexpr int NCH = SEQ / 128;
constexpr float EPS = 1e-5f;
constexpr int NTHREADS = 512, NWAVES = 8;
constexpr int LDS_BYTES = 147456;

constexpr size_t MiB = (size_t)1 << 20;
constexpr size_t WS_CTL = 0, WS_BAR = 65536, CTL_ZERO_BYTES = 131072;
constexpr size_t WS_WIN = 1 * MiB, WS_WOUT = 6 * MiB, WS_WQ = 8 * MiB, WS_WKV = 9 * MiB, WS_WO = 11 * MiB, WS_WR = 12 * MiB;
constexpr size_t WS_WGU = 16 * MiB, WS_WD = 48 * MiB;
constexpr size_t WS_MEMH = 64 * MiB, WS_KMEM = 68 * MiB, WS_VMEMT = 70 * MiB, WS_DTRAW = 72 * MiB, WS_CDEC = 73 * MiB, WS_ROUTE = 74 * MiB;
constexpr size_t WS_LIST = 76 * MiB, WS_SSQ = 80 * MiB;
constexpr size_t WS_PROJ = 96 * MiB, WS_A2 = 240 * MiB, WS_STATES = 304 * MiB, WS_START = 368 * MiB;
constexpr size_t WS_X1 = 96 * MiB, WS_XB = 304 * MiB, WS_Q2 = 368 * MiB, WS_XO = 224 * MiB, WS_XG = 96 * MiB, WS_HID = 368 * MiB, WS_Y = 96 * MiB;
constexpr size_t WS_NEED = 512 * MiB;

struct Params {
    const float* in[28];
    float* out;
    unsigned char* ws;
    float inv_freq[8];
    int ph_lo, ph_hi;
};

__device__ __forceinline__ unsigned f2bf(float f) { unsigned u = __float_as_uint(f); return (u + 0x7fffu + ((u >> 16) & 1u)) >> 16; }
__device__ __forceinline__ float bf2f(unsigned h) { return __uint_as_float(h << 16); }
__device__ __forceinline__ unsigned pk2(float lo, float hi) { return f2bf(lo) | (f2bf(hi) << 16); }
__device__ __forceinline__ float bflo(unsigned u) { return __uint_as_float(u << 16); }
__device__ __forceinline__ float bfhi(unsigned u) { return __uint_as_float(u & 0xffff0000u); }
__device__ __forceinline__ float wave_sum(float v) {
#pragma unroll
    for (int o = 32; o >= 1; o >>= 1) v += __shfl_xor(v, o);
    return v;
}
#define LDS_WAIT() asm volatile("s_waitcnt lgkmcnt(0)" ::: "memory")
__device__ __forceinline__ int opaque_tid() { int t = threadIdx.x; asm volatile("" : "+v"(t)); return t; }
__device__ __forceinline__ float siluf(float v) { return v * __builtin_amdgcn_rcpf(1.f + __expf(-v)); }
__device__ __forceinline__ f32x16 mfma32(bf16x8 a, bf16x8 b, f32x16 c) { return __builtin_amdgcn_mfma_f32_32x32x16_bf16(a, b, c, 0, 0, 0); }
__device__ __forceinline__ f32x16 zero16() { f32x16 z;
#pragma unroll
    for (int i = 0; i < 16; ++i) z[i] = 0.f;
    return z; }
__device__ __forceinline__ bf16x8 pack8(float a0, float a1, float a2, float a3, float a4, float a5, float a6, float a7) {
    u32x4 t; t.x = pk2(a0, a1); t.y = pk2(a2, a3); t.z = pk2(a4, a5); t.w = pk2(a6, a7);
    return __builtin_bit_cast(bf16x8, t);
}
__device__ __forceinline__ int crow(int i, int h) { return (i & 3) + 8 * (i >> 2) + 4 * h; }

namespace pg8 {
#define PG8_LAS __attribute__((address_space(3)))
typedef unsigned short bf16_t;
typedef short bf16x8 __attribute__((ext_vector_type(8)));
typedef float f32x4 __attribute__((ext_vector_type(4)));
typedef unsigned u32x4 __attribute__((ext_vector_type(4)));
constexpr int BM = 256, BK = 64, HALF = 128, HTB = HALF * BK * 2  , STAGE_BYTES = 8 * HTB, NXCD = 8, WGM = 8;

__host__ __device__ __forceinline__ int lds_byte(int r, int c) { const int st = (r >> 4) * 2 + (c >> 5), rr = r & 15, cc = c & 31, ob = rr * 64 + cc * 2; return st * 1024 + (ob ^ (((ob >> 9) & 1) << 5)); }
__host__ __device__ __forceinline__ void stage_rc(int b, int& R, int& C) { const int st = b / 1024, sb = b % 1024, swz = sb ^ (((sb >> 9) & 1) << 5); R = (st >> 1) * 16 + swz / 64; C = (st & 1) * 32 + (swz % 64) / 2; }
__host__ __device__ __forceinline__ int perm32(int rho) { const int n = rho >> 4, i = rho & 15; return 8 * (i >> 2) + 4 * n + (i & 3); }

struct Unit { int pm, pn; };
struct Gemm { const bf16_t* A; const bf16_t* Bt; int M, N, K; };

struct StaticOrder {
    int nM, nN, nwg, G, c;
    __host__ __device__ void init(int M, int N, int G_, int c_) { nM = M / BM; nN = N / BM; nwg = nM * nN; G = G_; c = c_; }
    __host__ __device__ bool next(int i, Unit& u) const {
        const long L = (long)i * G + c; if (L >= nwg) return false;
        int wgid = (int)L; { const int q = nwg / NXCD, r = nwg % NXCD, xcd = wgid % NXCD, off = wgid / NXCD; wgid = (xcd < r ? xcd * (q + 1) : r * (q + 1) + (xcd - r) * q) + off; }
        const int nig = WGM * nN, gid = wgid / nig, fm = gid * WGM, gsz = (nM - fm) < WGM ? (nM - fm) : WGM;
        u.pm = fm + ((wgid % nig) % gsz); u.pn = (wgid % nig) / gsz; return true;
    }
    __device__ __forceinline__ void a_ready(const Unit&) const {}
    __device__ __forceinline__ void done(const Unit&) const {}
};
__device__ __forceinline__ unsigned cvt_pk_bf16(float lo, float hi) { unsigned r; asm volatile("v_cvt_pk_bf16_f32 %0, %1, %2" : "=v"(r) : "v"(lo), "v"(hi)); return r; }
typedef float f32x2 __attribute__((ext_vector_type(2)));
template <class Epi, class Sched, bool ALIGN_EPI = false, bool SP2 = false>
__device__ __forceinline__ void gemm_phase(PG8_LAS unsigned char* lds, const Gemm g, const Sched& S, const Epi& E) {
    const int tid = threadIdx.x, wid = __builtin_amdgcn_readfirstlane(tid >> 6), lane = tid & 63, wr = wid >> 2, wc = wid & 3, fr = lane & 15, fq = lane >> 4;
    const int K = g.K, nt = K / BK;
    unsigned voffA[2], voffB[2];
#pragma unroll
    for (int i = 0; i < 2; ++i) { int R, C; stage_rc(tid * 16 + i * 8192, R, C); const int Rb = Epi::PERM ? ((R & ~31) + perm32(R & 31)) : R;
        voffA[i] = (unsigned)(R * K + C) * 2u; voffB[i] = (unsigned)(Rb * K + C) * 2u; }
    const size_t kstep = (size_t)(BK * 2);
    const size_t hstep = (size_t)HALF * K * 2;
    const size_t tstep = 2 * hstep;
    const unsigned ldsw = (unsigned)wid * 1024u;
    const int aoff = lds_byte(wr * 64 + fr, fq * 8), boff = lds_byte(wc * 32 + fr, fq * 8);
#define PG8_SA(b, h) (((b) * 2 + (h)) * HTB)
#define PG8_SB(b, h) ((4 + (b) * 2 + (h)) * HTB)
#define PG8_STAGE(bufoff, gbase, voff) do { _Pragma("unroll") for (int _i = 0; _i < 2; ++_i) \
        __builtin_amdgcn_global_load_lds((const unsigned*)((const char*)(gbase) + (voff)[_i]), (PG8_LAS unsigned*)(lds + (bufoff) + ldsw + _i * 8192), 16, 0, 0); } while (0)
#define PG8_LDA(dst, b, h) do { _Pragma("unroll") for (int m = 0; m < 4; ++m) _Pragma("unroll") for (int k = 0; k < 2; ++k) dst[m][k] = *(const PG8_LAS bf16x8*)(lds + PG8_SA(b, h) + aoff + m * 2048 + k * 1024); } while (0)
#define PG8_LDB(dst, b, h) do { _Pragma("unroll") for (int n = 0; n < 2; ++n) _Pragma("unroll") for (int k = 0; k < 2; ++k) dst[n][k] = *(const PG8_LAS bf16x8*)(lds + PG8_SB(b, h) + boff + n * 2048 + k * 1024); } while (0)
#define PG8_MMA(ai, bj, At, Bt) do { __builtin_amdgcn_s_setprio(1); _Pragma("unroll") for (int m = 0; m < 4; ++m) _Pragma("unroll") for (int n = 0; n < 2; ++n) _Pragma("unroll") for (int k = 0; k < 2; ++k) \
        acc[ai][bj][m][n] = __builtin_amdgcn_mfma_f32_16x16x32_bf16(Bt[n][k], At[m][k], acc[ai][bj][m][n], 0, 0, 0); __builtin_amdgcn_s_setprio(0); } while (0)
#define PG8_WAIT_V(n) asm volatile("s_waitcnt vmcnt(" #n ")" ::: "memory")
#define PG8_WAIT_L(n) asm volatile("s_waitcnt lgkmcnt(" #n ")" ::: "memory")
#define PG8_BAR __builtin_amdgcn_s_barrier()
#define PG8_SCHED __builtin_amdgcn_sched_barrier(0)
    Unit cur, nxt; int ui = 0;
    if (!S.next(0, cur)) return;
    f32x4 acc[2][2][4][2];
#pragma unroll
    for (int a = 0; a < 2; ++a)
#pragma unroll
        for (int b = 0; b < 2; ++b)
#pragma unroll
            for (int m = 0; m < 4; ++m)
#pragma unroll
                for (int n = 0; n < 2; ++n) acc[a][b][m][n] = (f32x4){0.f, 0.f, 0.f, 0.f};
    bf16x8 At[4][2], B0[2][2], B1[2][2];
    const char* cA = (const char*)g.A + (size_t)cur.pm * tstep; const char* cB = (const char*)g.Bt + (size_t)cur.pn * tstep;
    S.a_ready(cur);
    if constexpr (SP2) {
        PG8_STAGE(PG8_SB(0, 0), cB, voffB); PG8_STAGE(PG8_SB(0, 1), cB + hstep, voffB); PG8_STAGE(PG8_SA(0, 0), cA, voffA); PG8_STAGE(PG8_SA(0, 1), cA + hstep, voffA);
        if (wr == 1) PG8_BAR;
        PG8_WAIT_V(2); PG8_BAR;
        PG8_STAGE(PG8_SB(1, 0), cB + kstep, voffB); PG8_STAGE(PG8_SA(1, 0), cA + kstep, voffA); PG8_STAGE(PG8_SB(1, 1), cB + hstep + kstep, voffB);
        PG8_WAIT_V(6); PG8_BAR;
    } else {
        PG8_STAGE(PG8_SB(0, 0), cB, voffB); PG8_STAGE(PG8_SA(0, 0), cA, voffA); PG8_STAGE(PG8_SB(0, 1), cB + hstep, voffB); PG8_STAGE(PG8_SA(0, 1), cA + hstep, voffA);
        if (wr == 1) PG8_BAR;
        PG8_WAIT_V(4); PG8_BAR;
        PG8_STAGE(PG8_SB(1, 0), cB + kstep, voffB); PG8_STAGE(PG8_SA(1, 0), cA + kstep, voffA); PG8_STAGE(PG8_SB(1, 1), cB + hstep + kstep, voffB);
        PG8_WAIT_V(6); PG8_BAR;
    }
    for (;;) {
        const bool has_next = S.next(ui + 1, nxt);
        const char* nA = has_next ? (const char*)g.A + (size_t)nxt.pm * tstep : cA; const char* nB = has_next ? (const char*)g.Bt + (size_t)nxt.pn * tstep : cB;
        for (int t = 0; t < nt; t += 2) {
            const bool last = (t == nt - 2);
            const char* a1 = cA + (size_t)(t + 1) * kstep;
            const char* a2 = last ? nA : cA + (size_t)(t + 2) * kstep; const char* b2 = last ? nB : cB + (size_t)(t + 2) * kstep;
            const char* a3 = a2 + kstep; const char* b3 = b2 + kstep;
            if (last && has_next) S.a_ready(nxt);
            if constexpr (SP2) {
            PG8_LDB(B0, 0, 0); PG8_LDB(B1, 0, 1); PG8_SCHED; PG8_LDA(At, 0, 0); PG8_STAGE(PG8_SA(1, 1), a1 + hstep, voffA);
            PG8_WAIT_V(8); PG8_WAIT_L(0); PG8_BAR; PG8_MMA(0, 0, At, B0); PG8_MMA(0, 1, At, B1); PG8_BAR; PG8_SCHED;
            PG8_LDA(At, 0, 1); PG8_STAGE(PG8_SB(0, 0), b2, voffB); PG8_STAGE(PG8_SB(0, 1), b2 + hstep, voffB); PG8_STAGE(PG8_SA(0, 0), a2, voffA);
            PG8_WAIT_V(8); PG8_WAIT_L(0); PG8_BAR; PG8_MMA(1, 0, At, B0); PG8_MMA(1, 1, At, B1); PG8_BAR; PG8_SCHED;
            PG8_LDB(B0, 1, 0); PG8_LDB(B1, 1, 1); PG8_SCHED; PG8_LDA(At, 1, 0); PG8_STAGE(PG8_SA(0, 1), a2 + hstep, voffA);
            PG8_WAIT_V(8); PG8_WAIT_L(0); PG8_BAR; PG8_MMA(0, 0, At, B0); PG8_MMA(0, 1, At, B1); PG8_BAR; PG8_SCHED;
            PG8_LDA(At, 1, 1); PG8_STAGE(PG8_SB(1, 0), b3, voffB); PG8_STAGE(PG8_SB(1, 1), b3 + hstep, voffB); PG8_STAGE(PG8_SA(1, 0), a3, voffA);
            PG8_WAIT_V(8); PG8_WAIT_L(0); PG8_BAR; PG8_MMA(1, 0, At, B0); PG8_MMA(1, 1, At, B1); PG8_BAR; PG8_SCHED;
            } else {
            PG8_LDB(B0, 0, 0); PG8_SCHED; PG8_LDA(At, 0, 0); PG8_STAGE(PG8_SA(1, 1), a1 + hstep, voffA);
            PG8_WAIT_L(8); PG8_BAR; PG8_WAIT_L(0); PG8_MMA(0, 0, At, B0); PG8_BAR; PG8_SCHED;
            PG8_LDB(B1, 0, 1); PG8_STAGE(PG8_SB(0, 0), b2, voffB);
            PG8_BAR; PG8_WAIT_L(0); PG8_MMA(0, 1, At, B1); PG8_BAR;
            PG8_LDA(At, 0, 1); PG8_STAGE(PG8_SA(0, 0), a2, voffA);
            PG8_BAR; PG8_WAIT_L(0); PG8_MMA(1, 0, At, B0); PG8_BAR; PG8_SCHED;
            PG8_STAGE(PG8_SB(0, 1), b2 + hstep, voffB);
            PG8_WAIT_V(6); PG8_BAR; PG8_MMA(1, 1, At, B1); PG8_BAR;
            PG8_LDB(B0, 1, 0); PG8_SCHED; PG8_LDA(At, 1, 0); PG8_STAGE(PG8_SA(0, 1), a2 + hstep, voffA);
            PG8_WAIT_L(8); PG8_BAR; PG8_WAIT_L(0); PG8_MMA(0, 0, At, B0); PG8_BAR; PG8_SCHED;
            PG8_LDB(B1, 1, 1); PG8_STAGE(PG8_SB(1, 0), b3, voffB);
            PG8_BAR; PG8_WAIT_L(0); PG8_MMA(0, 1, At, B1); PG8_BAR;
            PG8_LDA(At, 1, 1); PG8_STAGE(PG8_SA(1, 0), a3, voffA);
            PG8_BAR; PG8_WAIT_L(0); PG8_MMA(1, 0, At, B0); PG8_BAR; PG8_SCHED;
            PG8_STAGE(PG8_SB(1, 1), b3 + hstep, voffB);
            PG8_WAIT_V(6); PG8_BAR; PG8_MMA(1, 1, At, B1); PG8_BAR;
            }
        }
        if constexpr (ALIGN_EPI) { if (wr == 0) PG8_BAR; }
        if constexpr (!Epi::AFTER_DRAIN) { E(acc, cur, wr, wc, fr, fq); S.done(cur); }
        if (!has_next) break;
#pragma unroll
        for (int a = 0; a < 2; ++a)
#pragma unroll
            for (int b = 0; b < 2; ++b)
#pragma unroll
                for (int m = 0; m < 4; ++m)
#pragma unroll
                    for (int n = 0; n < 2; ++n) acc[a][b][m][n] = (f32x4){0.f, 0.f, 0.f, 0.f};
        cur = nxt; cA = nA; cB = nB; ++ui;
        if constexpr (ALIGN_EPI) { if (wr == 1) PG8_BAR; }
    }
    PG8_WAIT_V(0);
    if constexpr (!ALIGN_EPI) { if (wr == 0) PG8_BAR; }
    PG8_BAR;
    if constexpr (Epi::AFTER_DRAIN) { E.fused(acc, cur, wr, wc, fr, fq, lds, wid, lane); S.done(cur); }
#undef PG8_SA
#undef PG8_SB
#undef PG8_STAGE
#undef PG8_LDA
#undef PG8_LDB
#undef PG8_MMA
#undef PG8_WAIT_V
#undef PG8_WAIT_L
#undef PG8_BAR
#undef PG8_SCHED
}

struct EpiBf16 {
    static constexpr bool PERM = true, AFTER_DRAIN = false;
    bf16_t* O; int ldc; int npn;
    __device__ __forceinline__ void operator()(const f32x4 (&acc)[2][2][4][2], const Unit& u, int wr, int wc, int fr, int fq) const {
        const int row0 = u.pm * BM + wr * 64 + fr, col0 = (u.pn % npn) * BM + wc * 32 + 8 * fq;
#pragma unroll
        for (int ai = 0; ai < 2; ++ai)
#pragma unroll
            for (int m = 0; m < 4; ++m) { bf16_t* rowp = O + (size_t)(row0 + ai * HALF + m * 16) * ldc + col0;
#pragma unroll
                for (int bj = 0; bj < 2; ++bj) { const f32x4 v0 = acc[ai][bj][m][0], v1 = acc[ai][bj][m][1];
                    u32x4 w; w.x = cvt_pk_bf16(v0[0], v0[1]); w.y = cvt_pk_bf16(v0[2], v0[3]); w.z = cvt_pk_bf16(v1[0], v1[1]); w.w = cvt_pk_bf16(v1[2], v1[3]);
                    *(u32x4*)(rowp + bj * HALF) = w; } }
    }
};
struct EpiKV {
    static constexpr bool PERM = true, AFTER_DRAIN = false;
    bf16_t* kmem; bf16_t* vmemT;
    __device__ __forceinline__ void operator()(const f32x4 (&acc)[2][2][4][2], const Unit& u, int wr, int wc, int fr, int fq) const {
        const int row0 = u.pm * BM + wr * 64 + fr, col0 = u.pn * BM + wc * 32 + 8 * fq;
#pragma unroll
        for (int ai = 0; ai < 2; ++ai)
#pragma unroll
            for (int m = 0; m < 4; ++m) { const int row = row0 + ai * HALF + m * 16;
#pragma unroll
                for (int bj = 0; bj < 2; ++bj) { const f32x4 v0 = acc[ai][bj][m][0], v1 = acc[ai][bj][m][1]; const int col = col0 + bj * HALF;
                    if (col < 512) { u32x4 w; w.x = cvt_pk_bf16(v0[0], v0[1]); w.y = cvt_pk_bf16(v0[2], v0[3]); w.z = cvt_pk_bf16(v1[0], v1[1]); w.w = cvt_pk_bf16(v1[2], v1[3]);
                        *(u32x4*)(kmem + (size_t)row * 512 + col) = w; }
                    else { const int c2 = col - 512, hx = c2 >> 7, d = c2 & 127, b = row >> 8, key = row & 255;
                        bf16_t* vp = vmemT + (((size_t)b * 4 + hx) * 128 + d) * 256 + key;
                        const unsigned w0 = cvt_pk_bf16(v0[0], v0[1]), w1 = cvt_pk_bf16(v0[2], v0[3]), w2 = cvt_pk_bf16(v1[0], v1[1]), w3 = cvt_pk_bf16(v1[2], v1[3]);
                        vp[0 * 256] = (bf16_t)(w0 & 0xffffu); vp[1 * 256] = (bf16_t)(w0 >> 16); vp[2 * 256] = (bf16_t)(w1 & 0xffffu); vp[3 * 256] = (bf16_t)(w1 >> 16);
                        vp[4 * 256] = (bf16_t)(w2 & 0xffffu); vp[5 * 256] = (bf16_t)(w2 >> 16); vp[6 * 256] = (bf16_t)(w3 & 0xffffu); vp[7 * 256] = (bf16_t)(w3 >> 16); } } }
    }
};
template <bool XF32, bool STATS> struct EpiResid {
    static constexpr bool PERM = false, AFTER_DRAIN = false;
    const void* xin; bf16_t* xb; float* ssq;
    __device__ __forceinline__ void operator()(const f32x4 (&acc)[2][2][4][2], const Unit& u, int wr, int wc, int fr, int fq) const {
        typedef unsigned u32x2v __attribute__((ext_vector_type(2)));
        const int col0 = u.pn * BM + wc * 32 + 4 * fq;
#pragma unroll
        for (int ai = 0; ai < 2; ++ai)
#pragma unroll
            for (int m = 0; m < 4; ++m) { const size_t row = (size_t)(u.pm * BM + ai * HALF + wr * 64 + m * 16 + fr); const size_t off = row * 1024 + col0;
                float q = 0.f;
#pragma unroll
                for (int bj = 0; bj < 2; ++bj)
#pragma unroll
                    for (int n = 0; n < 2; ++n) {
                        f32x4 bs;
                        if (XF32) bs = *(const f32x4*)((const float*)xin + off + bj * HALF + n * 16);
                        else { const u32x2v t = *(const u32x2v*)((const bf16_t*)xin + off + bj * HALF + n * 16);
                            bs[0] = __uint_as_float(t.x << 16); bs[1] = __uint_as_float(t.x & 0xffff0000u); bs[2] = __uint_as_float(t.y << 16); bs[3] = __uint_as_float(t.y & 0xffff0000u); }
                        const f32x4 o = bs + acc[ai][bj][m][n];
                        u32x2v w; w.x = cvt_pk_bf16(o[0], o[1]); w.y = cvt_pk_bf16(o[2], o[3]); *(u32x2v*)(xb + off + bj * HALF + n * 16) = w;
                        if (STATS) q += (o[0] * o[0] + o[1] * o[1]) + (o[2] * o[2] + o[3] * o[3]); }
                if (STATS) { q += __shfl_xor(q, 16); q += __shfl_xor(q, 32); if (fq == 0) ssq[row * 16 + u.pn * 4 + wc] = q; }
                asm volatile("" ::: "memory"); }
    }
};
struct EpiQ {
    static constexpr bool PERM = true, AFTER_DRAIN = false;
    bf16_t* O; const float* ssq;
    __device__ __forceinline__ void operator()(const f32x4 (&acc)[2][2][4][2], const Unit& u, int wr, int wc, int fr, int fq) const {
        const int row0 = u.pm * BM + wr * 64 + fr, col0 = u.pn * BM + wc * 32 + 8 * fq;
#pragma unroll
        for (int ai = 0; ai < 2; ++ai)
#pragma unroll
            for (int m = 0; m < 4; ++m) { const size_t row = (size_t)(row0 + ai * HALF + m * 16);
                const f32x4* sp = (const f32x4*)(ssq + row * 16); const f32x4 s0 = sp[0], s1 = sp[1], s2 = sp[2], s3 = sp[3];
                const float s = ((s0[0] + s0[1]) + (s0[2] + s0[3])) + ((s1[0] + s1[1]) + (s1[2] + s1[3])) + ((s2[0] + s2[1]) + (s2[2] + s2[3])) + ((s3[0] + s3[1]) + (s3[2] + s3[3]));
                const float rs = 1.f / sqrtf(s * (1.f / 1024.f) + 1e-5f);
                bf16_t* rowp = O + row * 512 + col0;
#pragma unroll
                for (int bj = 0; bj < 2; ++bj) { const f32x4 v0 = acc[ai][bj][m][0] * rs, v1 = acc[ai][bj][m][1] * rs;
                    u32x4 w; w.x = cvt_pk_bf16(v0[0], v0[1]); w.y = cvt_pk_bf16(v0[2], v0[3]); w.z = cvt_pk_bf16(v1[0], v1[1]); w.w = cvt_pk_bf16(v1[2], v1[3]);
                    *(u32x4*)(rowp + bj * HALF) = w; } }
    }
};
struct EpiGU {
    static constexpr bool PERM = true, AFTER_DRAIN = false;
    bf16_t* hid;
    __device__ __forceinline__ void operator()(const f32x4 (&acc)[2][2][4][2], const Unit& u, int wr, int wc, int fr, int fq) const {
        const int row0 = u.pm * BM + wr * 64 + fr, j0 = (u.pn & 1) * 128 + wc * 16 + 4 * fq;
#pragma unroll
        for (int ai = 0; ai < 2; ++ai)
#pragma unroll
            for (int m = 0; m < 4; ++m) { bf16_t* rowp = hid + (size_t)(row0 + ai * HALF + m * 16) * 256 + j0;
#pragma unroll
                for (int bj = 0; bj < 2; ++bj) { const f32x4 v0 = acc[ai][bj][m][0], v1 = acc[ai][bj][m][1];
                    const float h0 = v0[0] / (1.f + __expf(-v0[0])) * v0[1], h1 = v0[2] / (1.f + __expf(-v0[2])) * v0[3];
                    const float h2 = v1[0] / (1.f + __expf(-v1[0])) * v1[1], h3 = v1[2] / (1.f + __expf(-v1[2])) * v1[3];
                    typedef unsigned u32x2v __attribute__((ext_vector_type(2))); u32x2v w; w.x = cvt_pk_bf16(h0, h1); w.y = cvt_pk_bf16(h2, h3);
                    *(u32x2v*)(rowp + bj * 64) = w; } }
    }
};
struct SubOrder {
    int nM, nN, nwg, span, c;
    __device__ void init(int M, int N, int span_, int c_) { nM = M / BM; nN = N / BM; nwg = nM * nN; span = span_; c = c_; }
    __device__ bool next(int i, Unit& u) const { if (c < 0 || c >= span) return false; const int L = i * span + c; if (L >= nwg) return false; u.pm = L / nN; u.pn = L % nN; return true; }
    __device__ __forceinline__ void a_ready(const Unit&) const {}
    __device__ __forceinline__ void done(const Unit&) const {}
};
struct MoeOrder {
    const PG8_LAS int* tile_e; int nrt, npn, G, c;
    __device__ bool next(int i, Unit& u) const { const int L = i * G + c; if (L >= nrt * npn) return false; const int rt = L / npn, pnl = L % npn; u.pm = rt; u.pn = tile_e[rt] * npn + pnl; return true; }
    __device__ __forceinline__ void a_ready(const Unit&) const {}
    __device__ __forceinline__ void done(const Unit&) const {}
};
}

#define LAS __attribute__((address_space(3)))
#define XB_TMO      128
#define XB_XCNT(j)  (256  + 64 * (j))
#define XB_XSUB(j)  (1280 + 64 * (j))
#define XB_XGEN(j)  (2304 + 64 * (j))
#define XB_TOP      3328
#define XB_TOPGEN   3392
#define XCD_BAR_WORDS 3456
#define XB_SPIN_CAP (1u << 18)

__device__ __forceinline__ unsigned xb_ld(unsigned* p)              { return __hip_atomic_load(p, __ATOMIC_RELAXED, __HIP_MEMORY_SCOPE_AGENT); }
__device__ __forceinline__ unsigned xb_add(unsigned* p, unsigned v) { return __hip_atomic_fetch_add(p, v, __ATOMIC_RELAXED, __HIP_MEMORY_SCOPE_AGENT); }
__device__ __forceinline__ unsigned xb_xcc_id() { return (unsigned)__builtin_amdgcn_s_getreg((3 << 11) | 20) & 0xFu; }
#define XB_SPIN(cond, bar) do { unsigned _sp = 0; while (cond) { __builtin_amdgcn_s_sleep(1); \
    if ((++_sp & 255u) == 0u) { if (xb_ld(&(bar)[XB_TMO])) break; if (_sp > XB_SPIN_CAP) { atomicAdd(&(bar)[XB_TMO], 1u); break; } } } } while (0)

struct XcdBarrier {
    unsigned* bar; unsigned x;
    volatile LAS unsigned* st;
};

__device__ __forceinline__ XcdBarrier xcd_barrier_post(unsigned* bar, volatile LAS unsigned* st) {
    XcdBarrier b; b.bar = bar; b.x = xb_xcc_id(); b.st = st;
    if (threadIdx.x == 0) (void)xb_add(&bar[XB_XCNT(b.x)], 1u);
    return b;
}
__device__ __forceinline__ void xcd_barrier_complete(unsigned* bar, unsigned x, unsigned& nloc, unsigned& nx) {
    const unsigned G = gridDim.x * gridDim.y * gridDim.z;
    unsigned sum, cnt, mine, sp = 0u;
    for (;;) {
        sum = 0u; cnt = 0u; mine = 0u;
#pragma unroll
        for (unsigned j = 0; j < 16; ++j) { const unsigned c = xb_ld(&bar[XB_XCNT(j)]); sum += c; cnt += (c > 0u) ? 1u : 0u; mine = (j == x) ? c : mine; }
        if (sum == G) break;
        __builtin_amdgcn_s_sleep(1);
        if ((++sp & 255u) == 0u) { if (xb_ld(&bar[XB_TMO])) break; if (sp > XB_SPIN_CAP) { atomicAdd(&bar[XB_TMO], 1u); break; } }
    }
    nloc = mine > 0u ? mine : 1u; nx = cnt > 0u ? cnt : 1u;
}

__device__ __forceinline__ void xcd_barrier(const XcdBarrier& b) {
    asm volatile("s_waitcnt vmcnt(0)" ::: "memory");
    __syncthreads();
    if (threadIdx.x == 0) {
        unsigned* bar = b.bar;
        __builtin_amdgcn_s_waitcnt(0);
        unsigned nloc = b.st[0], nx = b.st[1];
        if (nloc == 0u) { xcd_barrier_complete(bar, b.x, nloc, nx); b.st[0] = nloc; b.st[1] = nx; }
        const unsigned old = xb_add(&bar[XB_XSUB(b.x)], 1u);
        const unsigned gen = old / nloc;
        if (old + 1u == (gen + 1u) * nloc) {
            __builtin_amdgcn_fence(__ATOMIC_RELEASE, "agent");
            asm volatile("s_waitcnt vmcnt(0)" ::: "memory");
            const unsigned og = xb_add(&bar[XB_TOP], 1u);
            const unsigned tg = og / nx;
            if (og + 1u == (tg + 1u) * nx) xb_add(&bar[XB_TOPGEN], 1u);
            else XB_SPIN(xb_ld(&bar[XB_TOPGEN]) == tg, bar);
            __builtin_amdgcn_fence(__ATOMIC_ACQUIRE, "agent");
            xb_add(&bar[XB_XGEN(b.x)], 1u);
            asm volatile("s_waitcnt vmcnt(0)" ::: "memory");
        } else {
            XB_SPIN(xb_ld(&bar[XB_XGEN(b.x)]) == gen, bar);
            __builtin_amdgcn_fence(__ATOMIC_ACQUIRE, "agent");
            asm volatile("s_waitcnt vmcnt(0)" ::: "memory");
        }
    }
    __syncthreads();
}

__device__ __forceinline__ void gemm128(unsigned char* lds, const bf16_t* arow, const bf16_t* brow, int K, f32x16& acc0, f32x16& acc1) {
    const int tid = opaque_tid(), lane = tid & 63, w = tid >> 6;
    bf16_t* sA = (bf16_t*)lds;
    bf16_t* sB = sA + 128 * 72;
    const int srow = tid >> 2, skc = (tid & 3) * 16;
    const bf16_t* ap = arow + skc;
    const bf16_t* bp = brow + skc;
    const int wm = w >> 1, wn = w & 1, r = lane & 31, h = lane >> 5;
    acc0 = zero16(); acc1 = zero16();
    for (int k0 = 0; k0 < K; k0 += 64) {
        const u32x4 a0 = *(const u32x4*)(ap + k0), a1 = *(const u32x4*)(ap + k0 + 8);
        const u32x4 b0 = *(const u32x4*)(bp + k0), b1 = *(const u32x4*)(bp + k0 + 8);
        __syncthreads();
        *(u32x4*)(sA + srow * 72 + skc) = a0; *(u32x4*)(sA + srow * 72 + skc + 8) = a1;
        *(u32x4*)(sB + srow * 72 + skc) = b0; *(u32x4*)(sB + srow * 72 + skc + 8) = b1;
        __syncthreads();
#pragma unroll
        for (int kk = 0; kk < 64; kk += 16) {
            const bf16x8 a = *(const bf16x8*)(sA + (wm * 32 + r) * 72 + kk + 8 * h);
            const bf16x8 bA = *(const bf16x8*)(sB + (wn * 64 + r) * 72 + kk + 8 * h);
            const bf16x8 bB = *(const bf16x8*)(sB + (wn * 64 + 32 + r) * 72 + kk + 8 * h);
            acc0 = mfma32(a, bA, acc0); acc1 = mfma32(a, bB, acc1);
        }
    }
    __syncthreads();
}

__device__ __forceinline__ void p0_transpose64(const float* W, int ldw, int K, int nblk, const float* scale, bf16_t* WT, int row_off, int row_mul, float* scr, int item, int lane) {
    const int kb = item / nblk, nb = item % nblk, k0 = 64 * kb, n0 = 64 * nb;
    f32x4 v[16];
    const float* wp = W + (size_t)(k0 + (lane >> 4)) * ldw + n0 + 4 * (lane & 15);
#pragma unroll
    for (int i = 0; i < 16; ++i) v[i] = *(const f32x4*)(wp + (size_t)(4 * i) * ldw);
#pragma unroll
    for (int i = 0; i < 16; ++i) { const int kk = (lane >> 4) + 4 * i; const float sc = scale ? scale[k0 + kk] : 1.f; float* d = scr + kk * 65 + 4 * (lane & 15);
        d[0] = v[i].x * sc; d[1] = v[i].y * sc; d[2] = v[i].z * sc; d[3] = v[i].w * sc; }
    LDS_WAIT();
    const int c = lane & 7;
#pragma unroll
    for (int j = 0; j < 8; ++j) { const int n = (lane >> 3) + 8 * j; const float* sp = scr + (8 * c) * 65 + n;
        u32x4 o; o.x = pk2(sp[0 * 65], sp[1 * 65]); o.y = pk2(sp[2 * 65], sp[3 * 65]); o.z = pk2(sp[4 * 65], sp[5 * 65]); o.w = pk2(sp[6 * 65], sp[7 * 65]);
        *(u32x4*)(WT + (size_t)(row_off + (n0 + n) * row_mul) * K + k0 + 8 * c) = o; }
    LDS_WAIT();
}

__device__ __forceinline__ void phase0(const Params& p, unsigned char* lds) {
    const int tid = opaque_tid(), lane = tid & 63, w = tid >> 6;
    unsigned char* ws = p.ws;
    const int gw = blockIdx.x * NWAVES + w, NGW = gridDim.x * NWAVES;
    {
        float* WR = (float*)(ws + WS_WR);
        const float* w3 = p.in[19]; const float* wg = p.in[20]; const float* we = p.in[22];
        for (int i = blockIdx.x * NTHREADS + tid; i < 36 * 1024; i += gridDim.x * NTHREADS) {
            const int n = i >> 10, k = i & 1023;
            const float v = (n < 4) ? wg[k * 4 + n] : we[k * 32 + (n - 4)];
            WR[i] = v * w3[k];
        }
    }
    {
        float* scr = (float*)lds + w * (64 * 65);
        constexpr int I_IN = 16 * 36, I_OUT = 16 * 16, I_Q = 16 * 8, I_KV = 16 * 16, I_O = 8 * 16, I_G = 32 * 16 * 4, I_D = 32 * 4 * 16;
        constexpr int NITEMS = I_IN + I_OUT + I_Q + I_KV + I_O + 2 * I_G + I_D;
#pragma unroll 1
        for (int it = gw; it < NITEMS; it += NGW) {
            int r = it;
            if (r < I_IN) { p0_transpose64(p.in[4], LDWIN, 1024, 36, nullptr, (bf16_t*)(ws + WS_WIN), 0, 1, scr, r, lane); continue; } r -= I_IN;
            if (r < I_OUT) { p0_transpose64(p.in[13], 1024, 1024, 16, nullptr, (bf16_t*)(ws + WS_WOUT), 0, 1, scr, r, lane); continue; } r -= I_OUT;
            if (r < I_Q) { p0_transpose64(p.in[16], 512, 1024, 8, p.in[14], (bf16_t*)(ws + WS_WQ), 0, 1, scr, r, lane); continue; } r -= I_Q;
            if (r < I_KV) { p0_transpose64(p.in[17], 1024, 1024, 16, nullptr, (bf16_t*)(ws + WS_WKV), 0, 1, scr, r, lane); continue; } r -= I_KV;
            if (r < I_O) { p0_transpose64(p.in[18], 1024, 512, 16, nullptr, (bf16_t*)(ws + WS_WO), 0, 1, scr, r, lane); continue; } r -= I_O;
            if (r < I_G) { const int e = r / 64, ri = r % 64; p0_transpose64(p.in[24] + (size_t)e * 1024 * 256, 256, 1024, 4, p.in[19], (bf16_t*)(ws + WS_WGU) + (size_t)e * 512 * 1024, 0, 2, scr, ri, lane); continue; } r -= I_G;
            if (r < I_G) { const int e = r / 64, ri = r % 64; p0_transpose64(p.in[25] + (size_t)e * 1024 * 256, 256, 1024, 4, p.in[19], (bf16_t*)(ws + WS_WGU) + (size_t)e * 512 * 1024, 1, 2, scr, ri, lane); continue; } r -= I_G;
            { const int e = r / 64, ri = r % 64; p0_transpose64(p.in[26] + (size_t)e * 256 * 1024, 1024, 256, 16, nullptr, (bf16_t*)(ws + WS_WD) + (size_t)e * 1024 * 256, 0, 1, scr, ri, lane); }
        }
    }
    __syncthreads();
    float* wdt = (float*)lds;
    {
        const float* win = p.in[4]; const float* w1 = p.in[3];
        for (int i = tid; i < 8192; i += NTHREADS) { const int k = i >> 3, n = i & 7; wdt[n * 1024 + k] = win[(size_t)k * LDWIN + 2304 + n] * w1[k]; }
    }
    __syncthreads();
    {
        const float* x = p.in[0]; const float* w1 = p.in[3];
        bf16_t* h1 = (bf16_t*)p.out; float* dtraw = (float*)(ws + WS_DTRAW);
        f32x4 wv[4];
#pragma unroll
        for (int j = 0; j < 4; ++j) wv[j] = *(const f32x4*)(w1 + 4 * lane + 256 * j);
        f32x4 nx[4];
        if (gw < NT) {
#pragma unroll
            for (int j = 0; j < 4; ++j) nx[j] = *((const f32x4*)(x + (size_t)gw * DM) + lane + 64 * j);
        }
#pragma unroll 1
        for (int m = gw; m < NT; m += NGW) {
            f32x4 v[4];
#pragma unroll
            for (int j = 0; j < 4; ++j) v[j] = nx[j];
            if (m + NGW < NT) {
#pragma unroll
                for (int j = 0; j < 4; ++j) nx[j] = *((const f32x4*)(x + (size_t)(m + NGW) * DM) + lane + 64 * j);
            }
            float a[16];
#pragma unroll
            for (int q = 0; q < 16; ++q) a[q] = 0.f;
#pragma unroll
            for (int j = 0; j < 4; ++j) a[0] += (v[j].x * v[j].x + v[j].y * v[j].y) + (v[j].z * v[j].z + v[j].w * v[j].w);
#pragma unroll
            for (int n = 0; n < 8; ++n)
#pragma unroll
                for (int j = 0; j < 4; ++j) { const f32x4 ww = *(const f32x4*)(wdt + n * 1024 + 4 * lane + 256 * j); a[1 + n] += (v[j].x * ww.x + v[j].y * ww.y) + (v[j].z * ww.z + v[j].w * ww.w); }
            float b8[8], b4[4], b2[2], b1;
            { const bool hi = (lane & 32) != 0;
#pragma unroll
              for (int q = 0; q < 8; ++q) { const float send = hi ? a[q] : a[q + 8], keep = hi ? a[q + 8] : a[q]; b8[q] = keep + __shfl_xor(send, 32); } }
            { const bool hi = (lane & 16) != 0;
#pragma unroll
              for (int q = 0; q < 4; ++q) { const float send = hi ? b8[q] : b8[q + 4], keep = hi ? b8[q + 4] : b8[q]; b4[q] = keep + __shfl_xor(send, 16); } }
            { const bool hi = (lane & 8) != 0;
#pragma unroll
              for (int q = 0; q < 2; ++q) { const float send = hi ? b4[q] : b4[q + 2], keep = hi ? b4[q + 2] : b4[q]; b2[q] = keep + __shfl_xor(send, 8); } }
            { const bool hi = (lane & 4) != 0; const float send = hi ? b2[0] : b2[1], keep = hi ? b2[1] : b2[0]; b1 = keep + __shfl_xor(send, 4); }
            b1 += __shfl_xor(b1, 2); b1 += __shfl_xor(b1, 1);
            const float rstd = 1.f / sqrtf(__shfl(b1, 0) * (1.f / DM) + EPS);
            const int slot = (lane >> 2) & 15;
            if ((lane & 3) == 0 && slot >= 1 && slot <= 8) dtraw[(size_t)m * 8 + (slot - 1)] = b1 * rstd;
            u32x2* o8 = (u32x2*)(h1 + (size_t)m * DM) + lane;
#pragma unroll
            for (int j = 0; j < 4; ++j) { u32x2 o; o.x = pk2(v[j].x * rstd * wv[j].x, v[j].y * rstd * wv[j].y); o.y = pk2(v[j].z * rstd * wv[j].z, v[j].w * rstd * wv[j].w); o8[64 * j] = o; }
        }
    }
    {
        const float* mem = p.in[1]; const float* wm = p.in[15];
        bf16_t* memh = (bf16_t*)(ws + WS_MEMH);
        f32x4 wv[4];
#pragma unroll
        for (int j = 0; j < 4; ++j) wv[j] = *(const f32x4*)(wm + 4 * lane + 256 * j);
        for (int m = gw; m < NMEM; m += NGW) {
            const f32x4* xr = (const f32x4*)(mem + (size_t)m * DM) + lane;
            f32x4 v[4]; float s = 0.f;
#pragma unroll
            for (int j = 0; j < 4; ++j) { v[j] = xr[64 * j]; s += (v[j].x * v[j].x + v[j].y * v[j].y) + (v[j].z * v[j].z + v[j].w * v[j].w); }
            const float rstd = 1.f / sqrtf(wave_sum(s) * (1.f / DM) + EPS);
            u32x2* o8 = (u32x2*)(memh + (size_t)m * DM) + lane;
#pragma unroll
            for (int j = 0; j < 4; ++j) { u32x2 o; o.x = pk2(v[j].x * rstd * wv[j].x, v[j].y * rstd * wv[j].y); o.y = pk2(v[j].z * rstd * wv[j].z, v[j].w * rstd * wv[j].w); o8[64 * j] = o; }
        }
    }
    __syncthreads();
}

#define LDS3(p) ((__attribute__((address_space(3))) unsigned char*)(p))
__device__ __forceinline__ void phase1(const Params& p, unsigned char* lds) {
    unsigned char* ws = p.ws;
#ifdef PROBE_PHASE
    _Pragma("unroll 1") for (int rep = 0; rep < ((PROBE_PHASE == 101) ? 2 : 1); ++rep)
#endif
    {
        pg8::Gemm g{(const bf16_t*)p.out, (const bf16_t*)(ws + WS_WIN), NT, NPROJ, DM};
        pg8::StaticOrder S; S.init(NT, NPROJ, (int)gridDim.x, (int)blockIdx.x);
        pg8::EpiBf16 E{(bf16_t*)(ws + WS_PROJ), NPROJ, NPROJ / 256};
        pg8::gemm_phase<pg8::EpiBf16, pg8::StaticOrder, true, true>(LDS3(lds), g, S, E);
    }
    {
        pg8::Gemm g{(const bf16_t*)(ws + WS_MEMH), (const bf16_t*)(ws + WS_WKV), NMEM, 1024, DM};
        pg8::SubOrder S; S.init(NMEM, 1024, 128, (int)blockIdx.x - 128);
        pg8::EpiKV E{(bf16_t*)(ws + WS_KMEM), (bf16_t*)(ws + WS_VMEMT)};
        pg8::gemm_phase<pg8::EpiKV, pg8::SubOrder, true, true>(LDS3(lds), g, S, E);
    }
}

__device__ __forceinline__ float bfel(const u32x4& v, int ci) { const unsigned wv = (ci >> 1) == 0 ? v.x : (ci >> 1) == 1 ? v.y : (ci >> 1) == 2 ? v.z : v.w; return (ci & 1) ? bfhi(wv) : bflo(wv); }
template <bool TRANS>
__device__ __forceinline__ void conv8x8(const Params& p, int b, int c, int l0, int ch0, const float (&f)[8], u32x4 (&res)[8]) {
    const bf16_t* proj = (const bf16_t*)(p.ws + WS_PROJ);
    const float* cw = p.in[6]; const float* cb = p.in[7];
    float wgt[4][8], bias[8];
#pragma unroll
    for (int j = 0; j < 4; ++j) { const f32x4 a = *(const f32x4*)(cw + j * 1024 + ch0), b2 = *(const f32x4*)(cw + j * 1024 + ch0 + 4);
        wgt[j][0] = a.x; wgt[j][1] = a.y; wgt[j][2] = a.z; wgt[j][3] = a.w; wgt[j][4] = b2.x; wgt[j][5] = b2.y; wgt[j][6] = b2.z; wgt[j][7] = b2.w; }
    { const f32x4 a = *(const f32x4*)(cb + ch0), b2 = *(const f32x4*)(cb + ch0 + 4); bias[0] = a.x; bias[1] = a.y; bias[2] = a.z; bias[3] = a.w; bias[4] = b2.x; bias[5] = b2.y; bias[6] = b2.z; bias[7] = b2.w; }
    u32x4 in[11];
    const int t0 = c * 128 + l0 - 3;
    const bf16_t* rp = proj + ((long)(b * SEQ) + t0) * NPROJ + C_X + ch0;
    asm volatile("" : "+v"(rp));
#pragma unroll
    for (int i = 0; i < 11; ++i) {
        const int t = t0 + i;
        in[i] = (u32x4){0u, 0u, 0u, 0u};
        if (t >= 0) in[i] = *(const u32x4*)(rp + (size_t)i * NPROJ);
    }
    if (TRANS) {
#pragma unroll
        for (int ci = 0; ci < 8; ++ci) {
            float o[8];
#pragma unroll
            for (int li = 0; li < 8; ++li) { float a = bias[ci];
#pragma unroll
                for (int j = 0; j < 4; ++j) a += wgt[j][ci] * bfel(in[li + j], ci);
                o[li] = siluf(a) * f[li]; }
            res[ci] = (u32x4){pk2(o[0], o[1]), pk2(o[2], o[3]), pk2(o[4], o[5]), pk2(o[6], o[7])};
        }
    } else {
#pragma unroll
        for (int li = 0; li < 8; ++li) {
            float o[8];
#pragma unroll
            for (int ci = 0; ci < 8; ++ci) { float a = bias[ci];
#pragma unroll
                for (int j = 0; j < 4; ++j) a += wgt[j][ci] * bfel(in[li + j], ci);
                o[ci] = siluf(a) * f[li]; }
            res[li] = (u32x4){pk2(o[0], o[1]), pk2(o[2], o[3]), pk2(o[4], o[5]), pk2(o[6], o[7])};
        }
    }
}

__device__ __forceinline__ void conv2x8T(const Params& p, int b, int c, int l0, int ch0, u32x4 (&res)[2]) {
    const bf16_t* proj = (const bf16_t*)(p.ws + WS_PROJ);
    const float* cw = p.in[6]; const float* cb = p.in[7];
    float wgt[4][2], bias[2];
#pragma unroll
    for (int j = 0; j < 4; ++j) { wgt[j][0] = cw[j * 1024 + ch0]; wgt[j][1] = cw[j * 1024 + ch0 + 1]; }
    bias[0] = cb[ch0]; bias[1] = cb[ch0 + 1];
    unsigned in[11];
    const int t0 = c * 128 + l0 - 3;
    const bf16_t* rp = proj + ((long)(b * SEQ) + t0) * NPROJ + C_X + ch0;
    asm volatile("" : "+v"(rp));
#pragma unroll
    for (int i = 0; i < 11; ++i) { const int t = t0 + i; in[i] = 0u; if (t >= 0) in[i] = *(const unsigned*)(rp + (size_t)i * NPROJ); }
#pragma unroll
    for (int ci = 0; ci < 2; ++ci) {
        float o[8];
#pragma unroll
        for (int li = 0; li < 8; ++li) { float a = bias[ci];
#pragma unroll
            for (int j = 0; j < 4; ++j) a += wgt[j][ci] * (ci ? bfhi(in[li + j]) : bflo(in[li + j]));
            o[li] = siluf(a); }
        res[ci] = (u32x4){pk2(o[0], o[1]), pk2(o[2], o[3]), pk2(o[4], o[5]), pk2(o[6], o[7])};
    }
}

__device__ __forceinline__ void ssd_dt_cum(const Params& p, int b, int c, float* dts, float* cums) {
    const int tid = opaque_tid(), lane = tid & 63, w = tid >> 6;
    const float* dtraw = (const float*)(p.ws + WS_DTRAW);
    const float bias = p.in[8][w], a = -__expf(p.in[9][w]);
    const size_t row0 = (size_t)b * SEQ + c * 128;
    float x0 = dtraw[(row0 + 2 * lane) * 8 + w] + bias, x1 = dtraw[(row0 + 2 * lane + 1) * 8 + w] + bias;
    const float d0 = fmaxf(x0, 0.f) + log1pf(__expf(-fabsf(x0))), d1 = fmaxf(x1, 0.f) + log1pf(__expf(-fabsf(x1)));
    const float a0 = d0 * a, a1 = d1 * a;
    float s = a0 + a1;
#pragma unroll
    for (int o = 1; o < 64; o <<= 1) { const float t = __shfl_up(s, o); if (lane >= o) s += t; }
    dts[w * 128 + 2 * lane] = d0; dts[w * 128 + 2 * lane + 1] = d1;
    cums[w * 128 + 2 * lane] = s - a1; cums[w * 128 + 2 * lane + 1] = s;
}

__device__ __forceinline__ void attn_unit(const Params& p, const bf16_t* sK, const bf16_t* sV, const float* cs, const float* sn, float* ssq, int b, int blk, int hq, int rg, int lane, u32x2 (&oh)[8]) {
    const int r = lane & 31, h = lane >> 5;
    const bf16_t* proj = (const bf16_t*)(p.ws + WS_PROJ);
    const int tband0 = blk * 128 - 128;
    const bf16_t* qp = proj + (size_t)(b * SEQ + blk * 128 + rg * 32 + r) * NPROJ + hq * 64 + 8 * h;
    u32x4 qv[4];
#pragma unroll
    for (int kk = 0; kk < 4; ++kk) qv[kk] = *(const u32x4*)(qp + kk * 16);
    {
        u32x4 ot; ot.x = __shfl_xor(qv[0].x, 32); ot.y = __shfl_xor(qv[0].y, 32); ot.z = __shfl_xor(qv[0].z, 32); ot.w = __shfl_xor(qv[0].w, 32);
        const float* cp = cs + (128 + rg * 32 + r) * 8; const float* sp = sn + (128 + rg * 32 + r) * 8;
        float o[8];
#pragma unroll
        for (int f = 0; f < 8; ++f) {
            const float mine = bfel(qv[0], f), oth = bfel(ot, f), c = cp[f], sv = sp[f];
            o[f] = h ? (mine * c + oth * sv) : (mine * c - oth * sv);
        }
        qv[0] = (u32x4){pk2(o[0], o[1]), pk2(o[2], o[3]), pk2(o[4], o[5]), pk2(o[6], o[7])};
    }
    f32x16 S[5];
#pragma unroll
    for (int jt = 0; jt < 5; ++jt) S[jt] = zero16();
    const bf16_t* kp = sK + (rg * 32 + r) * 72 + 8 * h;
#pragma unroll
    for (int kk = 0; kk < 4; ++kk) {
        const bf16x8 qf = __builtin_bit_cast(bf16x8, qv[kk]);
#pragma unroll
        for (int jt = 0; jt < 5; ++jt) { const bf16x8 a = *(const bf16x8*)(kp + jt * (32 * 72) + kk * 16); S[jt] = mfma32(a, qf, S[jt]); }
    }
    const float sink = p.in[5][hq] * 8.f;
    float m = sink;
    const bool noprev = (blk == 0);
#pragma unroll
    for (int jt = 0; jt < 5; ++jt)
#pragma unroll
        for (int i = 0; i < 16; ++i) {
            const int cr = (i & 3) + 8 * (i >> 2) + 4 * h;
            bool ok = true;
            if (jt == 0) ok = cr > r;
            if (jt == 4) ok = cr <= r;
            if (noprev && (rg + jt) < 4) ok = false;
            const float v = ok ? S[jt][i] : -INFINITY; S[jt][i] = v; m = fmaxf(m, v);
        }
    m = fmaxf(m, __shfl_xor(m, 32));
    const float sc = 0.125f * 1.4426950408889634f;
    float sum = 0.f;
    bf16x8 P[10];
#pragma unroll
    for (int jt = 0; jt < 5; ++jt) {
        float e[16];
#pragma unroll
        for (int i = 0; i < 16; ++i) { e[i] = __builtin_amdgcn_exp2f((S[jt][i] - m) * sc); sum += e[i]; }
        P[2 * jt] = pack8(e[0], e[1], e[2], e[3], e[4], e[5], e[6], e[7]);
        P[2 * jt + 1] = pack8(e[8], e[9], e[10], e[11], e[12], e[13], e[14], e[15]);
    }
    sum += __shfl_xor(sum, 32);
    sum += __builtin_amdgcn_exp2f((sink - m) * sc);
    const float inv = 1.f / sum;
    f32x16 O0 = zero16(), O1 = zero16();
    const bf16_t* vp0 = sV + r * 260 + rg * 32 + 4 * h;
#pragma unroll
    for (int ts = 0; ts < 10; ++ts) {
        const bf16_t* vp = vp0 + 16 * ts;
        const u32x2 lo0 = *(const u32x2*)vp, hi0 = *(const u32x2*)(vp + 8);
        const u32x2 lo1 = *(const u32x2*)(vp + 32 * 260), hi1 = *(const u32x2*)(vp + 32 * 260 + 8);
        O0 = mfma32(__builtin_bit_cast(bf16x8, (u32x4){lo0.x, lo0.y, hi0.x, hi0.y}), P[ts], O0);
        O1 = mfma32(__builtin_bit_cast(bf16x8, (u32x4){lo1.x, lo1.y, hi1.x, hi1.y}), P[ts], O1);
    }
    float q = 0.f;
#pragma unroll
    for (int g = 0; g < 4; ++g) {
        const unsigned a0 = pk2(O0[4 * g] * inv, O0[4 * g + 1] * inv), a1 = pk2(O0[4 * g + 2] * inv, O0[4 * g + 3] * inv);
        const unsigned b0 = pk2(O1[4 * g] * inv, O1[4 * g + 1] * inv), b1 = pk2(O1[4 * g + 2] * inv, O1[4 * g + 3] * inv);
        oh[g] = (u32x2){a0, a1}; oh[4 + g] = (u32x2){b0, b1};
        q += (bflo(a0) * bflo(a0) + bfhi(a0) * bfhi(a0)) + (bflo(a1) * bflo(a1) + bfhi(a1) * bfhi(a1)) + (bflo(b0) * bflo(b0) + bfhi(b0) * bfhi(b0)) + (bflo(b1) * bflo(b1) + bfhi(b1) * bfhi(b1));
    }
    q += __shfl_xor(q, 32);
    if (h == 0) ssq[(rg * 32 + r) * 8 + hq] = q;
}

__device__ __forceinline__ void phase2_attn(const Params& p, unsigned char* lds, int b, int blk) {
    const int tid = opaque_tid(), lane = tid & 63, w = tid >> 6, r = lane & 31, h = lane >> 5;
    const bf16_t* proj = (const bf16_t*)(p.ws + WS_PROJ);
    const int* positions = (const int*)p.in[2];
    float* cs = (float*)lds;
    float* sn = cs + 2048;
    float* ssq = sn + 2048;
    bf16_t* sK = (bf16_t*)(lds + 20480);
    bf16_t* sV = sK + 256 * 72;
    const int tband0 = blk * 128 - 128;
    for (int i = tid; i < 2048; i += NTHREADS) {
        const int kb = i >> 3, f = i & 7, t = tband0 + kb;
        float c = 1.f, sv = 0.f;
        if (t >= 0) { const float ang = (float)positions[b * SEQ + t] * p.inv_freq[f]; const double rev = (double)ang * 0.15915494309189535; const float fr = (float)(rev - floor(rev));
            c = __builtin_amdgcn_cosf(fr); sv = __builtin_amdgcn_sinf(fr); }
        cs[i] = c; sn[i] = sv;
    }
    u32x2 oh[4][8];
#pragma unroll
    for (int g = 0; g < 2; ++g) {
        __syncthreads();
        {
            const int key = tid >> 1, half = tid & 1, t = tband0 + key;
            u32x4 kv[4];
#pragma unroll
            for (int q = 0; q < 4; ++q) kv[q] = (u32x4){0u, 0u, 0u, 0u};
            if (t >= 0) { const bf16_t* kp = proj + (size_t)(b * SEQ + t) * NPROJ + C_K + g * 64 + half * 32;
#pragma unroll
                for (int q = 0; q < 4; ++q) kv[q] = *(const u32x4*)(kp + 8 * q); }
            if (half == 0) {
                float o1[8], o2[8];
#pragma unroll
                for (int f = 0; f < 8; ++f) { const float x1 = bfel(kv[0], f), x2 = bfel(kv[1], f), c = cs[key * 8 + f], sv = sn[key * 8 + f]; o1[f] = x1 * c - x2 * sv; o2[f] = x2 * c + x1 * sv; }
                kv[0] = (u32x4){pk2(o1[0], o1[1]), pk2(o1[2], o1[3]), pk2(o1[4], o1[5]), pk2(o1[6], o1[7])};
                kv[1] = (u32x4){pk2(o2[0], o2[1]), pk2(o2[2], o2[3]), pk2(o2[4], o2[5]), pk2(o2[6], o2[7])};
            }
#pragma unroll
            for (int q = 0; q < 4; ++q) *(u32x4*)(sK + key * 72 + half * 32 + 8 * q) = kv[q];
        }
        {
            const int kg = tid >> 3, dc = tid & 7;
            u32x4 v[4];
#pragma unroll
            for (int i = 0; i < 4; ++i) { const int t = tband0 + 4 * kg + i; v[i] = (u32x4){0u, 0u, 0u, 0u};
                if (t >= 0) v[i] = *(const u32x4*)(proj + (size_t)(b * SEQ + t) * NPROJ + C_V + g * 64 + dc * 8); }
            bf16_t* vd = sV + (dc * 8) * 260 + 4 * kg;
#define VT_ROW(j, W) { const unsigned e0 = ((j) & 1) ? (v[0].W >> 16) : (v[0].W & 0xffffu), e1 = ((j) & 1) ? (v[1].W >> 16) : (v[1].W & 0xffffu), e2 = ((j) & 1) ? (v[2].W >> 16) : (v[2].W & 0xffffu), e3 = ((j) & 1) ? (v[3].W >> 16) : (v[3].W & 0xffffu); \
                *(u32x2*)(vd + (j) * 260) = (u32x2){e0 | (e1 << 16), e2 | (e3 << 16)}; }
            VT_ROW(0, x) VT_ROW(1, x) VT_ROW(2, y) VT_ROW(3, y) VT_ROW(4, z) VT_ROW(5, z) VT_ROW(6, w) VT_ROW(7, w)
#undef VT_ROW
        }
        __syncthreads();
#pragma unroll
        for (int uu = 0; uu < 2; ++uu) {
            const int u = w + 8 * uu;
            attn_unit(p, sK, sV, cs, sn, ssq, b, blk, g * 4 + (u >> 2), u & 3, lane, oh[g * 2 + uu]);
            __builtin_amdgcn_sched_barrier(0);
        }
    }
    __syncthreads();
    {
        bf16_t* A2 = (bf16_t*)(p.ws + WS_A2);
        const float* wa = p.in[11];
#pragma unroll
        for (int k = 0; k < 4; ++k) {
            const int u = w + 8 * (k & 1), hq = (k >> 1) * 4 + (u >> 2), rg = u & 3, ql = rg * 32 + r;
            const f32x4 s0 = *(const f32x4*)(ssq + ql * 8), s1 = *(const f32x4*)(ssq + ql * 8 + 4);
            const float rstd = 1.f / sqrtf((((s0.x + s0.y) + (s0.z + s0.w)) + ((s1.x + s1.y) + (s1.z + s1.w))) * (1.f / 512.f) + EPS);
            bf16_t* op = A2 + (size_t)(b * SEQ + blk * 128 + ql) * 1024 + hq * 64 + 4 * h;
#pragma unroll
            for (int j = 0; j < 8; ++j) {
                const int d0 = 32 * (j >> 2) + 8 * (j & 3);
                const f32x4 wv = *(const f32x4*)(wa + hq * 64 + d0 + 4 * h);
                const u32x2 t = oh[k][j];
                u32x2 o; o.x = pk2(bflo(t.x) * rstd * wv.x, bfhi(t.x) * rstd * wv.y); o.y = pk2(bflo(t.y) * rstd * wv.z, bfhi(t.y) * rstd * wv.w);
                *(u32x2*)(op + d0) = o;
            }
        }
    }
    __syncthreads();
}

__device__ __forceinline__ void phase2_states(const Params& p, unsigned char* lds, int b, int c) {
    const int tid = opaque_tid(), lane = tid & 63, w = tid >> 6, r = lane & 31, h = lane >> 5;
    float* dts = (float*)lds;
    float* cums = dts + 1024;
    bf16_t* sBT = (bf16_t*)(lds + 8192);
    bf16_t* sXT = sBT + 128 * 136;
    ssd_dt_cum(p, b, c, dts, cums);
    __syncthreads();
    bf16_t* states = (bf16_t*)(p.ws + WS_START);
    if (tid < 8) ((float*)(p.ws + WS_CDEC))[(b * NCH + c) * 8 + tid] = __expf(cums[tid * 128 + 127]);
#pragma unroll 1
    for (int g = 0; g < 2; ++g) {
        if (tid < 256) {
            const int cg8 = tid & 15, lr = tid >> 4;
            const float one[8] = {1.f, 1.f, 1.f, 1.f, 1.f, 1.f, 1.f, 1.f};
            u32x4 res[8];
            conv8x8<true>(p, b, c, lr * 8, 512 + g * 128 + cg8 * 8, one, res);
#pragma unroll
            for (int ci = 0; ci < 8; ++ci) *(u32x4*)(sBT + (cg8 * 8 + ci) * 136 + lr * 8) = res[ci];
        }
        {
            const int cg8 = tid & 31, lr = tid >> 5, hh = cg8 >> 3, hd = g * 4 + hh;
            float f[8];
            const float cl = cums[hd * 128 + 127];
#pragma unroll
            for (int li = 0; li < 8; ++li) f[li] = dts[hd * 128 + lr * 8 + li] * __expf(cl - cums[hd * 128 + lr * 8 + li]);
            u32x4 res[8];
            conv8x8<true>(p, b, c, lr * 8, g * 256 + cg8 * 8, f, res);
#pragma unroll
            for (int ci = 0; ci < 8; ++ci) *(u32x4*)(sXT + (cg8 * 8 + ci) * 136 + lr * 8) = res[ci];
        }
        __syncthreads();
        {
            f32x16 acc[4];
#pragma unroll
            for (int j = 0; j < 4; ++j) acc[j] = zero16();
#pragma unroll
            for (int kk = 0; kk < 128; kk += 16) {
                const bf16x8 a = *(const bf16x8*)(sXT + (w * 32 + r) * 136 + kk + 8 * h);
#pragma unroll
                for (int j = 0; j < 4; ++j) { const bf16x8 bb = *(const bf16x8*)(sBT + (j * 32 + r) * 136 + kk + 8 * h); acc[j] = mfma32(a, bb, acc[j]); }
            }
            const int hd = g * 4 + (w >> 1), p0 = (w & 1) * 32;
            bf16_t* sp = states + ((size_t)((b * NCH + c) * 8 + hd) * 64) * 128;
#pragma unroll
            for (int j = 0; j < 4; ++j)
#pragma unroll
                for (int i = 0; i < 16; ++i) sp[(size_t)(p0 + crow(i, h)) * 128 + j * 32 + r] = (bf16_t)f2bf(acc[j][i]);
        }
        __syncthreads();
    }
}

__device__ __forceinline__ void phase3(const Params& p) {
    const float* cdec = (const float*)(p.ws + WS_CDEC);
    bf16_t* start = (bf16_t*)(p.ws + WS_START);
    for (int u = blockIdx.x * NTHREADS + threadIdx.x; u < 131072; u += gridDim.x * NTHREADS) {
        const int n4 = u & 31, pp = (u >> 5) & 63, hd = (u >> 11) & 7, b = u >> 14;
        f32x4 s = (f32x4){0.f, 0.f, 0.f, 0.f};
        for (int c = 0; c < NCH; ++c) {
            const size_t off = ((size_t)((b * NCH + c) * 8 + hd) * 64 + pp) * 128 + n4 * 4;
            const u32x2 t = *(const u32x2*)(start + off);
            u32x2 o; o.x = pk2(s.x, s.y); o.y = pk2(s.z, s.w);
            *(u32x2*)(start + off) = o;
            const f32x4 st = (f32x4){bflo(t.x), bfhi(t.x), bflo(t.y), bfhi(t.y)};
            const float d = cdec[(b * NCH + c) * 8 + hd];
            s = s * d + st;
        }
    }
}

__device__ __forceinline__ void phase4(const Params& p, unsigned char* lds, int b, int c) {
    const int tid = opaque_tid(), lane = tid & 63, w = tid >> 6, r = lane & 31, h = lane >> 5;
    float* dts = (float*)lds;
    float* cums = dts + 1024;
    float* gsq = cums + 1024;
    bf16_t* sC = (bf16_t*)(lds + 12288);
    bf16_t* sB = sC + 128 * 136;
    bf16_t* sM = sB + 128 * 136;
    bf16_t* sXT = sM + 128 * 136;
    const bf16_t* proj = (const bf16_t*)(p.ws + WS_PROJ);
    const bf16_t* start = (const bf16_t*)(p.ws + WS_START);
    bf16_t* A2 = (bf16_t*)(p.ws + WS_A2);
    ssd_dt_cum(p, b, c, dts, cums);
    __syncthreads();
    const size_t row0 = (size_t)b * SEQ + c * 128;
#pragma unroll 1
    for (int g = 0; g < 2; ++g) {
        {
            const int which = tid >> 8, cg8 = tid & 15, lr = (tid >> 4) & 15;
            const float one[8] = {1.f, 1.f, 1.f, 1.f, 1.f, 1.f, 1.f, 1.f};
            u32x4 res[8];
            conv8x8<false>(p, b, c, lr * 8, (which ? 768 : 512) + g * 128 + cg8 * 8, one, res);
            bf16_t* dst = which ? sC : sB;
#pragma unroll
            for (int li = 0; li < 8; ++li) *(u32x4*)(dst + (lr * 8 + li) * 136 + cg8 * 8) = res[li];
        }
        __syncthreads();
        f32x16 cb0 = zero16(), cb1 = zero16();
        const int lt = w >> 1, st0 = 2 * (w & 1);
#pragma unroll 2
        for (int kk = 0; kk < 128; kk += 16) {
            const bf16x8 a = *(const bf16x8*)(sC + (lt * 32 + r) * 136 + kk + 8 * h);
            const bf16x8 b0 = *(const bf16x8*)(sB + (st0 * 32 + r) * 136 + kk + 8 * h);
            const bf16x8 b1 = *(const bf16x8*)(sB + ((st0 + 1) * 32 + r) * 136 + kk + 8 * h);
            cb0 = mfma32(a, b0, cb0); cb1 = mfma32(a, b1, cb1);
        }
        __syncthreads();
        bf16_t* sS = sB;
        bf16_t* sZ = sB + 64 * 136;
#pragma unroll 1
        for (int hh = 0; hh < 4; ++hh) {
            const int hd = g * 4 + hh;
            u32x4 stv[2], zv[2];
            {
                const bf16_t* stb = start + ((size_t)((b * NCH + c) * 8 + hd) * 64) * 128;
#pragma unroll
                for (int i = 0; i < 2; ++i) { const int id = tid + 512 * i; stv[i] = *(const u32x4*)(stb + (id >> 4) * 128 + (id & 15) * 8); }
#pragma unroll
                for (int i = 0; i < 2; ++i) { const int id = tid + 512 * i; zv[i] = *(const u32x4*)(proj + (row0 + (id >> 3)) * NPROJ + C_Z + hd * 64 + (id & 7) * 8); }
            }
#pragma unroll
            for (int i = 0; i < 16; ++i) {
                const int l = lt * 32 + crow(i, h);
                const float cl = cums[hd * 128 + l];
                { const int s = st0 * 32 + r; const float v = (s <= l) ? cb0[i] * __expf(cl - cums[hd * 128 + s]) * dts[hd * 128 + s] : 0.f; sM[l * 136 + s] = (bf16_t)f2bf(v); }
                { const int s = (st0 + 1) * 32 + r; const float v = (s <= l) ? cb1[i] * __expf(cl - cums[hd * 128 + s]) * dts[hd * 128 + s] : 0.f; sM[l * 136 + s] = (bf16_t)f2bf(v); }
            }
            __builtin_amdgcn_sched_barrier(0);
            {
                const int cp = tid & 31, lr = tid >> 5;
                u32x4 res[2];
                conv2x8T(p, b, c, lr * 8, hd * 64 + cp * 2, res);
                *(u32x4*)(sXT + (cp * 2) * 136 + lr * 8) = res[0];
                *(u32x4*)(sXT + (cp * 2 + 1) * 136 + lr * 8) = res[1];
            }
#pragma unroll
            for (int i = 0; i < 2; ++i) { const int id = tid + 512 * i; *(u32x4*)(sS + (id >> 4) * 136 + (id & 15) * 8) = stv[i]; *(u32x4*)(sZ + (id >> 3) * 64 + (id & 7) * 8) = zv[i]; }
            __syncthreads();
            {
                const int lt2 = w >> 1, pt = w & 1;
                f32x16 yd = zero16(), yo = zero16();
#pragma unroll 2
                for (int kk = 0; kk < 128; kk += 16) {
                    const bf16x8 a = *(const bf16x8*)(sM + (lt2 * 32 + r) * 136 + kk + 8 * h);
                    const bf16x8 bb = *(const bf16x8*)(sXT + (pt * 32 + r) * 136 + kk + 8 * h);
                    yd = mfma32(a, bb, yd);
                }
#pragma unroll 2
                for (int kk = 0; kk < 128; kk += 16) {
                    const bf16x8 a = *(const bf16x8*)(sC + (lt2 * 32 + r) * 136 + kk + 8 * h);
                    const bf16x8 bb = *(const bf16x8*)(sS + (pt * 32 + r) * 136 + kk + 8 * h);
                    yo = mfma32(a, bb, yo);
                }
                const float dsk = p.in[10][hd];
                const int pcol = pt * 32 + r;
                int lb = lt2 * 32 + 4 * h;
                asm volatile("" : "+v"(lb));
                bf16_t* gp = A2 + (row0 + lb) * 1024 + 512 + hd * 64 + pcol;
#pragma unroll
                for (int i = 0; i < 16; ++i) {
                    const int dl = (i & 3) + 8 * (i >> 2);
                    const int l = lb + dl;
                    const float xs = bf2f((unsigned)sXT[pcol * 136 + l]);
                    const float y = yd[i] + __expf(cums[hd * 128 + l]) * yo[i] + dsk * xs;
                    const float z = bf2f((unsigned)sZ[l * 64 + pcol]);
                    const unsigned gh = f2bf(y * siluf(z));
                    gp[dl * 1024] = (bf16_t)gh;
                    const float gv = bf2f(gh);
                    float q = gv * gv;
#pragma unroll
                    for (int o = 16; o >= 1; o >>= 1) q += __shfl_xor(q, o);
                    if (r == 0) gsq[l * 8 + hh * 2 + pt] = q;
                }
            }
            __syncthreads();
        }
        {
            const float* wsn = p.in[12];
            for (int i = tid; i < 128 * 32; i += NTHREADS) {
                const int l = i >> 5, c8 = (i & 31) * 8;
                float s = 0.f;
#pragma unroll
                for (int q = 0; q < 8; ++q) s += gsq[l * 8 + q];
                const float rstd = 1.f / sqrtf(s * (1.f / 256.f) + EPS);
                const u32x4 t = *(const u32x4*)(A2 + (row0 + l) * 1024 + 512 + g * 256 + c8);
                const f32x4 w0 = *(const f32x4*)(wsn + g * 256 + c8), w1 = *(const f32x4*)(wsn + g * 256 + c8 + 4);
                u32x4 o; o.x = pk2(bflo(t.x) * rstd * w0.x, bfhi(t.x) * rstd * w0.y); o.y = pk2(bflo(t.y) * rstd * w0.z, bfhi(t.y) * rstd * w0.w); o.z = pk2(bflo(t.z) * rstd * w1.x, bfhi(t.z) * rstd * w1.y); o.w = pk2(bflo(t.w) * rstd * w1.z, bfhi(t.w) * rstd * w1.w);
                *(u32x4*)(A2 + (row0 + l) * 1024 + 512 + g * 256 + c8) = o;
            }
        }
        __syncthreads();
    }
}

__device__ __forceinline__ void phase5(const Params& p, unsigned char* lds) {
    unsigned char* ws = p.ws;
    pg8::Gemm g{(const bf16_t*)(ws + WS_A2), (const bf16_t*)(ws + WS_WOUT), NT, DM, DM};
    pg8::StaticOrder S; S.init(NT, DM, (int)gridDim.x, (int)blockIdx.x);
    pg8::EpiResid<true, true> E{p.in[0], (bf16_t*)(ws + WS_XB), (float*)(ws + WS_SSQ)};
    pg8::gemm_phase<pg8::EpiResid<true, true>, pg8::StaticOrder, true, true>(LDS3(lds), g, S, E);
}
__device__ __forceinline__ void phase6(const Params& p, unsigned char* lds) {
    unsigned char* ws = p.ws;
    pg8::Gemm g{(const bf16_t*)(ws + WS_XB), (const bf16_t*)(ws + WS_WQ), NT, 512, DM};
    pg8::StaticOrder S; S.init(NT, 512, (int)gridDim.x, (int)blockIdx.x);
    pg8::EpiQ E{(bf16_t*)(ws + WS_Q2), (const float*)(ws + WS_SSQ)};
    pg8::gemm_phase<pg8::EpiQ, pg8::StaticOrder, true, true>(LDS3(lds), g, S, E);
}
__device__ __forceinline__ void phase8(const Params& p, unsigned char* lds) {
    unsigned char* ws = p.ws;
    pg8::Gemm g{(const bf16_t*)(ws + WS_XO), (const bf16_t*)(ws + WS_WO), NT, DM, 512};
    pg8::StaticOrder S; S.init(NT, DM, (int)gridDim.x, (int)blockIdx.x);
    pg8::EpiResid<false, false> E{(const void*)(ws + WS_XB), (bf16_t*)(ws + WS_XB), nullptr};
    pg8::gemm_phase<pg8::EpiResid<false, false>, pg8::StaticOrder, true, true>(LDS3(lds), g, S, E);
}

__device__ __forceinline__ void phase7(const Params& p, unsigned char* lds) {
    const int tid = opaque_tid(), lane = tid & 63, w = tid >> 6, r = lane & 31, h = lane >> 5;
    const bf16_t* q2 = (const bf16_t*)(p.ws + WS_Q2); const bf16_t* kmem = (const bf16_t*)(p.ws + WS_KMEM); const bf16_t* vmemT = (const bf16_t*)(p.ws + WS_VMEMT);
    bf16_t* xo = (bf16_t*)(p.ws + WS_XO);
    bf16_t* sK = (bf16_t*)lds;
    bf16_t* sV = sK + 256 * 136;
    const float sc = 0.08838834764831845f * 1.4426950408889634f;
    for (int pr = blockIdx.x; pr < 256; pr += gridDim.x) {
        const int bh = pr >> 3, rp = pr & 7, b = bh >> 2, hx = bh & 3;
        __syncthreads();
        for (int i = tid; i < 4096; i += NTHREADS) { const int key = i >> 4, ch = i & 15;
            *(u32x4*)(sK + key * 136 + ch * 8) = *(const u32x4*)(kmem + ((size_t)b * 256 + key) * 512 + hx * 128 + ch * 8); }
        for (int i = tid; i < 4096; i += NTHREADS) { const int d = i >> 5, ch = i & 31;
            const u32x4 v = *(const u32x4*)(vmemT + (((size_t)b * 4 + hx) * 128 + d) * 256 + ch * 8);
            *(u32x2*)(sV + d * 260 + ch * 8) = (u32x2){v.x, v.y}; *(u32x2*)(sV + d * 260 + ch * 8 + 4) = (u32x2){v.z, v.w}; }
        __syncthreads();
#pragma unroll 1
        for (int ib = 0; ib < 2; ++ib) {
            const size_t row0 = (size_t)b * SEQ + (size_t)(2 * rp + ib) * 256 + w * 32;
            bf16x8 qf[8];
            const bf16_t* qp = q2 + (row0 + r) * 512 + hx * 128 + 8 * h;
#pragma unroll
            for (int kk = 0; kk < 8; ++kk) qf[kk] = *(const bf16x8*)(qp + kk * 16);
            f32x16 S[8];
#pragma unroll
            for (int t = 0; t < 8; ++t) S[t] = zero16();
            const bf16_t* kp = sK + r * 136 + 8 * h;
#pragma unroll
            for (int kk = 0; kk < 8; ++kk) {
#pragma unroll
                for (int t = 0; t < 8; ++t) { const bf16x8 a = *(const bf16x8*)(kp + t * (32 * 136) + kk * 16); S[t] = mfma32(a, qf[kk], S[t]); }
                __builtin_amdgcn_sched_barrier(0);
            }
            float m = -INFINITY;
#pragma unroll
            for (int t = 0; t < 8; ++t)
#pragma unroll
                for (int i = 0; i < 16; ++i) m = fmaxf(m, S[t][i]);
            m = fmaxf(m, __shfl_xor(m, 32));
            float sum = 0.f;
            bf16x8 P[16];
#pragma unroll
            for (int t = 0; t < 8; ++t) {
                float e[16];
#pragma unroll
                for (int i = 0; i < 16; ++i) { e[i] = __builtin_amdgcn_exp2f((S[t][i] - m) * sc); sum += e[i]; }
                P[2 * t] = pack8(e[0], e[1], e[2], e[3], e[4], e[5], e[6], e[7]);
                P[2 * t + 1] = pack8(e[8], e[9], e[10], e[11], e[12], e[13], e[14], e[15]);
            }
            sum += __shfl_xor(sum, 32);
            const float inv = 1.f / sum;
            f32x16 O[4];
#pragma unroll
            for (int dt = 0; dt < 4; ++dt) O[dt] = zero16();
            const bf16_t* vp0 = sV + r * 260 + 4 * h;
#pragma unroll
            for (int ts = 0; ts < 16; ++ts) {
#pragma unroll
                for (int dt = 0; dt < 4; ++dt) {
                    const bf16_t* vp = vp0 + dt * (32 * 260) + 16 * ts;
                    const u32x2 lo = *(const u32x2*)vp, hi = *(const u32x2*)(vp + 8);
                    const bf16x8 a = __builtin_bit_cast(bf16x8, (u32x4){lo.x, lo.y, hi.x, hi.y});
                    O[dt] = mfma32(a, P[ts], O[dt]);
                }
                if (ts & 1) __builtin_amdgcn_sched_barrier(0);
            }
            bf16_t* op = xo + (row0 + r) * 512 + hx * 128 + 4 * h;
#pragma unroll
            for (int dt = 0; dt < 4; ++dt)
#pragma unroll
                for (int g = 0; g < 4; ++g) { u32x2 o; o.x = pk2(O[dt][4 * g] * inv, O[dt][4 * g + 1] * inv); o.y = pk2(O[dt][4 * g + 2] * inv, O[dt][4 * g + 3] * inv);
                    *(u32x2*)(op + 32 * dt + 8 * g) = o; }
        }
    }
}

__device__ __forceinline__ void phase9(const Params& p) {
    const int tid = opaque_tid(), lane = tid & 63, w = tid >> 6;
    const int gw = blockIdx.x * NWAVES + w, NGW = gridDim.x * NWAVES;
    const bf16_t* x2 = (const bf16_t*)(p.ws + WS_XB);
    const float* WR = (const float*)(p.ws + WS_WR);
    int* cnt = (int*)(p.ws + WS_CTL);
    int* list = (int*)(p.ws + WS_LIST);
    float* route = (float*)(p.ws + WS_ROUTE);
    const float* bg = p.in[21]; const float* be = p.in[23];
    for (int m = gw; m < NT; m += NGW) {
        const u32x2* xr = (const u32x2*)(x2 + (size_t)m * DM) + lane;
        f32x4 v[4]; float s = 0.f;
#pragma unroll
        for (int j = 0; j < 4; ++j) { const u32x2 t = xr[64 * j]; v[j] = (f32x4){bflo(t.x), bfhi(t.x), bflo(t.y), bfhi(t.y)}; s += (v[j].x * v[j].x + v[j].y * v[j].y) + (v[j].z * v[j].z + v[j].w * v[j].w); }
        const float rstd = 1.f / sqrtf(wave_sum(s) * (1.f / DM) + EPS);
        float mine = 0.f;
#ifdef PROBE_PHASE
        if (PROBE_PHASE == 9) {
#pragma unroll 4
        for (int n = 0; n < 36; ++n) {
            float a = 0.f;
#pragma unroll
            for (int j = 0; j < 4; ++j) { const f32x4 ww = *(const f32x4*)(WR + n * 1024 + 4 * lane + 256 * j); a += (v[j].x * ww.x + v[j].y * ww.y) + (v[j].z * ww.z + v[j].w * ww.w); }
            a = wave_sum(a) * rstd;
            if (lane == n) mine = a;
        }
        asm volatile("" : "+v"(mine));
        mine = 0.f;
        }
#endif
#pragma unroll 4
        for (int n = 0; n < 36; ++n) {
            float a = 0.f;
#pragma unroll
            for (int j = 0; j < 4; ++j) { const f32x4 ww = *(const f32x4*)(WR + n * 1024 + 4 * lane + 256 * j); a += (v[j].x * ww.x + v[j].y * ww.y) + (v[j].z * ww.z + v[j].w * ww.w); }
            a = wave_sum(a) * rstd;
            if (lane == n) mine = a;
        }
        if (lane < 4) mine += bg[lane]; else if (lane < 36) mine += be[lane - 4];
        const float g0 = __shfl(mine, 0), g1 = __shfl(mine, 1), g2 = __shfl(mine, 2), g3 = __shfl(mine, 3);
        int gi = 0; float gm = g0;
        if (g1 > gm) { gm = g1; gi = 1; }
        if (g2 > gm) { gm = g2; gi = 2; }
        if (g3 > gm) { gm = g3; gi = 3; }
        const float gden = __expf(g0 - gm) + __expf(g1 - gm) + __expf(g2 - gm) + __expf(g3 - gm);
        const float ggate = 1.f / gden;
        float ev[8];
#pragma unroll
        for (int j = 0; j < 8; ++j) ev[j] = __shfl(mine, 4 + gi * 8 + j);
        int i1 = 0; float v1 = ev[0];
#pragma unroll
        for (int j = 1; j < 8; ++j) if (ev[j] > v1) { v1 = ev[j]; i1 = j; }
        int i2 = -1; float v2 = -INFINITY;
#pragma unroll
        for (int j = 0; j < 8; ++j) if (j != i1 && ev[j] > v2) { v2 = ev[j]; i2 = j; }
        const float e2 = __expf(v2 - v1);
        const float w1 = ggate / (1.f + e2), w2 = ggate * e2 / (1.f + e2);
        if (lane == 0) {
            const int ea = gi * 8 + i1, eb = gi * 8 + i2;
            const int pa = atomicAdd(cnt + ea, 1), pb = atomicAdd(cnt + eb, 1);
            list[ea * NT + pa] = m; list[eb * NT + pb] = m;
            int* ri = (int*)(route + (size_t)m * 8);
            ri[0] = ea; ri[1] = eb; ri[2] = pa; ri[3] = pb;
            route[(size_t)m * 8 + 4] = w1; route[(size_t)m * 8 + 5] = w2; route[(size_t)m * 8 + 6] = rstd; route[(size_t)m * 8 + 7] = 0.f;
        }
    }
}

__device__ __forceinline__ int* moe_tables(const Params& p, unsigned char* lds) {
    int* off = (int*)(lds + 131072);
    const int* cnt = (const int*)(p.ws + WS_CTL);
    if (threadIdx.x == 0) { int a = 0; for (int e = 0; e < NEXP; ++e) { off[e] = a; a += ((cnt[e] + 255) >> 8) << 8; } off[NEXP] = a; }
    if (threadIdx.x < NEXP) off[40 + threadIdx.x] = cnt[threadIdx.x];
    __syncthreads();
    const int nrt = off[NEXP] >> 8;
    for (int rt = threadIdx.x; rt < nrt; rt += NTHREADS) { int e = 0; for (int q = 1; q < NEXP; ++q) if (off[q] <= rt * 256) e = q; off[128 + rt] = e; }
    __syncthreads();
    return off;
}

__device__ __forceinline__ void phase10(const Params& p, unsigned char* lds) {
    const int tid = opaque_tid(), lane = tid & 63, w = tid >> 6;
    const int* off = moe_tables(p, lds);
    const int gw = blockIdx.x * NWAVES + w, NGW = gridDim.x * NWAVES;
    const bf16_t* x2 = (const bf16_t*)(p.ws + WS_XB); const float* route = (const float*)(p.ws + WS_ROUTE);
    bf16_t* xg = (bf16_t*)(p.ws + WS_XG);
    for (int m = gw; m < NT; m += NGW) {
        const int* ri = (const int*)(route + (size_t)m * 8);
        const int ea = ri[0], eb = ri[1], pa = ri[2], pb = ri[3];
        const float rs = route[(size_t)m * 8 + 6];
        const size_t sa = (size_t)off[ea] + pa, sb = (size_t)off[eb] + pb;
        const u32x2* xr = (const u32x2*)(x2 + (size_t)m * DM) + lane;
        u32x2* oa = (u32x2*)(xg + sa * DM) + lane; u32x2* ob = (u32x2*)(xg + sb * DM) + lane;
#pragma unroll
        for (int j = 0; j < 4; ++j) { const u32x2 t = xr[64 * j]; u32x2 o; o.x = pk2(bflo(t.x) * rs, bfhi(t.x) * rs); o.y = pk2(bflo(t.y) * rs, bfhi(t.y) * rs); oa[64 * j] = o; ob[64 * j] = o; }
    }
}

__device__ __forceinline__ void phase11(const Params& p, unsigned char* lds) {
    const int* off = moe_tables(p, lds);
    pg8::Gemm g{(const bf16_t*)(p.ws + WS_XG), (const bf16_t*)(p.ws + WS_WGU), 0, 0, DM};
    pg8::MoeOrder S{(const __attribute__((address_space(3))) int*)(off + 128), off[NEXP] >> 8, 2, (int)gridDim.x, (int)blockIdx.x};
    pg8::EpiGU E{(bf16_t*)(p.ws + WS_HID)};
    pg8::gemm_phase<pg8::EpiGU, pg8::MoeOrder, true, true>(LDS3(lds), g, S, E);
}
__device__ __forceinline__ void phase12(const Params& p, unsigned char* lds) {
    const int* off = moe_tables(p, lds);
    int kdim = EFF; asm volatile("" : "+s"(kdim));
    pg8::Gemm g{(const bf16_t*)(p.ws + WS_HID), (const bf16_t*)(p.ws + WS_WD), 0, 0, kdim};
    pg8::MoeOrder S{(const __attribute__((address_space(3))) int*)(off + 128), off[NEXP] >> 8, 4, (int)gridDim.x, (int)blockIdx.x};
    pg8::EpiBf16 E{(bf16_t*)(p.ws + WS_Y), DM, 4};
    pg8::gemm_phase<pg8::EpiBf16, pg8::MoeOrder, true, true>(LDS3(lds), g, S, E);
}

__device__ __forceinline__ void phase13(const Params& p, unsigned char* lds) {
    const int tid = opaque_tid(), lane = tid & 63, w = tid >> 6;
    const int* off = moe_tables(p, lds);
    const int gw = blockIdx.x * NWAVES + w, NGW = gridDim.x * NWAVES;
    const bf16_t* x2 = (const bf16_t*)(p.ws + WS_XB); const bf16_t* yb = (const bf16_t*)(p.ws + WS_Y);
    const float* route = (const float*)(p.ws + WS_ROUTE); const float* wf = p.in[27];
    f32x4 wv[4];
#pragma unroll
    for (int j = 0; j < 4; ++j) wv[j] = *(const f32x4*)(wf + 4 * lane + 256 * j);
    for (int m = gw; m < NT; m += NGW) {
        const int* ri = (const int*)(route + (size_t)m * 8);
        const int ea = ri[0], eb = ri[1], pa = ri[2], pb = ri[3];
        const float w1 = route[(size_t)m * 8 + 4], w2 = route[(size_t)m * 8 + 5];
        const size_t sa = (size_t)off[ea] + pa, sb = (size_t)off[eb] + pb;
        const u32x2* xr = (const u32x2*)(x2 + (size_t)m * DM) + lane;
        const u32x2* ya = (const u32x2*)(yb + sa * DM) + lane; const u32x2* ybp = (const u32x2*)(yb + sb * DM) + lane;
        f32x4 v[4]; float s = 0.f;
#pragma unroll
        for (int j = 0; j < 4; ++j) {
            const u32x2 t = xr[64 * j]; v[j] = (f32x4){bflo(t.x), bfhi(t.x), bflo(t.y), bfhi(t.y)}; const u32x2 a = ya[64 * j], bq = ybp[64 * j];
            v[j].x += w1 * bflo(a.x) + w2 * bflo(bq.x); v[j].y += w1 * bfhi(a.x) + w2 * bfhi(bq.x);
            v[j].z += w1 * bflo(a.y) + w2 * bflo(bq.y); v[j].w += w1 * bfhi(a.y) + w2 * bfhi(bq.y);
            s += (v[j].x * v[j].x + v[j].y * v[j].y) + (v[j].z * v[j].z + v[j].w * v[j].w);
        }
        const float rstd = 1.f / sqrtf(wave_sum(s) * (1.f / DM) + EPS);
        f32x4* o = (f32x4*)(p.out + (size_t)m * DM) + lane;
#pragma unroll
        for (int j = 0; j < 4; ++j) o[64 * j] = v[j] * rstd * wv[j];
    }
}

constexpr int NPHASE = 14;
__global__ void __launch_bounds__(NTHREADS, 2) fwd_kernel(Params p) {
    extern __shared__ __attribute__((aligned(16))) unsigned char lds[];
#if MK_ONE_LAUNCH
    cg::grid_group grid = cg::this_grid();
    volatile LAS unsigned* bst = (volatile LAS unsigned*)(LDS3(lds) + LDS_BYTES - 16);
    if (threadIdx.x < 2) bst[threadIdx.x] = 0u;
    __syncthreads();
    const XcdBarrier xbar = xcd_barrier_post((unsigned*)(p.ws + WS_BAR), bst);
#define SEAM(k) do { if (p.ph_lo <= (k) && (k) + 1 < p.ph_hi) { if ((k) == 0) grid.sync(); else xcd_barrier(xbar); } } while (0)
#else
#define SEAM(k) do { } while (0)
#endif
#ifndef PROBE_PHASE
#define PROBE_PHASE -1
#endif
#define IN(k) (p.ph_lo <= (k) && (k) < p.ph_hi)
#define REPS(k) (((k) == PROBE_PHASE) ? 2 : 1)
    if (IN(0)) { _Pragma("unroll 1") for (int rep = 0; rep < REPS(0); ++rep) { phase0(p, lds); } } SEAM(0);
    if (IN(1)) { _Pragma("unroll 1") for (int rep = 0; rep < REPS(1); ++rep) { phase1(p, lds); } } SEAM(1);
    if (IN(2)) { _Pragma("unroll 1") for (int rep = 0; rep < REPS(2); ++rep) for (int it = blockIdx.x; it < NB * NCH; it += gridDim.x) { const int b = it / NCH, c = it % NCH; phase2_attn(p, lds, b, c); phase2_states(p, lds, b, c); } } SEAM(2);
    if (IN(3)) { _Pragma("unroll 1") for (int rep = 0; rep < REPS(3); ++rep) { phase3(p); } } SEAM(3);
    if (IN(4)) { _Pragma("unroll 1") for (int rep = 0; rep < REPS(4); ++rep) for (int it = blockIdx.x; it < NB * NCH; it += gridDim.x) { const int b = it / NCH, c = it % NCH; phase4(p, lds, b, c); } } SEAM(4);
    if (IN(5)) { _Pragma("unroll 1") for (int rep = 0; rep < REPS(5); ++rep) { phase5(p, lds); } } SEAM(5);
    if (IN(6)) { _Pragma("unroll 1") for (int rep = 0; rep < REPS(6); ++rep) { phase6(p, lds); } } SEAM(6);
    if (IN(7)) { _Pragma("unroll 1") for (int rep = 0; rep < REPS(7); ++rep) { phase7(p, lds); } } SEAM(7);
    if (IN(8)) { phase8(p, lds); } SEAM(8);
    if (IN(9)) { phase9(p); } SEAM(9);
    if (IN(10)) { _Pragma("unroll 1") for (int rep = 0; rep < REPS(10); ++rep) { phase10(p, lds); } } SEAM(10);
    if (IN(11)) { _Pragma("unroll 1") for (int rep = 0; rep < REPS(11); ++rep) { phase11(p, lds); } } SEAM(11);
    if (IN(12)) { _Pragma("unroll 1") for (int rep = 0; rep < REPS(12); ++rep) { phase12(p, lds); } } SEAM(12);
    if (IN(13)) { _Pragma("unroll 1") for (int rep = 0; rep < REPS(13); ++rep) { phase13(p, lds); } }
#undef IN
#undef SEAM
}

extern "C" void kernel_launch(void* const* d_in, const int* in_sizes, int n_in, void* d_out, int out_size, void* d_ws, size_t ws_size, hipStream_t stream) {
    static int grid = 0;
    if (grid == 0) {
        if (n_in != 28 || out_size != NT * DM || ws_size < WS_NEED) { fprintf(stderr, "kernel_launch: unexpected sizes n_in %d out %d ws %zu\n", n_in, out_size, ws_size); grid = -1; return; }
        int dev = 0, cus = 0, per_cu = 0;
        hipGetDevice(&dev);
        hipDeviceGetAttribute(&cus, hipDeviceAttributeMultiprocessorCount, dev);
        if (hipFuncSetAttribute((const void*)fwd_kernel, hipFuncAttributeMaxDynamicSharedMemorySize, LDS_BYTES) != hipSuccess) { fprintf(stderr, "kernel_launch: hipFuncSetAttribute failed\n"); grid = -1; return; }
        if (hipOccupancyMaxActiveBlocksPerMultiprocessor(&per_cu, (const void*)fwd_kernel, NTHREADS, LDS_BYTES) != hipSuccess || per_cu < 1) { fprintf(stderr, "kernel_launch: occupancy query says %d\n", per_cu); per_cu = 1; }
        (void)hipGetLastError();
        grid = cus;
    }
    if (grid < 0) return;
    Params prm{};
    for (int i = 0; i < 28; ++i) prm.in[i] = (const float*)d_in[i];
    prm.out = (float*)d_out; prm.ws = (unsigned char*)d_ws;
    for (int i = 0; i < 8; ++i) prm.inv_freq[i] = powf(500000.0f, -(float)(2 * i) / 16.0f);
    if (hipMemsetAsync((char*)d_ws + WS_CTL, 0, CTL_ZERO_BYTES, stream) != hipSuccess) { fprintf(stderr, "kernel_launch: memset failed\n"); return; }
#if MK_ONE_LAUNCH
    prm.ph_lo = 0; prm.ph_hi = NPHASE;
    void* args[] = {&prm};
    hipError_t e = hipLaunchCooperativeKernel((const void*)fwd_kernel, dim3(grid), dim3(NTHREADS), args, LDS_BYTES, stream);
    if (e != hipSuccess) fprintf(stderr, "cooperative launch failed: %s (grid %d)\n", hipGetErrorString(e), grid);
#else
#ifndef PROBE_DUP
#define PROBE_DUP -1
#endif
    for (int ph = 0; ph < NPHASE; ++ph) {
        prm.ph_lo = ph; prm.ph_hi = ph + 1;
        hipLaunchKernelGGL(fwd_kernel, dim3(grid), dim3(NTHREADS), LDS_BYTES, stream, prm);
        if (ph == PROBE_DUP) hipLaunchKernelGGL(fwd_kernel, dim3(grid), dim3(NTHREADS), LDS_BYTES, stream, prm);
    }
#endif
}
```

```cpp
#include <hip/hip_runtime.h>
#include <hip/hip_cooperative_groups.h>
#include <cstdio>
#include <cmath>
namespace cg = cooperative_groups;

#ifndef MK_ONE_LAUNCH
#define MK_ONE_LAUNCH 1
#endif

typedef unsigned short bf16_t;
typedef short bf16x8 __attribute__((ext_vector_type(8)));
typedef float f32x4 __attribute__((ext_vector_type(4)));
typedef float f32x16 __attribute__((ext_vector_type(16)));
typedef unsigned u32x4 __attribute__((ext_vector_type(4)));
typedef unsigned u32x2 __attribute__((ext_vector_type(2)));

constexpr int NB = 8, SEQ = 4096, DM = 1024, NT = NB * SEQ;
constexpr int NPROJ = 2304, LDWIN = 2312;
constexpr int C_K = 512, C_V = 640, C_Z = 768, C_X = 1280, C_B = 1792, C_C = 2048;
constexpr int MEMT = 256, NMEM = NB * MEMT;
constexpr int NEXP = 32, EFF = 256;
constexpr int NCH = SEQ / 128;
constexpr float EPS = 1e-5f;
constexpr int NTHREADS = 512, NWAVES = 8;
constexpr int LDS_BYTES = 147456;

constexpr size_t MiB = (size_t)1 << 20;
constexpr size_t WS_CTL = 0, WS_BAR = 65536, CTL_ZERO_BYTES = 131072;
constexpr size_t WS_WIN = 1 * MiB, WS_WOUT = 6 * MiB, WS_WQ = 8 * MiB, WS_WKV = 9 * MiB, WS_WO = 11 * MiB, WS_WR = 12 * MiB;
constexpr size_t WS_WGU = 16 * MiB, WS_WD = 48 * MiB;
constexpr size_t WS_MEMH = 64 * MiB, WS_KMEM = 68 * MiB, WS_VMEMT = 70 * MiB, WS_DTRAW = 72 * MiB, WS_CDEC = 73 * MiB, WS_ROUTE = 74 * MiB;
constexpr size_t WS_LIST = 76 * MiB, WS_SSQ = 80 * MiB;
constexpr size_t WS_PROJ = 96 * MiB, WS_A2 = 240 * MiB, WS_STATES = 304 * MiB, WS_START = 368 * MiB;
constexpr size_t WS_X1 = 96 * MiB, WS_XB = 304 * MiB, WS_Q2 = 368 * MiB, WS_XO = 224 * MiB, WS_XG = 96 * MiB, WS_HID = 368 * MiB, WS_Y = 96 * MiB;
constexpr size_t WS_H1 = 416 * MiB;
constexpr size_t WS_NEED = 512 * MiB;

struct Params {
    const float* in[28];
    float* out;
    unsigned char* ws;
    float inv_freq[8];
    int ph_lo, ph_hi, skip, pad;
};

__device__ __forceinline__ unsigned f2bf(float f) { unsigned u = __float_as_uint(f); return (u + 0x7fffu + ((u >> 16) & 1u)) >> 16; }
__device__ __forceinline__ float bf2f(unsigned h) { return __uint_as_float(h << 16); }
__device__ __forceinline__ unsigned pk2(float lo, float hi) { return f2bf(lo) | (f2bf(hi) << 16); }
__device__ __forceinline__ float bflo(unsigned u) { return __uint_as_float(u << 16); }
__device__ __forceinline__ float bfhi(unsigned u) { return __uint_as_float(u & 0xffff0000u); }
__device__ __forceinline__ float wave_sum(float v) {
#pragma unroll
    for (int o = 32; o >= 1; o >>= 1) v += __shfl_xor(v, o);
    return v;
}
#define LDS_WAIT() asm volatile("s_waitcnt lgkmcnt(0)" ::: "memory")
__device__ __forceinline__ int opaque_tid() { int t = threadIdx.x; asm volatile("" : "+v"(t)); return t; }
__device__ __forceinline__ float siluf(float v) { return v * __builtin_amdgcn_rcpf(1.f + __expf(-v)); }
__device__ __forceinline__ f32x16 mfma32(bf16x8 a, bf16x8 b, f32x16 c) { return __builtin_amdgcn_mfma_f32_32x32x16_bf16(a, b, c, 0, 0, 0); }
__device__ __forceinline__ f32x16 zero16() { f32x16 z;
#pragma unroll
    for (int i = 0; i < 16; ++i) z[i] = 0.f;
    return z; }
__device__ __forceinline__ bf16x8 pack8(float a0, float a1, float a2, float a3, float a4, float a5, float a6, float a7) {
    u32x4 t; t.x = pk2(a0, a1); t.y = pk2(a2, a3); t.z = pk2(a4, a5); t.w = pk2(a6, a7);
    return __builtin_bit_cast(bf16x8, t);
}
__device__ __forceinline__ int crow(int i, int h) { return (i & 3) + 8 * (i >> 2) + 4 * h; }

namespace pg8 {
#define PG8_LAS __attribute__((address_space(3)))
typedef unsigned short bf16_t;
typedef short bf16x8 __attribute__((ext_vector_type(8)));
typedef float f32x4 __attribute__((ext_vector_type(4)));
typedef unsigned u32x4 __attribute__((ext_vector_type(4)));
constexpr int BM = 256, BK = 64, HALF = 128, HTB = HALF * BK * 2  , STAGE_BYTES = 8 * HTB, NXCD = 8, WGM = 8;

__host__ __device__ __forceinline__ int lds_byte(int r, int c) { const int st = (r >> 4) * 2 + (c >> 5), rr = r & 15, cc = c & 31, ob = rr * 64 + cc * 2; return st * 1024 + (ob ^ (((ob >> 9) & 1) << 5)); }
__host__ __device__ __forceinline__ void stage_rc(int b, int& R, int& C) { const int st = b / 1024, sb = b % 1024, swz = sb ^ (((sb >> 9) & 1) << 5); R = (st >> 1) * 16 + swz / 64; C = (st & 1) * 32 + (swz % 64) / 2; }
__host__ __device__ __forceinline__ int perm32(int rho) { const int n = rho >> 4, i = rho & 15; return 8 * (i >> 2) + 4 * n + (i & 3); }

struct Unit { int pm, pn; };
struct Gemm { const bf16_t* A; const bf16_t* Bt; int M, N, K; };

struct StaticOrder {
    int nM, nN, nwg, G, c;
    __host__ __device__ void init(int M, int N, int G_, int c_) { nM = M / BM; nN = N / BM; nwg = nM * nN; G = G_; c = c_; }
    __host__ __device__ bool next(int i, Unit& u) const {
        const long L = (long)i * G + c; if (L >= nwg) return false;
        int wgid = (int)L; { const int q = nwg / NXCD, r = nwg % NXCD, xcd = wgid % NXCD, off = wgid / NXCD; wgid = (xcd < r ? xcd * (q + 1) : r * (q + 1) + (xcd - r) * q) + off; }
        const int nig = WGM * nN, gid = wgid / nig, fm = gid * WGM, gsz = (nM - fm) < WGM ? (nM - fm) : WGM;
        u.pm = fm + ((wgid % nig) % gsz); u.pn = (wgid % nig) / gsz; return true;
    }
    __device__ __forceinline__ void a_ready(const Unit&) const {}
    __device__ __forceinline__ void done(const Unit&) const {}
};
__device__ __forceinline__ unsigned cvt_pk_bf16(float lo, float hi) { unsigned r; asm volatile("v_cvt_pk_bf16_f32 %0, %1, %2" : "=v"(r) : "v"(lo), "v"(hi)); return r; }
typedef float f32x2 __attribute__((ext_vector_type(2)));
template <class Epi, class Sched, bool ALIGN_EPI = false, bool SP2 = false>
__device__ __forceinline__ void gemm_phase(PG8_LAS unsigned char* lds, const Gemm g, const Sched& S, const Epi& E) {
    const int tid = threadIdx.x, wid = __builtin_amdgcn_readfirstlane(tid >> 6), lane = tid & 63, wr = wid >> 2, wc = wid & 3, fr = lane & 15, fq = lane >> 4;
    const int K = g.K, nt = K / BK;
    unsigned voffA[2], voffB[2];
#pragma unroll
    for (int i = 0; i < 2; ++i) { int R, C; stage_rc(tid * 16 + i * 8192, R, C); const int Rb = Epi::PERM ? ((R & ~31) + perm32(R & 31)) : R;
        voffA[i] = (unsigned)(R * K + C) * 2u; voffB[i] = (unsigned)(Rb * K + C) * 2u; }
    const size_t kstep = (size_t)(BK * 2);
    const size_t hstep = (size_t)HALF * K * 2;
    const size_t tstep = 2 * hstep;
    const unsigned ldsw = (unsigned)wid * 1024u;
    const int aoff = lds_byte(wr * 64 + fr, fq * 8), boff = lds_byte(wc * 32 + fr, fq * 8);
#define PG8_SA(b, h) (((b) * 2 + (h)) * HTB)
#define PG8_SB(b, h) ((4 + (b) * 2 + (h)) * HTB)
#define PG8_STAGE(bufoff, gbase, voff) do { _Pragma("unroll") for (int _i = 0; _i < 2; ++_i) \
        __builtin_amdgcn_global_load_lds((const unsigned*)((const char*)(gbase) + (voff)[_i]), (PG8_LAS unsigned*)(lds + (bufoff) + ldsw + _i * 8192), 16, 0, 0); } while (0)
#define PG8_LDA(dst, b, h) do { _Pragma("unroll") for (int m = 0; m < 4; ++m) _Pragma("unroll") for (int k = 0; k < 2; ++k) dst[m][k] = *(const PG8_LAS bf16x8*)(lds + PG8_SA(b, h) + aoff + m * 2048 + k * 1024); } while (0)
#define PG8_LDB(dst, b, h) do { _Pragma("unroll") for (int n = 0; n < 2; ++n) _Pragma("unroll") for (int k = 0; k < 2; ++k) dst[n][k] = *(const PG8_LAS bf16x8*)(lds + PG8_SB(b, h) + boff + n * 2048 + k * 1024); } while (0)
#define PG8_MMA(ai, bj, At, Bt) do { __builtin_amdgcn_s_setprio(1); _Pragma("unroll") for (int m = 0; m < 4; ++m) _Pragma("unroll") for (int n = 0; n < 2; ++n) _Pragma("unroll") for (int k = 0; k < 2; ++k) \
        acc[ai][bj][m][n] = __builtin_amdgcn_mfma_f32_16x16x32_bf16(Bt[n][k], At[m][k], acc[ai][bj][m][n], 0, 0, 0); __builtin_amdgcn_s_setprio(0); } while (0)
#define PG8_WAIT_V(n) asm volatile("s_waitcnt vmcnt(" #n ")" ::: "memory")
#define PG8_WAIT_L(n) asm volatile("s_waitcnt lgkmcnt(" #n ")" ::: "memory")
#define PG8_BAR __builtin_amdgcn_s_barrier()
#define PG8_SCHED __builtin_amdgcn_sched_barrier(0)
    Unit cur, nxt; int ui = 0;
    if (!S.next(0, cur)) return;
    f32x4 acc[2][2][4][2];
#pragma unroll
    for (int a = 0; a < 2; ++a)
#pragma unroll
        for (int b = 0; b < 2; ++b)
#pragma unroll
            for (int m = 0; m < 4; ++m)
#pragma unroll
                for (int n = 0; n < 2; ++n) acc[a][b][m][n] = (f32x4){0.f, 0.f, 0.f, 0.f};
    bf16x8 At[4][2], B0[2][2], B1[2][2];
    const char* cA = (const char*)g.A + (size_t)cur.pm * tstep; const char* cB = (const char*)g.Bt + (size_t)cur.pn * tstep;
    S.a_ready(cur);
    if constexpr (SP2) {
        PG8_STAGE(PG8_SB(0, 0), cB, voffB); PG8_STAGE(PG8_SB(0, 1), cB + hstep, voffB); PG8_STAGE(PG8_SA(0, 0), cA, voffA); PG8_STAGE(PG8_SA(0, 1), cA + hstep, voffA);
        if (wr == 1) PG8_BAR;
        PG8_WAIT_V(2); PG8_BAR;
        PG8_STAGE(PG8_SB(1, 0), cB + kstep, voffB); PG8_STAGE(PG8_SA(1, 0), cA + kstep, voffA); PG8_STAGE(PG8_SB(1, 1), cB + hstep + kstep, voffB);
        PG8_WAIT_V(6); PG8_BAR;
    } else {
        PG8_STAGE(PG8_SB(0, 0), cB, voffB); PG8_STAGE(PG8_SA(0, 0), cA, voffA); PG8_STAGE(PG8_SB(0, 1), cB + hstep, voffB); PG8_STAGE(PG8_SA(0, 1), cA + hstep, voffA);
        if (wr == 1) PG8_BAR;
        PG8_WAIT_V(4); PG8_BAR;
        PG8_STAGE(PG8_SB(1, 0), cB + kstep, voffB); PG8_STAGE(PG8_SA(1, 0), cA + kstep, voffA); PG8_STAGE(PG8_SB(1, 1), cB + hstep + kstep, voffB);
        PG8_WAIT_V(6); PG8_BAR;
    }
    for (;;) {
        const bool has_next = S.next(ui + 1, nxt);
        const char* nA = has_next ? (const char*)g.A + (size_t)nxt.pm * tstep : cA; const char* nB = has_next ? (const char*)g.Bt + (size_t)nxt.pn * tstep : cB;
        for (int t = 0; t < nt; t += 2) {
            const bool last = (t == nt - 2);
            const char* a1 = cA + (size_t)(t + 1) * kstep;
            const char* a2 = last ? nA : cA + (size_t)(t + 2) * kstep; const char* b2 = last ? nB : cB + (size_t)(t + 2) * kstep;
            const char* a3 = a2 + kstep; const char* b3 = b2 + kstep;
            if (last && has_next) S.a_ready(nxt);
            if constexpr (SP2) {
            PG8_LDB(B0, 0, 0); PG8_LDB(B1, 0, 1); PG8_SCHED; PG8_LDA(At, 0, 0); PG8_STAGE(PG8_SA(1, 1), a1 + hstep, voffA);
            PG8_WAIT_V(8); PG8_WAIT_L(0); PG8_BAR; PG8_MMA(0, 0, At, B0); PG8_MMA(0, 1, At, B1); PG8_BAR; PG8_SCHED;
            PG8_LDA(At, 0, 1); PG8_STAGE(PG8_SB(0, 0), b2, voffB); PG8_STAGE(PG8_SB(0, 1), b2 + hstep, voffB); PG8_STAGE(PG8_SA(0, 0), a2, voffA);
            PG8_WAIT_V(8); PG8_WAIT_L(0); PG8_BAR; PG8_MMA(1, 0, At, B0); PG8_MMA(1, 1, At, B1); PG8_BAR; PG8_SCHED;
            PG8_LDB(B0, 1, 0); PG8_LDB(B1, 1, 1); PG8_SCHED; PG8_LDA(At, 1, 0); PG8_STAGE(PG8_SA(0, 1), a2 + hstep, voffA);
            PG8_WAIT_V(8); PG8_WAIT_L(0); PG8_BAR; PG8_MMA(0, 0, At, B0); PG8_MMA(0, 1, At, B1); PG8_BAR; PG8_SCHED;
            PG8_LDA(At, 1, 1); PG8_STAGE(PG8_SB(1, 0), b3, voffB); PG8_STAGE(PG8_SB(1, 1), b3 + hstep, voffB); PG8_STAGE(PG8_SA(1, 0), a3, voffA);
            PG8_WAIT_V(8); PG8_WAIT_L(0); PG8_BAR; PG8_MMA(1, 0, At, B0); PG8_MMA(1, 1, At, B1); PG8_BAR; PG8_SCHED;
            } else {
            PG8_LDB(B0, 0, 0); PG8_SCHED; PG8_LDA(At, 0, 0); PG8_STAGE(PG8_SA(1, 1), a1 + hstep, voffA);
            PG8_WAIT_L(8); PG8_BAR; PG8_WAIT_L(0); PG8_MMA(0, 0, At, B0); PG8_BAR; PG8_SCHED;
            PG8_LDB(B1, 0, 1); PG8_STAGE(PG8_SB(0, 0), b2, voffB);
            PG8_BAR; PG8_WAIT_L(0); PG8_MMA(0, 1, At, B1); PG8_BAR;
            PG8_LDA(At, 0, 1); PG8_STAGE(PG8_SA(0, 0), a2, voffA);
            PG8_BAR; PG8_WAIT_L(0); PG8_MMA(1, 0, At, B0); PG8_BAR; PG8_SCHED;
            PG8_STAGE(PG8_SB(0, 1), b2 + hstep, voffB);
            PG8_WAIT_V(6); PG8_BAR; PG8_MMA(1, 1, At, B1); PG8_BAR;
            PG8_LDB(B0, 1, 0); PG8_SCHED; PG8_LDA(At, 1, 0); PG8_STAGE(PG8_SA(0, 1), a2 + hstep, voffA);
            PG8_WAIT_L(8); PG8_BAR; PG8_WAIT_L(0); PG8_MMA(0, 0, At, B0); PG8_BAR; PG8_SCHED;
            PG8_LDB(B1, 1, 1); PG8_STAGE(PG8_SB(1, 0), b3, voffB);
            PG8_BAR; PG8_WAIT_L(0); PG8_MMA(0, 1, At, B1); PG8_BAR;
            PG8_LDA(At, 1, 1); PG8_STAGE(PG8_SA(1, 0), a3, voffA);
            PG8_BAR; PG8_WAIT_L(0); PG8_MMA(1, 0, At, B0); PG8_BAR; PG8_SCHED;
            PG8_STAGE(PG8_SB(1, 1), b3 + hstep, voffB);
            PG8_WAIT_V(6); PG8_BAR; PG8_MMA(1, 1, At, B1); PG8_BAR;
            }
        }
        if constexpr (ALIGN_EPI) { if (wr == 0) PG8_BAR; }
        if constexpr (!Epi::AFTER_DRAIN) { E(acc, cur, wr, wc, fr, fq); S.done(cur); }
        if (!has_next) break;
#pragma unroll
        for (int a = 0; a < 2; ++a)
#pragma unroll
            for (int b = 0; b < 2; ++b)
#pragma unroll
                for (int m = 0; m < 4; ++m)
#pragma unroll
                    for (int n = 0; n < 2; ++n) acc[a][b][m][n] = (f32x4){0.f, 0.f, 0.f, 0.f};
        cur = nxt; cA = nA; cB = nB; ++ui;
        if constexpr (ALIGN_EPI) { if (wr == 1) PG8_BAR; }
    }
    PG8_WAIT_V(0);
    if constexpr (!ALIGN_EPI) { if (wr == 0) PG8_BAR; }
    PG8_BAR;
    if constexpr (Epi::AFTER_DRAIN) { E.fused(acc, cur, wr, wc, fr, fq, lds, wid, lane); S.done(cur); }
#undef PG8_SA
#undef PG8_SB
#undef PG8_STAGE
#undef PG8_LDA
#undef PG8_LDB
#undef PG8_MMA
#undef PG8_WAIT_V
#undef PG8_WAIT_L
#undef PG8_BAR
#undef PG8_SCHED
}

template <class Epi, class Sched, bool ALIGN_EPI = false, bool SP2 = false>
__device__ __forceinline__ void gemm_phase_g(PG8_LAS unsigned char* lds, const Gemm g, const Sched& S, const Epi& E, const PG8_LAS unsigned* rowtab) {
    const int tid = threadIdx.x, wid = __builtin_amdgcn_readfirstlane(tid >> 6), lane = tid & 63, wr = wid >> 2, wc = wid & 3, fr = lane & 15, fq = lane >> 4;
    const int K = g.K, nt = K / BK;
    unsigned voffA[2], voffB[2]; int RA[2]; unsigned CA2[2];
#pragma unroll
    for (int i = 0; i < 2; ++i) { int R, C; stage_rc(tid * 16 + i * 8192, R, C); const int Rb = Epi::PERM ? ((R & ~31) + perm32(R & 31)) : R;
        voffA[i] = (unsigned)(R * K + C) * 2u; voffB[i] = (unsigned)(Rb * K + C) * 2u; RA[i] = R; CA2[i] = (unsigned)C * 2u; }
    unsigned vA0[2], vA1[2], nvA0[2], nvA1[2];
#pragma unroll
    for (int i = 0; i < 2; ++i) { vA0[i] = rowtab[RA[i]] + CA2[i]; vA1[i] = rowtab[128 + RA[i]] + CA2[i]; nvA0[i] = vA0[i]; nvA1[i] = vA1[i]; }
    const size_t kstep = (size_t)(BK * 2);
    const size_t hstep = (size_t)HALF * K * 2;
    const size_t tstep = 2 * hstep;
    const unsigned ldsw = (unsigned)wid * 1024u;
    const int aoff = lds_byte(wr * 64 + fr, fq * 8), boff = lds_byte(wc * 32 + fr, fq * 8);
#define PG8_SA(b, h) (((b) * 2 + (h)) * HTB)
#define PG8_SB(b, h) ((4 + (b) * 2 + (h)) * HTB)
#define PG8_STAGE(bufoff, gbase, voff) do { _Pragma("unroll") for (int _i = 0; _i < 2; ++_i) \
        __builtin_amdgcn_global_load_lds((const unsigned*)((const char*)(gbase) + (voff)[_i]), (PG8_LAS unsigned*)(lds + (bufoff) + ldsw + _i * 8192), 16, 0, 0); } while (0)
#define PG8_LDA(dst, b, h) do { _Pragma("unroll") for (int m = 0; m < 4; ++m) _Pragma("unroll") for (int k = 0; k < 2; ++k) dst[m][k] = *(const PG8_LAS bf16x8*)(lds + PG8_SA(b, h) + aoff + m * 2048 + k * 1024); } while (0)
#define PG8_LDB(dst, b, h) do { _Pragma("unroll") for (int n = 0; n < 2; ++n) _Pragma("unroll") for (int k = 0; k < 2; ++k) dst[n][k] = *(const PG8_LAS bf16x8*)(lds + PG8_SB(b, h) + boff + n * 2048 + k * 1024); } while (0)
#define PG8_MMA(ai, bj, At, Bt) do { __builtin_amdgcn_s_setprio(1); _Pragma("unroll") for (int m = 0; m < 4; ++m) _Pragma("unroll") for (int n = 0; n < 2; ++n) _Pragma("unroll") for (int k = 0; k < 2; ++k) \
        acc[ai][bj][m][n] = __builtin_amdgcn_mfma_f32_16x16x32_bf16(Bt[n][k], At[m][k], acc[ai][bj][m][n], 0, 0, 0); __builtin_amdgcn_s_setprio(0); } while (0)
#define PG8_WAIT_V(n) asm volatile("s_waitcnt vmcnt(" #n ")" ::: "memory")
#define PG8_WAIT_L(n) asm volatile("s_waitcnt lgkmcnt(" #n ")" ::: "memory")
#define PG8_BAR __builtin_amdgcn_s_barrier()
#define PG8_SCHED __builtin_amdgcn_sched_barrier(0)
    Unit cur, nxt; int ui = 0;
    if (!S.next(0, cur)) return;
    f32x4 acc[2][2][4][2];
#pragma unroll
    for (int a = 0; a < 2; ++a)
#pragma unroll
        for (int b = 0; b < 2; ++b)
#pragma unroll
            for (int m = 0; m < 4; ++m)
#pragma unroll
                for (int n = 0; n < 2; ++n) acc[a][b][m][n] = (f32x4){0.f, 0.f, 0.f, 0.f};
    bf16x8 At[4][2], B0[2][2], B1[2][2];
    const char* cA = (const char*)g.A; const char* cB = (const char*)g.Bt + (size_t)cur.pn * tstep;
    S.a_ready(cur);
    if constexpr (SP2) {
        PG8_STAGE(PG8_SB(0, 0), cB, voffB); PG8_STAGE(PG8_SB(0, 1), cB + hstep, voffB); PG8_STAGE(PG8_SA(0, 0), cA, vA0); PG8_STAGE(PG8_SA(0, 1), cA, vA1);
        if (wr == 1) PG8_BAR;
        PG8_WAIT_V(2); PG8_BAR;
        PG8_STAGE(PG8_SB(1, 0), cB + kstep, voffB); PG8_STAGE(PG8_SA(1, 0), cA + kstep, vA0); PG8_STAGE(PG8_SB(1, 1), cB + hstep + kstep, voffB);
        PG8_WAIT_V(6); PG8_BAR;
    } else {
        PG8_STAGE(PG8_SB(0, 0), cB, voffB); PG8_STAGE(PG8_SA(0, 0), cA, vA0); PG8_STAGE(PG8_SB(0, 1), cB + hstep, voffB); PG8_STAGE(PG8_SA(0, 1), cA, vA1);
        if (wr == 1) PG8_BAR;
        PG8_WAIT_V(4); PG8_BAR;
        PG8_STAGE(PG8_SB(1, 0), cB + kstep, voffB); PG8_STAGE(PG8_SA(1, 0), cA + kstep, vA0); PG8_STAGE(PG8_SB(1, 1), cB + hstep + kstep, voffB);
        PG8_WAIT_V(6); PG8_BAR;
    }
    for (;;) {
        const bool has_next = S.next(ui + 1, nxt);
        if (has_next) {
#pragma unroll
            for (int i = 0; i < 2; ++i) { nvA0[i] = rowtab[(ui + 1) * 256 + RA[i]] + CA2[i]; nvA1[i] = rowtab[(ui + 1) * 256 + 128 + RA[i]] + CA2[i]; }
        }
        const char* nA = cA; const char* nB = has_next ? (const char*)g.Bt + (size_t)nxt.pn * tstep : cB;
        for (int t = 0; t < nt; t += 2) {
            const bool last = (t == nt - 2);
            unsigned sA0[2], sA1[2];
#pragma unroll
            for (int i = 0; i < 2; ++i) { sA0[i] = last ? nvA0[i] : vA0[i]; sA1[i] = last ? nvA1[i] : vA1[i]; }
            const char* a1 = cA + (size_t)(t + 1) * kstep;
            const char* a2 = last ? nA : cA + (size_t)(t + 2) * kstep; const char* b2 = last ? nB : cB + (size_t)(t + 2) * kstep;
            const char* a3 = a2 + kstep; const char* b3 = b2 + kstep;
            if (last && has_next) S.a_ready(nxt);
            if constexpr (SP2) {
            PG8_LDB(B0, 0, 0); PG8_LDB(B1, 0, 1); PG8_SCHED; PG8_LDA(At, 0, 0); PG8_STAGE(PG8_SA(1, 1), a1, vA1);
            PG8_WAIT_V(8); PG8_WAIT_L(0); PG8_BAR; PG8_MMA(0, 0, At, B0); PG8_MMA(0, 1, At, B1); PG8_BAR; PG8_SCHED;
            PG8_LDA(At, 0, 1); PG8_STAGE(PG8_SB(0, 0), b2, voffB); PG8_STAGE(PG8_SB(0, 1), b2 + hstep, voffB); PG8_STAGE(PG8_SA(0, 0), a2, sA0);
            PG8_WAIT_V(8); PG8_WAIT_L(0); PG8_BAR; PG8_MMA(1, 0, At, B0); PG8_MMA(1, 1, At, B1); PG8_BAR; PG8_SCHED;
            PG8_LDB(B0, 1, 0); PG8_LDB(B1, 1, 1); PG8_SCHED; PG8_LDA(At, 1, 0); PG8_STAGE(PG8_SA(0, 1), a2, sA1);
            PG8_WAIT_V(8); PG8_WAIT_L(0); PG8_BAR; PG8_MMA(0, 0, At, B0); PG8_MMA(0, 1, At, B1); PG8_BAR; PG8_SCHED;
            PG8_LDA(At, 1, 1); PG8_STAGE(PG8_SB(1, 0), b3, voffB); PG8_STAGE(PG8_SB(1, 1), b3 + hstep, voffB); PG8_STAGE(PG8_SA(1, 0), a3, sA0);
            PG8_WAIT_V(8); PG8_WAIT_L(0); PG8_BAR; PG8_MMA(1, 0, At, B0); PG8_MMA(1, 1, At, B1); PG8_BAR; PG8_SCHED;
            } else {
            PG8_LDB(B0, 0, 0); PG8_SCHED; PG8_LDA(At, 0, 0); PG8_STAGE(PG8_SA(1, 1), a1, vA1);
            PG8_WAIT_L(8); PG8_BAR; PG8_WAIT_L(0); PG8_MMA(0, 0, At, B0); PG8_BAR; PG8_SCHED;
            PG8_LDB(B1, 0, 1); PG8_STAGE(PG8_SB(0, 0), b2, voffB);
            PG8_BAR; PG8_WAIT_L(0); PG8_MMA(0, 1, At, B1); PG8_BAR;
            PG8_LDA(At, 0, 1); PG8_STAGE(PG8_SA(0, 0), a2, sA0);
            PG8_BAR; PG8_WAIT_L(0); PG8_MMA(1, 0, At, B0); PG8_BAR; PG8_SCHED;
            PG8_STAGE(PG8_SB(0, 1), b2 + hstep, voffB);
            PG8_WAIT_V(6); PG8_BAR; PG8_MMA(1, 1, At, B1); PG8_BAR;
            PG8_LDB(B0, 1, 0); PG8_SCHED; PG8_LDA(At, 1, 0); PG8_STAGE(PG8_SA(0, 1), a2, sA1);
            PG8_WAIT_L(8); PG8_BAR; PG8_WAIT_L(0); PG8_MMA(0, 0, At, B0); PG8_BAR; PG8_SCHED;
            PG8_LDB(B1, 1, 1); PG8_STAGE(PG8_SB(1, 0), b3, voffB);
            PG8_BAR; PG8_WAIT_L(0); PG8_MMA(0, 1, At, B1); PG8_BAR;
            PG8_LDA(At, 1, 1); PG8_STAGE(PG8_SA(1, 0), a3, sA0);
            PG8_BAR; PG8_WAIT_L(0); PG8_MMA(1, 0, At, B0); PG8_BAR; PG8_SCHED;
            PG8_STAGE(PG8_SB(1, 1), b3 + hstep, voffB);
            PG8_WAIT_V(6); PG8_BAR; PG8_MMA(1, 1, At, B1); PG8_BAR;
            }
        }
        if constexpr (ALIGN_EPI) { if (wr == 0) PG8_BAR; }
        if constexpr (!Epi::AFTER_DRAIN) { E(acc, cur, wr, wc, fr, fq); S.done(cur); }
        if (!has_next) break;
#pragma unroll
        for (int a = 0; a < 2; ++a)
#pragma unroll
            for (int b = 0; b < 2; ++b)
#pragma unroll
                for (int m = 0; m < 4; ++m)
#pragma unroll
                    for (int n = 0; n < 2; ++n) acc[a][b][m][n] = (f32x4){0.f, 0.f, 0.f, 0.f};
        cur = nxt; cA = nA; cB = nB; ++ui;
#pragma unroll
        for (int i = 0; i < 2; ++i) { vA0[i] = nvA0[i]; vA1[i] = nvA1[i]; }
        if constexpr (ALIGN_EPI) { if (wr == 1) PG8_BAR; }
    }
    PG8_WAIT_V(0);
    if constexpr (!ALIGN_EPI) { if (wr == 0) PG8_BAR; }
    PG8_BAR;
    if constexpr (Epi::AFTER_DRAIN) { E.fused(acc, cur, wr, wc, fr, fq, lds, wid, lane); S.done(cur); }
#undef PG8_SA
#undef PG8_SB
#undef PG8_STAGE
#undef PG8_LDA
#undef PG8_LDB
#undef PG8_MMA
#undef PG8_WAIT_V
#undef PG8_WAIT_L
#undef PG8_BAR
#undef PG8_SCHED
}

struct EpiBf16 {
    static constexpr bool PERM = true, AFTER_DRAIN = false;
    bf16_t* O; int ldc; int npn;
    __device__ __forceinline__ void operator()(const f32x4 (&acc)[2][2][4][2], const Unit& u, int wr, int wc, int fr, int fq) const {
        const int row0 = u.pm * BM + wr * 64 + fr, col0 = (u.pn % npn) * BM + wc * 32 + 8 * fq;
#pragma unroll
        for (int ai = 0; ai < 2; ++ai)
#pragma unroll
            for (int m = 0; m < 4; ++m) { bf16_t* rowp = O + (size_t)(row0 + ai * HALF + m * 16) * ldc + col0;
#pragma unroll
                for (int bj = 0; bj < 2; ++bj) { const f32x4 v0 = acc[ai][bj][m][0], v1 = acc[ai][bj][m][1];
                    u32x4 w; w.x = cvt_pk_bf16(v0[0], v0[1]); w.y = cvt_pk_bf16(v0[2], v0[3]); w.z = cvt_pk_bf16(v1[0], v1[1]); w.w = cvt_pk_bf16(v1[2], v1[3]);
                    *(u32x4*)(rowp + bj * HALF) = w; } }
    }
};
struct EpiKV {
    static constexpr bool PERM = true, AFTER_DRAIN = false;
    bf16_t* kmem; bf16_t* vmemT;
    __device__ __forceinline__ void operator()(const f32x4 (&acc)[2][2][4][2], const Unit& u, int wr, int wc, int fr, int fq) const {
        const int row0 = u.pm * BM + wr * 64 + fr, col0 = u.pn * BM + wc * 32 + 8 * fq;
#pragma unroll
        for (int ai = 0; ai < 2; ++ai)
#pragma unroll
            for (int m = 0; m < 4; ++m) { const int row = row0 + ai * HALF + m * 16;
#pragma unroll
                for (int bj = 0; bj < 2; ++bj) { const f32x4 v0 = acc[ai][bj][m][0], v1 = acc[ai][bj][m][1]; const int col = col0 + bj * HALF;
                    if (col < 512) { u32x4 w; w.x = cvt_pk_bf16(v0[0], v0[1]); w.y = cvt_pk_bf16(v0[2], v0[3]); w.z = cvt_pk_bf16(v1[0], v1[1]); w.w = cvt_pk_bf16(v1[2], v1[3]);
                        *(u32x4*)(kmem + (size_t)row * 512 + col) = w; }
                    else { const int c2 = col - 512, hx = c2 >> 7, d = c2 & 127, b = row >> 8, key = row & 255;
                        bf16_t* vp = vmemT + (((size_t)b * 4 + hx) * 128 + d) * 256 + key;
                        const unsigned w0 = cvt_pk_bf16(v0[0], v0[1]), w1 = cvt_pk_bf16(v0[2], v0[3]), w2 = cvt_pk_bf16(v1[0], v1[1]), w3 = cvt_pk_bf16(v1[2], v1[3]);
                        vp[0 * 256] = (bf16_t)(w0 & 0xffffu); vp[1 * 256] = (bf16_t)(w0 >> 16); vp[2 * 256] = (bf16_t)(w1 & 0xffffu); vp[3 * 256] = (bf16_t)(w1 >> 16);
                        vp[4 * 256] = (bf16_t)(w2 & 0xffffu); vp[5 * 256] = (bf16_t)(w2 >> 16); vp[6 * 256] = (bf16_t)(w3 & 0xffffu); vp[7 * 256] = (bf16_t)(w3 >> 16); } } }
    }
};
template <bool XF32, bool STATS> struct EpiResid {
    static constexpr bool PERM = false, AFTER_DRAIN = false;
    const void* xin; bf16_t* xb; float* ssq;
    __device__ __forceinline__ void operator()(const f32x4 (&acc)[2][2][4][2], const Unit& u, int wr, int wc, int fr, int fq) const {
        typedef unsigned u32x2v __attribute__((ext_vector_type(2)));
        const int col0 = u.pn * BM + wc * 32 + 4 * fq;
#pragma unroll
        for (int ai = 0; ai < 2; ++ai) {
            const size_t rowb = (size_t)(u.pm * BM + ai * HALF + wr * 64 + fr);
            f32x4 pf[4][2][2]; u32x2v pb[4][2][2];
#pragma unroll
            for (int m = 0; m < 4; ++m)
#pragma unroll
                for (int bj = 0; bj < 2; ++bj)
#pragma unroll
                    for (int n = 0; n < 2; ++n) { const size_t off = (rowb + m * 16) * 1024 + col0 + bj * HALF + n * 16;
                        if (XF32) pf[m][bj][n] = *(const f32x4*)((const float*)xin + off); else pb[m][bj][n] = *(const u32x2v*)((const bf16_t*)xin + off); }
#pragma unroll
            for (int m = 0; m < 4; ++m) { const size_t row = rowb + m * 16;
                float q = 0.f;
#pragma unroll
                for (int bj = 0; bj < 2; ++bj)
#pragma unroll
                    for (int n = 0; n < 2; ++n) { const size_t off = row * 1024 + col0 + bj * HALF + n * 16;
                        f32x4 bs;
                        if (XF32) bs = pf[m][bj][n];
                        else { const u32x2v t = pb[m][bj][n]; bs[0] = __uint_as_float(t.x << 16); bs[1] = __uint_as_float(t.x & 0xffff0000u); bs[2] = __uint_as_float(t.y << 16); bs[3] = __uint_as_float(t.y & 0xffff0000u); }
                        const f32x4 o = bs + acc[ai][bj][m][n];
                        u32x2v w; w.x = cvt_pk_bf16(o[0], o[1]); w.y = cvt_pk_bf16(o[2], o[3]); *(u32x2v*)(xb + off) = w;
                        if (STATS) q += (o[0] * o[0] + o[1] * o[1]) + (o[2] * o[2] + o[3] * o[3]); }
                if (STATS) { q += __shfl_xor(q, 16); q += __shfl_xor(q, 32); if (fq == 0) ssq[row * 16 + u.pn * 4 + wc] = q; } }
            asm volatile("" ::: "memory"); }
    }
};
struct EpiQ {
    static constexpr bool PERM = true, AFTER_DRAIN = false;
    bf16_t* O; const float* ssq;
    __device__ __forceinline__ void operator()(const f32x4 (&acc)[2][2][4][2], const Unit& u, int wr, int wc, int fr, int fq) const {
        const int row0 = u.pm * BM + wr * 64 + fr, col0 = u.pn * BM + wc * 32 + 8 * fq;
#pragma unroll
        for (int ai = 0; ai < 2; ++ai)
#pragma unroll
            for (int m = 0; m < 4; ++m) { const size_t row = (size_t)(row0 + ai * HALF + m * 16);
                const f32x4* sp = (const f32x4*)(ssq + row * 16); const f32x4 s0 = sp[0], s1 = sp[1], s2 = sp[2], s3 = sp[3];
                const float s = ((s0[0] + s0[1]) + (s0[2] + s0[3])) + ((s1[0] + s1[1]) + (s1[2] + s1[3])) + ((s2[0] + s2[1]) + (s2[2] + s2[3])) + ((s3[0] + s3[1]) + (s3[2] + s3[3]));
                const float rs = 1.f / sqrtf(s * (1.f / 1024.f) + 1e-5f);
                bf16_t* rowp = O + row * 512 + col0;
#pragma unroll
                for (int bj = 0; bj < 2; ++bj) { const f32x4 v0 = acc[ai][bj][m][0] * rs, v1 = acc[ai][bj][m][1] * rs;
                    u32x4 w; w.x = cvt_pk_bf16(v0[0], v0[1]); w.y = cvt_pk_bf16(v0[2], v0[3]); w.z = cvt_pk_bf16(v1[0], v1[1]); w.w = cvt_pk_bf16(v1[2], v1[3]);
                    *(u32x4*)(rowp + bj * HALF) = w; } }
    }
};
struct EpiGU {
    static constexpr bool PERM = true, AFTER_DRAIN = false;
    bf16_t* hid; const PG8_LAS float* rstab; int G, c;
    __device__ __forceinline__ void operator()(const f32x4 (&acc)[2][2][4][2], const Unit& u, int wr, int wc, int fr, int fq) const {
        const int row0 = u.pm * BM + wr * 64 + fr, j0 = (u.pn & 1) * 128 + wc * 16 + 4 * fq;
        const int ui = (u.pm * 2 + (u.pn & 1) - c) / G;
#pragma unroll
        for (int ai = 0; ai < 2; ++ai)
#pragma unroll
            for (int m = 0; m < 4; ++m) { bf16_t* rowp = hid + (size_t)(row0 + ai * HALF + m * 16) * 256 + j0;
                const float rs = rstab[ui * 256 + ai * HALF + wr * 64 + m * 16 + fr];
#pragma unroll
                for (int bj = 0; bj < 2; ++bj) { const f32x4 v0 = acc[ai][bj][m][0] * rs, v1 = acc[ai][bj][m][1] * rs;
                    const float h0 = v0[0] * __builtin_amdgcn_rcpf(1.f + __expf(-v0[0])) * v0[1], h1 = v0[2] * __builtin_amdgcn_rcpf(1.f + __expf(-v0[2])) * v0[3];
                    const float h2 = v1[0] * __builtin_amdgcn_rcpf(1.f + __expf(-v1[0])) * v1[1], h3 = v1[2] * __builtin_amdgcn_rcpf(1.f + __expf(-v1[2])) * v1[3];
                    typedef unsigned u32x2v __attribute__((ext_vector_type(2))); u32x2v w; w.x = cvt_pk_bf16(h0, h1); w.y = cvt_pk_bf16(h2, h3);
                    *(u32x2v*)(rowp + bj * 64) = w; } }
    }
};
struct SubOrder {
    int nM, nN, nwg, span, c;
    __device__ void init(int M, int N, int span_, int c_) { nM = M / BM; nN = N / BM; nwg = nM * nN; span = span_; c = c_; }
    __device__ bool next(int i, Unit& u) const { if (c < 0 || c >= span) return false; const int L = i * span + c; if (L >= nwg) return false; u.pm = L / nN; u.pn = L % nN; return true; }
    __device__ __forceinline__ void a_ready(const Unit&) const {}
    __device__ __forceinline__ void done(const Unit&) const {}
};
struct MoeOrder {
    const PG8_LAS int* tile_e; int nrt, npn, G, c;
    __device__ bool next(int i, Unit& u) const { const int L = i * G + c; if (L >= nrt * npn) return false; const int rt = L / npn, pnl = L % npn; u.pm = rt; u.pn = tile_e[rt] * npn + pnl; return true; }
    __device__ __forceinline__ void a_ready(const Unit&) const {}
    __device__ __forceinline__ void done(const Unit&) const {}
};
}

#define LAS __attribute__((address_space(3)))
#define XB_TMO      128
#define XB_XCNT(j)  (256  + 64 * (j))
#define XB_XSUB(j)  (1280 + 64 * (j))
#define XB_XGEN(j)  (2304 + 64 * (j))
#define XB_TOP      3328
#define XB_TOPGEN   3392
#define XCD_BAR_WORDS 3456
#define XB_SPIN_CAP (1u << 18)

__device__ __forceinline__ unsigned xb_ld(unsigned* p)              { return __hip_atomic_load(p, __ATOMIC_RELAXED, __HIP_MEMORY_SCOPE_AGENT); }
__device__ __forceinline__ unsigned xb_add(unsigned* p, unsigned v) { return __hip_atomic_fetch_add(p, v, __ATOMIC_RELAXED, __HIP_MEMORY_SCOPE_AGENT); }
__device__ __forceinline__ unsigned xb_xcc_id() { return (unsigned)__builtin_amdgcn_s_getreg((3 << 11) | 20) & 0xFu; }
#define XB_SPIN(cond, bar) do { unsigned _sp = 0; while (cond) { __builtin_amdgcn_s_sleep(1); \
    if ((++_sp & 255u) == 0u) { if (xb_ld(&(bar)[XB_TMO])) break; if (_sp > XB_SPIN_CAP) { atomicAdd(&(bar)[XB_TMO], 1u); break; } } } } while (0)

struct XcdBarrier {
    unsigned* bar; unsigned x;
    volatile LAS unsigned* st;
};

__device__ __forceinline__ XcdBarrier xcd_barrier_post(unsigned* bar, volatile LAS unsigned* st) {
    XcdBarrier b; b.bar = bar; b.x = xb_xcc_id(); b.st = st;
    if (threadIdx.x == 0) (void)xb_add(&bar[XB_XCNT(b.x)], 1u);
    return b;
}
__device__ __forceinline__ void xcd_barrier_complete(unsigned* bar, unsigned x, unsigned& nloc, unsigned& nx) {
    const unsigned G = gridDim.x * gridDim.y * gridDim.z;
    unsigned sum, cnt, mine, sp = 0u;
    for (;;) {
        sum = 0u; cnt = 0u; mine = 0u;
#pragma unroll
        for (unsigned j = 0; j < 16; ++j) { const unsigned c = xb_ld(&bar[XB_XCNT(j)]); sum += c; cnt += (c > 0u) ? 1u : 0u; mine = (j == x) ? c : mine; }
        if (sum == G) break;
        __builtin_amdgcn_s_sleep(1);
        if ((++sp & 255u) == 0u) { if (xb_ld(&bar[XB_TMO])) break; if (sp > XB_SPIN_CAP) { atomicAdd(&bar[XB_TMO], 1u); break; } }
    }
    nloc = mine > 0u ? mine : 1u; nx = cnt > 0u ? cnt : 1u;
}

__device__ __forceinline__ void xcd_barrier(const XcdBarrier& b) {
    asm volatile("s_waitcnt vmcnt(0)" ::: "memory");
    __syncthreads();
    if (threadIdx.x == 0) {
        unsigned* bar = b.bar;
        __builtin_amdgcn_s_waitcnt(0);
        unsigned nloc = b.st[0], nx = b.st[1];
        if (nloc == 0u) { xcd_barrier_complete(bar, b.x, nloc, nx); b.st[0] = nloc; b.st[1] = nx; }
        const unsigned old = xb_add(&bar[XB_XSUB(b.x)], 1u);
        const unsigned gen = old / nloc;
        if (old + 1u == (gen + 1u) * nloc) {
            __builtin_amdgcn_fence(__ATOMIC_RELEASE, "agent");
            asm volatile("s_waitcnt vmcnt(0)" ::: "memory");
            const unsigned og = xb_add(&bar[XB_TOP], 1u);
            const unsigned tg = og / nx;
            if (og + 1u == (tg + 1u) * nx) xb_add(&bar[XB_TOPGEN], 1u);
            else XB_SPIN(xb_ld(&bar[XB_TOPGEN]) == tg, bar);
            __builtin_amdgcn_fence(__ATOMIC_ACQUIRE, "agent");
            xb_add(&bar[XB_XGEN(b.x)], 1u);
            asm volatile("s_waitcnt vmcnt(0)" ::: "memory");
        } else {
            XB_SPIN(xb_ld(&bar[XB_XGEN(b.x)]) == gen, bar);
            __builtin_amdgcn_fence(__ATOMIC_ACQUIRE, "agent");
            asm volatile("s_waitcnt vmcnt(0)" ::: "memory");
        }
    }
    __syncthreads();
}

__device__ __forceinline__ void gemm128(unsigned char* lds, const bf16_t* arow, const bf16_t* brow, int K, f32x16& acc0, f32x16& acc1) {
    const int tid = opaque_tid(), lane = tid & 63, w = tid >> 6;
    bf16_t* sA = (bf16_t*)lds;
    bf16_t* sB = sA + 128 * 72;
    const int srow = tid >> 2, skc = (tid & 3) * 16;
    const bf16_t* ap = arow + skc;
    const bf16_t* bp = brow + skc;
    const int wm = w >> 1, wn = w & 1, r = lane & 31, h = lane >> 5;
    acc0 = zero16(); acc1 = zero16();
    for (int k0 = 0; k0 < K; k0 += 64) {
        const u32x4 a0 = *(const u32x4*)(ap + k0), a1 = *(const u32x4*)(ap + k0 + 8);
        const u32x4 b0 = *(const u32x4*)(bp + k0), b1 = *(const u32x4*)(bp + k0 + 8);
        __syncthreads();
        *(u32x4*)(sA + srow * 72 + skc) = a0; *(u32x4*)(sA + srow * 72 + skc + 8) = a1;
        *(u32x4*)(sB + srow * 72 + skc) = b0; *(u32x4*)(sB + srow * 72 + skc + 8) = b1;
        __syncthreads();
#pragma unroll
        for (int kk = 0; kk < 64; kk += 16) {
            const bf16x8 a = *(const bf16x8*)(sA + (wm * 32 + r) * 72 + kk + 8 * h);
            const bf16x8 bA = *(const bf16x8*)(sB + (wn * 64 + r) * 72 + kk + 8 * h);
            const bf16x8 bB = *(const bf16x8*)(sB + (wn * 64 + 32 + r) * 72 + kk + 8 * h);
            acc0 = mfma32(a, bA, acc0); acc1 = mfma32(a, bB, acc1);
        }
    }
    __syncthreads();
}

__device__ __forceinline__ void p0_transpose64(const float* W, int ldw, int K, int nblk, const float* scale, bf16_t* WT, int row_off, int row_mul, float* scr, int item, int lane) {
    const int kb = item / nblk, nb = item % nblk, k0 = 64 * kb, n0 = 64 * nb;
    f32x4 v[16];
    const float* wp = W + (size_t)(k0 + (lane >> 4)) * ldw + n0 + 4 * (lane & 15);
#pragma unroll
    for (int i = 0; i < 16; ++i) v[i] = *(const f32x4*)(wp + (size_t)(4 * i) * ldw);
#pragma unroll
    for (int i = 0; i < 16; ++i) { const int kk = (lane >> 4) + 4 * i; const float sc = scale ? scale[k0 + kk] : 1.f; float* d = scr + kk * 65 + 4 * (lane & 15);
        d[0] = v[i].x * sc; d[1] = v[i].y * sc; d[2] = v[i].z * sc; d[3] = v[i].w * sc; }
    LDS_WAIT();
    const int c = lane & 7;
#pragma unroll
    for (int j = 0; j < 8; ++j) { const int n = (lane >> 3) + 8 * j; const float* sp = scr + (8 * c) * 65 + n;
        u32x4 o; o.x = pk2(sp[0 * 65], sp[1 * 65]); o.y = pk2(sp[2 * 65], sp[3 * 65]); o.z = pk2(sp[4 * 65], sp[5 * 65]); o.w = pk2(sp[6 * 65], sp[7 * 65]);
        *(u32x4*)(WT + (size_t)(row_off + (n0 + n) * row_mul) * K + k0 + 8 * c) = o; }
    LDS_WAIT();
}

__device__ __forceinline__ void phase0(const Params& p, unsigned char* lds) {
    const int tid = opaque_tid(), lane = tid & 63, w = tid >> 6;
    unsigned char* ws = p.ws;
    const int gw = blockIdx.x * NWAVES + w, NGW = gridDim.x * NWAVES;
    {
        bf16_t* WR = (bf16_t*)(ws + WS_WR);
        const float* w3 = p.in[19]; const float* wg = p.in[20]; const float* we = p.in[22];
        for (int i = blockIdx.x * NTHREADS + tid; i < 36 * 1024; i += gridDim.x * NTHREADS) {
            const int n = i >> 10, k = i & 1023;
            const float v = (n < 4) ? wg[k * 4 + n] : we[k * 32 + (n - 4)];
            WR[i] = (bf16_t)f2bf(v * w3[k]);
        }
    }
    {
        float* scr = (float*)lds + w * (64 * 65);
        constexpr int I_IN = 16 * 36, I_OUT = 16 * 16, I_Q = 16 * 8, I_KV = 16 * 16, I_O = 8 * 16, I_G = 32 * 16 * 4, I_D = 32 * 4 * 16;
        constexpr int NITEMS = I_IN + I_OUT + I_Q + I_KV + I_O + 2 * I_G + I_D;
#pragma unroll 1
        for (int it = gw; it < NITEMS; it += NGW) {
            int r = it;
            if (r < I_IN) { p0_transpose64(p.in[4], LDWIN, 1024, 36, nullptr, (bf16_t*)(ws + WS_WIN), 0, 1, scr, r, lane); continue; } r -= I_IN;
            if (r < I_OUT) { p0_transpose64(p.in[13], 1024, 1024, 16, nullptr, (bf16_t*)(ws + WS_WOUT), 0, 1, scr, r, lane); continue; } r -= I_OUT;
            if (r < I_Q) { p0_transpose64(p.in[16], 512, 1024, 8, p.in[14], (bf16_t*)(ws + WS_WQ), 0, 1, scr, r, lane); continue; } r -= I_Q;
            if (r < I_KV) { p0_transpose64(p.in[17], 1024, 1024, 16, nullptr, (bf16_t*)(ws + WS_WKV), 0, 1, scr, r, lane); continue; } r -= I_KV;
            if (r < I_O) { p0_transpose64(p.in[18], 1024, 512, 16, nullptr, (bf16_t*)(ws + WS_WO), 0, 1, scr, r, lane); continue; } r -= I_O;
            if (r < I_G) { const int e = r / 64, ri = r % 64; p0_transpose64(p.in[24] + (size_t)e * 1024 * 256, 256, 1024, 4, p.in[19], (bf16_t*)(ws + WS_WGU) + (size_t)e * 512 * 1024, 0, 2, scr, ri, lane); continue; } r -= I_G;
            if (r < I_G) { const int e = r / 64, ri = r % 64; p0_transpose64(p.in[25] + (size_t)e * 1024 * 256, 256, 1024, 4, p.in[19], (bf16_t*)(ws + WS_WGU) + (size_t)e * 512 * 1024, 1, 2, scr, ri, lane); continue; } r -= I_G;
            { const int e = r / 64, ri = r % 64; p0_transpose64(p.in[26] + (size_t)e * 256 * 1024, 1024, 256, 16, nullptr, (bf16_t*)(ws + WS_WD) + (size_t)e * 1024 * 256, 0, 1, scr, ri, lane); }
        }
    }
    __syncthreads();
    float* wdt = (float*)lds;
    {
        const float* win = p.in[4]; const float* w1 = p.in[3];
        for (int i = tid; i < 8192; i += NTHREADS) { const int k = i >> 3, n = i & 7; wdt[n * 1024 + k] = win[(size_t)k * LDWIN + 2304 + n] * w1[k]; }
    }
    __syncthreads();
    {
        const float* x = p.in[0]; const float* w1 = p.in[3];
        bf16_t* h1 = (bf16_t*)(ws + WS_H1); float* dtraw = (float*)(ws + WS_DTRAW);
        f32x4 wv[4];
#pragma unroll
        for (int j = 0; j < 4; ++j) wv[j] = *(const f32x4*)(w1 + 4 * lane + 256 * j);
        f32x4 nx[4];
        if (gw < NT) {
#pragma unroll
            for (int j = 0; j < 4; ++j) nx[j] = *((const f32x4*)(x + (size_t)gw * DM) + lane + 64 * j);
        }
#pragma unroll 1
        for (int m = gw; m < NT; m += NGW) {
            f32x4 v[4];
#pragma unroll
            for (int j = 0; j < 4; ++j) v[j] = nx[j];
            if (m + NGW < NT) {
#pragma unroll
                for (int j = 0; j < 4; ++j) nx[j] = *((const f32x4*)(x + (size_t)(m + NGW) * DM) + lane + 64 * j);
            }
            float a[16];
#pragma unroll
            for (int q = 0; q < 16; ++q) a[q] = 0.f;
#pragma unroll
            for (int j = 0; j < 4; ++j) a[0] += (v[j].x * v[j].x + v[j].y * v[j].y) + (v[j].z * v[j].z + v[j].w * v[j].w);
#pragma unroll
            for (int n = 0; n < 8; ++n)
#pragma unroll
                for (int j = 0; j < 4; ++j) { const f32x4 ww = *(const f32x4*)(wdt + n * 1024 + 4 * lane + 256 * j); a[1 + n] += (v[j].x * ww.x + v[j].y * ww.y) + (v[j].z * ww.z + v[j].w * ww.w); }
            float b8[8], b4[4], b2[2], b1;
            { const bool hi = (lane & 32) != 0;
#pragma unroll
              for (int q = 0; q < 8; ++q) { const float send = hi ? a[q] : a[q + 8], keep = hi ? a[q + 8] : a[q]; b8[q] = keep + __shfl_xor(send, 32); } }
            { const bool hi = (lane & 16) != 0;
#pragma unroll
              for (int q = 0; q < 4; ++q) { const float send = hi ? b8[q] : b8[q + 4], keep = hi ? b8[q + 4] : b8[q]; b4[q] = keep + __shfl_xor(send, 16); } }
            { const bool hi = (lane & 8) != 0;
#pragma unroll
              for (int q = 0; q < 2; ++q) { const float send = hi ? b4[q] : b4[q + 2], keep = hi ? b4[q + 2] : b4[q]; b2[q] = keep + __shfl_xor(send, 8); } }
            { const bool hi = (lane & 4) != 0; const float send = hi ? b2[0] : b2[1], keep = hi ? b2[1] : b2[0]; b1 = keep + __shfl_xor(send, 4); }
            b1 += __shfl_xor(b1, 2); b1 += __shfl_xor(b1, 1);
            const float rstd = 1.f / sqrtf(__shfl(b1, 0) * (1.f / DM) + EPS);
            const int slot = (lane >> 2) & 15;
            if ((lane & 3) == 0 && slot >= 1 && slot <= 8) dtraw[(size_t)m * 8 + (slot - 1)] = b1 * rstd;
            u32x2* o8 = (u32x2*)(h1 + (size_t)m * DM) + lane;
#pragma unroll
            for (int j = 0; j < 4; ++j) { u32x2 o; o.x = pk2(v[j].x * rstd * wv[j].x, v[j].y * rstd * wv[j].y); o.y = pk2(v[j].z * rstd * wv[j].z, v[j].w * rstd * wv[j].w); o8[64 * j] = o; }
        }
    }
    {
        const float* mem = p.in[1]; const float* wm = p.in[15];
        bf16_t* memh = (bf16_t*)(ws + WS_MEMH);
        f32x4 wv[4];
#pragma unroll
        for (int j = 0; j < 4; ++j) wv[j] = *(const f32x4*)(wm + 4 * lane + 256 * j);
        for (int m = gw; m < NMEM; m += NGW) {
            const f32x4* xr = (const f32x4*)(mem + (size_t)m * DM) + lane;
            f32x4 v[4]; float s = 0.f;
#pragma unroll
            for (int j = 0; j < 4; ++j) { v[j] = xr[64 * j]; s += (v[j].x * v[j].x + v[j].y * v[j].y) + (v[j].z * v[j].z + v[j].w * v[j].w); }
            const float rstd = 1.f / sqrtf(wave_sum(s) * (1.f / DM) + EPS);
            u32x2* o8 = (u32x2*)(memh + (size_t)m * DM) + lane;
#pragma unroll
            for (int j = 0; j < 4; ++j) { u32x2 o; o.x = pk2(v[j].x * rstd * wv[j].x, v[j].y * rstd * wv[j].y); o.y = pk2(v[j].z * rstd * wv[j].z, v[j].w * rstd * wv[j].w); o8[64 * j] = o; }
        }
    }
    __syncthreads();
}

#define LDS3(p) ((__attribute__((address_space(3))) unsigned char*)(p))
__device__ __forceinline__ void phase1(const Params& p, unsigned char* lds) {
    unsigned char* ws = p.ws;
#ifdef PROBE_PHASE
    _Pragma("unroll 1") for (int rep = 0; rep < ((PROBE_PHASE == 101) ? 2 : 1); ++rep)
#endif
    {
        pg8::Gemm g{(const bf16_t*)(ws + WS_H1), (const bf16_t*)(ws + WS_WIN), NT, NPROJ, DM};
        pg8::StaticOrder S; S.init(NT, NPROJ, (int)gridDim.x, (int)blockIdx.x);
        pg8::EpiBf16 E{(bf16_t*)(ws + WS_PROJ), NPROJ, NPROJ / 256};
        pg8::gemm_phase<pg8::EpiBf16, pg8::StaticOrder, true, true>(LDS3(lds), g, S, E);
    }
    {
        pg8::Gemm g{(const bf16_t*)(ws + WS_MEMH), (const bf16_t*)(ws + WS_WKV), NMEM, 1024, DM};
        pg8::SubOrder S; S.init(NMEM, 1024, 128, (int)blockIdx.x - 128);
        pg8::EpiKV E{(bf16_t*)(ws + WS_KMEM), (bf16_t*)(ws + WS_VMEMT)};
        pg8::gemm_phase<pg8::EpiKV, pg8::SubOrder, true, true>(LDS3(lds), g, S, E);
    }
}

__device__ __forceinline__ float bfel(const u32x4& v, int ci) { const unsigned wv = (ci >> 1) == 0 ? v.x : (ci >> 1) == 1 ? v.y : (ci >> 1) == 2 ? v.z : v.w; return (ci & 1) ? bfhi(wv) : bflo(wv); }
template <bool TRANS>
__device__ __forceinline__ void conv8x8(const Params& p, int b, int c, int l0, int ch0, const float (&f)[8], u32x4 (&res)[8]) {
    const bf16_t* proj = (const bf16_t*)(p.ws + WS_PROJ);
    const float* cw = p.in[6]; const float* cb = p.in[7];
    float wgt[4][8], bias[8];
#pragma unroll
    for (int j = 0; j < 4; ++j) { const f32x4 a = *(const f32x4*)(cw + j * 1024 + ch0), b2 = *(const f32x4*)(cw + j * 1024 + ch0 + 4);
        wgt[j][0] = a.x; wgt[j][1] = a.y; wgt[j][2] = a.z; wgt[j][3] = a.w; wgt[j][4] = b2.x; wgt[j][5] = b2.y; wgt[j][6] = b2.z; wgt[j][7] = b2.w; }
    { const f32x4 a = *(const f32x4*)(cb + ch0), b2 = *(const f32x4*)(cb + ch0 + 4); bias[0] = a.x; bias[1] = a.y; bias[2] = a.z; bias[3] = a.w; bias[4] = b2.x; bias[5] = b2.y; bias[6] = b2.z; bias[7] = b2.w; }
    u32x4 in[11];
    const int t0 = c * 128 + l0 - 3;
    const bf16_t* rp = proj + ((long)(b * SEQ) + t0) * NPROJ + C_X + ch0;
    asm volatile("" : "+v"(rp));
#pragma unroll
    for (int i = 0; i < 11; ++i) {
        const int t = t0 + i;
        in[i] = (u32x4){0u, 0u, 0u, 0u};
        if (t >= 0) in[i] = *(const u32x4*)(rp + (size_t)i * NPROJ);
    }
    if (TRANS) {
#pragma unroll
        for (int ci = 0; ci < 8; ++ci) {
            float o[8];
#pragma unroll
            for (int li = 0; li < 8; ++li) { float a = bias[ci];
#pragma unroll
                for (int j = 0; j < 4; ++j) a += wgt[j][ci] * bfel(in[li + j], ci);
                o[li] = siluf(a) * f[li]; }
            res[ci] = (u32x4){pk2(o[0], o[1]), pk2(o[2], o[3]), pk2(o[4], o[5]), pk2(o[6], o[7])};
        }
    } else {
#pragma unroll
        for (int li = 0; li < 8; ++li) {
            float o[8];
#pragma unroll
            for (int ci = 0; ci < 8; ++ci) { float a = bias[ci];
#pragma unroll
                for (int j = 0; j < 4; ++j) a += wgt[j][ci] * bfel(in[li + j], ci);
                o[ci] = siluf(a) * f[li]; }
            res[li] = (u32x4){pk2(o[0], o[1]), pk2(o[2], o[3]), pk2(o[4], o[5]), pk2(o[6], o[7])};
        }
    }
}

__device__ __forceinline__ void conv2_load(const Params& p, int b, int c, int l0, int ch0, unsigned (&in)[11]) {
    const bf16_t* proj = (const bf16_t*)(p.ws + WS_PROJ);
    const int t0 = c * 128 + l0 - 3;
    const bf16_t* rp = proj + ((long)(b * SEQ) + t0) * NPROJ + C_X + ch0;
    asm volatile("" : "+v"(rp));
#pragma unroll
    for (int i = 0; i < 11; ++i) { const int t = t0 + i; in[i] = 0u; if (t >= 0) in[i] = *(const unsigned*)(rp + (size_t)i * NPROJ); }
}
__device__ __forceinline__ void conv2_math(const Params& p, int ch0, const unsigned (&in)[11], u32x4 (&res)[2]) {
    const float* cw = p.in[6]; const float* cb = p.in[7];
    float wgt[4][2], bias[2];
#pragma unroll
    for (int j = 0; j < 4; ++j) { wgt[j][0] = cw[j * 1024 + ch0]; wgt[j][1] = cw[j * 1024 + ch0 + 1]; }
    bias[0] = cb[ch0]; bias[1] = cb[ch0 + 1];
#pragma unroll
    for (int ci = 0; ci < 2; ++ci) {
        float o[8];
#pragma unroll
        for (int li = 0; li < 8; ++li) { float a = bias[ci];
#pragma unroll
            for (int j = 0; j < 4; ++j) a += wgt[j][ci] * (ci ? bfhi(in[li + j]) : bflo(in[li + j]));
            o[li] = siluf(a); }
        res[ci] = (u32x4){pk2(o[0], o[1]), pk2(o[2], o[3]), pk2(o[4], o[5]), pk2(o[6], o[7])};
    }
}

__device__ __forceinline__ void ssd_dt_cum(const Params& p, int b, int c, float* dts, float* cums) {
    const int tid = opaque_tid(), lane = tid & 63, w = tid >> 6;
    const float* dtraw = (const float*)(p.ws + WS_DTRAW);
    const float bias = p.in[8][w], a = -__expf(p.in[9][w]);
    const size_t row0 = (size_t)b * SEQ + c * 128;
    float x0 = dtraw[(row0 + 2 * lane) * 8 + w] + bias, x1 = dtraw[(row0 + 2 * lane + 1) * 8 + w] + bias;
    const float d0 = fmaxf(x0, 0.f) + log1pf(__expf(-fabsf(x0))), d1 = fmaxf(x1, 0.f) + log1pf(__expf(-fabsf(x1)));
    const float a0 = d0 * a, a1 = d1 * a;
    float s = a0 + a1;
#pragma unroll
    for (int o = 1; o < 64; o <<= 1) { const float t = __shfl_up(s, o); if (lane >= o) s += t; }
    dts[w * 128 + 2 * lane] = d0; dts[w * 128 + 2 * lane + 1] = d1;
    cums[w * 128 + 2 * lane] = s - a1; cums[w * 128 + 2 * lane + 1] = s;
}

__device__ __forceinline__ void attn_unit(const Params& p, const bf16_t* sK, const bf16_t* sV, const float* cs, const float* sn, float* ssq, int b, int blk, int hq, int rg, int lane, u32x2 (&oh)[8]) {
    const int r = lane & 31, h = lane >> 5;
    const bf16_t* proj = (const bf16_t*)(p.ws + WS_PROJ);
    const int tband0 = blk * 128 - 128;
    const bf16_t* qp = proj + (size_t)(b * SEQ + blk * 128 + rg * 32 + r) * NPROJ + hq * 64 + 8 * h;
    u32x4 qv[4];
#pragma unroll
    for (int kk = 0; kk < 4; ++kk) qv[kk] = *(const u32x4*)(qp + kk * 16);
    {
        u32x4 ot; ot.x = __shfl_xor(qv[0].x, 32); ot.y = __shfl_xor(qv[0].y, 32); ot.z = __shfl_xor(qv[0].z, 32); ot.w = __shfl_xor(qv[0].w, 32);
        const float* cp = cs + (128 + rg * 32 + r) * 8; const float* sp = sn + (128 + rg * 32 + r) * 8;
        float o[8];
#pragma unroll
        for (int f = 0; f < 8; ++f) {
            const float mine = bfel(qv[0], f), oth = bfel(ot, f), c = cp[f], sv = sp[f];
            o[f] = h ? (mine * c + oth * sv) : (mine * c - oth * sv);
        }
        qv[0] = (u32x4){pk2(o[0], o[1]), pk2(o[2], o[3]), pk2(o[4], o[5]), pk2(o[6], o[7])};
    }
    f32x16 S[5];
#pragma unroll
    for (int jt = 0; jt < 5; ++jt) S[jt] = zero16();
    const bf16_t* kp = sK + (rg * 32 + r) * 72 + 8 * h;
#pragma unroll
    for (int kk = 0; kk < 4; ++kk) {
        const bf16x8 qf = __builtin_bit_cast(bf16x8, qv[kk]);
#pragma unroll
        for (int jt = 0; jt < 5; ++jt) { const bf16x8 a = *(const bf16x8*)(kp + jt * (32 * 72) + kk * 16); S[jt] = mfma32(a, qf, S[jt]); }
    }
    const float sink = p.in[5][hq] * 8.f;
    float m = sink;
    const bool noprev = (blk == 0);
#pragma unroll
    for (int jt = 0; jt < 5; ++jt)
#pragma unroll
        for (int i = 0; i < 16; ++i) {
            const int cr = (i & 3) + 8 * (i >> 2) + 4 * h;
            bool ok = true;
            if (jt == 0) ok = cr > r;
            if (jt == 4) ok = cr <= r;
            if (noprev && (rg + jt) < 4) ok = false;
            const float v = ok ? S[jt][i] : -INFINITY; S[jt][i] = v; m = fmaxf(m, v);
        }
    m = fmaxf(m, __shfl_xor(m, 32));
    const float sc = 0.125f * 1.4426950408889634f;
    float sum = 0.f;
    bf16x8 P[10];
#pragma unroll
    for (int jt = 0; jt < 5; ++jt) {
        float e[16];
#pragma unroll
        for (int i = 0; i < 16; ++i) { e[i] = __builtin_amdgcn_exp2f((S[jt][i] - m) * sc); sum += e[i]; }
        P[2 * jt] = pack8(e[0], e[1], e[2], e[3], e[4], e[5], e[6], e[7]);
        P[2 * jt + 1] = pack8(e[8], e[9], e[10], e[11], e[12], e[13], e[14], e[15]);
    }
    sum += __shfl_xor(sum, 32);
    sum += __builtin_amdgcn_exp2f((sink - m) * sc);
    const float inv = 1.f / sum;
    f32x16 O0 = zero16(), O1 = zero16();
    const bf16_t* vp0 = sV + r * 260 + rg * 32 + 4 * h;
#pragma unroll
    for (int ts = 0; ts < 10; ++ts) {
        const bf16_t* vp = vp0 + 16 * ts;
        const u32x2 lo0 = *(const u32x2*)vp, hi0 = *(const u32x2*)(vp + 8);
        const u32x2 lo1 = *(const u32x2*)(vp + 32 * 260), hi1 = *(const u32x2*)(vp + 32 * 260 + 8);
        O0 = mfma32(__builtin_bit_cast(bf16x8, (u32x4){lo0.x, lo0.y, hi0.x, hi0.y}), P[ts], O0);
        O1 = mfma32(__builtin_bit_cast(bf16x8, (u32x4){lo1.x, lo1.y, hi1.x, hi1.y}), P[ts], O1);
    }
    float q = 0.f;
#pragma unroll
    for (int g = 0; g < 4; ++g) {
        const unsigned a0 = pk2(O0[4 * g] * inv, O0[4 * g + 1] * inv), a1 = pk2(O0[4 * g + 2] * inv, O0[4 * g + 3] * inv);
        const unsigned b0 = pk2(O1[4 * g] * inv, O1[4 * g + 1] * inv), b1 = pk2(O1[4 * g + 2] * inv, O1[4 * g + 3] * inv);
        oh[g] = (u32x2){a0, a1}; oh[4 + g] = (u32x2){b0, b1};
        q += (bflo(a0) * bflo(a0) + bfhi(a0) * bfhi(a0)) + (bflo(a1) * bflo(a1) + bfhi(a1) * bfhi(a1)) + (bflo(b0) * bflo(b0) + bfhi(b0) * bfhi(b0)) + (bflo(b1) * bflo(b1) + bfhi(b1) * bfhi(b1));
    }
    q += __shfl_xor(q, 32);
    if (h == 0) ssq[(rg * 32 + r) * 8 + hq] = q;
}

__device__ __forceinline__ void phase2_attn(const Params& p, unsigned char* lds, int b, int blk) {
    const int tid = opaque_tid(), lane = tid & 63, w = tid >> 6, r = lane & 31, h = lane >> 5;
    const bf16_t* proj = (const bf16_t*)(p.ws + WS_PROJ);
    const int* positions = (const int*)p.in[2];
    float* cs = (float*)lds;
    float* sn = cs + 2048;
    float* ssq = sn + 2048;
    bf16_t* sK = (bf16_t*)(lds + 20480);
    bf16_t* sV = sK + 256 * 72;
    const int tband0 = blk * 128 - 128;
    for (int i = tid; i < 2048; i += NTHREADS) {
        const int kb = i >> 3, f = i & 7, t = tband0 + kb;
        float c = 1.f, sv = 0.f;
        if (t >= 0) { const float ang = (float)positions[b * SEQ + t] * p.inv_freq[f]; const double rev = (double)ang * 0.15915494309189535; const float fr = (float)(rev - floor(rev));
            c = __builtin_amdgcn_cosf(fr); sv = __builtin_amdgcn_sinf(fr); }
        cs[i] = c; sn[i] = sv;
    }
    u32x2 oh[4][8];
#pragma unroll
    for (int g = 0; g < 2; ++g) {
        __syncthreads();
        {
            const int key = tid >> 1, half = tid & 1, t = tband0 + key;
            u32x4 kv[4];
#pragma unroll
            for (int q = 0; q < 4; ++q) kv[q] = (u32x4){0u, 0u, 0u, 0u};
            if (t >= 0) { const bf16_t* kp = proj + (size_t)(b * SEQ + t) * NPROJ + C_K + g * 64 + half * 32;
#pragma unroll
                for (int q = 0; q < 4; ++q) kv[q] = *(const u32x4*)(kp + 8 * q); }
            if (half == 0) {
                float o1[8], o2[8];
#pragma unroll
                for (int f = 0; f < 8; ++f) { const float x1 = bfel(kv[0], f), x2 = bfel(kv[1], f), c = cs[key * 8 + f], sv = sn[key * 8 + f]; o1[f] = x1 * c - x2 * sv; o2[f] = x2 * c + x1 * sv; }
                kv[0] = (u32x4){pk2(o1[0], o1[1]), pk2(o1[2], o1[3]), pk2(o1[4], o1[5]), pk2(o1[6], o1[7])};
                kv[1] = (u32x4){pk2(o2[0], o2[1]), pk2(o2[2], o2[3]), pk2(o2[4], o2[5]), pk2(o2[6], o2[7])};
            }
#pragma unroll
            for (int q = 0; q < 4; ++q) *(u32x4*)(sK + key * 72 + half * 32 + 8 * q) = kv[q];
        }
        {
            const int kg = tid >> 3, dc = tid & 7;
            u32x4 v[4];
#pragma unroll
            for (int i = 0; i < 4; ++i) { const int t = tband0 + 4 * kg + i; v[i] = (u32x4){0u, 0u, 0u, 0u};
                if (t >= 0) v[i] = *(const u32x4*)(proj + (size_t)(b * SEQ + t) * NPROJ + C_V + g * 64 + dc * 8); }
            bf16_t* vd = sV + (dc * 8) * 260 + 4 * kg;
#define VT_ROW(j, W) { const unsigned e0 = ((j) & 1) ? (v[0].W >> 16) : (v[0].W & 0xffffu), e1 = ((j) & 1) ? (v[1].W >> 16) : (v[1].W & 0xffffu), e2 = ((j) & 1) ? (v[2].W >> 16) : (v[2].W & 0xffffu), e3 = ((j) & 1) ? (v[3].W >> 16) : (v[3].W & 0xffffu); \
                *(u32x2*)(vd + (j) * 260) = (u32x2){e0 | (e1 << 16), e2 | (e3 << 16)}; }
            VT_ROW(0, x) VT_ROW(1, x) VT_ROW(2, y) VT_ROW(3, y) VT_ROW(4, z) VT_ROW(5, z) VT_ROW(6, w) VT_ROW(7, w)
#undef VT_ROW
        }
        __syncthreads();
#pragma unroll
        for (int uu = 0; uu < 2; ++uu) {
            const int u = w + 8 * uu;
            attn_unit(p, sK, sV, cs, sn, ssq, b, blk, g * 4 + (u >> 2), u & 3, lane, oh[g * 2 + uu]);
            __builtin_amdgcn_sched_barrier(0);
        }
    }
    __syncthreads();
    {
        bf16_t* A2 = (bf16_t*)(p.ws + WS_A2);
        const float* wa = p.in[11];
#pragma unroll
        for (int k = 0; k < 4; ++k) {
            const int u = w + 8 * (k & 1), hq = (k >> 1) * 4 + (u >> 2), rg = u & 3, ql = rg * 32 + r;
            const f32x4 s0 = *(const f32x4*)(ssq + ql * 8), s1 = *(const f32x4*)(ssq + ql * 8 + 4);
            const float rstd = 1.f / sqrtf((((s0.x + s0.y) + (s0.z + s0.w)) + ((s1.x + s1.y) + (s1.z + s1.w))) * (1.f / 512.f) + EPS);
            bf16_t* op = A2 + (size_t)(b * SEQ + blk * 128 + ql) * 1024 + hq * 64 + 4 * h;
#pragma unroll
            for (int j = 0; j < 8; ++j) {
                const int d0 = 32 * (j >> 2) + 8 * (j & 3);
                const f32x4 wv = *(const f32x4*)(wa + hq * 64 + d0 + 4 * h);
                const u32x2 t = oh[k][j];
                u32x2 o; o.x = pk2(bflo(t.x) * rstd * wv.x, bfhi(t.x) * rstd * wv.y); o.y = pk2(bflo(t.y) * rstd * wv.z, bfhi(t.y) * rstd * wv.w);
                *(u32x2*)(op + d0) = o;
            }
        }
    }
    __syncthreads();
}

__device__ __forceinline__ void phase2_states(const Params& p, unsigned char* lds, int b, int c) {
    const int tid = opaque_tid(), lane = tid & 63, w = tid >> 6, r = lane & 31, h = lane >> 5;
    float* dts = (float*)lds;
    float* cums = dts + 1024;
    bf16_t* sBT = (bf16_t*)(lds + 8192);
    bf16_t* sXT = sBT + 128 * 136;
    ssd_dt_cum(p, b, c, dts, cums);
    __syncthreads();
    bf16_t* states = (bf16_t*)(p.ws + WS_START);
    if (tid < 8) ((float*)(p.ws + WS_CDEC))[(b * NCH + c) * 8 + tid] = __expf(cums[tid * 128 + 127]);
#pragma unroll 1
    for (int g = 0; g < 2; ++g) {
        if (tid < 256) {
            const int cg8 = tid & 15, lr = tid >> 4;
            const float one[8] = {1.f, 1.f, 1.f, 1.f, 1.f, 1.f, 1.f, 1.f};
            u32x4 res[8];
            conv8x8<true>(p, b, c, lr * 8, 512 + g * 128 + cg8 * 8, one, res);
#pragma unroll
            for (int ci = 0; ci < 8; ++ci) *(u32x4*)(sBT + (cg8 * 8 + ci) * 136 + lr * 8) = res[ci];
        }
        {
            const int cg8 = tid & 31, lr = tid >> 5, hh = cg8 >> 3, hd = g * 4 + hh;
            float f[8];
            const float cl = cums[hd * 128 + 127];
#pragma unroll
            for (int li = 0; li < 8; ++li) f[li] = dts[hd * 128 + lr * 8 + li] * __expf(cl - cums[hd * 128 + lr * 8 + li]);
            u32x4 res[8];
            conv8x8<true>(p, b, c, lr * 8, g * 256 + cg8 * 8, f, res);
#pragma unroll
            for (int ci = 0; ci < 8; ++ci) *(u32x4*)(sXT + (cg8 * 8 + ci) * 136 + lr * 8) = res[ci];
        }
        __syncthreads();
        {
            f32x16 acc[4];
#pragma unroll
            for (int j = 0; j < 4; ++j) acc[j] = zero16();
#pragma unroll
            for (int kk = 0; kk < 128; kk += 16) {
                const bf16x8 a = *(const bf16x8*)(sXT + (w * 32 + r) * 136 + kk + 8 * h);
#pragma unroll
                for (int j = 0; j < 4; ++j) { const bf16x8 bb = *(const bf16x8*)(sBT + (j * 32 + r) * 136 + kk + 8 * h); acc[j] = mfma32(a, bb, acc[j]); }
            }
            const int hd = g * 4 + (w >> 1), p0 = (w & 1) * 32;
            bf16_t* sp = states + ((size_t)((b * NCH + c) * 8 + hd) * 64) * 128;
#pragma unroll
            for (int j = 0; j < 4; ++j)
#pragma unroll
                for (int i = 0; i < 16; ++i) sp[(size_t)(p0 + crow(i, h)) * 128 + j * 32 + r] = (bf16_t)f2bf(acc[j][i]);
        }
        __syncthreads();
    }
}

__device__ __forceinline__ void phase3(const Params& p) {
    const float* cdec = (const float*)(p.ws + WS_CDEC);
    bf16_t* start = (bf16_t*)(p.ws + WS_START);
    const int tid3 = opaque_tid();
#pragma unroll 1
    for (int u = blockIdx.x * NTHREADS + tid3; u < 131072; u += gridDim.x * NTHREADS) {
        const int n4 = u & 31, pp = (u >> 5) & 63, hd = (u >> 11) & 7, b = u >> 14;
        bf16_t* base = start + ((size_t)((b * NCH) * 8 + hd) * 64 + pp) * 128 + n4 * 4;
        constexpr size_t CSTRIDE = (size_t)8 * 64 * 128;
        f32x4 s = (f32x4){0.f, 0.f, 0.f, 0.f};
#pragma unroll 1
        for (int c0 = 0; c0 < NCH; c0 += 16) {
            bf16_t* bp = base + c0 * CSTRIDE; const float* dp = cdec + (b * NCH + c0) * 8 + hd;
            asm volatile("" : "+v"(bp));
            u32x2 t[16]; float d[16];
#pragma unroll
            for (int c = 0; c < 16; ++c) { t[c] = *(const u32x2*)(bp + c * CSTRIDE); d[c] = dp[c * 8]; }
#pragma unroll
            for (int c = 0; c < 16; ++c) {
                u32x2 o; o.x = pk2(s.x, s.y); o.y = pk2(s.z, s.w);
                *(u32x2*)(bp + c * CSTRIDE) = o;
                const f32x4 st = (f32x4){bflo(t[c].x), bfhi(t[c].x), bflo(t[c].y), bfhi(t[c].y)};
                s = s * d[c] + st;
            }
        }
    }
}

__device__ __forceinline__ void phase4(const Params& p, unsigned char* lds, int b, int c) {
    const int tid = opaque_tid(), lane = tid & 63, w = tid >> 6, r = lane & 31, h = lane >> 5;
    float* dts = (float*)lds;
    float* cums = dts + 1024;
    float* gsq = cums + 1024;
    bf16_t* sC = (bf16_t*)(lds + 12288);
    bf16_t* sB = sC + 128 * 136;
    bf16_t* sM = sB + 128 * 136;
    bf16_t* sXT = sM + 128 * 136;
    const bf16_t* proj = (const bf16_t*)(p.ws + WS_PROJ);
    const bf16_t* start = (const bf16_t*)(p.ws + WS_START);
    bf16_t* A2 = (bf16_t*)(p.ws + WS_A2);
    ssd_dt_cum(p, b, c, dts, cums);
    __syncthreads();
    const size_t row0 = (size_t)b * SEQ + c * 128;
#pragma unroll 1
    for (int g = 0; g < 2; ++g) {
        {
            const int which = tid >> 8, cg8 = tid & 15, lr = (tid >> 4) & 15;
            const float one[8] = {1.f, 1.f, 1.f, 1.f, 1.f, 1.f, 1.f, 1.f};
            u32x4 res[8];
            conv8x8<false>(p, b, c, lr * 8, (which ? 768 : 512) + g * 128 + cg8 * 8, one, res);
            bf16_t* dst = which ? sC : sB;
#pragma unroll
            for (int li = 0; li < 8; ++li) *(u32x4*)(dst + (lr * 8 + li) * 136 + cg8 * 8) = res[li];
        }
        __syncthreads();
        f32x16 cb0 = zero16(), cb1 = zero16();
        const int lt = w >> 1, st0 = 2 * (w & 1);
#pragma unroll 2
        for (int kk = 0; kk < 128; kk += 16) {
            const bf16x8 a = *(const bf16x8*)(sC + (lt * 32 + r) * 136 + kk + 8 * h);
            const bf16x8 b0 = *(const bf16x8*)(sB + (st0 * 32 + r) * 136 + kk + 8 * h);
            const bf16x8 b1 = *(const bf16x8*)(sB + ((st0 + 1) * 32 + r) * 136 + kk + 8 * h);
            cb0 = mfma32(a, b0, cb0); cb1 = mfma32(a, b1, cb1);
        }
        __syncthreads();
        bf16_t* sS = sB;
#pragma unroll 1
        for (int hh = 0; hh < 4; ++hh) {
            const int hd = g * 4 + hh;
            const int lt2 = w >> 1, pt = w & 1;
            const int lme = lt2 * 32 + r;
            u32x4 stv[2]; unsigned xin[11]; u32x2 zr[4];
            const int cp = tid & 31, lr = tid >> 5;
            {
                const bf16_t* stb = start + ((size_t)((b * NCH + c) * 8 + hd) * 64) * 128;
#pragma unroll
                for (int i = 0; i < 2; ++i) { const int id = tid + 512 * i; stv[i] = *(const u32x4*)(stb + (id >> 4) * 128 + (id & 15) * 8); }
                conv2_load(p, b, c, lr * 8, hd * 64 + cp * 2, xin);
                const bf16_t* zp = proj + (row0 + lme) * NPROJ + C_Z + hd * 64 + 32 * pt + 4 * h;
#pragma unroll
                for (int g4 = 0; g4 < 4; ++g4) zr[g4] = *(const u32x2*)(zp + 8 * g4);
            }
#pragma unroll
            for (int q = 0; q < 2; ++q) {
                const int st = st0 + q;
                if (st <= lt) {
                    const int sme = st * 32 + r; const float cs_ = cums[hd * 128 + sme], ds_ = dts[hd * 128 + sme];
#pragma unroll
                    for (int i = 0; i < 16; ++i) {
                        const int l = lt * 32 + crow(i, h);
                        const float cbv = q ? cb1[i] : cb0[i];
                        const float v = (sme <= l) ? cbv * __expf(cums[hd * 128 + l] - cs_) * ds_ : 0.f;
                        sM[l * 136 + sme] = (bf16_t)f2bf(v);
                    }
                }
            }
            {
                u32x4 res[2];
                conv2_math(p, hd * 64 + cp * 2, xin, res);
                *(u32x4*)(sXT + (cp * 2) * 136 + lr * 8) = res[0];
                *(u32x4*)(sXT + (cp * 2 + 1) * 136 + lr * 8) = res[1];
            }
#pragma unroll
            for (int i = 0; i < 2; ++i) { const int id = tid + 512 * i; *(u32x4*)(sS + (id >> 4) * 136 + (id & 15) * 8) = stv[i]; }
            __syncthreads();
            {
                f32x16 yd = zero16(), yo = zero16();
                const int kend = 32 * (lt2 + 1);
#pragma unroll 2
                for (int kk = 0; kk < kend; kk += 16) {
                    const bf16x8 a = *(const bf16x8*)(sXT + (pt * 32 + r) * 136 + kk + 8 * h);
                    const bf16x8 bb = *(const bf16x8*)(sM + (lt2 * 32 + r) * 136 + kk + 8 * h);
                    yd = mfma32(a, bb, yd);
                }
#pragma unroll 2
                for (int kk = 0; kk < 128; kk += 16) {
                    const bf16x8 a = *(const bf16x8*)(sS + (pt * 32 + r) * 136 + kk + 8 * h);
                    const bf16x8 bb = *(const bf16x8*)(sC + (lt2 * 32 + r) * 136 + kk + 8 * h);
                    yo = mfma32(a, bb, yo);
                }
                const float dsk = p.in[10][hd];
                const float el = __expf(cums[hd * 128 + lme]);
                bf16_t* gp = A2 + (row0 + lme) * 1024 + 512 + hd * 64 + 32 * pt + 4 * h;
                float q = 0.f;
#pragma unroll
                for (int g4 = 0; g4 < 4; ++g4) {
                    float gv[4];
#pragma unroll
                    for (int e = 0; e < 4; ++e) {
                        const int i = 4 * g4 + e, pl = 32 * pt + 8 * g4 + 4 * h + e;
                        const float xs = bf2f((unsigned)sXT[pl * 136 + lme]);
                        const float y = yd[i] + el * yo[i] + dsk * xs;
                        const unsigned zw = (e >> 1) ? zr[g4].y : zr[g4].x;
                        const float z = (e & 1) ? bfhi(zw) : bflo(zw);
                        gv[e] = y * siluf(z);
                    }
                    const unsigned w0 = pk2(gv[0], gv[1]), w1 = pk2(gv[2], gv[3]);
                    *(u32x2*)(gp + 8 * g4) = (u32x2){w0, w1};
                    q += (bflo(w0) * bflo(w0) + bfhi(w0) * bfhi(w0)) + (bflo(w1) * bflo(w1) + bfhi(w1) * bfhi(w1));
                }
                q += __shfl_xor(q, 32);
                if (h == 0) gsq[lme * 8 + hh * 2 + pt] = q;
            }
            __syncthreads();
        }
        {
            const float* wsn = p.in[12];
            for (int i = tid; i < 128 * 32; i += NTHREADS) {
                const int l = i >> 5, c8 = (i & 31) * 8;
                float s = 0.f;
#pragma unroll
                for (int q = 0; q < 8; ++q) s += gsq[l * 8 + q];
                const float rstd = 1.f / sqrtf(s * (1.f / 256.f) + EPS);
                const u32x4 t = *(const u32x4*)(A2 + (row0 + l) * 1024 + 512 + g * 256 + c8);
                const f32x4 w0 = *(const f32x4*)(wsn + g * 256 + c8), w1 = *(const f32x4*)(wsn + g * 256 + c8 + 4);
                u32x4 o; o.x = pk2(bflo(t.x) * rstd * w0.x, bfhi(t.x) * rstd * w0.y); o.y = pk2(bflo(t.y) * rstd * w0.z, bfhi(t.y) * rstd * w0.w); o.z = pk2(bflo(t.z) * rstd * w1.x, bfhi(t.z) * rstd * w1.y); o.w = pk2(bflo(t.w) * rstd * w1.z, bfhi(t.w) * rstd * w1.w);
                *(u32x4*)(A2 + (row0 + l) * 1024 + 512 + g * 256 + c8) = o;
            }
        }
        __syncthreads();
    }
}

__device__ __forceinline__ void phase5(const Params& p, unsigned char* lds) {
    unsigned char* ws = p.ws;
    pg8::Gemm g{(const bf16_t*)(ws + WS_A2), (const bf16_t*)(ws + WS_WOUT), NT, DM, DM};
    pg8::StaticOrder S; S.init(NT, DM, (int)gridDim.x, (int)blockIdx.x);
    pg8::EpiResid<true, true> E{p.in[0], (bf16_t*)(ws + WS_XB), (float*)(ws + WS_SSQ)};
    pg8::gemm_phase<pg8::EpiResid<true, true>, pg8::StaticOrder, true, true>(LDS3(lds), g, S, E);
}
__device__ __forceinline__ void phase6(const Params& p, unsigned char* lds) {
    unsigned char* ws = p.ws;
    pg8::Gemm g{(const bf16_t*)(ws + WS_XB), (const bf16_t*)(ws + WS_WQ), NT, 512, DM};
    pg8::StaticOrder S; S.init(NT, 512, (int)gridDim.x, (int)blockIdx.x);
    pg8::EpiQ E{(bf16_t*)(ws + WS_Q2), (const float*)(ws + WS_SSQ)};
    pg8::gemm_phase<pg8::EpiQ, pg8::StaticOrder, true, true>(LDS3(lds), g, S, E);
}
__device__ __forceinline__ void phase8(const Params& p, unsigned char* lds) {
    unsigned char* ws = p.ws;
    pg8::Gemm g{(const bf16_t*)(ws + WS_XO), (const bf16_t*)(ws + WS_WO), NT, DM, 512};
    pg8::StaticOrder S; S.init(NT, DM, (int)gridDim.x, (int)blockIdx.x);
    pg8::EpiResid<false, false> E{(const void*)(ws + WS_XB), (bf16_t*)(ws + WS_XB), nullptr};
    pg8::gemm_phase<pg8::EpiResid<false, false>, pg8::StaticOrder, true, true>(LDS3(lds), g, S, E);
}

__device__ __forceinline__ void phase7(const Params& p, unsigned char* lds) {
    const int tid = opaque_tid(), lane = tid & 63, w = tid >> 6, r = lane & 31, h = lane >> 5;
    const bf16_t* q2 = (const bf16_t*)(p.ws + WS_Q2); const bf16_t* kmem = (const bf16_t*)(p.ws + WS_KMEM); const bf16_t* vmemT = (const bf16_t*)(p.ws + WS_VMEMT);
    bf16_t* xo = (bf16_t*)(p.ws + WS_XO);
    bf16_t* sK = (bf16_t*)lds;
    bf16_t* sV = sK + 256 * 136;
    const float sc = 0.08838834764831845f * 1.4426950408889634f;
    for (int pr = blockIdx.x; pr < 256; pr += gridDim.x) {
        const int bh = pr >> 3, rp = pr & 7, b = bh >> 2, hx = bh & 3;
        __syncthreads();
        for (int i = tid; i < 4096; i += NTHREADS) { const int key = i >> 4, ch = i & 15;
            *(u32x4*)(sK + key * 136 + ch * 8) = *(const u32x4*)(kmem + ((size_t)b * 256 + key) * 512 + hx * 128 + ch * 8); }
        for (int i = tid; i < 4096; i += NTHREADS) { const int d = i >> 5, ch = i & 31;
            const u32x4 v = *(const u32x4*)(vmemT + (((size_t)b * 4 + hx) * 128 + d) * 256 + ch * 8);
            *(u32x2*)(sV + d * 260 + ch * 8) = (u32x2){v.x, v.y}; *(u32x2*)(sV + d * 260 + ch * 8 + 4) = (u32x2){v.z, v.w}; }
        __syncthreads();
#pragma unroll 1
        for (int ib = 0; ib < 2; ++ib) {
            const size_t row0 = (size_t)b * SEQ + (size_t)(2 * rp + ib) * 256 + w * 32;
            bf16x8 qf[8];
            const bf16_t* qp = q2 + (row0 + r) * 512 + hx * 128 + 8 * h;
#pragma unroll
            for (int kk = 0; kk < 8; ++kk) qf[kk] = *(const bf16x8*)(qp + kk * 16);
            f32x16 S[8];
#pragma unroll
            for (int t = 0; t < 8; ++t) S[t] = zero16();
            const bf16_t* kp = sK + r * 136 + 8 * h;
#pragma unroll
            for (int kk = 0; kk < 8; ++kk) {
#pragma unroll
                for (int t = 0; t < 8; ++t) { const bf16x8 a = *(const bf16x8*)(kp + t * (32 * 136) + kk * 16); S[t] = mfma32(a, qf[kk], S[t]); }
                __builtin_amdgcn_sched_barrier(0);
            }
            float m = -INFINITY;
#pragma unroll
            for (int t = 0; t < 8; ++t)
#pragma unroll
                for (int i = 0; i < 16; ++i) m = fmaxf(m, S[t][i]);
            m = fmaxf(m, __shfl_xor(m, 32));
            float sum = 0.f;
            bf16x8 P[16];
#pragma unroll
            for (int t = 0; t < 8; ++t) {
                float e[16];
#pragma unroll
                for (int i = 0; i < 16; ++i) { e[i] = __builtin_amdgcn_exp2f((S[t][i] - m) * sc); sum += e[i]; }
                P[2 * t] = pack8(e[0], e[1], e[2], e[3], e[4], e[5], e[6], e[7]);
                P[2 * t + 1] = pack8(e[8], e[9], e[10], e[11], e[12], e[13], e[14], e[15]);
            }
            sum += __shfl_xor(sum, 32);
            const float inv = 1.f / sum;
            f32x16 O[4];
#pragma unroll
            for (int dt = 0; dt < 4; ++dt) O[dt] = zero16();
            const bf16_t* vp0 = sV + r * 260 + 4 * h;
#pragma unroll
            for (int ts = 0; ts < 16; ++ts) {
#pragma unroll
                for (int dt = 0; dt < 4; ++dt) {
                    const bf16_t* vp = vp0 + dt * (32 * 260) + 16 * ts;
                    const u32x2 lo = *(const u32x2*)vp, hi = *(const u32x2*)(vp + 8);
                    const bf16x8 a = __builtin_bit_cast(bf16x8, (u32x4){lo.x, lo.y, hi.x, hi.y});
                    O[dt] = mfma32(a, P[ts], O[dt]);
                }
                if (ts & 1) __builtin_amdgcn_sched_barrier(0);
            }
            bf16_t* op = xo + (row0 + r) * 512 + hx * 128 + 4 * h;
#pragma unroll
            for (int dt = 0; dt < 4; ++dt)
#pragma unroll
                for (int g = 0; g < 4; ++g) { u32x2 o; o.x = pk2(O[dt][4 * g] * inv, O[dt][4 * g + 1] * inv); o.y = pk2(O[dt][4 * g + 2] * inv, O[dt][4 * g + 3] * inv);
                    *(u32x2*)(op + 32 * dt + 8 * g) = o; }
        }
    }
}

typedef __bf16 bf16x2_t __attribute__((ext_vector_type(2)));
__device__ __forceinline__ float dot2bf(unsigned a, unsigned b, float acc) { return __builtin_amdgcn_fdot2_f32_bf16(__builtin_bit_cast(bf16x2_t, a), __builtin_bit_cast(bf16x2_t, b), acc, false); }
__device__ __forceinline__ void phase9(const Params& p, unsigned char* lds) {
    const int tid = opaque_tid(), lane = tid & 63, w = tid >> 6;
    const int gw = blockIdx.x * NWAVES + w, NGW = gridDim.x * NWAVES;
    const bf16_t* x2 = (const bf16_t*)(p.ws + WS_XB);
    int* cnt = (int*)(p.ws + WS_CTL);
    int* list = (int*)(p.ws + WS_LIST);
    float* route = (float*)(p.ws + WS_ROUTE);
    const float* bg = p.in[21]; const float* be = p.in[23];
    bf16_t* sW = (bf16_t*)lds;
    { const u32x4* src = (const u32x4*)(p.ws + WS_WR); u32x4* dst = (u32x4*)lds;
      for (int i = tid; i < 36 * 1024 / 8; i += NTHREADS) dst[i] = src[i]; }
    __syncthreads();
    const float mybias = (lane < 4) ? bg[lane] : ((lane < 36) ? be[lane - 4] : 0.f);
    int* lcnt = (int*)(lds + 73728);
    float* lrec = (float*)(lds + 73728 + 256);
    if (tid < 64) lcnt[tid] = 0;
    __syncthreads();
    u32x4 nx0, nx1;
    if (gw < NT) { const u32x4* xr = (const u32x4*)(x2 + (size_t)gw * DM); nx0 = xr[lane]; nx1 = xr[64 + lane]; }
    int nloc = 0;
    const int cap = (NT + NGW - 1) / NGW;
#pragma unroll 1
    for (int m = gw; m < NT; m += NGW) {
        const u32x4 x0 = nx0, x1 = nx1;
        if (m + NGW < NT) { const u32x4* xr = (const u32x4*)(x2 + (size_t)(m + NGW) * DM); nx0 = xr[lane]; nx1 = xr[64 + lane]; }
        float a[64];
#pragma unroll
        for (int q = 0; q < 64; ++q) a[q] = 0.f;
#pragma unroll
        for (int n = 0; n < 36; ++n) {
            const u32x4 w0 = *(const u32x4*)(sW + n * 1024 + 8 * lane), w1 = *(const u32x4*)(sW + n * 1024 + 512 + 8 * lane);
            float acc = dot2bf(w0.x, x0.x, 0.f); acc = dot2bf(w0.y, x0.y, acc); acc = dot2bf(w0.z, x0.z, acc); acc = dot2bf(w0.w, x0.w, acc);
            float acc2 = dot2bf(w1.x, x1.x, 0.f); acc2 = dot2bf(w1.y, x1.y, acc2); acc2 = dot2bf(w1.z, x1.z, acc2); acc2 = dot2bf(w1.w, x1.w, acc2);
            a[n] = acc + acc2;
            if ((n & 3) == 3) __builtin_amdgcn_sched_barrier(0);
        }
        { float q1 = dot2bf(x0.x, x0.x, 0.f); q1 = dot2bf(x0.y, x0.y, q1); q1 = dot2bf(x0.z, x0.z, q1); q1 = dot2bf(x0.w, x0.w, q1);
          float q2 = dot2bf(x1.x, x1.x, 0.f); q2 = dot2bf(x1.y, x1.y, q2); q2 = dot2bf(x1.z, x1.z, q2); q2 = dot2bf(x1.w, x1.w, q2);
          a[36] = q1 + q2; }
        float b32[32], b16[16], b8[8], b4[4], b2[2], mine;
        { const bool hi = (lane & 32) != 0;
#pragma unroll
          for (int q = 0; q < 32; ++q) { const float send = hi ? a[q] : a[q + 32], keep = hi ? a[q + 32] : a[q]; b32[q] = keep + __shfl_xor(send, 32); } }
        { const bool hi = (lane & 16) != 0;
#pragma unroll
          for (int q = 0; q < 16; ++q) { const float send = hi ? b32[q] : b32[q + 16], keep = hi ? b32[q + 16] : b32[q]; b16[q] = keep + __shfl_xor(send, 16); } }
        { const bool hi = (lane & 8) != 0;
#pragma unroll
          for (int q = 0; q < 8; ++q) { const float send = hi ? b16[q] : b16[q + 8], keep = hi ? b16[q + 8] : b16[q]; b8[q] = keep + __shfl_xor(send, 8); } }
        { const bool hi = (lane & 4) != 0;
#pragma unroll
          for (int q = 0; q < 4; ++q) { const float send = hi ? b8[q] : b8[q + 4], keep = hi ? b8[q + 4] : b8[q]; b4[q] = keep + __shfl_xor(send, 4); } }
        { const bool hi = (lane & 2) != 0;
#pragma unroll
          for (int q = 0; q < 2; ++q) { const float send = hi ? b4[q] : b4[q + 2], keep = hi ? b4[q + 2] : b4[q]; b2[q] = keep + __shfl_xor(send, 2); } }
        { const bool hi = (lane & 1) != 0; const float send = hi ? b2[0] : b2[1], keep = hi ? b2[1] : b2[0]; mine = keep + __shfl_xor(send, 1); }
        const float rstd = 1.f / sqrtf(__shfl(mine, 36) * (1.f / DM) + EPS);
        mine = mine * rstd + mybias;
        const float g0 = __shfl(mine, 0), g1 = __shfl(mine, 1), g2 = __shfl(mine, 2), g3 = __shfl(mine, 3);
        int gi = 0; float gm = g0;
        if (g1 > gm) { gm = g1; gi = 1; }
        if (g2 > gm) { gm = g2; gi = 2; }
        if (g3 > gm) { gm = g3; gi = 3; }
        const float gden = __expf(g0 - gm) + __expf(g1 - gm) + __expf(g2 - gm) + __expf(g3 - gm);
        const float ggate = 1.f / gden;
        float ev[8];
#pragma unroll
        for (int j = 0; j < 8; ++j) ev[j] = __shfl(mine, 4 + gi * 8 + j);
        int i1 = 0; float v1 = ev[0];
#pragma unroll
        for (int j = 1; j < 8; ++j) if (ev[j] > v1) { v1 = ev[j]; i1 = j; }
        int i2 = -1; float v2 = -INFINITY;
#pragma unroll
        for (int j = 0; j < 8; ++j) if (j != i1 && ev[j] > v2) { v2 = ev[j]; i2 = j; }
        const float e2 = __expf(v2 - v1);
        const float w1 = ggate / (1.f + e2), w2 = ggate * e2 / (1.f + e2);
        const int ea = gi * 8 + i1, eb = gi * 8 + i2;
        if (lane == 0) {
            const int la = atomicAdd(lcnt + ea, 1), lb = atomicAdd(lcnt + eb, 1);
            float* rc = lrec + (size_t)(w * cap + nloc) * 8;
            ((int*)rc)[0] = ea; ((int*)rc)[1] = eb; ((int*)rc)[2] = la; ((int*)rc)[3] = lb; rc[4] = w1; rc[5] = w2; rc[6] = rstd; ((int*)rc)[7] = m;
        }
        ++nloc;
    }
    __syncthreads();
    if (tid < 32) lcnt[32 + tid] = lcnt[tid] ? atomicAdd(cnt + tid * 64, lcnt[tid]) : 0;
    __syncthreads();
    if (lane < nloc) {
        const float* rc = lrec + (size_t)(w * cap + lane) * 8;
        const int ea = ((const int*)rc)[0], eb = ((const int*)rc)[1], m = ((const int*)rc)[7];
        const int pa = lcnt[32 + ea] + ((const int*)rc)[2], pb = lcnt[32 + eb] + ((const int*)rc)[3];
        list[ea * NT + pa] = m; list[eb * NT + pb] = m;
        int* ri = (int*)(route + (size_t)m * 8);
        ri[0] = ea; ri[1] = eb; ri[2] = pa; ri[3] = pb;
        route[(size_t)m * 8 + 4] = rc[4]; route[(size_t)m * 8 + 5] = rc[5]; route[(size_t)m * 8 + 6] = rc[6]; route[(size_t)m * 8 + 7] = 0.f;
    }
}

__device__ __forceinline__ int* moe_tables(const Params& p, unsigned char* lds) {
    int* off = (int*)(lds + 131072);
    const int* cnt = (const int*)(p.ws + WS_CTL);
    if (threadIdx.x == 0) { int a = 0; for (int e = 0; e < NEXP; ++e) { off[e] = a; a += ((cnt[e * 64] + 255) >> 8) << 8; } off[NEXP] = a; }
    if (threadIdx.x < NEXP) off[40 + threadIdx.x] = cnt[threadIdx.x * 64];
    __syncthreads();
    const int nrt = off[NEXP] >> 8;
    for (int rt = threadIdx.x; rt < nrt; rt += NTHREADS) { int e = 0; for (int q = 1; q < NEXP; ++q) if (off[q] <= rt * 256) e = q; off[128 + rt] = e; }
    __syncthreads();
    return off;
}

__device__ __forceinline__ void phase10(const Params& p, unsigned char* lds) {
    const int tid = opaque_tid(), lane = tid & 63, w = tid >> 6;
    const int* off = moe_tables(p, lds);
    const int gw = blockIdx.x * NWAVES + w, NGW = gridDim.x * NWAVES;
    const bf16_t* x2 = (const bf16_t*)(p.ws + WS_XB); const float* route = (const float*)(p.ws + WS_ROUTE);
    bf16_t* xg = (bf16_t*)(p.ws + WS_XG);
    for (int m = gw; m < NT; m += NGW) {
        const int* ri = (const int*)(route + (size_t)m * 8);
        const int ea = ri[0], eb = ri[1], pa = ri[2], pb = ri[3];
        const float rs = route[(size_t)m * 8 + 6];
        const size_t sa = (size_t)off[ea] + pa, sb = (size_t)off[eb] + pb;
        const u32x2* xr = (const u32x2*)(x2 + (size_t)m * DM) + lane;
        u32x2* oa = (u32x2*)(xg + sa * DM) + lane; u32x2* ob = (u32x2*)(xg + sb * DM) + lane;
#pragma unroll
        for (int j = 0; j < 4; ++j) { const u32x2 t = xr[64 * j]; u32x2 o; o.x = pk2(bflo(t.x) * rs, bfhi(t.x) * rs); o.y = pk2(bflo(t.y) * rs, bfhi(t.y) * rs); oa[64 * j] = o; ob[64 * j] = o; }
    }
}

__device__ __forceinline__ void phase11(const Params& p, unsigned char* lds) {
    const int tid = opaque_tid();
    const int* off = moe_tables(p, lds);
    const int nrt = off[NEXP] >> 8, G = (int)gridDim.x, c = (int)blockIdx.x;
    unsigned* rowtab = (unsigned*)(lds + 131072 + 2048);
    float* rstab = (float*)(lds + 131072 + 2048 + 3072);
    {
        const int* list = (const int*)(p.ws + WS_LIST); const float* route = (const float*)(p.ws + WS_ROUTE);
        for (int i = 0; i < 3; ++i) {
            const int L = i * G + c; if (L >= nrt * 2) break;
            const int rt = L >> 1, e = off[128 + rt], cnt_e = off[40 + e], pos0 = rt * 256 - off[e];
            if (tid < 256) { const int pos = pos0 + tid; int tok = 0; float rs = 0.f;
                if (pos < cnt_e) { tok = list[e * NT + pos]; rs = route[(size_t)tok * 8 + 6]; }
                rowtab[i * 256 + tid] = (unsigned)tok * (unsigned)(DM * 2); rstab[i * 256 + tid] = rs; }
        }
    }
    __syncthreads();
    pg8::Gemm g{(const bf16_t*)(p.ws + WS_XB), (const bf16_t*)(p.ws + WS_WGU), 0, 0, DM};
    pg8::MoeOrder S{(const __attribute__((address_space(3))) int*)(off + 128), nrt, 2, G, c};
    pg8::EpiGU E{(bf16_t*)(p.ws + WS_HID), (const __attribute__((address_space(3))) float*)rstab, G, c};
    pg8::gemm_phase_g<pg8::EpiGU, pg8::MoeOrder, true, true>(LDS3(lds), g, S, E, (const __attribute__((address_space(3))) unsigned*)rowtab);
}
__device__ __forceinline__ void phase12(const Params& p, unsigned char* lds) {
    const int* off = moe_tables(p, lds);
    int kdim = EFF; asm volatile("" : "+s"(kdim));
    pg8::Gemm g{(const bf16_t*)(p.ws + WS_HID), (const bf16_t*)(p.ws + WS_WD), 0, 0, kdim};
    pg8::MoeOrder S{(const __attribute__((address_space(3))) int*)(off + 128), off[NEXP] >> 8, 4, (int)gridDim.x, (int)blockIdx.x};
    pg8::EpiBf16 E{(bf16_t*)(p.ws + WS_Y), DM, 4};
    pg8::gemm_phase<pg8::EpiBf16, pg8::MoeOrder, true, true>(LDS3(lds), g, S, E);
}

__device__ __forceinline__ void phase13(const Params& p, unsigned char* lds) {
    const int tid = opaque_tid(), lane = tid & 63, w = tid >> 6;
    const int* off = moe_tables(p, lds);
    const int gw = blockIdx.x * NWAVES + w, NGW = gridDim.x * NWAVES;
    const bf16_t* x2 = (const bf16_t*)(p.ws + WS_XB); const bf16_t* yb = (const bf16_t*)(p.ws + WS_Y);
    const float* route = (const float*)(p.ws + WS_ROUTE); const float* wf = p.in[27];
    f32x4 wv[4];
#pragma unroll
    for (int j = 0; j < 4; ++j) wv[j] = *(const f32x4*)(wf + 4 * lane + 256 * j);
    u32x4 recA, recB;
    u32x2 cx[4], cya[4], cyb[4]; float cw1 = 0.f, cw2 = 0.f;
    u32x4 rec0;
#define ISSUE_ROWS(m_, rec_, X, YA, YB) { const size_t sa_ = (size_t)off[(int)(rec_).x] + (rec_).z, sb_ = (size_t)off[(int)(rec_).y] + (rec_).w; \
        const u32x2* xr_ = (const u32x2*)(x2 + (size_t)(m_) * DM) + lane; const u32x2* ya_ = (const u32x2*)(yb + sa_ * DM) + lane; const u32x2* yb_ = (const u32x2*)(yb + sb_ * DM) + lane; \
        _Pragma("unroll") for (int j = 0; j < 4; ++j) { X[j] = xr_[64 * j]; YA[j] = ya_[64 * j]; YB[j] = yb_[64 * j]; } }
    if (gw < NT) {
        rec0 = *(const u32x4*)(route + (size_t)gw * 8); const u32x2 wq = *(const u32x2*)(route + (size_t)gw * 8 + 4);
        cw1 = __uint_as_float(wq.x); cw2 = __uint_as_float(wq.y);
        ISSUE_ROWS(gw, rec0, cx, cya, cyb);
    }
    u32x2 wA = (u32x2){0u, 0u};
    if (gw + NGW < NT) { recA = *(const u32x4*)(route + (size_t)(gw + NGW) * 8); wA = *(const u32x2*)(route + (size_t)(gw + NGW) * 8 + 4); }
#pragma unroll 1
    for (int m = gw; m < NT; m += NGW) {
        u32x2 nx[4], nya[4], nyb[4]; u32x2 wB = (u32x2){0u, 0u};
        const bool has1 = (m + NGW < NT), has2 = (m + 2 * NGW < NT);
        if (has1) ISSUE_ROWS(m + NGW, recA, nx, nya, nyb);
        if (has2) { recB = *(const u32x4*)(route + (size_t)(m + 2 * NGW) * 8); wB = *(const u32x2*)(route + (size_t)(m + 2 * NGW) * 8 + 4); }
        f32x4 v[4]; float s = 0.f;
#pragma unroll
        for (int j = 0; j < 4; ++j) {
            const u32x2 t = cx[j], a = cya[j], bq = cyb[j];
            v[j].x = bflo(t.x) + cw1 * bflo(a.x) + cw2 * bflo(bq.x); v[j].y = bfhi(t.x) + cw1 * bfhi(a.x) + cw2 * bfhi(bq.x);
            v[j].z = bflo(t.y) + cw1 * bflo(a.y) + cw2 * bflo(bq.y); v[j].w = bfhi(t.y) + cw1 * bfhi(a.y) + cw2 * bfhi(bq.y);
            s += (v[j].x * v[j].x + v[j].y * v[j].y) + (v[j].z * v[j].z + v[j].w * v[j].w);
        }
        const float rstd = 1.f / sqrtf(wave_sum(s) * (1.f / DM) + EPS);
        f32x4* o = (f32x4*)(p.out + (size_t)m * DM) + lane;
#pragma unroll
        for (int j = 0; j < 4; ++j) o[64 * j] = v[j] * rstd * wv[j];
        if (has1) {
#pragma unroll
            for (int j = 0; j < 4; ++j) { cx[j] = nx[j]; cya[j] = nya[j]; cyb[j] = nyb[j]; }
            cw1 = __uint_as_float(wA.x); cw2 = __uint_as_float(wA.y);
        }
        recA = recB; wA = wB;
    }
#undef ISSUE_ROWS
}

constexpr int NPHASE = 14;
__global__ void __launch_bounds__(NTHREADS, 2) fwd_kernel(Params p) {
    extern __shared__ __attribute__((aligned(16))) unsigned char lds[];
#if MK_ONE_LAUNCH
    cg::grid_group grid = cg::this_grid();
    volatile LAS unsigned* bst = (volatile LAS unsigned*)(LDS3(lds) + LDS_BYTES - 16);
    if (threadIdx.x < 2) bst[threadIdx.x] = 0u;
    __syncthreads();
    const XcdBarrier xbar = xcd_barrier_post((unsigned*)(p.ws + WS_BAR), bst);
#define SEAM(k) do { if (p.ph_lo <= (k) && (k) + 1 < p.ph_hi) { if ((k) == 0) grid.sync(); else xcd_barrier(xbar); } } while (0)
#else
#define SEAM(k) do { } while (0)
#endif
#ifndef PROBE_PHASE
#define PROBE_PHASE -1
#endif
#define IN(k) (p.ph_lo <= (k) && (k) < p.ph_hi && (k) != p.skip)
#define REPS(k) (((k) == PROBE_PHASE) ? 2 : 1)
    if (IN(0)) { _Pragma("unroll 1") for (int rep = 0; rep < REPS(0); ++rep) { phase0(p, lds); } } SEAM(0);
    if (IN(1)) { _Pragma("unroll 1") for (int rep = 0; rep < REPS(1); ++rep) { phase1(p, lds); } } SEAM(1);
    if (IN(2)) { _Pragma("unroll 1") for (int rep = 0; rep < REPS(2); ++rep) for (int it = blockIdx.x; it < NB * NCH; it += gridDim.x) { const int b = it / NCH, c = it % NCH; phase2_attn(p, lds, b, c); phase2_states(p, lds, b, c); } } SEAM(2);
    if (IN(3)) { _Pragma("unroll 1") for (int rep = 0; rep < REPS(3); ++rep) { phase3(p); } } SEAM(3);
    if (IN(4)) { _Pragma("unroll 1") for (int rep = 0; rep < REPS(4); ++rep) for (int it = blockIdx.x; it < NB * NCH; it += gridDim.x) { const int b = it / NCH, c = it % NCH; phase4(p, lds, b, c); } } SEAM(4);
    if (IN(5)) { _Pragma("unroll 1") for (int rep = 0; rep < REPS(5); ++rep) { phase5(p, lds); } } SEAM(5);
    if (IN(6)) { _Pragma("unroll 1") for (int rep = 0; rep < REPS(6); ++rep) { phase6(p, lds); } } SEAM(6);
    if (IN(7)) { _Pragma("unroll 1") for (int rep = 0; rep < REPS(7); ++rep) { phase7(p, lds); } } SEAM(7);
    if (IN(8)) { phase8(p, lds); } SEAM(8);
    if (IN(9)) { phase9(p, lds); } SEAM(9);
    if (IN(11)) { _Pragma("unroll 1") for (int rep = 0; rep < REPS(11); ++rep) { phase11(p, lds); } } SEAM(11);
    if (IN(12)) { _Pragma("unroll 1") for (int rep = 0; rep < REPS(12); ++rep) { phase12(p, lds); } } SEAM(12);
    if (IN(13)) { _Pragma("unroll 1") for (int rep = 0; rep < REPS(13); ++rep) { phase13(p, lds); } }
#undef IN
#undef SEAM
}

extern "C" void kernel_launch(void* const* d_in, const int* in_sizes, int n_in, void* d_out, int out_size, void* d_ws, size_t ws_size, hipStream_t stream) {
    static int grid = 0;
    if (grid == 0) {
        if (n_in != 28 || out_size != NT * DM || ws_size < WS_NEED) { fprintf(stderr, "kernel_launch: unexpected sizes n_in %d out %d ws %zu\n", n_in, out_size, ws_size); grid = -1; return; }
        int dev = 0, cus = 0, per_cu = 0;
        hipGetDevice(&dev);
        hipDeviceGetAttribute(&cus, hipDeviceAttributeMultiprocessorCount, dev);
        if (hipFuncSetAttribute((const void*)fwd_kernel, hipFuncAttributeMaxDynamicSharedMemorySize, LDS_BYTES) != hipSuccess) { fprintf(stderr, "kernel_launch: hipFuncSetAttribute failed\n"); grid = -1; return; }
        if (hipOccupancyMaxActiveBlocksPerMultiprocessor(&per_cu, (const void*)fwd_kernel, NTHREADS, LDS_BYTES) != hipSuccess || per_cu < 1) { fprintf(stderr, "kernel_launch: occupancy query says %d\n", per_cu); per_cu = 1; }
        (void)hipGetLastError();
        grid = cus;
    }
    if (grid < 0) return;
    Params prm{};
    for (int i = 0; i < 28; ++i) prm.in[i] = (const float*)d_in[i];
    prm.out = (float*)d_out; prm.ws = (unsigned char*)d_ws;
    for (int i = 0; i < 8; ++i) prm.inv_freq[i] = powf(500000.0f, -(float)(2 * i) / 16.0f);
    prm.skip = -1;
#ifndef PROBE_SKIP
#define PROBE_SKIP -2
#endif
#if MK_ONE_LAUNCH
    for (int twice = 0; twice < ((PROBE_SKIP >= -1) ? 2 : 1); ++twice) {
    if (hipMemsetAsync((char*)d_ws + WS_CTL, 0, CTL_ZERO_BYTES, stream) != hipSuccess) { fprintf(stderr, "kernel_launch: memset failed\n"); return; }
#ifndef PROBE_TRUNC
#define PROBE_TRUNC NPHASE
#endif
    prm.ph_lo = 0; prm.ph_hi = twice ? PROBE_TRUNC : NPHASE; prm.skip = twice ? PROBE_SKIP : -1;
    void* args[] = {&prm};
    hipError_t e = hipLaunchCooperativeKernel((const void*)fwd_kernel, dim3(grid), dim3(NTHREADS), args, LDS_BYTES, stream);
    if (e != hipSuccess) fprintf(stderr, "cooperative launch failed: %s (grid %d)\n", hipGetErrorString(e), grid);
    }
#else
    if (hipMemsetAsync((char*)d_ws + WS_CTL, 0, CTL_ZERO_BYTES, stream) != hipSuccess) { fprintf(stderr, "kernel_launch: memset failed\n"); return; }
#ifndef PROBE_DUP
#define PROBE_DUP -1
#endif
    for (int ph = 0; ph < NPHASE; ++ph) {
        prm.ph_lo = ph; prm.ph_hi = ph + 1;
        hipLaunchKernelGGL(fwd_kernel, dim3(grid), dim3(NTHREADS), LDS_BYTES, stream, prm);
        if (ph == PROBE_DUP) hipLaunchKernelGGL(fwd_kernel, dim3(grid), dim3(NTHREADS), LDS_BYTES, stream, prm);
    }
#endif
}
```

```cpp
#include <hip/hip_runtime.h>
#include <hip/hip_cooperative_groups.h>
#include <cstdio>
#include <cmath>
namespace cg = cooperative_groups;

#ifndef MK_ONE_LAUNCH
#define MK_ONE_LAUNCH 1
#endif

typedef unsigned short bf16_t;
typedef short bf16x8 __attribute__((ext_vector_type(8)));
typedef float f32x4 __attribute__((ext_vector_type(4)));
typedef float f32x16 __attribute__((ext_vector_type(16)));
typedef unsigned u32x4 __attribute__((ext_vector_type(4)));
typedef unsigned u32x2 __attribute__((ext_vector_type(2)));

constexpr int NB = 8, SEQ = 4096, DM = 1024, NT = NB * SEQ;
constexpr int NPROJ = 2304, LDWIN = 2312;
constexpr int C_K = 512, C_V = 640, C_Z = 768, C_X = 1280, C_B = 1792, C_C = 2048;
constexpr int MEMT = 256, NMEM = NB * MEMT;
constexpr int NEXP = 32, EFF = 256;
constexpr int NCH = SEQ / 128;
constexpr float EPS = 1e-5f;
constexpr int NTHREADS = 512, NWAVES = 8;
constexpr int LDS_BYTES = 147456;

constexpr size_t MiB = (size_t)1 << 20;
constexpr size_t WS_CTL = 0, WS_BAR = 65536, CTL_ZERO_BYTES = 131072;
constexpr size_t WS_WIN = 1 * MiB, WS_WOUT = 6 * MiB, WS_WQ = 8 * MiB, WS_WKV = 9 * MiB, WS_WO = 11 * MiB, WS_WR = 12 * MiB;
constexpr size_t WS_WGU = 16 * MiB, WS_WD = 48 * MiB;
constexpr size_t WS_MEMH = 64 * MiB, WS_KMEM = 68 * MiB, WS_VMEMT = 70 * MiB, WS_DTRAW = 72 * MiB, WS_CDEC = 73 * MiB, WS_ROUTE = 74 * MiB;
constexpr size_t WS_LIST = 76 * MiB, WS_SSQ = 80 * MiB;
constexpr size_t WS_PROJ = 96 * MiB, WS_A2 = 240 * MiB, WS_STATES = 304 * MiB, WS_START = 368 * MiB;
constexpr size_t WS_X1 = 96 * MiB, WS_XB = 304 * MiB, WS_Q2 = 368 * MiB, WS_XO = 224 * MiB, WS_XG = 96 * MiB, WS_HID = 368 * MiB, WS_Y = 96 * MiB;
constexpr size_t WS_H1 = 416 * MiB;
constexpr size_t WS_NEED = 512 * MiB;

struct Params {
    const float* in[28];
    float* out;
    unsigned char* ws;
    float inv_freq[8];
    int ph_lo, ph_hi, skip, pad;
};

__device__ __forceinline__ unsigned f2bf(float f) { unsigned u = __float_as_uint(f); return (u + 0x7fffu + ((u >> 16) & 1u)) >> 16; }
__device__ __forceinline__ float bf2f(unsigned h) { return __uint_as_float(h << 16); }
__device__ __forceinline__ unsigned pk2(float lo, float hi) { return f2bf(lo) | (f2bf(hi) << 16); }
__device__ __forceinline__ float bflo(unsigned u) { return __uint_as_float(u << 16); }
__device__ __forceinline__ float bfhi(unsigned u) { return __uint_as_float(u & 0xffff0000u); }
__device__ __forceinline__ float wave_sum(float v) {
#pragma unroll
    for (int o = 32; o >= 1; o >>= 1) v += __shfl_xor(v, o);
    return v;
}
#define LDS_WAIT() asm volatile("s_waitcnt lgkmcnt(0)" ::: "memory")
__device__ __forceinline__ int opaque_tid() { int t = threadIdx.x; asm volatile("" : "+v"(t)); return t; }
__device__ __forceinline__ float siluf(float v) { return v * __builtin_amdgcn_rcpf(1.f + __expf(-v)); }
__device__ __forceinline__ f32x16 mfma32(bf16x8 a, bf16x8 b, f32x16 c) { return __builtin_amdgcn_mfma_f32_32x32x16_bf16(a, b, c, 0, 0, 0); }
__device__ __forceinline__ f32x16 zero16() { f32x16 z;
#pragma unroll
    for (int i = 0; i < 16; ++i) z[i] = 0.f;
    return z; }
__device__ __forceinline__ bf16x8 pack8(float a0, float a1, float a2, float a3, float a4, float a5, float a6, float a7) {
    u32x4 t; t.x = pk2(a0, a1); t.y = pk2(a2, a3); t.z = pk2(a4, a5); t.w = pk2(a6, a7);
    return __builtin_bit_cast(bf16x8, t);
}
__device__ __forceinline__ int crow(int i, int h) { return (i & 3) + 8 * (i >> 2) + 4 * h; }

namespace pg8 {
#define PG8_LAS __attribute__((address_space(3)))
typedef unsigned short bf16_t;
typedef short bf16x8 __attribute__((ext_vector_type(8)));
typedef float f32x4 __attribute__((ext_vector_type(4)));
typedef unsigned u32x4 __attribute__((ext_vector_type(4)));
constexpr int BM = 256, BK = 64, HALF = 128, HTB = HALF * BK * 2  , STAGE_BYTES = 8 * HTB, NXCD = 8, WGM = 8;

__host__ __device__ __forceinline__ int lds_byte(int r, int c) { const int st = (r >> 4) * 2 + (c >> 5), rr = r & 15, cc = c & 31, ob = rr * 64 + cc * 2; return st * 1024 + (ob ^ (((ob >> 9) & 1) << 5)); }
__host__ __device__ __forceinline__ void stage_rc(int b, int& R, int& C) { const int st = b / 1024, sb = b % 1024, swz = sb ^ (((sb >> 9) & 1) << 5); R = (st >> 1) * 16 + swz / 64; C = (st & 1) * 32 + (swz % 64) / 2; }
__host__ __device__ __forceinline__ int perm32(int rho) { const int n = rho >> 4, i = rho & 15; return 8 * (i >> 2) + 4 * n + (i & 3); }

struct Unit { int pm, pn; };
struct Gemm { const bf16_t* A; const bf16_t* Bt; int M, N, K; };

struct StaticOrder {
    int nM, nN, nwg, G, c;
    __host__ __device__ void init(int M, int N, int G_, int c_) { nM = M / BM; nN = N / BM; nwg = nM * nN; G = G_; c = c_; }
    __host__ __device__ bool next(int i, Unit& u) const {
        const long L = (long)i * G + c; if (L >= nwg) return false;
        int wgid = (int)L; { const int q = nwg / NXCD, r = nwg % NXCD, xcd = wgid % NXCD, off = wgid / NXCD; wgid = (xcd < r ? xcd * (q + 1) : r * (q + 1) + (xcd - r) * q) + off; }
        const int nig = WGM * nN, gid = wgid / nig, fm = gid * WGM, gsz = (nM - fm) < WGM ? (nM - fm) : WGM;
        u.pm = fm + ((wgid % nig) % gsz); u.pn = (wgid % nig) / gsz; return true;
    }
    __device__ __forceinline__ void a_ready(const Unit&) const {}
    __device__ __forceinline__ void done(const Unit&) const {}
};
__device__ __forceinline__ unsigned cvt_pk_bf16(float lo, float hi) { unsigned r; asm volatile("v_cvt_pk_bf16_f32 %0, %1, %2" : "=v"(r) : "v"(lo), "v"(hi)); return r; }
typedef float f32x2 __attribute__((ext_vector_type(2)));
template <class Epi, class Sched, bool ALIGN_EPI = false, bool SP2 = false>
__device__ __forceinline__ void gemm_phase(PG8_LAS unsigned char* lds, const Gemm g, const Sched& S, const Epi& E) {
    const int tid = threadIdx.x, wid = __builtin_amdgcn_readfirstlane(tid >> 6), lane = tid & 63, wr = wid >> 2, wc = wid & 3, fr = lane & 15, fq = lane >> 4;
    const int K = g.K, nt = K / BK;
    unsigned voffA[2], voffB[2];
#pragma unroll
    for (int i = 0; i < 2; ++i) { int R, C; stage_rc(tid * 16 + i * 8192, R, C); const int Rb = Epi::PERM ? ((R & ~31) + perm32(R & 31)) : R;
        voffA[i] = (unsigned)(R * K + C) * 2u; voffB[i] = (unsigned)(Rb * K + C) * 2u; }
    const size_t kstep = (size_t)(BK * 2);
    const size_t hstep = (size_t)HALF * K * 2;
    const size_t tstep = 2 * hstep;
    const unsigned ldsw = (unsigned)wid * 1024u;
    const int aoff = lds_byte(wr * 64 + fr, fq * 8), boff = lds_byte(wc * 32 + fr, fq * 8);
#define PG8_SA(b, h) (((b) * 2 + (h)) * HTB)
#define PG8_SB(b, h) ((4 + (b) * 2 + (h)) * HTB)
#define PG8_STAGE(bufoff, gbase, voff) do { _Pragma("unroll") for (int _i = 0; _i < 2; ++_i) \
        __builtin_amdgcn_global_load_lds((const unsigned*)((const char*)(gbase) + (voff)[_i]), (PG8_LAS unsigned*)(lds + (bufoff) + ldsw + _i * 8192), 16, 0, 0); } while (0)
#define PG8_LDA(dst, b, h) do { _Pragma("unroll") for (int m = 0; m < 4; ++m) _Pragma("unroll") for (int k = 0; k < 2; ++k) dst[m][k] = *(const PG8_LAS bf16x8*)(lds + PG8_SA(b, h) + aoff + m * 2048 + k * 1024); } while (0)
#define PG8_LDB(dst, b, h) do { _Pragma("unroll") for (int n = 0; n < 2; ++n) _Pragma("unroll") for (int k = 0; k < 2; ++k) dst[n][k] = *(const PG8_LAS bf16x8*)(lds + PG8_SB(b, h) + boff + n * 2048 + k * 1024); } while (0)
#define PG8_MMA(ai, bj, At, Bt) do { __builtin_amdgcn_s_setprio(1); _Pragma("unroll") for (int m = 0; m < 4; ++m) _Pragma("unroll") for (int n = 0; n < 2; ++n) _Pragma("unroll") for (int k = 0; k < 2; ++k) \
        acc[ai][bj][m][n] = __builtin_amdgcn_mfma_f32_16x16x32_bf16(Bt[n][k], At[m][k], acc[ai][bj][m][n], 0, 0, 0); __builtin_amdgcn_s_setprio(0); } while (0)
#define PG8_WAIT_V(n) asm volatile("s_waitcnt vmcnt(" #n ")" ::: "memory")
#define PG8_WAIT_L(n) asm volatile("s_waitcnt lgkmcnt(" #n ")" ::: "memory")
#define PG8_BAR __builtin_amdgcn_s_barrier()
#define PG8_SCHED __builtin_amdgcn_sched_barrier(0)
    Unit cur, nxt; int ui = 0;
    if (!S.next(0, cur)) return;
    f32x4 acc[2][2][4][2];
#pragma unroll
    for (int a = 0; a < 2; ++a)
#pragma unroll
        for (int b = 0; b < 2; ++b)
#pragma unroll
            for (int m = 0; m < 4; ++m)
#pragma unroll
                for (int n = 0; n < 2; ++n) acc[a][b][m][n] = (f32x4){0.f, 0.f, 0.f, 0.f};
    bf16x8 At[4][2], B0[2][2], B1[2][2];
    const char* cA = (const char*)g.A + (size_t)cur.pm * tstep; const char* cB = (const char*)g.Bt + (size_t)cur.pn * tstep;
    S.a_ready(cur);
    if constexpr (SP2) {
        PG8_STAGE(PG8_SB(0, 0), cB, voffB); PG8_STAGE(PG8_SB(0, 1), cB + hstep, voffB); PG8_STAGE(PG8_SA(0, 0), cA, voffA); PG8_STAGE(PG8_SA(0, 1), cA + hstep, voffA);
        if (wr == 1) PG8_BAR;
        PG8_WAIT_V(2); PG8_BAR;
        PG8_STAGE(PG8_SB(1, 0), cB + kstep, voffB); PG8_STAGE(PG8_SA(1, 0), cA + kstep, voffA); PG8_STAGE(PG8_SB(1, 1), cB + hstep + kstep, voffB);
        PG8_WAIT_V(6); PG8_BAR;
    } else {
        PG8_STAGE(PG8_SB(0, 0), cB, voffB); PG8_STAGE(PG8_SA(0, 0), cA, voffA); PG8_STAGE(PG8_SB(0, 1), cB + hstep, voffB); PG8_STAGE(PG8_SA(0, 1), cA + hstep, voffA);
        if (wr == 1) PG8_BAR;
        PG8_WAIT_V(4); PG8_BAR;
        PG8_STAGE(PG8_SB(1, 0), cB + kstep, voffB); PG8_STAGE(PG8_SA(1, 0), cA + kstep, voffA); PG8_STAGE(PG8_SB(1, 1), cB + hstep + kstep, voffB);
        PG8_WAIT_V(6); PG8_BAR;
    }
    for (;;) {
        const bool has_next = S.next(ui + 1, nxt);
        const char* nA = has_next ? (const char*)g.A + (size_t)nxt.pm * tstep : cA; const char* nB = has_next ? (const char*)g.Bt + (size_t)nxt.pn * tstep : cB;
        for (int t = 0; t < nt; t += 2) {
            const bool last = (t == nt - 2);
            const char* a1 = cA + (size_t)(t + 1) * kstep;
            const char* a2 = last ? nA : cA + (size_t)(t + 2) * kstep; const char* b2 = last ? nB : cB + (size_t)(t + 2) * kstep;
            const char* a3 = a2 + kstep; const char* b3 = b2 + kstep;
            if (last && has_next) S.a_ready(nxt);
            if constexpr (SP2) {
            PG8_LDB(B0, 0, 0); PG8_LDB(B1, 0, 1); PG8_SCHED; PG8_LDA(At, 0, 0); PG8_STAGE(PG8_SA(1, 1), a1 + hstep, voffA);
            PG8_WAIT_V(8); PG8_WAIT_L(0); PG8_BAR; PG8_MMA(0, 0, At, B0); PG8_MMA(0, 1, At, B1); PG8_BAR; PG8_SCHED;
            PG8_LDA(At, 0, 1); PG8_STAGE(PG8_SB(0, 0), b2, voffB); PG8_STAGE(PG8_SB(0, 1), b2 + hstep, voffB); PG8_STAGE(PG8_SA(0, 0), a2, voffA);
            PG8_WAIT_V(8); PG8_WAIT_L(0); PG8_BAR; PG8_MMA(1, 0, At, B0); PG8_MMA(1, 1, At, B1); PG8_BAR; PG8_SCHED;
            PG8_LDB(B0, 1, 0); PG8_LDB(B1, 1, 1); PG8_SCHED; PG8_LDA(At, 1, 0); PG8_STAGE(PG8_SA(0, 1), a2 + hstep, voffA);
            PG8_WAIT_V(8); PG8_WAIT_L(0); PG8_BAR; PG8_MMA(0, 0, At, B0); PG8_MMA(0, 1, At, B1); PG8_BAR; PG8_SCHED;
            PG8_LDA(At, 1, 1); PG8_STAGE(PG8_SB(1, 0), b3, voffB); PG8_STAGE(PG8_SB(1, 1), b3 + hstep, voffB); PG8_STAGE(PG8_SA(1, 0), a3, voffA);
            PG8_WAIT_V(8); PG8_WAIT_L(0); PG8_BAR; PG8_MMA(1, 0, At, B0); PG8_MMA(1, 1, At, B1); PG8_BAR; PG8_SCHED;
            } else {
            PG8_LDB(B0, 0, 0); PG8_SCHED; PG8_LDA(At, 0, 0); PG8_STAGE(PG8_SA(1, 1), a1 + hstep, voffA);
            PG8_WAIT_L(8); PG8_BAR; PG8_WAIT_L(0); PG8_MMA(0, 0, At, B0); PG8_BAR; PG8_SCHED;
            PG8_LDB(B1, 0, 1); PG8_STAGE(PG8_SB(0, 0), b2, voffB);
            PG8_BAR; PG8_WAIT_L(0); PG8_MMA(0, 1, At, B1); PG8_BAR;
            PG8_LDA(At, 0, 1); PG8_STAGE(PG8_SA(0, 0), a2, voffA);
            PG8_BAR; PG8_WAIT_L(0); PG8_MMA(1, 0, At, B0); PG8_BAR; PG8_SCHED;
            PG8_STAGE(PG8_SB(0, 1), b2 + hstep, voffB);
            PG8_WAIT_V(6); PG8_BAR; PG8_MMA(1, 1, At, B1); PG8_BAR;
            PG8_LDB(B0, 1, 0); PG8_SCHED; PG8_LDA(At, 1, 0); PG8_STAGE(PG8_SA(0, 1), a2 + hstep, voffA);
            PG8_WAIT_L(8); PG8_BAR; PG8_WAIT_L(0); PG8_MMA(0, 0, At, B0); PG8_BAR; PG8_SCHED;
            PG8_LDB(B1, 1, 1); PG8_STAGE(PG8_SB(1, 0), b3, voffB);
            PG8_BAR; PG8_WAIT_L(0); PG8_MMA(0, 1, At, B1); PG8_BAR;
            PG8_LDA(At, 1, 1); PG8_STAGE(PG8_SA(1, 0), a3, voffA);
            PG8_BAR; PG8_WAIT_L(0); PG8_MMA(1, 0, At, B0); PG8_BAR; PG8_SCHED;
            PG8_STAGE(PG8_SB(1, 1), b3 + hstep, voffB);
            PG8_WAIT_V(6); PG8_BAR; PG8_MMA(1, 1, At, B1); PG8_BAR;
            }
        }
        if constexpr (ALIGN_EPI) { if (wr == 0) PG8_BAR; }
        if constexpr (!Epi::AFTER_DRAIN) { E(acc, cur, wr, wc, fr, fq); S.done(cur); }
        if (!has_next) break;
#pragma unroll
        for (int a = 0; a < 2; ++a)
#pragma unroll
            for (int b = 0; b < 2; ++b)
#pragma unroll
                for (int m = 0; m < 4; ++m)
#pragma unroll
                    for (int n = 0; n < 2; ++n) acc[a][b][m][n] = (f32x4){0.f, 0.f, 0.f, 0.f};
        cur = nxt; cA = nA; cB = nB; ++ui;
        if constexpr (ALIGN_EPI) { if (wr == 1) PG8_BAR; }
    }
    PG8_WAIT_V(0);
    if constexpr (!ALIGN_EPI) { if (wr == 0) PG8_BAR; }
    PG8_BAR;
    if constexpr (Epi::AFTER_DRAIN) { E.fused(acc, cur, wr, wc, fr, fq, lds, wid, lane); S.done(cur); }
#undef PG8_SA
#undef PG8_SB
#undef PG8_STAGE
#undef PG8_LDA
#undef PG8_LDB
#undef PG8_MMA
#undef PG8_WAIT_V
#undef PG8_WAIT_L
#undef PG8_BAR
#undef PG8_SCHED
}

template <class Epi, class Sched, bool ALIGN_EPI = false, bool SP2 = false>
__device__ __forceinline__ void gemm_phase_g(PG8_LAS unsigned char* lds, const Gemm g, const Sched& S, const Epi& E, const PG8_LAS unsigned* rowtab) {
    const int tid = threadIdx.x, wid = __builtin_amdgcn_readfirstlane(tid >> 6), lane = tid & 63, wr = wid >> 2, wc = wid & 3, fr = lane & 15, fq = lane >> 4;
    const int K = g.K, nt = K / BK;
    unsigned voffA[2], voffB[2]; int RA[2]; unsigned CA2[2];
#pragma unroll
    for (int i = 0; i < 2; ++i) { int R, C; stage_rc(tid * 16 + i * 8192, R, C); const int Rb = Epi::PERM ? ((R & ~31) + perm32(R & 31)) : R;
        voffA[i] = (unsigned)(R * K + C) * 2u; voffB[i] = (unsigned)(Rb * K + C) * 2u; RA[i] = R; CA2[i] = (unsigned)C * 2u; }
    unsigned vA0[2], vA1[2], nvA0[2], nvA1[2];
#pragma unroll
    for (int i = 0; i < 2; ++i) { vA0[i] = rowtab[RA[i]] + CA2[i]; vA1[i] = rowtab[128 + RA[i]] + CA2[i]; nvA0[i] = vA0[i]; nvA1[i] = vA1[i]; }
    const size_t kstep = (size_t)(BK * 2);
    const size_t hstep = (size_t)HALF * K * 2;
    const size_t tstep = 2 * hstep;
    const unsigned ldsw = (unsigned)wid * 1024u;
    const int aoff = lds_byte(wr * 64 + fr, fq * 8), boff = lds_byte(wc * 32 + fr, fq * 8);
#define PG8_SA(b, h) (((b) * 2 + (h)) * HTB)
#define PG8_SB(b, h) ((4 + (b) * 2 + (h)) * HTB)
#define PG8_STAGE(bufoff, gbase, voff) do { _Pragma("unroll") for (int _i = 0; _i < 2; ++_i) \
        __builtin_amdgcn_global_load_lds((const unsigned*)((const char*)(gbase) + (voff)[_i]), (PG8_LAS unsigned*)(lds + (bufoff) + ldsw + _i * 8192), 16, 0, 0); } while (0)
#define PG8_LDA(dst, b, h) do { _Pragma("unroll") for (int m = 0; m < 4; ++m) _Pragma("unroll") for (int k = 0; k < 2; ++k) dst[m][k] = *(const PG8_LAS bf16x8*)(lds + PG8_SA(b, h) + aoff + m * 2048 + k * 1024); } while (0)
#define PG8_LDB(dst, b, h) do { _Pragma("unroll") for (int n = 0; n < 2; ++n) _Pragma("unroll") for (int k = 0; k < 2; ++k) dst[n][k] = *(const PG8_LAS bf16x8*)(lds + PG8_SB(b, h) + boff + n * 2048 + k * 1024); } while (0)
#define PG8_MMA(ai, bj, At, Bt) do { __builtin_amdgcn_s_setprio(1); _Pragma("unroll") for (int m = 0; m < 4; ++m) _Pragma("unroll") for (int n = 0; n < 2; ++n) _Pragma("unroll") for (int k = 0; k < 2; ++k) \
        acc[ai][bj][m][n] = __builtin_amdgcn_mfma_f32_16x16x32_bf16(Bt[n][k], At[m][k], acc[ai][bj][m][n], 0, 0, 0); __builtin_amdgcn_s_setprio(0); } while (0)
#define PG8_WAIT_V(n) asm volatile("s_waitcnt vmcnt(" #n ")" ::: "memory")
#define PG8_WAIT_L(n) asm volatile("s_waitcnt lgkmcnt(" #n ")" ::: "memory")
#define PG8_BAR __builtin_amdgcn_s_barrier()
#define PG8_SCHED __builtin_amdgcn_sched_barrier(0)
    Unit cur, nxt; int ui = 0;
    if (!S.next(0, cur)) return;
    f32x4 acc[2][2][4][2];
#pragma unroll
    for (int a = 0; a < 2; ++a)
#pragma unroll
        for (int b = 0; b < 2; ++b)
#pragma unroll
            for (int m = 0; m < 4; ++m)
#pragma unroll
                for (int n = 0; n < 2; ++n) acc[a][b][m][n] = (f32x4){0.f, 0.f, 0.f, 0.f};
    bf16x8 At[4][2], B0[2][2], B1[2][2];
    const char* cA = (const char*)g.A; const char* cB = (const char*)g.Bt + (size_t)cur.pn * tstep;
    S.a_ready(cur);
    if constexpr (SP2) {
        PG8_STAGE(PG8_SB(0, 0), cB, voffB); PG8_STAGE(PG8_SB(0, 1), cB + hstep, voffB); PG8_STAGE(PG8_SA(0, 0), cA, vA0); PG8_STAGE(PG8_SA(0, 1), cA, vA1);
        if (wr == 1) PG8_BAR;
        PG8_WAIT_V(2); PG8_BAR;
        PG8_STAGE(PG8_SB(1, 0), cB + kstep, voffB); PG8_STAGE(PG8_SA(1, 0), cA + kstep, vA0); PG8_STAGE(PG8_SB(1, 1), cB + hstep + kstep, voffB);
        PG8_WAIT_V(6); PG8_BAR;
    } else {
        PG8_STAGE(PG8_SB(0, 0), cB, voffB); PG8_STAGE(PG8_SA(0, 0), cA, vA0); PG8_STAGE(PG8_SB(0, 1), cB + hstep, voffB); PG8_STAGE(PG8_SA(0, 1), cA, vA1);
        if (wr == 1) PG8_BAR;
        PG8_WAIT_V(4); PG8_BAR;
        PG8_STAGE(PG8_SB(1, 0), cB + kstep, voffB); PG8_STAGE(PG8_SA(1, 0), cA + kstep, vA0); PG8_STAGE(PG8_SB(1, 1), cB + hstep + kstep, voffB);
        PG8_WAIT_V(6); PG8_BAR;
    }
    for (;;) {
        const bool has_next = S.next(ui + 1, nxt);
        if (has_next) {
#pragma unroll
            for (int i = 0; i < 2; ++i) { nvA0[i] = rowtab[(ui + 1) * 256 + RA[i]] + CA2[i]; nvA1[i] = rowtab[(ui + 1) * 256 + 128 + RA[i]] + CA2[i]; }
        }
        const char* nA = cA; const char* nB = has_next ? (const char*)g.Bt + (size_t)nxt.pn * tstep : cB;
        for (int t = 0; t < nt; t += 2) {
            const bool last = (t == nt - 2);
            unsigned sA0[2], sA1[2];
#pragma unroll
            for (int i = 0; i < 2; ++i) { sA0[i] = last ? nvA0[i] : vA0[i]; sA1[i] = last ? nvA1[i] : vA1[i]; }
            const char* a1 = cA + (size_t)(t + 1) * kstep;
            const char* a2 = last ? nA : cA + (size_t)(t + 2) * kstep; const char* b2 = last ? nB : cB + (size_t)(t + 2) * kstep;
            const char* a3 = a2 + kstep; const char* b3 = b2 + kstep;
            if (last && has_next) S.a_ready(nxt);
            if constexpr (SP2) {
            PG8_LDB(B0, 0, 0); PG8_LDB(B1, 0, 1); PG8_SCHED; PG8_LDA(At, 0, 0); PG8_STAGE(PG8_SA(1, 1), a1, vA1);
            PG8_WAIT_V(8); PG8_WAIT_L(0); PG8_BAR; PG8_MMA(0, 0, At, B0); PG8_MMA(0, 1, At, B1); PG8_BAR; PG8_SCHED;
            PG8_LDA(At, 0, 1); PG8_STAGE(PG8_SB(0, 0), b2, voffB); PG8_STAGE(PG8_SB(0, 1), b2 + hstep, voffB); PG8_STAGE(PG8_SA(0, 0), a2, sA0);
            PG8_WAIT_V(8); PG8_WAIT_L(0); PG8_BAR; PG8_MMA(1, 0, At, B0); PG8_MMA(1, 1, At, B1); PG8_BAR; PG8_SCHED;
            PG8_LDB(B0, 1, 0); PG8_LDB(B1, 1, 1); PG8_SCHED; PG8_LDA(At, 1, 0); PG8_STAGE(PG8_SA(0, 1), a2, sA1);
            PG8_WAIT_V(8); PG8_WAIT_L(0); PG8_BAR; PG8_MMA(0, 0, At, B0); PG8_MMA(0, 1, At, B1); PG8_BAR; PG8_SCHED;
            PG8_LDA(At, 1, 1); PG8_STAGE(PG8_SB(1, 0), b3, voffB); PG8_STAGE(PG8_SB(1, 1), b3 + hstep, voffB); PG8_STAGE(PG8_SA(1, 0), a3, sA0);
            PG8_WAIT_V(8); PG8_WAIT_L(0); PG8_BAR; PG8_MMA(1, 0, At, B0); PG8_MMA(1, 1, At, B1); PG8_BAR; PG8_SCHED;
            } else {
            PG8_LDB(B0, 0, 0); PG8_SCHED; PG8_LDA(At, 0, 0); PG8_STAGE(PG8_SA(1, 1), a1, vA1);
            PG8_WAIT_L(8); PG8_BAR; PG8_WAIT_L(0); PG8_MMA(0, 0, At, B0); PG8_BAR; PG8_SCHED;
            PG8_LDB(B1, 0, 1); PG8_STAGE(PG8_SB(0, 0), b2, voffB);
            PG8_BAR; PG8_WAIT_L(0); PG8_MMA(0, 1, At, B1); PG8_BAR;
            PG8_LDA(At, 0, 1); PG8_STAGE(PG8_SA(0, 0), a2, sA0);
            PG8_BAR; PG8_WAIT_L(0); PG8_MMA(1, 0, At, B0); PG8_BAR; PG8_SCHED;
            PG8_STAGE(PG8_SB(0, 1), b2 + hstep, voffB);
            PG8_WAIT_V(6); PG8_BAR; PG8_MMA(1, 1, At, B1); PG8_BAR;
            PG8_LDB(B0, 1, 0); PG8_SCHED; PG8_LDA(At, 1, 0); PG8_STAGE(PG8_SA(0, 1), a2, sA1);
            PG8_WAIT_L(8); PG8_BAR; PG8_WAIT_L(0); PG8_MMA(0, 0, At, B0); PG8_BAR; PG8_SCHED;
            PG8_LDB(B1, 1, 1); PG8_STAGE(PG8_SB(1, 0), b3, voffB);
            PG8_BAR; PG8_WAIT_L(0); PG8_MMA(0, 1, At, B1); PG8_BAR;
            PG8_LDA(At, 1, 1); PG8_STAGE(PG8_SA(1, 0), a3, sA0);
            PG8_BAR; PG8_WAIT_L(0); PG8_MMA(1, 0, At, B0); PG8_BAR; PG8_SCHED;
            PG8_STAGE(PG8_SB(1, 1), b3 + hstep, voffB);
            PG8_WAIT_V(6); PG8_BAR; PG8_MMA(1, 1, At, B1); PG8_BAR;
            }
        }
        if constexpr (ALIGN_EPI) { if (wr == 0) PG8_BAR; }
        if constexpr (!Epi::AFTER_DRAIN) { E(acc, cur, wr, wc, fr, fq); S.done(cur); }
        if (!has_next) break;
#pragma unroll
        for (int a = 0; a < 2; ++a)
#pragma unroll
            for (int b = 0; b < 2; ++b)
#pragma unroll
                for (int m = 0; m < 4; ++m)
#pragma unroll
                    for (int n = 0; n < 2; ++n) acc[a][b][m][n] = (f32x4){0.f, 0.f, 0.f, 0.f};
        cur = nxt; cA = nA; cB = nB; ++ui;
#pragma unroll
        for (int i = 0; i < 2; ++i) { vA0[i] = nvA0[i]; vA1[i] = nvA1[i]; }
        if constexpr (ALIGN_EPI) { if (wr == 1) PG8_BAR; }
    }
    PG8_WAIT_V(0);
    if constexpr (!ALIGN_EPI) { if (wr == 0) PG8_BAR; }
    PG8_BAR;
    if constexpr (Epi::AFTER_DRAIN) { E.fused(acc, cur, wr, wc, fr, fq, lds, wid, lane); S.done(cur); }
#undef PG8_SA
#undef PG8_SB
#undef PG8_STAGE
#undef PG8_LDA
#undef PG8_LDB
#undef PG8_MMA
#undef PG8_WAIT_V
#undef PG8_WAIT_L
#undef PG8_BAR
#undef PG8_SCHED
}

struct EpiBf16 {
    static constexpr bool PERM = true, AFTER_DRAIN = false;
    bf16_t* O; int ldc; int npn;
    __device__ __forceinline__ void operator()(const f32x4 (&acc)[2][2][4][2], const Unit& u, int wr, int wc, int fr, int fq) const {
        const int row0 = u.pm * BM + wr * 64 + fr, col0 = (u.pn % npn) * BM + wc * 32 + 8 * fq;
#pragma unroll
        for (int ai = 0; ai < 2; ++ai)
#pragma unroll
            for (int m = 0; m < 4; ++m) { bf16_t* rowp = O + (size_t)(row0 + ai * HALF + m * 16) * ldc + col0;
#pragma unroll
                for (int bj = 0; bj < 2; ++bj) { const f32x4 v0 = acc[ai][bj][m][0], v1 = acc[ai][bj][m][1];
                    u32x4 w; w.x = cvt_pk_bf16(v0[0], v0[1]); w.y = cvt_pk_bf16(v0[2], v0[3]); w.z = cvt_pk_bf16(v1[0], v1[1]); w.w = cvt_pk_bf16(v1[2], v1[3]);
                    *(u32x4*)(rowp + bj * HALF) = w; } }
    }
};
struct EpiKV {
    static constexpr bool PERM = true, AFTER_DRAIN = false;
    bf16_t* kmem; bf16_t* vmemT;
    __device__ __forceinline__ void operator()(const f32x4 (&acc)[2][2][4][2], const Unit& u, int wr, int wc, int fr, int fq) const {
        const int row0 = u.pm * BM + wr * 64 + fr, col0 = u.pn * BM + wc * 32 + 8 * fq;
#pragma unroll
        for (int ai = 0; ai < 2; ++ai)
#pragma unroll
            for (int m = 0; m < 4; ++m) { const int row = row0 + ai * HALF + m * 16;
#pragma unroll
                for (int bj = 0; bj < 2; ++bj) { const f32x4 v0 = acc[ai][bj][m][0], v1 = acc[ai][bj][m][1]; const int col = col0 + bj * HALF;
                    if (col < 512) { u32x4 w; w.x = cvt_pk_bf16(v0[0], v0[1]); w.y = cvt_pk_bf16(v0[2], v0[3]); w.z = cvt_pk_bf16(v1[0], v1[1]); w.w = cvt_pk_bf16(v1[2], v1[3]);
                        *(u32x4*)(kmem + (size_t)row * 512 + col) = w; }
                    else { const int c2 = col - 512, hx = c2 >> 7, d = c2 & 127, b = row >> 8, key = row & 255;
                        bf16_t* vp = vmemT + (((size_t)b * 4 + hx) * 128 + d) * 256 + key;
                        const unsigned w0 = cvt_pk_bf16(v0[0], v0[1]), w1 = cvt_pk_bf16(v0[2], v0[3]), w2 = cvt_pk_bf16(v1[0], v1[1]), w3 = cvt_pk_bf16(v1[2], v1[3]);
                        vp[0 * 256] = (bf16_t)(w0 & 0xffffu); vp[1 * 256] = (bf16_t)(w0 >> 16); vp[2 * 256] = (bf16_t)(w1 & 0xffffu); vp[3 * 256] = (bf16_t)(w1 >> 16);
                        vp[4 * 256] = (bf16_t)(w2 & 0xffffu); vp[5 * 256] = (bf16_t)(w2 >> 16); vp[6 * 256] = (bf16_t)(w3 & 0xffffu); vp[7 * 256] = (bf16_t)(w3 >> 16); } } }
    }
};
template <bool XF32, bool STATS> struct EpiResid {
    static constexpr bool PERM = true, AFTER_DRAIN = false;
    const void* xin; bf16_t* xb; float* ssq;
    __device__ __forceinline__ void operator()(const f32x4 (&acc)[2][2][4][2], const Unit& u, int wr, int wc, int fr, int fq) const {
        const int col0 = u.pn * BM + wc * 32 + 8 * fq;
#pragma unroll
        for (int ai = 0; ai < 2; ++ai) {
            const size_t rowb = (size_t)(u.pm * BM + ai * HALF + wr * 64 + fr);
            f32x4 pf[4][2][2]; u32x4 pb[4][2];
#pragma unroll
            for (int m = 0; m < 4; ++m)
#pragma unroll
                for (int bj = 0; bj < 2; ++bj) { const size_t off = (rowb + m * 16) * 1024 + col0 + bj * HALF;
                    if (XF32) { pf[m][bj][0] = *(const f32x4*)((const float*)xin + off); pf[m][bj][1] = *(const f32x4*)((const float*)xin + off + 4); }
                    else pb[m][bj] = *(const u32x4*)((const bf16_t*)xin + off); }
#pragma unroll
            for (int m = 0; m < 4; ++m) { const size_t row = rowb + m * 16;
                float q = 0.f;
#pragma unroll
                for (int bj = 0; bj < 2; ++bj) { const size_t off = row * 1024 + col0 + bj * HALF;
                    f32x4 b0, b1;
                    if (XF32) { b0 = pf[m][bj][0]; b1 = pf[m][bj][1]; }
                    else { const u32x4 t = pb[m][bj];
                        b0[0] = __uint_as_float(t.x << 16); b0[1] = __uint_as_float(t.x & 0xffff0000u); b0[2] = __uint_as_float(t.y << 16); b0[3] = __uint_as_float(t.y & 0xffff0000u);
                        b1[0] = __uint_as_float(t.z << 16); b1[1] = __uint_as_float(t.z & 0xffff0000u); b1[2] = __uint_as_float(t.w << 16); b1[3] = __uint_as_float(t.w & 0xffff0000u); }
                    const f32x4 o0 = b0 + acc[ai][bj][m][0], o1 = b1 + acc[ai][bj][m][1];
                    u32x4 w; w.x = cvt_pk_bf16(o0[0], o0[1]); w.y = cvt_pk_bf16(o0[2], o0[3]); w.z = cvt_pk_bf16(o1[0], o1[1]); w.w = cvt_pk_bf16(o1[2], o1[3]);
                    *(u32x4*)(xb + off) = w;
                    if (STATS) q += ((o0[0] * o0[0] + o0[1] * o0[1]) + (o0[2] * o0[2] + o0[3] * o0[3])) + ((o1[0] * o1[0] + o1[1] * o1[1]) + (o1[2] * o1[2] + o1[3] * o1[3])); }
                if (STATS) { q += __shfl_xor(q, 16); q += __shfl_xor(q, 32); if (fq == 0) ssq[row * 16 + u.pn * 4 + wc] = q; } }
            asm volatile("" ::: "memory"); }
    }
};
struct EpiQ {
    static constexpr bool PERM = true, AFTER_DRAIN = false;
    bf16_t* O; const float* ssq;
    __device__ __forceinline__ void operator()(const f32x4 (&acc)[2][2][4][2], const Unit& u, int wr, int wc, int fr, int fq) const {
        const int row0 = u.pm * BM + wr * 64 + fr, col0 = u.pn * BM + wc * 32 + 8 * fq;
#pragma unroll
        for (int ai = 0; ai < 2; ++ai)
#pragma unroll
            for (int m = 0; m < 4; ++m) { const size_t row = (size_t)(row0 + ai * HALF + m * 16);
                const f32x4* sp = (const f32x4*)(ssq + row * 16); const f32x4 s0 = sp[0], s1 = sp[1], s2 = sp[2], s3 = sp[3];
                const float s = ((s0[0] + s0[1]) + (s0[2] + s0[3])) + ((s1[0] + s1[1]) + (s1[2] + s1[3])) + ((s2[0] + s2[1]) + (s2[2] + s2[3])) + ((s3[0] + s3[1]) + (s3[2] + s3[3]));
                const float rs = 1.f / sqrtf(s * (1.f / 1024.f) + 1e-5f);
                bf16_t* rowp = O + row * 512 + col0;
#pragma unroll
                for (int bj = 0; bj < 2; ++bj) { const f32x4 v0 = acc[ai][bj][m][0] * rs, v1 = acc[ai][bj][m][1] * rs;
                    u32x4 w; w.x = cvt_pk_bf16(v0[0], v0[1]); w.y = cvt_pk_bf16(v0[2], v0[3]); w.z = cvt_pk_bf16(v1[0], v1[1]); w.w = cvt_pk_bf16(v1[2], v1[3]);
                    *(u32x4*)(rowp + bj * HALF) = w; } }
    }
};
struct EpiGU {
    static constexpr bool PERM = true, AFTER_DRAIN = false;
    bf16_t* hid; const PG8_LAS float* rstab; int G, c;
    __device__ __forceinline__ void operator()(const f32x4 (&acc)[2][2][4][2], const Unit& u, int wr, int wc, int fr, int fq) const {
        const int row0 = u.pm * BM + wr * 64 + fr, j0 = (u.pn & 1) * 128 + wc * 16 + 4 * fq;
        const int ui = (u.pm * 2 + (u.pn & 1) - c) / G;
#pragma unroll
        for (int ai = 0; ai < 2; ++ai)
#pragma unroll
            for (int m = 0; m < 4; ++m) { bf16_t* rowp = hid + (size_t)(row0 + ai * HALF + m * 16) * 256 + j0;
                const float rs = rstab[ui * 256 + ai * HALF + wr * 64 + m * 16 + fr];
#pragma unroll
                for (int bj = 0; bj < 2; ++bj) { const f32x4 v0 = acc[ai][bj][m][0] * rs, v1 = acc[ai][bj][m][1] * rs;
                    const float h0 = v0[0] * __builtin_amdgcn_rcpf(1.f + __expf(-v0[0])) * v0[1], h1 = v0[2] * __builtin_amdgcn_rcpf(1.f + __expf(-v0[2])) * v0[3];
                    const float h2 = v1[0] * __builtin_amdgcn_rcpf(1.f + __expf(-v1[0])) * v1[1], h3 = v1[2] * __builtin_amdgcn_rcpf(1.f + __expf(-v1[2])) * v1[3];
                    typedef unsigned u32x2v __attribute__((ext_vector_type(2))); u32x2v w; w.x = cvt_pk_bf16(h0, h1); w.y = cvt_pk_bf16(h2, h3);
                    *(u32x2v*)(rowp + bj * 64) = w; } }
    }
};
struct SubOrder {
    int nM, nN, nwg, span, c;
    __device__ void init(int M, int N, int span_, int c_) { nM = M / BM; nN = N / BM; nwg = nM * nN; span = span_; c = c_; }
    __device__ bool next(int i, Unit& u) const { if (c < 0 || c >= span) return false; const int L = i * span + c; if (L >= nwg) return false; u.pm = L / nN; u.pn = L % nN; return true; }
    __device__ __forceinline__ void a_ready(const Unit&) const {}
    __device__ __forceinline__ void done(const Unit&) const {}
};
struct MoeOrder {
    const PG8_LAS int* tile_e; int nrt, npn, G, c;
    __device__ bool next(int i, Unit& u) const { const int L = i * G + c; if (L >= nrt * npn) return false; const int rt = L / npn, pnl = L % npn; u.pm = rt; u.pn = tile_e[rt] * npn + pnl; return true; }
    __device__ __forceinline__ void a_ready(const Unit&) const {}
    __device__ __forceinline__ void done(const Unit&) const {}
};
}

#define LAS __attribute__((address_space(3)))
#define XB_TMO      128
#define XB_XCNT(j)  (256  + 64 * (j))
#define XB_XSUB(j)  (1280 + 64 * (j))
#define XB_XGEN(j)  (2304 + 64 * (j))
#define XB_TOP      3328
#define XB_TOPGEN   3392
#define XCD_BAR_WORDS 3456
#define XB_SPIN_CAP (1u << 18)

__device__ __forceinline__ unsigned xb_ld(unsigned* p)              { return __hip_atomic_load(p, __ATOMIC_RELAXED, __HIP_MEMORY_SCOPE_AGENT); }
__device__ __forceinline__ unsigned xb_add(unsigned* p, unsigned v) { return __hip_atomic_fetch_add(p, v, __ATOMIC_RELAXED, __HIP_MEMORY_SCOPE_AGENT); }
__device__ __forceinline__ unsigned xb_xcc_id() { return (unsigned)__builtin_amdgcn_s_getreg((3 << 11) | 20) & 0xFu; }
#define XB_SPIN(cond, bar) do { unsigned _sp = 0; while (cond) { __builtin_amdgcn_s_sleep(1); \
    if ((++_sp & 255u) == 0u) { if (xb_ld(&(bar)[XB_TMO])) break; if (_sp > XB_SPIN_CAP) { atomicAdd(&(bar)[XB_TMO], 1u); break; } } } } while (0)

struct XcdBarrier {
    unsigned* bar; unsigned x;
    volatile LAS unsigned* st;
};

__device__ __forceinline__ XcdBarrier xcd_barrier_post(unsigned* bar, volatile LAS unsigned* st) {
    XcdBarrier b; b.bar = bar; b.x = xb_xcc_id(); b.st = st;
    if (threadIdx.x == 0) (void)xb_add(&bar[XB_XCNT(b.x)], 1u);
    return b;
}
__device__ __forceinline__ void xcd_barrier_complete(unsigned* bar, unsigned x, unsigned& nloc, unsigned& nx) {
    const unsigned G = gridDim.x * gridDim.y * gridDim.z;
    unsigned sum, cnt, mine, sp = 0u;
    for (;;) {
        sum = 0u; cnt = 0u; mine = 0u;
#pragma unroll
        for (unsigned j = 0; j < 16; ++j) { const unsigned c = xb_ld(&bar[XB_XCNT(j)]); sum += c; cnt += (c > 0u) ? 1u : 0u; mine = (j == x) ? c : mine; }
        if (sum == G) break;
        __builtin_amdgcn_s_sleep(1);
        if ((++sp & 255u) == 0u) { if (xb_ld(&bar[XB_TMO])) break; if (sp > XB_SPIN_CAP) { atomicAdd(&bar[XB_TMO], 1u); break; } }
    }
    nloc = mine > 0u ? mine : 1u; nx = cnt > 0u ? cnt : 1u;
}

__device__ __forceinline__ void xcd_barrier(const XcdBarrier& b) {
    asm volatile("s_waitcnt vmcnt(0)" ::: "memory");
    __syncthreads();
    if (threadIdx.x == 0) {
        unsigned* bar = b.bar;
        __builtin_amdgcn_s_waitcnt(0);
        unsigned nloc = b.st[0], nx = b.st[1];
        if (nloc == 0u) { xcd_barrier_complete(bar, b.x, nloc, nx); b.st[0] = nloc; b.st[1] = nx; }
        const unsigned old = xb_add(&bar[XB_XSUB(b.x)], 1u);
        const unsigned gen = old / nloc;
        if (old + 1u == (gen + 1u) * nloc) {
            __builtin_amdgcn_fence(__ATOMIC_RELEASE, "agent");
            asm volatile("s_waitcnt vmcnt(0)" ::: "memory");
            const unsigned og = xb_add(&bar[XB_TOP], 1u);
            const unsigned tg = og / nx;
            if (og + 1u == (tg + 1u) * nx) xb_add(&bar[XB_TOPGEN], 1u);
            else XB_SPIN(xb_ld(&bar[XB_TOPGEN]) == tg, bar);
            __builtin_amdgcn_fence(__ATOMIC_ACQUIRE, "agent");
            xb_add(&bar[XB_XGEN(b.x)], 1u);
            asm volatile("s_waitcnt vmcnt(0)" ::: "memory");
        } else {
            XB_SPIN(xb_ld(&bar[XB_XGEN(b.x)]) == gen, bar);
            __builtin_amdgcn_fence(__ATOMIC_ACQUIRE, "agent");
            asm volatile("s_waitcnt vmcnt(0)" ::: "memory");
        }
    }
    __syncthreads();
}

__device__ __forceinline__ void gemm128(unsigned char* lds, const bf16_t* arow, const bf16_t* brow, int K, f32x16& acc0, f32x16& acc1) {
    const int tid = opaque_tid(), lane = tid & 63, w = tid >> 6;
    bf16_t* sA = (bf16_t*)lds;
    bf16_t* sB = sA + 128 * 72;
    const int srow = tid >> 2, skc = (tid & 3) * 16;
    const bf16_t* ap = arow + skc;
    const bf16_t* bp = brow + skc;
    const int wm = w >> 1, wn = w & 1, r = lane & 31, h = lane >> 5;
    acc0 = zero16(); acc1 = zero16();
    for (int k0 = 0; k0 < K; k0 += 64) {
        const u32x4 a0 = *(const u32x4*)(ap + k0), a1 = *(const u32x4*)(ap + k0 + 8);
        const u32x4 b0 = *(const u32x4*)(bp + k0), b1 = *(const u32x4*)(bp + k0 + 8);
        __syncthreads();
        *(u32x4*)(sA + srow * 72 + skc) = a0; *(u32x4*)(sA + srow * 72 + skc + 8) = a1;
        *(u32x4*)(sB + srow * 72 + skc) = b0; *(u32x4*)(sB + srow * 72 + skc + 8) = b1;
        __syncthreads();
#pragma unroll
        for (int kk = 0; kk < 64; kk += 16) {
            const bf16x8 a = *(const bf16x8*)(sA + (wm * 32 + r) * 72 + kk + 8 * h);
            const bf16x8 bA = *(const bf16x8*)(sB + (wn * 64 + r) * 72 + kk + 8 * h);
            const bf16x8 bB = *(const bf16x8*)(sB + (wn * 64 + 32 + r) * 72 + kk + 8 * h);
            acc0 = mfma32(a, bA, acc0); acc1 = mfma32(a, bB, acc1);
        }
    }
    __syncthreads();
}

__device__ __forceinline__ void p0_transpose64(const float* W, int ldw, int K, int nblk, const float* scale, bf16_t* WT, int row_off, int row_mul, float* scr, int item, int lane) {
    const int kb = item / nblk, nb = item % nblk, k0 = 64 * kb, n0 = 64 * nb;
    f32x4 v[16];
    const float* wp = W + (size_t)(k0 + (lane >> 4)) * ldw + n0 + 4 * (lane & 15);
#pragma unroll
    for (int i = 0; i < 16; ++i) v[i] = *(const f32x4*)(wp + (size_t)(4 * i) * ldw);
#pragma unroll
    for (int i = 0; i < 16; ++i) { const int kk = (lane >> 4) + 4 * i; const float sc = scale ? scale[k0 + kk] : 1.f; float* d = scr + kk * 65 + 4 * (lane & 15);
        d[0] = v[i].x * sc; d[1] = v[i].y * sc; d[2] = v[i].z * sc; d[3] = v[i].w * sc; }
    LDS_WAIT();
    const int c = lane & 7;
#pragma unroll
    for (int j = 0; j < 8; ++j) { const int n = (lane >> 3) + 8 * j; const float* sp = scr + (8 * c) * 65 + n;
        u32x4 o; o.x = pk2(sp[0 * 65], sp[1 * 65]); o.y = pk2(sp[2 * 65], sp[3 * 65]); o.z = pk2(sp[4 * 65], sp[5 * 65]); o.w = pk2(sp[6 * 65], sp[7 * 65]);
        *(u32x4*)(WT + (size_t)(row_off + (n0 + n) * row_mul) * K + k0 + 8 * c) = o; }
    LDS_WAIT();
}

__device__ __forceinline__ void phase0(const Params& p, unsigned char* lds) {
    const int tid = opaque_tid(), lane = tid & 63, w = tid >> 6;
    unsigned char* ws = p.ws;
    const int gw = blockIdx.x * NWAVES + w, NGW = gridDim.x * NWAVES;
    {
        bf16_t* WR = (bf16_t*)(ws + WS_WR);
        const float* w3 = p.in[19]; const float* wg = p.in[20]; const float* we = p.in[22];
        for (int i = blockIdx.x * NTHREADS + tid; i < 36 * 1024; i += gridDim.x * NTHREADS) {
            const int n = i >> 10, k = i & 1023;
            float v;
            if (n >= 32) v = wg[k * 4 + (n - 32)];
            else { const int hh = (n >> 2) & 1, ii = (n & 3) + 4 * (n >> 3), e = (2 * hh + (ii >> 3)) * 8 + (ii & 7); v = we[k * 32 + e]; }
            WR[i] = (bf16_t)f2bf(v * w3[k]);
        }
    }
    {
        float* scr = (float*)lds + w * (64 * 65);
        constexpr int I_IN = 16 * 36, I_OUT = 16 * 16, I_Q = 16 * 8, I_KV = 16 * 16, I_O = 8 * 16;
        constexpr int NITEMS = I_IN + I_OUT + I_Q + I_KV + I_O;
#pragma unroll 1
        for (int it = gw; it < NITEMS; it += NGW) {
            int r = it;
            if (r < I_IN) { p0_transpose64(p.in[4], LDWIN, 1024, 36, nullptr, (bf16_t*)(ws + WS_WIN), 0, 1, scr, r, lane); continue; } r -= I_IN;
            if (r < I_OUT) { p0_transpose64(p.in[13], 1024, 1024, 16, nullptr, (bf16_t*)(ws + WS_WOUT), 0, 1, scr, r, lane); continue; } r -= I_OUT;
            if (r < I_Q) { p0_transpose64(p.in[16], 512, 1024, 8, p.in[14], (bf16_t*)(ws + WS_WQ), 0, 1, scr, r, lane); continue; } r -= I_Q;
            if (r < I_KV) { p0_transpose64(p.in[17], 1024, 1024, 16, nullptr, (bf16_t*)(ws + WS_WKV), 0, 1, scr, r, lane); continue; } r -= I_KV;
            p0_transpose64(p.in[18], 1024, 512, 16, nullptr, (bf16_t*)(ws + WS_WO), 0, 1, scr, r, lane);
        }
    }
    __syncthreads();
    float* wdt = (float*)lds;
    {
        const float* win = p.in[4]; const float* w1 = p.in[3];
        for (int i = tid; i < 8192; i += NTHREADS) { const int k = i >> 3, n = i & 7; wdt[n * 1024 + k] = win[(size_t)k * LDWIN + 2304 + n] * w1[k]; }
    }
    __syncthreads();
    {
        const float* x = p.in[0]; const float* w1 = p.in[3];
        bf16_t* h1 = (bf16_t*)(ws + WS_H1); float* dtraw = (float*)(ws + WS_DTRAW);
        f32x4 wv[4];
#pragma unroll
        for (int j = 0; j < 4; ++j) wv[j] = *(const f32x4*)(w1 + 4 * lane + 256 * j);
        f32x4 nx[4];
        if (gw < NT) {
#pragma unroll
            for (int j = 0; j < 4; ++j) nx[j] = *((const f32x4*)(x + (size_t)gw * DM) + lane + 64 * j);
        }
#pragma unroll 1
        for (int m = gw; m < NT; m += NGW) {
            f32x4 v[4];
#pragma unroll
            for (int j = 0; j < 4; ++j) v[j] = nx[j];
            if (m + NGW < NT) {
#pragma unroll
                for (int j = 0; j < 4; ++j) nx[j] = *((const f32x4*)(x + (size_t)(m + NGW) * DM) + lane + 64 * j);
            }
            float a[16];
#pragma unroll
            for (int q = 0; q < 16; ++q) a[q] = 0.f;
#pragma unroll
            for (int j = 0; j < 4; ++j) a[0] += (v[j].x * v[j].x + v[j].y * v[j].y) + (v[j].z * v[j].z + v[j].w * v[j].w);
#pragma unroll
            for (int n = 0; n < 8; ++n)
#pragma unroll
                for (int j = 0; j < 4; ++j) { const f32x4 ww = *(const f32x4*)(wdt + n * 1024 + 4 * lane + 256 * j); a[1 + n] += (v[j].x * ww.x + v[j].y * ww.y) + (v[j].z * ww.z + v[j].w * ww.w); }
            float b8[8], b4[4], b2[2], b1;
            { const bool hi = (lane & 32) != 0;
#pragma unroll
              for (int q = 0; q < 8; ++q) { const float send = hi ? a[q] : a[q + 8], keep = hi ? a[q + 8] : a[q]; b8[q] = keep + __shfl_xor(send, 32); } }
            { const bool hi = (lane & 16) != 0;
#pragma unroll
              for (int q = 0; q < 4; ++q) { const float send = hi ? b8[q] : b8[q + 4], keep = hi ? b8[q + 4] : b8[q]; b4[q] = keep + __shfl_xor(send, 16); } }
            { const bool hi = (lane & 8) != 0;
#pragma unroll
              for (int q = 0; q < 2; ++q) { const float send = hi ? b4[q] : b4[q + 2], keep = hi ? b4[q + 2] : b4[q]; b2[q] = keep + __shfl_xor(send, 8); } }
            { const bool hi = (lane & 4) != 0; const float send = hi ? b2[0] : b2[1], keep = hi ? b2[1] : b2[0]; b1 = keep + __shfl_xor(send, 4); }
            b1 += __shfl_xor(b1, 2); b1 += __shfl_xor(b1, 1);
            const float rstd = 1.f / sqrtf(__shfl(b1, 0) * (1.f / DM) + EPS);
            const int slot = (lane >> 2) & 15;
            if ((lane & 3) == 0 && slot >= 1 && slot <= 8) dtraw[(size_t)m * 8 + (slot - 1)] = b1 * rstd;
            u32x2* o8 = (u32x2*)(h1 + (size_t)m * DM) + lane;
#pragma unroll
            for (int j = 0; j < 4; ++j) { u32x2 o; o.x = pk2(v[j].x * rstd * wv[j].x, v[j].y * rstd * wv[j].y); o.y = pk2(v[j].z * rstd * wv[j].z, v[j].w * rstd * wv[j].w); o8[64 * j] = o; }
        }
    }
    {
        const float* mem = p.in[1]; const float* wm = p.in[15];
        bf16_t* memh = (bf16_t*)(ws + WS_MEMH);
        f32x4 wv[4];
#pragma unroll
        for (int j = 0; j < 4; ++j) wv[j] = *(const f32x4*)(wm + 4 * lane + 256 * j);
        for (int m = gw; m < NMEM; m += NGW) {
            const f32x4* xr = (const f32x4*)(mem + (size_t)m * DM) + lane;
            f32x4 v[4]; float s = 0.f;
#pragma unroll
            for (int j = 0; j < 4; ++j) { v[j] = xr[64 * j]; s += (v[j].x * v[j].x + v[j].y * v[j].y) + (v[j].z * v[j].z + v[j].w * v[j].w); }
            const float rstd = 1.f / sqrtf(wave_sum(s) * (1.f / DM) + EPS);
            u32x2* o8 = (u32x2*)(memh + (size_t)m * DM) + lane;
#pragma unroll
            for (int j = 0; j < 4; ++j) { u32x2 o; o.x = pk2(v[j].x * rstd * wv[j].x, v[j].y * rstd * wv[j].y); o.y = pk2(v[j].z * rstd * wv[j].z, v[j].w * rstd * wv[j].w); o8[64 * j] = o; }
        }
    }
    __syncthreads();
}

__device__ __forceinline__ void expert_transposes(const Params& p, unsigned char* lds, int vw, int nvw) {
    const int lane = opaque_tid() & 63, w = (opaque_tid() >> 6);
    unsigned char* ws = p.ws;
    float* scr = (float*)lds + w * (64 * 65);
    constexpr int I_G = 32 * 16 * 4, I_D = 32 * 4 * 16;
#pragma unroll 1
    for (int it = vw; it < 2 * I_G + I_D; it += nvw) {
        int r = it;
        if (r < I_G) { const int e = r / 64, ri = r % 64; p0_transpose64(p.in[24] + (size_t)e * 1024 * 256, 256, 1024, 4, p.in[19], (bf16_t*)(ws + WS_WGU) + (size_t)e * 512 * 1024, 0, 2, scr, ri, lane); continue; } r -= I_G;
        if (r < I_G) { const int e = r / 64, ri = r % 64; p0_transpose64(p.in[25] + (size_t)e * 1024 * 256, 256, 1024, 4, p.in[19], (bf16_t*)(ws + WS_WGU) + (size_t)e * 512 * 1024, 1, 2, scr, ri, lane); continue; } r -= I_G;
        { const int e = r / 64, ri = r % 64; p0_transpose64(p.in[26] + (size_t)e * 256 * 1024, 1024, 256, 16, nullptr, (bf16_t*)(ws + WS_WD) + (size_t)e * 1024 * 256, 0, 1, scr, ri, lane); }
    }
}

#define LDS3(p) ((__attribute__((address_space(3))) unsigned char*)(p))
__device__ __forceinline__ void phase1(const Params& p, unsigned char* lds) {
    unsigned char* ws = p.ws;
#ifdef PROBE_PHASE
    _Pragma("unroll 1") for (int rep = 0; rep < ((PROBE_PHASE == 101) ? 2 : 1); ++rep)
#endif
    {
        pg8::Gemm g{(const bf16_t*)(ws + WS_H1), (const bf16_t*)(ws + WS_WIN), NT, NPROJ, DM};
        pg8::StaticOrder S; S.init(NT, NPROJ, (int)gridDim.x, (int)blockIdx.x);
        pg8::EpiBf16 E{(bf16_t*)(ws + WS_PROJ), NPROJ, NPROJ / 256};
        pg8::gemm_phase<pg8::EpiBf16, pg8::StaticOrder, true, true>(LDS3(lds), g, S, E);
    }
    {
        pg8::Gemm g{(const bf16_t*)(ws + WS_MEMH), (const bf16_t*)(ws + WS_WKV), NMEM, 1024, DM};
        pg8::SubOrder S; S.init(NMEM, 1024, 128, (int)blockIdx.x - 128);
        pg8::EpiKV E{(bf16_t*)(ws + WS_KMEM), (bf16_t*)(ws + WS_VMEMT)};
        pg8::gemm_phase<pg8::EpiKV, pg8::SubOrder, true, true>(LDS3(lds), g, S, E);
    }
    {
        const int w = opaque_tid() >> 6;
        if (gridDim.x == 256) { if (blockIdx.x >= 160) expert_transposes(p, lds, ((int)blockIdx.x - 160) * NWAVES + w, 96 * NWAVES); }
        else expert_transposes(p, lds, (int)blockIdx.x * NWAVES + w, (int)gridDim.x * NWAVES);
    }
}

__device__ __forceinline__ float bfel(const u32x4& v, int ci) { const unsigned wv = (ci >> 1) == 0 ? v.x : (ci >> 1) == 1 ? v.y : (ci >> 1) == 2 ? v.z : v.w; return (ci & 1) ? bfhi(wv) : bflo(wv); }
template <bool TRANS>
__device__ __forceinline__ void conv8x8(const Params& p, int b, int c, int l0, int ch0, const float (&f)[8], u32x4 (&res)[8]) {
    const bf16_t* proj = (const bf16_t*)(p.ws + WS_PROJ);
    const float* cw = p.in[6]; const float* cb = p.in[7];
    float wgt[4][8], bias[8];
#pragma unroll
    for (int j = 0; j < 4; ++j) { const f32x4 a = *(const f32x4*)(cw + j * 1024 + ch0), b2 = *(const f32x4*)(cw + j * 1024 + ch0 + 4);
        wgt[j][0] = a.x; wgt[j][1] = a.y; wgt[j][2] = a.z; wgt[j][3] = a.w; wgt[j][4] = b2.x; wgt[j][5] = b2.y; wgt[j][6] = b2.z; wgt[j][7] = b2.w; }
    { const f32x4 a = *(const f32x4*)(cb + ch0), b2 = *(const f32x4*)(cb + ch0 + 4); bias[0] = a.x; bias[1] = a.y; bias[2] = a.z; bias[3] = a.w; bias[4] = b2.x; bias[5] = b2.y; bias[6] = b2.z; bias[7] = b2.w; }
    u32x4 in[11];
    const int t0 = c * 128 + l0 - 3;
    const bf16_t* rp = proj + ((long)(b * SEQ) + t0) * NPROJ + C_X + ch0;
    asm volatile("" : "+v"(rp));
#pragma unroll
    for (int i = 0; i < 11; ++i) {
        const int t = t0 + i;
        in[i] = (u32x4){0u, 0u, 0u, 0u};
        if (t >= 0) in[i] = *(const u32x4*)(rp + (size_t)i * NPROJ);
    }
    if (TRANS) {
#pragma unroll
        for (int ci = 0; ci < 8; ++ci) {
            float o[8];
#pragma unroll
            for (int li = 0; li < 8; ++li) { float a = bias[ci];
#pragma unroll
                for (int j = 0; j < 4; ++j) a += wgt[j][ci] * bfel(in[li + j], ci);
                o[li] = siluf(a) * f[li]; }
            res[ci] = (u32x4){pk2(o[0], o[1]), pk2(o[2], o[3]), pk2(o[4], o[5]), pk2(o[6], o[7])};
        }
    } else {
#pragma unroll
        for (int li = 0; li < 8; ++li) {
            float o[8];
#pragma unroll
            for (int ci = 0; ci < 8; ++ci) { float a = bias[ci];
#pragma unroll
                for (int j = 0; j < 4; ++j) a += wgt[j][ci] * bfel(in[li + j], ci);
                o[ci] = siluf(a) * f[li]; }
            res[li] = (u32x4){pk2(o[0], o[1]), pk2(o[2], o[3]), pk2(o[4], o[5]), pk2(o[6], o[7])};
        }
    }
}

__device__ __forceinline__ void conv2_load(const Params& p, int b, int c, int l0, int ch0, unsigned (&in)[11]) {
    const bf16_t* proj = (const bf16_t*)(p.ws + WS_PROJ);
    const int t0 = c * 128 + l0 - 3;
    const bf16_t* rp = proj + ((long)(b * SEQ) + t0) * NPROJ + C_X + ch0;
    asm volatile("" : "+v"(rp));
#pragma unroll
    for (int i = 0; i < 11; ++i) { const int t = t0 + i; in[i] = 0u; if (t >= 0) in[i] = *(const unsigned*)(rp + (size_t)i * NPROJ); }
}
__device__ __forceinline__ void conv2_math(const Params& p, int ch0, const unsigned (&in)[11], u32x4 (&res)[2]) {
    const float* cw = p.in[6]; const float* cb = p.in[7];
    float wgt[4][2], bias[2];
#pragma unroll
    for (int j = 0; j < 4; ++j) { wgt[j][0] = cw[j * 1024 + ch0]; wgt[j][1] = cw[j * 1024 + ch0 + 1]; }
    bias[0] = cb[ch0]; bias[1] = cb[ch0 + 1];
#pragma unroll
    for (int ci = 0; ci < 2; ++ci) {
        float o[8];
#pragma unroll
        for (int li = 0; li < 8; ++li) { float a = bias[ci];
#pragma unroll
            for (int j = 0; j < 4; ++j) a += wgt[j][ci] * (ci ? bfhi(in[li + j]) : bflo(in[li + j]));
            o[li] = siluf(a); }
        res[ci] = (u32x4){pk2(o[0], o[1]), pk2(o[2], o[3]), pk2(o[4], o[5]), pk2(o[6], o[7])};
    }
}

__device__ __forceinline__ void ssd_dt_cum(const Params& p, int b, int c, float* dts, float* cums) {
    const int tid = opaque_tid(), lane = tid & 63, w = tid >> 6;
    const float* dtraw = (const float*)(p.ws + WS_DTRAW);
    const float bias = p.in[8][w], a = -__expf(p.in[9][w]);
    const size_t row0 = (size_t)b * SEQ + c * 128;
    float x0 = dtraw[(row0 + 2 * lane) * 8 + w] + bias, x1 = dtraw[(row0 + 2 * lane + 1) * 8 + w] + bias;
    const float d0 = fmaxf(x0, 0.f) + log1pf(__expf(-fabsf(x0))), d1 = fmaxf(x1, 0.f) + log1pf(__expf(-fabsf(x1)));
    const float a0 = d0 * a, a1 = d1 * a;
    float s = a0 + a1;
#pragma unroll
    for (int o = 1; o < 64; o <<= 1) { const float t = __shfl_up(s, o); if (lane >= o) s += t; }
    dts[w * 128 + 2 * lane] = d0; dts[w * 128 + 2 * lane + 1] = d1;
    cums[w * 128 + 2 * lane] = s - a1; cums[w * 128 + 2 * lane + 1] = s;
}

__device__ __forceinline__ void attn_unit(const Params& p, const bf16_t* sK, const bf16_t* sV, const float* cs, const float* sn, float* ssq, int b, int blk, int hq, int rg, int lane, u32x2 (&oh)[8]) {
    const int r = lane & 31, h = lane >> 5;
    const bf16_t* proj = (const bf16_t*)(p.ws + WS_PROJ);
    const int tband0 = blk * 128 - 128;
    const bf16_t* qp = proj + (size_t)(b * SEQ + blk * 128 + rg * 32 + r) * NPROJ + hq * 64 + 8 * h;
    u32x4 qv[4];
#pragma unroll
    for (int kk = 0; kk < 4; ++kk) qv[kk] = *(const u32x4*)(qp + kk * 16);
    {
        u32x4 ot; ot.x = __shfl_xor(qv[0].x, 32); ot.y = __shfl_xor(qv[0].y, 32); ot.z = __shfl_xor(qv[0].z, 32); ot.w = __shfl_xor(qv[0].w, 32);
        const float* cp = cs + (128 + rg * 32 + r) * 8; const float* sp = sn + (128 + rg * 32 + r) * 8;
        float o[8];
#pragma unroll
        for (int f = 0; f < 8; ++f) {
            const float mine = bfel(qv[0], f), oth = bfel(ot, f), c = cp[f], sv = sp[f];
            o[f] = h ? (mine * c + oth * sv) : (mine * c - oth * sv);
        }
        qv[0] = (u32x4){pk2(o[0], o[1]), pk2(o[2], o[3]), pk2(o[4], o[5]), pk2(o[6], o[7])};
    }
    f32x16 S[5];
#pragma unroll
    for (int jt = 0; jt < 5; ++jt) S[jt] = zero16();
    const bf16_t* kp = sK + (rg * 32 + r) * 72 + 8 * h;
#pragma unroll
    for (int kk = 0; kk < 4; ++kk) {
        const bf16x8 qf = __builtin_bit_cast(bf16x8, qv[kk]);
#pragma unroll
        for (int jt = 0; jt < 5; ++jt) { const bf16x8 a = *(const bf16x8*)(kp + jt * (32 * 72) + kk * 16); S[jt] = mfma32(a, qf, S[jt]); }
    }
    const float sink = p.in[5][hq] * 8.f;
    float m = sink;
    const bool noprev = (blk == 0);
#pragma unroll
    for (int jt = 0; jt < 5; ++jt)
#pragma unroll
        for (int i = 0; i < 16; ++i) {
            const int cr = (i & 3) + 8 * (i >> 2) + 4 * h;
            bool ok = true;
            if (jt == 0) ok = cr > r;
            if (jt == 4) ok = cr <= r;
            if (noprev && (rg + jt) < 4) ok = false;
            const float v = ok ? S[jt][i] : -INFINITY; S[jt][i] = v; m = fmaxf(m, v);
        }
    m = fmaxf(m, __shfl_xor(m, 32));
    const float sc = 0.125f * 1.4426950408889634f;
    float sum = 0.f;
    bf16x8 P[10];
#pragma unroll
    for (int jt = 0; jt < 5; ++jt) {
        float e[16];
#pragma unroll
        for (int i = 0; i < 16; ++i) { e[i] = __builtin_amdgcn_exp2f((S[jt][i] - m) * sc); sum += e[i]; }
        P[2 * jt] = pack8(e[0], e[1], e[2], e[3], e[4], e[5], e[6], e[7]);
        P[2 * jt + 1] = pack8(e[8], e[9], e[10], e[11], e[12], e[13], e[14], e[15]);
    }
    sum += __shfl_xor(sum, 32);
    sum += __builtin_amdgcn_exp2f((sink - m) * sc);
    const float inv = 1.f / sum;
    f32x16 O0 = zero16(), O1 = zero16();
    const bf16_t* vp0 = sV + r * 260 + rg * 32 + 4 * h;
#pragma unroll
    for (int ts = 0; ts < 10; ++ts) {
        const bf16_t* vp = vp0 + 16 * ts;
        const u32x2 lo0 = *(const u32x2*)vp, hi0 = *(const u32x2*)(vp + 8);
        const u32x2 lo1 = *(const u32x2*)(vp + 32 * 260), hi1 = *(const u32x2*)(vp + 32 * 260 + 8);
        O0 = mfma32(__builtin_bit_cast(bf16x8, (u32x4){lo0.x, lo0.y, hi0.x, hi0.y}), P[ts], O0);
        O1 = mfma32(__builtin_bit_cast(bf16x8, (u32x4){lo1.x, lo1.y, hi1.x, hi1.y}), P[ts], O1);
    }
    float q = 0.f;
#pragma unroll
    for (int g = 0; g < 4; ++g) {
        const unsigned a0 = pk2(O0[4 * g] * inv, O0[4 * g + 1] * inv), a1 = pk2(O0[4 * g + 2] * inv, O0[4 * g + 3] * inv);
        const unsigned b0 = pk2(O1[4 * g] * inv, O1[4 * g + 1] * inv), b1 = pk2(O1[4 * g + 2] * inv, O1[4 * g + 3] * inv);
        oh[g] = (u32x2){a0, a1}; oh[4 + g] = (u32x2){b0, b1};
        q += (bflo(a0) * bflo(a0) + bfhi(a0) * bfhi(a0)) + (bflo(a1) * bflo(a1) + bfhi(a1) * bfhi(a1)) + (bflo(b0) * bflo(b0) + bfhi(b0) * bfhi(b0)) + (bflo(b1) * bflo(b1) + bfhi(b1) * bfhi(b1));
    }
    q += __shfl_xor(q, 32);
    if (h == 0) ssq[(rg * 32 + r) * 8 + hq] = q;
}

__device__ __forceinline__ void phase2_attn(const Params& p, unsigned char* lds, int b, int blk) {
    const int tid = opaque_tid(), lane = tid & 63, w = tid >> 6, r = lane & 31, h = lane >> 5;
    const bf16_t* proj = (const bf16_t*)(p.ws + WS_PROJ);
    const int* positions = (const int*)p.in[2];
    float* cs = (float*)lds;
    float* sn = cs + 2048;
    float* ssq = sn + 2048;
    bf16_t* sK = (bf16_t*)(lds + 20480);
    bf16_t* sV = sK + 256 * 72;
    const int tband0 = blk * 128 - 128;
    for (int i = tid; i < 2048; i += NTHREADS) {
        const int kb = i >> 3, f = i & 7, t = tband0 + kb;
        float c = 1.f, sv = 0.f;
        if (t >= 0) { const float ang = (float)positions[b * SEQ + t] * p.inv_freq[f]; const double rev = (double)ang * 0.15915494309189535; const float fr = (float)(rev - floor(rev));
            c = __builtin_amdgcn_cosf(fr); sv = __builtin_amdgcn_sinf(fr); }
        cs[i] = c; sn[i] = sv;
    }
    u32x2 oh[4][8];
#pragma unroll
    for (int g = 0; g < 2; ++g) {
        __syncthreads();
        {
            const int key = tid >> 1, half = tid & 1, t = tband0 + key;
            u32x4 kv[4];
#pragma unroll
            for (int q = 0; q < 4; ++q) kv[q] = (u32x4){0u, 0u, 0u, 0u};
            if (t >= 0) { const bf16_t* kp = proj + (size_t)(b * SEQ + t) * NPROJ + C_K + g * 64 + half * 32;
#pragma unroll
                for (int q = 0; q < 4; ++q) kv[q] = *(const u32x4*)(kp + 8 * q); }
            if (half == 0) {
                float o1[8], o2[8];
#pragma unroll
                for (int f = 0; f < 8; ++f) { const float x1 = bfel(kv[0], f), x2 = bfel(kv[1], f), c = cs[key * 8 + f], sv = sn[key * 8 + f]; o1[f] = x1 * c - x2 * sv; o2[f] = x2 * c + x1 * sv; }
                kv[0] = (u32x4){pk2(o1[0], o1[1]), pk2(o1[2], o1[3]), pk2(o1[4], o1[5]), pk2(o1[6], o1[7])};
                kv[1] = (u32x4){pk2(o2[0], o2[1]), pk2(o2[2], o2[3]), pk2(o2[4], o2[5]), pk2(o2[6], o2[7])};
            }
#pragma unroll
            for (int q = 0; q < 4; ++q) *(u32x4*)(sK + key * 72 + half * 32 + 8 * q) = kv[q];
        }
        {
            const int kg = tid >> 3, dc = tid & 7;
            u32x4 v[4];
#pragma unroll
            for (int i = 0; i < 4; ++i) { const int t = tband0 + 4 * kg + i; v[i] = (u32x4){0u, 0u, 0u, 0u};
                if (t >= 0) v[i] = *(const u32x4*)(proj + (size_t)(b * SEQ + t) * NPROJ + C_V + g * 64 + dc * 8); }
            bf16_t* vd = sV + (dc * 8) * 260 + 4 * kg;
#define VT_ROW(j, W) { const unsigned e0 = ((j) & 1) ? (v[0].W >> 16) : (v[0].W & 0xffffu), e1 = ((j) & 1) ? (v[1].W >> 16) : (v[1].W & 0xffffu), e2 = ((j) & 1) ? (v[2].W >> 16) : (v[2].W & 0xffffu), e3 = ((j) & 1) ? (v[3].W >> 16) : (v[3].W & 0xffffu); \
                *(u32x2*)(vd + (j) * 260) = (u32x2){e0 | (e1 << 16), e2 | (e3 << 16)}; }
            VT_ROW(0, x) VT_ROW(1, x) VT_ROW(2, y) VT_ROW(3, y) VT_ROW(4, z) VT_ROW(5, z) VT_ROW(6, w) VT_ROW(7, w)
#undef VT_ROW
        }
        __syncthreads();
#pragma unroll
        for (int uu = 0; uu < 2; ++uu) {
            const int u = w + 8 * uu;
            attn_unit(p, sK, sV, cs, sn, ssq, b, blk, g * 4 + (u >> 2), u & 3, lane, oh[g * 2 + uu]);
            __builtin_amdgcn_sched_barrier(0);
        }
    }
    __syncthreads();
    {
        bf16_t* A2 = (bf16_t*)(p.ws + WS_A2);
        const float* wa = p.in[11];
#pragma unroll
        for (int k = 0; k < 4; ++k) {
            const int u = w + 8 * (k & 1), hq = (k >> 1) * 4 + (u >> 2), rg = u & 3, ql = rg * 32 + r;
            const f32x4 s0 = *(const f32x4*)(ssq + ql * 8), s1 = *(const f32x4*)(ssq + ql * 8 + 4);
            const float rstd = 1.f / sqrtf((((s0.x + s0.y) + (s0.z + s0.w)) + ((s1.x + s1.y) + (s1.z + s1.w))) * (1.f / 512.f) + EPS);
            bf16_t* op = A2 + (size_t)(b * SEQ + blk * 128 + ql) * 1024 + hq * 64 + 4 * h;
#pragma unroll
            for (int j = 0; j < 8; ++j) {
                const int d0 = 32 * (j >> 2) + 8 * (j & 3);
                const f32x4 wv = *(const f32x4*)(wa + hq * 64 + d0 + 4 * h);
                const u32x2 t = oh[k][j];
                u32x2 o; o.x = pk2(bflo(t.x) * rstd * wv.x, bfhi(t.x) * rstd * wv.y); o.y = pk2(bflo(t.y) * rstd * wv.z, bfhi(t.y) * rstd * wv.w);
                *(u32x2*)(op + d0) = o;
            }
        }
    }
    __syncthreads();
}

__device__ __forceinline__ void phase2_states(const Params& p, unsigned char* lds, int b, int c) {
    const int tid = opaque_tid(), lane = tid & 63, w = tid >> 6, r = lane & 31, h = lane >> 5;
    float* dts = (float*)lds;
    float* cums = dts + 1024;
    bf16_t* sBT = (bf16_t*)(lds + 8192);
    bf16_t* sXT = sBT + 128 * 136;
    ssd_dt_cum(p, b, c, dts, cums);
    __syncthreads();
    bf16_t* states = (bf16_t*)(p.ws + WS_START);
    if (tid < 8) ((float*)(p.ws + WS_CDEC))[(b * NCH + c) * 8 + tid] = __expf(cums[tid * 128 + 127]);
#pragma unroll 1
    for (int g = 0; g < 2; ++g) {
        if (tid < 256) {
            const int cg8 = tid & 15, lr = tid >> 4;
            const float one[8] = {1.f, 1.f, 1.f, 1.f, 1.f, 1.f, 1.f, 1.f};
            u32x4 res[8];
            conv8x8<true>(p, b, c, lr * 8, 512 + g * 128 + cg8 * 8, one, res);
#pragma unroll
            for (int ci = 0; ci < 8; ++ci) *(u32x4*)(sBT + (cg8 * 8 + ci) * 136 + lr * 8) = res[ci];
        }
        {
            const int cg8 = tid & 31, lr = tid >> 5, hh = cg8 >> 3, hd = g * 4 + hh;
            float f[8];
            const float cl = cums[hd * 128 + 127];
#pragma unroll
            for (int li = 0; li < 8; ++li) f[li] = dts[hd * 128 + lr * 8 + li] * __expf(cl - cums[hd * 128 + lr * 8 + li]);
            u32x4 res[8];
            conv8x8<true>(p, b, c, lr * 8, g * 256 + cg8 * 8, f, res);
#pragma unroll
            for (int ci = 0; ci < 8; ++ci) *(u32x4*)(sXT + (cg8 * 8 + ci) * 136 + lr * 8) = res[ci];
        }
        __syncthreads();
        {
            f32x16 acc[4];
#pragma unroll
            for (int j = 0; j < 4; ++j) acc[j] = zero16();
#pragma unroll
            for (int kk = 0; kk < 128; kk += 16) {
                const bf16x8 a = *(const bf16x8*)(sXT + (w * 32 + r) * 136 + kk + 8 * h);
#pragma unroll
                for (int j = 0; j < 4; ++j) { const bf16x8 bb = *(const bf16x8*)(sBT + (j * 32 + r) * 136 + kk + 8 * h); acc[j] = mfma32(a, bb, acc[j]); }
            }
            const int hd = g * 4 + (w >> 1), p0 = (w & 1) * 32;
            bf16_t* sp = states + ((size_t)((b * NCH + c) * 8 + hd) * 64) * 128;
#pragma unroll
            for (int j = 0; j < 4; ++j)
#pragma unroll
                for (int i = 0; i < 16; ++i) sp[(size_t)(p0 + crow(i, h)) * 128 + j * 32 + r] = (bf16_t)f2bf(acc[j][i]);
        }
        __syncthreads();
    }
}

__device__ __forceinline__ void phase3(const Params& p) {
    const float* cdec = (const float*)(p.ws + WS_CDEC);
    bf16_t* start = (bf16_t*)(p.ws + WS_START);
    const int tid3 = opaque_tid();
#pragma unroll 1
    for (int u = blockIdx.x * NTHREADS + tid3; u < 131072; u += gridDim.x * NTHREADS) {
        const int n4 = u & 31, pp = (u >> 5) & 63, hd = (u >> 11) & 7, b = u >> 14;
        bf16_t* base = start + ((size_t)((b * NCH) * 8 + hd) * 64 + pp) * 128 + n4 * 4;
        constexpr size_t CSTRIDE = (size_t)8 * 64 * 128;
        f32x4 s = (f32x4){0.f, 0.f, 0.f, 0.f};
#pragma unroll 1
        for (int c0 = 0; c0 < NCH; c0 += 16) {
            bf16_t* bp = base + c0 * CSTRIDE; const float* dp = cdec + (b * NCH + c0) * 8 + hd;
            asm volatile("" : "+v"(bp));
            u32x2 t[16]; float d[16];
#pragma unroll
            for (int c = 0; c < 16; ++c) { t[c] = *(const u32x2*)(bp + c * CSTRIDE); d[c] = dp[c * 8]; }
#pragma unroll
            for (int c = 0; c < 16; ++c) {
                u32x2 o; o.x = pk2(s.x, s.y); o.y = pk2(s.z, s.w);
                *(u32x2*)(bp + c * CSTRIDE) = o;
                const f32x4 st = (f32x4){bflo(t[c].x), bfhi(t[c].x), bflo(t[c].y), bfhi(t[c].y)};
                s = s * d[c] + st;
            }
        }
    }
}

__device__ __forceinline__ void phase4(const Params& p, unsigned char* lds, int b, int c) {
    const int tid = opaque_tid(), lane = tid & 63, w = tid >> 6, r = lane & 31, h = lane >> 5;
    float* dts = (float*)lds;
    float* cums = dts + 1024;
    float* gsq = cums + 1024;
    bf16_t* sC = (bf16_t*)(lds + 12288);
    bf16_t* sB = sC + 128 * 136;
    bf16_t* sM = sB + 128 * 136;
    bf16_t* sXT = sM + 128 * 136;
    const bf16_t* proj = (const bf16_t*)(p.ws + WS_PROJ);
    const bf16_t* start = (const bf16_t*)(p.ws + WS_START);
    bf16_t* A2 = (bf16_t*)(p.ws + WS_A2);
    ssd_dt_cum(p, b, c, dts, cums);
    __syncthreads();
    const size_t row0 = (size_t)b * SEQ + c * 128;
#pragma unroll 1
    for (int g = 0; g < 2; ++g) {
        {
            const int which = tid >> 8, cg8 = tid & 15, lr = (tid >> 4) & 15;
            const float one[8] = {1.f, 1.f, 1.f, 1.f, 1.f, 1.f, 1.f, 1.f};
            u32x4 res[8];
            conv8x8<false>(p, b, c, lr * 8, (which ? 768 : 512) + g * 128 + cg8 * 8, one, res);
            bf16_t* dst = which ? sC : sB;
#pragma unroll
            for (int li = 0; li < 8; ++li) *(u32x4*)(dst + (lr * 8 + li) * 136 + cg8 * 8) = res[li];
        }
        __syncthreads();
        f32x16 cb0 = zero16(), cb1 = zero16();
        const int lt = w >> 1, st0 = 2 * (w & 1);
#pragma unroll 2
        for (int kk = 0; kk < 128; kk += 16) {
            const bf16x8 a = *(const bf16x8*)(sC + (lt * 32 + r) * 136 + kk + 8 * h);
            const bf16x8 b0 = *(const bf16x8*)(sB + (st0 * 32 + r) * 136 + kk + 8 * h);
            const bf16x8 b1 = *(const bf16x8*)(sB + ((st0 + 1) * 32 + r) * 136 + kk + 8 * h);
            cb0 = mfma32(a, b0, cb0); cb1 = mfma32(a, b1, cb1);
        }
        __syncthreads();
        bf16_t* sS = sB;
#pragma unroll 1
        for (int hh = 0; hh < 4; ++hh) {
            const int hd = g * 4 + hh;
            const int lt2 = w >> 1, pt = w & 1;
            const int lme = lt2 * 32 + r;
            u32x4 stv[2]; unsigned xin[11]; u32x2 zr[4];
            const int cp = tid & 31, lr = tid >> 5;
            {
                const bf16_t* stb = start + ((size_t)((b * NCH + c) * 8 + hd) * 64) * 128;
#pragma unroll
                for (int i = 0; i < 2; ++i) { const int id = tid + 512 * i; stv[i] = *(const u32x4*)(stb + (id >> 4) * 128 + (id & 15) * 8); }
                conv2_load(p, b, c, lr * 8, hd * 64 + cp * 2, xin);
                const bf16_t* zp = proj + (row0 + lme) * NPROJ + C_Z + hd * 64 + 32 * pt + 4 * h;
#pragma unroll
                for (int g4 = 0; g4 < 4; ++g4) zr[g4] = *(const u32x2*)(zp + 8 * g4);
            }
#pragma unroll
            for (int q = 0; q < 2; ++q) {
                const int st = st0 + q;
                if (st <= lt) {
                    const int sme = st * 32 + r; const float cs_ = cums[hd * 128 + sme], ds_ = dts[hd * 128 + sme];
#pragma unroll
                    for (int i = 0; i < 16; ++i) {
                        const int l = lt * 32 + crow(i, h);
                        const float cbv = q ? cb1[i] : cb0[i];
                        const float v = (sme <= l) ? cbv * __expf(cums[hd * 128 + l] - cs_) * ds_ : 0.f;
                        sM[l * 136 + sme] = (bf16_t)f2bf(v);
                    }
                }
            }
            {
                u32x4 res[2];
                conv2_math(p, hd * 64 + cp * 2, xin, res);
                *(u32x4*)(sXT + (cp * 2) * 136 + lr * 8) = res[0];
                *(u32x4*)(sXT + (cp * 2 + 1) * 136 + lr * 8) = res[1];
            }
#pragma unroll
            for (int i = 0; i < 2; ++i) { const int id = tid + 512 * i; *(u32x4*)(sS + (id >> 4) * 136 + (id & 15) * 8) = stv[i]; }
            __syncthreads();
            {
                f32x16 yd = zero16(), yo = zero16();
                const int kend = 32 * (lt2 + 1);
#pragma unroll 2
                for (int kk = 0; kk < kend; kk += 16) {
                    const bf16x8 a = *(const bf16x8*)(sXT + (pt * 32 + r) * 136 + kk + 8 * h);
                    const bf16x8 bb = *(const bf16x8*)(sM + (lt2 * 32 + r) * 136 + kk + 8 * h);
                    yd = mfma32(a, bb, yd);
                }
#pragma unroll 2
                for (int kk = 0; kk < 128; kk += 16) {
                    const bf16x8 a = *(const bf16x8*)(sS + (pt * 32 + r) * 136 + kk + 8 * h);
                    const bf16x8 bb = *(const bf16x8*)(sC + (lt2 * 32 + r) * 136 + kk + 8 * h);
                    yo = mfma32(a, bb, yo);
                }
                const float dsk = p.in[10][hd];
                const float el = __expf(cums[hd * 128 + lme]);
                bf16_t* gp = A2 + (row0 + lme) * 1024 + 512 + hd * 64 + 32 * pt + 4 * h;
                float q = 0.f;
#pragma unroll
                for (int g4 = 0; g4 < 4; ++g4) {
                    float gv[4];
#pragma unroll
                    for (int e = 0; e < 4; ++e) {
                        const int i = 4 * g4 + e, pl = 32 * pt + 8 * g4 + 4 * h + e;
                        const float xs = bf2f((unsigned)sXT[pl * 136 + lme]);
                        const float y = yd[i] + el * yo[i] + dsk * xs;
                        const unsigned zw = (e >> 1) ? zr[g4].y : zr[g4].x;
                        const float z = (e & 1) ? bfhi(zw) : bflo(zw);
                        gv[e] = y * siluf(z);
                    }
                    const unsigned w0 = pk2(gv[0], gv[1]), w1 = pk2(gv[2], gv[3]);
                    *(u32x2*)(gp + 8 * g4) = (u32x2){w0, w1};
                    q += (bflo(w0) * bflo(w0) + bfhi(w0) * bfhi(w0)) + (bflo(w1) * bflo(w1) + bfhi(w1) * bfhi(w1));
                }
                q += __shfl_xor(q, 32);
                if (h == 0) gsq[lme * 8 + hh * 2 + pt] = q;
            }
            __syncthreads();
        }
        {
            const float* wsn = p.in[12];
            for (int i = tid; i < 128 * 32; i += NTHREADS) {
                const int l = i >> 5, c8 = (i & 31) * 8;
                float s = 0.f;
#pragma unroll
                for (int q = 0; q < 8; ++q) s += gsq[l * 8 + q];
                const float rstd = 1.f / sqrtf(s * (1.f / 256.f) + EPS);
                const u32x4 t = *(const u32x4*)(A2 + (row0 + l) * 1024 + 512 + g * 256 + c8);
                const f32x4 w0 = *(const f32x4*)(wsn + g * 256 + c8), w1 = *(const f32x4*)(wsn + g * 256 + c8 + 4);
                u32x4 o; o.x = pk2(bflo(t.x) * rstd * w0.x, bfhi(t.x) * rstd * w0.y); o.y = pk2(bflo(t.y) * rstd * w0.z, bfhi(t.y) * rstd * w0.w); o.z = pk2(bflo(t.z) * rstd * w1.x, bfhi(t.z) * rstd * w1.y); o.w = pk2(bflo(t.w) * rstd * w1.z, bfhi(t.w) * rstd * w1.w);
                *(u32x4*)(A2 + (row0 + l) * 1024 + 512 + g * 256 + c8) = o;
            }
        }
        __syncthreads();
    }
}

__device__ __forceinline__ void phase5(const Params& p, unsigned char* lds) {
    unsigned char* ws = p.ws;
    pg8::Gemm g{(const bf16_t*)(ws + WS_A2), (const bf16_t*)(ws + WS_WOUT), NT, DM, DM};
    pg8::StaticOrder S; S.init(NT, DM, (int)gridDim.x, (int)blockIdx.x);
    pg8::EpiResid<true, true> E{p.in[0], (bf16_t*)(ws + WS_XB), (float*)(ws + WS_SSQ)};
    pg8::gemm_phase<pg8::EpiResid<true, true>, pg8::StaticOrder, true, true>(LDS3(lds), g, S, E);
}
__device__ __forceinline__ void phase6(const Params& p, unsigned char* lds) {
    unsigned char* ws = p.ws;
    pg8::Gemm g{(const bf16_t*)(ws + WS_XB), (const bf16_t*)(ws + WS_WQ), NT, 512, DM};
    pg8::StaticOrder S; S.init(NT, 512, (int)gridDim.x, (int)blockIdx.x);
    pg8::EpiQ E{(bf16_t*)(ws + WS_Q2), (const float*)(ws + WS_SSQ)};
    pg8::gemm_phase<pg8::EpiQ, pg8::StaticOrder, true, true>(LDS3(lds), g, S, E);
}
__device__ __forceinline__ void phase8(const Params& p, unsigned char* lds) {
    unsigned char* ws = p.ws;
    pg8::Gemm g{(const bf16_t*)(ws + WS_XO), (const bf16_t*)(ws + WS_WO), NT, DM, 512};
    pg8::StaticOrder S; S.init(NT, DM, (int)gridDim.x, (int)blockIdx.x);
    pg8::EpiResid<false, false> E{(const void*)(ws + WS_XB), (bf16_t*)(ws + WS_XB), nullptr};
    pg8::gemm_phase<pg8::EpiResid<false, false>, pg8::StaticOrder, true, true>(LDS3(lds), g, S, E);
}

__device__ __forceinline__ void phase7(const Params& p, unsigned char* lds) {
    const int tid = opaque_tid(), lane = tid & 63, w = tid >> 6, r = lane & 31, h = lane >> 5;
    const bf16_t* q2 = (const bf16_t*)(p.ws + WS_Q2); const bf16_t* kmem = (const bf16_t*)(p.ws + WS_KMEM); const bf16_t* vmemT = (const bf16_t*)(p.ws + WS_VMEMT);
    bf16_t* xo = (bf16_t*)(p.ws + WS_XO);
    bf16_t* sK = (bf16_t*)lds;
    bf16_t* sV = sK + 256 * 136;
    const float sc = 0.08838834764831845f * 1.4426950408889634f;
    for (int pr = blockIdx.x; pr < 256; pr += gridDim.x) {
        const int bh = pr >> 3, rp = pr & 7, b = bh >> 2, hx = bh & 3;
        __syncthreads();
        for (int i = tid; i < 4096; i += NTHREADS) { const int key = i >> 4, ch = i & 15;
            *(u32x4*)(sK + key * 136 + ch * 8) = *(const u32x4*)(kmem + ((size_t)b * 256 + key) * 512 + hx * 128 + ch * 8); }
        for (int i = tid; i < 4096; i += NTHREADS) { const int d = i >> 5, ch = i & 31;
            const u32x4 v = *(const u32x4*)(vmemT + (((size_t)b * 4 + hx) * 128 + d) * 256 + ch * 8);
            *(u32x2*)(sV + d * 260 + ch * 8) = (u32x2){v.x, v.y}; *(u32x2*)(sV + d * 260 + ch * 8 + 4) = (u32x2){v.z, v.w}; }
        __syncthreads();
#pragma unroll 1
        for (int ib = 0; ib < 2; ++ib) {
            const size_t row0 = (size_t)b * SEQ + (size_t)(2 * rp + ib) * 256 + w * 32;
            bf16x8 qf[8];
            const bf16_t* qp = q2 + (row0 + r) * 512 + hx * 128 + 8 * h;
#pragma unroll
            for (int kk = 0; kk < 8; ++kk) qf[kk] = *(const bf16x8*)(qp + kk * 16);
            f32x16 S[8];
#pragma unroll
            for (int t = 0; t < 8; ++t) S[t] = zero16();
            const bf16_t* kp = sK + r * 136 + 8 * h;
#pragma unroll
            for (int kk = 0; kk < 8; ++kk) {
#pragma unroll
                for (int t = 0; t < 8; ++t) { const bf16x8 a = *(const bf16x8*)(kp + t * (32 * 136) + kk * 16); S[t] = mfma32(a, qf[kk], S[t]); }
                __builtin_amdgcn_sched_barrier(0);
            }
            float m = -INFINITY;
#pragma unroll
            for (int t = 0; t < 8; ++t)
#pragma unroll
                for (int i = 0; i < 16; ++i) m = fmaxf(m, S[t][i]);
            m = fmaxf(m, __shfl_xor(m, 32));
            float sum = 0.f;
            bf16x8 P[16];
#pragma unroll
            for (int t = 0; t < 8; ++t) {
                float e[16];
#pragma unroll
                for (int i = 0; i < 16; ++i) { e[i] = __builtin_amdgcn_exp2f((S[t][i] - m) * sc); sum += e[i]; }
                P[2 * t] = pack8(e[0], e[1], e[2], e[3], e[4], e[5], e[6], e[7]);
                P[2 * t + 1] = pack8(e[8], e[9], e[10], e[11], e[12], e[13], e[14], e[15]);
            }
            sum += __shfl_xor(sum, 32);
            const float inv = 1.f / sum;
            f32x16 O[4];
#pragma unroll
            for (int dt = 0; dt < 4; ++dt) O[dt] = zero16();
            const bf16_t* vp0 = sV + r * 260 + 4 * h;
#pragma unroll
            for (int ts = 0; ts < 16; ++ts) {
#pragma unroll
                for (int dt = 0; dt < 4; ++dt) {
                    const bf16_t* vp = vp0 + dt * (32 * 260) + 16 * ts;
                    const u32x2 lo = *(const u32x2*)vp, hi = *(const u32x2*)(vp + 8);
                    const bf16x8 a = __builtin_bit_cast(bf16x8, (u32x4){lo.x, lo.y, hi.x, hi.y});
                    O[dt] = mfma32(a, P[ts], O[dt]);
                }
                if (ts & 1) __builtin_amdgcn_sched_barrier(0);
            }
            bf16_t* op = xo + (row0 + r) * 512 + hx * 128 + 4 * h;
#pragma unroll
            for (int dt = 0; dt < 4; ++dt)
#pragma unroll
                for (int g = 0; g < 4; ++g) { u32x2 o; o.x = pk2(O[dt][4 * g] * inv, O[dt][4 * g + 1] * inv); o.y = pk2(O[dt][4 * g + 2] * inv, O[dt][4 * g + 3] * inv);
                    *(u32x2*)(op + 32 * dt + 8 * g) = o; }
        }
    }
}

typedef __bf16 bf16x2_t __attribute__((ext_vector_type(2)));
__device__ __forceinline__ float dot2bf(unsigned a, unsigned b, float acc) { return __builtin_amdgcn_fdot2_f32_bf16(__builtin_bit_cast(bf16x2_t, a), __builtin_bit_cast(bf16x2_t, b), acc, false); }
__device__ __forceinline__ void phase9(const Params& p, unsigned char* lds) {
    const int tid = opaque_tid(), lane = tid & 63, w = tid >> 6, r = lane & 31, h = lane >> 5;
    const bf16_t* x2 = (const bf16_t*)(p.ws + WS_XB);
    int* cnt = (int*)(p.ws + WS_CTL);
    int* list = (int*)(p.ws + WS_LIST);
    float* route = (float*)(p.ws + WS_ROUTE);
    const float* bg = p.in[21]; const float* be = p.in[23];
    bf16_t* sW = (bf16_t*)lds;
    int* lcnt = (int*)(lds + 74752);
    float* lrec = (float*)(lds + 74752 + 256);
    for (int i = tid; i < 36 * 128; i += NTHREADS) { const int n = i >> 7, ch = i & 127; *(u32x4*)(sW + n * 1032 + ch * 8) = *(const u32x4*)((const bf16_t*)(p.ws + WS_WR) + n * 1024 + ch * 8); }
    if (tid < 64) lcnt[tid] = 0;
    __syncthreads();
    const int njobs = NT / 32, jstride = gridDim.x * 4;
    int nrec = 0;
    for (int job0 = blockIdx.x * 4; job0 < njobs; job0 += jstride, ++nrec) {
        const int job = job0 + w;
        if (w < 4 && job < njobs) {
            const int m0 = job * 32;
            f32x16 acc0 = zero16(), acc1 = zero16();
            float ss = 0.f;
            const bf16_t* xp = x2 + (size_t)(m0 + r) * DM + 8 * h;
            const bf16_t* w0p = sW + r * 1032 + 8 * h;
            const bf16_t* w1p = sW + (32 + (r & 3)) * 1032 + 8 * h;
#pragma unroll 1
            for (int kb = 0; kb < 4; ++kb) {
                u32x4 xf[16];
#pragma unroll
                for (int q = 0; q < 16; ++q) xf[q] = *(const u32x4*)(xp + (kb * 16 + q) * 16);
#pragma unroll
                for (int q = 0; q < 16; ++q) {
                    const bf16x8 a0 = *(const bf16x8*)(w0p + (kb * 16 + q) * 16), a1 = *(const bf16x8*)(w1p + (kb * 16 + q) * 16);
                    const bf16x8 xb = __builtin_bit_cast(bf16x8, xf[q]);
                    acc0 = mfma32(a0, xb, acc0); acc1 = mfma32(a1, xb, acc1);
                    ss = dot2bf(xf[q].x, xf[q].x, ss); ss = dot2bf(xf[q].y, xf[q].y, ss); ss = dot2bf(xf[q].z, xf[q].z, ss); ss = dot2bf(xf[q].w, xf[q].w, ss);
                }
            }
            ss += __shfl_xor(ss, 32);
            const float rstd = 1.f / sqrtf(ss * (1.f / DM) + EPS);
            const float g0 = __shfl(acc1[0], r) * rstd + bg[0], g1 = __shfl(acc1[1], r) * rstd + bg[1], g2 = __shfl(acc1[2], r) * rstd + bg[2], g3 = __shfl(acc1[3], r) * rstd + bg[3];
            int gi = 0; float gm = g0;
            if (g1 > gm) { gm = g1; gi = 1; }
            if (g2 > gm) { gm = g2; gi = 2; }
            if (g3 > gm) { gm = g3; gi = 3; }
            const float gden = __expf(g0 - gm) + __expf(g1 - gm) + __expf(g2 - gm) + __expf(g3 - gm);
            const float ggate = 1.f / gden;
            const bool up = (gi & 1) != 0;
            const int gme = 2 * h + (gi & 1);
            float ev[8];
#pragma unroll
            for (int j = 0; j < 8; ++j) ev[j] = (up ? acc0[8 + j] : acc0[j]) * rstd + be[gme * 8 + j];
            int i1 = 0; float v1 = ev[0];
#pragma unroll
            for (int j = 1; j < 8; ++j) if (ev[j] > v1) { v1 = ev[j]; i1 = j; }
            int i2 = -1; float v2 = -INFINITY;
#pragma unroll
            for (int j = 0; j < 8; ++j) if (j != i1 && ev[j] > v2) { v2 = ev[j]; i2 = j; }
            const float e2 = __expf(v2 - v1);
            const float w1 = ggate / (1.f + e2), w2 = ggate * e2 / (1.f + e2);
            if (h == (gi >> 1)) {
                const int ea = gi * 8 + i1, eb = gi * 8 + i2;
                const int la = atomicAdd(lcnt + ea, 1), lb = atomicAdd(lcnt + eb, 1);
                float* rc = lrec + (size_t)(nrec * 128 + w * 32 + r) * 8;
                ((int*)rc)[0] = ea; ((int*)rc)[1] = eb; ((int*)rc)[2] = la; ((int*)rc)[3] = lb; rc[4] = w1; rc[5] = w2; rc[6] = rstd; ((int*)rc)[7] = m0 + r;
            }
        }
    }
    __syncthreads();
    if (tid < 32) lcnt[32 + tid] = lcnt[tid] ? atomicAdd(cnt + tid * 64, lcnt[tid]) : 0;
    __syncthreads();
    {
        int rd = 0;
        for (int job0 = blockIdx.x * 4; job0 < njobs; job0 += jstride, ++rd) {
            if (tid < 128 && job0 + (tid >> 5) < njobs) {
                const float* rc = lrec + (size_t)(rd * 128 + tid) * 8;
                const int ea = ((const int*)rc)[0], eb = ((const int*)rc)[1], m = ((const int*)rc)[7];
                const int pa = lcnt[32 + ea] + ((const int*)rc)[2], pb = lcnt[32 + eb] + ((const int*)rc)[3];
                list[ea * NT + pa] = m; list[eb * NT + pb] = m;
                int* ri = (int*)(route + (size_t)m * 8);
                ri[0] = ea; ri[1] = eb; ri[2] = pa; ri[3] = pb;
                route[(size_t)m * 8 + 4] = rc[4]; route[(size_t)m * 8 + 5] = rc[5]; route[(size_t)m * 8 + 6] = rc[6]; route[(size_t)m * 8 + 7] = 0.f;
            }
        }
    }
}

__device__ __forceinline__ int* moe_tables(const Params& p, unsigned char* lds) {
    int* off = (int*)(lds + 131072);
    const int* cnt = (const int*)(p.ws + WS_CTL);
    if (threadIdx.x < 64) {
        const int l = threadIdx.x & 63;
        const int cv = (l < NEXP) ? cnt[l * 64] : 0;
        int pad = ((cv + 255) >> 8) << 8, incl = pad;
#pragma unroll
        for (int o = 1; o < 32; o <<= 1) { const int t = __shfl_up(incl, o); if (l >= o) incl += t; }
        if (l < NEXP) { off[l] = incl - pad; off[40 + l] = cv; }
        if (l == NEXP - 1) off[NEXP] = incl;
    }
    __syncthreads();
    const int nrt = off[NEXP] >> 8;
    for (int rt = threadIdx.x; rt < nrt; rt += NTHREADS) { int e = 0; for (int q = 1; q < NEXP; ++q) if (off[q] <= rt * 256) e = q; off[128 + rt] = e; }
    __syncthreads();
    return off;
}

__device__ __forceinline__ void phase10(const Params& p, unsigned char* lds) {
    const int tid = opaque_tid(), lane = tid & 63, w = tid >> 6;
    const int* off = moe_tables(p, lds);
    const int gw = blockIdx.x * NWAVES + w, NGW = gridDim.x * NWAVES;
    const bf16_t* x2 = (const bf16_t*)(p.ws + WS_XB); const float* route = (const float*)(p.ws + WS_ROUTE);
    bf16_t* xg = (bf16_t*)(p.ws + WS_XG);
    for (int m = gw; m < NT; m += NGW) {
        const int* ri = (const int*)(route + (size_t)m * 8);
        const int ea = ri[0], eb = ri[1], pa = ri[2], pb = ri[3];
        const float rs = route[(size_t)m * 8 + 6];
        const size_t sa = (size_t)off[ea] + pa, sb = (size_t)off[eb] + pb;
        const u32x2* xr = (const u32x2*)(x2 + (size_t)m * DM) + lane;
        u32x2* oa = (u32x2*)(xg + sa * DM) + lane; u32x2* ob = (u32x2*)(xg + sb * DM) + lane;
#pragma unroll
        for (int j = 0; j < 4; ++j) { const u32x2 t = xr[64 * j]; u32x2 o; o.x = pk2(bflo(t.x) * rs, bfhi(t.x) * rs); o.y = pk2(bflo(t.y) * rs, bfhi(t.y) * rs); oa[64 * j] = o; ob[64 * j] = o; }
    }
}

__device__ __forceinline__ void phase11(const Params& p, unsigned char* lds) {
    const int tid = opaque_tid();
    const int* off = moe_tables(p, lds);
    const int nrt = off[NEXP] >> 8, G = (int)gridDim.x, c = (int)blockIdx.x;
    unsigned* rowtab = (unsigned*)(lds + 131072 + 2048);
    float* rstab = (float*)(lds + 131072 + 2048 + 3072);
    {
        const int* list = (const int*)(p.ws + WS_LIST); const float* route = (const float*)(p.ws + WS_ROUTE);
        for (int i = 0; i < 3; ++i) {
            const int L = i * G + c; if (L >= nrt * 2) break;
            const int rt = L >> 1, e = off[128 + rt], cnt_e = off[40 + e], pos0 = rt * 256 - off[e];
            if (tid < 256) { const int pos = pos0 + tid; int tok = 0; float rs = 0.f;
                if (pos < cnt_e) { tok = list[e * NT + pos]; rs = route[(size_t)tok * 8 + 6]; }
                rowtab[i * 256 + tid] = (unsigned)tok * (unsigned)(DM * 2); rstab[i * 256 + tid] = rs; }
        }
    }
    __syncthreads();
    pg8::Gemm g{(const bf16_t*)(p.ws + WS_XB), (const bf16_t*)(p.ws + WS_WGU), 0, 0, DM};
    pg8::MoeOrder S{(const __attribute__((address_space(3))) int*)(off + 128), nrt, 2, G, c};
    pg8::EpiGU E{(bf16_t*)(p.ws + WS_HID), (const __attribute__((address_space(3))) float*)rstab, G, c};
    pg8::gemm_phase_g<pg8::EpiGU, pg8::MoeOrder, true, true>(LDS3(lds), g, S, E, (const __attribute__((address_space(3))) unsigned*)rowtab);
}
__device__ __forceinline__ void phase12(const Params& p, unsigned char* lds) {
    const int* off = moe_tables(p, lds);
    int kdim = EFF; asm volatile("" : "+s"(kdim));
    pg8::Gemm g{(const bf16_t*)(p.ws + WS_HID), (const bf16_t*)(p.ws + WS_WD), 0, 0, kdim};
    pg8::MoeOrder S{(const __attribute__((address_space(3))) int*)(off + 128), off[NEXP] >> 8, 4, (int)gridDim.x, (int)blockIdx.x};
    pg8::EpiBf16 E{(bf16_t*)(p.ws + WS_Y), DM, 4};
    pg8::gemm_phase<pg8::EpiBf16, pg8::MoeOrder, true, true>(LDS3(lds), g, S, E);
}

__device__ __forceinline__ void phase13(const Params& p, unsigned char* lds) {
    const int tid = opaque_tid(), lane = tid & 63, w = tid >> 6;
    const int* off = moe_tables(p, lds);
    const int gw = blockIdx.x * NWAVES + w, NGW = gridDim.x * NWAVES;
    const bf16_t* x2 = (const bf16_t*)(p.ws + WS_XB); const bf16_t* yb = (const bf16_t*)(p.ws + WS_Y);
    const float* route = (const float*)(p.ws + WS_ROUTE); const float* wf = p.in[27];
    f32x4 wv[4];
#pragma unroll
    for (int j = 0; j < 4; ++j) wv[j] = *(const f32x4*)(wf + 4 * lane + 256 * j);
    u32x4 recA, recB;
    u32x2 cx[4], cya[4], cyb[4]; float cw1 = 0.f, cw2 = 0.f;
    u32x4 rec0;
#define ISSUE_ROWS(m_, rec_, X, YA, YB) { const size_t sa_ = (size_t)off[(int)(rec_).x] + (rec_).z, sb_ = (size_t)off[(int)(rec_).y] + (rec_).w; \
        const u32x2* xr_ = (const u32x2*)(x2 + (size_t)(m_) * DM) + lane; const u32x2* ya_ = (const u32x2*)(yb + sa_ * DM) + lane; const u32x2* yb_ = (const u32x2*)(yb + sb_ * DM) + lane; \
        _Pragma("unroll") for (int j = 0; j < 4; ++j) { X[j] = xr_[64 * j]; YA[j] = ya_[64 * j]; YB[j] = yb_[64 * j]; } }
    if (gw < NT) {
        rec0 = *(const u32x4*)(route + (size_t)gw * 8); const u32x2 wq = *(const u32x2*)(route + (size_t)gw * 8 + 4);
        cw1 = __uint_as_float(wq.x); cw2 = __uint_as_float(wq.y);
        ISSUE_ROWS(gw, rec0, cx, cya, cyb);
    }
    u32x2 wA = (u32x2){0u, 0u};
    if (gw + NGW < NT) { recA = *(const u32x4*)(route + (size_t)(gw + NGW) * 8); wA = *(const u32x2*)(route + (size_t)(gw + NGW) * 8 + 4); }
#pragma unroll 1
    for (int m = gw; m < NT; m += NGW) {
        u32x2 nx[4], nya[4], nyb[4]; u32x2 wB = (u32x2){0u, 0u};
        const bool has1 = (m + NGW < NT), has2 = (m + 2 * NGW < NT);
        if (has1) ISSUE_ROWS(m + NGW, recA, nx, nya, nyb);
        if (has2) { recB = *(const u32x4*)(route + (size_t)(m + 2 * NGW) * 8); wB = *(const u32x2*)(route + (size_t)(m + 2 * NGW) * 8 + 4); }
        f32x4 v[4]; float s = 0.f;
#pragma unroll
        for (int j = 0; j < 4; ++j) {
            const u32x2 t = cx[j], a = cya[j], bq = cyb[j];
            v[j].x = bflo(t.x) + cw1 * bflo(a.x) + cw2 * bflo(bq.x); v[j].y = bfhi(t.x) + cw1 * bfhi(a.x) + cw2 * bfhi(bq.x);
            v[j].z = bflo(t.y) + cw1 * bflo(a.y) + cw2 * bflo(bq.y); v[j].w = bfhi(t.y) + cw1 * bfhi(a.y) + cw2 * bfhi(bq.y);
            s += (v[j].x * v[j].x + v[j].y * v[j].y) + (v[j].z * v[j].z + v[j].w * v[j].w);
        }
        const float rstd = 1.f / sqrtf(wave_sum(s) * (1.f / DM) + EPS);
        f32x4* o = (f32x4*)(p.out + (size_t)m * DM) + lane;
#pragma unroll
        for (int j = 0; j < 4; ++j) o[64 * j] = v[j] * rstd * wv[j];
        if (has1) {
#pragma unroll
            for (int j = 0; j < 4; ++j) { cx[j] = nx[j]; cya[j] = nya[j]; cyb[j] = nyb[j]; }
            cw1 = __uint_as_float(wA.x); cw2 = __uint_as_float(wA.y);
        }
        recA = recB; wA = wB;
    }
#undef ISSUE_ROWS
}

constexpr int NPHASE = 14;
__global__ void __launch_bounds__(NTHREADS, 2) fwd_kernel(Params p) {
    extern __shared__ __attribute__((aligned(16))) unsigned char lds[];
#if MK_ONE_LAUNCH
    cg::grid_group grid = cg::this_grid();
    volatile LAS unsigned* bst = (volatile LAS unsigned*)(LDS3(lds) + LDS_BYTES - 16);
    if (threadIdx.x < 2) bst[threadIdx.x] = 0u;
    __syncthreads();
    const XcdBarrier xbar = xcd_barrier_post((unsigned*)(p.ws + WS_BAR), bst);
#define SEAM(k) do { if (p.ph_lo <= (k) && (k) + 1 < p.ph_hi) { if ((k) == 0) grid.sync(); else xcd_barrier(xbar); } } while (0)
#else
#define SEAM(k) do { } while (0)
#endif
#ifndef PROBE_PHASE
#define PROBE_PHASE -1
#endif
#define IN(k) (p.ph_lo <= (k) && (k) < p.ph_hi && (k) != p.skip)
#define REPS(k) (((k) == PROBE_PHASE) ? 2 : 1)
    if (IN(0)) { _Pragma("unroll 1") for (int rep = 0; rep < REPS(0); ++rep) { phase0(p, lds); } } SEAM(0);
    if (IN(1)) { _Pragma("unroll 1") for (int rep = 0; rep < REPS(1); ++rep) { phase1(p, lds); } } SEAM(1);
    if (IN(2)) { _Pragma("unroll 1") for (int rep = 0; rep < REPS(2); ++rep) for (int it = blockIdx.x; it < NB * NCH; it += gridDim.x) { const int b = it / NCH, c = it % NCH; phase2_attn(p, lds, b, c); phase2_states(p, lds, b, c); } } SEAM(2);
    if (IN(3)) { _Pragma("unroll 1") for (int rep = 0; rep < REPS(3); ++rep) { phase3(p); } } SEAM(3);
    if (IN(4)) { _Pragma("unroll 1") for (int rep = 0; rep < REPS(4); ++rep) for (int it = blockIdx.x; it < NB * NCH; it += gridDim.x) { const int b = it / NCH, c = it % NCH; phase4(p, lds, b, c); } } SEAM(4);
    if (IN(5)) { _Pragma("unroll 1") for (int rep = 0; rep < REPS(5); ++rep) { phase5(p, lds); } } SEAM(5);
    if (IN(6)) { _Pragma("unroll 1") for (int rep = 0; rep < REPS(6); ++rep) { phase6(p, lds); } } SEAM(6);
    if (IN(7)) { _Pragma("unroll 1") for (int rep = 0; rep < REPS(7); ++rep) { phase7(p, lds); } } SEAM(7);
    if (IN(8)) { phase8(p, lds); } SEAM(8);
    if (IN(9)) { phase9(p, lds); } SEAM(9);
    if (IN(11)) { _Pragma("unroll 1") for (int rep = 0; rep < REPS(11); ++rep) { phase11(p, lds); } } SEAM(11);
    if (IN(12)) { _Pragma("unroll 1") for (int rep = 0; rep < REPS(12); ++rep) { phase12(p, lds); } } SEAM(12);
    if (IN(13)) { _Pragma("unroll 1") for (int rep = 0; rep < REPS(13); ++rep) { phase13(p, lds); } }
#undef IN
#undef SEAM
}

extern "C" void kernel_launch(void* const* d_in, const int* in_sizes, int n_in, void* d_out, int out_size, void* d_ws, size_t ws_size, hipStream_t stream) {
    static int grid = 0;
    if (grid == 0) {
        if (n_in != 28 || out_size != NT * DM || ws_size < WS_NEED) { fprintf(stderr, "kernel_launch: unexpected sizes n_in %d out %d ws %zu\n", n_in, out_size, ws_size); grid = -1; return; }
        int dev = 0, cus = 0, per_cu = 0;
        hipGetDevice(&dev);
        hipDeviceGetAttribute(&cus, hipDeviceAttributeMultiprocessorCount, dev);
        if (hipFuncSetAttribute((const void*)fwd_kernel, hipFuncAttributeMaxDynamicSharedMemorySize, LDS_BYTES) != hipSuccess) { fprintf(stderr, "kernel_launch: hipFuncSetAttribute failed\n"); grid = -1; return; }
        if (hipOccupancyMaxActiveBlocksPerMultiprocessor(&per_cu, (const void*)fwd_kernel, NTHREADS, LDS_BYTES) != hipSuccess || per_cu < 1) { fprintf(stderr, "kernel_launch: occupancy query says %d\n", per_cu); per_cu = 1; }
        (void)hipGetLastError();
        grid = cus;
    }
    if (grid < 0) return;
    Params prm{};
    for (int i = 0; i < 28; ++i) prm.in[i] = (const float*)d_in[i];
    prm.out = (float*)d_out; prm.ws = (unsigned char*)d_ws;
    for (int i = 0; i < 8; ++i) prm.inv_freq[i] = powf(500000.0f, -(float)(2 * i) / 16.0f);
    prm.skip = -1;
#ifndef PROBE_SKIP
#define PROBE_SKIP -2
#endif
#if MK_ONE_LAUNCH
    for (int twice = 0; twice < ((PROBE_SKIP >= -1) ? 2 : 1); ++twice) {
    if (hipMemsetAsync((char*)d_ws + WS_CTL, 0, CTL_ZERO_BYTES, stream) != hipSuccess) { fprintf(stderr, "kernel_launch: memset failed\n"); return; }
#ifndef PROBE_TRUNC
#define PROBE_TRUNC NPHASE
#endif
    prm.ph_lo = 0; prm.ph_hi = twice ? PROBE_TRUNC : NPHASE; prm.skip = twice ? PROBE_SKIP : -1;
    void* args[] = {&prm};
    hipError_t e = hipLaunchCooperativeKernel((const void*)fwd_kernel, dim3(grid), dim3(NTHREADS), args, LDS_BYTES, stream);
    if (e != hipSuccess) fprintf(stderr, "cooperative launch failed: %s (grid %d)\n", hipGetErrorString(e), grid);
    }
#else
    if (hipMemsetAsync((char*)d_ws + WS_CTL, 0, CTL_ZERO_BYTES, stream) != hipSuccess) { fprintf(stderr, "kernel_launch: memset failed\n"); return; }
#ifndef PROBE_DUP
#define PROBE_DUP -1
#endif
    for (int ph = 0; ph < NPHASE; ++ph) {
        prm.ph_lo = ph; prm.ph_hi = ph + 1;
        hipLaunchKernelGGL(fwd_kernel, dim3(grid), dim3(NTHREADS), LDS_BYTES, stream, prm);
        if (ph == PROBE_DUP) hipLaunchKernelGGL(fwd_kernel, dim3(grid), dim3(NTHREADS), LDS_BYTES, stream, prm);
    }
#endif
}
```

```cpp
#include <hip/hip_runtime.h>
#include <hip/hip_cooperative_groups.h>
#include <cstdio>
#include <cmath>
namespace cg = cooperative_groups;

#ifndef MK_ONE_LAUNCH
#define MK_ONE_LAUNCH 1
#endif

typedef unsigned short bf16_t;
typedef short bf16x8 __attribute__((ext_vector_type(8)));
typedef float f32x4 __attribute__((ext_vector_type(4)));
typedef float f32x16 __attribute__((ext_vector_type(16)));
typedef unsigned u32x4 __attribute__((ext_vector_type(4)));
typedef unsigned u32x2 __attribute__((ext_vector_type(2)));

constexpr int NB = 8, SEQ = 4096, DM = 1024, NT = NB * SEQ;
constexpr int NPROJ = 2304, LDWIN = 2312;
constexpr int C_K = 512, C_V = 640, C_Z = 768, C_X = 1280, C_B = 1792, C_C = 2048;
constexpr int MEMT = 256, NMEM = NB * MEMT;
constexpr int NEXP = 32, EFF = 256;
constexpr int NCH = SEQ / 128;
constexpr float EPS = 1e-5f;
constexpr int NTHREADS = 512, NWAVES = 8;
constexpr int LDS_BYTES = 147456;

constexpr size_t MiB = (size_t)1 << 20;
constexpr size_t WS_CTL = 0, WS_BAR = 65536, CTL_ZERO_BYTES = 131072;
constexpr size_t WS_WIN = 1 * MiB, WS_WOUT = 6 * MiB, WS_WQ = 8 * MiB, WS_WKV = 9 * MiB, WS_WO = 11 * MiB, WS_WR = 12 * MiB;
constexpr size_t WS_WGU = 16 * MiB, WS_WD = 48 * MiB;
constexpr size_t WS_MEMH = 64 * MiB, WS_KMEM = 68 * MiB, WS_VMEMT = 70 * MiB, WS_DTRAW = 72 * MiB, WS_CDEC = 73 * MiB, WS_ROUTE = 74 * MiB;
constexpr size_t WS_LIST = 76 * MiB, WS_SSQ = 80 * MiB;
constexpr size_t WS_PROJ = 96 * MiB, WS_A2 = 240 * MiB, WS_STATES = 304 * MiB, WS_START = 368 * MiB;
constexpr size_t WS_X1 = 96 * MiB, WS_XB = 304 * MiB, WS_Q2 = 368 * MiB, WS_XO = 224 * MiB, WS_XG = 96 * MiB, WS_HID = 368 * MiB, WS_Y = 96 * MiB;
constexpr size_t WS_H1 = 416 * MiB;
constexpr size_t WS_NEED = 512 * MiB;

struct Params {
    const float* in[28];
    float* out;
    unsigned char* ws;
    float inv_freq[8];
    int ph_lo, ph_hi, skip, pad;
};

__device__ __forceinline__ unsigned f2bf(float f) { unsigned u = __float_as_uint(f); return (u + 0x7fffu + ((u >> 16) & 1u)) >> 16; }
__device__ __forceinline__ float bf2f(unsigned h) { return __uint_as_float(h << 16); }
__device__ __forceinline__ unsigned pk2(float lo, float hi) { return f2bf(lo) | (f2bf(hi) << 16); }
__device__ __forceinline__ float bflo(unsigned u) { return __uint_as_float(u << 16); }
__device__ __forceinline__ float bfhi(unsigned u) { return __uint_as_float(u & 0xffff0000u); }
__device__ __forceinline__ float wave_sum(float v) {
#pragma unroll
    for (int o = 32; o >= 1; o >>= 1) v += __shfl_xor(v, o);
    return v;
}
#define LDS_WAIT() asm volatile("s_waitcnt lgkmcnt(0)" ::: "memory")
__device__ __forceinline__ int opaque_tid() { int t = threadIdx.x; asm volatile("" : "+v"(t)); return t; }
__device__ __forceinline__ float siluf(float v) { return v * __builtin_amdgcn_rcpf(1.f + __expf(-v)); }
__device__ __forceinline__ f32x16 mfma32(bf16x8 a, bf16x8 b, f32x16 c) { return __builtin_amdgcn_mfma_f32_32x32x16_bf16(a, b, c, 0, 0, 0); }
__device__ __forceinline__ f32x16 zero16() { f32x16 z;
#pragma unroll
    for (int i = 0; i < 16; ++i) z[i] = 0.f;
    return z; }
__device__ __forceinline__ bf16x8 pack8(float a0, float a1, float a2, float a3, float a4, float a5, float a6, float a7) {
    u32x4 t; t.x = pk2(a0, a1); t.y = pk2(a2, a3); t.z = pk2(a4, a5); t.w = pk2(a6, a7);
    return __builtin_bit_cast(bf16x8, t);
}
__device__ __forceinline__ int crow(int i, int h) { return (i & 3) + 8 * (i >> 2) + 4 * h; }

namespace pg8 {
#define PG8_LAS __attribute__((address_space(3)))
typedef unsigned short bf16_t;
typedef short bf16x8 __attribute__((ext_vector_type(8)));
typedef float f32x4 __attribute__((ext_vector_type(4)));
typedef unsigned u32x4 __attribute__((ext_vector_type(4)));
constexpr int BM = 256, BK = 64, HALF = 128, HTB = HALF * BK * 2  , STAGE_BYTES = 8 * HTB, NXCD = 8, WGM = 8;

__host__ __device__ __forceinline__ int lds_byte(int r, int c) { const int st = (r >> 4) * 2 + (c >> 5), rr = r & 15, cc = c & 31, ob = rr * 64 + cc * 2; return st * 1024 + (ob ^ (((ob >> 9) & 1) << 5)); }
__host__ __device__ __forceinline__ void stage_rc(int b, int& R, int& C) { const int st = b / 1024, sb = b % 1024, swz = sb ^ (((sb >> 9) & 1) << 5); R = (st >> 1) * 16 + swz / 64; C = (st & 1) * 32 + (swz % 64) / 2; }
__host__ __device__ __forceinline__ int perm32(int rho) { const int n = rho >> 4, i = rho & 15; return 8 * (i >> 2) + 4 * n + (i & 3); }

struct Unit { int pm, pn; };
struct Gemm { const bf16_t* A; const bf16_t* Bt; int M, N, K; };

struct StaticOrder {
    int nM, nN, nwg, G, c;
    __host__ __device__ void init(int M, int N, int G_, int c_) { nM = M / BM; nN = N / BM; nwg = nM * nN; G = G_; c = c_; }
    __host__ __device__ bool next(int i, Unit& u) const {
        const long L = (long)i * G + c; if (L >= nwg) return false;
        int wgid = (int)L; { const int q = nwg / NXCD, r = nwg % NXCD, xcd = wgid % NXCD, off = wgid / NXCD; wgid = (xcd < r ? xcd * (q + 1) : r * (q + 1) + (xcd - r) * q) + off; }
        const int nig = WGM * nN, gid = wgid / nig, fm = gid * WGM, gsz = (nM - fm) < WGM ? (nM - fm) : WGM;
        u.pm = fm + ((wgid % nig) % gsz); u.pn = (wgid % nig) / gsz; return true;
    }
    __device__ __forceinline__ void a_ready(const Unit&) const {}
    __device__ __forceinline__ void done(const Unit&) const {}
};
__device__ __forceinline__ unsigned cvt_pk_bf16(float lo, float hi) { unsigned r; asm volatile("v_cvt_pk_bf16_f32 %0, %1, %2" : "=v"(r) : "v"(lo), "v"(hi)); return r; }
typedef float f32x2 __attribute__((ext_vector_type(2)));
template <class Epi, class Sched, bool ALIGN_EPI = false, bool SP2 = false>
__device__ __forceinline__ void gemm_phase(PG8_LAS unsigned char* lds, const Gemm g, const Sched& S, const Epi& E) {
    const int tid = threadIdx.x, wid = __builtin_amdgcn_readfirstlane(tid >> 6), lane = tid & 63, wr = wid >> 2, wc = wid & 3, fr = lane & 15, fq = lane >> 4;
    const int K = g.K, nt = K / BK;
    unsigned voffA[2], voffB[2];
#pragma unroll
    for (int i = 0; i < 2; ++i) { int R, C; stage_rc(tid * 16 + i * 8192, R, C); const int Rb = Epi::PERM ? ((R & ~31) + perm32(R & 31)) : R;
        voffA[i] = (unsigned)(R * K + C) * 2u; voffB[i] = (unsigned)(Rb * K + C) * 2u; }
    const size_t kstep = (size_t)(BK * 2);
    const size_t hstep = (size_t)HALF * K * 2;
    const size_t tstep = 2 * hstep;
    const unsigned ldsw = (unsigned)wid * 1024u;
    const int aoff = lds_byte(wr * 64 + fr, fq * 8), boff = lds_byte(wc * 32 + fr, fq * 8);
#define PG8_SA(b, h) (((b) * 2 + (h)) * HTB)
#define PG8_SB(b, h) ((4 + (b) * 2 + (h)) * HTB)
#define PG8_STAGE(bufoff, gbase, voff) do { _Pragma("unroll") for (int _i = 0; _i < 2; ++_i) \
        __builtin_amdgcn_global_load_lds((const unsigned*)((const char*)(gbase) + (voff)[_i]), (PG8_LAS unsigned*)(lds + (bufoff) + ldsw + _i * 8192), 16, 0, 0); } while (0)
#define PG8_LDA(dst, b, h) do { _Pragma("unroll") for (int m = 0; m < 4; ++m) _Pragma("unroll") for (int k = 0; k < 2; ++k) dst[m][k] = *(const PG8_LAS bf16x8*)(lds + PG8_SA(b, h) + aoff + m * 2048 + k * 1024); } while (0)
#define PG8_LDB(dst, b, h) do { _Pragma("unroll") for (int n = 0; n < 2; ++n) _Pragma("unroll") for (int k = 0; k < 2; ++k) dst[n][k] = *(const PG8_LAS bf16x8*)(lds + PG8_SB(b, h) + boff + n * 2048 + k * 1024); } while (0)
#define PG8_MMA(ai, bj, At, Bt) do { __builtin_amdgcn_s_setprio(1); _Pragma("unroll") for (int m = 0; m < 4; ++m) _Pragma("unroll") for (int n = 0; n < 2; ++n) _Pragma("unroll") for (int k = 0; k < 2; ++k) \
        acc[ai][bj][m][n] = __builtin_amdgcn_mfma_f32_16x16x32_bf16(Bt[n][k], At[m][k], acc[ai][bj][m][n], 0, 0, 0); __builtin_amdgcn_s_setprio(0); } while (0)
#define PG8_WAIT_V(n) asm volatile("s_waitcnt vmcnt(" #n ")" ::: "memory")
#define PG8_WAIT_L(n) asm volatile("s_waitcnt lgkmcnt(" #n ")" ::: "memory")
#define PG8_BAR __builtin_amdgcn_s_barrier()
#define PG8_SCHED __builtin_amdgcn_sched_barrier(0)
    Unit cur, nxt; int ui = 0;
    if (!S.next(0, cur)) return;
    f32x4 acc[2][2][4][2];
#pragma unroll
    for (int a = 0; a < 2; ++a)
#pragma unroll
        for (int b = 0; b < 2; ++b)
#pragma unroll
            for (int m = 0; m < 4; ++m)
#pragma unroll
                for (int n = 0; n < 2; ++n) acc[a][b][m][n] = (f32x4){0.f, 0.f, 0.f, 0.f};
    bf16x8 At[4][2], B0[2][2], B1[2][2];
    const char* cA = (const char*)g.A + (size_t)cur.pm * tstep; const char* cB = (const char*)g.Bt + (size_t)cur.pn * tstep;
    S.a_ready(cur);
    if constexpr (SP2) {
        PG8_STAGE(PG8_SB(0, 0), cB, voffB); PG8_STAGE(PG8_SB(0, 1), cB + hstep, voffB); PG8_STAGE(PG8_SA(0, 0), cA, voffA); PG8_STAGE(PG8_SA(0, 1), cA + hstep, voffA);
        if (wr == 1) PG8_BAR;
        PG8_WAIT_V(2); PG8_BAR;
        PG8_STAGE(PG8_SB(1, 0), cB + kstep, voffB); PG8_STAGE(PG8_SA(1, 0), cA + kstep, voffA); PG8_STAGE(PG8_SB(1, 1), cB + hstep + kstep, voffB);
        PG8_WAIT_V(6); PG8_BAR;
    } else {
        PG8_STAGE(PG8_SB(0, 0), cB, voffB); PG8_STAGE(PG8_SA(0, 0), cA, voffA); PG8_STAGE(PG8_SB(0, 1), cB + hstep, voffB); PG8_STAGE(PG8_SA(0, 1), cA + hstep, voffA);
        if (wr == 1) PG8_BAR;
        PG8_WAIT_V(4); PG8_BAR;
        PG8_STAGE(PG8_SB(1, 0), cB + kstep, voffB); PG8_STAGE(PG8_SA(1, 0), cA + kstep, voffA); PG8_STAGE(PG8_SB(1, 1), cB + hstep + kstep, voffB);
        PG8_WAIT_V(6); PG8_BAR;
    }
    for (;;) {
        const bool has_next = S.next(ui + 1, nxt);
        const char* nA = has_next ? (const char*)g.A + (size_t)nxt.pm * tstep : cA; const char* nB = has_next ? (const char*)g.Bt + (size_t)nxt.pn * tstep : cB;
        for (int t = 0; t < nt; t += 2) {
            const bool last = (t == nt - 2);
            const char* a1 = cA + (size_t)(t + 1) * kstep;
            const char* a2 = last ? nA : cA + (size_t)(t + 2) * kstep; const char* b2 = last ? nB : cB + (size_t)(t + 2) * kstep;
            const char* a3 = a2 + kstep; const char* b3 = b2 + kstep;
            if (last && has_next) S.a_ready(nxt);
            if constexpr (SP2) {
            PG8_LDB(B0, 0, 0); PG8_LDB(B1, 0, 1); PG8_SCHED; PG8_LDA(At, 0, 0); PG8_STAGE(PG8_SA(1, 1), a1 + hstep, voffA);
            PG8_WAIT_V(8); PG8_WAIT_L(0); PG8_BAR; PG8_MMA(0, 0, At, B0); PG8_MMA(0, 1, At, B1); PG8_BAR; PG8_SCHED;
            PG8_LDA(At, 0, 1); PG8_STAGE(PG8_SB(0, 0), b2, voffB); PG8_STAGE(PG8_SB(0, 1), b2 + hstep, voffB); PG8_STAGE(PG8_SA(0, 0), a2, voffA);
            PG8_WAIT_V(8); PG8_WAIT_L(0); PG8_BAR; PG8_MMA(1, 0, At, B0); PG8_MMA(1, 1, At, B1); PG8_BAR; PG8_SCHED;
            PG8_LDB(B0, 1, 0); PG8_LDB(B1, 1, 1); PG8_SCHED; PG8_LDA(At, 1, 0); PG8_STAGE(PG8_SA(0, 1), a2 + hstep, voffA);
            PG8_WAIT_V(8); PG8_WAIT_L(0); PG8_BAR; PG8_MMA(0, 0, At, B0); PG8_MMA(0, 1, At, B1); PG8_BAR; PG8_SCHED;
            PG8_LDA(At, 1, 1); PG8_STAGE(PG8_SB(1, 0), b3, voffB); PG8_STAGE(PG8_SB(1, 1), b3 + hstep, voffB); PG8_STAGE(PG8_SA(1, 0), a3, voffA);
            PG8_WAIT_V(8); PG8_WAIT_L(0); PG8_BAR; PG8_MMA(1, 0, At, B0); PG8_MMA(1, 1, At, B1); PG8_BAR; PG8_SCHED;
            } else {
            PG8_LDB(B0, 0, 0); PG8_SCHED; PG8_LDA(At, 0, 0); PG8_STAGE(PG8_SA(1, 1), a1 + hstep, voffA);
            PG8_WAIT_L(8); PG8_BAR; PG8_WAIT_L(0); PG8_MMA(0, 0, At, B0); PG8_BAR; PG8_SCHED;
            PG8_LDB(B1, 0, 1); PG8_STAGE(PG8_SB(0, 0), b2, voffB);
            PG8_BAR; PG8_WAIT_L(0); PG8_MMA(0, 1, At, B1); PG8_BAR;
            PG8_LDA(At, 0, 1); PG8_STAGE(PG8_SA(0, 0), a2, voffA);
            PG8_BAR; PG8_WAIT_L(0); PG8_MMA(1, 0, At, B0); PG8_BAR; PG8_SCHED;
            PG8_STAGE(PG8_SB(0, 1), b2 + hstep, voffB);
            PG8_WAIT_V(6); PG8_BAR; PG8_MMA(1, 1, At, B1); PG8_BAR;
            PG8_LDB(B0, 1, 0); PG8_SCHED; PG8_LDA(At, 1, 0); PG8_STAGE(PG8_SA(0, 1), a2 + hstep, voffA);
            PG8_WAIT_L(8); PG8_BAR; PG8_WAIT_L(0); PG8_MMA(0, 0, At, B0); PG8_BAR; PG8_SCHED;
            PG8_LDB(B1, 1, 1); PG8_STAGE(PG8_SB(1, 0), b3, voffB);
            PG8_BAR; PG8_WAIT_L(0); PG8_MMA(0, 1, At, B1); PG8_BAR;
            PG8_LDA(At, 1, 1); PG8_STAGE(PG8_SA(1, 0), a3, voffA);
            PG8_BAR; PG8_WAIT_L(0); PG8_MMA(1, 0, At, B0); PG8_BAR; PG8_SCHED;
            PG8_STAGE(PG8_SB(1, 1), b3 + hstep, voffB);
            PG8_WAIT_V(6); PG8_BAR; PG8_MMA(1, 1, At, B1); PG8_BAR;
            }
        }
        if constexpr (ALIGN_EPI) { if (wr == 0) PG8_BAR; }
        if constexpr (!Epi::AFTER_DRAIN) { E(acc, cur, wr, wc, fr, fq); S.done(cur); }
        if (!has_next) break;
#pragma unroll
        for (int a = 0; a < 2; ++a)
#pragma unroll
            for (int b = 0; b < 2; ++b)
#pragma unroll
                for (int m = 0; m < 4; ++m)
#pragma unroll
                    for (int n = 0; n < 2; ++n) acc[a][b][m][n] = (f32x4){0.f, 0.f, 0.f, 0.f};
        cur = nxt; cA = nA; cB = nB; ++ui;
        if constexpr (ALIGN_EPI) { if (wr == 1) PG8_BAR; }
    }
    PG8_WAIT_V(0);
    if constexpr (!ALIGN_EPI) { if (wr == 0) PG8_BAR; }
    PG8_BAR;
    if constexpr (Epi::AFTER_DRAIN) { E.fused(acc, cur, wr, wc, fr, fq, lds, wid, lane); S.done(cur); }
#undef PG8_SA
#undef PG8_SB
#undef PG8_STAGE
#undef PG8_LDA
#undef PG8_LDB
#undef PG8_MMA
#undef PG8_WAIT_V
#undef PG8_WAIT_L
#undef PG8_BAR
#undef PG8_SCHED
}

template <class Epi, class Sched, bool ALIGN_EPI = false, bool SP2 = false>
__device__ __forceinline__ void gemm_phase_g(PG8_LAS unsigned char* lds, const Gemm g, const Sched& S, const Epi& E, const PG8_LAS unsigned* rowtab) {
    const int tid = threadIdx.x, wid = __builtin_amdgcn_readfirstlane(tid >> 6), lane = tid & 63, wr = wid >> 2, wc = wid & 3, fr = lane & 15, fq = lane >> 4;
    const int K = g.K, nt = K / BK;
    unsigned voffA[2], voffB[2]; int RA[2]; unsigned CA2[2];
#pragma unroll
    for (int i = 0; i < 2; ++i) { int R, C; stage_rc(tid * 16 + i * 8192, R, C); const int Rb = Epi::PERM ? ((R & ~31) + perm32(R & 31)) : R;
        voffA[i] = (unsigned)(R * K + C) * 2u; voffB[i] = (unsigned)(Rb * K + C) * 2u; RA[i] = R; CA2[i] = (unsigned)C * 2u; }
    unsigned vA0[2], vA1[2], nvA0[2], nvA1[2];
#pragma unroll
    for (int i = 0; i < 2; ++i) { vA0[i] = rowtab[RA[i]] + CA2[i]; vA1[i] = rowtab[128 + RA[i]] + CA2[i]; nvA0[i] = vA0[i]; nvA1[i] = vA1[i]; }
    const size_t kstep = (size_t)(BK * 2);
    const size_t hstep = (size_t)HALF * K * 2;
    const size_t tstep = 2 * hstep;
    const unsigned ldsw = (unsigned)wid * 1024u;
    const int aoff = lds_byte(wr * 64 + fr, fq * 8), boff = lds_byte(wc * 32 + fr, fq * 8);
#define PG8_SA(b, h) (((b) * 2 + (h)) * HTB)
#define PG8_SB(b, h) ((4 + (b) * 2 + (h)) * HTB)
#define PG8_STAGE(bufoff, gbase, voff) do { _Pragma("unroll") for (int _i = 0; _i < 2; ++_i) \
        __builtin_amdgcn_global_load_lds((const unsigned*)((const char*)(gbase) + (voff)[_i]), (PG8_LAS unsigned*)(lds + (bufoff) + ldsw + _i * 8192), 16, 0, 0); } while (0)
#define PG8_LDA(dst, b, h) do { _Pragma("unroll") for (int m = 0; m < 4; ++m) _Pragma("unroll") for (int k = 0; k < 2; ++k) dst[m][k] = *(const PG8_LAS bf16x8*)(lds + PG8_SA(b, h) + aoff + m * 2048 + k * 1024); } while (0)
#define PG8_LDB(dst, b, h) do { _Pragma("unroll") for (int n = 0; n < 2; ++n) _Pragma("unroll") for (int k = 0; k < 2; ++k) dst[n][k] = *(const PG8_LAS bf16x8*)(lds + PG8_SB(b, h) + boff + n * 2048 + k * 1024); } while (0)
#define PG8_MMA(ai, bj, At, Bt) do { __builtin_amdgcn_s_setprio(1); _Pragma("unroll") for (int m = 0; m < 4; ++m) _Pragma("unroll") for (int n = 0; n < 2; ++n) _Pragma("unroll") for (int k = 0; k < 2; ++k) \
        acc[ai][bj][m][n] = __builtin_amdgcn_mfma_f32_16x16x32_bf16(Bt[n][k], At[m][k], acc[ai][bj][m][n], 0, 0, 0); __builtin_amdgcn_s_setprio(0); } while (0)
#define PG8_WAIT_V(n) asm volatile("s_waitcnt vmcnt(" #n ")" ::: "memory")
#define PG8_WAIT_L(n) asm volatile("s_waitcnt lgkmcnt(" #n ")" ::: "memory")
#define PG8_BAR __builtin_amdgcn_s_barrier()
#define PG8_SCHED __builtin_amdgcn_sched_barrier(0)
    Unit cur, nxt; int ui = 0;
    if (!S.next(0, cur)) return;
    f32x4 acc[2][2][4][2];
#pragma unroll
    for (int a = 0; a < 2; ++a)
#pragma unroll
        for (int b = 0; b < 2; ++b)
#pragma unroll
            for (int m = 0; m < 4; ++m)
#pragma unroll
                for (int n = 0; n < 2; ++n) acc[a][b][m][n] = (f32x4){0.f, 0.f, 0.f, 0.f};
    bf16x8 At[4][2], B0[2][2], B1[2][2];
    const char* cA = (const char*)g.A; const char* cB = (const char*)g.Bt + (size_t)cur.pn * tstep;
    S.a_ready(cur);
    if constexpr (SP2) {
        PG8_STAGE(PG8_SB(0, 0), cB, voffB); PG8_STAGE(PG8_SB(0, 1), cB + hstep, voffB); PG8_STAGE(PG8_SA(0, 0), cA, vA0); PG8_STAGE(PG8_SA(0, 1), cA, vA1);
        if (wr == 1) PG8_BAR;
        PG8_WAIT_V(2); PG8_BAR;
        PG8_STAGE(PG8_SB(1, 0), cB + kstep, voffB); PG8_STAGE(PG8_SA(1, 0), cA + kstep, vA0); PG8_STAGE(PG8_SB(1, 1), cB + hstep + kstep, voffB);
        PG8_WAIT_V(6); PG8_BAR;
    } else {
        PG8_STAGE(PG8_SB(0, 0), cB, voffB); PG8_STAGE(PG8_SA(0, 0), cA, vA0); PG8_STAGE(PG8_SB(0, 1), cB + hstep, voffB); PG8_STAGE(PG8_SA(0, 1), cA, vA1);
        if (wr == 1) PG8_BAR;
        PG8_WAIT_V(4); PG8_BAR;
        PG8_STAGE(PG8_SB(1, 0), cB + kstep, voffB); PG8_STAGE(PG8_SA(1, 0), cA + kstep, vA0); PG8_STAGE(PG8_SB(1, 1), cB + hstep + kstep, voffB);
        PG8_WAIT_V(6); PG8_BAR;
    }
    for (;;) {
        const bool has_next = S.next(ui + 1, nxt);
        if (has_next) {
#pragma unroll
            for (int i = 0; i < 2; ++i) { nvA0[i] = rowtab[(ui + 1) * 256 + RA[i]] + CA2[i]; nvA1[i] = rowtab[(ui + 1) * 256 + 128 + RA[i]] + CA2[i]; }
        }
        const char* nA = cA; const char* nB = has_next ? (const char*)g.Bt + (size_t)nxt.pn * tstep : cB;
        for (int t = 0; t < nt; t += 2) {
            const bool last = (t == nt - 2);
            unsigned sA0[2], sA1[2];
#pragma unroll
            for (int i = 0; i < 2; ++i) { sA0[i] = last ? nvA0[i] : vA0[i]; sA1[i] = last ? nvA1[i] : vA1[i]; }
            const char* a1 = cA + (size_t)(t + 1) * kstep;
            const char* a2 = last ? nA : cA + (size_t)(t + 2) * kstep; const char* b2 = last ? nB : cB + (size_t)(t + 2) * kstep;
            const char* a3 = a2 + kstep; const char* b3 = b2 + kstep;
            if (last && has_next) S.a_ready(nxt);
            if constexpr (SP2) {
            PG8_LDB(B0, 0, 0); PG8_LDB(B1, 0, 1); PG8_SCHED; PG8_LDA(At, 0, 0); PG8_STAGE(PG8_SA(1, 1), a1, vA1);
            PG8_WAIT_V(8); PG8_WAIT_L(0); PG8_BAR; PG8_MMA(0, 0, At, B0); PG8_MMA(0, 1, At, B1); PG8_BAR; PG8_SCHED;
            PG8_LDA(At, 0, 1); PG8_STAGE(PG8_SB(0, 0), b2, voffB); PG8_STAGE(PG8_SB(0, 1), b2 + hstep, voffB); PG8_STAGE(PG8_SA(0, 0), a2, sA0);
            PG8_WAIT_V(8); PG8_WAIT_L(0); PG8_BAR; PG8_MMA(1, 0, At, B0); PG8_MMA(1, 1, At, B1); PG8_BAR; PG8_SCHED;
            PG8_LDB(B0, 1, 0); PG8_LDB(B1, 1, 1); PG8_SCHED; PG8_LDA(At, 1, 0); PG8_STAGE(PG8_SA(0, 1), a2, sA1);
            PG8_WAIT_V(8); PG8_WAIT_L(0); PG8_BAR; PG8_MMA(0, 0, At, B0); PG8_MMA(0, 1, At, B1); PG8_BAR; PG8_SCHED;
            PG8_LDA(At, 1, 1); PG8_STAGE(PG8_SB(1, 0), b3, voffB); PG8_STAGE(PG8_SB(1, 1), b3 + hstep, voffB); PG8_STAGE(PG8_SA(1, 0), a3, sA0);
            PG8_WAIT_V(8); PG8_WAIT_L(0); PG8_BAR; PG8_MMA(1, 0, At, B0); PG8_MMA(1, 1, At, B1); PG8_BAR; PG8_SCHED;
            } else {
            PG8_LDB(B0, 0, 0); PG8_SCHED; PG8_LDA(At, 0, 0); PG8_STAGE(PG8_SA(1, 1), a1, vA1);
            PG8_WAIT_L(8); PG8_BAR; PG8_WAIT_L(0); PG8_MMA(0, 0, At, B0); PG8_BAR; PG8_SCHED;
            PG8_LDB(B1, 0, 1); PG8_STAGE(PG8_SB(0, 0), b2, voffB);
            PG8_BAR; PG8_WAIT_L(0); PG8_MMA(0, 1, At, B1); PG8_BAR;
            PG8_LDA(At, 0, 1); PG8_STAGE(PG8_SA(0, 0), a2, sA0);
            PG8_BAR; PG8_WAIT_L(0); PG8_MMA(1, 0, At, B0); PG8_BAR; PG8_SCHED;
            PG8_STAGE(PG8_SB(0, 1), b2 + hstep, voffB);
            PG8_WAIT_V(6); PG8_BAR; PG8_MMA(1, 1, At, B1); PG8_BAR;
            PG8_LDB(B0, 1, 0); PG8_SCHED; PG8_LDA(At, 1, 0); PG8_STAGE(PG8_SA(0, 1), a2, sA1);
            PG8_WAIT_L(8); PG8_BAR; PG8_WAIT_L(0); PG8_MMA(0, 0, At, B0); PG8_BAR; PG8_SCHED;
            PG8_LDB(B1, 1, 1); PG8_STAGE(PG8_SB(1, 0), b3, voffB);
            PG8_BAR; PG8_WAIT_L(0); PG8_MMA(0, 1, At, B1); PG8_BAR;
            PG8_LDA(At, 1, 1); PG8_STAGE(PG8_SA(1, 0), a3, sA0);
            PG8_BAR; PG8_WAIT_L(0); PG8_MMA(1, 0, At, B0); PG8_BAR; PG8_SCHED;
            PG8_STAGE(PG8_SB(1, 1), b3 + hstep, voffB);
            PG8_WAIT_V(6); PG8_BAR; PG8_MMA(1, 1, At, B1); PG8_BAR;
            }
        }
        if constexpr (ALIGN_EPI) { if (wr == 0) PG8_BAR; }
        if constexpr (!Epi::AFTER_DRAIN) { E(acc, cur, wr, wc, fr, fq); S.done(cur); }
        if (!has_next) break;
#pragma unroll
        for (int a = 0; a < 2; ++a)
#pragma unroll
            for (int b = 0; b < 2; ++b)
#pragma unroll
                for (int m = 0; m < 4; ++m)
#pragma unroll
                    for (int n = 0; n < 2; ++n) acc[a][b][m][n] = (f32x4){0.f, 0.f, 0.f, 0.f};
        cur = nxt; cA = nA; cB = nB; ++ui;
#pragma unroll
        for (int i = 0; i < 2; ++i) { vA0[i] = nvA0[i]; vA1[i] = nvA1[i]; }
        if constexpr (ALIGN_EPI) { if (wr == 1) PG8_BAR; }
    }
    PG8_WAIT_V(0);
    if constexpr (!ALIGN_EPI) { if (wr == 0) PG8_BAR; }
    PG8_BAR;
    if constexpr (Epi::AFTER_DRAIN) { E.fused(acc, cur, wr, wc, fr, fq, lds, wid, lane); S.done(cur); }
#undef PG8_SA
#undef PG8_SB
#undef PG8_STAGE
#undef PG8_LDA
#undef PG8_LDB
#undef PG8_MMA
#undef PG8_WAIT_V
#undef PG8_WAIT_L
#undef PG8_BAR
#undef PG8_SCHED
}

struct EpiBf16 {
    static constexpr bool PERM = true, AFTER_DRAIN = false;
    bf16_t* O; int ldc; int npn;
    __device__ __forceinline__ void operator()(const f32x4 (&acc)[2][2][4][2], const Unit& u, int wr, int wc, int fr, int fq) const {
        const int row0 = u.pm * BM + wr * 64 + fr, col0 = (u.pn % npn) * BM + wc * 32 + 8 * fq;
#pragma unroll
        for (int ai = 0; ai < 2; ++ai)
#pragma unroll
            for (int m = 0; m < 4; ++m) { bf16_t* rowp = O + (size_t)(row0 + ai * HALF + m * 16) * ldc + col0;
#pragma unroll
                for (int bj = 0; bj < 2; ++bj) { const f32x4 v0 = acc[ai][bj][m][0], v1 = acc[ai][bj][m][1];
                    u32x4 w; w.x = cvt_pk_bf16(v0[0], v0[1]); w.y = cvt_pk_bf16(v0[2], v0[3]); w.z = cvt_pk_bf16(v1[0], v1[1]); w.w = cvt_pk_bf16(v1[2], v1[3]);
                    *(u32x4*)(rowp + bj * HALF) = w; } }
    }
};
struct EpiY8 {
    static constexpr bool PERM = true, AFTER_DRAIN = false;
    unsigned char* O; int ldc; int npn;
    __device__ __forceinline__ void operator()(const f32x4 (&acc)[2][2][4][2], const Unit& u, int wr, int wc, int fr, int fq) const {
        typedef unsigned u32x2v __attribute__((ext_vector_type(2)));
        const int row0 = u.pm * BM + wr * 64 + fr, col0 = (u.pn % npn) * BM + wc * 32 + 8 * fq;
#pragma unroll
        for (int ai = 0; ai < 2; ++ai)
#pragma unroll
            for (int m = 0; m < 4; ++m) { unsigned char* rowp = O + (size_t)(row0 + ai * HALF + m * 16) * ldc + col0;
#pragma unroll
                for (int bj = 0; bj < 2; ++bj) { const f32x4 v0 = acc[ai][bj][m][0] * 16.f, v1 = acc[ai][bj][m][1] * 16.f;
                    int a = 0, b = 0;
                    a = __builtin_amdgcn_cvt_pk_fp8_f32(v0[0], v0[1], a, false); a = __builtin_amdgcn_cvt_pk_fp8_f32(v0[2], v0[3], a, true);
                    b = __builtin_amdgcn_cvt_pk_fp8_f32(v1[0], v1[1], b, false); b = __builtin_amdgcn_cvt_pk_fp8_f32(v1[2], v1[3], b, true);
                    *(u32x2v*)(rowp + bj * HALF) = (u32x2v){(unsigned)a, (unsigned)b}; } }
    }
};
struct EpiKV {
    static constexpr bool PERM = true, AFTER_DRAIN = false;
    bf16_t* kmem; bf16_t* vmemT;
    __device__ __forceinline__ void operator()(const f32x4 (&acc)[2][2][4][2], const Unit& u, int wr, int wc, int fr, int fq) const {
        const int row0 = u.pm * BM + wr * 64 + fr, col0 = u.pn * BM + wc * 32 + 8 * fq;
#pragma unroll
        for (int ai = 0; ai < 2; ++ai)
#pragma unroll
            for (int m = 0; m < 4; ++m) { const int row = row0 + ai * HALF + m * 16;
#pragma unroll
                for (int bj = 0; bj < 2; ++bj) { const f32x4 v0 = acc[ai][bj][m][0], v1 = acc[ai][bj][m][1]; const int col = col0 + bj * HALF;
                    if (col < 512) { u32x4 w; w.x = cvt_pk_bf16(v0[0], v0[1]); w.y = cvt_pk_bf16(v0[2], v0[3]); w.z = cvt_pk_bf16(v1[0], v1[1]); w.w = cvt_pk_bf16(v1[2], v1[3]);
                        *(u32x4*)(kmem + (size_t)row * 512 + col) = w; }
                    else { const int c2 = col - 512, hx = c2 >> 7, d = c2 & 127, b = row >> 8, key = row & 255;
                        bf16_t* vp = vmemT + (((size_t)b * 4 + hx) * 128 + d) * 256 + key;
                        const unsigned w0 = cvt_pk_bf16(v0[0], v0[1]), w1 = cvt_pk_bf16(v0[2], v0[3]), w2 = cvt_pk_bf16(v1[0], v1[1]), w3 = cvt_pk_bf16(v1[2], v1[3]);
                        vp[0 * 256] = (bf16_t)(w0 & 0xffffu); vp[1 * 256] = (bf16_t)(w0 >> 16); vp[2 * 256] = (bf16_t)(w1 & 0xffffu); vp[3 * 256] = (bf16_t)(w1 >> 16);
                        vp[4 * 256] = (bf16_t)(w2 & 0xffffu); vp[5 * 256] = (bf16_t)(w2 >> 16); vp[6 * 256] = (bf16_t)(w3 & 0xffffu); vp[7 * 256] = (bf16_t)(w3 >> 16); } } }
    }
};
template <bool XF32, bool STATS> struct EpiResid {
    static constexpr bool PERM = true, AFTER_DRAIN = false;
    const void* xin; bf16_t* xb; float* ssq;
    __device__ __forceinline__ void operator()(const f32x4 (&acc)[2][2][4][2], const Unit& u, int wr, int wc, int fr, int fq) const {
        const int col0 = u.pn * BM + wc * 32 + 8 * fq;
#pragma unroll
        for (int ai = 0; ai < 2; ++ai) {
            const size_t rowb = (size_t)(u.pm * BM + ai * HALF + wr * 64 + fr);
            f32x4 pf[4][2][2]; u32x4 pb[4][2];
#pragma unroll
            for (int m = 0; m < 4; ++m)
#pragma unroll
                for (int bj = 0; bj < 2; ++bj) { const size_t off = (rowb + m * 16) * 1024 + col0 + bj * HALF;
                    if (XF32) { pf[m][bj][0] = *(const f32x4*)((const float*)xin + off); pf[m][bj][1] = *(const f32x4*)((const float*)xin + off + 4); }
                    else pb[m][bj] = *(const u32x4*)((const bf16_t*)xin + off); }
#pragma unroll
            for (int m = 0; m < 4; ++m) { const size_t row = rowb + m * 16;
                float q = 0.f;
#pragma unroll
                for (int bj = 0; bj < 2; ++bj) { const size_t off = row * 1024 + col0 + bj * HALF;
                    f32x4 b0, b1;
                    if (XF32) { b0 = pf[m][bj][0]; b1 = pf[m][bj][1]; }
                    else { const u32x4 t = pb[m][bj];
                        b0[0] = __uint_as_float(t.x << 16); b0[1] = __uint_as_float(t.x & 0xffff0000u); b0[2] = __uint_as_float(t.y << 16); b0[3] = __uint_as_float(t.y & 0xffff0000u);
                        b1[0] = __uint_as_float(t.z << 16); b1[1] = __uint_as_float(t.z & 0xffff0000u); b1[2] = __uint_as_float(t.w << 16); b1[3] = __uint_as_float(t.w & 0xffff0000u); }
                    const f32x4 o0 = b0 + acc[ai][bj][m][0], o1 = b1 + acc[ai][bj][m][1];
                    u32x4 w; w.x = cvt_pk_bf16(o0[0], o0[1]); w.y = cvt_pk_bf16(o0[2], o0[3]); w.z = cvt_pk_bf16(o1[0], o1[1]); w.w = cvt_pk_bf16(o1[2], o1[3]);
                    *(u32x4*)(xb + off) = w;
                    if (STATS) q += ((o0[0] * o0[0] + o0[1] * o0[1]) + (o0[2] * o0[2] + o0[3] * o0[3])) + ((o1[0] * o1[0] + o1[1] * o1[1]) + (o1[2] * o1[2] + o1[3] * o1[3])); }
                if (STATS) { q += __shfl_xor(q, 16); q += __shfl_xor(q, 32); if (fq == 0) ssq[row * 16 + u.pn * 4 + wc] = q; } }
            asm volatile("" ::: "memory"); }
    }
};
struct EpiQ {
    static constexpr bool PERM = true, AFTER_DRAIN = false;
    bf16_t* O; const float* ssq;
    __device__ __forceinline__ void operator()(const f32x4 (&acc)[2][2][4][2], const Unit& u, int wr, int wc, int fr, int fq) const {
        const int row0 = u.pm * BM + wr * 64 + fr, col0 = u.pn * BM + wc * 32 + 8 * fq;
#pragma unroll
        for (int ai = 0; ai < 2; ++ai)
#pragma unroll
            for (int m = 0; m < 4; ++m) { const size_t row = (size_t)(row0 + ai * HALF + m * 16);
                const f32x4* sp = (const f32x4*)(ssq + row * 16); const f32x4 s0 = sp[0], s1 = sp[1], s2 = sp[2], s3 = sp[3];
                const float s = ((s0[0] + s0[1]) + (s0[2] + s0[3])) + ((s1[0] + s1[1]) + (s1[2] + s1[3])) + ((s2[0] + s2[1]) + (s2[2] + s2[3])) + ((s3[0] + s3[1]) + (s3[2] + s3[3]));
                const float rs = 1.f / sqrtf(s * (1.f / 1024.f) + 1e-5f);
                bf16_t* rowp = O + row * 512 + col0;
#pragma unroll
                for (int bj = 0; bj < 2; ++bj) { const f32x4 v0 = acc[ai][bj][m][0] * rs, v1 = acc[ai][bj][m][1] * rs;
                    u32x4 w; w.x = cvt_pk_bf16(v0[0], v0[1]); w.y = cvt_pk_bf16(v0[2], v0[3]); w.z = cvt_pk_bf16(v1[0], v1[1]); w.w = cvt_pk_bf16(v1[2], v1[3]);
                    *(u32x4*)(rowp + bj * HALF) = w; } }
    }
};
struct EpiGU {
    static constexpr bool PERM = true, AFTER_DRAIN = false;
    bf16_t* hid; const PG8_LAS float* rstab; int G, c;
    __device__ __forceinline__ void operator()(const f32x4 (&acc)[2][2][4][2], const Unit& u, int wr, int wc, int fr, int fq) const {
        const int row0 = u.pm * BM + wr * 64 + fr, j0 = (u.pn & 1) * 128 + wc * 16 + 4 * fq;
        const int ui = (u.pm * 2 + (u.pn & 1) - c) / G;
#pragma unroll
        for (int ai = 0; ai < 2; ++ai)
#pragma unroll
            for (int m = 0; m < 4; ++m) { bf16_t* rowp = hid + (size_t)(row0 + ai * HALF + m * 16) * 256 + j0;
                const float rs = rstab[ui * 256 + ai * HALF + wr * 64 + m * 16 + fr];
#pragma unroll
                for (int bj = 0; bj < 2; ++bj) { const f32x4 v0 = acc[ai][bj][m][0] * rs, v1 = acc[ai][bj][m][1] * rs;
                    const float h0 = v0[0] * __builtin_amdgcn_rcpf(1.f + __expf(-v0[0])) * v0[1], h1 = v0[2] * __builtin_amdgcn_rcpf(1.f + __expf(-v0[2])) * v0[3];
                    const float h2 = v1[0] * __builtin_amdgcn_rcpf(1.f + __expf(-v1[0])) * v1[1], h3 = v1[2] * __builtin_amdgcn_rcpf(1.f + __expf(-v1[2])) * v1[3];
                    typedef unsigned u32x2v __attribute__((ext_vector_type(2))); u32x2v w; w.x = cvt_pk_bf16(h0, h1); w.y = cvt_pk_bf16(h2, h3);
                    *(u32x2v*)(rowp + bj * 64) = w; } }
    }
};
struct SubOrder {
    int nM, nN, nwg, span, c;
    __device__ void init(int M, int N, int span_, int c_) { nM = M / BM; nN = N / BM; nwg = nM * nN; span = span_; c = c_; }
    __device__ bool next(int i, Unit& u) const { if (c < 0 || c >= span) return false; const int L = i * span + c; if (L >= nwg) return false; u.pm = L / nN; u.pn = L % nN; return true; }
    __device__ __forceinline__ void a_ready(const Unit&) const {}
    __device__ __forceinline__ void done(const Unit&) const {}
};
struct MoeOrder {
    const PG8_LAS int* tile_e; int nrt, npn, G, c;
    __device__ bool next(int i, Unit& u) const { const int L = i * G + c; if (L >= nrt * npn) return false; const int rt = L / npn, pnl = L % npn; u.pm = rt; u.pn = tile_e[rt] * npn + pnl; return true; }
    __device__ __forceinline__ void a_ready(const Unit&) const {}
    __device__ __forceinline__ void done(const Unit&) const {}
};
}

#define LAS __attribute__((address_space(3)))
#define XB_TMO      128
#define XB_XCNT(j)  (256  + 64 * (j))
#define XB_XSUB(j)  (1280 + 64 * (j))
#define XB_XGEN(j)  (2304 + 64 * (j))
#define XB_TOP      3328
#define XB_TOPGEN   3392
#define XCD_BAR_WORDS 3456
#define XB_SPIN_CAP (1u << 18)

__device__ __forceinline__ unsigned xb_ld(unsigned* p)              { return __hip_atomic_load(p, __ATOMIC_RELAXED, __HIP_MEMORY_SCOPE_AGENT); }
__device__ __forceinline__ unsigned xb_add(unsigned* p, unsigned v) { return __hip_atomic_fetch_add(p, v, __ATOMIC_RELAXED, __HIP_MEMORY_SCOPE_AGENT); }
__device__ __forceinline__ unsigned xb_xcc_id() { return (unsigned)__builtin_amdgcn_s_getreg((3 << 11) | 20) & 0xFu; }
#define XB_SPIN(cond, bar) do { unsigned _sp = 0; while (cond) { __builtin_amdgcn_s_sleep(1); \
    if ((++_sp & 255u) == 0u) { if (xb_ld(&(bar)[XB_TMO])) break; if (_sp > XB_SPIN_CAP) { atomicAdd(&(bar)[XB_TMO], 1u); break; } } } } while (0)

struct XcdBarrier {
    unsigned* bar; unsigned x;
    volatile LAS unsigned* st;
};

__device__ __forceinline__ XcdBarrier xcd_barrier_post(unsigned* bar, volatile LAS unsigned* st) {
    XcdBarrier b; b.bar = bar; b.x = xb_xcc_id(); b.st = st;
    if (threadIdx.x == 0) (void)xb_add(&bar[XB_XCNT(b.x)], 1u);
    return b;
}
__device__ __forceinline__ void xcd_barrier_complete(unsigned* bar, unsigned x, unsigned& nloc, unsigned& nx) {
    const unsigned G = gridDim.x * gridDim.y * gridDim.z;
    unsigned sum, cnt, mine, sp = 0u;
    for (;;) {
        sum = 0u; cnt = 0u; mine = 0u;
#pragma unroll
        for (unsigned j = 0; j < 16; ++j) { const unsigned c = xb_ld(&bar[XB_XCNT(j)]); sum += c; cnt += (c > 0u) ? 1u : 0u; mine = (j == x) ? c : mine; }
        if (sum == G) break;
        __builtin_amdgcn_s_sleep(1);
        if ((++sp & 255u) == 0u) { if (xb_ld(&bar[XB_TMO])) break; if (sp > XB_SPIN_CAP) { atomicAdd(&bar[XB_TMO], 1u); break; } }
    }
    nloc = mine > 0u ? mine : 1u; nx = cnt > 0u ? cnt : 1u;
}

__device__ __forceinline__ void xcd_barrier(const XcdBarrier& b) {
    asm volatile("s_waitcnt vmcnt(0)" ::: "memory");
    __syncthreads();
    if (threadIdx.x == 0) {
        unsigned* bar = b.bar;
        __builtin_amdgcn_s_waitcnt(0);
        unsigned nloc = b.st[0], nx = b.st[1];
        if (nloc == 0u) { xcd_barrier_complete(bar, b.x, nloc, nx); b.st[0] = nloc; b.st[1] = nx; }
        const unsigned old = xb_add(&bar[XB_XSUB(b.x)], 1u);
        const unsigned gen = old / nloc;
        if (old + 1u == (gen + 1u) * nloc) {
            __builtin_amdgcn_fence(__ATOMIC_RELEASE, "agent");
            asm volatile("s_waitcnt vmcnt(0)" ::: "memory");
            const unsigned og = xb_add(&bar[XB_TOP], 1u);
            const unsigned tg = og / nx;
            if (og + 1u == (tg + 1u) * nx) xb_add(&bar[XB_TOPGEN], 1u);
            else XB_SPIN(xb_ld(&bar[XB_TOPGEN]) == tg, bar);
            __builtin_amdgcn_fence(__ATOMIC_ACQUIRE, "agent");
            xb_add(&bar[XB_XGEN(b.x)], 1u);
            asm volatile("s_waitcnt vmcnt(0)" ::: "memory");
        } else {
            XB_SPIN(xb_ld(&bar[XB_XGEN(b.x)]) == gen, bar);
            __builtin_amdgcn_fence(__ATOMIC_ACQUIRE, "agent");
            asm volatile("s_waitcnt vmcnt(0)" ::: "memory");
        }
    }
    __syncthreads();
}

__device__ __forceinline__ void gemm128(unsigned char* lds, const bf16_t* arow, const bf16_t* brow, int K, f32x16& acc0, f32x16& acc1) {
    const int tid = opaque_tid(), lane = tid & 63, w = tid >> 6;
    bf16_t* sA = (bf16_t*)lds;
    bf16_t* sB = sA + 128 * 72;
    const int srow = tid >> 2, skc = (tid & 3) * 16;
    const bf16_t* ap = arow + skc;
    const bf16_t* bp = brow + skc;
    const int wm = w >> 1, wn = w & 1, r = lane & 31, h = lane >> 5;
    acc0 = zero16(); acc1 = zero16();
    for (int k0 = 0; k0 < K; k0 += 64) {
        const u32x4 a0 = *(const u32x4*)(ap + k0), a1 = *(const u32x4*)(ap + k0 + 8);
        const u32x4 b0 = *(const u32x4*)(bp + k0), b1 = *(const u32x4*)(bp + k0 + 8);
        __syncthreads();
        *(u32x4*)(sA + srow * 72 + skc) = a0; *(u32x4*)(sA + srow * 72 + skc + 8) = a1;
        *(u32x4*)(sB + srow * 72 + skc) = b0; *(u32x4*)(sB + srow * 72 + skc + 8) = b1;
        __syncthreads();
#pragma unroll
        for (int kk = 0; kk < 64; kk += 16) {
            const bf16x8 a = *(const bf16x8*)(sA + (wm * 32 + r) * 72 + kk + 8 * h);
            const bf16x8 bA = *(const bf16x8*)(sB + (wn * 64 + r) * 72 + kk + 8 * h);
            const bf16x8 bB = *(const bf16x8*)(sB + (wn * 64 + 32 + r) * 72 + kk + 8 * h);
            acc0 = mfma32(a, bA, acc0); acc1 = mfma32(a, bB, acc1);
        }
    }
    __syncthreads();
}

__device__ __forceinline__ void p0_transpose64(const float* W, int ldw, int K, int nblk, const float* scale, bf16_t* WT, int row_off, int row_mul, float* scr, int item, int lane) {
    const int kb = item / nblk, nb = item % nblk, k0 = 64 * kb, n0 = 64 * nb;
    f32x4 v[16];
    const float* wp = W + (size_t)(k0 + (lane >> 4)) * ldw + n0 + 4 * (lane & 15);
#pragma unroll
    for (int i = 0; i < 16; ++i) v[i] = *(const f32x4*)(wp + (size_t)(4 * i) * ldw);
#pragma unroll
    for (int i = 0; i < 16; ++i) { const int kk = (lane >> 4) + 4 * i; const float sc = scale ? scale[k0 + kk] : 1.f; float* d = scr + kk * 65 + 4 * (lane & 15);
        d[0] = v[i].x * sc; d[1] = v[i].y * sc; d[2] = v[i].z * sc; d[3] = v[i].w * sc; }
    LDS_WAIT();
    const int c = lane & 7;
#pragma unroll
    for (int j = 0; j < 8; ++j) { const int n = (lane >> 3) + 8 * j; const float* sp = scr + (8 * c) * 65 + n;
        u32x4 o; o.x = pk2(sp[0 * 65], sp[1 * 65]); o.y = pk2(sp[2 * 65], sp[3 * 65]); o.z = pk2(sp[4 * 65], sp[5 * 65]); o.w = pk2(sp[6 * 65], sp[7 * 65]);
        *(u32x4*)(WT + (size_t)(row_off + (n0 + n) * row_mul) * K + k0 + 8 * c) = o; }
    LDS_WAIT();
}

__device__ __forceinline__ void phase0(const Params& p, unsigned char* lds) {
    const int tid = opaque_tid(), lane = tid & 63, w = tid >> 6;
    unsigned char* ws = p.ws;
    const int gw = blockIdx.x * NWAVES + w, NGW = gridDim.x * NWAVES;
    {
        bf16_t* WR = (bf16_t*)(ws + WS_WR);
        const float* w3 = p.in[19]; const float* wg = p.in[20]; const float* we = p.in[22];
        for (int i = blockIdx.x * NTHREADS + tid; i < 36 * 1024; i += gridDim.x * NTHREADS) {
            const int n = i >> 10, k = i & 1023;
            float v;
            if (n >= 32) v = wg[k * 4 + (n - 32)];
            else { const int hh = (n >> 2) & 1, ii = (n & 3) + 4 * (n >> 3), e = (2 * hh + (ii >> 3)) * 8 + (ii & 7); v = we[k * 32 + e]; }
            WR[i] = (bf16_t)f2bf(v * w3[k]);
        }
    }
    {
        float* scr = (float*)lds + w * (64 * 65);
        constexpr int I_IN = 16 * 36, I_OUT = 16 * 16, I_Q = 16 * 8, I_KV = 16 * 16, I_O = 8 * 16;
        constexpr int NITEMS = I_IN + I_OUT + I_Q + I_KV + I_O;
#pragma unroll 1
        for (int it = gw; it < NITEMS; it += NGW) {
            int r = it;
            if (r < I_IN) { p0_transpose64(p.in[4], LDWIN, 1024, 36, nullptr, (bf16_t*)(ws + WS_WIN), 0, 1, scr, r, lane); continue; } r -= I_IN;
            if (r < I_OUT) { p0_transpose64(p.in[13], 1024, 1024, 16, nullptr, (bf16_t*)(ws + WS_WOUT), 0, 1, scr, r, lane); continue; } r -= I_OUT;
            if (r < I_Q) { p0_transpose64(p.in[16], 512, 1024, 8, p.in[14], (bf16_t*)(ws + WS_WQ), 0, 1, scr, r, lane); continue; } r -= I_Q;
            if (r < I_KV) { p0_transpose64(p.in[17], 1024, 1024, 16, nullptr, (bf16_t*)(ws + WS_WKV), 0, 1, scr, r, lane); continue; } r -= I_KV;
            p0_transpose64(p.in[18], 1024, 512, 16, nullptr, (bf16_t*)(ws + WS_WO), 0, 1, scr, r, lane);
        }
    }
    __syncthreads();
    float* wdt = (float*)lds;
    {
        const float* win = p.in[4]; const float* w1 = p.in[3];
        for (int i = tid; i < 8192; i += NTHREADS) { const int k = i >> 3, n = i & 7; wdt[n * 1024 + k] = win[(size_t)k * LDWIN + 2304 + n] * w1[k]; }
    }
    __syncthreads();
    {
        const float* x = p.in[0]; const float* w1 = p.in[3];
        bf16_t* h1 = (bf16_t*)(ws + WS_H1); float* dtraw = (float*)(ws + WS_DTRAW);
        f32x4 wv[4];
#pragma unroll
        for (int j = 0; j < 4; ++j) wv[j] = *(const f32x4*)(w1 + 4 * lane + 256 * j);
        f32x4 nx[4];
        if (gw < NT) {
#pragma unroll
            for (int j = 0; j < 4; ++j) nx[j] = *((const f32x4*)(x + (size_t)gw * DM) + lane + 64 * j);
        }
#pragma unroll 1
        for (int m = gw; m < NT; m += NGW) {
            f32x4 v[4];
#pragma unroll
            for (int j = 0; j < 4; ++j) v[j] = nx[j];
            if (m + NGW < NT) {
#pragma unroll
                for (int j = 0; j < 4; ++j) nx[j] = *((const f32x4*)(x + (size_t)(m + NGW) * DM) + lane + 64 * j);
            }
            float a[16];
#pragma unroll
            for (int q = 0; q < 16; ++q) a[q] = 0.f;
#pragma unroll
            for (int j = 0; j < 4; ++j) a[0] += (v[j].x * v[j].x + v[j].y * v[j].y) + (v[j].z * v[j].z + v[j].w * v[j].w);
#pragma unroll
            for (int n = 0; n < 8; ++n)
#pragma unroll
                for (int j = 0; j < 4; ++j) { const f32x4 ww = *(const f32x4*)(wdt + n * 1024 + 4 * lane + 256 * j); a[1 + n] += (v[j].x * ww.x + v[j].y * ww.y) + (v[j].z * ww.z + v[j].w * ww.w); }
            float b8[8], b4[4], b2[2], b1;
            { const bool hi = (lane & 32) != 0;
#pragma unroll
              for (int q = 0; q < 8; ++q) { const float send = hi ? a[q] : a[q + 8], keep = hi ? a[q + 8] : a[q]; b8[q] = keep + __shfl_xor(send, 32); } }
            { const bool hi = (lane & 16) != 0;
#pragma unroll
              for (int q = 0; q < 4; ++q) { const float send = hi ? b8[q] : b8[q + 4], keep = hi ? b8[q + 4] : b8[q]; b4[q] = keep + __shfl_xor(send, 16); } }
            { const bool hi = (lane & 8) != 0;
#pragma unroll
              for (int q = 0; q < 2; ++q) { const float send = hi ? b4[q] : b4[q + 2], keep = hi ? b4[q + 2] : b4[q]; b2[q] = keep + __shfl_xor(send, 8); } }
            { const bool hi = (lane & 4) != 0; const float send = hi ? b2[0] : b2[1], keep = hi ? b2[1] : b2[0]; b1 = keep + __shfl_xor(send, 4); }
            b1 += __shfl_xor(b1, 2); b1 += __shfl_xor(b1, 1);
            const float rstd = 1.f / sqrtf(__shfl(b1, 0) * (1.f / DM) + EPS);
            const int slot = (lane >> 2) & 15;
            if ((lane & 3) == 0 && slot >= 1 && slot <= 8) dtraw[(size_t)m * 8 + (slot - 1)] = b1 * rstd;
            u32x2* o8 = (u32x2*)(h1 + (size_t)m * DM) + lane;
#pragma unroll
            for (int j = 0; j < 4; ++j) { u32x2 o; o.x = pk2(v[j].x * rstd * wv[j].x, v[j].y * rstd * wv[j].y); o.y = pk2(v[j].z * rstd * wv[j].z, v[j].w * rstd * wv[j].w); o8[64 * j] = o; }
        }
    }
    {
        const float* mem = p.in[1]; const float* wm = p.in[15];
        bf16_t* memh = (bf16_t*)(ws + WS_MEMH);
        f32x4 wv[4];
#pragma unroll
        for (int j = 0; j < 4; ++j) wv[j] = *(const f32x4*)(wm + 4 * lane + 256 * j);
        for (int m = gw; m < NMEM; m += NGW) {
            const f32x4* xr = (const f32x4*)(mem + (size_t)m * DM) + lane;
            f32x4 v[4]; float s = 0.f;
#pragma unroll
            for (int j = 0; j < 4; ++j) { v[j] = xr[64 * j]; s += (v[j].x * v[j].x + v[j].y * v[j].y) + (v[j].z * v[j].z + v[j].w * v[j].w); }
            const float rstd = 1.f / sqrtf(wave_sum(s) * (1.f / DM) + EPS);
            u32x2* o8 = (u32x2*)(memh + (size_t)m * DM) + lane;
#pragma unroll
            for (int j = 0; j < 4; ++j) { u32x2 o; o.x = pk2(v[j].x * rstd * wv[j].x, v[j].y * rstd * wv[j].y); o.y = pk2(v[j].z * rstd * wv[j].z, v[j].w * rstd * wv[j].w); o8[64 * j] = o; }
        }
    }
    __syncthreads();
}

__device__ __forceinline__ void expert_transposes(const Params& p, unsigned char* lds, int vw, int nvw) {
    const int lane = opaque_tid() & 63, w = (opaque_tid() >> 6);
    unsigned char* ws = p.ws;
    float* scr = (float*)lds + w * (64 * 65);
    constexpr int I_G = 32 * 16 * 4, I_D = 32 * 4 * 16;
#pragma unroll 1
    for (int it = vw; it < 2 * I_G + I_D; it += nvw) {
        int r = it;
        if (r < I_G) { const int e = r / 64, ri = r % 64; p0_transpose64(p.in[24] + (size_t)e * 1024 * 256, 256, 1024, 4, p.in[19], (bf16_t*)(ws + WS_WGU) + (size_t)e * 512 * 1024, 0, 2, scr, ri, lane); continue; } r -= I_G;
        if (r < I_G) { const int e = r / 64, ri = r % 64; p0_transpose64(p.in[25] + (size_t)e * 1024 * 256, 256, 1024, 4, p.in[19], (bf16_t*)(ws + WS_WGU) + (size_t)e * 512 * 1024, 1, 2, scr, ri, lane); continue; } r -= I_G;
        { const int e = r / 64, ri = r % 64; p0_transpose64(p.in[26] + (size_t)e * 256 * 1024, 1024, 256, 16, nullptr, (bf16_t*)(ws + WS_WD) + (size_t)e * 1024 * 256, 0, 1, scr, ri, lane); }
    }
}

#define LDS3(p) ((__attribute__((address_space(3))) unsigned char*)(p))
__device__ __forceinline__ void phase1(const Params& p, unsigned char* lds) {
    unsigned char* ws = p.ws;
#ifdef PROBE_PHASE
    _Pragma("unroll 1") for (int rep = 0; rep < ((PROBE_PHASE == 101) ? 2 : 1); ++rep)
#endif
    {
        pg8::Gemm g{(const bf16_t*)(ws + WS_H1), (const bf16_t*)(ws + WS_WIN), NT, NPROJ, DM};
        pg8::StaticOrder S; S.init(NT, NPROJ, (int)gridDim.x, (int)blockIdx.x);
        pg8::EpiBf16 E{(bf16_t*)(ws + WS_PROJ), NPROJ, NPROJ / 256};
        pg8::gemm_phase<pg8::EpiBf16, pg8::StaticOrder, true, true>(LDS3(lds), g, S, E);
    }
    {
        pg8::Gemm g{(const bf16_t*)(ws + WS_MEMH), (const bf16_t*)(ws + WS_WKV), NMEM, 1024, DM};
        pg8::SubOrder S; S.init(NMEM, 1024, 128, (int)blockIdx.x - 128);
        pg8::EpiKV E{(bf16_t*)(ws + WS_KMEM), (bf16_t*)(ws + WS_VMEMT)};
        pg8::gemm_phase<pg8::EpiKV, pg8::SubOrder, true, true>(LDS3(lds), g, S, E);
    }
    {
        const int w = opaque_tid() >> 6;
        if (gridDim.x == 256) { if (blockIdx.x >= 160) expert_transposes(p, lds, ((int)blockIdx.x - 160) * NWAVES + w, 96 * NWAVES); }
        else expert_transposes(p, lds, (int)blockIdx.x * NWAVES + w, (int)gridDim.x * NWAVES);
    }
}

__device__ __forceinline__ float bfel(const u32x4& v, int ci) { const unsigned wv = (ci >> 1) == 0 ? v.x : (ci >> 1) == 1 ? v.y : (ci >> 1) == 2 ? v.z : v.w; return (ci & 1) ? bfhi(wv) : bflo(wv); }
__device__ __forceinline__ void conv8_load(const Params& p, int b, int c, int l0, int ch0, u32x4 (&in)[11]) {
    const bf16_t* proj = (const bf16_t*)(p.ws + WS_PROJ);
    const int t0 = c * 128 + l0 - 3;
    const bf16_t* rp = proj + ((long)(b * SEQ) + t0) * NPROJ + C_X + ch0;
    asm volatile("" : "+v"(rp));
#pragma unroll
    for (int i = 0; i < 11; ++i) {
        const int t = t0 + i;
        in[i] = (u32x4){0u, 0u, 0u, 0u};
        if (t >= 0) in[i] = *(const u32x4*)(rp + (size_t)i * NPROJ);
    }
}
template <bool TRANS>
__device__ __forceinline__ void conv8_math(const Params& p, int ch0, const u32x4 (&in)[11], const float (&f)[8], u32x4 (&res)[8]) {
    const float* cw = p.in[6]; const float* cb = p.in[7];
    float wgt[4][8], bias[8];
#pragma unroll
    for (int j = 0; j < 4; ++j) { const f32x4 a = *(const f32x4*)(cw + j * 1024 + ch0), b2 = *(const f32x4*)(cw + j * 1024 + ch0 + 4);
        wgt[j][0] = a.x; wgt[j][1] = a.y; wgt[j][2] = a.z; wgt[j][3] = a.w; wgt[j][4] = b2.x; wgt[j][5] = b2.y; wgt[j][6] = b2.z; wgt[j][7] = b2.w; }
    { const f32x4 a = *(const f32x4*)(cb + ch0), b2 = *(const f32x4*)(cb + ch0 + 4); bias[0] = a.x; bias[1] = a.y; bias[2] = a.z; bias[3] = a.w; bias[4] = b2.x; bias[5] = b2.y; bias[6] = b2.z; bias[7] = b2.w; }
    if (TRANS) {
#pragma unroll
        for (int ci = 0; ci < 8; ++ci) {
            float o[8];
#pragma unroll
            for (int li = 0; li < 8; ++li) { float a = bias[ci];
#pragma unroll
                for (int j = 0; j < 4; ++j) a += wgt[j][ci] * bfel(in[li + j], ci);
                o[li] = siluf(a) * f[li]; }
            res[ci] = (u32x4){pk2(o[0], o[1]), pk2(o[2], o[3]), pk2(o[4], o[5]), pk2(o[6], o[7])};
        }
    } else {
#pragma unroll
        for (int li = 0; li < 8; ++li) {
            float o[8];
#pragma unroll
            for (int ci = 0; ci < 8; ++ci) { float a = bias[ci];
#pragma unroll
                for (int j = 0; j < 4; ++j) a += wgt[j][ci] * bfel(in[li + j], ci);
                o[ci] = siluf(a) * f[li]; }
            res[li] = (u32x4){pk2(o[0], o[1]), pk2(o[2], o[3]), pk2(o[4], o[5]), pk2(o[6], o[7])};
        }
    }
}
template <bool TRANS>
__device__ __forceinline__ void conv8x8(const Params& p, int b, int c, int l0, int ch0, const float (&f)[8], u32x4 (&res)[8]) {
    u32x4 in[11];
    conv8_load(p, b, c, l0, ch0, in);
    conv8_math<TRANS>(p, ch0, in, f, res);
}

__device__ __forceinline__ void conv2_load(const Params& p, int b, int c, int l0, int ch0, unsigned (&in)[11]) {
    const bf16_t* proj = (const bf16_t*)(p.ws + WS_PROJ);
    const int t0 = c * 128 + l0 - 3;
    const bf16_t* rp = proj + ((long)(b * SEQ) + t0) * NPROJ + C_X + ch0;
    asm volatile("" : "+v"(rp));
#pragma unroll
    for (int i = 0; i < 11; ++i) { const int t = t0 + i; in[i] = 0u; if (t >= 0) in[i] = *(const unsigned*)(rp + (size_t)i * NPROJ); }
}
__device__ __forceinline__ void conv2_math(const Params& p, int ch0, const unsigned (&in)[11], u32x4 (&res)[2]) {
    const float* cw = p.in[6]; const float* cb = p.in[7];
    float wgt[4][2], bias[2];
#pragma unroll
    for (int j = 0; j < 4; ++j) { wgt[j][0] = cw[j * 1024 + ch0]; wgt[j][1] = cw[j * 1024 + ch0 + 1]; }
    bias[0] = cb[ch0]; bias[1] = cb[ch0 + 1];
#pragma unroll
    for (int ci = 0; ci < 2; ++ci) {
        float o[8];
#pragma unroll
        for (int li = 0; li < 8; ++li) { float a = bias[ci];
#pragma unroll
            for (int j = 0; j < 4; ++j) a += wgt[j][ci] * (ci ? bfhi(in[li + j]) : bflo(in[li + j]));
            o[li] = siluf(a); }
        res[ci] = (u32x4){pk2(o[0], o[1]), pk2(o[2], o[3]), pk2(o[4], o[5]), pk2(o[6], o[7])};
    }
}

__device__ __forceinline__ void ssd_dt_cum(const Params& p, int b, int c, float* dts, float* cums) {
    const int tid = opaque_tid(), lane = tid & 63, w = tid >> 6;
    const float* dtraw = (const float*)(p.ws + WS_DTRAW);
    const float bias = p.in[8][w], a = -__expf(p.in[9][w]);
    const size_t row0 = (size_t)b * SEQ + c * 128;
    float x0 = dtraw[(row0 + 2 * lane) * 8 + w] + bias, x1 = dtraw[(row0 + 2 * lane + 1) * 8 + w] + bias;
    const float d0 = fmaxf(x0, 0.f) + log1pf(__expf(-fabsf(x0))), d1 = fmaxf(x1, 0.f) + log1pf(__expf(-fabsf(x1)));
    const float a0 = d0 * a, a1 = d1 * a;
    float s = a0 + a1;
#pragma unroll
    for (int o = 1; o < 64; o <<= 1) { const float t = __shfl_up(s, o); if (lane >= o) s += t; }
    dts[w * 128 + 2 * lane] = d0; dts[w * 128 + 2 * lane + 1] = d1;
    cums[w * 128 + 2 * lane] = s - a1; cums[w * 128 + 2 * lane + 1] = s;
}

__device__ __forceinline__ void attn_unit(const Params& p, const bf16_t* sK, const bf16_t* sV, const float* cs, const float* sn, float* ssq, int b, int blk, int hq, int rg, int lane, u32x2 (&oh)[8]) {
    const int r = lane & 31, h = lane >> 5;
    const bf16_t* proj = (const bf16_t*)(p.ws + WS_PROJ);
    const int tband0 = blk * 128 - 128;
    const bf16_t* qp = proj + (size_t)(b * SEQ + blk * 128 + rg * 32 + r) * NPROJ + hq * 64 + 8 * h;
    u32x4 qv[4];
#pragma unroll
    for (int kk = 0; kk < 4; ++kk) qv[kk] = *(const u32x4*)(qp + kk * 16);
    {
        u32x4 ot; ot.x = __shfl_xor(qv[0].x, 32); ot.y = __shfl_xor(qv[0].y, 32); ot.z = __shfl_xor(qv[0].z, 32); ot.w = __shfl_xor(qv[0].w, 32);
        const float* cp = cs + (128 + rg * 32 + r) * 8; const float* sp = sn + (128 + rg * 32 + r) * 8;
        float o[8];
#pragma unroll
        for (int f = 0; f < 8; ++f) {
            const float mine = bfel(qv[0], f), oth = bfel(ot, f), c = cp[f], sv = sp[f];
            o[f] = h ? (mine * c + oth * sv) : (mine * c - oth * sv);
        }
        qv[0] = (u32x4){pk2(o[0], o[1]), pk2(o[2], o[3]), pk2(o[4], o[5]), pk2(o[6], o[7])};
    }
    f32x16 S[5];
#pragma unroll
    for (int jt = 0; jt < 5; ++jt) S[jt] = zero16();
    const bf16_t* kp = sK + (rg * 32 + r) * 72 + 8 * h;
#pragma unroll
    for (int kk = 0; kk < 4; ++kk) {
        const bf16x8 qf = __builtin_bit_cast(bf16x8, qv[kk]);
#pragma unroll
        for (int jt = 0; jt < 5; ++jt) { const bf16x8 a = *(const bf16x8*)(kp + jt * (32 * 72) + kk * 16); S[jt] = mfma32(a, qf, S[jt]); }
    }
    const float sink = p.in[5][hq] * 8.f;
    float m = sink;
    const bool noprev = (blk == 0);
#pragma unroll
    for (int jt = 0; jt < 5; ++jt)
#pragma unroll
        for (int i = 0; i < 16; ++i) {
            const int cr = (i & 3) + 8 * (i >> 2) + 4 * h;
            bool ok = true;
            if (jt == 0) ok = cr > r;
            if (jt == 4) ok = cr <= r;
            if (noprev && (rg + jt) < 4) ok = false;
            const float v = ok ? S[jt][i] : -INFINITY; S[jt][i] = v; m = fmaxf(m, v);
        }
    m = fmaxf(m, __shfl_xor(m, 32));
    const float sc = 0.125f * 1.4426950408889634f;
    float sum = 0.f;
    bf16x8 P[10];
#pragma unroll
    for (int jt = 0; jt < 5; ++jt) {
        float e[16];
#pragma unroll
        for (int i = 0; i < 16; ++i) { e[i] = __builtin_amdgcn_exp2f((S[jt][i] - m) * sc); sum += e[i]; }
        P[2 * jt] = pack8(e[0], e[1], e[2], e[3], e[4], e[5], e[6], e[7]);
        P[2 * jt + 1] = pack8(e[8], e[9], e[10], e[11], e[12], e[13], e[14], e[15]);
    }
    sum += __shfl_xor(sum, 32);
    sum += __builtin_amdgcn_exp2f((sink - m) * sc);
    const float inv = 1.f / sum;
    f32x16 O0 = zero16(), O1 = zero16();
    const bf16_t* vp0 = sV + r * 260 + rg * 32 + 4 * h;
#pragma unroll
    for (int ts = 0; ts < 10; ++ts) {
        const bf16_t* vp = vp0 + 16 * ts;
        const u32x2 lo0 = *(const u32x2*)vp, hi0 = *(const u32x2*)(vp + 8);
        const u32x2 lo1 = *(const u32x2*)(vp + 32 * 260), hi1 = *(const u32x2*)(vp + 32 * 260 + 8);
        O0 = mfma32(__builtin_bit_cast(bf16x8, (u32x4){lo0.x, lo0.y, hi0.x, hi0.y}), P[ts], O0);
        O1 = mfma32(__builtin_bit_cast(bf16x8, (u32x4){lo1.x, lo1.y, hi1.x, hi1.y}), P[ts], O1);
    }
    float q = 0.f;
#pragma unroll
    for (int g = 0; g < 4; ++g) {
        const unsigned a0 = pk2(O0[4 * g] * inv, O0[4 * g + 1] * inv), a1 = pk2(O0[4 * g + 2] * inv, O0[4 * g + 3] * inv);
        const unsigned b0 = pk2(O1[4 * g] * inv, O1[4 * g + 1] * inv), b1 = pk2(O1[4 * g + 2] * inv, O1[4 * g + 3] * inv);
        oh[g] = (u32x2){a0, a1}; oh[4 + g] = (u32x2){b0, b1};
        q += (bflo(a0) * bflo(a0) + bfhi(a0) * bfhi(a0)) + (bflo(a1) * bflo(a1) + bfhi(a1) * bfhi(a1)) + (bflo(b0) * bflo(b0) + bfhi(b0) * bfhi(b0)) + (bflo(b1) * bflo(b1) + bfhi(b1) * bfhi(b1));
    }
    q += __shfl_xor(q, 32);
    if (h == 0) ssq[(rg * 32 + r) * 8 + hq] = q;
}

__device__ __forceinline__ void phase2_attn(const Params& p, unsigned char* lds, int b, int blk) {
    const int tid = opaque_tid(), lane = tid & 63, w = tid >> 6, r = lane & 31, h = lane >> 5;
    const bf16_t* proj = (const bf16_t*)(p.ws + WS_PROJ);
    const int* positions = (const int*)p.in[2];
    float* cs = (float*)lds;
    float* sn = cs + 2048;
    float* ssq = sn + 2048;
    bf16_t* sK = (bf16_t*)(lds + 20480);
    bf16_t* sV = sK + 256 * 72;
    const int tband0 = blk * 128 - 128;
    for (int i = tid; i < 2048; i += NTHREADS) {
        const int kb = i >> 3, f = i & 7, t = tband0 + kb;
        float c = 1.f, sv = 0.f;
        if (t >= 0) { const float ang = (float)positions[b * SEQ + t] * p.inv_freq[f]; const double rev = (double)ang * 0.15915494309189535; const float fr = (float)(rev - floor(rev));
            c = __builtin_amdgcn_cosf(fr); sv = __builtin_amdgcn_sinf(fr); }
        cs[i] = c; sn[i] = sv;
    }
    u32x2 oh[4][8];
#pragma unroll
    for (int g = 0; g < 2; ++g) {
        __syncthreads();
        {
            const int key = tid >> 1, half = tid & 1, t = tband0 + key;
            u32x4 kv[4];
#pragma unroll
            for (int q = 0; q < 4; ++q) kv[q] = (u32x4){0u, 0u, 0u, 0u};
            if (t >= 0) { const bf16_t* kp = proj + (size_t)(b * SEQ + t) * NPROJ + C_K + g * 64 + half * 32;
#pragma unroll
                for (int q = 0; q < 4; ++q) kv[q] = *(const u32x4*)(kp + 8 * q); }
            if (half == 0) {
                float o1[8], o2[8];
#pragma unroll
                for (int f = 0; f < 8; ++f) { const float x1 = bfel(kv[0], f), x2 = bfel(kv[1], f), c = cs[key * 8 + f], sv = sn[key * 8 + f]; o1[f] = x1 * c - x2 * sv; o2[f] = x2 * c + x1 * sv; }
                kv[0] = (u32x4){pk2(o1[0], o1[1]), pk2(o1[2], o1[3]), pk2(o1[4], o1[5]), pk2(o1[6], o1[7])};
                kv[1] = (u32x4){pk2(o2[0], o2[1]), pk2(o2[2], o2[3]), pk2(o2[4], o2[5]), pk2(o2[6], o2[7])};
            }
#pragma unroll
            for (int q = 0; q < 4; ++q) *(u32x4*)(sK + key * 72 + half * 32 + 8 * q) = kv[q];
        }
        {
            const int kg = tid >> 3, dc = tid & 7;
            u32x4 v[4];
#pragma unroll
            for (int i = 0; i < 4; ++i) { const int t = tband0 + 4 * kg + i; v[i] = (u32x4){0u, 0u, 0u, 0u};
                if (t >= 0) v[i] = *(const u32x4*)(proj + (size_t)(b * SEQ + t) * NPROJ + C_V + g * 64 + dc * 8); }
            bf16_t* vd = sV + (dc * 8) * 260 + 4 * kg;
#define VT_ROW(j, W) { const unsigned e0 = ((j) & 1) ? (v[0].W >> 16) : (v[0].W & 0xffffu), e1 = ((j) & 1) ? (v[1].W >> 16) : (v[1].W & 0xffffu), e2 = ((j) & 1) ? (v[2].W >> 16) : (v[2].W & 0xffffu), e3 = ((j) & 1) ? (v[3].W >> 16) : (v[3].W & 0xffffu); \
                *(u32x2*)(vd + (j) * 260) = (u32x2){e0 | (e1 << 16), e2 | (e3 << 16)}; }
            VT_ROW(0, x) VT_ROW(1, x) VT_ROW(2, y) VT_ROW(3, y) VT_ROW(4, z) VT_ROW(5, z) VT_ROW(6, w) VT_ROW(7, w)
#undef VT_ROW
        }
        __syncthreads();
#pragma unroll
        for (int uu = 0; uu < 2; ++uu) {
            const int u = w + 8 * uu;
            attn_unit(p, sK, sV, cs, sn, ssq, b, blk, g * 4 + (u >> 2), u & 3, lane, oh[g * 2 + uu]);
            __builtin_amdgcn_sched_barrier(0);
        }
    }
    __syncthreads();
    {
        bf16_t* A2 = (bf16_t*)(p.ws + WS_A2);
        const float* wa = p.in[11];
#pragma unroll
        for (int k = 0; k < 4; ++k) {
            const int u = w + 8 * (k & 1), hq = (k >> 1) * 4 + (u >> 2), rg = u & 3, ql = rg * 32 + r;
            const f32x4 s0 = *(const f32x4*)(ssq + ql * 8), s1 = *(const f32x4*)(ssq + ql * 8 + 4);
            const float rstd = 1.f / sqrtf((((s0.x + s0.y) + (s0.z + s0.w)) + ((s1.x + s1.y) + (s1.z + s1.w))) * (1.f / 512.f) + EPS);
            bf16_t* op = A2 + (size_t)(b * SEQ + blk * 128 + ql) * 1024 + hq * 64 + 4 * h;
#pragma unroll
            for (int j = 0; j < 8; ++j) {
                const int d0 = 32 * (j >> 2) + 8 * (j & 3);
                const f32x4 wv = *(const f32x4*)(wa + hq * 64 + d0 + 4 * h);
                const u32x2 t = oh[k][j];
                u32x2 o; o.x = pk2(bflo(t.x) * rstd * wv.x, bfhi(t.x) * rstd * wv.y); o.y = pk2(bflo(t.y) * rstd * wv.z, bfhi(t.y) * rstd * wv.w);
                *(u32x2*)(op + d0) = o;
            }
        }
    }
    __syncthreads();
}

__device__ __forceinline__ void phase2_states(const Params& p, unsigned char* lds, int b, int c) {
    const int tid = opaque_tid(), lane = tid & 63, w = tid >> 6, r = lane & 31, h = lane >> 5;
    float* dts = (float*)lds;
    float* cums = dts + 1024;
    bf16_t* sBT = (bf16_t*)(lds + 8192);
    bf16_t* sXT = sBT + 128 * 136;
    ssd_dt_cum(p, b, c, dts, cums);
    __syncthreads();
    bf16_t* states = (bf16_t*)(p.ws + WS_START);
    if (tid < 8) ((float*)(p.ws + WS_CDEC))[(b * NCH + c) * 8 + tid] = __expf(cums[tid * 128 + 127]);
#pragma unroll 1
    for (int g = 0; g < 2; ++g) {
        if (tid < 256) {
            const int cg8 = tid & 15, lr = tid >> 4;
            const float one[8] = {1.f, 1.f, 1.f, 1.f, 1.f, 1.f, 1.f, 1.f};
            u32x4 res[8];
            conv8x8<true>(p, b, c, lr * 8, 512 + g * 128 + cg8 * 8, one, res);
#pragma unroll
            for (int ci = 0; ci < 8; ++ci) *(u32x4*)(sBT + (cg8 * 8 + ci) * 136 + lr * 8) = res[ci];
        }
        {
            const int cg8 = tid & 31, lr = tid >> 5, hh = cg8 >> 3, hd = g * 4 + hh;
            float f[8];
            const float cl = cums[hd * 128 + 127];
#pragma unroll
            for (int li = 0; li < 8; ++li) f[li] = dts[hd * 128 + lr * 8 + li] * __expf(cl - cums[hd * 128 + lr * 8 + li]);
            u32x4 res[8];
            conv8x8<true>(p, b, c, lr * 8, g * 256 + cg8 * 8, f, res);
#pragma unroll
            for (int ci = 0; ci < 8; ++ci) *(u32x4*)(sXT + (cg8 * 8 + ci) * 136 + lr * 8) = res[ci];
        }
        __syncthreads();
        {
            f32x16 acc[4];
#pragma unroll
            for (int j = 0; j < 4; ++j) acc[j] = zero16();
#pragma unroll
            for (int kk = 0; kk < 128; kk += 16) {
                const bf16x8 a = *(const bf16x8*)(sXT + (w * 32 + r) * 136 + kk + 8 * h);
#pragma unroll
                for (int j = 0; j < 4; ++j) { const bf16x8 bb = *(const bf16x8*)(sBT + (j * 32 + r) * 136 + kk + 8 * h); acc[j] = mfma32(a, bb, acc[j]); }
            }
            const int hd = g * 4 + (w >> 1), p0 = (w & 1) * 32;
            bf16_t* sp = states + ((size_t)((b * NCH + c) * 8 + hd) * 64) * 128;
#pragma unroll
            for (int j = 0; j < 4; ++j)
#pragma unroll
                for (int i = 0; i < 16; ++i) sp[(size_t)(p0 + crow(i, h)) * 128 + j * 32 + r] = (bf16_t)f2bf(acc[j][i]);
        }
        __syncthreads();
    }
}

__device__ __forceinline__ void phase3(const Params& p) {
    const float* cdec = (const float*)(p.ws + WS_CDEC);
    bf16_t* start = (bf16_t*)(p.ws + WS_START);
    const int tid3 = opaque_tid();
#pragma unroll 1
    for (int u = blockIdx.x * NTHREADS + tid3; u < 131072; u += gridDim.x * NTHREADS) {
        const int n4 = u & 31, pp = (u >> 5) & 63, hd = (u >> 11) & 7, b = u >> 14;
        bf16_t* base = start + ((size_t)((b * NCH) * 8 + hd) * 64 + pp) * 128 + n4 * 4;
        constexpr size_t CSTRIDE = (size_t)8 * 64 * 128;
        f32x4 s = (f32x4){0.f, 0.f, 0.f, 0.f};
#pragma unroll 1
        for (int c0 = 0; c0 < NCH; c0 += 16) {
            bf16_t* bp = base + c0 * CSTRIDE; const float* dp = cdec + (b * NCH + c0) * 8 + hd;
            asm volatile("" : "+v"(bp));
            u32x2 t[16]; float d[16];
#pragma unroll
            for (int c = 0; c < 16; ++c) { t[c] = *(const u32x2*)(bp + c * CSTRIDE); d[c] = dp[c * 8]; }
#pragma unroll
            for (int c = 0; c < 16; ++c) {
                u32x2 o; o.x = pk2(s.x, s.y); o.y = pk2(s.z, s.w);
                *(u32x2*)(bp + c * CSTRIDE) = o;
                const f32x4 st = (f32x4){bflo(t[c].x), bfhi(t[c].x), bflo(t[c].y), bfhi(t[c].y)};
                s = s * d[c] + st;
            }
        }
    }
}

__device__ __forceinline__ void phase4(const Params& p, unsigned char* lds, int b, int c) {
    const int tid = opaque_tid(), lane = tid & 63, w = tid >> 6, r = lane & 31, h = lane >> 5;
    float* dts = (float*)lds;
    float* cums = dts + 1024;
    float* gsq = cums + 1024;
    bf16_t* sC = (bf16_t*)(lds + 12288);
    bf16_t* sB = sC + 128 * 136;
    bf16_t* sM = sB + 128 * 136;
    bf16_t* sXT = sM + 128 * 136;
    const bf16_t* proj = (const bf16_t*)(p.ws + WS_PROJ);
    const bf16_t* start = (const bf16_t*)(p.ws + WS_START);
    bf16_t* A2 = (bf16_t*)(p.ws + WS_A2);
    ssd_dt_cum(p, b, c, dts, cums);
    __syncthreads();
    const size_t row0 = (size_t)b * SEQ + c * 128;
#pragma unroll 1
    for (int g = 0; g < 2; ++g) {
        {
            const int which = tid >> 8, cg8 = tid & 15, lr = (tid >> 4) & 15;
            const float one[8] = {1.f, 1.f, 1.f, 1.f, 1.f, 1.f, 1.f, 1.f};
            u32x4 res[8];
            conv8x8<false>(p, b, c, lr * 8, (which ? 768 : 512) + g * 128 + cg8 * 8, one, res);
            bf16_t* dst = which ? sC : sB;
#pragma unroll
            for (int li = 0; li < 8; ++li) *(u32x4*)(dst + (lr * 8 + li) * 136 + cg8 * 8) = res[li];
        }
        __syncthreads();
        f32x16 cb0 = zero16(), cb1 = zero16();
        const int lt = w >> 1, st0 = 2 * (w & 1);
#pragma unroll 2
        for (int kk = 0; kk < 128; kk += 16) {
            const bf16x8 a = *(const bf16x8*)(sC + (lt * 32 + r) * 136 + kk + 8 * h);
            const bf16x8 b0 = *(const bf16x8*)(sB + (st0 * 32 + r) * 136 + kk + 8 * h);
            const bf16x8 b1 = *(const bf16x8*)(sB + ((st0 + 1) * 32 + r) * 136 + kk + 8 * h);
            cb0 = mfma32(a, b0, cb0); cb1 = mfma32(a, b1, cb1);
        }
        __syncthreads();
        bf16_t* sS = sB;
        const int lt2 = w >> 1, pt = w & 1;
        const int lme = lt2 * 32 + r;
        const int cp = tid & 31, lr = tid >> 5;
        u32x4 stv[2]; unsigned xin[11]; u32x2 zrn[4];
#define P4_PREFETCH(HD) { const bf16_t* stb_ = start + ((size_t)((b * NCH + c) * 8 + (HD)) * 64) * 128; \
            _Pragma("unroll") for (int i_ = 0; i_ < 2; ++i_) { const int id_ = tid + 512 * i_; stv[i_] = *(const u32x4*)(stb_ + (id_ >> 4) * 128 + (id_ & 15) * 8); } \
            conv2_load(p, b, c, lr * 8, (HD) * 64 + cp * 2, xin); \
            const bf16_t* zp_ = proj + (row0 + lme) * NPROJ + C_Z + (HD) * 64 + 32 * pt + 4 * h; \
            _Pragma("unroll") for (int g4_ = 0; g4_ < 4; ++g4_) zrn[g4_] = *(const u32x2*)(zp_ + 8 * g4_); }
        P4_PREFETCH(g * 4);
#pragma unroll 1
        for (int hh = 0; hh < 4; ++hh) {
            const int hd = g * 4 + hh;
            u32x2 zr[4];
#pragma unroll
            for (int g4 = 0; g4 < 4; ++g4) zr[g4] = zrn[g4];
#pragma unroll
            for (int q = 0; q < 2; ++q) {
                const int st = st0 + q;
                if (st <= lt) {
                    const int sme = st * 32 + r; const float cs_ = cums[hd * 128 + sme], ds_ = dts[hd * 128 + sme];
#pragma unroll
                    for (int i = 0; i < 16; ++i) {
                        const int l = lt * 32 + crow(i, h);
                        const float cbv = q ? cb1[i] : cb0[i];
                        const float v = (sme <= l) ? cbv * __expf(cums[hd * 128 + l] - cs_) * ds_ : 0.f;
                        sM[l * 136 + sme] = (bf16_t)f2bf(v);
                    }
                }
            }
            {
                u32x4 res[2];
                conv2_math(p, hd * 64 + cp * 2, xin, res);
                *(u32x4*)(sXT + (cp * 2) * 136 + lr * 8) = res[0];
                *(u32x4*)(sXT + (cp * 2 + 1) * 136 + lr * 8) = res[1];
            }
#pragma unroll
            for (int i = 0; i < 2; ++i) { const int id = tid + 512 * i; *(u32x4*)(sS + (id >> 4) * 136 + (id & 15) * 8) = stv[i]; }
            __syncthreads();
            if (hh < 3) P4_PREFETCH(hd + 1);
            {
                f32x16 yd = zero16(), yo = zero16();
                const int kend = 32 * (lt2 + 1);
#pragma unroll 2
                for (int kk = 0; kk < kend; kk += 16) {
                    const bf16x8 a = *(const bf16x8*)(sXT + (pt * 32 + r) * 136 + kk + 8 * h);
                    const bf16x8 bb = *(const bf16x8*)(sM + (lt2 * 32 + r) * 136 + kk + 8 * h);
                    yd = mfma32(a, bb, yd);
                }
#pragma unroll 2
                for (int kk = 0; kk < 128; kk += 16) {
                    const bf16x8 a = *(const bf16x8*)(sS + (pt * 32 + r) * 136 + kk + 8 * h);
                    const bf16x8 bb = *(const bf16x8*)(sC + (lt2 * 32 + r) * 136 + kk + 8 * h);
                    yo = mfma32(a, bb, yo);
                }
                const float dsk = p.in[10][hd];
                const float el = __expf(cums[hd * 128 + lme]);
                bf16_t* gp = A2 + (row0 + lme) * 1024 + 512 + hd * 64 + 32 * pt + 4 * h;
                float q = 0.f;
#pragma unroll
                for (int g4 = 0; g4 < 4; ++g4) {
                    float gv[4];
#pragma unroll
                    for (int e = 0; e < 4; ++e) {
                        const int i = 4 * g4 + e, pl = 32 * pt + 8 * g4 + 4 * h + e;
                        const float xs = bf2f((unsigned)sXT[pl * 136 + lme]);
                        const float y = yd[i] + el * yo[i] + dsk * xs;
                        const unsigned zw = (e >> 1) ? zr[g4].y : zr[g4].x;
                        const float z = (e & 1) ? bfhi(zw) : bflo(zw);
                        gv[e] = y * siluf(z);
                    }
                    const unsigned w0 = pk2(gv[0], gv[1]), w1 = pk2(gv[2], gv[3]);
                    *(u32x2*)(gp + 8 * g4) = (u32x2){w0, w1};
                    q += (bflo(w0) * bflo(w0) + bfhi(w0) * bfhi(w0)) + (bflo(w1) * bflo(w1) + bfhi(w1) * bfhi(w1));
                }
                q += __shfl_xor(q, 32);
                if (h == 0) gsq[lme * 8 + hh * 2 + pt] = q;
            }
            __syncthreads();
        }
#undef P4_PREFETCH
        {
            const float* wsn = p.in[12];
            for (int i = tid; i < 128 * 32; i += NTHREADS) {
                const int l = i >> 5, c8 = (i & 31) * 8;
                float s = 0.f;
#pragma unroll
                for (int q = 0; q < 8; ++q) s += gsq[l * 8 + q];
                const float rstd = 1.f / sqrtf(s * (1.f / 256.f) + EPS);
                const u32x4 t = *(const u32x4*)(A2 + (row0 + l) * 1024 + 512 + g * 256 + c8);
                const f32x4 w0 = *(const f32x4*)(wsn + g * 256 + c8), w1 = *(const f32x4*)(wsn + g * 256 + c8 + 4);
                u32x4 o; o.x = pk2(bflo(t.x) * rstd * w0.x, bfhi(t.x) * rstd * w0.y); o.y = pk2(bflo(t.y) * rstd * w0.z, bfhi(t.y) * rstd * w0.w); o.z = pk2(bflo(t.z) * rstd * w1.x, bfhi(t.z) * rstd * w1.y); o.w = pk2(bflo(t.w) * rstd * w1.z, bfhi(t.w) * rstd * w1.w);
                *(u32x4*)(A2 + (row0 + l) * 1024 + 512 + g * 256 + c8) = o;
            }
        }
        __syncthreads();
    }
}

__device__ __forceinline__ void phase5(const Params& p, unsigned char* lds) {
    unsigned char* ws = p.ws;
    pg8::Gemm g{(const bf16_t*)(ws + WS_A2), (const bf16_t*)(ws + WS_WOUT), NT, DM, DM};
    pg8::StaticOrder S; S.init(NT, DM, (int)gridDim.x, (int)blockIdx.x);
    pg8::EpiResid<true, true> E{p.in[0], (bf16_t*)(ws + WS_XB), (float*)(ws + WS_SSQ)};
    pg8::gemm_phase<pg8::EpiResid<true, true>, pg8::StaticOrder, true, true>(LDS3(lds), g, S, E);
}
__device__ __forceinline__ void phase6(const Params& p, unsigned char* lds) {
    unsigned char* ws = p.ws;
    pg8::Gemm g{(const bf16_t*)(ws + WS_XB), (const bf16_t*)(ws + WS_WQ), NT, 512, DM};
    pg8::StaticOrder S; S.init(NT, 512, (int)gridDim.x, (int)blockIdx.x);
    pg8::EpiQ E{(bf16_t*)(ws + WS_Q2), (const float*)(ws + WS_SSQ)};
    pg8::gemm_phase<pg8::EpiQ, pg8::StaticOrder, true, true>(LDS3(lds), g, S, E);
}
__device__ __forceinline__ void phase8(const Params& p, unsigned char* lds) {
    unsigned char* ws = p.ws;
    pg8::Gemm g{(const bf16_t*)(ws + WS_XO), (const bf16_t*)(ws + WS_WO), NT, DM, 512};
    pg8::StaticOrder S; S.init(NT, DM, (int)gridDim.x, (int)blockIdx.x);
    pg8::EpiResid<false, false> E{(const void*)(ws + WS_XB), (bf16_t*)(ws + WS_XB), nullptr};
    pg8::gemm_phase<pg8::EpiResid<false, false>, pg8::StaticOrder, true, true>(LDS3(lds), g, S, E);
}

__device__ __forceinline__ void phase7(const Params& p, unsigned char* lds) {
    const int tid = opaque_tid(), lane = tid & 63, w = tid >> 6, r = lane & 31, h = lane >> 5;
    const bf16_t* q2 = (const bf16_t*)(p.ws + WS_Q2); const bf16_t* kmem = (const bf16_t*)(p.ws + WS_KMEM); const bf16_t* vmemT = (const bf16_t*)(p.ws + WS_VMEMT);
    bf16_t* xo = (bf16_t*)(p.ws + WS_XO);
    bf16_t* sK = (bf16_t*)lds;
    bf16_t* sV = sK + 256 * 136;
    const float sc = 0.08838834764831845f * 1.4426950408889634f;
    for (int pr = blockIdx.x; pr < 256; pr += gridDim.x) {
        const int bh = pr >> 3, rp = pr & 7, b = bh >> 2, hx = bh & 3;
        __syncthreads();
        for (int i = tid; i < 4096; i += NTHREADS) { const int key = i >> 4, ch = i & 15;
            *(u32x4*)(sK + key * 136 + ch * 8) = *(const u32x4*)(kmem + ((size_t)b * 256 + key) * 512 + hx * 128 + ch * 8); }
        for (int i = tid; i < 4096; i += NTHREADS) { const int d = i >> 5, ch = i & 31;
            const u32x4 v = *(const u32x4*)(vmemT + (((size_t)b * 4 + hx) * 128 + d) * 256 + ch * 8);
            *(u32x2*)(sV + d * 260 + ch * 8) = (u32x2){v.x, v.y}; *(u32x2*)(sV + d * 260 + ch * 8 + 4) = (u32x2){v.z, v.w}; }
        __syncthreads();
#pragma unroll 1
        for (int ib = 0; ib < 2; ++ib) {
            const size_t row0 = (size_t)b * SEQ + (size_t)(2 * rp + ib) * 256 + w * 32;
            bf16x8 qf[8];
            const bf16_t* qp = q2 + (row0 + r) * 512 + hx * 128 + 8 * h;
#pragma unroll
            for (int kk = 0; kk < 8; ++kk) qf[kk] = *(const bf16x8*)(qp + kk * 16);
            f32x16 S[8];
#pragma unroll
            for (int t = 0; t < 8; ++t) S[t] = zero16();
            const bf16_t* kp = sK + r * 136 + 8 * h;
#pragma unroll
            for (int kk = 0; kk < 8; ++kk) {
#pragma unroll
                for (int t = 0; t < 8; ++t) { const bf16x8 a = *(const bf16x8*)(kp + t * (32 * 136) + kk * 16); S[t] = mfma32(a, qf[kk], S[t]); }
                __builtin_amdgcn_sched_barrier(0);
            }
            float m = -INFINITY;
#pragma unroll
            for (int t = 0; t < 8; ++t)
#pragma unroll
                for (int i = 0; i < 16; ++i) m = fmaxf(m, S[t][i]);
            m = fmaxf(m, __shfl_xor(m, 32));
            float sum = 0.f;
            bf16x8 P[16];
#pragma unroll
            for (int t = 0; t < 8; ++t) {
                float e[16];
#pragma unroll
                for (int i = 0; i < 16; ++i) { e[i] = __builtin_amdgcn_exp2f((S[t][i] - m) * sc); sum += e[i]; }
                P[2 * t] = pack8(e[0], e[1], e[2], e[3], e[4], e[5], e[6], e[7]);
                P[2 * t + 1] = pack8(e[8], e[9], e[10], e[11], e[12], e[13], e[14], e[15]);
            }
            sum += __shfl_xor(sum, 32);
            const float inv = 1.f / sum;
            f32x16 O[4];
#pragma unroll
            for (int dt = 0; dt < 4; ++dt) O[dt] = zero16();
            const bf16_t* vp0 = sV + r * 260 + 4 * h;
#pragma unroll
            for (int ts = 0; ts < 16; ++ts) {
#pragma unroll
                for (int dt = 0; dt < 4; ++dt) {
                    const bf16_t* vp = vp0 + dt * (32 * 260) + 16 * ts;
                    const u32x2 lo = *(const u32x2*)vp, hi = *(const u32x2*)(vp + 8);
                    const bf16x8 a = __builtin_bit_cast(bf16x8, (u32x4){lo.x, lo.y, hi.x, hi.y});
                    O[dt] = mfma32(a, P[ts], O[dt]);
                }
                if (ts & 1) __builtin_amdgcn_sched_barrier(0);
            }
            bf16_t* op = xo + (row0 + r) * 512 + hx * 128 + 4 * h;
#pragma unroll
            for (int dt = 0; dt < 4; ++dt)
#pragma unroll
                for (int g = 0; g < 4; ++g) { u32x2 o; o.x = pk2(O[dt][4 * g] * inv, O[dt][4 * g + 1] * inv); o.y = pk2(O[dt][4 * g + 2] * inv, O[dt][4 * g + 3] * inv);
                    *(u32x2*)(op + 32 * dt + 8 * g) = o; }
        }
    }
}

typedef __bf16 bf16x2_t __attribute__((ext_vector_type(2)));
__device__ __forceinline__ float dot2bf(unsigned a, unsigned b, float acc) { return __builtin_amdgcn_fdot2_f32_bf16(__builtin_bit_cast(bf16x2_t, a), __builtin_bit_cast(bf16x2_t, b), acc, false); }
__device__ __forceinline__ void phase9(const Params& p, unsigned char* lds) {
    const int tid = opaque_tid(), lane = tid & 63, w = tid >> 6, r = lane & 31, h = lane >> 5;
    const bf16_t* x2 = (const bf16_t*)(p.ws + WS_XB);
    int* cnt = (int*)(p.ws + WS_CTL);
    int* list = (int*)(p.ws + WS_LIST);
    float* route = (float*)(p.ws + WS_ROUTE);
    const float* bg = p.in[21]; const float* be = p.in[23];
    bf16_t* sW = (bf16_t*)lds;
    int* lcnt = (int*)(lds + 74752);
    float* lrec = (float*)(lds + 74752 + 256);
    for (int i = tid; i < 36 * 128; i += NTHREADS) { const int n = i >> 7, ch = i & 127; *(u32x4*)(sW + n * 1032 + ch * 8) = *(const u32x4*)((const bf16_t*)(p.ws + WS_WR) + n * 1024 + ch * 8); }
    if (tid < 64) lcnt[tid] = 0;
    __syncthreads();
    const int njobs = NT / 32, jstride = gridDim.x * 4;
    int nrec = 0;
    for (int job0 = blockIdx.x * 4; job0 < njobs; job0 += jstride, ++nrec) {
        const int job = job0 + w;
        if (w < 4 && job < njobs) {
            const int m0 = job * 32;
            f32x16 acc0 = zero16(), acc1 = zero16();
            float ss = 0.f;
            const bf16_t* xp = x2 + (size_t)(m0 + r) * DM + 8 * h;
            const bf16_t* w0p = sW + r * 1032 + 8 * h;
            const bf16_t* w1p = sW + (32 + (r & 3)) * 1032 + 8 * h;
#pragma unroll 1
            for (int kb = 0; kb < 4; ++kb) {
                u32x4 xf[16];
#pragma unroll
                for (int q = 0; q < 16; ++q) xf[q] = *(const u32x4*)(xp + (kb * 16 + q) * 16);
#pragma unroll
                for (int q = 0; q < 16; ++q) {
                    const bf16x8 a0 = *(const bf16x8*)(w0p + (kb * 16 + q) * 16), a1 = *(const bf16x8*)(w1p + (kb * 16 + q) * 16);
                    const bf16x8 xb = __builtin_bit_cast(bf16x8, xf[q]);
                    acc0 = mfma32(a0, xb, acc0); acc1 = mfma32(a1, xb, acc1);
                    ss = dot2bf(xf[q].x, xf[q].x, ss); ss = dot2bf(xf[q].y, xf[q].y, ss); ss = dot2bf(xf[q].z, xf[q].z, ss); ss = dot2bf(xf[q].w, xf[q].w, ss);
                }
            }
            ss += __shfl_xor(ss, 32);
            const float rstd = 1.f / sqrtf(ss * (1.f / DM) + EPS);
            const float g0 = __shfl(acc1[0], r) * rstd + bg[0], g1 = __shfl(acc1[1], r) * rstd + bg[1], g2 = __shfl(acc1[2], r) * rstd + bg[2], g3 = __shfl(acc1[3], r) * rstd + bg[3];
            int gi = 0; float gm = g0;
            if (g1 > gm) { gm = g1; gi = 1; }
            if (g2 > gm) { gm = g2; gi = 2; }
            if (g3 > gm) { gm = g3; gi = 3; }
            const float gden = __expf(g0 - gm) + __expf(g1 - gm) + __expf(g2 - gm) + __expf(g3 - gm);
            const float ggate = 1.f / gden;
            const bool up = (gi & 1) != 0;
            const int gme = 2 * h + (gi & 1);
            float ev[8];
#pragma unroll
            for (int j = 0; j < 8; ++j) ev[j] = (up ? acc0[8 + j] : acc0[j]) * rstd + be[gme * 8 + j];
            int i1 = 0; float v1 = ev[0];
#pragma unroll
            for (int j = 1; j < 8; ++j) if (ev[j] > v1) { v1 = ev[j]; i1 = j; }
            int i2 = -1; float v2 = -INFINITY;
#pragma unroll
            for (int j = 0; j < 8; ++j) if (j != i1 && ev[j] > v2) { v2 = ev[j]; i2 = j; }
            const float e2 = __expf(v2 - v1);
            const float w1 = ggate / (1.f + e2), w2 = ggate * e2 / (1.f + e2);
            if (h == (gi >> 1)) {
                const int ea = gi * 8 + i1, eb = gi * 8 + i2;
                const int la = atomicAdd(lcnt + ea, 1), lb = atomicAdd(lcnt + eb, 1);
                float* rc = lrec + (size_t)(nrec * 128 + w * 32 + r) * 8;
                ((int*)rc)[0] = ea; ((int*)rc)[1] = eb; ((int*)rc)[2] = la; ((int*)rc)[3] = lb; rc[4] = w1; rc[5] = w2; rc[6] = rstd; ((int*)rc)[7] = m0 + r;
            }
        }
    }
    __syncthreads();
    if (tid < 32) lcnt[32 + tid] = lcnt[tid] ? atomicAdd(cnt + tid * 64, lcnt[tid]) : 0;
    __syncthreads();
    {
        int rd = 0;
        for (int job0 = blockIdx.x * 4; job0 < njobs; job0 += jstride, ++rd) {
            if (tid < 128 && job0 + (tid >> 5) < njobs) {
                const float* rc = lrec + (size_t)(rd * 128 + tid) * 8;
                const int ea = ((const int*)rc)[0], eb = ((const int*)rc)[1], m = ((const int*)rc)[7];
                const int pa = lcnt[32 + ea] + ((const int*)rc)[2], pb = lcnt[32 + eb] + ((const int*)rc)[3];
                list[ea * NT + pa] = m; list[eb * NT + pb] = m;
                int* ri = (int*)(route + (size_t)m * 8);
                ri[0] = ea; ri[1] = eb; ri[2] = pa; ri[3] = pb;
                route[(size_t)m * 8 + 4] = rc[4]; route[(size_t)m * 8 + 5] = rc[5]; route[(size_t)m * 8 + 6] = rc[6]; route[(size_t)m * 8 + 7] = 0.f;
            }
        }
    }
}

__device__ __forceinline__ int* moe_tables(const Params& p, unsigned char* lds) {
    int* off = (int*)(lds + 131072);
    const int* cnt = (const int*)(p.ws + WS_CTL);
    if (threadIdx.x < 64) {
        const int l = threadIdx.x & 63;
        const int cv = (l < NEXP) ? cnt[l * 64] : 0;
        int pad = ((cv + 255) >> 8) << 8, incl = pad;
#pragma unroll
        for (int o = 1; o < 32; o <<= 1) { const int t = __shfl_up(incl, o); if (l >= o) incl += t; }
        if (l < NEXP) { off[l] = incl - pad; off[40 + l] = cv; }
        if (l == NEXP - 1) off[NEXP] = incl;
    }
    __syncthreads();
    const int nrt = off[NEXP] >> 8;
    for (int rt = threadIdx.x; rt < nrt; rt += NTHREADS) { int e = 0; for (int q = 1; q < NEXP; ++q) if (off[q] <= rt * 256) e = q; off[128 + rt] = e; }
    __syncthreads();
    return off;
}

__device__ __forceinline__ void phase10(const Params& p, unsigned char* lds) {
    const int tid = opaque_tid(), lane = tid & 63, w = tid >> 6;
    const int* off = moe_tables(p, lds);
    const int gw = blockIdx.x * NWAVES + w, NGW = gridDim.x * NWAVES;
    const bf16_t* x2 = (const bf16_t*)(p.ws + WS_XB); const float* route = (const float*)(p.ws + WS_ROUTE);
    bf16_t* xg = (bf16_t*)(p.ws + WS_XG);
    for (int m = gw; m < NT; m += NGW) {
        const int* ri = (const int*)(route + (size_t)m * 8);
        const int ea = ri[0], eb = ri[1], pa = ri[2], pb = ri[3];
        const float rs = route[(size_t)m * 8 + 6];
        const size_t sa = (size_t)off[ea] + pa, sb = (size_t)off[eb] + pb;
        const u32x2* xr = (const u32x2*)(x2 + (size_t)m * DM) + lane;
        u32x2* oa = (u32x2*)(xg + sa * DM) + lane; u32x2* ob = (u32x2*)(xg + sb * DM) + lane;
#pragma unroll
        for (int j = 0; j < 4; ++j) { const u32x2 t = xr[64 * j]; u32x2 o; o.x = pk2(bflo(t.x) * rs, bfhi(t.x) * rs); o.y = pk2(bflo(t.y) * rs, bfhi(t.y) * rs); oa[64 * j] = o; ob[64 * j] = o; }
    }
}

__device__ __forceinline__ void phase11(const Params& p, unsigned char* lds) {
    const int tid = opaque_tid();
    const int* off = moe_tables(p, lds);
    const int nrt = off[NEXP] >> 8, G = (int)gridDim.x, c = (int)blockIdx.x;
    unsigned* rowtab = (unsigned*)(lds + 131072 + 2048);
    float* rstab = (float*)(lds + 131072 + 2048 + 3072);
    {
        const int* list = (const int*)(p.ws + WS_LIST); const float* route = (const float*)(p.ws + WS_ROUTE);
        for (int i = 0; i < 3; ++i) {
            const int L = i * G + c; if (L >= nrt * 2) break;
            const int rt = L >> 1, e = off[128 + rt], cnt_e = off[40 + e], pos0 = rt * 256 - off[e];
            if (tid < 256) { const int pos = pos0 + tid; int tok = 0; float rs = 0.f;
                if (pos < cnt_e) { tok = list[e * NT + pos]; rs = route[(size_t)tok * 8 + 6]; }
                rowtab[i * 256 + tid] = (unsigned)tok * (unsigned)(DM * 2); rstab[i * 256 + tid] = rs; }
        }
    }
    __syncthreads();
    pg8::Gemm g{(const bf16_t*)(p.ws + WS_XB), (const bf16_t*)(p.ws + WS_WGU), 0, 0, DM};
    pg8::MoeOrder S{(const __attribute__((address_space(3))) int*)(off + 128), nrt, 2, G, c};
    pg8::EpiGU E{(bf16_t*)(p.ws + WS_HID), (const __attribute__((address_space(3))) float*)rstab, G, c};
    pg8::gemm_phase_g<pg8::EpiGU, pg8::MoeOrder, true, true>(LDS3(lds), g, S, E, (const __attribute__((address_space(3))) unsigned*)rowtab);
}
__device__ __forceinline__ void phase12(const Params& p, unsigned char* lds) {
    const int* off = moe_tables(p, lds);
    int kdim = EFF; asm volatile("" : "+s"(kdim));
    pg8::Gemm g{(const bf16_t*)(p.ws + WS_HID), (const bf16_t*)(p.ws + WS_WD), 0, 0, kdim};
    pg8::MoeOrder S{(const __attribute__((address_space(3))) int*)(off + 128), off[NEXP] >> 8, 4, (int)gridDim.x, (int)blockIdx.x};
    pg8::EpiY8 E{(unsigned char*)(p.ws + WS_Y), DM, 4};
    pg8::gemm_phase<pg8::EpiY8, pg8::MoeOrder, true, true>(LDS3(lds), g, S, E);
}

__device__ __forceinline__ void phase13(const Params& p, unsigned char* lds) {
    const int tid = opaque_tid(), lane = tid & 63, w = tid >> 6;
    const int* off = moe_tables(p, lds);
    const int gw = blockIdx.x * NWAVES + w, NGW = gridDim.x * NWAVES;
    const bf16_t* x2 = (const bf16_t*)(p.ws + WS_XB); const unsigned char* yb = (const unsigned char*)(p.ws + WS_Y);
    const float* route = (const float*)(p.ws + WS_ROUTE); const float* wf = p.in[27];
    f32x4 wv[2][2];
#pragma unroll
    for (int j = 0; j < 2; ++j) { wv[j][0] = *(const f32x4*)(wf + 8 * lane + 512 * j); wv[j][1] = *(const f32x4*)(wf + 8 * lane + 512 * j + 4); }
    struct Rows { u32x4 x[2]; u32x2 ya[2], yb[2]; float w1, w2; };
    Rows R0, R1, R2;
    u32x4 recN; u32x2 wN;
#define LOAD_REC(m_, REC, WW) { REC = *(const u32x4*)(route + (size_t)(m_) * 8); WW = *(const u32x2*)(route + (size_t)(m_) * 8 + 4); }
#define ISSUE_ROWS(m_, REC, WW, R) { const size_t sa_ = (size_t)off[(int)(REC).x] + (REC).z, sb_ = (size_t)off[(int)(REC).y] + (REC).w; \
        const u32x4* xr_ = (const u32x4*)(x2 + (size_t)(m_) * DM) + lane; const u32x2* ya_ = (const u32x2*)(yb + sa_ * DM) + lane; const u32x2* yb_ = (const u32x2*)(yb + sb_ * DM) + lane; \
        _Pragma("unroll") for (int j = 0; j < 2; ++j) { R.x[j] = xr_[64 * j]; R.ya[j] = ya_[64 * j]; R.yb[j] = yb_[64 * j]; } \
        R.w1 = __uint_as_float((WW).x) * 0.0625f; R.w2 = __uint_as_float((WW).y) * 0.0625f; }
    {
        u32x4 rc; u32x2 ww;
        if (gw < NT) { LOAD_REC(gw, rc, ww); ISSUE_ROWS(gw, rc, ww, R0); }
        if (gw + NGW < NT) { LOAD_REC(gw + NGW, rc, ww); ISSUE_ROWS(gw + NGW, rc, ww, R1); }
        if (gw + 2 * NGW < NT) LOAD_REC(gw + 2 * NGW, recN, wN);
    }
#pragma unroll 1
    for (int m = gw; m < NT; m += NGW) {
        if (m + 2 * NGW < NT) ISSUE_ROWS(m + 2 * NGW, recN, wN, R2);
        if (m + 3 * NGW < NT) LOAD_REC(m + 3 * NGW, recN, wN);
        f32x4 v[2][2]; float s = 0.f;
#pragma unroll
        for (int j = 0; j < 2; ++j) {
            typedef float f32x2v __attribute__((ext_vector_type(2)));
            const u32x4 t = R0.x[j]; const u32x2 a = R0.ya[j], bq = R0.yb[j]; const float w1 = R0.w1, w2 = R0.w2;
            const f32x2v a0 = __builtin_amdgcn_cvt_pk_f32_fp8((int)a.x, false), a1 = __builtin_amdgcn_cvt_pk_f32_fp8((int)a.x, true), a2 = __builtin_amdgcn_cvt_pk_f32_fp8((int)a.y, false), a3 = __builtin_amdgcn_cvt_pk_f32_fp8((int)a.y, true);
            const f32x2v b0 = __builtin_amdgcn_cvt_pk_f32_fp8((int)bq.x, false), b1 = __builtin_amdgcn_cvt_pk_f32_fp8((int)bq.x, true), b2 = __builtin_amdgcn_cvt_pk_f32_fp8((int)bq.y, false), b3 = __builtin_amdgcn_cvt_pk_f32_fp8((int)bq.y, true);
            v[j][0] = (f32x4){bflo(t.x) + w1 * a0.x + w2 * b0.x, bfhi(t.x) + w1 * a0.y + w2 * b0.y, bflo(t.y) + w1 * a1.x + w2 * b1.x, bfhi(t.y) + w1 * a1.y + w2 * b1.y};
            v[j][1] = (f32x4){bflo(t.z) + w1 * a2.x + w2 * b2.x, bfhi(t.z) + w1 * a2.y + w2 * b2.y, bflo(t.w) + w1 * a3.x + w2 * b3.x, bfhi(t.w) + w1 * a3.y + w2 * b3.y};
#pragma unroll
            for (int q = 0; q < 2; ++q) s += (v[j][q].x * v[j][q].x + v[j][q].y * v[j][q].y) + (v[j][q].z * v[j][q].z + v[j][q].w * v[j][q].w);
        }
        const float rstd = 1.f / sqrtf(wave_sum(s) * (1.f / DM) + EPS);
        float* o = p.out + (size_t)m * DM + 8 * lane;
#pragma unroll
        for (int j = 0; j < 2; ++j) { *(f32x4*)(o + 512 * j) = v[j][0] * rstd * wv[j][0]; *(f32x4*)(o + 512 * j + 4) = v[j][1] * rstd * wv[j][1]; }
        R0 = R1; R1 = R2;
    }
#undef ISSUE_ROWS
#undef LOAD_REC
}

constexpr int NPHASE = 14;
__global__ void __launch_bounds__(NTHREADS, 2) fwd_kernel(Params p) {
    extern __shared__ __attribute__((aligned(16))) unsigned char lds[];
#if MK_ONE_LAUNCH
    cg::grid_group grid = cg::this_grid();
    volatile LAS unsigned* bst = (volatile LAS unsigned*)(LDS3(lds) + LDS_BYTES - 16);
    if (threadIdx.x < 2) bst[threadIdx.x] = 0u;
    __syncthreads();
    const XcdBarrier xbar = xcd_barrier_post((unsigned*)(p.ws + WS_BAR), bst);
#define SEAM(k) do { if (p.ph_lo <= (k) && (k) + 1 < p.ph_hi) { if ((k) == 0) grid.sync(); else xcd_barrier(xbar); } } while (0)
#else
#define SEAM(k) do { } while (0)
#endif
#ifndef PROBE_PHASE
#define PROBE_PHASE -1
#endif
#define IN(k) (p.ph_lo <= (k) && (k) < p.ph_hi && (k) != p.skip)
#define REPS(k) (((k) == PROBE_PHASE) ? 2 : 1)
    if (IN(0)) { _Pragma("unroll 1") for (int rep = 0; rep < REPS(0); ++rep) { phase0(p, lds); } } SEAM(0);
    if (IN(1)) { _Pragma("unroll 1") for (int rep = 0; rep < REPS(1); ++rep) { phase1(p, lds); } } SEAM(1);
    if (IN(2)) { _Pragma("unroll 1") for (int rep = 0; rep < REPS(2); ++rep) for (int it = blockIdx.x; it < NB * NCH; it += gridDim.x) { const int b = it / NCH, c = it % NCH; phase2_attn(p, lds, b, c); phase2_states(p, lds, b, c); } } SEAM(2);
    if (IN(3)) { _Pragma("unroll 1") for (int rep = 0; rep < REPS(3); ++rep) { phase3(p); } } SEAM(3);
    if (IN(4)) { _Pragma("unroll 1") for (int rep = 0; rep < REPS(4); ++rep) for (int it = blockIdx.x; it < NB * NCH; it += gridDim.x) { const int b = it / NCH, c = it % NCH; phase4(p, lds, b, c); } } SEAM(4);
    if (IN(5)) { _Pragma("unroll 1") for (int rep = 0; rep < REPS(5); ++rep) { phase5(p, lds); } } SEAM(5);
    if (IN(6)) { _Pragma("unroll 1") for (int rep = 0; rep < REPS(6); ++rep) { phase6(p, lds); } } SEAM(6);
    if (IN(7)) { _Pragma("unroll 1") for (int rep = 0; rep < REPS(7); ++rep) { phase7(p, lds); } } SEAM(7);
    if (IN(8)) { phase8(p, lds); } SEAM(8);
    if (IN(9)) { phase9(p, lds); } SEAM(9);
    if (IN(11)) { _Pragma("unroll 1") for (int rep = 0; rep < REPS(11); ++rep) { phase11(p, lds); } } SEAM(11);
    if (IN(12)) { _Pragma("unroll 1") for (int rep = 0; rep < REPS(12); ++rep) { phase12(p, lds); } } SEAM(12);
    if (IN(13)) { _Pragma("unroll 1") for (int rep = 0; rep < REPS(13); ++rep) { phase13(p, lds); } }
#undef IN
#undef SEAM
}

extern "C" void kernel_launch(void* const* d_in, const int* in_sizes, int n_in, void* d_out, int out_size, void* d_ws, size_t ws_size, hipStream_t stream) {
    static int grid = 0;
    if (grid == 0) {
        if (n_in != 28 || out_size != NT * DM || ws_size < WS_NEED) { fprintf(stderr, "kernel_launch: unexpected sizes n_in %d out %d ws %zu\n", n_in, out_size, ws_size); grid = -1; return; }
        int dev = 0, cus = 0, per_cu = 0;
        hipGetDevice(&dev);
        hipDeviceGetAttribute(&cus, hipDeviceAttributeMultiprocessorCount, dev);
        if (hipFuncSetAttribute((const void*)fwd_kernel, hipFuncAttributeMaxDynamicSharedMemorySize, LDS_BYTES) != hipSuccess) { fprintf(stderr, "kernel_launch: hipFuncSetAttribute failed\n"); grid = -1; return; }
        if (hipOccupancyMaxActiveBlocksPerMultiprocessor(&per_cu, (const void*)fwd_kernel, NTHREADS, LDS_BYTES) != hipSuccess || per_cu < 1) { fprintf(stderr, "kernel_launch: occupancy query says %d\n", per_cu); per_cu = 1; }
        (void)hipGetLastError();
        grid = cus;
    }
    if (grid < 0) return;
    Params prm{};
    for (int i = 0; i < 28; ++i) prm.in[i] = (const float*)d_in[i];
    prm.out = (float*)d_out; prm.ws = (unsigned char*)d_ws;
    for (int i = 0; i < 8; ++i) prm.inv_freq[i] = powf(500000.0f, -(float)(2 * i) / 16.0f);
    prm.skip = -1;
#ifndef PROBE_SKIP
#define PROBE_SKIP -2
#endif
#if MK_ONE_LAUNCH
    for (int twice = 0; twice < ((PROBE_SKIP >= -1) ? 2 : 1); ++twice) {
    if (hipMemsetAsync((char*)d_ws + WS_CTL, 0, CTL_ZERO_BYTES, stream) != hipSuccess) { fprintf(stderr, "kernel_launch: memset failed\n"); return; }
#ifndef PROBE_TRUNC
#define PROBE_TRUNC NPHASE
#endif
    prm.ph_lo = 0; prm.ph_hi = twice ? PROBE_TRUNC : NPHASE; prm.skip = twice ? PROBE_SKIP : -1;
    void* args[] = {&prm};
    hipError_t e = hipLaunchCooperativeKernel((const void*)fwd_kernel, dim3(grid), dim3(NTHREADS), args, LDS_BYTES, stream);
    if (e != hipSuccess) fprintf(stderr, "cooperative launch failed: %s (grid %d)\n", hipGetErrorString(e), grid);
    }
#else
    if (hipMemsetAsync((char*)d_ws + WS_CTL, 0, CTL_ZERO_BYTES, stream) != hipSuccess) { fprintf(stderr, "kernel_launch: memset failed\n"); return; }
#ifndef PROBE_DUP
#define PROBE_DUP -1
#endif
    for (int ph = 0; ph < NPHASE; ++ph) {
        prm.ph_lo = ph; prm.ph_hi = ph + 1;
        hipLaunchKernelGGL(fwd_kernel, dim3(grid), dim3(NTHREADS), LDS_BYTES, stream, prm);
        if (ph == PROBE_DUP) hipLaunchKernelGGL(fwd_kernel, dim3(grid), dim3(NTHREADS), LDS_BYTES, stream, prm);
    }
#endif
}
```

```cpp
#include <hip/hip_runtime.h>
#include <hip/hip_cooperative_groups.h>
#include <cstdio>
#include <cmath>
namespace cg = cooperative_groups;

#ifndef MK_ONE_LAUNCH
#define MK_ONE_LAUNCH 1
#endif

typedef unsigned short bf16_t;
typedef short bf16x8 __attribute__((ext_vector_type(8)));
typedef float f32x4 __attribute__((ext_vector_type(4)));
typedef float f32x16 __attribute__((ext_vector_type(16)));
typedef unsigned u32x4 __attribute__((ext_vector_type(4)));
typedef unsigned u32x2 __attribute__((ext_vector_type(2)));

constexpr int NB = 8, SEQ = 4096, DM = 1024, NT = NB * SEQ;
constexpr int NPROJ = 2304, LDWIN = 2312;
constexpr int C_K = 512, C_V = 640, C_Z = 768, C_X = 1280, C_B = 1792, C_C = 2048;
constexpr int MEMT = 256, NMEM = NB * MEMT;
constexpr int NEXP = 32, EFF = 256;
constexpr int NCH = SEQ / 128;
constexpr float EPS = 1e-5f;
constexpr int NTHREADS = 512, NWAVES = 8;
constexpr int LDS_BYTES = 147456;

constexpr size_t MiB = (size_t)1 << 20;
constexpr size_t WS_CTL = 0, WS_BAR = 65536, CTL_ZERO_BYTES = 131072;
constexpr size_t WS_WIN = 1 * MiB, WS_WOUT = 6 * MiB, WS_WQ = 8 * MiB, WS_WKV = 9 * MiB, WS_WO = 11 * MiB, WS_WR = 12 * MiB;
constexpr size_t WS_WGU = 16 * MiB, WS_WD = 48 * MiB;
constexpr size_t WS_MEMH = 64 * MiB, WS_KMEM = 68 * MiB, WS_VMEMT = 70 * MiB, WS_DTRAW = 72 * MiB, WS_CDEC = 73 * MiB, WS_ROUTE = 74 * MiB;
constexpr size_t WS_LIST = 76 * MiB, WS_SSQ = 80 * MiB;
constexpr size_t WS_PROJ = 96 * MiB, WS_A2 = 240 * MiB, WS_STATES = 304 * MiB, WS_START = 368 * MiB;
constexpr size_t WS_X1 = 96 * MiB, WS_XB = 304 * MiB, WS_Q2 = 368 * MiB, WS_XO = 224 * MiB, WS_XG = 96 * MiB, WS_HID = 368 * MiB, WS_Y = 96 * MiB;
constexpr size_t WS_H1 = 416 * MiB;
constexpr size_t WS_NEED = 512 * MiB;

struct Params {
    const float* in[28];
    float* out;
    unsigned char* ws;
    float inv_freq[8];
    int ph_lo, ph_hi, skip, pad;
};

__device__ __forceinline__ unsigned f2bf(float f) { unsigned u = __float_as_uint(f); return (u + 0x7fffu + ((u >> 16) & 1u)) >> 16; }
__device__ __forceinline__ float bf2f(unsigned h) { return __uint_as_float(h << 16); }
__device__ __forceinline__ unsigned pk2(float lo, float hi) { return f2bf(lo) | (f2bf(hi) << 16); }
__device__ __forceinline__ float bflo(unsigned u) { return __uint_as_float(u << 16); }
__device__ __forceinline__ float bfhi(unsigned u) { return __uint_as_float(u & 0xffff0000u); }
__device__ __forceinline__ float wave_sum(float v) {
#pragma unroll
    for (int o = 32; o >= 1; o >>= 1) v += __shfl_xor(v, o);
    return v;
}
#define LDS_WAIT() asm volatile("s_waitcnt lgkmcnt(0)" ::: "memory")
__device__ __forceinline__ int opaque_tid() { int t = threadIdx.x; asm volatile("" : "+v"(t)); return t; }
__device__ __forceinline__ float siluf(float v) { return v * __builtin_amdgcn_rcpf(1.f + __expf(-v)); }
__device__ __forceinline__ f32x16 mfma32(bf16x8 a, bf16x8 b, f32x16 c) { return __builtin_amdgcn_mfma_f32_32x32x16_bf16(a, b, c, 0, 0, 0); }
__device__ __forceinline__ f32x16 zero16() { f32x16 z;
#pragma unroll
    for (int i = 0; i < 16; ++i) z[i] = 0.f;
    return z; }
__device__ __forceinline__ bf16x8 pack8(float a0, float a1, float a2, float a3, float a4, float a5, float a6, float a7) {
    u32x4 t; t.x = pk2(a0, a1); t.y = pk2(a2, a3); t.z = pk2(a4, a5); t.w = pk2(a6, a7);
    return __builtin_bit_cast(bf16x8, t);
}
__device__ __forceinline__ int crow(int i, int h) { return (i & 3) + 8 * (i >> 2) + 4 * h; }

namespace pg8 {
#define PG8_LAS __attribute__((address_space(3)))
typedef unsigned short bf16_t;
typedef short bf16x8 __attribute__((ext_vector_type(8)));
typedef float f32x4 __attribute__((ext_vector_type(4)));
typedef unsigned u32x4 __attribute__((ext_vector_type(4)));
constexpr int BM = 256, BK = 64, HALF = 128, HTB = HALF * BK * 2  , STAGE_BYTES = 8 * HTB, NXCD = 8, WGM = 8;

__host__ __device__ __forceinline__ int lds_byte(int r, int c) { const int st = (r >> 4) * 2 + (c >> 5), rr = r & 15, cc = c & 31, ob = rr * 64 + cc * 2; return st * 1024 + (ob ^ (((ob >> 9) & 1) << 5)); }
__host__ __device__ __forceinline__ void stage_rc(int b, int& R, int& C) { const int st = b / 1024, sb = b % 1024, swz = sb ^ (((sb >> 9) & 1) << 5); R = (st >> 1) * 16 + swz / 64; C = (st & 1) * 32 + (swz % 64) / 2; }
__host__ __device__ __forceinline__ int perm32(int rho) { const int n = rho >> 4, i = rho & 15; return 8 * (i >> 2) + 4 * n + (i & 3); }

struct Unit { int pm, pn; };
struct Gemm { const bf16_t* A; const bf16_t* Bt; int M, N, K; };

struct StaticOrder {
    int nM, nN, nwg, G, c;
    __host__ __device__ void init(int M, int N, int G_, int c_) { nM = M / BM; nN = N / BM; nwg = nM * nN; G = G_; c = c_; }
    __host__ __device__ bool next(int i, Unit& u) const {
        const long L = (long)i * G + c; if (L >= nwg) return false;
        int wgid = (int)L; { const int q = nwg / NXCD, r = nwg % NXCD, xcd = wgid % NXCD, off = wgid / NXCD; wgid = (xcd < r ? xcd * (q + 1) : r * (q + 1) + (xcd - r) * q) + off; }
        const int nig = WGM * nN, gid = wgid / nig, fm = gid * WGM, gsz = (nM - fm) < WGM ? (nM - fm) : WGM;
        u.pm = fm + ((wgid % nig) % gsz); u.pn = (wgid % nig) / gsz; return true;
    }
    __device__ __forceinline__ void a_ready(const Unit&) const {}
    __device__ __forceinline__ void done(const Unit&) const {}
};
__device__ __forceinline__ unsigned cvt_pk_bf16(float lo, float hi) { unsigned r; asm volatile("v_cvt_pk_bf16_f32 %0, %1, %2" : "=v"(r) : "v"(lo), "v"(hi)); return r; }
typedef float f32x2 __attribute__((ext_vector_type(2)));
template <class Epi, class Sched, bool ALIGN_EPI = false, bool SP2 = false>
__device__ __forceinline__ void gemm_phase(PG8_LAS unsigned char* lds, const Gemm g, const Sched& S, const Epi& E) {
    const int tid = threadIdx.x, wid = __builtin_amdgcn_readfirstlane(tid >> 6), lane = tid & 63, wr = wid >> 2, wc = wid & 3, fr = lane & 15, fq = lane >> 4;
    const int K = g.K, nt = K / BK;
    unsigned voffA[2], voffB[2];
#pragma unroll
    for (int i = 0; i < 2; ++i) { int R, C; stage_rc(tid * 16 + i * 8192, R, C); const int Rb = Epi::PERM ? ((R & ~31) + perm32(R & 31)) : R;
        voffA[i] = (unsigned)(R * K + C) * 2u; voffB[i] = (unsigned)(Rb * K + C) * 2u; }
    const size_t kstep = (size_t)(BK * 2);
    const size_t hstep = (size_t)HALF * K * 2;
    const size_t tstep = 2 * hstep;
    const unsigned ldsw = (unsigned)wid * 1024u;
    const int aoff = lds_byte(wr * 64 + fr, fq * 8), boff = lds_byte(wc * 32 + fr, fq * 8);
#define PG8_SA(b, h) (((b) * 2 + (h)) * HTB)
#define PG8_SB(b, h) ((4 + (b) * 2 + (h)) * HTB)
#define PG8_STAGE(bufoff, gbase, voff) do { _Pragma("unroll") for (int _i = 0; _i < 2; ++_i) \
        __builtin_amdgcn_global_load_lds((const unsigned*)((const char*)(gbase) + (voff)[_i]), (PG8_LAS unsigned*)(lds + (bufoff) + ldsw + _i * 8192), 16, 0, 0); } while (0)
#define PG8_LDA(dst, b, h) do { _Pragma("unroll") for (int m = 0; m < 4; ++m) _Pragma("unroll") for (int k = 0; k < 2; ++k) dst[m][k] = *(const PG8_LAS bf16x8*)(lds + PG8_SA(b, h) + aoff + m * 2048 + k * 1024); } while (0)
#define PG8_LDB(dst, b, h) do { _Pragma("unroll") for (int n = 0; n < 2; ++n) _Pragma("unroll") for (int k = 0; k < 2; ++k) dst[n][k] = *(const PG8_LAS bf16x8*)(lds + PG8_SB(b, h) + boff + n * 2048 + k * 1024); } while (0)
#define PG8_MMA(ai, bj, At, Bt) do { __builtin_amdgcn_s_setprio(1); _Pragma("unroll") for (int m = 0; m < 4; ++m) _Pragma("unroll") for (int n = 0; n < 2; ++n) _Pragma("unroll") for (int k = 0; k < 2; ++k) \
        acc[ai][bj][m][n] = __builtin_amdgcn_mfma_f32_16x16x32_bf16(Bt[n][k], At[m][k], acc[ai][bj][m][n], 0, 0, 0); __builtin_amdgcn_s_setprio(0); } while (0)
#define PG8_WAIT_V(n) asm volatile("s_waitcnt vmcnt(" #n ")" ::: "memory")
#define PG8_WAIT_L(n) asm volatile("s_waitcnt lgkmcnt(" #n ")" ::: "memory")
#define PG8_BAR __builtin_amdgcn_s_barrier()
#define PG8_SCHED __builtin_amdgcn_sched_barrier(0)
    Unit cur, nxt; int ui = 0;
    if (!S.next(0, cur)) return;
    f32x4 acc[2][2][4][2];
#pragma unroll
    for (int a = 0; a < 2; ++a)
#pragma unroll
        for (int b = 0; b < 2; ++b)
#pragma unroll
            for (int m = 0; m < 4; ++m)
#pragma unroll
                for (int n = 0; n < 2; ++n) acc[a][b][m][n] = (f32x4){0.f, 0.f, 0.f, 0.f};
    bf16x8 At[4][2], B0[2][2], B1[2][2];
    const char* cA = (const char*)g.A + (size_t)cur.pm * tstep; const char* cB = (const char*)g.Bt + (size_t)cur.pn * tstep;
    S.a_ready(cur);
    if constexpr (SP2) {
        PG8_STAGE(PG8_SB(0, 0), cB, voffB); PG8_STAGE(PG8_SB(0, 1), cB + hstep, voffB); PG8_STAGE(PG8_SA(0, 0), cA, voffA); PG8_STAGE(PG8_SA(0, 1), cA + hstep, voffA);
        if (wr == 1) PG8_BAR;
        PG8_WAIT_V(2); PG8_BAR;
        PG8_STAGE(PG8_SB(1, 0), cB + kstep, voffB); PG8_STAGE(PG8_SA(1, 0), cA + kstep, voffA); PG8_STAGE(PG8_SB(1, 1), cB + hstep + kstep, voffB);
        PG8_WAIT_V(6); PG8_BAR;
    } else {
        PG8_STAGE(PG8_SB(0, 0), cB, voffB); PG8_STAGE(PG8_SA(0, 0), cA, voffA); PG8_STAGE(PG8_SB(0, 1), cB + hstep, voffB); PG8_STAGE(PG8_SA(0, 1), cA + hstep, voffA);
        if (wr == 1) PG8_BAR;
        PG8_WAIT_V(4); PG8_BAR;
        PG8_STAGE(PG8_SB(1, 0), cB + kstep, voffB); PG8_STAGE(PG8_SA(1, 0), cA + kstep, voffA); PG8_STAGE(PG8_SB(1, 1), cB + hstep + kstep, voffB);
        PG8_WAIT_V(6); PG8_BAR;
    }
    for (;;) {
        const bool has_next = S.next(ui + 1, nxt);
        const char* nA = has_next ? (const char*)g.A + (size_t)nxt.pm * tstep : cA; const char* nB = has_next ? (const char*)g.Bt + (size_t)nxt.pn * tstep : cB;
        for (int t = 0; t < nt; t += 2) {
            const bool last = (t == nt - 2);
            const char* a1 = cA + (size_t)(t + 1) * kstep;
            const char* a2 = last ? nA : cA + (size_t)(t + 2) * kstep; const char* b2 = last ? nB : cB + (size_t)(t + 2) * kstep;
            const char* a3 = a2 + kstep; const char* b3 = b2 + kstep;
            if (last && has_next) S.a_ready(nxt);
            if constexpr (SP2) {
            PG8_LDB(B0, 0, 0); PG8_LDB(B1, 0, 1); PG8_SCHED; PG8_LDA(At, 0, 0); PG8_STAGE(PG8_SA(1, 1), a1 + hstep, voffA);
            PG8_WAIT_V(8); PG8_WAIT_L(0); PG8_BAR; PG8_MMA(0, 0, At, B0); PG8_MMA(0, 1, At, B1); PG8_BAR; PG8_SCHED;
            PG8_LDA(At, 0, 1); PG8_STAGE(PG8_SB(0, 0), b2, voffB); PG8_STAGE(PG8_SB(0, 1), b2 + hstep, voffB); PG8_STAGE(PG8_SA(0, 0), a2, voffA);
            PG8_WAIT_V(8); PG8_WAIT_L(0); PG8_BAR; PG8_MMA(1, 0, At, B0); PG8_MMA(1, 1, At, B1); PG8_BAR; PG8_SCHED;
            PG8_LDB(B0, 1, 0); PG8_LDB(B1, 1, 1); PG8_SCHED; PG8_LDA(At, 1, 0); PG8_STAGE(PG8_SA(0, 1), a2 + hstep, voffA);
            PG8_WAIT_V(8); PG8_WAIT_L(0); PG8_BAR; PG8_MMA(0, 0, At, B0); PG8_MMA(0, 1, At, B1); PG8_BAR; PG8_SCHED;
            PG8_LDA(At, 1, 1); PG8_STAGE(PG8_SB(1, 0), b3, voffB); PG8_STAGE(PG8_SB(1, 1), b3 + hstep, voffB); PG8_STAGE(PG8_SA(1, 0), a3, voffA);
            PG8_WAIT_V(8); PG8_WAIT_L(0); PG8_BAR; PG8_MMA(1, 0, At, B0); PG8_MMA(1, 1, At, B1); PG8_BAR; PG8_SCHED;
            } else {
            PG8_LDB(B0, 0, 0); PG8_SCHED; PG8_LDA(At, 0, 0); PG8_STAGE(PG8_SA(1, 1), a1 + hstep, voffA);
            PG8_WAIT_L(8); PG8_BAR; PG8_WAIT_L(0); PG8_MMA(0, 0, At, B0); PG8_BAR; PG8_SCHED;
            PG8_LDB(B1, 0, 1); PG8_STAGE(PG8_SB(0, 0), b2, voffB);
            PG8_BAR; PG8_WAIT_L(0); PG8_MMA(0, 1, At, B1); PG8_BAR;
            PG8_LDA(At, 0, 1); PG8_STAGE(PG8_SA(0, 0), a2, voffA);
            PG8_BAR; PG8_WAIT_L(0); PG8_MMA(1, 0, At, B0); PG8_BAR; PG8_SCHED;
            PG8_STAGE(PG8_SB(0, 1), b2 + hstep, voffB);
            PG8_WAIT_V(6); PG8_BAR; PG8_MMA(1, 1, At, B1); PG8_BAR;
            PG8_LDB(B0, 1, 0); PG8_SCHED; PG8_LDA(At, 1, 0); PG8_STAGE(PG8_SA(0, 1), a2 + hstep, voffA);
            PG8_WAIT_L(8); PG8_BAR; PG8_WAIT_L(0); PG8_MMA(0, 0, At, B0); PG8_BAR; PG8_SCHED;
            PG8_LDB(B1, 1, 1); PG8_STAGE(PG8_SB(1, 0), b3, voffB);
            PG8_BAR; PG8_WAIT_L(0); PG8_MMA(0, 1, At, B1); PG8_BAR;
            PG8_LDA(At, 1, 1); PG8_STAGE(PG8_SA(1, 0), a3, voffA);
            PG8_BAR; PG8_WAIT_L(0); PG8_MMA(1, 0, At, B0); PG8_BAR; PG8_SCHED;
            PG8_STAGE(PG8_SB(1, 1), b3 + hstep, voffB);
            PG8_WAIT_V(6); PG8_BAR; PG8_MMA(1, 1, At, B1); PG8_BAR;
            }
        }
        if constexpr (ALIGN_EPI) { if (wr == 0) PG8_BAR; }
        if constexpr (!Epi::AFTER_DRAIN) { E(acc, cur, wr, wc, fr, fq); S.done(cur); }
        if (!has_next) break;
#pragma unroll
        for (int a = 0; a < 2; ++a)
#pragma unroll
            for (int b = 0; b < 2; ++b)
#pragma unroll
                for (int m = 0; m < 4; ++m)
#pragma unroll
                    for (int n = 0; n < 2; ++n) acc[a][b][m][n] = (f32x4){0.f, 0.f, 0.f, 0.f};
        cur = nxt; cA = nA; cB = nB; ++ui;
        if constexpr (ALIGN_EPI) { if (wr == 1) PG8_BAR; }
    }
    PG8_WAIT_V(0);
    if constexpr (!ALIGN_EPI) { if (wr == 0) PG8_BAR; }
    PG8_BAR;
    if constexpr (Epi::AFTER_DRAIN) { E.fused(acc, cur, wr, wc, fr, fq, lds, wid, lane); S.done(cur); }
#undef PG8_SA
#undef PG8_SB
#undef PG8_STAGE
#undef PG8_LDA
#undef PG8_LDB
#undef PG8_MMA
#undef PG8_WAIT_V
#undef PG8_WAIT_L
#undef PG8_BAR
#undef PG8_SCHED
}

template <class Epi, class Sched, bool ALIGN_EPI = false, bool SP2 = false>
__device__ __forceinline__ void gemm_phase_g(PG8_LAS unsigned char* lds, const Gemm g, const Sched& S, const Epi& E, const PG8_LAS unsigned* rowtab) {
    const int tid = threadIdx.x, wid = __builtin_amdgcn_readfirstlane(tid >> 6), lane = tid & 63, wr = wid >> 2, wc = wid & 3, fr = lane & 15, fq = lane >> 4;
    const int K = g.K, nt = K / BK;
    unsigned voffA[2], voffB[2]; int RA[2]; unsigned CA2[2];
#pragma unroll
    for (int i = 0; i < 2; ++i) { int R, C; stage_rc(tid * 16 + i * 8192, R, C); const int Rb = Epi::PERM ? ((R & ~31) + perm32(R & 31)) : R;
        voffA[i] = (unsigned)(R * K + C) * 2u; voffB[i] = (unsigned)(Rb * K + C) * 2u; RA[i] = R; CA2[i] = (unsigned)C * 2u; }
    unsigned vA0[2], vA1[2], nvA0[2], nvA1[2];
#pragma unroll
    for (int i = 0; i < 2; ++i) { vA0[i] = rowtab[RA[i]] + CA2[i]; vA1[i] = rowtab[128 + RA[i]] + CA2[i]; nvA0[i] = vA0[i]; nvA1[i] = vA1[i]; }
    const size_t kstep = (size_t)(BK * 2);
    const size_t hstep = (size_t)HALF * K * 2;
    const size_t tstep = 2 * hstep;
    const unsigned ldsw = (unsigned)wid * 1024u;
    const int aoff = lds_byte(wr * 64 + fr, fq * 8), boff = lds_byte(wc * 32 + fr, fq * 8);
#define PG8_SA(b, h) (((b) * 2 + (h)) * HTB)
#define PG8_SB(b, h) ((4 + (b) * 2 + (h)) * HTB)
#define PG8_STAGE(bufoff, gbase, voff) do { _Pragma("unroll") for (int _i = 0; _i < 2; ++_i) \
        __builtin_amdgcn_global_load_lds((const unsigned*)((const char*)(gbase) + (voff)[_i]), (PG8_LAS unsigned*)(lds + (bufoff) + ldsw + _i * 8192), 16, 0, 0); } while (0)
#define PG8_LDA(dst, b, h) do { _Pragma("unroll") for (int m = 0; m < 4; ++m) _Pragma("unroll") for (int k = 0; k < 2; ++k) dst[m][k] = *(const PG8_LAS bf16x8*)(lds + PG8_SA(b, h) + aoff + m * 2048 + k * 1024); } while (0)
#define PG8_LDB(dst, b, h) do { _Pragma("unroll") for (int n = 0; n < 2; ++n) _Pragma("unroll") for (int k = 0; k < 2; ++k) dst[n][k] = *(const PG8_LAS bf16x8*)(lds + PG8_SB(b, h) + boff + n * 2048 + k * 1024); } while (0)
#define PG8_MMA(ai, bj, At, Bt) do { __builtin_amdgcn_s_setprio(1); _Pragma("unroll") for (int m = 0; m < 4; ++m) _Pragma("unroll") for (int n = 0; n < 2; ++n) _Pragma("unroll") for (int k = 0; k < 2; ++k) \
        acc[ai][bj][m][n] = __builtin_amdgcn_mfma_f32_16x16x32_bf16(Bt[n][k], At[m][k], acc[ai][bj][m][n], 0, 0, 0); __builtin_amdgcn_s_setprio(0); } while (0)
#define PG8_WAIT_V(n) asm volatile("s_waitcnt vmcnt(" #n ")" ::: "memory")
#define PG8_WAIT_L(n) asm volatile("s_waitcnt lgkmcnt(" #n ")" ::: "memory")
#define PG8_BAR __builtin_amdgcn_s_barrier()
#define PG8_SCHED __builtin_amdgcn_sched_barrier(0)
    Unit cur, nxt; int ui = 0;
    if (!S.next(0, cur)) return;
    f32x4 acc[2][2][4][2];
#pragma unroll
    for (int a = 0; a < 2; ++a)
#pragma unroll
        for (int b = 0; b < 2; ++b)
#pragma unroll
            for (int m = 0; m < 4; ++m)
#pragma unroll
                for (int n = 0; n < 2; ++n) acc[a][b][m][n] = (f32x4){0.f, 0.f, 0.f, 0.f};
    bf16x8 At[4][2], B0[2][2], B1[2][2];
    const char* cA = (const char*)g.A; const char* cB = (const char*)g.Bt + (size_t)cur.pn * tstep;
    S.a_ready(cur);
    if constexpr (SP2) {
        PG8_STAGE(PG8_SB(0, 0), cB, voffB); PG8_STAGE(PG8_SB(0, 1), cB + hstep, voffB); PG8_STAGE(PG8_SA(0, 0), cA, vA0); PG8_STAGE(PG8_SA(0, 1), cA, vA1);
        if (wr == 1) PG8_BAR;
        PG8_WAIT_V(2); PG8_BAR;
        PG8_STAGE(PG8_SB(1, 0), cB + kstep, voffB); PG8_STAGE(PG8_SA(1, 0), cA + kstep, vA0); PG8_STAGE(PG8_SB(1, 1), cB + hstep + kstep, voffB);
        PG8_WAIT_V(6); PG8_BAR;
    } else {
        PG8_STAGE(PG8_SB(0, 0), cB, voffB); PG8_STAGE(PG8_SA(0, 0), cA, vA0); PG8_STAGE(PG8_SB(0, 1), cB + hstep, voffB); PG8_STAGE(PG8_SA(0, 1), cA, vA1);
        if (wr == 1) PG8_BAR;
        PG8_WAIT_V(4); PG8_BAR;
        PG8_STAGE(PG8_SB(1, 0), cB + kstep, voffB); PG8_STAGE(PG8_SA(1, 0), cA + kstep, vA0); PG8_STAGE(PG8_SB(1, 1), cB + hstep + kstep, voffB);
        PG8_WAIT_V(6); PG8_BAR;
    }
    for (;;) {
        const bool has_next = S.next(ui + 1, nxt);
        if (has_next) {
#pragma unroll
            for (int i = 0; i < 2; ++i) { nvA0[i] = rowtab[(ui + 1) * 256 + RA[i]] + CA2[i]; nvA1[i] = rowtab[(ui + 1) * 256 + 128 + RA[i]] + CA2[i]; }
        }
        const char* nA = cA; const char* nB = has_next ? (const char*)g.Bt + (size_t)nxt.pn * tstep : cB;
        for (int t = 0; t < nt; t += 2) {
            const bool last = (t == nt - 2);
            unsigned sA0[2], sA1[2];
#pragma unroll
            for (int i = 0; i < 2; ++i) { sA0[i] = last ? nvA0[i] : vA0[i]; sA1[i] = last ? nvA1[i] : vA1[i]; }
            const char* a1 = cA + (size_t)(t + 1) * kstep;
            const char* a2 = last ? nA : cA + (size_t)(t + 2) * kstep; const char* b2 = last ? nB : cB + (size_t)(t + 2) * kstep;
            const char* a3 = a2 + kstep; const char* b3 = b2 + kstep;
            if (last && has_next) S.a_ready(nxt);
            if constexpr (SP2) {
            PG8_LDB(B0, 0, 0); PG8_LDB(B1, 0, 1); PG8_SCHED; PG8_LDA(At, 0, 0); PG8_STAGE(PG8_SA(1, 1), a1, vA1);
            PG8_WAIT_V(8); PG8_WAIT_L(0); PG8_BAR; PG8_MMA(0, 0, At, B0); PG8_MMA(0, 1, At, B1); PG8_BAR; PG8_SCHED;
            PG8_LDA(At, 0, 1); PG8_STAGE(PG8_SB(0, 0), b2, voffB); PG8_STAGE(PG8_SB(0, 1), b2 + hstep, voffB); PG8_STAGE(PG8_SA(0, 0), a2, sA0);
            PG8_WAIT_V(8); PG8_WAIT_L(0); PG8_BAR; PG8_MMA(1, 0, At, B0); PG8_MMA(1, 1, At, B1); PG8_BAR; PG8_SCHED;
            PG8_LDB(B0, 1, 0); PG8_LDB(B1, 1, 1); PG8_SCHED; PG8_LDA(At, 1, 0); PG8_STAGE(PG8_SA(0, 1), a2, sA1);
            PG8_WAIT_V(8); PG8_WAIT_L(0); PG8_BAR; PG8_MMA(0, 0, At, B0); PG8_MMA(0, 1, At, B1); PG8_BAR; PG8_SCHED;
            PG8_LDA(At, 1, 1); PG8_STAGE(PG8_SB(1, 0), b3, voffB); PG8_STAGE(PG8_SB(1, 1), b3 + hstep, voffB); PG8_STAGE(PG8_SA(1, 0), a3, sA0);
            PG8_WAIT_V(8); PG8_WAIT_L(0); PG8_BAR; PG8_MMA(1, 0, At, B0); PG8_MMA(1, 1, At, B1); PG8_BAR; PG8_SCHED;
            } else {
            PG8_LDB(B0, 0, 0); PG8_SCHED; PG8_LDA(At, 0, 0); PG8_STAGE(PG8_SA(1, 1), a1, vA1);
            PG8_WAIT_L(8); PG8_BAR; PG8_WAIT_L(0); PG8_MMA(0, 0, At, B0); PG8_BAR; PG8_SCHED;
            PG8_LDB(B1, 0, 1); PG8_STAGE(PG8_SB(0, 0), b2, voffB);
            PG8_BAR; PG8_WAIT_L(0); PG8_MMA(0, 1, At, B1); PG8_BAR;
            PG8_LDA(At, 0, 1); PG8_STAGE(PG8_SA(0, 0), a2, sA0);
            PG8_BAR; PG8_WAIT_L(0); PG8_MMA(1, 0, At, B0); PG8_BAR; PG8_SCHED;
            PG8_STAGE(PG8_SB(0, 1), b2 + hstep, voffB);
            PG8_WAIT_V(6); PG8_BAR; PG8_MMA(1, 1, At, B1); PG8_BAR;
            PG8_LDB(B0, 1, 0); PG8_SCHED; PG8_LDA(At, 1, 0); PG8_STAGE(PG8_SA(0, 1), a2, sA1);
            PG8_WAIT_L(8); PG8_BAR; PG8_WAIT_L(0); PG8_MMA(0, 0, At, B0); PG8_BAR; PG8_SCHED;
            PG8_LDB(B1, 1, 1); PG8_STAGE(PG8_SB(1, 0), b3, voffB);
            PG8_BAR; PG8_WAIT_L(0); PG8_MMA(0, 1, At, B1); PG8_BAR;
            PG8_LDA(At, 1, 1); PG8_STAGE(PG8_SA(1, 0), a3, sA0);
            PG8_BAR; PG8_WAIT_L(0); PG8_MMA(1, 0, At, B0); PG8_BAR; PG8_SCHED;
            PG8_STAGE(PG8_SB(1, 1), b3 + hstep, voffB);
            PG8_WAIT_V(6); PG8_BAR; PG8_MMA(1, 1, At, B1); PG8_BAR;
            }
        }
        if constexpr (ALIGN_EPI) { if (wr == 0) PG8_BAR; }
        if constexpr (!Epi::AFTER_DRAIN) { E(acc, cur, wr, wc, fr, fq); S.done(cur); }
        if (!has_next) break;
#pragma unroll
        for (int a = 0; a < 2; ++a)
#pragma unroll
            for (int b = 0; b < 2; ++b)
#pragma unroll
                for (int m = 0; m < 4; ++m)
#pragma unroll
                    for (int n = 0; n < 2; ++n) acc[a][b][m][n] = (f32x4){0.f, 0.f, 0.f, 0.f};
        cur = nxt; cA = nA; cB = nB; ++ui;
#pragma unroll
        for (int i = 0; i < 2; ++i) { vA0[i] = nvA0[i]; vA1[i] = nvA1[i]; }
        if constexpr (ALIGN_EPI) { if (wr == 1) PG8_BAR; }
    }
    PG8_WAIT_V(0);
    if constexpr (!ALIGN_EPI) { if (wr == 0) PG8_BAR; }
    PG8_BAR;
    if constexpr (Epi::AFTER_DRAIN) { E.fused(acc, cur, wr, wc, fr, fq, lds, wid, lane); S.done(cur); }
#undef PG8_SA
#undef PG8_SB
#undef PG8_STAGE
#undef PG8_LDA
#undef PG8_LDB
#undef PG8_MMA
#undef PG8_WAIT_V
#undef PG8_WAIT_L
#undef PG8_BAR
#undef PG8_SCHED
}

struct EpiBf16 {
    static constexpr bool PERM = true, AFTER_DRAIN = false;
    bf16_t* O; int ldc; int npn;
    __device__ __forceinline__ void operator()(const f32x4 (&acc)[2][2][4][2], const Unit& u, int wr, int wc, int fr, int fq) const {
        const int row0 = u.pm * BM + wr * 64 + fr, col0 = (u.pn % npn) * BM + wc * 32 + 8 * fq;
#pragma unroll
        for (int ai = 0; ai < 2; ++ai)
#pragma unroll
            for (int m = 0; m < 4; ++m) { bf16_t* rowp = O + (size_t)(row0 + ai * HALF + m * 16) * ldc + col0;
#pragma unroll
                for (int bj = 0; bj < 2; ++bj) { const f32x4 v0 = acc[ai][bj][m][0], v1 = acc[ai][bj][m][1];
                    u32x4 w; w.x = cvt_pk_bf16(v0[0], v0[1]); w.y = cvt_pk_bf16(v0[2], v0[3]); w.z = cvt_pk_bf16(v1[0], v1[1]); w.w = cvt_pk_bf16(v1[2], v1[3]);
                    *(u32x4*)(rowp + bj * HALF) = w; } }
    }
};
struct EpiY8 {
    static constexpr bool PERM = true, AFTER_DRAIN = false;
    unsigned char* O; int ldc; int npn;
    __device__ __forceinline__ void operator()(const f32x4 (&acc)[2][2][4][2], const Unit& u, int wr, int wc, int fr, int fq) const {
        typedef unsigned u32x2v __attribute__((ext_vector_type(2)));
        const int row0 = u.pm * BM + wr * 64 + fr, col0 = (u.pn % npn) * BM + wc * 32 + 8 * fq;
#pragma unroll
        for (int ai = 0; ai < 2; ++ai)
#pragma unroll
            for (int m = 0; m < 4; ++m) { unsigned char* rowp = O + (size_t)(row0 + ai * HALF + m * 16) * ldc + col0;
#pragma unroll
                for (int bj = 0; bj < 2; ++bj) { const f32x4 v0 = acc[ai][bj][m][0] * 16.f, v1 = acc[ai][bj][m][1] * 16.f;
                    int a = 0, b = 0;
                    a = __builtin_amdgcn_cvt_pk_fp8_f32(v0[0], v0[1], a, false); a = __builtin_amdgcn_cvt_pk_fp8_f32(v0[2], v0[3], a, true);
                    b = __builtin_amdgcn_cvt_pk_fp8_f32(v1[0], v1[1], b, false); b = __builtin_amdgcn_cvt_pk_fp8_f32(v1[2], v1[3], b, true);
                    *(u32x2v*)(rowp + bj * HALF) = (u32x2v){(unsigned)a, (unsigned)b}; } }
    }
};
struct EpiKV {
    static constexpr bool PERM = true, AFTER_DRAIN = false;
    bf16_t* kmem; bf16_t* vmemT;
    __device__ __forceinline__ void operator()(const f32x4 (&acc)[2][2][4][2], const Unit& u, int wr, int wc, int fr, int fq) const {
        const int row0 = u.pm * BM + wr * 64 + fr, col0 = u.pn * BM + wc * 32 + 8 * fq;
#pragma unroll
        for (int ai = 0; ai < 2; ++ai)
#pragma unroll
            for (int m = 0; m < 4; ++m) { const int row = row0 + ai * HALF + m * 16;
#pragma unroll
                for (int bj = 0; bj < 2; ++bj) { const f32x4 v0 = acc[ai][bj][m][0], v1 = acc[ai][bj][m][1]; const int col = col0 + bj * HALF;
                    if (col < 512) { u32x4 w; w.x = cvt_pk_bf16(v0[0], v0[1]); w.y = cvt_pk_bf16(v0[2], v0[3]); w.z = cvt_pk_bf16(v1[0], v1[1]); w.w = cvt_pk_bf16(v1[2], v1[3]);
                        *(u32x4*)(kmem + (size_t)row * 512 + col) = w; }
                    else { const int c2 = col - 512, hx = c2 >> 7, d = c2 & 127, b = row >> 8, key = row & 255;
                        bf16_t* vp = vmemT + (((size_t)b * 4 + hx) * 128 + d) * 256 + key;
                        const unsigned w0 = cvt_pk_bf16(v0[0], v0[1]), w1 = cvt_pk_bf16(v0[2], v0[3]), w2 = cvt_pk_bf16(v1[0], v1[1]), w3 = cvt_pk_bf16(v1[2], v1[3]);
                        vp[0 * 256] = (bf16_t)(w0 & 0xffffu); vp[1 * 256] = (bf16_t)(w0 >> 16); vp[2 * 256] = (bf16_t)(w1 & 0xffffu); vp[3 * 256] = (bf16_t)(w1 >> 16);
                        vp[4 * 256] = (bf16_t)(w2 & 0xffffu); vp[5 * 256] = (bf16_t)(w2 >> 16); vp[6 * 256] = (bf16_t)(w3 & 0xffffu); vp[7 * 256] = (bf16_t)(w3 >> 16); } } }
    }
};
template <bool XF32, bool STATS> struct EpiResid {
    static constexpr bool PERM = true, AFTER_DRAIN = false;
    const void* xin; bf16_t* xb; float* ssq;
    __device__ __forceinline__ void operator()(const f32x4 (&acc)[2][2][4][2], const Unit& u, int wr, int wc, int fr, int fq) const {
        const int col0 = u.pn * BM + wc * 32 + 8 * fq;
#pragma unroll
        for (int ai = 0; ai < 2; ++ai) {
            const size_t rowb = (size_t)(u.pm * BM + ai * HALF + wr * 64 + fr);
            f32x4 pf[4][2][2]; u32x4 pb[4][2];
#pragma unroll
            for (int m = 0; m < 4; ++m)
#pragma unroll
                for (int bj = 0; bj < 2; ++bj) { const size_t off = (rowb + m * 16) * 1024 + col0 + bj * HALF;
                    if (XF32) { pf[m][bj][0] = __builtin_nontemporal_load((const f32x4*)((const float*)xin + off)); pf[m][bj][1] = __builtin_nontemporal_load((const f32x4*)((const float*)xin + off + 4)); }
                    else pb[m][bj] = *(const u32x4*)((const bf16_t*)xin + off); }
#pragma unroll
            for (int m = 0; m < 4; ++m) { const size_t row = rowb + m * 16;
                float q = 0.f;
#pragma unroll
                for (int bj = 0; bj < 2; ++bj) { const size_t off = row * 1024 + col0 + bj * HALF;
                    f32x4 b0, b1;
                    if (XF32) { b0 = pf[m][bj][0]; b1 = pf[m][bj][1]; }
                    else { const u32x4 t = pb[m][bj];
                        b0[0] = __uint_as_float(t.x << 16); b0[1] = __uint_as_float(t.x & 0xffff0000u); b0[2] = __uint_as_float(t.y << 16); b0[3] = __uint_as_float(t.y & 0xffff0000u);
                        b1[0] = __uint_as_float(t.z << 16); b1[1] = __uint_as_float(t.z & 0xffff0000u); b1[2] = __uint_as_float(t.w << 16); b1[3] = __uint_as_float(t.w & 0xffff0000u); }
                    const f32x4 o0 = b0 + acc[ai][bj][m][0], o1 = b1 + acc[ai][bj][m][1];
                    u32x4 w; w.x = cvt_pk_bf16(o0[0], o0[1]); w.y = cvt_pk_bf16(o0[2], o0[3]); w.z = cvt_pk_bf16(o1[0], o1[1]); w.w = cvt_pk_bf16(o1[2], o1[3]);
                    *(u32x4*)(xb + off) = w;
                    if (STATS) q += ((o0[0] * o0[0] + o0[1] * o0[1]) + (o0[2] * o0[2] + o0[3] * o0[3])) + ((o1[0] * o1[0] + o1[1] * o1[1]) + (o1[2] * o1[2] + o1[3] * o1[3])); }
                if (STATS) { q += __shfl_xor(q, 16); q += __shfl_xor(q, 32); if (fq == 0) ssq[row * 16 + u.pn * 4 + wc] = q; } }
            asm volatile("" ::: "memory"); }
    }
};
struct EpiQ {
    static constexpr bool PERM = true, AFTER_DRAIN = false;
    bf16_t* O; const float* ssq;
    __device__ __forceinline__ void operator()(const f32x4 (&acc)[2][2][4][2], const Unit& u, int wr, int wc, int fr, int fq) const {
        const int row0 = u.pm * BM + wr * 64 + fr, col0 = u.pn * BM + wc * 32 + 8 * fq;
#pragma unroll
        for (int ai = 0; ai < 2; ++ai)
#pragma unroll
            for (int m = 0; m < 4; ++m) { const size_t row = (size_t)(row0 + ai * HALF + m * 16);
                const f32x4* sp = (const f32x4*)(ssq + row * 16); const f32x4 s0 = sp[0], s1 = sp[1], s2 = sp[2], s3 = sp[3];
                const float s = ((s0[0] + s0[1]) + (s0[2] + s0[3])) + ((s1[0] + s1[1]) + (s1[2] + s1[3])) + ((s2[0] + s2[1]) + (s2[2] + s2[3])) + ((s3[0] + s3[1]) + (s3[2] + s3[3]));
                const float rs = 1.f / sqrtf(s * (1.f / 1024.f) + 1e-5f);
                bf16_t* rowp = O + row * 512 + col0;
#pragma unroll
                for (int bj = 0; bj < 2; ++bj) { const f32x4 v0 = acc[ai][bj][m][0] * rs, v1 = acc[ai][bj][m][1] * rs;
                    u32x4 w; w.x = cvt_pk_bf16(v0[0], v0[1]); w.y = cvt_pk_bf16(v0[2], v0[3]); w.z = cvt_pk_bf16(v1[0], v1[1]); w.w = cvt_pk_bf16(v1[2], v1[3]);
                    *(u32x4*)(rowp + bj * HALF) = w; } }
    }
};
struct EpiGU {
    static constexpr bool PERM = true, AFTER_DRAIN = false;
    bf16_t* hid; const PG8_LAS float* rstab; int G, c;
    __device__ __forceinline__ void operator()(const f32x4 (&acc)[2][2][4][2], const Unit& u, int wr, int wc, int fr, int fq) const {
        const int row0 = u.pm * BM + wr * 64 + fr, j0 = (u.pn & 1) * 128 + wc * 16 + 4 * fq;
        const int ui = (u.pm * 2 + (u.pn & 1) - c) / G;
#pragma unroll
        for (int ai = 0; ai < 2; ++ai)
#pragma unroll
            for (int m = 0; m < 4; ++m) { bf16_t* rowp = hid + (size_t)(row0 + ai * HALF + m * 16) * 256 + j0;
                const float rs = rstab[ui * 256 + ai * HALF + wr * 64 + m * 16 + fr];
#pragma unroll
                for (int bj = 0; bj < 2; ++bj) { const f32x4 v0 = acc[ai][bj][m][0] * rs, v1 = acc[ai][bj][m][1] * rs;
                    const float h0 = v0[0] * __builtin_amdgcn_rcpf(1.f + __expf(-v0[0])) * v0[1], h1 = v0[2] * __builtin_amdgcn_rcpf(1.f + __expf(-v0[2])) * v0[3];
                    const float h2 = v1[0] * __builtin_amdgcn_rcpf(1.f + __expf(-v1[0])) * v1[1], h3 = v1[2] * __builtin_amdgcn_rcpf(1.f + __expf(-v1[2])) * v1[3];
                    typedef unsigned u32x2v __attribute__((ext_vector_type(2))); u32x2v w; w.x = cvt_pk_bf16(h0, h1); w.y = cvt_pk_bf16(h2, h3);
                    *(u32x2v*)(rowp + bj * 64) = w; } }
    }
};
struct SubOrder {
    int nM, nN, nwg, span, c;
    __device__ void init(int M, int N, int span_, int c_) { nM = M / BM; nN = N / BM; nwg = nM * nN; span = span_; c = c_; }
    __device__ bool next(int i, Unit& u) const { if (c < 0 || c >= span) return false; const int L = i * span + c; if (L >= nwg) return false; u.pm = L / nN; u.pn = L % nN; return true; }
    __device__ __forceinline__ void a_ready(const Unit&) const {}
    __device__ __forceinline__ void done(const Unit&) const {}
};
struct MoeOrder {
    const PG8_LAS int* tile_e; int nrt, npn, G, c;
    __device__ bool next(int i, Unit& u) const { const int L = i * G + c; if (L >= nrt * npn) return false; const int rt = L / npn, pnl = L % npn; u.pm = rt; u.pn = tile_e[rt] * npn + pnl; return true; }
    __device__ __forceinline__ void a_ready(const Unit&) const {}
    __device__ __forceinline__ void done(const Unit&) const {}
};
}

#define LAS __attribute__((address_space(3)))
#define XB_TMO      128
#define XB_XCNT(j)  (256  + 64 * (j))
#define XB_XSUB(j)  (1280 + 64 * (j))
#define XB_XGEN(j)  (2304 + 64 * (j))
#define XB_TOP      3328
#define XB_TOPGEN   3392
#define XCD_BAR_WORDS 3456
#define XB_SPIN_CAP (1u << 18)

__device__ __forceinline__ unsigned xb_ld(unsigned* p)              { return __hip_atomic_load(p, __ATOMIC_RELAXED, __HIP_MEMORY_SCOPE_AGENT); }
__device__ __forceinline__ unsigned xb_add(unsigned* p, unsigned v) { return __hip_atomic_fetch_add(p, v, __ATOMIC_RELAXED, __HIP_MEMORY_SCOPE_AGENT); }
__device__ __forceinline__ unsigned xb_xcc_id() { return (unsigned)__builtin_amdgcn_s_getreg((3 << 11) | 20) & 0xFu; }
#define XB_SPIN(cond, bar) do { unsigned _sp = 0; while (cond) { __builtin_amdgcn_s_sleep(1); \
    if ((++_sp & 255u) == 0u) { if (xb_ld(&(bar)[XB_TMO])) break; if (_sp > XB_SPIN_CAP) { atomicAdd(&(bar)[XB_TMO], 1u); break; } } } } while (0)

struct XcdBarrier {
    unsigned* bar; unsigned x;
    volatile LAS unsigned* st;
};

__device__ __forceinline__ XcdBarrier xcd_barrier_post(unsigned* bar, volatile LAS unsigned* st) {
    XcdBarrier b; b.bar = bar; b.x = xb_xcc_id(); b.st = st;
    if (threadIdx.x == 0) (void)xb_add(&bar[XB_XCNT(b.x)], 1u);
    return b;
}
__device__ __forceinline__ void xcd_barrier_complete(unsigned* bar, unsigned x, unsigned& nloc, unsigned& nx) {
    const unsigned G = gridDim.x * gridDim.y * gridDim.z;
    unsigned sum, cnt, mine, sp = 0u;
    for (;;) {
        sum = 0u; cnt = 0u; mine = 0u;
#pragma unroll
        for (unsigned j = 0; j < 16; ++j) { const unsigned c = xb_ld(&bar[XB_XCNT(j)]); sum += c; cnt += (c > 0u) ? 1u : 0u; mine = (j == x) ? c : mine; }
        if (sum == G) break;
        __builtin_amdgcn_s_sleep(1);
        if ((++sp & 255u) == 0u) { if (xb_ld(&bar[XB_TMO])) break; if (sp > XB_SPIN_CAP) { atomicAdd(&bar[XB_TMO], 1u); break; } }
    }
    nloc = mine > 0u ? mine : 1u; nx = cnt > 0u ? cnt : 1u;
}

__device__ __forceinline__ void xcd_barrier(const XcdBarrier& b) {
    asm volatile("s_waitcnt vmcnt(0)" ::: "memory");
    __syncthreads();
    if (threadIdx.x == 0) {
        unsigned* bar = b.bar;
        __builtin_amdgcn_s_waitcnt(0);
        unsigned nloc = b.st[0], nx = b.st[1];
        if (nloc == 0u) { xcd_barrier_complete(bar, b.x, nloc, nx); b.st[0] = nloc; b.st[1] = nx; }
        const unsigned old = xb_add(&bar[XB_XSUB(b.x)], 1u);
        const unsigned gen = old / nloc;
        if (old + 1u == (gen + 1u) * nloc) {
            __builtin_amdgcn_fence(__ATOMIC_RELEASE, "agent");
            asm volatile("s_waitcnt vmcnt(0)" ::: "memory");
            const unsigned og = xb_add(&bar[XB_TOP], 1u);
            const unsigned tg = og / nx;
            if (og + 1u == (tg + 1u) * nx) xb_add(&bar[XB_TOPGEN], 1u);
            else XB_SPIN(xb_ld(&bar[XB_TOPGEN]) == tg, bar);
            __builtin_amdgcn_fence(__ATOMIC_ACQUIRE, "agent");
            xb_add(&bar[XB_XGEN(b.x)], 1u);
            asm volatile("s_waitcnt vmcnt(0)" ::: "memory");
        } else {
            XB_SPIN(xb_ld(&bar[XB_XGEN(b.x)]) == gen, bar);
            __builtin_amdgcn_fence(__ATOMIC_ACQUIRE, "agent");
            asm volatile("s_waitcnt vmcnt(0)" ::: "memory");
        }
    }
    __syncthreads();
}

__device__ __forceinline__ void gemm128(unsigned char* lds, const bf16_t* arow, const bf16_t* brow, int K, f32x16& acc0, f32x16& acc1) {
    const int tid = opaque_tid(), lane = tid & 63, w = tid >> 6;
    bf16_t* sA = (bf16_t*)lds;
    bf16_t* sB = sA + 128 * 72;
    const int srow = tid >> 2, skc = (tid & 3) * 16;
    const bf16_t* ap = arow + skc;
    const bf16_t* bp = brow + skc;
    const int wm = w >> 1, wn = w & 1, r = lane & 31, h = lane >> 5;
    acc0 = zero16(); acc1 = zero16();
    for (int k0 = 0; k0 < K; k0 += 64) {
        const u32x4 a0 = *(const u32x4*)(ap + k0), a1 = *(const u32x4*)(ap + k0 + 8);
        const u32x4 b0 = *(const u32x4*)(bp + k0), b1 = *(const u32x4*)(bp + k0 + 8);
        __syncthreads();
        *(u32x4*)(sA + srow * 72 + skc) = a0; *(u32x4*)(sA + srow * 72 + skc + 8) = a1;
        *(u32x4*)(sB + srow * 72 + skc) = b0; *(u32x4*)(sB + srow * 72 + skc + 8) = b1;
        __syncthreads();
#pragma unroll
        for (int kk = 0; kk < 64; kk += 16) {
            const bf16x8 a = *(const bf16x8*)(sA + (wm * 32 + r) * 72 + kk + 8 * h);
            const bf16x8 bA = *(const bf16x8*)(sB + (wn * 64 + r) * 72 + kk + 8 * h);
            const bf16x8 bB = *(const bf16x8*)(sB + (wn * 64 + 32 + r) * 72 + kk + 8 * h);
            acc0 = mfma32(a, bA, acc0); acc1 = mfma32(a, bB, acc1);
        }
    }
    __syncthreads();
}

__device__ __forceinline__ void p0_transpose64(const float* W, int ldw, int K, int nblk, const float* scale, bf16_t* WT, int row_off, int row_mul, float* scr, int item, int lane) {
    const int kb = item / nblk, nb = item % nblk, k0 = 64 * kb, n0 = 64 * nb;
    f32x4 v[16];
    const float* wp = W + (size_t)(k0 + (lane >> 4)) * ldw + n0 + 4 * (lane & 15);
#pragma unroll
    for (int i = 0; i < 16; ++i) v[i] = __builtin_nontemporal_load((const f32x4*)(wp + (size_t)(4 * i) * ldw));
#pragma unroll
    for (int i = 0; i < 16; ++i) { const int kk = (lane >> 4) + 4 * i; const float sc = scale ? scale[k0 + kk] : 1.f; float* d = scr + kk * 65 + 4 * (lane & 15);
        d[0] = v[i].x * sc; d[1] = v[i].y * sc; d[2] = v[i].z * sc; d[3] = v[i].w * sc; }
    LDS_WAIT();
    const int c = lane & 7;
#pragma unroll
    for (int j = 0; j < 8; ++j) { const int n = (lane >> 3) + 8 * j; const float* sp = scr + (8 * c) * 65 + n;
        u32x4 o; o.x = pk2(sp[0 * 65], sp[1 * 65]); o.y = pk2(sp[2 * 65], sp[3 * 65]); o.z = pk2(sp[4 * 65], sp[5 * 65]); o.w = pk2(sp[6 * 65], sp[7 * 65]);
        *(u32x4*)(WT + (size_t)(row_off + (n0 + n) * row_mul) * K + k0 + 8 * c) = o; }
    LDS_WAIT();
}

__device__ __forceinline__ void phase0(const Params& p, unsigned char* lds) {
    const int tid = opaque_tid(), lane = tid & 63, w = tid >> 6;
    unsigned char* ws = p.ws;
    const int gw = blockIdx.x * NWAVES + w, NGW = gridDim.x * NWAVES;
    {
        bf16_t* WR = (bf16_t*)(ws + WS_WR);
        const float* w3 = p.in[19]; const float* wg = p.in[20]; const float* we = p.in[22];
        for (int i = blockIdx.x * NTHREADS + tid; i < 36 * 1024; i += gridDim.x * NTHREADS) {
            const int n = i >> 10, k = i & 1023;
            float v;
            if (n >= 32) v = wg[k * 4 + (n - 32)];
            else { const int hh = (n >> 2) & 1, ii = (n & 3) + 4 * (n >> 3), e = (2 * hh + (ii >> 3)) * 8 + (ii & 7); v = we[k * 32 + e]; }
            WR[i] = (bf16_t)f2bf(v * w3[k]);
        }
    }
    {
        float* scr = (float*)lds + w * (64 * 65);
        constexpr int I_IN = 16 * 36, I_OUT = 16 * 16, I_Q = 16 * 8, I_KV = 16 * 16, I_O = 8 * 16;
        constexpr int NITEMS = I_IN + I_OUT + I_Q + I_KV + I_O;
#pragma unroll 1
        for (int it = gw; it < NITEMS; it += NGW) {
            int r = it;
            if (r < I_IN) { p0_transpose64(p.in[4], LDWIN, 1024, 36, nullptr, (bf16_t*)(ws + WS_WIN), 0, 1, scr, r, lane); continue; } r -= I_IN;
            if (r < I_OUT) { p0_transpose64(p.in[13], 1024, 1024, 16, nullptr, (bf16_t*)(ws + WS_WOUT), 0, 1, scr, r, lane); continue; } r -= I_OUT;
            if (r < I_Q) { p0_transpose64(p.in[16], 512, 1024, 8, p.in[14], (bf16_t*)(ws + WS_WQ), 0, 1, scr, r, lane); continue; } r -= I_Q;
            if (r < I_KV) { p0_transpose64(p.in[17], 1024, 1024, 16, nullptr, (bf16_t*)(ws + WS_WKV), 0, 1, scr, r, lane); continue; } r -= I_KV;
            p0_transpose64(p.in[18], 1024, 512, 16, nullptr, (bf16_t*)(ws + WS_WO), 0, 1, scr, r, lane);
        }
    }
    __syncthreads();
    float* wdt = (float*)lds;
    {
        const float* win = p.in[4]; const float* w1 = p.in[3];
        for (int i = tid; i < 8192; i += NTHREADS) { const int k = i >> 3, n = i & 7; wdt[n * 1024 + k] = win[(size_t)k * LDWIN + 2304 + n] * w1[k]; }
    }
    __syncthreads();
    {
        const float* x = p.in[0]; const float* w1 = p.in[3];
        bf16_t* h1 = (bf16_t*)(ws + WS_H1); float* dtraw = (float*)(ws + WS_DTRAW);
        f32x4 wv[4];
#pragma unroll
        for (int j = 0; j < 4; ++j) wv[j] = *(const f32x4*)(w1 + 4 * lane + 256 * j);
        f32x4 nx[4];
        if (gw < NT) {
#pragma unroll
            for (int j = 0; j < 4; ++j) nx[j] = __builtin_nontemporal_load((const f32x4*)(x + (size_t)gw * DM) + lane + 64 * j);
        }
#pragma unroll 1
        for (int m = gw; m < NT; m += NGW) {
            f32x4 v[4];
#pragma unroll
            for (int j = 0; j < 4; ++j) v[j] = nx[j];
            if (m + NGW < NT) {
#pragma unroll
                for (int j = 0; j < 4; ++j) nx[j] = __builtin_nontemporal_load((const f32x4*)(x + (size_t)(m + NGW) * DM) + lane + 64 * j);
            }
            float a[16];
#pragma unroll
            for (int q = 0; q < 16; ++q) a[q] = 0.f;
#pragma unroll
            for (int j = 0; j < 4; ++j) a[0] += (v[j].x * v[j].x + v[j].y * v[j].y) + (v[j].z * v[j].z + v[j].w * v[j].w);
#pragma unroll
            for (int n = 0; n < 8; ++n)
#pragma unroll
                for (int j = 0; j < 4; ++j) { const f32x4 ww = *(const f32x4*)(wdt + n * 1024 + 4 * lane + 256 * j); a[1 + n] += (v[j].x * ww.x + v[j].y * ww.y) + (v[j].z * ww.z + v[j].w * ww.w); }
            float b8[8], b4[4], b2[2], b1;
            { const bool hi = (lane & 32) != 0;
#pragma unroll
              for (int q = 0; q < 8; ++q) { const float send = hi ? a[q] : a[q + 8], keep = hi ? a[q + 8] : a[q]; b8[q] = keep + __shfl_xor(send, 32); } }
            { const bool hi = (lane & 16) != 0;
#pragma unroll
              for (int q = 0; q < 4; ++q) { const float send = hi ? b8[q] : b8[q + 4], keep = hi ? b8[q + 4] : b8[q]; b4[q] = keep + __shfl_xor(send, 16); } }
            { const bool hi = (lane & 8) != 0;
#pragma unroll
              for (int q = 0; q < 2; ++q) { const float send = hi ? b4[q] : b4[q + 2], keep = hi ? b4[q + 2] : b4[q]; b2[q] = keep + __shfl_xor(send, 8); } }
            { const bool hi = (lane & 4) != 0; const float send = hi ? b2[0] : b2[1], keep = hi ? b2[1] : b2[0]; b1 = keep + __shfl_xor(send, 4); }
            b1 += __shfl_xor(b1, 2); b1 += __shfl_xor(b1, 1);
            const float rstd = 1.f / sqrtf(__shfl(b1, 0) * (1.f / DM) + EPS);
            const int slot = (lane >> 2) & 15;
            if ((lane & 3) == 0 && slot >= 1 && slot <= 8) dtraw[(size_t)m * 8 + (slot - 1)] = b1 * rstd;
            u32x2* o8 = (u32x2*)(h1 + (size_t)m * DM) + lane;
#pragma unroll
            for (int j = 0; j < 4; ++j) { u32x2 o; o.x = pk2(v[j].x * rstd * wv[j].x, v[j].y * rstd * wv[j].y); o.y = pk2(v[j].z * rstd * wv[j].z, v[j].w * rstd * wv[j].w); o8[64 * j] = o; }
        }
    }
    {
        const float* mem = p.in[1]; const float* wm = p.in[15];
        bf16_t* memh = (bf16_t*)(ws + WS_MEMH);
        f32x4 wv[4];
#pragma unroll
        for (int j = 0; j < 4; ++j) wv[j] = *(const f32x4*)(wm + 4 * lane + 256 * j);
        for (int m = gw; m < NMEM; m += NGW) {
            const f32x4* xr = (const f32x4*)(mem + (size_t)m * DM) + lane;
            f32x4 v[4]; float s = 0.f;
#pragma unroll
            for (int j = 0; j < 4; ++j) { v[j] = xr[64 * j]; s += (v[j].x * v[j].x + v[j].y * v[j].y) + (v[j].z * v[j].z + v[j].w * v[j].w); }
            const float rstd = 1.f / sqrtf(wave_sum(s) * (1.f / DM) + EPS);
            u32x2* o8 = (u32x2*)(memh + (size_t)m * DM) + lane;
#pragma unroll
            for (int j = 0; j < 4; ++j) { u32x2 o; o.x = pk2(v[j].x * rstd * wv[j].x, v[j].y * rstd * wv[j].y); o.y = pk2(v[j].z * rstd * wv[j].z, v[j].w * rstd * wv[j].w); o8[64 * j] = o; }
        }
    }
    __syncthreads();
}

__device__ __forceinline__ void expert_transposes(const Params& p, unsigned char* lds, int vw, int nvw) {
    const int lane = opaque_tid() & 63, w = (opaque_tid() >> 6);
    unsigned char* ws = p.ws;
    float* scr = (float*)lds + w * (64 * 65);
    constexpr int I_G = 32 * 16 * 4, I_D = 32 * 4 * 16;
#pragma unroll 1
    for (int it = vw; it < 2 * I_G + I_D; it += nvw) {
        int r = it;
        if (r < I_G) { const int e = r / 64, ri = r % 64; p0_transpose64(p.in[24] + (size_t)e * 1024 * 256, 256, 1024, 4, p.in[19], (bf16_t*)(ws + WS_WGU) + (size_t)e * 512 * 1024, 0, 2, scr, ri, lane); continue; } r -= I_G;
        if (r < I_G) { const int e = r / 64, ri = r % 64; p0_transpose64(p.in[25] + (size_t)e * 1024 * 256, 256, 1024, 4, p.in[19], (bf16_t*)(ws + WS_WGU) + (size_t)e * 512 * 1024, 1, 2, scr, ri, lane); continue; } r -= I_G;
        { const int e = r / 64, ri = r % 64; p0_transpose64(p.in[26] + (size_t)e * 256 * 1024, 1024, 256, 16, nullptr, (bf16_t*)(ws + WS_WD) + (size_t)e * 1024 * 256, 0, 1, scr, ri, lane); }
    }
}

#define LDS3(p) ((__attribute__((address_space(3))) unsigned char*)(p))
__device__ __forceinline__ void phase1(const Params& p, unsigned char* lds) {
    unsigned char* ws = p.ws;
#ifdef PROBE_PHASE
    _Pragma("unroll 1") for (int rep = 0; rep < ((PROBE_PHASE == 101) ? 2 : 1); ++rep)
#endif
    {
        pg8::Gemm g{(const bf16_t*)(ws + WS_H1), (const bf16_t*)(ws + WS_WIN), NT, NPROJ, DM};
        pg8::StaticOrder S; S.init(NT, NPROJ, (int)gridDim.x, (int)blockIdx.x);
        pg8::EpiBf16 E{(bf16_t*)(ws + WS_PROJ), NPROJ, NPROJ / 256};
        pg8::gemm_phase<pg8::EpiBf16, pg8::StaticOrder, true, true>(LDS3(lds), g, S, E);
    }
    {
        pg8::Gemm g{(const bf16_t*)(ws + WS_MEMH), (const bf16_t*)(ws + WS_WKV), NMEM, 1024, DM};
        pg8::SubOrder S; S.init(NMEM, 1024, 128, (int)blockIdx.x - 128);
        pg8::EpiKV E{(bf16_t*)(ws + WS_KMEM), (bf16_t*)(ws + WS_VMEMT)};
        pg8::gemm_phase<pg8::EpiKV, pg8::SubOrder, true, true>(LDS3(lds), g, S, E);
    }
    {
        const int w = opaque_tid() >> 6;
        if (gridDim.x == 256) { if (blockIdx.x >= 160) expert_transposes(p, lds, ((int)blockIdx.x - 160) * NWAVES + w, 96 * NWAVES); }
        else expert_transposes(p, lds, (int)blockIdx.x * NWAVES + w, (int)gridDim.x * NWAVES);
    }
}

__device__ __forceinline__ float bfel(const u32x4& v, int ci) { const unsigned wv = (ci >> 1) == 0 ? v.x : (ci >> 1) == 1 ? v.y : (ci >> 1) == 2 ? v.z : v.w; return (ci & 1) ? bfhi(wv) : bflo(wv); }
__device__ __forceinline__ void conv8_load(const Params& p, int b, int c, int l0, int ch0, u32x4 (&in)[11]) {
    const bf16_t* proj = (const bf16_t*)(p.ws + WS_PROJ);
    const int t0 = c * 128 + l0 - 3;
    const bf16_t* rp = proj + ((long)(b * SEQ) + t0) * NPROJ + C_X + ch0;
    asm volatile("" : "+v"(rp));
#pragma unroll
    for (int i = 0; i < 11; ++i) {
        const int t = t0 + i;
        in[i] = (u32x4){0u, 0u, 0u, 0u};
        if (t >= 0) in[i] = *(const u32x4*)(rp + (size_t)i * NPROJ);
    }
}
template <bool TRANS>
__device__ __forceinline__ void conv8_math(const Params& p, int ch0, const u32x4 (&in)[11], const float (&f)[8], u32x4 (&res)[8]) {
    const float* cw = p.in[6]; const float* cb = p.in[7];
    float wgt[4][8], bias[8];
#pragma unroll
    for (int j = 0; j < 4; ++j) { const f32x4 a = *(const f32x4*)(cw + j * 1024 + ch0), b2 = *(const f32x4*)(cw + j * 1024 + ch0 + 4);
        wgt[j][0] = a.x; wgt[j][1] = a.y; wgt[j][2] = a.z; wgt[j][3] = a.w; wgt[j][4] = b2.x; wgt[j][5] = b2.y; wgt[j][6] = b2.z; wgt[j][7] = b2.w; }
    { const f32x4 a = *(const f32x4*)(cb + ch0), b2 = *(const f32x4*)(cb + ch0 + 4); bias[0] = a.x; bias[1] = a.y; bias[2] = a.z; bias[3] = a.w; bias[4] = b2.x; bias[5] = b2.y; bias[6] = b2.z; bias[7] = b2.w; }
    if (TRANS) {
#pragma unroll
        for (int ci = 0; ci < 8; ++ci) {
            float o[8];
#pragma unroll
            for (int li = 0; li < 8; ++li) { float a = bias[ci];
#pragma unroll
                for (int j = 0; j < 4; ++j) a += wgt[j][ci] * bfel(in[li + j], ci);
                o[li] = siluf(a) * f[li]; }
            res[ci] = (u32x4){pk2(o[0], o[1]), pk2(o[2], o[3]), pk2(o[4], o[5]), pk2(o[6], o[7])};
        }
    } else {
#pragma unroll
        for (int li = 0; li < 8; ++li) {
            float o[8];
#pragma unroll
            for (int ci = 0; ci < 8; ++ci) { float a = bias[ci];
#pragma unroll
                for (int j = 0; j < 4; ++j) a += wgt[j][ci] * bfel(in[li + j], ci);
                o[ci] = siluf(a) * f[li]; }
            res[li] = (u32x4){pk2(o[0], o[1]), pk2(o[2], o[3]), pk2(o[4], o[5]), pk2(o[6], o[7])};
        }
    }
}
template <bool TRANS>
__device__ __forceinline__ void conv8x8(const Params& p, int b, int c, int l0, int ch0, const float (&f)[8], u32x4 (&res)[8]) {
    u32x4 in[11];
    conv8_load(p, b, c, l0, ch0, in);
    conv8_math<TRANS>(p, ch0, in, f, res);
}

__device__ __forceinline__ void conv2_load(const Params& p, int b, int c, int l0, int ch0, unsigned (&in)[11]) {
    const bf16_t* proj = (const bf16_t*)(p.ws + WS_PROJ);
    const int t0 = c * 128 + l0 - 3;
    const bf16_t* rp = proj + ((long)(b * SEQ) + t0) * NPROJ + C_X + ch0;
    asm volatile("" : "+v"(rp));
#pragma unroll
    for (int i = 0; i < 11; ++i) { const int t = t0 + i; in[i] = 0u; if (t >= 0) in[i] = *(const unsigned*)(rp + (size_t)i * NPROJ); }
}
__device__ __forceinline__ void conv2_math(const Params& p, int ch0, const unsigned (&in)[11], u32x4 (&res)[2]) {
    const float* cw = p.in[6]; const float* cb = p.in[7];
    float wgt[4][2], bias[2];
#pragma unroll
    for (int j = 0; j < 4; ++j) { wgt[j][0] = cw[j * 1024 + ch0]; wgt[j][1] = cw[j * 1024 + ch0 + 1]; }
    bias[0] = cb[ch0]; bias[1] = cb[ch0 + 1];
#pragma unroll
    for (int ci = 0; ci < 2; ++ci) {
        float o[8];
#pragma unroll
        for (int li = 0; li < 8; ++li) { float a = bias[ci];
#pragma unroll
            for (int j = 0; j < 4; ++j) a += wgt[j][ci] * (ci ? bfhi(in[li + j]) : bflo(in[li + j]));
            o[li] = siluf(a); }
        res[ci] = (u32x4){pk2(o[0], o[1]), pk2(o[2], o[3]), pk2(o[4], o[5]), pk2(o[6], o[7])};
    }
}

__device__ __forceinline__ void ssd_dt_cum(const Params& p, int b, int c, float* dts, float* cums) {
    const int tid = opaque_tid(), lane = tid & 63, w = tid >> 6;
    const float* dtraw = (const float*)(p.ws + WS_DTRAW);
    const float bias = p.in[8][w], a = -__expf(p.in[9][w]);
    const size_t row0 = (size_t)b * SEQ + c * 128;
    float x0 = dtraw[(row0 + 2 * lane) * 8 + w] + bias, x1 = dtraw[(row0 + 2 * lane + 1) * 8 + w] + bias;
    const float d0 = fmaxf(x0, 0.f) + log1pf(__expf(-fabsf(x0))), d1 = fmaxf(x1, 0.f) + log1pf(__expf(-fabsf(x1)));
    const float a0 = d0 * a, a1 = d1 * a;
    float s = a0 + a1;
#pragma unroll
    for (int o = 1; o < 64; o <<= 1) { const float t = __shfl_up(s, o); if (lane >= o) s += t; }
    dts[w * 128 + 2 * lane] = d0; dts[w * 128 + 2 * lane + 1] = d1;
    cums[w * 128 + 2 * lane] = s - a1; cums[w * 128 + 2 * lane + 1] = s;
}

__device__ __forceinline__ void attn_unit(const Params& p, const bf16_t* sK, const bf16_t* sV, const float* cs, const float* sn, float* ssq, int b, int blk, int hq, int rg, int lane, u32x2 (&oh)[8]) {
    const int r = lane & 31, h = lane >> 5;
    const bf16_t* proj = (const bf16_t*)(p.ws + WS_PROJ);
    const int tband0 = blk * 128 - 128;
    const bf16_t* qp = proj + (size_t)(b * SEQ + blk * 128 + rg * 32 + r) * NPROJ + hq * 64 + 8 * h;
    u32x4 qv[4];
#pragma unroll
    for (int kk = 0; kk < 4; ++kk) qv[kk] = *(const u32x4*)(qp + kk * 16);
    {
        u32x4 ot; ot.x = __shfl_xor(qv[0].x, 32); ot.y = __shfl_xor(qv[0].y, 32); ot.z = __shfl_xor(qv[0].z, 32); ot.w = __shfl_xor(qv[0].w, 32);
        const float* cp = cs + (128 + rg * 32 + r) * 8; const float* sp = sn + (128 + rg * 32 + r) * 8;
        float o[8];
#pragma unroll
        for (int f = 0; f < 8; ++f) {
            const float mine = bfel(qv[0], f), oth = bfel(ot, f), c = cp[f], sv = sp[f];
            o[f] = h ? (mine * c + oth * sv) : (mine * c - oth * sv);
        }
        qv[0] = (u32x4){pk2(o[0], o[1]), pk2(o[2], o[3]), pk2(o[4], o[5]), pk2(o[6], o[7])};
    }
    f32x16 S[5];
#pragma unroll
    for (int jt = 0; jt < 5; ++jt) S[jt] = zero16();
    const bf16_t* kp = sK + (rg * 32 + r) * 72 + 8 * h;
#pragma unroll
    for (int kk = 0; kk < 4; ++kk) {
        const bf16x8 qf = __builtin_bit_cast(bf16x8, qv[kk]);
#pragma unroll
        for (int jt = 0; jt < 5; ++jt) { const bf16x8 a = *(const bf16x8*)(kp + jt * (32 * 72) + kk * 16); S[jt] = mfma32(a, qf, S[jt]); }
    }
    const float sink = p.in[5][hq] * 8.f;
    float m = sink;
    const bool noprev = (blk == 0);
#pragma unroll
    for (int jt = 0; jt < 5; ++jt)
#pragma unroll
        for (int i = 0; i < 16; ++i) {
            const int cr = (i & 3) + 8 * (i >> 2) + 4 * h;
            bool ok = true;
            if (jt == 0) ok = cr > r;
            if (jt == 4) ok = cr <= r;
            if (noprev && (rg + jt) < 4) ok = false;
            const float v = ok ? S[jt][i] : -INFINITY; S[jt][i] = v; m = fmaxf(m, v);
        }
    m = fmaxf(m, __shfl_xor(m, 32));
    const float sc = 0.125f * 1.4426950408889634f;
    float sum = 0.f;
    bf16x8 P[10];
#pragma unroll
    for (int jt = 0; jt < 5; ++jt) {
        float e[16];
#pragma unroll
        for (int i = 0; i < 16; ++i) { e[i] = __builtin_amdgcn_exp2f((S[jt][i] - m) * sc); sum += e[i]; }
        P[2 * jt] = pack8(e[0], e[1], e[2], e[3], e[4], e[5], e[6], e[7]);
        P[2 * jt + 1] = pack8(e[8], e[9], e[10], e[11], e[12], e[13], e[14], e[15]);
    }
    sum += __shfl_xor(sum, 32);
    sum += __builtin_amdgcn_exp2f((sink - m) * sc);
    const float inv = 1.f / sum;
    f32x16 O0 = zero16(), O1 = zero16();
    const bf16_t* vp0 = sV + r * 260 + rg * 32 + 4 * h;
#pragma unroll
    for (int ts = 0; ts < 10; ++ts) {
        const bf16_t* vp = vp0 + 16 * ts;
        const u32x2 lo0 = *(const u32x2*)vp, hi0 = *(const u32x2*)(vp + 8);
        const u32x2 lo1 = *(const u32x2*)(vp + 32 * 260), hi1 = *(const u32x2*)(vp + 32 * 260 + 8);
        O0 = mfma32(__builtin_bit_cast(bf16x8, (u32x4){lo0.x, lo0.y, hi0.x, hi0.y}), P[ts], O0);
        O1 = mfma32(__builtin_bit_cast(bf16x8, (u32x4){lo1.x, lo1.y, hi1.x, hi1.y}), P[ts], O1);
    }
    float q = 0.f;
#pragma unroll
    for (int g = 0; g < 4; ++g) {
        const unsigned a0 = pk2(O0[4 * g] * inv, O0[4 * g + 1] * inv), a1 = pk2(O0[4 * g + 2] * inv, O0[4 * g + 3] * inv);
        const unsigned b0 = pk2(O1[4 * g] * inv, O1[4 * g + 1] * inv), b1 = pk2(O1[4 * g + 2] * inv, O1[4 * g + 3] * inv);
        oh[g] = (u32x2){a0, a1}; oh[4 + g] = (u32x2){b0, b1};
        q += (bflo(a0) * bflo(a0) + bfhi(a0) * bfhi(a0)) + (bflo(a1) * bflo(a1) + bfhi(a1) * bfhi(a1)) + (bflo(b0) * bflo(b0) + bfhi(b0) * bfhi(b0)) + (bflo(b1) * bflo(b1) + bfhi(b1) * bfhi(b1));
    }
    q += __shfl_xor(q, 32);
    if (h == 0) ssq[(rg * 32 + r) * 8 + hq] = q;
}

__device__ __forceinline__ void phase2_attn(const Params& p, unsigned char* lds, int b, int blk) {
    const int tid = opaque_tid(), lane = tid & 63, w = tid >> 6, r = lane & 31, h = lane >> 5;
    const bf16_t* proj = (const bf16_t*)(p.ws + WS_PROJ);
    const int* positions = (const int*)p.in[2];
    float* cs = (float*)lds;
    float* sn = cs + 2048;
    float* ssq = sn + 2048;
    bf16_t* sK = (bf16_t*)(lds + 20480);
    bf16_t* sV = sK + 256 * 72;
    const int tband0 = blk * 128 - 128;
    for (int i = tid; i < 2048; i += NTHREADS) {
        const int kb = i >> 3, f = i & 7, t = tband0 + kb;
        float c = 1.f, sv = 0.f;
        if (t >= 0) { const float ang = (float)positions[b * SEQ + t] * p.inv_freq[f]; const double rev = (double)ang * 0.15915494309189535; const float fr = (float)(rev - floor(rev));
            c = __builtin_amdgcn_cosf(fr); sv = __builtin_amdgcn_sinf(fr); }
        cs[i] = c; sn[i] = sv;
    }
    u32x2 oh[4][8];
#pragma unroll
    for (int g = 0; g < 2; ++g) {
        __syncthreads();
        {
            const int key = tid >> 1, half = tid & 1, t = tband0 + key;
            u32x4 kv[4];
#pragma unroll
            for (int q = 0; q < 4; ++q) kv[q] = (u32x4){0u, 0u, 0u, 0u};
            if (t >= 0) { const bf16_t* kp = proj + (size_t)(b * SEQ + t) * NPROJ + C_K + g * 64 + half * 32;
#pragma unroll
                for (int q = 0; q < 4; ++q) kv[q] = *(const u32x4*)(kp + 8 * q); }
            if (half == 0) {
                float o1[8], o2[8];
#pragma unroll
                for (int f = 0; f < 8; ++f) { const float x1 = bfel(kv[0], f), x2 = bfel(kv[1], f), c = cs[key * 8 + f], sv = sn[key * 8 + f]; o1[f] = x1 * c - x2 * sv; o2[f] = x2 * c + x1 * sv; }
                kv[0] = (u32x4){pk2(o1[0], o1[1]), pk2(o1[2], o1[3]), pk2(o1[4], o1[5]), pk2(o1[6], o1[7])};
                kv[1] = (u32x4){pk2(o2[0], o2[1]), pk2(o2[2], o2[3]), pk2(o2[4], o2[5]), pk2(o2[6], o2[7])};
            }
#pragma unroll
            for (int q = 0; q < 4; ++q) *(u32x4*)(sK + key * 72 + half * 32 + 8 * q) = kv[q];
        }
        {
            const int kg = tid >> 3, dc = tid & 7;
            u32x4 v[4];
#pragma unroll
            for (int i = 0; i < 4; ++i) { const int t = tband0 + 4 * kg + i; v[i] = (u32x4){0u, 0u, 0u, 0u};
                if (t >= 0) v[i] = *(const u32x4*)(proj + (size_t)(b * SEQ + t) * NPROJ + C_V + g * 64 + dc * 8); }
            bf16_t* vd = sV + (dc * 8) * 260 + 4 * kg;
#define VT_ROW(j, W) { const unsigned e0 = ((j) & 1) ? (v[0].W >> 16) : (v[0].W & 0xffffu), e1 = ((j) & 1) ? (v[1].W >> 16) : (v[1].W & 0xffffu), e2 = ((j) & 1) ? (v[2].W >> 16) : (v[2].W & 0xffffu), e3 = ((j) & 1) ? (v[3].W >> 16) : (v[3].W & 0xffffu); \
                *(u32x2*)(vd + (j) * 260) = (u32x2){e0 | (e1 << 16), e2 | (e3 << 16)}; }
            VT_ROW(0, x) VT_ROW(1, x) VT_ROW(2, y) VT_ROW(3, y) VT_ROW(4, z) VT_ROW(5, z) VT_ROW(6, w) VT_ROW(7, w)
#undef VT_ROW
        }
        __syncthreads();
#pragma unroll
        for (int uu = 0; uu < 2; ++uu) {
            const int u = w + 8 * uu;
            attn_unit(p, sK, sV, cs, sn, ssq, b, blk, g * 4 + (u >> 2), u & 3, lane, oh[g * 2 + uu]);
            __builtin_amdgcn_sched_barrier(0);
        }
    }
    __syncthreads();
    {
        bf16_t* A2 = (bf16_t*)(p.ws + WS_A2);
        const float* wa = p.in[11];
#pragma unroll
        for (int k = 0; k < 4; ++k) {
            const int u = w + 8 * (k & 1), hq = (k >> 1) * 4 + (u >> 2), rg = u & 3, ql = rg * 32 + r;
            const f32x4 s0 = *(const f32x4*)(ssq + ql * 8), s1 = *(const f32x4*)(ssq + ql * 8 + 4);
            const float rstd = 1.f / sqrtf((((s0.x + s0.y) + (s0.z + s0.w)) + ((s1.x + s1.y) + (s1.z + s1.w))) * (1.f / 512.f) + EPS);
            bf16_t* op = A2 + (size_t)(b * SEQ + blk * 128 + ql) * 1024 + hq * 64 + 4 * h;
#pragma unroll
            for (int j = 0; j < 8; ++j) {
                const int d0 = 32 * (j >> 2) + 8 * (j & 3);
                const f32x4 wv = *(const f32x4*)(wa + hq * 64 + d0 + 4 * h);
                const u32x2 t = oh[k][j];
                u32x2 o; o.x = pk2(bflo(t.x) * rstd * wv.x, bfhi(t.x) * rstd * wv.y); o.y = pk2(bflo(t.y) * rstd * wv.z, bfhi(t.y) * rstd * wv.w);
                *(u32x2*)(op + d0) = o;
            }
        }
    }
    __syncthreads();
}

__device__ __forceinline__ void phase2_states(const Params& p, unsigned char* lds, int b, int c) {
    const int tid = opaque_tid(), lane = tid & 63, w = tid >> 6, r = lane & 31, h = lane >> 5;
    float* dts = (float*)lds;
    float* cums = dts + 1024;
    bf16_t* sBT = (bf16_t*)(lds + 8192);
    bf16_t* sXT = sBT + 128 * 136;
    ssd_dt_cum(p, b, c, dts, cums);
    __syncthreads();
    bf16_t* states = (bf16_t*)(p.ws + WS_START);
    if (tid < 8) ((float*)(p.ws + WS_CDEC))[(b * NCH + c) * 8 + tid] = __expf(cums[tid * 128 + 127]);
#pragma unroll 1
    for (int g = 0; g < 2; ++g) {
        if (tid < 256) {
            const int cg8 = tid & 15, lr = tid >> 4;
            const float one[8] = {1.f, 1.f, 1.f, 1.f, 1.f, 1.f, 1.f, 1.f};
            u32x4 res[8];
            conv8x8<true>(p, b, c, lr * 8, 512 + g * 128 + cg8 * 8, one, res);
#pragma unroll
            for (int ci = 0; ci < 8; ++ci) *(u32x4*)(sBT + (cg8 * 8 + ci) * 136 + lr * 8) = res[ci];
        }
        {
            const int cg8 = tid & 31, lr = tid >> 5, hh = cg8 >> 3, hd = g * 4 + hh;
            float f[8];
            const float cl = cums[hd * 128 + 127];
#pragma unroll
            for (int li = 0; li < 8; ++li) f[li] = dts[hd * 128 + lr * 8 + li] * __expf(cl - cums[hd * 128 + lr * 8 + li]);
            u32x4 res[8];
            conv8x8<true>(p, b, c, lr * 8, g * 256 + cg8 * 8, f, res);
#pragma unroll
            for (int ci = 0; ci < 8; ++ci) *(u32x4*)(sXT + (cg8 * 8 + ci) * 136 + lr * 8) = res[ci];
        }
        __syncthreads();
        {
            f32x16 acc[4];
#pragma unroll
            for (int j = 0; j < 4; ++j) acc[j] = zero16();
#pragma unroll
            for (int kk = 0; kk < 128; kk += 16) {
                const bf16x8 a = *(const bf16x8*)(sXT + (w * 32 + r) * 136 + kk + 8 * h);
#pragma unroll
                for (int j = 0; j < 4; ++j) { const bf16x8 bb = *(const bf16x8*)(sBT + (j * 32 + r) * 136 + kk + 8 * h); acc[j] = mfma32(a, bb, acc[j]); }
            }
            const int hd = g * 4 + (w >> 1), p0 = (w & 1) * 32;
            bf16_t* sp = states + ((size_t)((b * NCH + c) * 8 + hd) * 64) * 128;
#pragma unroll
            for (int j = 0; j < 4; ++j)
#pragma unroll
                for (int i = 0; i < 16; ++i) sp[(size_t)(p0 + crow(i, h)) * 128 + j * 32 + r] = (bf16_t)f2bf(acc[j][i]);
        }
        __syncthreads();
    }
}

__device__ __forceinline__ void phase3(const Params& p) {
    const float* cdec = (const float*)(p.ws + WS_CDEC);
    bf16_t* start = (bf16_t*)(p.ws + WS_START);
    const int tid3 = opaque_tid();
#pragma unroll 1
    for (int u = blockIdx.x * NTHREADS + tid3; u < 131072; u += gridDim.x * NTHREADS) {
        const int n4 = u & 31, pp = (u >> 5) & 63, hd = (u >> 11) & 7, b = u >> 14;
        bf16_t* base = start + ((size_t)((b * NCH) * 8 + hd) * 64 + pp) * 128 + n4 * 4;
        constexpr size_t CSTRIDE = (size_t)8 * 64 * 128;
        f32x4 s = (f32x4){0.f, 0.f, 0.f, 0.f};
#pragma unroll 1
        for (int c0 = 0; c0 < NCH; c0 += 16) {
            bf16_t* bp = base + c0 * CSTRIDE; const float* dp = cdec + (b * NCH + c0) * 8 + hd;
            asm volatile("" : "+v"(bp));
            u32x2 t[16]; float d[16];
#pragma unroll
            for (int c = 0; c < 16; ++c) { t[c] = *(const u32x2*)(bp + c * CSTRIDE); d[c] = dp[c * 8]; }
#pragma unroll
            for (int c = 0; c < 16; ++c) {
                u32x2 o; o.x = pk2(s.x, s.y); o.y = pk2(s.z, s.w);
                *(u32x2*)(bp + c * CSTRIDE) = o;
                const f32x4 st = (f32x4){bflo(t[c].x), bfhi(t[c].x), bflo(t[c].y), bfhi(t[c].y)};
                s = s * d[c] + st;
            }
        }
    }
}

__device__ __forceinline__ void phase4(const Params& p, unsigned char* lds, int b, int c) {
    const int tid = opaque_tid(), lane = tid & 63, w = tid >> 6, r = lane & 31, h = lane >> 5;
    float* dts = (float*)lds;
    float* cums = dts + 1024;
    float* gsq = cums + 1024;
    bf16_t* sC = (bf16_t*)(lds + 12288);
    bf16_t* sB = sC + 128 * 136;
    bf16_t* sM = sB + 128 * 136;
    bf16_t* sXT = sM + 128 * 136;
    const bf16_t* proj = (const bf16_t*)(p.ws + WS_PROJ);
    const bf16_t* start = (const bf16_t*)(p.ws + WS_START);
    bf16_t* A2 = (bf16_t*)(p.ws + WS_A2);
    ssd_dt_cum(p, b, c, dts, cums);
    __syncthreads();
    const size_t row0 = (size_t)b * SEQ + c * 128;
#pragma unroll 1
    for (int g = 0; g < 2; ++g) {
        {
            const int which = tid >> 8, cg8 = tid & 15, lr = (tid >> 4) & 15;
            const float one[8] = {1.f, 1.f, 1.f, 1.f, 1.f, 1.f, 1.f, 1.f};
            u32x4 res[8];
            conv8x8<false>(p, b, c, lr * 8, (which ? 768 : 512) + g * 128 + cg8 * 8, one, res);
            bf16_t* dst = which ? sC : sB;
#pragma unroll
            for (int li = 0; li < 8; ++li) *(u32x4*)(dst + (lr * 8 + li) * 136 + cg8 * 8) = res[li];
        }
        __syncthreads();
        f32x16 cb0 = zero16(), cb1 = zero16();
        const int lt = w >> 1, st0 = 2 * (w & 1);
#pragma unroll 2
        for (int kk = 0; kk < 128; kk += 16) {
            const bf16x8 a = *(const bf16x8*)(sC + (lt * 32 + r) * 136 + kk + 8 * h);
            const bf16x8 b0 = *(const bf16x8*)(sB + (st0 * 32 + r) * 136 + kk + 8 * h);
            const bf16x8 b1 = *(const bf16x8*)(sB + ((st0 + 1) * 32 + r) * 136 + kk + 8 * h);
            cb0 = mfma32(a, b0, cb0); cb1 = mfma32(a, b1, cb1);
        }
        __syncthreads();
        bf16_t* sS = sB;
        const int lt2 = w >> 1, pt = w & 1;
        const int lme = lt2 * 32 + r;
        const int cp = tid & 31, lr = tid >> 5;
        u32x4 stv[2]; unsigned xin[11]; u32x2 zrn[4];
#define P4_PREFETCH(HD) { const bf16_t* stb_ = start + ((size_t)((b * NCH + c) * 8 + (HD)) * 64) * 128; \
            _Pragma("unroll") for (int i_ = 0; i_ < 2; ++i_) { const int id_ = tid + 512 * i_; stv[i_] = *(const u32x4*)(stb_ + (id_ >> 4) * 128 + (id_ & 15) * 8); } \
            conv2_load(p, b, c, lr * 8, (HD) * 64 + cp * 2, xin); \
            const bf16_t* zp_ = proj + (row0 + lme) * NPROJ + C_Z + (HD) * 64 + 32 * pt + 4 * h; \
            _Pragma("unroll") for (int g4_ = 0; g4_ < 4; ++g4_) zrn[g4_] = *(const u32x2*)(zp_ + 8 * g4_); }
        P4_PREFETCH(g * 4);
#pragma unroll 1
        for (int hh = 0; hh < 4; ++hh) {
            const int hd = g * 4 + hh;
            u32x2 zr[4];
#pragma unroll
            for (int g4 = 0; g4 < 4; ++g4) zr[g4] = zrn[g4];
#pragma unroll
            for (int q = 0; q < 2; ++q) {
                const int st = st0 + q;
                if (st <= lt) {
                    const int sme = st * 32 + r; const float cs_ = cums[hd * 128 + sme], ds_ = dts[hd * 128 + sme];
#pragma unroll
                    for (int i = 0; i < 16; ++i) {
                        const int l = lt * 32 + crow(i, h);
                        const float cbv = q ? cb1[i] : cb0[i];
                        const float v = (sme <= l) ? cbv * __expf(cums[hd * 128 + l] - cs_) * ds_ : 0.f;
                        sM[l * 136 + sme] = (bf16_t)f2bf(v);
                    }
                }
            }
            {
                u32x4 res[2];
                conv2_math(p, hd * 64 + cp * 2, xin, res);
                *(u32x4*)(sXT + (cp * 2) * 136 + lr * 8) = res[0];
                *(u32x4*)(sXT + (cp * 2 + 1) * 136 + lr * 8) = res[1];
            }
#pragma unroll
            for (int i = 0; i < 2; ++i) { const int id = tid + 512 * i; *(u32x4*)(sS + (id >> 4) * 136 + (id & 15) * 8) = stv[i]; }
            __syncthreads();
            if (hh < 3) P4_PREFETCH(hd + 1);
            {
                f32x16 yd = zero16(), yo = zero16();
                const int kend = 32 * (lt2 + 1);
#pragma unroll 2
                for (int kk = 0; kk < kend; kk += 16) {
                    const bf16x8 a = *(const bf16x8*)(sXT + (pt * 32 + r) * 136 + kk + 8 * h);
                    const bf16x8 bb = *(const bf16x8*)(sM + (lt2 * 32 + r) * 136 + kk + 8 * h);
                    yd = mfma32(a, bb, yd);
                }
#pragma unroll 2
                for (int kk = 0; kk < 128; kk += 16) {
                    const bf16x8 a = *(const bf16x8*)(sS + (pt * 32 + r) * 136 + kk + 8 * h);
                    const bf16x8 bb = *(const bf16x8*)(sC + (lt2 * 32 + r) * 136 + kk + 8 * h);
                    yo = mfma32(a, bb, yo);
                }
                const float dsk = p.in[10][hd];
                const float el = __expf(cums[hd * 128 + lme]);
                bf16_t* gp = A2 + (row0 + lme) * 1024 + 512 + hd * 64 + 32 * pt + 4 * h;
                float q = 0.f;
#pragma unroll
                for (int g4 = 0; g4 < 4; ++g4) {
                    float gv[4];
#pragma unroll
                    for (int e = 0; e < 4; ++e) {
                        const int i = 4 * g4 + e, pl = 32 * pt + 8 * g4 + 4 * h + e;
                        const float xs = bf2f((unsigned)sXT[pl * 136 + lme]);
                        const float y = yd[i] + el * yo[i] + dsk * xs;
                        const unsigned zw = (e >> 1) ? zr[g4].y : zr[g4].x;
                        const float z = (e & 1) ? bfhi(zw) : bflo(zw);
                        gv[e] = y * siluf(z);
                    }
                    const unsigned w0 = pk2(gv[0], gv[1]), w1 = pk2(gv[2], gv[3]);
                    *(u32x2*)(gp + 8 * g4) = (u32x2){w0, w1};
                    q += (bflo(w0) * bflo(w0) + bfhi(w0) * bfhi(w0)) + (bflo(w1) * bflo(w1) + bfhi(w1) * bfhi(w1));
                }
                q += __shfl_xor(q, 32);
                if (h == 0) gsq[lme * 8 + hh * 2 + pt] = q;
            }
            __syncthreads();
        }
#undef P4_PREFETCH
        {
            const float* wsn = p.in[12];
            for (int i = tid; i < 128 * 32; i += NTHREADS) {
                const int l = i >> 5, c8 = (i & 31) * 8;
                float s = 0.f;
#pragma unroll
                for (int q = 0; q < 8; ++q) s += gsq[l * 8 + q];
                const float rstd = 1.f / sqrtf(s * (1.f / 256.f) + EPS);
                const u32x4 t = *(const u32x4*)(A2 + (row0 + l) * 1024 + 512 + g * 256 + c8);
                const f32x4 w0 = *(const f32x4*)(wsn + g * 256 + c8), w1 = *(const f32x4*)(wsn + g * 256 + c8 + 4);
                u32x4 o; o.x = pk2(bflo(t.x) * rstd * w0.x, bfhi(t.x) * rstd * w0.y); o.y = pk2(bflo(t.y) * rstd * w0.z, bfhi(t.y) * rstd * w0.w); o.z = pk2(bflo(t.z) * rstd * w1.x, bfhi(t.z) * rstd * w1.y); o.w = pk2(bflo(t.w) * rstd * w1.z, bfhi(t.w) * rstd * w1.w);
                *(u32x4*)(A2 + (row0 + l) * 1024 + 512 + g * 256 + c8) = o;
            }
        }
        __syncthreads();
    }
}

__device__ __forceinline__ void phase5(const Params& p, unsigned char* lds) {
    unsigned char* ws = p.ws;
    pg8::Gemm g{(const bf16_t*)(ws + WS_A2), (const bf16_t*)(ws + WS_WOUT), NT, DM, DM};
    pg8::StaticOrder S; S.init(NT, DM, (int)gridDim.x, (int)blockIdx.x);
    pg8::EpiResid<true, true> E{p.in[0], (bf16_t*)(ws + WS_XB), (float*)(ws + WS_SSQ)};
    pg8::gemm_phase<pg8::EpiResid<true, true>, pg8::StaticOrder, true, true>(LDS3(lds), g, S, E);
}
__device__ __forceinline__ void phase6(const Params& p, unsigned char* lds) {
    unsigned char* ws = p.ws;
    pg8::Gemm g{(const bf16_t*)(ws + WS_XB), (const bf16_t*)(ws + WS_WQ), NT, 512, DM};
    pg8::StaticOrder S; S.init(NT, 512, (int)gridDim.x, (int)blockIdx.x);
    pg8::EpiQ E{(bf16_t*)(ws + WS_Q2), (const float*)(ws + WS_SSQ)};
    pg8::gemm_phase<pg8::EpiQ, pg8::StaticOrder, true, true>(LDS3(lds), g, S, E);
}
__device__ __forceinline__ void phase8(const Params& p, unsigned char* lds) {
    unsigned char* ws = p.ws;
    pg8::Gemm g{(const bf16_t*)(ws + WS_XO), (const bf16_t*)(ws + WS_WO), NT, DM, 512};
    pg8::StaticOrder S; S.init(NT, DM, (int)gridDim.x, (int)blockIdx.x);
    pg8::EpiResid<false, false> E{(const void*)(ws + WS_XB), (bf16_t*)(ws + WS_XB), nullptr};
    pg8::gemm_phase<pg8::EpiResid<false, false>, pg8::StaticOrder, true, true>(LDS3(lds), g, S, E);
}

__device__ __forceinline__ void phase7(const Params& p, unsigned char* lds) {
    const int tid = opaque_tid(), lane = tid & 63, w = tid >> 6, r = lane & 31, h = lane >> 5;
    const bf16_t* q2 = (const bf16_t*)(p.ws + WS_Q2); const bf16_t* kmem = (const bf16_t*)(p.ws + WS_KMEM); const bf16_t* vmemT = (const bf16_t*)(p.ws + WS_VMEMT);
    bf16_t* xo = (bf16_t*)(p.ws + WS_XO);
    bf16_t* sK = (bf16_t*)lds;
    bf16_t* sV = sK + 256 * 136;
    const float sc = 0.08838834764831845f * 1.4426950408889634f;
    for (int pr = blockIdx.x; pr < 256; pr += gridDim.x) {
        const int bh = pr >> 3, rp = pr & 7, b = bh >> 2, hx = bh & 3;
        __syncthreads();
        for (int i = tid; i < 4096; i += NTHREADS) { const int key = i >> 4, ch = i & 15;
            *(u32x4*)(sK + key * 136 + ch * 8) = *(const u32x4*)(kmem + ((size_t)b * 256 + key) * 512 + hx * 128 + ch * 8); }
        for (int i = tid; i < 4096; i += NTHREADS) { const int d = i >> 5, ch = i & 31;
            const u32x4 v = *(const u32x4*)(vmemT + (((size_t)b * 4 + hx) * 128 + d) * 256 + ch * 8);
            *(u32x2*)(sV + d * 260 + ch * 8) = (u32x2){v.x, v.y}; *(u32x2*)(sV + d * 260 + ch * 8 + 4) = (u32x2){v.z, v.w}; }
        __syncthreads();
#pragma unroll 1
        for (int ib = 0; ib < 2; ++ib) {
            const size_t row0 = (size_t)b * SEQ + (size_t)(2 * rp + ib) * 256 + w * 32;
            bf16x8 qf[8];
            const bf16_t* qp = q2 + (row0 + r) * 512 + hx * 128 + 8 * h;
#pragma unroll
            for (int kk = 0; kk < 8; ++kk) qf[kk] = *(const bf16x8*)(qp + kk * 16);
            f32x16 S[8];
#pragma unroll
            for (int t = 0; t < 8; ++t) S[t] = zero16();
            const bf16_t* kp = sK + r * 136 + 8 * h;
#pragma unroll
            for (int kk = 0; kk < 8; ++kk) {
#pragma unroll
                for (int t = 0; t < 8; ++t) { const bf16x8 a = *(const bf16x8*)(kp + t * (32 * 136) + kk * 16); S[t] = mfma32(a, qf[kk], S[t]); }
                __builtin_amdgcn_sched_barrier(0);
            }
            float m = -INFINITY;
#pragma unroll
            for (int t = 0; t < 8; ++t)
#pragma unroll
                for (int i = 0; i < 16; ++i) m = fmaxf(m, S[t][i]);
            m = fmaxf(m, __shfl_xor(m, 32));
            float sum = 0.f;
            bf16x8 P[16];
#pragma unroll
            for (int t = 0; t < 8; ++t) {
                float e[16];
#pragma unroll
                for (int i = 0; i < 16; ++i) { e[i] = __builtin_amdgcn_exp2f((S[t][i] - m) * sc); sum += e[i]; }
                P[2 * t] = pack8(e[0], e[1], e[2], e[3], e[4], e[5], e[6], e[7]);
                P[2 * t + 1] = pack8(e[8], e[9], e[10], e[11], e[12], e[13], e[14], e[15]);
            }
            sum += __shfl_xor(sum, 32);
            const float inv = 1.f / sum;
            f32x16 O[4];
#pragma unroll
            for (int dt = 0; dt < 4; ++dt) O[dt] = zero16();
            const bf16_t* vp0 = sV + r * 260 + 4 * h;
#pragma unroll
            for (int ts = 0; ts < 16; ++ts) {
#pragma unroll
                for (int dt = 0; dt < 4; ++dt) {
                    const bf16_t* vp = vp0 + dt * (32 * 260) + 16 * ts;
                    const u32x2 lo = *(const u32x2*)vp, hi = *(const u32x2*)(vp + 8);
                    const bf16x8 a = __builtin_bit_cast(bf16x8, (u32x4){lo.x, lo.y, hi.x, hi.y});
                    O[dt] = mfma32(a, P[ts], O[dt]);
                }
                if (ts & 1) __builtin_amdgcn_sched_barrier(0);
            }
            bf16_t* op = xo + (row0 + r) * 512 + hx * 128 + 4 * h;
#pragma unroll
            for (int dt = 0; dt < 4; ++dt)
#pragma unroll
                for (int g = 0; g < 4; ++g) { u32x2 o; o.x = pk2(O[dt][4 * g] * inv, O[dt][4 * g + 1] * inv); o.y = pk2(O[dt][4 * g + 2] * inv, O[dt][4 * g + 3] * inv);
                    *(u32x2*)(op + 32 * dt + 8 * g) = o; }
        }
    }
}

typedef __bf16 bf16x2_t __attribute__((ext_vector_type(2)));
__device__ __forceinline__ float dot2bf(unsigned a, unsigned b, float acc) { return __builtin_amdgcn_fdot2_f32_bf16(__builtin_bit_cast(bf16x2_t, a), __builtin_bit_cast(bf16x2_t, b), acc, false); }
__device__ __forceinline__ void phase9(const Params& p, unsigned char* lds) {
    const int tid = opaque_tid(), lane = tid & 63, w = tid >> 6, r = lane & 31, h = lane >> 5;
    const bf16_t* x2 = (const bf16_t*)(p.ws + WS_XB);
    int* cnt = (int*)(p.ws + WS_CTL);
    int* list = (int*)(p.ws + WS_LIST);
    float* route = (float*)(p.ws + WS_ROUTE);
    const float* bg = p.in[21]; const float* be = p.in[23];
    bf16_t* sW = (bf16_t*)lds;
    int* lcnt = (int*)(lds + 74752);
    float* lrec = (float*)(lds + 74752 + 256);
    for (int i = tid; i < 36 * 128; i += NTHREADS) { const int n = i >> 7, ch = i & 127; *(u32x4*)(sW + n * 1032 + ch * 8) = *(const u32x4*)((const bf16_t*)(p.ws + WS_WR) + n * 1024 + ch * 8); }
    if (tid < 64) lcnt[tid] = 0;
    __syncthreads();
    const int njobs = NT / 32, jstride = gridDim.x * 4;
    int nrec = 0;
    for (int job0 = blockIdx.x * 4; job0 < njobs; job0 += jstride, ++nrec) {
        const int job = job0 + w;
        if (w < 4 && job < njobs) {
            const int m0 = job * 32;
            f32x16 acc0 = zero16(), acc1 = zero16();
            float ss = 0.f;
            const bf16_t* xp = x2 + (size_t)(m0 + r) * DM + 8 * h;
            const bf16_t* w0p = sW + r * 1032 + 8 * h;
            const bf16_t* w1p = sW + (32 + (r & 3)) * 1032 + 8 * h;
#pragma unroll 1
            for (int kb = 0; kb < 4; ++kb) {
                u32x4 xf[16];
#pragma unroll
                for (int q = 0; q < 16; ++q) xf[q] = *(const u32x4*)(xp + (kb * 16 + q) * 16);
#pragma unroll
                for (int q = 0; q < 16; ++q) {
                    const bf16x8 a0 = *(const bf16x8*)(w0p + (kb * 16 + q) * 16), a1 = *(const bf16x8*)(w1p + (kb * 16 + q) * 16);
                    const bf16x8 xb = __builtin_bit_cast(bf16x8, xf[q]);
                    acc0 = mfma32(a0, xb, acc0); acc1 = mfma32(a1, xb, acc1);
                    ss = dot2bf(xf[q].x, xf[q].x, ss); ss = dot2bf(xf[q].y, xf[q].y, ss); ss = dot2bf(xf[q].z, xf[q].z, ss); ss = dot2bf(xf[q].w, xf[q].w, ss);
                }
            }
            ss += __shfl_xor(ss, 32);
            const float rstd = 1.f / sqrtf(ss * (1.f / DM) + EPS);
            const float g0 = __shfl(acc1[0], r) * rstd + bg[0], g1 = __shfl(acc1[1], r) * rstd + bg[1], g2 = __shfl(acc1[2], r) * rstd + bg[2], g3 = __shfl(acc1[3], r) * rstd + bg[3];
            int gi = 0; float gm = g0;
            if (g1 > gm) { gm = g1; gi = 1; }
            if (g2 > gm) { gm = g2; gi = 2; }
            if (g3 > gm) { gm = g3; gi = 3; }
            const float gden = __expf(g0 - gm) + __expf(g1 - gm) + __expf(g2 - gm) + __expf(g3 - gm);
            const float ggate = 1.f / gden;
            const bool up = (gi & 1) != 0;
            const int gme = 2 * h + (gi & 1);
            float ev[8];
#pragma unroll
            for (int j = 0; j < 8; ++j) ev[j] = (up ? acc0[8 + j] : acc0[j]) * rstd + be[gme * 8 + j];
            int i1 = 0; float v1 = ev[0];
#pragma unroll
            for (int j = 1; j < 8; ++j) if (ev[j] > v1) { v1 = ev[j]; i1 = j; }
            int i2 = -1; float v2 = -INFINITY;
#pragma unroll
            for (int j = 0; j < 8; ++j) if (j != i1 && ev[j] > v2) { v2 = ev[j]; i2 = j; }
            const float e2 = __expf(v2 - v1);
            const float w1 = ggate / (1.f + e2), w2 = ggate * e2 / (1.f + e2);
            if (h == (gi >> 1)) {
                const int ea = gi * 8 + i1, eb = gi * 8 + i2;
                const int la = atomicAdd(lcnt + ea, 1), lb = atomicAdd(lcnt + eb, 1);
                float* rc = lrec + (size_t)(nrec * 128 + w * 32 + r) * 8;
                ((int*)rc)[0] = ea; ((int*)rc)[1] = eb; ((int*)rc)[2] = la; ((int*)rc)[3] = lb; rc[4] = w1; rc[5] = w2; rc[6] = rstd; ((int*)rc)[7] = m0 + r;
            }
        }
    }
    __syncthreads();
    if (tid < 32) lcnt[32 + tid] = lcnt[tid] ? atomicAdd(cnt + tid * 64, lcnt[tid]) : 0;
    __syncthreads();
    {
        int rd = 0;
        for (int job0 = blockIdx.x * 4; job0 < njobs; job0 += jstride, ++rd) {
            if (tid < 128 && job0 + (tid >> 5) < njobs) {
                const float* rc = lrec + (size_t)(rd * 128 + tid) * 8;
                const int ea = ((const int*)rc)[0], eb = ((const int*)rc)[1], m = ((const int*)rc)[7];
                const int pa = lcnt[32 + ea] + ((const int*)rc)[2], pb = lcnt[32 + eb] + ((const int*)rc)[3];
                list[ea * NT + pa] = m; list[eb * NT + pb] = m;
                int* ri = (int*)(route + (size_t)m * 8);
                ri[0] = ea; ri[1] = eb; ri[2] = pa; ri[3] = pb;
                route[(size_t)m * 8 + 4] = rc[4]; route[(size_t)m * 8 + 5] = rc[5]; route[(size_t)m * 8 + 6] = rc[6]; route[(size_t)m * 8 + 7] = 0.f;
            }
        }
    }
}

__device__ __forceinline__ int* moe_tables(const Params& p, unsigned char* lds) {
    int* off = (int*)(lds + 131072);
    const int* cnt = (const int*)(p.ws + WS_CTL);
    if (threadIdx.x < 64) {
        const int l = threadIdx.x & 63;
        const int cv = (l < NEXP) ? cnt[l * 64] : 0;
        int pad = ((cv + 255) >> 8) << 8, incl = pad;
#pragma unroll
        for (int o = 1; o < 32; o <<= 1) { const int t = __shfl_up(incl, o); if (l >= o) incl += t; }
        if (l < NEXP) { off[l] = incl - pad; off[40 + l] = cv; }
        if (l == NEXP - 1) off[NEXP] = incl;
    }
    __syncthreads();
    const int nrt = off[NEXP] >> 8;
    for (int rt = threadIdx.x; rt < nrt; rt += NTHREADS) { int e = 0; for (int q = 1; q < NEXP; ++q) if (off[q] <= rt * 256) e = q; off[128 + rt] = e; }
    __syncthreads();
    return off;
}

__device__ __forceinline__ void phase10(const Params& p, unsigned char* lds) {
    const int tid = opaque_tid(), lane = tid & 63, w = tid >> 6;
    const int* off = moe_tables(p, lds);
    const int gw = blockIdx.x * NWAVES + w, NGW = gridDim.x * NWAVES;
    const bf16_t* x2 = (const bf16_t*)(p.ws + WS_XB); const float* route = (const float*)(p.ws + WS_ROUTE);
    bf16_t* xg = (bf16_t*)(p.ws + WS_XG);
    for (int m = gw; m < NT; m += NGW) {
        const int* ri = (const int*)(route + (size_t)m * 8);
        const int ea = ri[0], eb = ri[1], pa = ri[2], pb = ri[3];
        const float rs = route[(size_t)m * 8 + 6];
        const size_t sa = (size_t)off[ea] + pa, sb = (size_t)off[eb] + pb;
        const u32x2* xr = (const u32x2*)(x2 + (size_t)m * DM) + lane;
        u32x2* oa = (u32x2*)(xg + sa * DM) + lane; u32x2* ob = (u32x2*)(xg + sb * DM) + lane;
#pragma unroll
        for (int j = 0; j < 4; ++j) { const u32x2 t = xr[64 * j]; u32x2 o; o.x = pk2(bflo(t.x) * rs, bfhi(t.x) * rs); o.y = pk2(bflo(t.y) * rs, bfhi(t.y) * rs); oa[64 * j] = o; ob[64 * j] = o; }
    }
}

__device__ __forceinline__ void phase11(const Params& p, unsigned char* lds) {
    const int tid = opaque_tid();
    const int* off = moe_tables(p, lds);
    const int nrt = off[NEXP] >> 8, G = (int)gridDim.x, c = (int)blockIdx.x;
    unsigned* rowtab = (unsigned*)(lds + 131072 + 2048);
    float* rstab = (float*)(lds + 131072 + 2048 + 3072);
    {
        const int* list = (const int*)(p.ws + WS_LIST); const float* route = (const float*)(p.ws + WS_ROUTE);
        for (int i = 0; i < 3; ++i) {
            const int L = i * G + c; if (L >= nrt * 2) break;
            const int rt = L >> 1, e = off[128 + rt], cnt_e = off[40 + e], pos0 = rt * 256 - off[e];
            if (tid < 256) { const int pos = pos0 + tid; int tok = 0; float rs = 0.f;
                if (pos < cnt_e) { tok = list[e * NT + pos]; rs = route[(size_t)tok * 8 + 6]; }
                rowtab[i * 256 + tid] = (unsigned)tok * (unsigned)(DM * 2); rstab[i * 256 + tid] = rs; }
        }
    }
    __syncthreads();
    pg8::Gemm g{(const bf16_t*)(p.ws + WS_XB), (const bf16_t*)(p.ws + WS_WGU), 0, 0, DM};
    pg8::MoeOrder S{(const __attribute__((address_space(3))) int*)(off + 128), nrt, 2, G, c};
    pg8::EpiGU E{(bf16_t*)(p.ws + WS_HID), (const __attribute__((address_space(3))) float*)rstab, G, c};
    pg8::gemm_phase_g<pg8::EpiGU, pg8::MoeOrder, true, true>(LDS3(lds), g, S, E, (const __attribute__((address_space(3))) unsigned*)rowtab);
}
__device__ __forceinline__ void phase12(const Params& p, unsigned char* lds) {
    const int* off = moe_tables(p, lds);
    int kdim = EFF; asm volatile("" : "+s"(kdim));
    pg8::Gemm g{(const bf16_t*)(p.ws + WS_HID), (const bf16_t*)(p.ws + WS_WD), 0, 0, kdim};
    pg8::MoeOrder S{(const __attribute__((address_space(3))) int*)(off + 128), off[NEXP] >> 8, 4, (int)gridDim.x, (int)blockIdx.x};
    pg8::EpiY8 E{(unsigned char*)(p.ws + WS_Y), DM, 4};
    pg8::gemm_phase<pg8::EpiY8, pg8::MoeOrder, true, true>(LDS3(lds), g, S, E);
}

__device__ __forceinline__ void phase13(const Params& p, unsigned char* lds) {
    const int tid = opaque_tid(), lane = tid & 63, w = tid >> 6;
    const int* off = moe_tables(p, lds);
    const int gw = blockIdx.x * NWAVES + w, NGW = gridDim.x * NWAVES;
    const bf16_t* x2 = (const bf16_t*)(p.ws + WS_XB); const unsigned char* yb = (const unsigned char*)(p.ws + WS_Y);
    const float* route = (const float*)(p.ws + WS_ROUTE); const float* wf = p.in[27];
    f32x4 wv[2][2];
#pragma unroll
    for (int j = 0; j < 2; ++j) { wv[j][0] = *(const f32x4*)(wf + 8 * lane + 512 * j); wv[j][1] = *(const f32x4*)(wf + 8 * lane + 512 * j + 4); }
    struct Rows { u32x4 x[2]; u32x2 ya[2], yb[2]; float w1, w2; };
    Rows R0, R1, R2;
    u32x4 recN; u32x2 wN;
#define LOAD_REC(m_, REC, WW) { REC = *(const u32x4*)(route + (size_t)(m_) * 8); WW = *(const u32x2*)(route + (size_t)(m_) * 8 + 4); }
#define ISSUE_ROWS(m_, REC, WW, R) { const size_t sa_ = (size_t)off[(int)(REC).x] + (REC).z, sb_ = (size_t)off[(int)(REC).y] + (REC).w; \
        const u32x4* xr_ = (const u32x4*)(x2 + (size_t)(m_) * DM) + lane; const u32x2* ya_ = (const u32x2*)(yb + sa_ * DM) + lane; const u32x2* yb_ = (const u32x2*)(yb + sb_ * DM) + lane; \
        _Pragma("unroll") for (int j = 0; j < 2; ++j) { R.x[j] = xr_[64 * j]; R.ya[j] = ya_[64 * j]; R.yb[j] = yb_[64 * j]; } \
        R.w1 = __uint_as_float((WW).x) * 0.0625f; R.w2 = __uint_as_float((WW).y) * 0.0625f; }
    {
        u32x4 rc; u32x2 ww;
        if (gw < NT) { LOAD_REC(gw, rc, ww); ISSUE_ROWS(gw, rc, ww, R0); }
        if (gw + NGW < NT) { LOAD_REC(gw + NGW, rc, ww); ISSUE_ROWS(gw + NGW, rc, ww, R1); }
        if (gw + 2 * NGW < NT) LOAD_REC(gw + 2 * NGW, recN, wN);
    }
#pragma unroll 1
    for (int m = gw; m < NT; m += NGW) {
        if (m + 2 * NGW < NT) ISSUE_ROWS(m + 2 * NGW, recN, wN, R2);
        if (m + 3 * NGW < NT) LOAD_REC(m + 3 * NGW, recN, wN);
        f32x4 v[2][2]; float s = 0.f;
#pragma unroll
        for (int j = 0; j < 2; ++j) {
            typedef float f32x2v __attribute__((ext_vector_type(2)));
            const u32x4 t = R0.x[j]; const u32x2 a = R0.ya[j], bq = R0.yb[j]; const float w1 = R0.w1, w2 = R0.w2;
            const f32x2v a0 = __builtin_amdgcn_cvt_pk_f32_fp8((int)a.x, false), a1 = __builtin_amdgcn_cvt_pk_f32_fp8((int)a.x, true), a2 = __builtin_amdgcn_cvt_pk_f32_fp8((int)a.y, false), a3 = __builtin_amdgcn_cvt_pk_f32_fp8((int)a.y, true);
            const f32x2v b0 = __builtin_amdgcn_cvt_pk_f32_fp8((int)bq.x, false), b1 = __builtin_amdgcn_cvt_pk_f32_fp8((int)bq.x, true), b2 = __builtin_amdgcn_cvt_pk_f32_fp8((int)bq.y, false), b3 = __builtin_amdgcn_cvt_pk_f32_fp8((int)bq.y, true);
            v[j][0] = (f32x4){bflo(t.x) + w1 * a0.x + w2 * b0.x, bfhi(t.x) + w1 * a0.y + w2 * b0.y, bflo(t.y) + w1 * a1.x + w2 * b1.x, bfhi(t.y) + w1 * a1.y + w2 * b1.y};
            v[j][1] = (f32x4){bflo(t.z) + w1 * a2.x + w2 * b2.x, bfhi(t.z) + w1 * a2.y + w2 * b2.y, bflo(t.w) + w1 * a3.x + w2 * b3.x, bfhi(t.w) + w1 * a3.y + w2 * b3.y};
#pragma unroll
            for (int q = 0; q < 2; ++q) s += (v[j][q].x * v[j][q].x + v[j][q].y * v[j][q].y) + (v[j][q].z * v[j][q].z + v[j][q].w * v[j][q].w);
        }
        const float rstd = 1.f / sqrtf(wave_sum(s) * (1.f / DM) + EPS);
        float* o = p.out + (size_t)m * DM + 8 * lane;
#pragma unroll
        for (int j = 0; j < 2; ++j) { *(f32x4*)(o + 512 * j) = v[j][0] * rstd * wv[j][0]; *(f32x4*)(o + 512 * j + 4) = v[j][1] * rstd * wv[j][1]; }
        R0 = R1; R1 = R2;
    }
#undef ISSUE_ROWS
#undef LOAD_REC
}

constexpr int NPHASE = 14;
__global__ void __launch_bounds__(NTHREADS, 2) fwd_kernel(Params p) {
    extern __shared__ __attribute__((aligned(16))) unsigned char lds[];
#if MK_ONE_LAUNCH
    cg::grid_group grid = cg::this_grid();
    volatile LAS unsigned* bst = (volatile LAS unsigned*)(LDS3(lds) + LDS_BYTES - 16);
    if (threadIdx.x < 2) bst[threadIdx.x] = 0u;
    __syncthreads();
    const XcdBarrier xbar = xcd_barrier_post((unsigned*)(p.ws + WS_BAR), bst);
#define SEAM(k) do { if (p.ph_lo <= (k) && (k) + 1 < p.ph_hi) { if ((k) == 0) grid.sync(); else xcd_barrier(xbar); } } while (0)
#else
#define SEAM(k) do { } while (0)
#endif
#ifndef PROBE_PHASE
#define PROBE_PHASE -1
#endif
#define IN(k) (p.ph_lo <= (k) && (k) < p.ph_hi && (k) != p.skip)
#define REPS(k) (((k) == PROBE_PHASE) ? 2 : 1)
    if (IN(0)) { _Pragma("unroll 1") for (int rep = 0; rep < REPS(0); ++rep) { phase0(p, lds); } } SEAM(0);
    if (IN(1)) { _Pragma("unroll 1") for (int rep = 0; rep < REPS(1); ++rep) { phase1(p, lds); } } SEAM(1);
    if (IN(2)) { _Pragma("unroll 1") for (int rep = 0; rep < REPS(2); ++rep) for (int it = blockIdx.x; it < NB * NCH; it += gridDim.x) { const int b = it / NCH, c = it % NCH; phase2_attn(p, lds, b, c); phase2_states(p, lds, b, c); } } SEAM(2);
    if (IN(3)) { _Pragma("unroll 1") for (int rep = 0; rep < REPS(3); ++rep) { phase3(p); } } SEAM(3);
    if (IN(4)) { _Pragma("unroll 1") for (int rep = 0; rep < REPS(4); ++rep) for (int it = blockIdx.x; it < NB * NCH; it += gridDim.x) { const int b = it / NCH, c = it % NCH; phase4(p, lds, b, c); } } SEAM(4);
    if (IN(5)) { _Pragma("unroll 1") for (int rep = 0; rep < REPS(5); ++rep) { phase5(p, lds); } } SEAM(5);
    if (IN(6)) { _Pragma("unroll 1") for (int rep = 0; rep < REPS(6); ++rep) { phase6(p, lds); } } SEAM(6);
    if (IN(7)) { _Pragma("unroll 1") for (int rep = 0; rep < REPS(7); ++rep) { phase7(p, lds); } } SEAM(7);
    if (IN(8)) { phase8(p, lds); } SEAM(8);
    if (IN(9)) { phase9(p, lds); } SEAM(9);
    if (IN(11)) { _Pragma("unroll 1") for (int rep = 0; rep < REPS(11); ++rep) { phase11(p, lds); } } SEAM(11);
    if (IN(12)) { _Pragma("unroll 1") for (int rep = 0; rep < REPS(12); ++rep) { phase12(p, lds); } } SEAM(12);
    if (IN(13)) { _Pragma("unroll 1") for (int rep = 0; rep < REPS(13); ++rep) { phase13(p, lds); } }
#undef IN
#undef SEAM
}

extern "C" void kernel_launch(void* const* d_in, const int* in_sizes, int n_in, void* d_out, int out_size, void* d_ws, size_t ws_size, hipStream_t stream) {
    static int grid = 0;
    if (grid == 0) {
        if (n_in != 28 || out_size != NT * DM || ws_size < WS_NEED) { fprintf(stderr, "kernel_launch: unexpected sizes n_in %d out %d ws %zu\n", n_in, out_size, ws_size); grid = -1; return; }
        int dev = 0, cus = 0, per_cu = 0;
        hipGetDevice(&dev);
        hipDeviceGetAttribute(&cus, hipDeviceAttributeMultiprocessorCount, dev);
        if (hipFuncSetAttribute((const void*)fwd_kernel, hipFuncAttributeMaxDynamicSharedMemorySize, LDS_BYTES) != hipSuccess) { fprintf(stderr, "kernel_launch: hipFuncSetAttribute failed\n"); grid = -1; return; }
        if (hipOccupancyMaxActiveBlocksPerMultiprocessor(&per_cu, (const void*)fwd_kernel, NTHREADS, LDS_BYTES) != hipSuccess || per_cu < 1) { fprintf(stderr, "kernel_launch: occupancy query says %d\n", per_cu); per_cu = 1; }
        (void)hipGetLastError();
        grid = cus;
    }
    if (grid < 0) return;
    Params prm{};
    for (int i = 0; i < 28; ++i) prm.in[i] = (const float*)d_in[i];
    prm.out = (float*)d_out; prm.ws = (unsigned char*)d_ws;
    for (int i = 0; i < 8; ++i) prm.inv_freq[i] = powf(500000.0f, -(float)(2 * i) / 16.0f);
    prm.skip = -1;
#ifndef PROBE_SKIP
#define PROBE_SKIP -2
#endif
#if MK_ONE_LAUNCH
    for (int twice = 0; twice < ((PROBE_SKIP >= -1) ? 2 : 1); ++twice) {
    if (hipMemsetAsync((char*)d_ws + WS_CTL, 0, CTL_ZERO_BYTES, stream) != hipSuccess) { fprintf(stderr, "kernel_launch: memset failed\n"); return; }
#ifndef PROBE_TRUNC
#define PROBE_TRUNC NPHASE
#endif
    prm.ph_lo = 0; prm.ph_hi = twice ? PROBE_TRUNC : NPHASE; prm.skip = twice ? PROBE_SKIP : -1;
    void* args[] = {&prm};
    hipError_t e = hipLaunchCooperativeKernel((const void*)fwd_kernel, dim3(grid), dim3(NTHREADS), args, LDS_BYTES, stream);
    if (e != hipSuccess) fprintf(stderr, "cooperative launch failed: %s (grid %d)\n", hipGetErrorString(e), grid);
    }
#else
    if (hipMemsetAsync((char*)d_ws + WS_CTL, 0, CTL_ZERO_BYTES, stream) != hipSuccess) { fprintf(stderr, "kernel_launch: memset failed\n"); return; }
#ifndef PROBE_DUP
#define PROBE_DUP -1
#endif
    for (int ph = 0; ph < NPHASE; ++ph) {
        prm.ph_lo = ph; prm.ph_hi = ph + 1;
        hipLaunchKernelGGL(fwd_kernel, dim3(grid), dim3(NTHREADS), LDS_BYTES, stream, prm);
        if (ph == PROBE_DUP) hipLaunchKernelGGL(fwd_kernel, dim3(grid), dim3(NTHREADS), LDS_BYTES, stream, prm);
    }
#endif
}
```

```cpp
#include <hip/hip_runtime.h>
#include <hip/hip_cooperative_groups.h>
#include <cstdio>
#include <cmath>
namespace cg = cooperative_groups;

#ifndef MK_ONE_LAUNCH
#define MK_ONE_LAUNCH 1
#endif

typedef unsigned short bf16_t;
typedef short bf16x8 __attribute__((ext_vector_type(8)));
typedef float f32x4 __attribute__((ext_vector_type(4)));
typedef float f32x16 __attribute__((ext_vector_type(16)));
typedef unsigned u32x4 __attribute__((ext_vector_type(4)));
typedef unsigned u32x2 __attribute__((ext_vector_type(2)));

constexpr int NB = 8, SEQ = 4096, DM = 1024, NT = NB * SEQ;
constexpr int NPROJ = 2304, LDWIN = 2312;
constexpr int C_K = 512, C_V = 640, C_Z = 768, C_X = 1280, C_B = 1792, C_C = 2048;
constexpr int MEMT = 256, NMEM = NB * MEMT;
constexpr int NEXP = 32, EFF = 256;
constexpr int NCH = SEQ / 128;
constexpr float EPS = 1e-5f;
constexpr int NTHREADS = 512, NWAVES = 8;
constexpr int LDS_BYTES = 147456;

constexpr size_t MiB = (size_t)1 << 20;
constexpr size_t WS_CTL = 0, WS_BAR = 65536, CTL_ZERO_BYTES = 131072;
constexpr size_t WS_WIN = 1 * MiB, WS_WOUT = 6 * MiB, WS_WQ = 8 * MiB, WS_WKV = 9 * MiB, WS_WO = 11 * MiB, WS_WR = 12 * MiB;
constexpr size_t WS_WGU = 16 * MiB, WS_WD = 48 * MiB;
constexpr size_t WS_MEMH = 64 * MiB, WS_KMEM = 68 * MiB, WS_VMEMT = 70 * MiB, WS_DTRAW = 72 * MiB, WS_CDEC = 73 * MiB, WS_ROUTE = 74 * MiB;
constexpr size_t WS_LIST = 76 * MiB, WS_SSQ = 80 * MiB;
constexpr size_t WS_PROJ = 96 * MiB, WS_A2 = 240 * MiB, WS_STATES = 304 * MiB, WS_START = 368 * MiB;
constexpr size_t WS_X1 = 96 * MiB, WS_XB = 304 * MiB, WS_Q2 = 368 * MiB, WS_XO = 224 * MiB, WS_XG = 96 * MiB, WS_HID = 368 * MiB, WS_Y = 96 * MiB;
constexpr size_t WS_H1 = 416 * MiB;
constexpr size_t WS_NEED = 512 * MiB;

struct Params {
    const float* in[28];
    float* out;
    unsigned char* ws;
    float inv_freq[8];
    int ph_lo, ph_hi, skip, pad;
};

__device__ __forceinline__ unsigned f2bf(float f) { unsigned u = __float_as_uint(f); return (u + 0x7fffu + ((u >> 16) & 1u)) >> 16; }
__device__ __forceinline__ float bf2f(unsigned h) { return __uint_as_float(h << 16); }
__device__ __forceinline__ unsigned pk2(float lo, float hi) { return f2bf(lo) | (f2bf(hi) << 16); }
__device__ __forceinline__ float bflo(unsigned u) { return __uint_as_float(u << 16); }
__device__ __forceinline__ float bfhi(unsigned u) { return __uint_as_float(u & 0xffff0000u); }
__device__ __forceinline__ float wave_sum(float v) {
#pragma unroll
    for (int o = 32; o >= 1; o >>= 1) v += __shfl_xor(v, o);
    return v;
}
#define LDS_WAIT() asm volatile("s_waitcnt lgkmcnt(0)" ::: "memory")
__device__ __forceinline__ int opaque_tid() { int t = threadIdx.x; asm volatile("" : "+v"(t)); return t; }
__device__ __forceinline__ float siluf(float v) { return v * __builtin_amdgcn_rcpf(1.f + __expf(-v)); }
__device__ __forceinline__ f32x16 mfma32(bf16x8 a, bf16x8 b, f32x16 c) { return __builtin_amdgcn_mfma_f32_32x32x16_bf16(a, b, c, 0, 0, 0); }
__device__ __forceinline__ f32x16 zero16() { f32x16 z;
#pragma unroll
    for (int i = 0; i < 16; ++i) z[i] = 0.f;
    return z; }
__device__ __forceinline__ bf16x8 pack8(float a0, float a1, float a2, float a3, float a4, float a5, float a6, float a7) {
    u32x4 t; t.x = pk2(a0, a1); t.y = pk2(a2, a3); t.z = pk2(a4, a5); t.w = pk2(a6, a7);
    return __builtin_bit_cast(bf16x8, t);
}
__device__ __forceinline__ int crow(int i, int h) { return (i & 3) + 8 * (i >> 2) + 4 * h; }

namespace pg8 {
#define PG8_LAS __attribute__((address_space(3)))
typedef unsigned short bf16_t;
typedef short bf16x8 __attribute__((ext_vector_type(8)));
typedef float f32x4 __attribute__((ext_vector_type(4)));
typedef unsigned u32x4 __attribute__((ext_vector_type(4)));
constexpr int BM = 256, BK = 64, HALF = 128, HTB = HALF * BK * 2  , STAGE_BYTES = 8 * HTB, NXCD = 8, WGM = 8;

__host__ __device__ __forceinline__ int lds_byte(int r, int c) { const int st = (r >> 4) * 2 + (c >> 5), rr = r & 15, cc = c & 31, ob = rr * 64 + cc * 2; return st * 1024 + (ob ^ (((ob >> 9) & 1) << 5)); }
__host__ __device__ __forceinline__ void stage_rc(int b, int& R, int& C) { const int st = b / 1024, sb = b % 1024, swz = sb ^ (((sb >> 9) & 1) << 5); R = (st >> 1) * 16 + swz / 64; C = (st & 1) * 32 + (swz % 64) / 2; }
__host__ __device__ __forceinline__ int perm32(int rho) { const int n = rho >> 4, i = rho & 15; return 8 * (i >> 2) + 4 * n + (i & 3); }

struct Unit { int pm, pn; };
struct Gemm { const bf16_t* A; const bf16_t* Bt; int M, N, K; };

struct StaticOrder {
    int nM, nN, nwg, G, c;
    __host__ __device__ void init(int M, int N, int G_, int c_) { nM = M / BM; nN = N / BM; nwg = nM * nN; G = G_; c = c_; }
    __host__ __device__ bool next(int i, Unit& u) const {
        const long L = (long)i * G + c; if (L >= nwg) return false;
        int wgid = (int)L; { const int q = nwg / NXCD, r = nwg % NXCD, xcd = wgid % NXCD, off = wgid / NXCD; wgid = (xcd < r ? xcd * (q + 1) : r * (q + 1) + (xcd - r) * q) + off; }
        const int nig = WGM * nN, gid = wgid / nig, fm = gid * WGM, gsz = (nM - fm) < WGM ? (nM - fm) : WGM;
        u.pm = fm + ((wgid % nig) % gsz); u.pn = (wgid % nig) / gsz; return true;
    }
    __device__ __forceinline__ void a_ready(const Unit&) const {}
    __device__ __forceinline__ void done(const Unit&) const {}
};
__device__ __forceinline__ unsigned cvt_pk_bf16(float lo, float hi) { unsigned r; asm volatile("v_cvt_pk_bf16_f32 %0, %1, %2" : "=v"(r) : "v"(lo), "v"(hi)); return r; }
typedef float f32x2 __attribute__((ext_vector_type(2)));
template <class Epi, class Sched, bool ALIGN_EPI = false, bool SP2 = false>
__device__ __forceinline__ void gemm_phase(PG8_LAS unsigned char* lds, const Gemm g, const Sched& S, const Epi& E) {
    const int tid = threadIdx.x, wid = __builtin_amdgcn_readfirstlane(tid >> 6), lane = tid & 63, wr = wid >> 2, wc = wid & 3, fr = lane & 15, fq = lane >> 4;
    const int K = g.K, nt = K / BK;
    unsigned voffA[2], voffB[2];
#pragma unroll
    for (int i = 0; i < 2; ++i) { int R, C; stage_rc(tid * 16 + i * 8192, R, C); const int Rb = Epi::PERM ? ((R & ~31) + perm32(R & 31)) : R;
        voffA[i] = (unsigned)(R * K + C) * 2u; voffB[i] = (unsigned)(Rb * K + C) * 2u; }
    const size_t kstep = (size_t)(BK * 2);
    const size_t hstep = (size_t)HALF * K * 2;
    const size_t tstep = 2 * hstep;
    const unsigned ldsw = (unsigned)wid * 1024u;
    const int aoff = lds_byte(wr * 64 + fr, fq * 8), boff = lds_byte(wc * 32 + fr, fq * 8);
#define PG8_SA(b, h) (((b) * 2 + (h)) * HTB)
#define PG8_SB(b, h) ((4 + (b) * 2 + (h)) * HTB)
#define PG8_STAGE(bufoff, gbase, voff) do { _Pragma("unroll") for (int _i = 0; _i < 2; ++_i) \
        __builtin_amdgcn_global_load_lds((const unsigned*)((const char*)(gbase) + (voff)[_i]), (PG8_LAS unsigned*)(lds + (bufoff) + ldsw + _i * 8192), 16, 0, 0); } while (0)
#define PG8_LDA(dst, b, h) do { _Pragma("unroll") for (int m = 0; m < 4; ++m) _Pragma("unroll") for (int k = 0; k < 2; ++k) dst[m][k] = *(const PG8_LAS bf16x8*)(lds + PG8_SA(b, h) + aoff + m * 2048 + k * 1024); } while (0)
#define PG8_LDB(dst, b, h) do { _Pragma("unroll") for (int n = 0; n < 2; ++n) _Pragma("unroll") for (int k = 0; k < 2; ++k) dst[n][k] = *(const PG8_LAS bf16x8*)(lds + PG8_SB(b, h) + boff + n * 2048 + k * 1024); } while (0)
#define PG8_MMA(ai, bj, At, Bt) do { __builtin_amdgcn_s_setprio(1); _Pragma("unroll") for (int m = 0; m < 4; ++m) _Pragma("unroll") for (int n = 0; n < 2; ++n) _Pragma("unroll") for (int k = 0; k < 2; ++k) \
        acc[ai][bj][m][n] = __builtin_amdgcn_mfma_f32_16x16x32_bf16(Bt[n][k], At[m][k], acc[ai][bj][m][n], 0, 0, 0); __builtin_amdgcn_s_setprio(0); } while (0)
#define PG8_WAIT_V(n) asm volatile("s_waitcnt vmcnt(" #n ")" ::: "memory")
#define PG8_WAIT_L(n) asm volatile("s_waitcnt lgkmcnt(" #n ")" ::: "memory")
#define PG8_BAR __builtin_amdgcn_s_barrier()
#define PG8_SCHED __builtin_amdgcn_sched_barrier(0)
    Unit cur, nxt; int ui = 0;
    if (!S.next(0, cur)) return;
    f32x4 acc[2][2][4][2];
#pragma unroll
    for (int a = 0; a < 2; ++a)
#pragma unroll
        for (int b = 0; b < 2; ++b)
#pragma unroll
            for (int m = 0; m < 4; ++m)
#pragma unroll
                for (int n = 0; n < 2; ++n) acc[a][b][m][n] = (f32x4){0.f, 0.f, 0.f, 0.f};
    bf16x8 At[4][2], B0[2][2], B1[2][2];
    const char* cA = (const char*)g.A + (size_t)cur.pm * tstep; const char* cB = (const char*)g.Bt + (size_t)cur.pn * tstep;
    S.a_ready(cur);
    if constexpr (SP2) {
        PG8_STAGE(PG8_SB(0, 0), cB, voffB); PG8_STAGE(PG8_SB(0, 1), cB + hstep, voffB); PG8_STAGE(PG8_SA(0, 0), cA, voffA); PG8_STAGE(PG8_SA(0, 1), cA + hstep, voffA);
        if (wr == 1) PG8_BAR;
        PG8_WAIT_V(2); PG8_BAR;
        PG8_STAGE(PG8_SB(1, 0), cB + kstep, voffB); PG8_STAGE(PG8_SA(1, 0), cA + kstep, voffA); PG8_STAGE(PG8_SB(1, 1), cB + hstep + kstep, voffB);
        PG8_WAIT_V(6); PG8_BAR;
    } else {
        PG8_STAGE(PG8_SB(0, 0), cB, voffB); PG8_STAGE(PG8_SA(0, 0), cA, voffA); PG8_STAGE(PG8_SB(0, 1), cB + hstep, voffB); PG8_STAGE(PG8_SA(0, 1), cA + hstep, voffA);
        if (wr == 1) PG8_BAR;
        PG8_WAIT_V(4); PG8_BAR;
        PG8_STAGE(PG8_SB(1, 0), cB + kstep, voffB); PG8_STAGE(PG8_SA(1, 0), cA + kstep, voffA); PG8_STAGE(PG8_SB(1, 1), cB + hstep + kstep, voffB);
        PG8_WAIT_V(6); PG8_BAR;
    }
    for (;;) {
        const bool has_next = S.next(ui + 1, nxt);
        const char* nA = has_next ? (const char*)g.A + (size_t)nxt.pm * tstep : cA; const char* nB = has_next ? (const char*)g.Bt + (size_t)nxt.pn * tstep : cB;
        for (int t = 0; t < nt; t += 2) {
            const bool last = (t == nt - 2);
            const char* a1 = cA + (size_t)(t + 1) * kstep;
            const char* a2 = last ? nA : cA + (size_t)(t + 2) * kstep; const char* b2 = last ? nB : cB + (size_t)(t + 2) * kstep;
            const char* a3 = a2 + kstep; const char* b3 = b2 + kstep;
            if (last && has_next) S.a_ready(nxt);
            if constexpr (SP2) {
            PG8_LDB(B0, 0, 0); PG8_LDB(B1, 0, 1); PG8_SCHED; PG8_LDA(At, 0, 0); PG8_STAGE(PG8_SA(1, 1), a1 + hstep, voffA);
            PG8_WAIT_V(8); PG8_WAIT_L(0); PG8_BAR; PG8_MMA(0, 0, At, B0); PG8_MMA(0, 1, At, B1); PG8_BAR; PG8_SCHED;
            PG8_LDA(At, 0, 1); PG8_STAGE(PG8_SB(0, 0), b2, voffB); PG8_STAGE(PG8_SB(0, 1), b2 + hstep, voffB); PG8_STAGE(PG8_SA(0, 0), a2, voffA);
            PG8_WAIT_V(8); PG8_WAIT_L(0); PG8_BAR; PG8_MMA(1, 0, At, B0); PG8_MMA(1, 1, At, B1); PG8_BAR; PG8_SCHED;
            PG8_LDB(B0, 1, 0); PG8_LDB(B1, 1, 1); PG8_SCHED; PG8_LDA(At, 1, 0); PG8_STAGE(PG8_SA(0, 1), a2 + hstep, voffA);
            PG8_WAIT_V(8); PG8_WAIT_L(0); PG8_BAR; PG8_MMA(0, 0, At, B0); PG8_MMA(0, 1, At, B1); PG8_BAR; PG8_SCHED;
            PG8_LDA(At, 1, 1); PG8_STAGE(PG8_SB(1, 0), b3, voffB); PG8_STAGE(PG8_SB(1, 1), b3 + hstep, voffB); PG8_STAGE(PG8_SA(1, 0), a3, voffA);
            PG8_WAIT_V(8); PG8_WAIT_L(0); PG8_BAR; PG8_MMA(1, 0, At, B0); PG8_MMA(1, 1, At, B1); PG8_BAR; PG8_SCHED;
            } else {
            PG8_LDB(B0, 0, 0); PG8_SCHED; PG8_LDA(At, 0, 0); PG8_STAGE(PG8_SA(1, 1), a1 + hstep, voffA);
            PG8_WAIT_L(8); PG8_BAR; PG8_WAIT_L(0); PG8_MMA(0, 0, At, B0); PG8_BAR; PG8_SCHED;
            PG8_LDB(B1, 0, 1); PG8_STAGE(PG8_SB(0, 0), b2, voffB);
            PG8_BAR; PG8_WAIT_L(0); PG8_MMA(0, 1, At, B1); PG8_BAR;
            PG8_LDA(At, 0, 1); PG8_STAGE(PG8_SA(0, 0), a2, voffA);
            PG8_BAR; PG8_WAIT_L(0); PG8_MMA(1, 0, At, B0); PG8_BAR; PG8_SCHED;
            PG8_STAGE(PG8_SB(0, 1), b2 + hstep, voffB);
            PG8_WAIT_V(6); PG8_BAR; PG8_MMA(1, 1, At, B1); PG8_BAR;
            PG8_LDB(B0, 1, 0); PG8_SCHED; PG8_LDA(At, 1, 0); PG8_STAGE(PG8_SA(0, 1), a2 + hstep, voffA);
            PG8_WAIT_L(8); PG8_BAR; PG8_WAIT_L(0); PG8_MMA(0, 0, At, B0); PG8_BAR; PG8_SCHED;
            PG8_LDB(B1, 1, 1); PG8_STAGE(PG8_SB(1, 0), b3, voffB);
            PG8_BAR; PG8_WAIT_L(0); PG8_MMA(0, 1, At, B1); PG8_BAR;
            PG8_LDA(At, 1, 1); PG8_STAGE(PG8_SA(1, 0), a3, voffA);
            PG8_BAR; PG8_WAIT_L(0); PG8_MMA(1, 0, At, B0); PG8_BAR; PG8_SCHED;
            PG8_STAGE(PG8_SB(1, 1), b3 + hstep, voffB);
            PG8_WAIT_V(6); PG8_BAR; PG8_MMA(1, 1, At, B1); PG8_BAR;
            }
        }
        if constexpr (ALIGN_EPI) { if (wr == 0) PG8_BAR; }
        if constexpr (!Epi::AFTER_DRAIN) { E(acc, cur, wr, wc, fr, fq); S.done(cur); }
        if (!has_next) break;
#pragma unroll
        for (int a = 0; a < 2; ++a)
#pragma unroll
            for (int b = 0; b < 2; ++b)
#pragma unroll
                for (int m = 0; m < 4; ++m)
#pragma unroll
                    for (int n = 0; n < 2; ++n) acc[a][b][m][n] = (f32x4){0.f, 0.f, 0.f, 0.f};
        cur = nxt; cA = nA; cB = nB; ++ui;
        if constexpr (ALIGN_EPI) { if (wr == 1) PG8_BAR; }
    }
    PG8_WAIT_V(0);
    if constexpr (!ALIGN_EPI) { if (wr == 0) PG8_BAR; }
    PG8_BAR;
    if constexpr (Epi::AFTER_DRAIN) { E.fused(acc, cur, wr, wc, fr, fq, lds, wid, lane); S.done(cur); }
#undef PG8_SA
#undef PG8_SB
#undef PG8_STAGE
#undef PG8_LDA
#undef PG8_LDB
#undef PG8_MMA
#undef PG8_WAIT_V
#undef PG8_WAIT_L
#undef PG8_BAR
#undef PG8_SCHED
}

template <class Epi, class Sched, bool ALIGN_EPI = false, bool SP2 = false>
__device__ __forceinline__ void gemm_phase_g(PG8_LAS unsigned char* lds, const Gemm g, const Sched& S, const Epi& E, const PG8_LAS unsigned* rowtab) {
    const int tid = threadIdx.x, wid = __builtin_amdgcn_readfirstlane(tid >> 6), lane = tid & 63, wr = wid >> 2, wc = wid & 3, fr = lane & 15, fq = lane >> 4;
    const int K = g.K, nt = K / BK;
    unsigned voffA[2], voffB[2]; int RA[2]; unsigned CA2[2];
#pragma unroll
    for (int i = 0; i < 2; ++i) { int R, C; stage_rc(tid * 16 + i * 8192, R, C); const int Rb = Epi::PERM ? ((R & ~31) + perm32(R & 31)) : R;
        voffA[i] = (unsigned)(R * K + C) * 2u; voffB[i] = (unsigned)(Rb * K + C) * 2u; RA[i] = R; CA2[i] = (unsigned)C * 2u; }
    unsigned vA0[2], vA1[2], nvA0[2], nvA1[2];
#pragma unroll
    for (int i = 0; i < 2; ++i) { vA0[i] = rowtab[RA[i]] + CA2[i]; vA1[i] = rowtab[128 + RA[i]] + CA2[i]; nvA0[i] = vA0[i]; nvA1[i] = vA1[i]; }
    const size_t kstep = (size_t)(BK * 2);
    const size_t hstep = (size_t)HALF * K * 2;
    const size_t tstep = 2 * hstep;
    const unsigned ldsw = (unsigned)wid * 1024u;
    const int aoff = lds_byte(wr * 64 + fr, fq * 8), boff = lds_byte(wc * 32 + fr, fq * 8);
#define PG8_SA(b, h) (((b) * 2 + (h)) * HTB)
#define PG8_SB(b, h) ((4 + (b) * 2 + (h)) * HTB)
#define PG8_STAGE(bufoff, gbase, voff) do { _Pragma("unroll") for (int _i = 0; _i < 2; ++_i) \
        __builtin_amdgcn_global_load_lds((const unsigned*)((const char*)(gbase) + (voff)[_i]), (PG8_LAS unsigned*)(lds + (bufoff) + ldsw + _i * 8192), 16, 0, 0); } while (0)
#define PG8_LDA(dst, b, h) do { _Pragma("unroll") for (int m = 0; m < 4; ++m) _Pragma("unroll") for (int k = 0; k < 2; ++k) dst[m][k] = *(const PG8_LAS bf16x8*)(lds + PG8_SA(b, h) + aoff + m * 2048 + k * 1024); } while (0)
#define PG8_LDB(dst, b, h) do { _Pragma("unroll") for (int n = 0; n < 2; ++n) _Pragma("unroll") for (int k = 0; k < 2; ++k) dst[n][k] = *(const PG8_LAS bf16x8*)(lds + PG8_SB(b, h) + boff + n * 2048 + k * 1024); } while (0)
#define PG8_MMA(ai, bj, At, Bt) do { __builtin_amdgcn_s_setprio(1); _Pragma("unroll") for (int m = 0; m < 4; ++m) _Pragma("unroll") for (int n = 0; n < 2; ++n) _Pragma("unroll") for (int k = 0; k < 2; ++k) \
        acc[ai][bj][m][n] = __builtin_amdgcn_mfma_f32_16x16x32_bf16(Bt[n][k], At[m][k], acc[ai][bj][m][n], 0, 0, 0); __builtin_amdgcn_s_setprio(0); } while (0)
#define PG8_WAIT_V(n) asm volatile("s_waitcnt vmcnt(" #n ")" ::: "memory")
#define PG8_WAIT_L(n) asm volatile("s_waitcnt lgkmcnt(" #n ")" ::: "memory")
#define PG8_BAR __builtin_amdgcn_s_barrier()
#define PG8_SCHED __builtin_amdgcn_sched_barrier(0)
    Unit cur, nxt; int ui = 0;
    if (!S.next(0, cur)) return;
    f32x4 acc[2][2][4][2];
#pragma unroll
    for (int a = 0; a < 2; ++a)
#pragma unroll
        for (int b = 0; b < 2; ++b)
#pragma unroll
            for (int m = 0; m < 4; ++m)
#pragma unroll
                for (int n = 0; n < 2; ++n) acc[a][b][m][n] = (f32x4){0.f, 0.f, 0.f, 0.f};
    bf16x8 At[4][2], B0[2][2], B1[2][2];
    const char* cA = (const char*)g.A; const char* cB = (const char*)g.Bt + (size_t)cur.pn * tstep;
    S.a_ready(cur);
    if constexpr (SP2) {
        PG8_STAGE(PG8_SB(0, 0), cB, voffB); PG8_STAGE(PG8_SB(0, 1), cB + hstep, voffB); PG8_STAGE(PG8_SA(0, 0), cA, vA0); PG8_STAGE(PG8_SA(0, 1), cA, vA1);
        if (wr == 1) PG8_BAR;
        PG8_WAIT_V(2); PG8_BAR;
        PG8_STAGE(PG8_SB(1, 0), cB + kstep, voffB); PG8_STAGE(PG8_SA(1, 0), cA + kstep, vA0); PG8_STAGE(PG8_SB(1, 1), cB + hstep + kstep, voffB);
        PG8_WAIT_V(6); PG8_BAR;
    } else {
        PG8_STAGE(PG8_SB(0, 0), cB, voffB); PG8_STAGE(PG8_SA(0, 0), cA, vA0); PG8_STAGE(PG8_SB(0, 1), cB + hstep, voffB); PG8_STAGE(PG8_SA(0, 1), cA, vA1);
        if (wr == 1) PG8_BAR;
        PG8_WAIT_V(4); PG8_BAR;
        PG8_STAGE(PG8_SB(1, 0), cB + kstep, voffB); PG8_STAGE(PG8_SA(1, 0), cA + kstep, vA0); PG8_STAGE(PG8_SB(1, 1), cB + hstep + kstep, voffB);
        PG8_WAIT_V(6); PG8_BAR;
    }
    for (;;) {
        const bool has_next = S.next(ui + 1, nxt);
        if (has_next) {
#pragma unroll
            for (int i = 0; i < 2; ++i) { nvA0[i] = rowtab[(ui + 1) * 256 + RA[i]] + CA2[i]; nvA1[i] = rowtab[(ui + 1) * 256 + 128 + RA[i]] + CA2[i]; }
        }
        const char* nA = cA; const char* nB = has_next ? (const char*)g.Bt + (size_t)nxt.pn * tstep : cB;
        for (int t = 0; t < nt; t += 2) {
            const bool last = (t == nt - 2);
            unsigned sA0[2], sA1[2];
#pragma unroll
            for (int i = 0; i < 2; ++i) { sA0[i] = last ? nvA0[i] : vA0[i]; sA1[i] = last ? nvA1[i] : vA1[i]; }
            const char* a1 = cA + (size_t)(t + 1) * kstep;
            const char* a2 = last ? nA : cA + (size_t)(t + 2) * kstep; const char* b2 = last ? nB : cB + (size_t)(t + 2) * kstep;
            const char* a3 = a2 + kstep; const char* b3 = b2 + kstep;
            if (last && has_next) S.a_ready(nxt);
            if constexpr (SP2) {
            PG8_LDB(B0, 0, 0); PG8_LDB(B1, 0, 1); PG8_SCHED; PG8_LDA(At, 0, 0); PG8_STAGE(PG8_SA(1, 1), a1, vA1);
            PG8_WAIT_V(8); PG8_WAIT_L(0); PG8_BAR; PG8_MMA(0, 0, At, B0); PG8_MMA(0, 1, At, B1); PG8_BAR; PG8_SCHED;
            PG8_LDA(At, 0, 1); PG8_STAGE(PG8_SB(0, 0), b2, voffB); PG8_STAGE(PG8_SB(0, 1), b2 + hstep, voffB); PG8_STAGE(PG8_SA(0, 0), a2, sA0);
            PG8_WAIT_V(8); PG8_WAIT_L(0); PG8_BAR; PG8_MMA(1, 0, At, B0); PG8_MMA(1, 1, At, B1); PG8_BAR; PG8_SCHED;
            PG8_LDB(B0, 1, 0); PG8_LDB(B1, 1, 1); PG8_SCHED; PG8_LDA(At, 1, 0); PG8_STAGE(PG8_SA(0, 1), a2, sA1);
            PG8_WAIT_V(8); PG8_WAIT_L(0); PG8_BAR; PG8_MMA(0, 0, At, B0); PG8_MMA(0, 1, At, B1); PG8_BAR; PG8_SCHED;
            PG8_LDA(At, 1, 1); PG8_STAGE(PG8_SB(1, 0), b3, voffB); PG8_STAGE(PG8_SB(1, 1), b3 + hstep, voffB); PG8_STAGE(PG8_SA(1, 0), a3, sA0);
            PG8_WAIT_V(8); PG8_WAIT_L(0); PG8_BAR; PG8_MMA(1, 0, At, B0); PG8_MMA(1, 1, At, B1); PG8_BAR; PG8_SCHED;
            } else {
            PG8_LDB(B0, 0, 0); PG8_SCHED; PG8_LDA(At, 0, 0); PG8_STAGE(PG8_SA(1, 1), a1, vA1);
            PG8_WAIT_L(8); PG8_BAR; PG8_WAIT_L(0); PG8_MMA(0, 0, At, B0); PG8_BAR; PG8_SCHED;
            PG8_LDB(B1, 0, 1); PG8_STAGE(PG8_SB(0, 0), b2, voffB);
            PG8_BAR; PG8_WAIT_L(0); PG8_MMA(0, 1, At, B1); PG8_BAR;
            PG8_LDA(At, 0, 1); PG8_STAGE(PG8_SA(0, 0), a2, sA0);
            PG8_BAR; PG8_WAIT_L(0); PG8_MMA(1, 0, At, B0); PG8_BAR; PG8_SCHED;
            PG8_STAGE(PG8_SB(0, 1), b2 + hstep, voffB);
            PG8_WAIT_V(6); PG8_BAR; PG8_MMA(1, 1, At, B1); PG8_BAR;
            PG8_LDB(B0, 1, 0); PG8_SCHED; PG8_LDA(At, 1, 0); PG8_STAGE(PG8_SA(0, 1), a2, sA1);
            PG8_WAIT_L(8); PG8_BAR; PG8_WAIT_L(0); PG8_MMA(0, 0, At, B0); PG8_BAR; PG8_SCHED;
            PG8_LDB(B1, 1, 1); PG8_STAGE(PG8_SB(1, 0), b3, voffB);
            PG8_BAR; PG8_WAIT_L(0); PG8_MMA(0, 1, At, B1); PG8_BAR;
            PG8_LDA(At, 1, 1); PG8_STAGE(PG8_SA(1, 0), a3, sA0);
            PG8_BAR; PG8_WAIT_L(0); PG8_MMA(1, 0, At, B0); PG8_BAR; PG8_SCHED;
            PG8_STAGE(PG8_SB(1, 1), b3 + hstep, voffB);
            PG8_WAIT_V(6); PG8_BAR; PG8_MMA(1, 1, At, B1); PG8_BAR;
            }
        }
        if constexpr (ALIGN_EPI) { if (wr == 0) PG8_BAR; }
        if constexpr (!Epi::AFTER_DRAIN) { E(acc, cur, wr, wc, fr, fq); S.done(cur); }
        if (!has_next) break;
#pragma unroll
        for (int a = 0; a < 2; ++a)
#pragma unroll
            for (int b = 0; b < 2; ++b)
#pragma unroll
                for (int m = 0; m < 4; ++m)
#pragma unroll
                    for (int n = 0; n < 2; ++n) acc[a][b][m][n] = (f32x4){0.f, 0.f, 0.f, 0.f};
        cur = nxt; cA = nA; cB = nB; ++ui;
#pragma unroll
        for (int i = 0; i < 2; ++i) { vA0[i] = nvA0[i]; vA1[i] = nvA1[i]; }
        if constexpr (ALIGN_EPI) { if (wr == 1) PG8_BAR; }
    }
    PG8_WAIT_V(0);
    if constexpr (!ALIGN_EPI) { if (wr == 0) PG8_BAR; }
    PG8_BAR;
    if constexpr (Epi::AFTER_DRAIN) { E.fused(acc, cur, wr, wc, fr, fq, lds, wid, lane); S.done(cur); }
#undef PG8_SA
#undef PG8_SB
#undef PG8_STAGE
#undef PG8_LDA
#undef PG8_LDB
#undef PG8_MMA
#undef PG8_WAIT_V
#undef PG8_WAIT_L
#undef PG8_BAR
#undef PG8_SCHED
}

struct EpiBf16 {
    static constexpr bool PERM = true, AFTER_DRAIN = false;
    bf16_t* O; int ldc; int npn;
    __device__ __forceinline__ void operator()(const f32x4 (&acc)[2][2][4][2], const Unit& u, int wr, int wc, int fr, int fq) const {
        const int row0 = u.pm * BM + wr * 64 + fr, col0 = (u.pn % npn) * BM + wc * 32 + 8 * fq;
#pragma unroll
        for (int ai = 0; ai < 2; ++ai)
#pragma unroll
            for (int m = 0; m < 4; ++m) { bf16_t* rowp = O + (size_t)(row0 + ai * HALF + m * 16) * ldc + col0;
#pragma unroll
                for (int bj = 0; bj < 2; ++bj) { const f32x4 v0 = acc[ai][bj][m][0], v1 = acc[ai][bj][m][1];
                    u32x4 w; w.x = cvt_pk_bf16(v0[0], v0[1]); w.y = cvt_pk_bf16(v0[2], v0[3]); w.z = cvt_pk_bf16(v1[0], v1[1]); w.w = cvt_pk_bf16(v1[2], v1[3]);
                    *(u32x4*)(rowp + bj * HALF) = w; } }
    }
};
struct EpiY8 {
    static constexpr bool PERM = true, AFTER_DRAIN = false;
    unsigned char* O; int ldc; int npn;
    __device__ __forceinline__ void operator()(const f32x4 (&acc)[2][2][4][2], const Unit& u, int wr, int wc, int fr, int fq) const {
        typedef unsigned u32x2v __attribute__((ext_vector_type(2)));
        const int row0 = u.pm * BM + wr * 64 + fr, col0 = (u.pn % npn) * BM + wc * 32 + 8 * fq;
#pragma unroll
        for (int ai = 0; ai < 2; ++ai)
#pragma unroll
            for (int m = 0; m < 4; ++m) { unsigned char* rowp = O + (size_t)(row0 + ai * HALF + m * 16) * ldc + col0;
#pragma unroll
                for (int bj = 0; bj < 2; ++bj) { const f32x4 v0 = acc[ai][bj][m][0] * 16.f, v1 = acc[ai][bj][m][1] * 16.f;
                    int a = 0, b = 0;
                    a = __builtin_amdgcn_cvt_pk_fp8_f32(v0[0], v0[1], a, false); a = __builtin_amdgcn_cvt_pk_fp8_f32(v0[2], v0[3], a, true);
                    b = __builtin_amdgcn_cvt_pk_fp8_f32(v1[0], v1[1], b, false); b = __builtin_amdgcn_cvt_pk_fp8_f32(v1[2], v1[3], b, true);
                    *(u32x2v*)(rowp + bj * HALF) = (u32x2v){(unsigned)a, (unsigned)b}; } }
    }
};
struct EpiKV {
    static constexpr bool PERM = true, AFTER_DRAIN = false;
    bf16_t* kmem; bf16_t* vmemT;
    __device__ __forceinline__ void operator()(const f32x4 (&acc)[2][2][4][2], const Unit& u, int wr, int wc, int fr, int fq) const {
        const int row0 = u.pm * BM + wr * 64 + fr, col0 = u.pn * BM + wc * 32 + 8 * fq;
#pragma unroll
        for (int ai = 0; ai < 2; ++ai)
#pragma unroll
            for (int m = 0; m < 4; ++m) { const int row = row0 + ai * HALF + m * 16;
#pragma unroll
                for (int bj = 0; bj < 2; ++bj) { const f32x4 v0 = acc[ai][bj][m][0], v1 = acc[ai][bj][m][1]; const int col = col0 + bj * HALF;
                    if (col < 512) { u32x4 w; w.x = cvt_pk_bf16(v0[0], v0[1]); w.y = cvt_pk_bf16(v0[2], v0[3]); w.z = cvt_pk_bf16(v1[0], v1[1]); w.w = cvt_pk_bf16(v1[2], v1[3]);
                        *(u32x4*)(kmem + (size_t)row * 512 + col) = w; }
                    else { const int c2 = col - 512, hx = c2 >> 7, d = c2 & 127, b = row >> 8, key = row & 255;
                        bf16_t* vp = vmemT + (((size_t)b * 4 + hx) * 128 + d) * 256 + key;
                        const unsigned w0 = cvt_pk_bf16(v0[0], v0[1]), w1 = cvt_pk_bf16(v0[2], v0[3]), w2 = cvt_pk_bf16(v1[0], v1[1]), w3 = cvt_pk_bf16(v1[2], v1[3]);
                        vp[0 * 256] = (bf16_t)(w0 & 0xffffu); vp[1 * 256] = (bf16_t)(w0 >> 16); vp[2 * 256] = (bf16_t)(w1 & 0xffffu); vp[3 * 256] = (bf16_t)(w1 >> 16);
                        vp[4 * 256] = (bf16_t)(w2 & 0xffffu); vp[5 * 256] = (bf16_t)(w2 >> 16); vp[6 * 256] = (bf16_t)(w3 & 0xffffu); vp[7 * 256] = (bf16_t)(w3 >> 16); } } }
    }
};
template <bool XF32, bool STATS> struct EpiResid {
    static constexpr bool PERM = true, AFTER_DRAIN = false;
    const void* xin; bf16_t* xb; float* ssq;
    __device__ __forceinline__ void operator()(const f32x4 (&acc)[2][2][4][2], const Unit& u, int wr, int wc, int fr, int fq) const {
        const int col0 = u.pn * BM + wc * 32 + 8 * fq;
#pragma unroll
        for (int ai = 0; ai < 2; ++ai) {
            const size_t rowb = (size_t)(u.pm * BM + ai * HALF + wr * 64 + fr);
            f32x4 pf[4][2][2]; u32x4 pb[4][2];
#pragma unroll
            for (int m = 0; m < 4; ++m)
#pragma unroll
                for (int bj = 0; bj < 2; ++bj) { const size_t off = (rowb + m * 16) * 1024 + col0 + bj * HALF;
                    if (XF32) { pf[m][bj][0] = __builtin_nontemporal_load((const f32x4*)((const float*)xin + off)); pf[m][bj][1] = __builtin_nontemporal_load((const f32x4*)((const float*)xin + off + 4)); }
                    else pb[m][bj] = *(const u32x4*)((const bf16_t*)xin + off); }
#pragma unroll
            for (int m = 0; m < 4; ++m) { const size_t row = rowb + m * 16;
                float q = 0.f;
#pragma unroll
                for (int bj = 0; bj < 2; ++bj) { const size_t off = row * 1024 + col0 + bj * HALF;
                    f32x4 b0, b1;
                    if (XF32) { b0 = pf[m][bj][0]; b1 = pf[m][bj][1]; }
                    else { const u32x4 t = pb[m][bj];
                        b0[0] = __uint_as_float(t.x << 16); b0[1] = __uint_as_float(t.x & 0xffff0000u); b0[2] = __uint_as_float(t.y << 16); b0[3] = __uint_as_float(t.y & 0xffff0000u);
                        b1[0] = __uint_as_float(t.z << 16); b1[1] = __uint_as_float(t.z & 0xffff0000u); b1[2] = __uint_as_float(t.w << 16); b1[3] = __uint_as_float(t.w & 0xffff0000u); }
                    const f32x4 o0 = b0 + acc[ai][bj][m][0], o1 = b1 + acc[ai][bj][m][1];
                    u32x4 w; w.x = cvt_pk_bf16(o0[0], o0[1]); w.y = cvt_pk_bf16(o0[2], o0[3]); w.z = cvt_pk_bf16(o1[0], o1[1]); w.w = cvt_pk_bf16(o1[2], o1[3]);
                    *(u32x4*)(xb + off) = w;
                    if (STATS) q += ((o0[0] * o0[0] + o0[1] * o0[1]) + (o0[2] * o0[2] + o0[3] * o0[3])) + ((o1[0] * o1[0] + o1[1] * o1[1]) + (o1[2] * o1[2] + o1[3] * o1[3])); }
                if (STATS) { q += __shfl_xor(q, 16); q += __shfl_xor(q, 32); if (fq == 0) ssq[row * 16 + u.pn * 4 + wc] = q; } }
            asm volatile("" ::: "memory"); }
    }
};
struct EpiQ {
    static constexpr bool PERM = true, AFTER_DRAIN = false;
    bf16_t* O; const float* ssq;
    __device__ __forceinline__ void operator()(const f32x4 (&acc)[2][2][4][2], const Unit& u, int wr, int wc, int fr, int fq) const {
        const int row0 = u.pm * BM + wr * 64 + fr, col0 = u.pn * BM + wc * 32 + 8 * fq;
#pragma unroll
        for (int ai = 0; ai < 2; ++ai)
#pragma unroll
            for (int m = 0; m < 4; ++m) { const size_t row = (size_t)(row0 + ai * HALF + m * 16);
                const f32x4* sp = (const f32x4*)(ssq + row * 16); const f32x4 s0 = sp[0], s1 = sp[1], s2 = sp[2], s3 = sp[3];
                const float s = ((s0[0] + s0[1]) + (s0[2] + s0[3])) + ((s1[0] + s1[1]) + (s1[2] + s1[3])) + ((s2[0] + s2[1]) + (s2[2] + s2[3])) + ((s3[0] + s3[1]) + (s3[2] + s3[3]));
                const float rs = 1.f / sqrtf(s * (1.f / 1024.f) + 1e-5f);
                bf16_t* rowp = O + row * 512 + col0;
#pragma unroll
                for (int bj = 0; bj < 2; ++bj) { const f32x4 v0 = acc[ai][bj][m][0] * rs, v1 = acc[ai][bj][m][1] * rs;
                    u32x4 w; w.x = cvt_pk_bf16(v0[0], v0[1]); w.y = cvt_pk_bf16(v0[2], v0[3]); w.z = cvt_pk_bf16(v1[0], v1[1]); w.w = cvt_pk_bf16(v1[2], v1[3]);
                    *(u32x4*)(rowp + bj * HALF) = w; } }
    }
};
struct EpiGU {
    static constexpr bool PERM = true, AFTER_DRAIN = false;
    bf16_t* hid; const PG8_LAS float* rstab; int G, c;
    __device__ __forceinline__ void operator()(const f32x4 (&acc)[2][2][4][2], const Unit& u, int wr, int wc, int fr, int fq) const {
        const int row0 = u.pm * BM + wr * 64 + fr, j0 = (u.pn & 1) * 128 + wc * 16 + 4 * fq;
        const int ui = (u.pm * 2 + (u.pn & 1) - c) / G;
#pragma unroll
        for (int ai = 0; ai < 2; ++ai)
#pragma unroll
            for (int m = 0; m < 4; ++m) { bf16_t* rowp = hid + (size_t)(row0 + ai * HALF + m * 16) * 256 + j0;
                const float rs = rstab[ui * 256 + ai * HALF + wr * 64 + m * 16 + fr];
#pragma unroll
                for (int bj = 0; bj < 2; ++bj) { const f32x4 v0 = acc[ai][bj][m][0] * rs, v1 = acc[ai][bj][m][1] * rs;
                    const float h0 = v0[0] * __builtin_amdgcn_rcpf(1.f + __expf(-v0[0])) * v0[1], h1 = v0[2] * __builtin_amdgcn_rcpf(1.f + __expf(-v0[2])) * v0[3];
                    const float h2 = v1[0] * __builtin_amdgcn_rcpf(1.f + __expf(-v1[0])) * v1[1], h3 = v1[2] * __builtin_amdgcn_rcpf(1.f + __expf(-v1[2])) * v1[3];
                    typedef unsigned u32x2v __attribute__((ext_vector_type(2))); u32x2v w; w.x = cvt_pk_bf16(h0, h1); w.y = cvt_pk_bf16(h2, h3);
                    *(u32x2v*)(rowp + bj * 64) = w; } }
    }
};
struct SubOrder {
    int nM, nN, nwg, span, c;
    __device__ void init(int M, int N, int span_, int c_) { nM = M / BM; nN = N / BM; nwg = nM * nN; span = span_; c = c_; }
    __device__ bool next(int i, Unit& u) const { if (c < 0 || c >= span) return false; const int L = i * span + c; if (L >= nwg) return false; u.pm = L / nN; u.pn = L % nN; return true; }
    __device__ __forceinline__ void a_ready(const Unit&) const {}
    __device__ __forceinline__ void done(const Unit&) const {}
};
struct MoeOrder {
    const PG8_LAS int* tile_e; int nrt, npn, G, c;
    __device__ bool next(int i, Unit& u) const { const int L = i * G + c; if (L >= nrt * npn) return false; const int rt = L / npn, pnl = L % npn; u.pm = rt; u.pn = tile_e[rt] * npn + pnl; return true; }
    __device__ __forceinline__ void a_ready(const Unit&) const {}
    __device__ __forceinline__ void done(const Unit&) const {}
};
}

#define LAS __attribute__((address_space(3)))
#define XB_TMO      128
#define XB_XCNT(j)  (256  + 64 * (j))
#define XB_XSUB(j)  (1280 + 64 * (j))
#define XB_XGEN(j)  (2304 + 64 * (j))
#define XB_TOP      3328
#define XB_TOPGEN   3392
#define XCD_BAR_WORDS 3456
#define XB_SPIN_CAP (1u << 18)

__device__ __forceinline__ unsigned xb_ld(unsigned* p)              { return __hip_atomic_load(p, __ATOMIC_RELAXED, __HIP_MEMORY_SCOPE_AGENT); }
__device__ __forceinline__ unsigned xb_add(unsigned* p, unsigned v) { return __hip_atomic_fetch_add(p, v, __ATOMIC_RELAXED, __HIP_MEMORY_SCOPE_AGENT); }
__device__ __forceinline__ unsigned xb_xcc_id() { return (unsigned)__builtin_amdgcn_s_getreg((3 << 11) | 20) & 0xFu; }
#define XB_SPIN(cond, bar) do { unsigned _sp = 0; while (cond) { __builtin_amdgcn_s_sleep(1); \
    if ((++_sp & 255u) == 0u) { if (xb_ld(&(bar)[XB_TMO])) break; if (_sp > XB_SPIN_CAP) { atomicAdd(&(bar)[XB_TMO], 1u); break; } } } } while (0)

struct XcdBarrier {
    unsigned* bar; unsigned x;
    volatile LAS unsigned* st;
};

__device__ __forceinline__ XcdBarrier xcd_barrier_post(unsigned* bar, volatile LAS unsigned* st) {
    XcdBarrier b; b.bar = bar; b.x = xb_xcc_id(); b.st = st;
    if (threadIdx.x == 0) (void)xb_add(&bar[XB_XCNT(b.x)], 1u);
    return b;
}
__device__ __forceinline__ void xcd_barrier_complete(unsigned* bar, unsigned x, unsigned& nloc, unsigned& nx) {
    const unsigned G = gridDim.x * gridDim.y * gridDim.z;
    unsigned sum, cnt, mine, sp = 0u;
    for (;;) {
        sum = 0u; cnt = 0u; mine = 0u;
#pragma unroll
        for (unsigned j = 0; j < 16; ++j) { const unsigned c = xb_ld(&bar[XB_XCNT(j)]); sum += c; cnt += (c > 0u) ? 1u : 0u; mine = (j == x) ? c : mine; }
        if (sum == G) break;
        __builtin_amdgcn_s_sleep(1);
        if ((++sp & 255u) == 0u) { if (xb_ld(&bar[XB_TMO])) break; if (sp > XB_SPIN_CAP) { atomicAdd(&bar[XB_TMO], 1u); break; } }
    }
    nloc = mine > 0u ? mine : 1u; nx = cnt > 0u ? cnt : 1u;
}

__device__ __forceinline__ void xcd_barrier(const XcdBarrier& b) {
    asm volatile("s_waitcnt vmcnt(0)" ::: "memory");
    __syncthreads();
    if (threadIdx.x == 0) {
        unsigned* bar = b.bar;
        __builtin_amdgcn_s_waitcnt(0);
        unsigned nloc = b.st[0], nx = b.st[1];
        if (nloc == 0u) { xcd_barrier_complete(bar, b.x, nloc, nx); b.st[0] = nloc; b.st[1] = nx; }
        const unsigned old = xb_add(&bar[XB_XSUB(b.x)], 1u);
        const unsigned gen = old / nloc;
        if (old + 1u == (gen + 1u) * nloc) {
            __builtin_amdgcn_fence(__ATOMIC_RELEASE, "agent");
            asm volatile("s_waitcnt vmcnt(0)" ::: "memory");
            const unsigned og = xb_add(&bar[XB_TOP], 1u);
            const unsigned tg = og / nx;
            if (og + 1u == (tg + 1u) * nx) xb_add(&bar[XB_TOPGEN], 1u);
            else XB_SPIN(xb_ld(&bar[XB_TOPGEN]) == tg, bar);
            __builtin_amdgcn_fence(__ATOMIC_ACQUIRE, "agent");
            xb_add(&bar[XB_XGEN(b.x)], 1u);
            asm volatile("s_waitcnt vmcnt(0)" ::: "memory");
        } else {
            XB_SPIN(xb_ld(&bar[XB_XGEN(b.x)]) == gen, bar);
            __builtin_amdgcn_fence(__ATOMIC_ACQUIRE, "agent");
            asm volatile("s_waitcnt vmcnt(0)" ::: "memory");
        }
    }
    __syncthreads();
}

__device__ __forceinline__ void gemm128(unsigned char* lds, const bf16_t* arow, const bf16_t* brow, int K, f32x16& acc0, f32x16& acc1) {
    const int tid = opaque_tid(), lane = tid & 63, w = tid >> 6;
    bf16_t* sA = (bf16_t*)lds;
    bf16_t* sB = sA + 128 * 72;
    const int srow = tid >> 2, skc = (tid & 3) * 16;
    const bf16_t* ap = arow + skc;
    const bf16_t* bp = brow + skc;
    const int wm = w >> 1, wn = w & 1, r = lane & 31, h = lane >> 5;
    acc0 = zero16(); acc1 = zero16();
    for (int k0 = 0; k0 < K; k0 += 64) {
        const u32x4 a0 = *(const u32x4*)(ap + k0), a1 = *(const u32x4*)(ap + k0 + 8);
        const u32x4 b0 = *(const u32x4*)(bp + k0), b1 = *(const u32x4*)(bp + k0 + 8);
        __syncthreads();
        *(u32x4*)(sA + srow * 72 + skc) = a0; *(u32x4*)(sA + srow * 72 + skc + 8) = a1;
        *(u32x4*)(sB + srow * 72 + skc) = b0; *(u32x4*)(sB + srow * 72 + skc + 8) = b1;
        __syncthreads();
#pragma unroll
        for (int kk = 0; kk < 64; kk += 16) {
            const bf16x8 a = *(const bf16x8*)(sA + (wm * 32 + r) * 72 + kk + 8 * h);
            const bf16x8 bA = *(const bf16x8*)(sB + (wn * 64 + r) * 72 + kk + 8 * h);
            const bf16x8 bB = *(const bf16x8*)(sB + (wn * 64 + 32 + r) * 72 + kk + 8 * h);
            acc0 = mfma32(a, bA, acc0); acc1 = mfma32(a, bB, acc1);
        }
    }
    __syncthreads();
}

__device__ __forceinline__ void p0_transpose64(const float* W, int ldw, int K, int nblk, const float* scale, bf16_t* WT, int row_off, int row_mul, float* scr, int item, int lane) {
    const int kb = item / nblk, nb = item % nblk, k0 = 64 * kb, n0 = 64 * nb;
    f32x4 v[16];
    const float* wp = W + (size_t)(k0 + (lane >> 4)) * ldw + n0 + 4 * (lane & 15);
#pragma unroll
    for (int i = 0; i < 16; ++i) v[i] = __builtin_nontemporal_load((const f32x4*)(wp + (size_t)(4 * i) * ldw));
#pragma unroll
    for (int i = 0; i < 16; ++i) { const int kk = (lane >> 4) + 4 * i; const float sc = scale ? scale[k0 + kk] : 1.f; float* d = scr + kk * 65 + 4 * (lane & 15);
        d[0] = v[i].x * sc; d[1] = v[i].y * sc; d[2] = v[i].z * sc; d[3] = v[i].w * sc; }
    LDS_WAIT();
    const int c = lane & 7;
#pragma unroll
    for (int j = 0; j < 8; ++j) { const int n = (lane >> 3) + 8 * j; const float* sp = scr + (8 * c) * 65 + n;
        u32x4 o; o.x = pk2(sp[0 * 65], sp[1 * 65]); o.y = pk2(sp[2 * 65], sp[3 * 65]); o.z = pk2(sp[4 * 65], sp[5 * 65]); o.w = pk2(sp[6 * 65], sp[7 * 65]);
        *(u32x4*)(WT + (size_t)(row_off + (n0 + n) * row_mul) * K + k0 + 8 * c) = o; }
    LDS_WAIT();
}

__device__ __forceinline__ void phase0(const Params& p, unsigned char* lds) {
    const int tid = opaque_tid(), lane = tid & 63, w = tid >> 6;
    unsigned char* ws = p.ws;
    const int gw = blockIdx.x * NWAVES + w, NGW = gridDim.x * NWAVES;
    {
        bf16_t* WR = (bf16_t*)(ws + WS_WR);
        const float* w3 = p.in[19]; const float* wg = p.in[20]; const float* we = p.in[22];
        for (int i = blockIdx.x * NTHREADS + tid; i < 36 * 1024; i += gridDim.x * NTHREADS) {
            const int n = i >> 10, k = i & 1023;
            float v;
            if (n >= 32) v = wg[k * 4 + (n - 32)];
            else { const int hh = (n >> 2) & 1, ii = (n & 3) + 4 * (n >> 3), e = (2 * hh + (ii >> 3)) * 8 + (ii & 7); v = we[k * 32 + e]; }
            WR[i] = (bf16_t)f2bf(v * w3[k]);
        }
    }
    {
        float* scr = (float*)lds + w * (64 * 65);
        constexpr int I_IN = 16 * 36, I_OUT = 16 * 16, I_Q = 16 * 8, I_KV = 16 * 16, I_O = 8 * 16;
        constexpr int NITEMS = I_IN + I_OUT + I_Q + I_KV + I_O;
#pragma unroll 1
        for (int it = gw; it < NITEMS; it += NGW) {
            int r = it;
            if (r < I_IN) { p0_transpose64(p.in[4], LDWIN, 1024, 36, nullptr, (bf16_t*)(ws + WS_WIN), 0, 1, scr, r, lane); continue; } r -= I_IN;
            if (r < I_OUT) { p0_transpose64(p.in[13], 1024, 1024, 16, nullptr, (bf16_t*)(ws + WS_WOUT), 0, 1, scr, r, lane); continue; } r -= I_OUT;
            if (r < I_Q) { p0_transpose64(p.in[16], 512, 1024, 8, p.in[14], (bf16_t*)(ws + WS_WQ), 0, 1, scr, r, lane); continue; } r -= I_Q;
            if (r < I_KV) { p0_transpose64(p.in[17], 1024, 1024, 16, nullptr, (bf16_t*)(ws + WS_WKV), 0, 1, scr, r, lane); continue; } r -= I_KV;
            p0_transpose64(p.in[18], 1024, 512, 16, nullptr, (bf16_t*)(ws + WS_WO), 0, 1, scr, r, lane);
        }
    }
    __syncthreads();
    float* wdt = (float*)lds;
    {
        const float* win = p.in[4]; const float* w1 = p.in[3];
        for (int i = tid; i < 8192; i += NTHREADS) { const int k = i >> 3, n = i & 7; wdt[n * 1024 + k] = win[(size_t)k * LDWIN + 2304 + n] * w1[k]; }
    }
    __syncthreads();
    {
        const float* x = p.in[0]; const float* w1 = p.in[3];
        bf16_t* h1 = (bf16_t*)(ws + WS_H1); float* dtraw = (float*)(ws + WS_DTRAW);
        f32x4 wv[4];
#pragma unroll
        for (int j = 0; j < 4; ++j) wv[j] = *(const f32x4*)(w1 + 4 * lane + 256 * j);
        f32x4 nx[4];
        if (gw < NT) {
#pragma unroll
            for (int j = 0; j < 4; ++j) nx[j] = __builtin_nontemporal_load((const f32x4*)(x + (size_t)gw * DM) + lane + 64 * j);
        }
#pragma unroll 1
        for (int m = gw; m < NT; m += NGW) {
            f32x4 v[4];
#pragma unroll
            for (int j = 0; j < 4; ++j) v[j] = nx[j];
            if (m + NGW < NT) {
#pragma unroll
                for (int j = 0; j < 4; ++j) nx[j] = __builtin_nontemporal_load((const f32x4*)(x + (size_t)(m + NGW) * DM) + lane + 64 * j);
            }
            float a[16];
#pragma unroll
            for (int q = 0; q < 16; ++q) a[q] = 0.f;
#pragma unroll
            for (int j = 0; j < 4; ++j) a[0] += (v[j].x * v[j].x + v[j].y * v[j].y) + (v[j].z * v[j].z + v[j].w * v[j].w);
#pragma unroll
            for (int n = 0; n < 8; ++n)
#pragma unroll
                for (int j = 0; j < 4; ++j) { const f32x4 ww = *(const f32x4*)(wdt + n * 1024 + 4 * lane + 256 * j); a[1 + n] += (v[j].x * ww.x + v[j].y * ww.y) + (v[j].z * ww.z + v[j].w * ww.w); }
            float b8[8], b4[4], b2[2], b1;
            { const bool hi = (lane & 32) != 0;
#pragma unroll
              for (int q = 0; q < 8; ++q) { const float send = hi ? a[q] : a[q + 8], keep = hi ? a[q + 8] : a[q]; b8[q] = keep + __shfl_xor(send, 32); } }
            { const bool hi = (lane & 16) != 0;
#pragma unroll
              for (int q = 0; q < 4; ++q) { const float send = hi ? b8[q] : b8[q + 4], keep = hi ? b8[q + 4] : b8[q]; b4[q] = keep + __shfl_xor(send, 16); } }
            { const bool hi = (lane & 8) != 0;
#pragma unroll
              for (int q = 0; q < 2; ++q) { const float send = hi ? b4[q] : b4[q + 2], keep = hi ? b4[q + 2] : b4[q]; b2[q] = keep + __shfl_xor(send, 8); } }
            { const bool hi = (lane & 4) != 0; const float send = hi ? b2[0] : b2[1], keep = hi ? b2[1] : b2[0]; b1 = keep + __shfl_xor(send, 4); }
            b1 += __shfl_xor(b1, 2); b1 += __shfl_xor(b1, 1);
            const float rstd = 1.f / sqrtf(__shfl(b1, 0) * (1.f / DM) + EPS);
            const int slot = (lane >> 2) & 15;
            if ((lane & 3) == 0 && slot >= 1 && slot <= 8) dtraw[(size_t)m * 8 + (slot - 1)] = b1 * rstd;
            u32x2* o8 = (u32x2*)(h1 + (size_t)m * DM) + lane;
#pragma unroll
            for (int j = 0; j < 4; ++j) { u32x2 o; o.x = pk2(v[j].x * rstd * wv[j].x, v[j].y * rstd * wv[j].y); o.y = pk2(v[j].z * rstd * wv[j].z, v[j].w * rstd * wv[j].w); o8[64 * j] = o; }
        }
    }
    {
        const float* mem = p.in[1]; const float* wm = p.in[15];
        bf16_t* memh = (bf16_t*)(ws + WS_MEMH);
        f32x4 wv[4];
#pragma unroll
        for (int j = 0; j < 4; ++j) wv[j] = *(const f32x4*)(wm + 4 * lane + 256 * j);
        for (int m = gw; m < NMEM; m += NGW) {
            const f32x4* xr = (const f32x4*)(mem + (size_t)m * DM) + lane;
            f32x4 v[4]; float s = 0.f;
#pragma unroll
            for (int j = 0; j < 4; ++j) { v[j] = xr[64 * j]; s += (v[j].x * v[j].x + v[j].y * v[j].y) + (v[j].z * v[j].z + v[j].w * v[j].w); }
            const float rstd = 1.f / sqrtf(wave_sum(s) * (1.f / DM) + EPS);
            u32x2* o8 = (u32x2*)(memh + (size_t)m * DM) + lane;
#pragma unroll
            for (int j = 0; j < 4; ++j) { u32x2 o; o.x = pk2(v[j].x * rstd * wv[j].x, v[j].y * rstd * wv[j].y); o.y = pk2(v[j].z * rstd * wv[j].z, v[j].w * rstd * wv[j].w); o8[64 * j] = o; }
        }
    }
    __syncthreads();
}

__device__ __forceinline__ void expert_transposes(const Params& p, unsigned char* lds, int vw, int nvw) {
    const int lane = opaque_tid() & 63, w = (opaque_tid() >> 6);
    unsigned char* ws = p.ws;
    float* scr = (float*)lds + w * (64 * 65);
    constexpr int I_G = 32 * 16 * 4, I_D = 32 * 4 * 16;
#pragma unroll 1
    for (int it = vw; it < 2 * I_G + I_D; it += nvw) {
        int r = it;
        if (r < I_G) { const int e = r / 64, ri = r % 64; p0_transpose64(p.in[24] + (size_t)e * 1024 * 256, 256, 1024, 4, p.in[19], (bf16_t*)(ws + WS_WGU) + (size_t)e * 512 * 1024, 0, 2, scr, ri, lane); continue; } r -= I_G;
        if (r < I_G) { const int e = r / 64, ri = r % 64; p0_transpose64(p.in[25] + (size_t)e * 1024 * 256, 256, 1024, 4, p.in[19], (bf16_t*)(ws + WS_WGU) + (size_t)e * 512 * 1024, 1, 2, scr, ri, lane); continue; } r -= I_G;
        { const int e = r / 64, ri = r % 64; p0_transpose64(p.in[26] + (size_t)e * 256 * 1024, 1024, 256, 16, nullptr, (bf16_t*)(ws + WS_WD) + (size_t)e * 1024 * 256, 0, 1, scr, ri, lane); }
    }
}

#define LDS3(p) ((__attribute__((address_space(3))) unsigned char*)(p))
__device__ __forceinline__ void phase1(const Params& p, unsigned char* lds) {
    unsigned char* ws = p.ws;
#ifdef PROBE_PHASE
    _Pragma("unroll 1") for (int rep = 0; rep < ((PROBE_PHASE == 101) ? 2 : 1); ++rep)
#endif
    {
        pg8::Gemm g{(const bf16_t*)(ws + WS_H1), (const bf16_t*)(ws + WS_WIN), NT, NPROJ, DM};
        pg8::StaticOrder S; S.init(NT, NPROJ, (int)gridDim.x, (int)blockIdx.x);
        pg8::EpiBf16 E{(bf16_t*)(ws + WS_PROJ), NPROJ, NPROJ / 256};
        pg8::gemm_phase<pg8::EpiBf16, pg8::StaticOrder, true, true>(LDS3(lds), g, S, E);
    }
    {
        pg8::Gemm g{(const bf16_t*)(ws + WS_MEMH), (const bf16_t*)(ws + WS_WKV), NMEM, 1024, DM};
        pg8::SubOrder S; S.init(NMEM, 1024, 128, (int)blockIdx.x - 128);
        pg8::EpiKV E{(bf16_t*)(ws + WS_KMEM), (bf16_t*)(ws + WS_VMEMT)};
        pg8::gemm_phase<pg8::EpiKV, pg8::SubOrder, true, true>(LDS3(lds), g, S, E);
    }
    {
        const int w = opaque_tid() >> 6;
        if (gridDim.x == 256) { if (blockIdx.x >= 160) expert_transposes(p, lds, ((int)blockIdx.x - 160) * NWAVES + w, 96 * NWAVES); }
        else expert_transposes(p, lds, (int)blockIdx.x * NWAVES + w, (int)gridDim.x * NWAVES);
    }
}

__device__ __forceinline__ float bfel(const u32x4& v, int ci) { const unsigned wv = (ci >> 1) == 0 ? v.x : (ci >> 1) == 1 ? v.y : (ci >> 1) == 2 ? v.z : v.w; return (ci & 1) ? bfhi(wv) : bflo(wv); }
__device__ __forceinline__ void conv8_load(const Params& p, int b, int c, int l0, int ch0, u32x4 (&in)[11]) {
    const bf16_t* proj = (const bf16_t*)(p.ws + WS_PROJ);
    const int t0 = c * 128 + l0 - 3;
    const bf16_t* rp = proj + ((long)(b * SEQ) + t0) * NPROJ + C_X + ch0;
    asm volatile("" : "+v"(rp));
#pragma unroll
    for (int i = 0; i < 11; ++i) {
        const int t = t0 + i;
        in[i] = (u32x4){0u, 0u, 0u, 0u};
        if (t >= 0) in[i] = *(const u32x4*)(rp + (size_t)i * NPROJ);
    }
}
template <bool TRANS>
__device__ __forceinline__ void conv8_math(const Params& p, int ch0, const u32x4 (&in)[11], const float (&f)[8], u32x4 (&res)[8]) {
    const float* cw = p.in[6]; const float* cb = p.in[7];
    float wgt[4][8], bias[8];
#pragma unroll
    for (int j = 0; j < 4; ++j) { const f32x4 a = *(const f32x4*)(cw + j * 1024 + ch0), b2 = *(const f32x4*)(cw + j * 1024 + ch0 + 4);
        wgt[j][0] = a.x; wgt[j][1] = a.y; wgt[j][2] = a.z; wgt[j][3] = a.w; wgt[j][4] = b2.x; wgt[j][5] = b2.y; wgt[j][6] = b2.z; wgt[j][7] = b2.w; }
    { const f32x4 a = *(const f32x4*)(cb + ch0), b2 = *(const f32x4*)(cb + ch0 + 4); bias[0] = a.x; bias[1] = a.y; bias[2] = a.z; bias[3] = a.w; bias[4] = b2.x; bias[5] = b2.y; bias[6] = b2.z; bias[7] = b2.w; }
    if (TRANS) {
#pragma unroll
        for (int ci = 0; ci < 8; ++ci) {
            float o[8];
#pragma unroll
            for (int li = 0; li < 8; ++li) { float a = bias[ci];
#pragma unroll
                for (int j = 0; j < 4; ++j) a += wgt[j][ci] * bfel(in[li + j], ci);
                o[li] = siluf(a) * f[li]; }
            res[ci] = (u32x4){pk2(o[0], o[1]), pk2(o[2], o[3]), pk2(o[4], o[5]), pk2(o[6], o[7])};
        }
    } else {
#pragma unroll
        for (int li = 0; li < 8; ++li) {
            float o[8];
#pragma unroll
            for (int ci = 0; ci < 8; ++ci) { float a = bias[ci];
#pragma unroll
                for (int j = 0; j < 4; ++j) a += wgt[j][ci] * bfel(in[li + j], ci);
                o[ci] = siluf(a) * f[li]; }
            res[li] = (u32x4){pk2(o[0], o[1]), pk2(o[2], o[3]), pk2(o[4], o[5]), pk2(o[6], o[7])};
        }
    }
}
template <bool TRANS>
__device__ __forceinline__ void conv8x8(const Params& p, int b, int c, int l0, int ch0, const float (&f)[8], u32x4 (&res)[8]) {
    u32x4 in[11];
    conv8_load(p, b, c, l0, ch0, in);
    conv8_math<TRANS>(p, ch0, in, f, res);
}

__device__ __forceinline__ void conv2_load(const Params& p, int b, int c, int l0, int ch0, unsigned (&in)[11]) {
    const bf16_t* proj = (const bf16_t*)(p.ws + WS_PROJ);
    const int t0 = c * 128 + l0 - 3;
    const bf16_t* rp = proj + ((long)(b * SEQ) + t0) * NPROJ + C_X + ch0;
    asm volatile("" : "+v"(rp));
#pragma unroll
    for (int i = 0; i < 11; ++i) { const int t = t0 + i; in[i] = 0u; if (t >= 0) in[i] = *(const unsigned*)(rp + (size_t)i * NPROJ); }
}
__device__ __forceinline__ void conv2_math(const Params& p, int ch0, const unsigned (&in)[11], u32x4 (&res)[2]) {
    const float* cw = p.in[6]; const float* cb = p.in[7];
    float wgt[4][2], bias[2];
#pragma unroll
    for (int j = 0; j < 4; ++j) { wgt[j][0] = cw[j * 1024 + ch0]; wgt[j][1] = cw[j * 1024 + ch0 + 1]; }
    bias[0] = cb[ch0]; bias[1] = cb[ch0 + 1];
#pragma unroll
    for (int ci = 0; ci < 2; ++ci) {
        float o[8];
#pragma unroll
        for (int li = 0; li < 8; ++li) { float a = bias[ci];
#pragma unroll
            for (int j = 0; j < 4; ++j) a += wgt[j][ci] * (ci ? bfhi(in[li + j]) : bflo(in[li + j]));
            o[li] = siluf(a); }
        res[ci] = (u32x4){pk2(o[0], o[1]), pk2(o[2], o[3]), pk2(o[4], o[5]), pk2(o[6], o[7])};
    }
}

__device__ __forceinline__ void ssd_dt_cum(const Params& p, int b, int c, float* dts, float* cums) {
    const int tid = opaque_tid(), lane = tid & 63, w = tid >> 6;
    const float* dtraw = (const float*)(p.ws + WS_DTRAW);
    const float bias = p.in[8][w], a = -__expf(p.in[9][w]);
    const size_t row0 = (size_t)b * SEQ + c * 128;
    float x0 = dtraw[(row0 + 2 * lane) * 8 + w] + bias, x1 = dtraw[(row0 + 2 * lane + 1) * 8 + w] + bias;
    const float d0 = fmaxf(x0, 0.f) + log1pf(__expf(-fabsf(x0))), d1 = fmaxf(x1, 0.f) + log1pf(__expf(-fabsf(x1)));
    const float a0 = d0 * a, a1 = d1 * a;
    float s = a0 + a1;
#pragma unroll
    for (int o = 1; o < 64; o <<= 1) { const float t = __shfl_up(s, o); if (lane >= o) s += t; }
    dts[w * 128 + 2 * lane] = d0; dts[w * 128 + 2 * lane + 1] = d1;
    cums[w * 128 + 2 * lane] = s - a1; cums[w * 128 + 2 * lane + 1] = s;
}

__device__ __forceinline__ void attn_unit(const Params& p, const bf16_t* sK, const bf16_t* sV, const float* cs, const float* sn, float* ssq, int b, int blk, int hq, int rg, int lane, u32x2 (&oh)[8]) {
    const int r = lane & 31, h = lane >> 5;
    const bf16_t* proj = (const bf16_t*)(p.ws + WS_PROJ);
    const int tband0 = blk * 128 - 128;
    const bf16_t* qp = proj + (size_t)(b * SEQ + blk * 128 + rg * 32 + r) * NPROJ + hq * 64 + 8 * h;
    u32x4 qv[4];
#pragma unroll
    for (int kk = 0; kk < 4; ++kk) qv[kk] = *(const u32x4*)(qp + kk * 16);
    {
        u32x4 ot; ot.x = __shfl_xor(qv[0].x, 32); ot.y = __shfl_xor(qv[0].y, 32); ot.z = __shfl_xor(qv[0].z, 32); ot.w = __shfl_xor(qv[0].w, 32);
        const float* cp = cs + (128 + rg * 32 + r) * 8; const float* sp = sn + (128 + rg * 32 + r) * 8;
        float o[8];
#pragma unroll
        for (int f = 0; f < 8; ++f) {
            const float mine = bfel(qv[0], f), oth = bfel(ot, f), c = cp[f], sv = sp[f];
            o[f] = h ? (mine * c + oth * sv) : (mine * c - oth * sv);
        }
        qv[0] = (u32x4){pk2(o[0], o[1]), pk2(o[2], o[3]), pk2(o[4], o[5]), pk2(o[6], o[7])};
    }
    f32x16 S[5];
#pragma unroll
    for (int jt = 0; jt < 5; ++jt) S[jt] = zero16();
    const bf16_t* kp = sK + (rg * 32 + r) * 72 + 8 * h;
#pragma unroll
    for (int kk = 0; kk < 4; ++kk) {
        const bf16x8 qf = __builtin_bit_cast(bf16x8, qv[kk]);
#pragma unroll
        for (int jt = 0; jt < 5; ++jt) { const bf16x8 a = *(const bf16x8*)(kp + jt * (32 * 72) + kk * 16); S[jt] = mfma32(a, qf, S[jt]); }
    }
    const float sink = p.in[5][hq] * 8.f;
    float m = sink;
    const bool noprev = (blk == 0);
#pragma unroll
    for (int jt = 0; jt < 5; ++jt)
#pragma unroll
        for (int i = 0; i < 16; ++i) {
            const int cr = (i & 3) + 8 * (i >> 2) + 4 * h;
            bool ok = true;
            if (jt == 0) ok = cr > r;
            if (jt == 4) ok = cr <= r;
            if (noprev && (rg + jt) < 4) ok = false;
            const float v = ok ? S[jt][i] : -INFINITY; S[jt][i] = v; m = fmaxf(m, v);
        }
    m = fmaxf(m, __shfl_xor(m, 32));
    const float sc = 0.125f * 1.4426950408889634f;
    float sum = 0.f;
    bf16x8 P[10];
#pragma unroll
    for (int jt = 0; jt < 5; ++jt) {
        float e[16];
#pragma unroll
        for (int i = 0; i < 16; ++i) { e[i] = __builtin_amdgcn_exp2f((S[jt][i] - m) * sc); sum += e[i]; }
        P[2 * jt] = pack8(e[0], e[1], e[2], e[3], e[4], e[5], e[6], e[7]);
        P[2 * jt + 1] = pack8(e[8], e[9], e[10], e[11], e[12], e[13], e[14], e[15]);
    }
    sum += __shfl_xor(sum, 32);
    sum += __builtin_amdgcn_exp2f((sink - m) * sc);
    const float inv = 1.f / sum;
    f32x16 O0 = zero16(), O1 = zero16();
    const bf16_t* vp0 = sV + r * 260 + rg * 32 + 4 * h;
#pragma unroll
    for (int ts = 0; ts < 10; ++ts) {
        const bf16_t* vp = vp0 + 16 * ts;
        const u32x2 lo0 = *(const u32x2*)vp, hi0 = *(const u32x2*)(vp + 8);
        const u32x2 lo1 = *(const u32x2*)(vp + 32 * 260), hi1 = *(const u32x2*)(vp + 32 * 260 + 8);
        O0 = mfma32(__builtin_bit_cast(bf16x8, (u32x4){lo0.x, lo0.y, hi0.x, hi0.y}), P[ts], O0);
        O1 = mfma32(__builtin_bit_cast(bf16x8, (u32x4){lo1.x, lo1.y, hi1.x, hi1.y}), P[ts], O1);
    }
    float q = 0.f;
#pragma unroll
    for (int g = 0; g < 4; ++g) {
        const unsigned a0 = pk2(O0[4 * g] * inv, O0[4 * g + 1] * inv), a1 = pk2(O0[4 * g + 2] * inv, O0[4 * g + 3] * inv);
        const unsigned b0 = pk2(O1[4 * g] * inv, O1[4 * g + 1] * inv), b1 = pk2(O1[4 * g + 2] * inv, O1[4 * g + 3] * inv);
        oh[g] = (u32x2){a0, a1}; oh[4 + g] = (u32x2){b0, b1};
        q += (bflo(a0) * bflo(a0) + bfhi(a0) * bfhi(a0)) + (bflo(a1) * bflo(a1) + bfhi(a1) * bfhi(a1)) + (bflo(b0) * bflo(b0) + bfhi(b0) * bfhi(b0)) + (bflo(b1) * bflo(b1) + bfhi(b1) * bfhi(b1));
    }
    q += __shfl_xor(q, 32);
    if (h == 0) ssq[(rg * 32 + r) * 8 + hq] = q;
}

__device__ __forceinline__ void phase2_attn(const Params& p, unsigned char* lds, int b, int blk) {
    const int tid = opaque_tid(), lane = tid & 63, w = tid >> 6, r = lane & 31, h = lane >> 5;
    const bf16_t* proj = (const bf16_t*)(p.ws + WS_PROJ);
    const int* positions = (const int*)p.in[2];
    float* cs = (float*)lds;
    float* sn = cs + 2048;
    float* ssq = sn + 2048;
    bf16_t* sK = (bf16_t*)(lds + 20480);
    bf16_t* sV = sK + 256 * 72;
    const int tband0 = blk * 128 - 128;
    for (int i = tid; i < 2048; i += NTHREADS) {
        const int kb = i >> 3, f = i & 7, t = tband0 + kb;
        float c = 1.f, sv = 0.f;
        if (t >= 0) { const float ang = (float)positions[b * SEQ + t] * p.inv_freq[f]; const double rev = (double)ang * 0.15915494309189535; const float fr = (float)(rev - floor(rev));
            c = __builtin_amdgcn_cosf(fr); sv = __builtin_amdgcn_sinf(fr); }
        cs[i] = c; sn[i] = sv;
    }
    u32x2 oh[4][8];
#pragma unroll
    for (int g = 0; g < 2; ++g) {
        __syncthreads();
        {
            const int key = tid >> 1, half = tid & 1, t = tband0 + key;
            u32x4 kv[4];
#pragma unroll
            for (int q = 0; q < 4; ++q) kv[q] = (u32x4){0u, 0u, 0u, 0u};
            if (t >= 0) { const bf16_t* kp = proj + (size_t)(b * SEQ + t) * NPROJ + C_K + g * 64 + half * 32;
#pragma unroll
                for (int q = 0; q < 4; ++q) kv[q] = *(const u32x4*)(kp + 8 * q); }
            if (half == 0) {
                float o1[8], o2[8];
#pragma unroll
                for (int f = 0; f < 8; ++f) { const float x1 = bfel(kv[0], f), x2 = bfel(kv[1], f), c = cs[key * 8 + f], sv = sn[key * 8 + f]; o1[f] = x1 * c - x2 * sv; o2[f] = x2 * c + x1 * sv; }
                kv[0] = (u32x4){pk2(o1[0], o1[1]), pk2(o1[2], o1[3]), pk2(o1[4], o1[5]), pk2(o1[6], o1[7])};
                kv[1] = (u32x4){pk2(o2[0], o2[1]), pk2(o2[2], o2[3]), pk2(o2[4], o2[5]), pk2(o2[6], o2[7])};
            }
#pragma unroll
            for (int q = 0; q < 4; ++q) *(u32x4*)(sK + key * 72 + half * 32 + 8 * q) = kv[q];
        }
        {
            const int kg = tid >> 3, dc = tid & 7;
            u32x4 v[4];
#pragma unroll
            for (int i = 0; i < 4; ++i) { const int t = tband0 + 4 * kg + i; v[i] = (u32x4){0u, 0u, 0u, 0u};
                if (t >= 0) v[i] = *(const u32x4*)(proj + (size_t)(b * SEQ + t) * NPROJ + C_V + g * 64 + dc * 8); }
            bf16_t* vd = sV + (dc * 8) * 260 + 4 * kg;
#define VT_ROW(j, W) { const unsigned e0 = ((j) & 1) ? (v[0].W >> 16) : (v[0].W & 0xffffu), e1 = ((j) & 1) ? (v[1].W >> 16) : (v[1].W & 0xffffu), e2 = ((j) & 1) ? (v[2].W >> 16) : (v[2].W & 0xffffu), e3 = ((j) & 1) ? (v[3].W >> 16) : (v[3].W & 0xffffu); \
                *(u32x2*)(vd + (j) * 260) = (u32x2){e0 | (e1 << 16), e2 | (e3 << 16)}; }
            VT_ROW(0, x) VT_ROW(1, x) VT_ROW(2, y) VT_ROW(3, y) VT_ROW(4, z) VT_ROW(5, z) VT_ROW(6, w) VT_ROW(7, w)
#undef VT_ROW
        }
        __syncthreads();
#pragma unroll
        for (int uu = 0; uu < 2; ++uu) {
            const int u = w + 8 * uu;
            attn_unit(p, sK, sV, cs, sn, ssq, b, blk, g * 4 + (u >> 2), u & 3, lane, oh[g * 2 + uu]);
            __builtin_amdgcn_sched_barrier(0);
        }
    }
    __syncthreads();
    {
        bf16_t* A2 = (bf16_t*)(p.ws + WS_A2);
        const float* wa = p.in[11];
#pragma unroll
        for (int k = 0; k < 4; ++k) {
            const int u = w + 8 * (k & 1), hq = (k >> 1) * 4 + (u >> 2), rg = u & 3, ql = rg * 32 + r;
            const f32x4 s0 = *(const f32x4*)(ssq + ql * 8), s1 = *(const f32x4*)(ssq + ql * 8 + 4);
            const float rstd = 1.f / sqrtf((((s0.x + s0.y) + (s0.z + s0.w)) + ((s1.x + s1.y) + (s1.z + s1.w))) * (1.f / 512.f) + EPS);
            bf16_t* op = A2 + (size_t)(b * SEQ + blk * 128 + ql) * 1024 + hq * 64 + 4 * h;
#pragma unroll
            for (int j = 0; j < 8; ++j) {
                const int d0 = 32 * (j >> 2) + 8 * (j & 3);
                const f32x4 wv = *(const f32x4*)(wa + hq * 64 + d0 + 4 * h);
                const u32x2 t = oh[k][j];
                u32x2 o; o.x = pk2(bflo(t.x) * rstd * wv.x, bfhi(t.x) * rstd * wv.y); o.y = pk2(bflo(t.y) * rstd * wv.z, bfhi(t.y) * rstd * wv.w);
                *(u32x2*)(op + d0) = o;
            }
        }
    }
    __syncthreads();
}

__device__ __forceinline__ void phase2_states(const Params& p, unsigned char* lds, int b, int c) {
    const int tid = opaque_tid(), lane = tid & 63, w = tid >> 6, r = lane & 31, h = lane >> 5;
    float* dts = (float*)lds;
    float* cums = dts + 1024;
    bf16_t* sBT = (bf16_t*)(lds + 8192);
    bf16_t* sXT = sBT + 128 * 136;
    ssd_dt_cum(p, b, c, dts, cums);
    __syncthreads();
    bf16_t* states = (bf16_t*)(p.ws + WS_START);
    if (tid < 8) ((float*)(p.ws + WS_CDEC))[(b * NCH + c) * 8 + tid] = __expf(cums[tid * 128 + 127]);
#pragma unroll 1
    for (int g = 0; g < 2; ++g) {
        if (tid < 256) {
            const int cg8 = tid & 15, lr = tid >> 4;
            const float one[8] = {1.f, 1.f, 1.f, 1.f, 1.f, 1.f, 1.f, 1.f};
            u32x4 res[8];
            conv8x8<true>(p, b, c, lr * 8, 512 + g * 128 + cg8 * 8, one, res);
#pragma unroll
            for (int ci = 0; ci < 8; ++ci) *(u32x4*)(sBT + (cg8 * 8 + ci) * 136 + lr * 8) = res[ci];
        }
        {
            const int cg8 = tid & 31, lr = tid >> 5, hh = cg8 >> 3, hd = g * 4 + hh;
            float f[8];
            const float cl = cums[hd * 128 + 127];
#pragma unroll
            for (int li = 0; li < 8; ++li) f[li] = dts[hd * 128 + lr * 8 + li] * __expf(cl - cums[hd * 128 + lr * 8 + li]);
            u32x4 res[8];
            conv8x8<true>(p, b, c, lr * 8, g * 256 + cg8 * 8, f, res);
#pragma unroll
            for (int ci = 0; ci < 8; ++ci) *(u32x4*)(sXT + (cg8 * 8 + ci) * 136 + lr * 8) = res[ci];
        }
        __syncthreads();
        {
            f32x16 acc[4];
#pragma unroll
            for (int j = 0; j < 4; ++j) acc[j] = zero16();
#pragma unroll
            for (int kk = 0; kk < 128; kk += 16) {
                const bf16x8 a = *(const bf16x8*)(sXT + (w * 32 + r) * 136 + kk + 8 * h);
#pragma unroll
                for (int j = 0; j < 4; ++j) { const bf16x8 bb = *(const bf16x8*)(sBT + (j * 32 + r) * 136 + kk + 8 * h); acc[j] = mfma32(a, bb, acc[j]); }
            }
            const int hd = g * 4 + (w >> 1), p0 = (w & 1) * 32;
            bf16_t* sp = states + ((size_t)((b * NCH + c) * 8 + hd) * 64) * 128;
#pragma unroll
            for (int j = 0; j < 4; ++j)
#pragma unroll
                for (int i = 0; i < 16; ++i) sp[(size_t)(p0 + crow(i, h)) * 128 + j * 32 + r] = (bf16_t)f2bf(acc[j][i]);
        }
        __syncthreads();
    }
}

__device__ __forceinline__ void phase3(const Params& p) {
    const float* cdec = (const float*)(p.ws + WS_CDEC);
    bf16_t* start = (bf16_t*)(p.ws + WS_START);
    const int tid3 = opaque_tid();
#pragma unroll 1
    for (int u = blockIdx.x * NTHREADS + tid3; u < 131072; u += gridDim.x * NTHREADS) {
        const int n4 = u & 31, pp = (u >> 5) & 63, hd = (u >> 11) & 7, b = u >> 14;
        bf16_t* base = start + ((size_t)((b * NCH) * 8 + hd) * 64 + pp) * 128 + n4 * 4;
        constexpr size_t CSTRIDE = (size_t)8 * 64 * 128;
        f32x4 s = (f32x4){0.f, 0.f, 0.f, 0.f};
#pragma unroll 1
        for (int c0 = 0; c0 < NCH; c0 += 16) {
            bf16_t* bp = base + c0 * CSTRIDE; const float* dp = cdec + (b * NCH + c0) * 8 + hd;
            asm volatile("" : "+v"(bp));
            u32x2 t[16]; float d[16];
#pragma unroll
            for (int c = 0; c < 16; ++c) { t[c] = *(const u32x2*)(bp + c * CSTRIDE); d[c] = dp[c * 8]; }
#pragma unroll
            for (int c = 0; c < 16; ++c) {
                u32x2 o; o.x = pk2(s.x, s.y); o.y = pk2(s.z, s.w);
                *(u32x2*)(bp + c * CSTRIDE) = o;
                const f32x4 st = (f32x4){bflo(t[c].x), bfhi(t[c].x), bflo(t[c].y), bfhi(t[c].y)};
                s = s * d[c] + st;
            }
        }
    }
}

__device__ __forceinline__ void phase4(const Params& p, unsigned char* lds, int b, int c) {
    const int tid = opaque_tid(), lane = tid & 63, w = tid >> 6, r = lane & 31, h = lane >> 5;
    float* dts = (float*)lds;
    float* cums = dts + 1024;
    float* gsq = cums + 1024;
    bf16_t* sC = (bf16_t*)(lds + 12288);
    bf16_t* sB = sC + 128 * 136;
    bf16_t* sM = sB + 128 * 136;
    bf16_t* sXT = sM + 128 * 136;
    const bf16_t* proj = (const bf16_t*)(p.ws + WS_PROJ);
    const bf16_t* start = (const bf16_t*)(p.ws + WS_START);
    bf16_t* A2 = (bf16_t*)(p.ws + WS_A2);
    ssd_dt_cum(p, b, c, dts, cums);
    __syncthreads();
    const size_t row0 = (size_t)b * SEQ + c * 128;
#pragma unroll 1
    for (int g = 0; g < 2; ++g) {
        {
            const int which = tid >> 8, cg8 = tid & 15, lr = (tid >> 4) & 15;
            const float one[8] = {1.f, 1.f, 1.f, 1.f, 1.f, 1.f, 1.f, 1.f};
            u32x4 res[8];
            conv8x8<false>(p, b, c, lr * 8, (which ? 768 : 512) + g * 128 + cg8 * 8, one, res);
            bf16_t* dst = which ? sC : sB;
#pragma unroll
            for (int li = 0; li < 8; ++li) *(u32x4*)(dst + (lr * 8 + li) * 136 + cg8 * 8) = res[li];
        }
        __syncthreads();
        f32x16 cb0 = zero16(), cb1 = zero16();
        const int lt = w >> 1, st0 = 2 * (w & 1);
#pragma unroll 2
        for (int kk = 0; kk < 128; kk += 16) {
            const bf16x8 a = *(const bf16x8*)(sC + (lt * 32 + r) * 136 + kk + 8 * h);
            const bf16x8 b0 = *(const bf16x8*)(sB + (st0 * 32 + r) * 136 + kk + 8 * h);
            const bf16x8 b1 = *(const bf16x8*)(sB + ((st0 + 1) * 32 + r) * 136 + kk + 8 * h);
            cb0 = mfma32(a, b0, cb0); cb1 = mfma32(a, b1, cb1);
        }
        __syncthreads();
        bf16_t* sS = sB;
        const int lt2 = w >> 1, pt = w & 1;
        const int lme = lt2 * 32 + r;
        const int cp = tid & 31, lr = tid >> 5;
        u32x4 stv[2]; unsigned xin[11]; u32x2 zrn[4];
#define P4_PREFETCH(HD) { const bf16_t* stb_ = start + ((size_t)((b * NCH + c) * 8 + (HD)) * 64) * 128; \
            _Pragma("unroll") for (int i_ = 0; i_ < 2; ++i_) { const int id_ = tid + 512 * i_; stv[i_] = *(const u32x4*)(stb_ + (id_ >> 4) * 128 + (id_ & 15) * 8); } \
            conv2_load(p, b, c, lr * 8, (HD) * 64 + cp * 2, xin); \
            const bf16_t* zp_ = proj + (row0 + lme) * NPROJ + C_Z + (HD) * 64 + 32 * pt + 4 * h; \
            _Pragma("unroll") for (int g4_ = 0; g4_ < 4; ++g4_) zrn[g4_] = *(const u32x2*)(zp_ + 8 * g4_); }
        P4_PREFETCH(g * 4);
#pragma unroll 1
        for (int hh = 0; hh < 4; ++hh) {
            const int hd = g * 4 + hh;
            u32x2 zr[4];
#pragma unroll
            for (int g4 = 0; g4 < 4; ++g4) zr[g4] = zrn[g4];
#pragma unroll
            for (int q = 0; q < 2; ++q) {
                const int st = st0 + q;
                if (st <= lt) {
                    const int sme = st * 32 + r; const float cs_ = cums[hd * 128 + sme], ds_ = dts[hd * 128 + sme];
#pragma unroll
                    for (int i = 0; i < 16; ++i) {
                        const int l = lt * 32 + crow(i, h);
                        const float cbv = q ? cb1[i] : cb0[i];
                        const float v = (sme <= l) ? cbv * __expf(cums[hd * 128 + l] - cs_) * ds_ : 0.f;
                        sM[l * 136 + sme] = (bf16_t)f2bf(v);
                    }
                }
            }
            {
                u32x4 res[2];
                conv2_math(p, hd * 64 + cp * 2, xin, res);
                *(u32x4*)(sXT + (cp * 2) * 136 + lr * 8) = res[0];
                *(u32x4*)(sXT + (cp * 2 + 1) * 136 + lr * 8) = res[1];
            }
#pragma unroll
            for (int i = 0; i < 2; ++i) { const int id = tid + 512 * i; *(u32x4*)(sS + (id >> 4) * 136 + (id & 15) * 8) = stv[i]; }
            __syncthreads();
            if (hh < 3) P4_PREFETCH(hd + 1);
            {
                f32x16 yd = zero16(), yo = zero16();
                const int kend = 32 * (lt2 + 1);
#pragma unroll 2
                for (int kk = 0; kk < kend; kk += 16) {
                    const bf16x8 a = *(const bf16x8*)(sXT + (pt * 32 + r) * 136 + kk + 8 * h);
                    const bf16x8 bb = *(const bf16x8*)(sM + (lt2 * 32 + r) * 136 + kk + 8 * h);
                    yd = mfma32(a, bb, yd);
                }
#pragma unroll 2
                for (int kk = 0; kk < 128; kk += 16) {
                    const bf16x8 a = *(const bf16x8*)(sS + (pt * 32 + r) * 136 + kk + 8 * h);
                    const bf16x8 bb = *(const bf16x8*)(sC + (lt2 * 32 + r) * 136 + kk + 8 * h);
                    yo = mfma32(a, bb, yo);
                }
                const float dsk = p.in[10][hd];
                const float el = __expf(cums[hd * 128 + lme]);
                bf16_t* gp = A2 + (row0 + lme) * 1024 + 512 + hd * 64 + 32 * pt + 4 * h;
                float q = 0.f;
#pragma unroll
                for (int g4 = 0; g4 < 4; ++g4) {
                    float gv[4];
#pragma unroll
                    for (int e = 0; e < 4; ++e) {
                        const int i = 4 * g4 + e, pl = 32 * pt + 8 * g4 + 4 * h + e;
                        const float xs = bf2f((unsigned)sXT[pl * 136 + lme]);
                        const float y = yd[i] + el * yo[i] + dsk * xs;
                        const unsigned zw = (e >> 1) ? zr[g4].y : zr[g4].x;
                        const float z = (e & 1) ? bfhi(zw) : bflo(zw);
                        gv[e] = y * siluf(z);
                    }
                    const unsigned w0 = pk2(gv[0], gv[1]), w1 = pk2(gv[2], gv[3]);
                    *(u32x2*)(gp + 8 * g4) = (u32x2){w0, w1};
                    q += (bflo(w0) * bflo(w0) + bfhi(w0) * bfhi(w0)) + (bflo(w1) * bflo(w1) + bfhi(w1) * bfhi(w1));
                }
                q += __shfl_xor(q, 32);
                if (h == 0) gsq[lme * 8 + hh * 2 + pt] = q;
            }
            __syncthreads();
        }
#undef P4_PREFETCH
        {
            const float* wsn = p.in[12];
            for (int i = tid; i < 128 * 32; i += NTHREADS) {
                const int l = i >> 5, c8 = (i & 31) * 8;
                float s = 0.f;
#pragma unroll
                for (int q = 0; q < 8; ++q) s += gsq[l * 8 + q];
                const float rstd = 1.f / sqrtf(s * (1.f / 256.f) + EPS);
                const u32x4 t = *(const u32x4*)(A2 + (row0 + l) * 1024 + 512 + g * 256 + c8);
                const f32x4 w0 = *(const f32x4*)(wsn + g * 256 + c8), w1 = *(const f32x4*)(wsn + g * 256 + c8 + 4);
                u32x4 o; o.x = pk2(bflo(t.x) * rstd * w0.x, bfhi(t.x) * rstd * w0.y); o.y = pk2(bflo(t.y) * rstd * w0.z, bfhi(t.y) * rstd * w0.w); o.z = pk2(bflo(t.z) * rstd * w1.x, bfhi(t.z) * rstd * w1.y); o.w = pk2(bflo(t.w) * rstd * w1.z, bfhi(t.w) * rstd * w1.w);
                *(u32x4*)(A2 + (row0 + l) * 1024 + 512 + g * 256 + c8) = o;
            }
        }
        __syncthreads();
    }
}

__device__ __forceinline__ void phase5(const Params& p, unsigned char* lds) {
    unsigned char* ws = p.ws;
    pg8::Gemm g{(const bf16_t*)(ws + WS_A2), (const bf16_t*)(ws + WS_WOUT), NT, DM, DM};
    pg8::StaticOrder S; S.init(NT, DM, (int)gridDim.x, (int)blockIdx.x);
    pg8::EpiResid<true, true> E{p.in[0], (bf16_t*)(ws + WS_XB), (float*)(ws + WS_SSQ)};
    pg8::gemm_phase<pg8::EpiResid<true, true>, pg8::StaticOrder, true, true>(LDS3(lds), g, S, E);
}
__device__ __forceinline__ void phase6(const Params& p, unsigned char* lds) {
    unsigned char* ws = p.ws;
    pg8::Gemm g{(const bf16_t*)(ws + WS_XB), (const bf16_t*)(ws + WS_WQ), NT, 512, DM};
    pg8::StaticOrder S; S.init(NT, 512, (int)gridDim.x, (int)blockIdx.x);
    pg8::EpiQ E{(bf16_t*)(ws + WS_Q2), (const float*)(ws + WS_SSQ)};
    pg8::gemm_phase<pg8::EpiQ, pg8::StaticOrder, true, true>(LDS3(lds), g, S, E);
}
__device__ __forceinline__ void phase8(const Params& p, unsigned char* lds) {
    unsigned char* ws = p.ws;
    pg8::Gemm g{(const bf16_t*)(ws + WS_XO), (const bf16_t*)(ws + WS_WO), NT, DM, 512};
    pg8::StaticOrder S; S.init(NT, DM, (int)gridDim.x, (int)blockIdx.x);
    pg8::EpiResid<false, false> E{(const void*)(ws + WS_XB), (bf16_t*)(ws + WS_XB), nullptr};
    pg8::gemm_phase<pg8::EpiResid<false, false>, pg8::StaticOrder, true, true>(LDS3(lds), g, S, E);
}

__device__ __forceinline__ void phase7(const Params& p, unsigned char* lds) {
    const int tid = opaque_tid(), lane = tid & 63, w = tid >> 6, r = lane & 31, h = lane >> 5;
    const bf16_t* q2 = (const bf16_t*)(p.ws + WS_Q2); const bf16_t* kmem = (const bf16_t*)(p.ws + WS_KMEM); const bf16_t* vmemT = (const bf16_t*)(p.ws + WS_VMEMT);
    bf16_t* xo = (bf16_t*)(p.ws + WS_XO);
    bf16_t* sK = (bf16_t*)lds;
    bf16_t* sV = sK + 256 * 136;
    const float sc = 0.08838834764831845f * 1.4426950408889634f;
    for (int pr = blockIdx.x; pr < 256; pr += gridDim.x) {
        const int bh = pr >> 3, rp = pr & 7, b = bh >> 2, hx = bh & 3;
        __syncthreads();
        for (int i = tid; i < 4096; i += NTHREADS) { const int key = i >> 4, ch = i & 15;
            *(u32x4*)(sK + key * 136 + ch * 8) = *(const u32x4*)(kmem + ((size_t)b * 256 + key) * 512 + hx * 128 + ch * 8); }
        for (int i = tid; i < 4096; i += NTHREADS) { const int d = i >> 5, ch = i & 31;
            const u32x4 v = *(const u32x4*)(vmemT + (((size_t)b * 4 + hx) * 128 + d) * 256 + ch * 8);
            *(u32x2*)(sV + d * 260 + ch * 8) = (u32x2){v.x, v.y}; *(u32x2*)(sV + d * 260 + ch * 8 + 4) = (u32x2){v.z, v.w}; }
        __syncthreads();
#pragma unroll 1
        for (int ib = 0; ib < 2; ++ib) {
            const size_t row0 = (size_t)b * SEQ + (size_t)(2 * rp + ib) * 256 + w * 32;
            bf16x8 qf[8];
            const bf16_t* qp = q2 + (row0 + r) * 512 + hx * 128 + 8 * h;
#pragma unroll
            for (int kk = 0; kk < 8; ++kk) qf[kk] = *(const bf16x8*)(qp + kk * 16);
            f32x16 S[8];
#pragma unroll
            for (int t = 0; t < 8; ++t) S[t] = zero16();
            const bf16_t* kp = sK + r * 136 + 8 * h;
#pragma unroll
            for (int kk = 0; kk < 8; ++kk) {
#pragma unroll
                for (int t = 0; t < 8; ++t) { const bf16x8 a = *(const bf16x8*)(kp + t * (32 * 136) + kk * 16); S[t] = mfma32(a, qf[kk], S[t]); }
                __builtin_amdgcn_sched_barrier(0);
            }
            float m = -INFINITY;
#pragma unroll
            for (int t = 0; t < 8; ++t)
#pragma unroll
                for (int i = 0; i < 16; ++i) m = fmaxf(m, S[t][i]);
            m = fmaxf(m, __shfl_xor(m, 32));
            float sum = 0.f;
            bf16x8 P[16];
#pragma unroll
            for (int t = 0; t < 8; ++t) {
                float e[16];
#pragma unroll
                for (int i = 0; i < 16; ++i) { e[i] = __builtin_amdgcn_exp2f((S[t][i] - m) * sc); sum += e[i]; }
                P[2 * t] = pack8(e[0], e[1], e[2], e[3], e[4], e[5], e[6], e[7]);
                P[2 * t + 1] = pack8(e[8], e[9], e[10], e[11], e[12], e[13], e[14], e[15]);
            }
            sum += __shfl_xor(sum, 32);
            const float inv = 1.f / sum;
            f32x16 O[4];
#pragma unroll
            for (int dt = 0; dt < 4; ++dt) O[dt] = zero16();
            const bf16_t* vp0 = sV + r * 260 + 4 * h;
#pragma unroll
            for (int ts = 0; ts < 16; ++ts) {
#pragma unroll
                for (int dt = 0; dt < 4; ++dt) {
                    const bf16_t* vp = vp0 + dt * (32 * 260) + 16 * ts;
                    const u32x2 lo = *(const u32x2*)vp, hi = *(const u32x2*)(vp + 8);
                    const bf16x8 a = __builtin_bit_cast(bf16x8, (u32x4){lo.x, lo.y, hi.x, hi.y});
                    O[dt] = mfma32(a, P[ts], O[dt]);
                }
                if (ts & 1) __builtin_amdgcn_sched_barrier(0);
            }
            bf16_t* op = xo + (row0 + r) * 512 + hx * 128 + 4 * h;
#pragma unroll
            for (int dt = 0; dt < 4; ++dt)
#pragma unroll
                for (int g = 0; g < 4; ++g) { u32x2 o; o.x = pk2(O[dt][4 * g] * inv, O[dt][4 * g + 1] * inv); o.y = pk2(O[dt][4 * g + 2] * inv, O[dt][4 * g + 3] * inv);
                    *(u32x2*)(op + 32 * dt + 8 * g) = o; }
        }
    }
}

typedef __bf16 bf16x2_t __attribute__((ext_vector_type(2)));
__device__ __forceinline__ float dot2bf(unsigned a, unsigned b, float acc) { return __builtin_amdgcn_fdot2_f32_bf16(__builtin_bit_cast(bf16x2_t, a), __builtin_bit_cast(bf16x2_t, b), acc, false); }
__device__ __forceinline__ void phase9(const Params& p, unsigned char* lds) {
    const int tid = opaque_tid(), lane = tid & 63, w = tid >> 6, r = lane & 31, h = lane >> 5;
    const bf16_t* x2 = (const bf16_t*)(p.ws + WS_XB);
    int* cnt = (int*)(p.ws + WS_CTL);
    int* list = (int*)(p.ws + WS_LIST);
    float* route = (float*)(p.ws + WS_ROUTE);
    const float* bg = p.in[21]; const float* be = p.in[23];
    bf16_t* sW = (bf16_t*)lds;
    int* lcnt = (int*)(lds + 74752);
    float* lrec = (float*)(lds + 74752 + 256);
    for (int i = tid; i < 36 * 128; i += NTHREADS) { const int n = i >> 7, ch = i & 127; *(u32x4*)(sW + n * 1032 + ch * 8) = *(const u32x4*)((const bf16_t*)(p.ws + WS_WR) + n * 1024 + ch * 8); }
    if (tid < 64) lcnt[tid] = 0;
    __syncthreads();
    const int njobs = NT / 32, jstride = gridDim.x * 4;
    int nrec = 0;
    for (int job0 = blockIdx.x * 4; job0 < njobs; job0 += jstride, ++nrec) {
        const int job = job0 + w;
        if (w < 4 && job < njobs) {
            const int m0 = job * 32;
            f32x16 acc0 = zero16(), acc1 = zero16();
            float ss = 0.f;
            const bf16_t* xp = x2 + (size_t)(m0 + r) * DM + 8 * h;
            const bf16_t* w0p = sW + r * 1032 + 8 * h;
            const bf16_t* w1p = sW + (32 + (r & 3)) * 1032 + 8 * h;
#pragma unroll 1
            for (int kb = 0; kb < 4; ++kb) {
                u32x4 xf[16];
#pragma unroll
                for (int q = 0; q < 16; ++q) xf[q] = *(const u32x4*)(xp + (kb * 16 + q) * 16);
#pragma unroll
                for (int q = 0; q < 16; ++q) {
                    const bf16x8 a0 = *(const bf16x8*)(w0p + (kb * 16 + q) * 16), a1 = *(const bf16x8*)(w1p + (kb * 16 + q) * 16);
                    const bf16x8 xb = __builtin_bit_cast(bf16x8, xf[q]);
                    acc0 = mfma32(a0, xb, acc0); acc1 = mfma32(a1, xb, acc1);
                    ss = dot2bf(xf[q].x, xf[q].x, ss); ss = dot2bf(xf[q].y, xf[q].y, ss); ss = dot2bf(xf[q].z, xf[q].z, ss); ss = dot2bf(xf[q].w, xf[q].w, ss);
                }
            }
            ss += __shfl_xor(ss, 32);
            const float rstd = 1.f / sqrtf(ss * (1.f / DM) + EPS);
            const float g0 = __shfl(acc1[0], r) * rstd + bg[0], g1 = __shfl(acc1[1], r) * rstd + bg[1], g2 = __shfl(acc1[2], r) * rstd + bg[2], g3 = __shfl(acc1[3], r) * rstd + bg[3];
            int gi = 0; float gm = g0;
            if (g1 > gm) { gm = g1; gi = 1; }
            if (g2 > gm) { gm = g2; gi = 2; }
            if (g3 > gm) { gm = g3; gi = 3; }
            const float gden = __expf(g0 - gm) + __expf(g1 - gm) + __expf(g2 - gm) + __expf(g3 - gm);
            const float ggate = 1.f / gden;
            const bool up = (gi & 1) != 0;
            const int gme = 2 * h + (gi & 1);
            float ev[8];
#pragma unroll
            for (int j = 0; j < 8; ++j) ev[j] = (up ? acc0[8 + j] : acc0[j]) * rstd + be[gme * 8 + j];
            int i1 = 0; float v1 = ev[0];
#pragma unroll
            for (int j = 1; j < 8; ++j) if (ev[j] > v1) { v1 = ev[j]; i1 = j; }
            int i2 = -1; float v2 = -INFINITY;
#pragma unroll
            for (int j = 0; j < 8; ++j) if (j != i1 && ev[j] > v2) { v2 = ev[j]; i2 = j; }
            const float e2 = __expf(v2 - v1);
            const float w1 = ggate / (1.f + e2), w2 = ggate * e2 / (1.f + e2);
            if (h == (gi >> 1)) {
                const int ea = gi * 8 + i1, eb = gi * 8 + i2;
                const int la = atomicAdd(lcnt + ea, 1), lb = atomicAdd(lcnt + eb, 1);
                float* rc = lrec + (size_t)(nrec * 128 + w * 32 + r) * 8;
                ((int*)rc)[0] = ea; ((int*)rc)[1] = eb; ((int*)rc)[2] = la; ((int*)rc)[3] = lb; rc[4] = w1; rc[5] = w2; rc[6] = rstd; ((int*)rc)[7] = m0 + r;
            }
        }
    }
    __syncthreads();
    if (tid < 32) lcnt[32 + tid] = lcnt[tid] ? atomicAdd(cnt + tid * 64, lcnt[tid]) : 0;
    __syncthreads();
    {
        int rd = 0;
        for (int job0 = blockIdx.x * 4; job0 < njobs; job0 += jstride, ++rd) {
            if (tid < 128 && job0 + (tid >> 5) < njobs) {
                const float* rc = lrec + (size_t)(rd * 128 + tid) * 8;
                const int ea = ((const int*)rc)[0], eb = ((const int*)rc)[1], m = ((const int*)rc)[7];
                const int pa = lcnt[32 + ea] + ((const int*)rc)[2], pb = lcnt[32 + eb] + ((const int*)rc)[3];
                list[ea * NT + pa] = m; list[eb * NT + pb] = m;
                int* ri = (int*)(route + (size_t)m * 8);
                ri[0] = ea; ri[1] = eb; ri[2] = pa; ri[3] = pb;
                route[(size_t)m * 8 + 4] = rc[4]; route[(size_t)m * 8 + 5] = rc[5]; route[(size_t)m * 8 + 6] = rc[6]; route[(size_t)m * 8 + 7] = 0.f;
            }
        }
    }
}

__device__ __forceinline__ int* moe_tables(const Params& p, unsigned char* lds) {
    int* off = (int*)(lds + 131072);
    const int* cnt = (const int*)(p.ws + WS_CTL);
    if (threadIdx.x < 64) {
        const int l = threadIdx.x & 63;
        const int cv = (l < NEXP) ? cnt[l * 64] : 0;
        int pad = ((cv + 255) >> 8) << 8, incl = pad;
#pragma unroll
        for (int o = 1; o < 32; o <<= 1) { const int t = __shfl_up(incl, o); if (l >= o) incl += t; }
        if (l < NEXP) { off[l] = incl - pad; off[40 + l] = cv; }
        if (l == NEXP - 1) off[NEXP] = incl;
    }
    __syncthreads();
    const int nrt = off[NEXP] >> 8;
    for (int rt = threadIdx.x; rt < nrt; rt += NTHREADS) { int e = 0; for (int q = 1; q < NEXP; ++q) if (off[q] <= rt * 256) e = q; off[128 + rt] = e; }
    __syncthreads();
    return off;
}

__device__ __forceinline__ void phase10(const Params& p, unsigned char* lds) {
    const int tid = opaque_tid(), lane = tid & 63, w = tid >> 6;
    const int* off = moe_tables(p, lds);
    const int gw = blockIdx.x * NWAVES + w, NGW = gridDim.x * NWAVES;
    const bf16_t* x2 = (const bf16_t*)(p.ws + WS_XB); const float* route = (const float*)(p.ws + WS_ROUTE);
    bf16_t* xg = (bf16_t*)(p.ws + WS_XG);
    for (int m = gw; m < NT; m += NGW) {
        const int* ri = (const int*)(route + (size_t)m * 8);
        const int ea = ri[0], eb = ri[1], pa = ri[2], pb = ri[3];
        const float rs = route[(size_t)m * 8 + 6];
        const size_t sa = (size_t)off[ea] + pa, sb = (size_t)off[eb] + pb;
        const u32x2* xr = (const u32x2*)(x2 + (size_t)m * DM) + lane;
        u32x2* oa = (u32x2*)(xg + sa * DM) + lane; u32x2* ob = (u32x2*)(xg + sb * DM) + lane;
#pragma unroll
        for (int j = 0; j < 4; ++j) { const u32x2 t = xr[64 * j]; u32x2 o; o.x = pk2(bflo(t.x) * rs, bfhi(t.x) * rs); o.y = pk2(bflo(t.y) * rs, bfhi(t.y) * rs); oa[64 * j] = o; ob[64 * j] = o; }
    }
}

__device__ __forceinline__ void phase11(const Params& p, unsigned char* lds) {
    const int tid = opaque_tid();
    const int* off = moe_tables(p, lds);
    const int nrt = off[NEXP] >> 8, G = (int)gridDim.x, c = (int)blockIdx.x;
    unsigned* rowtab = (unsigned*)(lds + 131072 + 2048);
    float* rstab = (float*)(lds + 131072 + 2048 + 3072);
    {
        const int* list = (const int*)(p.ws + WS_LIST); const float* route = (const float*)(p.ws + WS_ROUTE);
        for (int i = 0; i < 3; ++i) {
            const int L = i * G + c; if (L >= nrt * 2) break;
            const int rt = L >> 1, e = off[128 + rt], cnt_e = off[40 + e], pos0 = rt * 256 - off[e];
            if (tid < 256) { const int pos = pos0 + tid; int tok = 0; float rs = 0.f;
                if (pos < cnt_e) { tok = list[e * NT + pos]; rs = route[(size_t)tok * 8 + 6]; }
                rowtab[i * 256 + tid] = (unsigned)tok * (unsigned)(DM * 2); rstab[i * 256 + tid] = rs; }
        }
    }
    __syncthreads();
    pg8::Gemm g{(const bf16_t*)(p.ws + WS_XB), (const bf16_t*)(p.ws + WS_WGU), 0, 0, DM};
    pg8::MoeOrder S{(const __attribute__((address_space(3))) int*)(off + 128), nrt, 2, G, c};
    pg8::EpiGU E{(bf16_t*)(p.ws + WS_HID), (const __attribute__((address_space(3))) float*)rstab, G, c};
    pg8::gemm_phase_g<pg8::EpiGU, pg8::MoeOrder, true, true>(LDS3(lds), g, S, E, (const __attribute__((address_space(3))) unsigned*)rowtab);
}
__device__ __forceinline__ void phase12(const Params& p, unsigned char* lds) {
    const int* off = moe_tables(p, lds);
    int kdim = EFF; asm volatile("" : "+s"(kdim));
    pg8::Gemm g{(const bf16_t*)(p.ws + WS_HID), (const bf16_t*)(p.ws + WS_WD), 0, 0, kdim};
    pg8::MoeOrder S{(const __attribute__((address_space(3))) int*)(off + 128), off[NEXP] >> 8, 4, (int)gridDim.x, (int)blockIdx.x};
    pg8::EpiY8 E{(unsigned char*)(p.ws + WS_Y), DM, 4};
    pg8::gemm_phase<pg8::EpiY8, pg8::MoeOrder, true, true>(LDS3(lds), g, S, E);
}

__device__ __forceinline__ void phase13(const Params& p, unsigned char* lds) {
    const int tid = opaque_tid(), lane = tid & 63, w = tid >> 6;
    const int* off = moe_tables(p, lds);
    const int gw = blockIdx.x * NWAVES + w, NGW = gridDim.x * NWAVES;
    const bf16_t* x2 = (const bf16_t*)(p.ws + WS_XB); const unsigned char* yb = (const unsigned char*)(p.ws + WS_Y);
    const float* route = (const float*)(p.ws + WS_ROUTE); const float* wf = p.in[27];
    f32x4 wv[2][2];
#pragma unroll
    for (int j = 0; j < 2; ++j) { wv[j][0] = *(const f32x4*)(wf + 8 * lane + 512 * j); wv[j][1] = *(const f32x4*)(wf + 8 * lane + 512 * j + 4); }
    struct Rows { u32x4 x[2]; u32x2 ya[2], yb[2]; float w1, w2; };
    Rows R0, R1, R2;
    u32x4 recN; u32x2 wN;
#define LOAD_REC(m_, REC, WW) { REC = *(const u32x4*)(route + (size_t)(m_) * 8); WW = *(const u32x2*)(route + (size_t)(m_) * 8 + 4); }
#define ISSUE_ROWS(m_, REC, WW, R) { const size_t sa_ = (size_t)off[(int)(REC).x] + (REC).z, sb_ = (size_t)off[(int)(REC).y] + (REC).w; \
        const u32x4* xr_ = (const u32x4*)(x2 + (size_t)(m_) * DM) + lane; const u32x2* ya_ = (const u32x2*)(yb + sa_ * DM) + lane; const u32x2* yb_ = (const u32x2*)(yb + sb_ * DM) + lane; \
        _Pragma("unroll") for (int j = 0; j < 2; ++j) { R.x[j] = xr_[64 * j]; R.ya[j] = ya_[64 * j]; R.yb[j] = yb_[64 * j]; } \
        R.w1 = __uint_as_float((WW).x) * 0.0625f; R.w2 = __uint_as_float((WW).y) * 0.0625f; }
    {
        u32x4 rc; u32x2 ww;
        if (gw < NT) { LOAD_REC(gw, rc, ww); ISSUE_ROWS(gw, rc, ww, R0); }
        if (gw + NGW < NT) { LOAD_REC(gw + NGW, rc, ww); ISSUE_ROWS(gw + NGW, rc, ww, R1); }
        if (gw + 2 * NGW < NT) LOAD_REC(gw + 2 * NGW, recN, wN);
    }
#pragma unroll 1
    for (int m = gw; m < NT; m += NGW) {
        if (m + 2 * NGW < NT) ISSUE_ROWS(m + 2 * NGW, recN, wN, R2);
        if (m + 3 * NGW < NT) LOAD_REC(m + 3 * NGW, recN, wN);
        f32x4 v[2][2]; float s = 0.f;
#pragma unroll
        for (int j = 0; j < 2; ++j) {
            typedef float f32x2v __attribute__((ext_vector_type(2)));
            const u32x4 t = R0.x[j]; const u32x2 a = R0.ya[j], bq = R0.yb[j]; const float w1 = R0.w1, w2 = R0.w2;
            const f32x2v a0 = __builtin_amdgcn_cvt_pk_f32_fp8((int)a.x, false), a1 = __builtin_amdgcn_cvt_pk_f32_fp8((int)a.x, true), a2 = __builtin_amdgcn_cvt_pk_f32_fp8((int)a.y, false), a3 = __builtin_amdgcn_cvt_pk_f32_fp8((int)a.y, true);
            const f32x2v b0 = __builtin_amdgcn_cvt_pk_f32_fp8((int)bq.x, false), b1 = __builtin_amdgcn_cvt_pk_f32_fp8((int)bq.x, true), b2 = __builtin_amdgcn_cvt_pk_f32_fp8((int)bq.y, false), b3 = __builtin_amdgcn_cvt_pk_f32_fp8((int)bq.y, true);
            v[j][0] = (f32x4){bflo(t.x) + w1 * a0.x + w2 * b0.x, bfhi(t.x) + w1 * a0.y + w2 * b0.y, bflo(t.y) + w1 * a1.x + w2 * b1.x, bfhi(t.y) + w1 * a1.y + w2 * b1.y};
            v[j][1] = (f32x4){bflo(t.z) + w1 * a2.x + w2 * b2.x, bfhi(t.z) + w1 * a2.y + w2 * b2.y, bflo(t.w) + w1 * a3.x + w2 * b3.x, bfhi(t.w) + w1 * a3.y + w2 * b3.y};
#pragma unroll
            for (int q = 0; q < 2; ++q) s += (v[j][q].x * v[j][q].x + v[j][q].y * v[j][q].y) + (v[j][q].z * v[j][q].z + v[j][q].w * v[j][q].w);
        }
        const float rstd = 1.f / sqrtf(wave_sum(s) * (1.f / DM) + EPS);
        float* o = p.out + (size_t)m * DM + 8 * lane;
#pragma unroll
        for (int j = 0; j < 2; ++j) { *(f32x4*)(o + 512 * j) = v[j][0] * rstd * wv[j][0]; *(f32x4*)(o + 512 * j + 4) = v[j][1] * rstd * wv[j][1]; }
        R0 = R1; R1 = R2;
    }
#undef ISSUE_ROWS
#undef LOAD_REC
}

constexpr int NPHASE = 14;
__global__ void __launch_bounds__(NTHREADS, 2) fwd_kernel(Params p) {
    extern __shared__ __attribute__((aligned(16))) unsigned char lds[];
#if MK_ONE_LAUNCH
    cg::grid_group grid = cg::this_grid();
    volatile LAS unsigned* bst = (volatile LAS unsigned*)(LDS3(lds) + LDS_BYTES - 16);
    if (threadIdx.x < 2) bst[threadIdx.x] = 0u;
    __syncthreads();
    const XcdBarrier xbar = xcd_barrier_post((unsigned*)(p.ws + WS_BAR), bst);
    if (p.ph_hi > NPHASE) grid.sync();
#define SEAM(k) do { if (p.ph_lo <= (k) && (k) + 1 < p.ph_hi) xcd_barrier(xbar); } while (0)
#else
#define SEAM(k) do { } while (0)
#endif
#ifndef PROBE_PHASE
#define PROBE_PHASE -1
#endif
#define IN(k) (p.ph_lo <= (k) && (k) < p.ph_hi && (k) != p.skip)
#define REPS(k) (((k) == PROBE_PHASE) ? 2 : 1)
    if (IN(0)) { _Pragma("unroll 1") for (int rep = 0; rep < REPS(0); ++rep) { phase0(p, lds); } } SEAM(0);
    if (IN(1)) { _Pragma("unroll 1") for (int rep = 0; rep < REPS(1); ++rep) { phase1(p, lds); } } SEAM(1);
    if (IN(2)) { _Pragma("unroll 1") for (int rep = 0; rep < REPS(2); ++rep) for (int it = blockIdx.x; it < NB * NCH; it += gridDim.x) { const int b = it / NCH, c = it % NCH; phase2_attn(p, lds, b, c); phase2_states(p, lds, b, c); } } SEAM(2);
    if (IN(3)) { _Pragma("unroll 1") for (int rep = 0; rep < REPS(3); ++rep) { phase3(p); } } SEAM(3);
    if (IN(4)) { _Pragma("unroll 1") for (int rep = 0; rep < REPS(4); ++rep) for (int it = blockIdx.x; it < NB * NCH; it += gridDim.x) { const int b = it / NCH, c = it % NCH; phase4(p, lds, b, c); } } SEAM(4);
    if (IN(5)) { _Pragma("unroll 1") for (int rep = 0; rep < REPS(5); ++rep) { phase5(p, lds); } } SEAM(5);
    if (IN(6)) { _Pragma("unroll 1") for (int rep = 0; rep < REPS(6); ++rep) { phase6(p, lds); } } SEAM(6);
    if (IN(7)) { _Pragma("unroll 1") for (int rep = 0; rep < REPS(7); ++rep) { phase7(p, lds); } } SEAM(7);
    if (IN(8)) { phase8(p, lds); } SEAM(8);
    if (IN(9)) { phase9(p, lds); } SEAM(9);
    if (IN(11)) { _Pragma("unroll 1") for (int rep = 0; rep < REPS(11); ++rep) { phase11(p, lds); } } SEAM(11);
    if (IN(12)) { _Pragma("unroll 1") for (int rep = 0; rep < REPS(12); ++rep) { phase12(p, lds); } } SEAM(12);
    if (IN(13)) { _Pragma("unroll 1") for (int rep = 0; rep < REPS(13); ++rep) { phase13(p, lds); } }
#undef IN
#undef SEAM
}

extern "C" void kernel_launch(void* const* d_in, const int* in_sizes, int n_in, void* d_out, int out_size, void* d_ws, size_t ws_size, hipStream_t stream) {
    static int grid = 0;
    if (grid == 0) {
        if (n_in != 28 || out_size != NT * DM || ws_size < WS_NEED) { fprintf(stderr, "kernel_launch: unexpected sizes n_in %d out %d ws %zu\n", n_in, out_size, ws_size); grid = -1; return; }
        int dev = 0, cus = 0, per_cu = 0;
        hipGetDevice(&dev);
        hipDeviceGetAttribute(&cus, hipDeviceAttributeMultiprocessorCount, dev);
        if (hipFuncSetAttribute((const void*)fwd_kernel, hipFuncAttributeMaxDynamicSharedMemorySize, LDS_BYTES) != hipSuccess) { fprintf(stderr, "kernel_launch: hipFuncSetAttribute failed\n"); grid = -1; return; }
        if (hipOccupancyMaxActiveBlocksPerMultiprocessor(&per_cu, (const void*)fwd_kernel, NTHREADS, LDS_BYTES) != hipSuccess || per_cu < 1) { fprintf(stderr, "kernel_launch: occupancy query says %d\n", per_cu); per_cu = 1; }
        (void)hipGetLastError();
        grid = cus;
    }
    if (grid < 0) return;
    Params prm{};
    for (int i = 0; i < 28; ++i) prm.in[i] = (const float*)d_in[i];
    prm.out = (float*)d_out; prm.ws = (unsigned char*)d_ws;
    for (int i = 0; i < 8; ++i) prm.inv_freq[i] = powf(500000.0f, -(float)(2 * i) / 16.0f);
    prm.skip = -1;
#ifndef PROBE_SKIP
#define PROBE_SKIP -2
#endif
#if MK_ONE_LAUNCH
    for (int twice = 0; twice < ((PROBE_SKIP >= -1) ? 2 : 1); ++twice) {
    if (hipMemsetAsync((char*)d_ws + WS_CTL, 0, CTL_ZERO_BYTES, stream) != hipSuccess) { fprintf(stderr, "kernel_launch: memset failed\n"); return; }
#ifndef PROBE_TRUNC
#define PROBE_TRUNC NPHASE
#endif
    prm.ph_lo = 0; prm.ph_hi = twice ? PROBE_TRUNC : NPHASE; prm.skip = twice ? PROBE_SKIP : -1;
    void* args[] = {&prm};
    hipError_t e = hipLaunchCooperativeKernel((const void*)fwd_kernel, dim3(grid), dim3(NTHREADS), args, LDS_BYTES, stream);
    if (e != hipSuccess) fprintf(stderr, "cooperative launch failed: %s (grid %d)\n", hipGetErrorString(e), grid);
    }
#else
    if (hipMemsetAsync((char*)d_ws + WS_CTL, 0, CTL_ZERO_BYTES, stream) != hipSuccess) { fprintf(stderr, "kernel_launch: memset failed\n"); return; }
#ifndef PROBE_DUP
#define PROBE_DUP -1
#endif
    for (int ph = 0; ph < NPHASE; ++ph) {
        prm.ph_lo = ph; prm.ph_hi = ph + 1;
        hipLaunchKernelGGL(fwd_kernel, dim3(grid), dim3(NTHREADS), LDS_BYTES, stream, prm);
        if (ph == PROBE_DUP) hipLaunchKernelGGL(fwd_kernel, dim3(grid), dim3(NTHREADS), LDS_BYTES, stream, prm);
    }
#endif
}
```

```cpp
#include <hip/hip_runtime.h>
#include <hip/hip_cooperative_groups.h>
#include <cstdio>
#include <cmath>
namespace cg = cooperative_groups;

#ifndef MK_ONE_LAUNCH
#define MK_ONE_LAUNCH 1
#endif

typedef unsigned short bf16_t;
typedef short bf16x8 __attribute__((ext_vector_type(8)));
typedef float f32x4 __attribute__((ext_vector_type(4)));
typedef float f32x16 __attribute__((ext_vector_type(16)));
typedef unsigned u32x4 __attribute__((ext_vector_type(4)));
typedef unsigned u32x2 __attribute__((ext_vector_type(2)));

constexpr int NB = 8, SEQ = 4096, DM = 1024, NT = NB * SEQ;
constexpr int NPROJ = 2304, LDWIN = 2312;
constexpr int C_K = 512, C_V = 640, C_Z = 768, C_X = 1280, C_B = 1792, C_C = 2048;
constexpr int MEMT = 256, NMEM = NB * MEMT;
constexpr int NEXP = 32, EFF = 256;
constexpr int NCH = SEQ / 128;
constexpr float EPS = 1e-5f;
constexpr int NTHREADS = 512, NWAVES = 8;
constexpr int LDS_BYTES = 147456;

constexpr size_t MiB = (size_t)1 << 20;
constexpr size_t WS_CTL = 0, WS_BAR = 65536, CTL_ZERO_BYTES = 131072;
constexpr size_t WS_WIN = 1 * MiB, WS_WOUT = 6 * MiB, WS_WQ = 8 * MiB, WS_WKV = 9 * MiB, WS_WO = 11 * MiB, WS_WR = 12 * MiB;
constexpr size_t WS_WGU = 16 * MiB, WS_WD = 48 * MiB;
constexpr size_t WS_MEMH = 64 * MiB, WS_KMEM = 68 * MiB, WS_VMEMT = 70 * MiB, WS_DTRAW = 72 * MiB, WS_CDEC = 73 * MiB, WS_ROUTE = 74 * MiB;
constexpr size_t WS_LIST = 76 * MiB, WS_SSQ = 80 * MiB;
constexpr size_t WS_PROJ = 96 * MiB, WS_A2 = 240 * MiB, WS_STATES = 304 * MiB, WS_START = 368 * MiB;
constexpr size_t WS_X1 = 96 * MiB, WS_XB = 304 * MiB, WS_Q2 = 368 * MiB, WS_XO = 224 * MiB, WS_XG = 96 * MiB, WS_HID = 368 * MiB, WS_Y = 96 * MiB;
constexpr size_t WS_H1 = 416 * MiB;
constexpr size_t WS_NEED = 512 * MiB;

struct Params {
    const float* in[28];
    float* out;
    unsigned char* ws;
    float inv_freq[8];
    int ph_lo, ph_hi, skip, pad;
};

__device__ __forceinline__ unsigned f2bf(float f) { unsigned u = __float_as_uint(f); return (u + 0x7fffu + ((u >> 16) & 1u)) >> 16; }
__device__ __forceinline__ float bf2f(unsigned h) { return __uint_as_float(h << 16); }
__device__ __forceinline__ unsigned pk2(float lo, float hi) { return f2bf(lo) | (f2bf(hi) << 16); }
__device__ __forceinline__ float bflo(unsigned u) { return __uint_as_float(u << 16); }
__device__ __forceinline__ float bfhi(unsigned u) { return __uint_as_float(u & 0xffff0000u); }
__device__ __forceinline__ float wave_sum(float v) {
#pragma unroll
    for (int o = 32; o >= 1; o >>= 1) v += __shfl_xor(v, o);
    return v;
}
#define LDS_WAIT() asm volatile("s_waitcnt lgkmcnt(0)" ::: "memory")
__device__ __forceinline__ int opaque_tid() { int t = threadIdx.x; asm volatile("" : "+v"(t)); return t; }
__device__ __forceinline__ float siluf(float v) { return v * __builtin_amdgcn_rcpf(1.f + __expf(-v)); }
__device__ __forceinline__ f32x16 mfma32(bf16x8 a, bf16x8 b, f32x16 c) { return __builtin_amdgcn_mfma_f32_32x32x16_bf16(a, b, c, 0, 0, 0); }
__device__ __forceinline__ f32x16 zero16() { f32x16 z;
#pragma unroll
    for (int i = 0; i < 16; ++i) z[i] = 0.f;
    return z; }
__device__ __forceinline__ bf16x8 pack8(float a0, float a1, float a2, float a3, float a4, float a5, float a6, float a7) {
    u32x4 t; t.x = pk2(a0, a1); t.y = pk2(a2, a3); t.z = pk2(a4, a5); t.w = pk2(a6, a7);
    return __builtin_bit_cast(bf16x8, t);
}
__device__ __forceinline__ int crow(int i, int h) { return (i & 3) + 8 * (i >> 2) + 4 * h; }

namespace pg8 {
#define PG8_LAS __attribute__((address_space(3)))
typedef unsigned short bf16_t;
typedef short bf16x8 __attribute__((ext_vector_type(8)));
typedef float f32x4 __attribute__((ext_vector_type(4)));
typedef unsigned u32x4 __attribute__((ext_vector_type(4)));
constexpr int BM = 256, BK = 64, HALF = 128, HTB = HALF * BK * 2  , STAGE_BYTES = 8 * HTB, NXCD = 8, WGM = 8;

__host__ __device__ __forceinline__ int lds_byte(int r, int c) { const int st = (r >> 4) * 2 + (c >> 5), rr = r & 15, cc = c & 31, ob = rr * 64 + cc * 2; return st * 1024 + (ob ^ (((ob >> 9) & 1) << 5)); }
__host__ __device__ __forceinline__ void stage_rc(int b, int& R, int& C) { const int st = b / 1024, sb = b % 1024, swz = sb ^ (((sb >> 9) & 1) << 5); R = (st >> 1) * 16 + swz / 64; C = (st & 1) * 32 + (swz % 64) / 2; }
__host__ __device__ __forceinline__ int perm32(int rho) { const int n = rho >> 4, i = rho & 15; return 8 * (i >> 2) + 4 * n + (i & 3); }

struct Unit { int pm, pn; };
struct Gemm { const bf16_t* A; const bf16_t* Bt; int M, N, K; };

struct StaticOrder {
    int nM, nN, nwg, G, c;
    __host__ __device__ void init(int M, int N, int G_, int c_) { nM = M / BM; nN = N / BM; nwg = nM * nN; G = G_; c = c_; }
    __host__ __device__ bool next(int i, Unit& u) const {
        const long L = (long)i * G + c; if (L >= nwg) return false;
        int wgid = (int)L; { const int q = nwg / NXCD, r = nwg % NXCD, xcd = wgid % NXCD, off = wgid / NXCD; wgid = (xcd < r ? xcd * (q + 1) : r * (q + 1) + (xcd - r) * q) + off; }
        const int nig = WGM * nN, gid = wgid / nig, fm = gid * WGM, gsz = (nM - fm) < WGM ? (nM - fm) : WGM;
        u.pm = fm + ((wgid % nig) % gsz); u.pn = (wgid % nig) / gsz; return true;
    }
    __device__ __forceinline__ void a_ready(const Unit&) const {}
    __device__ __forceinline__ void done(const Unit&) const {}
};
__device__ __forceinline__ unsigned cvt_pk_bf16(float lo, float hi) { unsigned r; asm volatile("v_cvt_pk_bf16_f32 %0, %1, %2" : "=v"(r) : "v"(lo), "v"(hi)); return r; }
typedef float f32x2 __attribute__((ext_vector_type(2)));
template <class Epi, class Sched, bool ALIGN_EPI = false, bool SP2 = false>
__device__ __forceinline__ void gemm_phase(PG8_LAS unsigned char* lds, const Gemm g, const Sched& S, const Epi& E) {
    const int tid = threadIdx.x, wid = __builtin_amdgcn_readfirstlane(tid >> 6), lane = tid & 63, wr = wid >> 2, wc = wid & 3, fr = lane & 15, fq = lane >> 4;
    const int K = g.K, nt = K / BK;
    unsigned voffA[2], voffB[2];
#pragma unroll
    for (int i = 0; i < 2; ++i) { int R, C; stage_rc(tid * 16 + i * 8192, R, C); const int Rb = Epi::PERM ? ((R & ~31) + perm32(R & 31)) : R;
        voffA[i] = (unsigned)(R * K + C) * 2u; voffB[i] = (unsigned)(Rb * K + C) * 2u; }
    const size_t kstep = (size_t)(BK * 2);
    const size_t hstep = (size_t)HALF * K * 2;
    const size_t tstep = 2 * hstep;
    const unsigned ldsw = (unsigned)wid * 1024u;
    const int aoff = lds_byte(wr * 64 + fr, fq * 8), boff = lds_byte(wc * 32 + fr, fq * 8);
#define PG8_SA(b, h) (((b) * 2 + (h)) * HTB)
#define PG8_SB(b, h) ((4 + (b) * 2 + (h)) * HTB)
#define PG8_STAGE(bufoff, gbase, voff) do { _Pragma("unroll") for (int _i = 0; _i < 2; ++_i) \
        __builtin_amdgcn_global_load_lds((const unsigned*)((const char*)(gbase) + (voff)[_i]), (PG8_LAS unsigned*)(lds + (bufoff) + ldsw + _i * 8192), 16, 0, 0); } while (0)
#define PG8_LDA(dst, b, h) do { _Pragma("unroll") for (int m = 0; m < 4; ++m) _Pragma("unroll") for (int k = 0; k < 2; ++k) dst[m][k] = *(const PG8_LAS bf16x8*)(lds + PG8_SA(b, h) + aoff + m * 2048 + k * 1024); } while (0)
#define PG8_LDB(dst, b, h) do { _Pragma("unroll") for (int n = 0; n < 2; ++n) _Pragma("unroll") for (int k = 0; k < 2; ++k) dst[n][k] = *(const PG8_LAS bf16x8*)(lds + PG8_SB(b, h) + boff + n * 2048 + k * 1024); } while (0)
#define PG8_MMA(ai, bj, At, Bt) do { __builtin_amdgcn_s_setprio(1); _Pragma("unroll") for (int m = 0; m < 4; ++m) _Pragma("unroll") for (int n = 0; n < 2; ++n) _Pragma("unroll") for (int k = 0; k < 2; ++k) \
        acc[ai][bj][m][n] = __builtin_amdgcn_mfma_f32_16x16x32_bf16(Bt[n][k], At[m][k], acc[ai][bj][m][n], 0, 0, 0); __builtin_amdgcn_s_setprio(0); } while (0)
#define PG8_WAIT_V(n) asm volatile("s_waitcnt vmcnt(" #n ")" ::: "memory")
#define PG8_WAIT_L(n) asm volatile("s_waitcnt lgkmcnt(" #n ")" ::: "memory")
#define PG8_BAR __builtin_amdgcn_s_barrier()
#define PG8_SCHED __builtin_amdgcn_sched_barrier(0)
    Unit cur, nxt; int ui = 0;
    if (!S.next(0, cur)) return;
    f32x4 acc[2][2][4][2];
#pragma unroll
    for (int a = 0; a < 2; ++a)
#pragma unroll
        for (int b = 0; b < 2; ++b)
#pragma unroll
            for (int m = 0; m < 4; ++m)
#pragma unroll
                for (int n = 0; n < 2; ++n) acc[a][b][m][n] = (f32x4){0.f, 0.f, 0.f, 0.f};
    bf16x8 At[4][2], B0[2][2], B1[2][2];
    const char* cA = (const char*)g.A + (size_t)cur.pm * tstep; const char* cB = (const char*)g.Bt + (size_t)cur.pn * tstep;
    S.a_ready(cur);
    if constexpr (SP2) {
        PG8_STAGE(PG8_SB(0, 0), cB, voffB); PG8_STAGE(PG8_SB(0, 1), cB + hstep, voffB); PG8_STAGE(PG8_SA(0, 0), cA, voffA); PG8_STAGE(PG8_SA(0, 1), cA + hstep, voffA);
        if (wr == 1) PG8_BAR;
        PG8_WAIT_V(2); PG8_BAR;
        PG8_STAGE(PG8_SB(1, 0), cB + kstep, voffB); PG8_STAGE(PG8_SA(1, 0), cA + kstep, voffA); PG8_STAGE(PG8_SB(1, 1), cB + hstep + kstep, voffB);
        PG8_WAIT_V(6); PG8_BAR;
    } else {
        PG8_STAGE(PG8_SB(0, 0), cB, voffB); PG8_STAGE(PG8_SA(0, 0), cA, voffA); PG8_STAGE(PG8_SB(0, 1), cB + hstep, voffB); PG8_STAGE(PG8_SA(0, 1), cA + hstep, voffA);
        if (wr == 1) PG8_BAR;
        PG8_WAIT_V(4); PG8_BAR;
        PG8_STAGE(PG8_SB(1, 0), cB + kstep, voffB); PG8_STAGE(PG8_SA(1, 0), cA + kstep, voffA); PG8_STAGE(PG8_SB(1, 1), cB + hstep + kstep, voffB);
        PG8_WAIT_V(6); PG8_BAR;
    }
    for (;;) {
        const bool has_next = S.next(ui + 1, nxt);
        const char* nA = has_next ? (const char*)g.A + (size_t)nxt.pm * tstep : cA; const char* nB = has_next ? (const char*)g.Bt + (size_t)nxt.pn * tstep : cB;
        for (int t = 0; t < nt; t += 2) {
            const bool last = (t == nt - 2);
            const char* a1 = cA + (size_t)(t + 1) * kstep;
            const char* a2 = last ? nA : cA + (size_t)(t + 2) * kstep; const char* b2 = last ? nB : cB + (size_t)(t + 2) * kstep;
            const char* a3 = a2 + kstep; const char* b3 = b2 + kstep;
            if (last && has_next) S.a_ready(nxt);
            if constexpr (SP2) {
            PG8_LDB(B0, 0, 0); PG8_LDB(B1, 0, 1); PG8_SCHED; PG8_LDA(At, 0, 0); PG8_STAGE(PG8_SA(1, 1), a1 + hstep, voffA);
            PG8_WAIT_V(8); PG8_WAIT_L(0); PG8_BAR; PG8_MMA(0, 0, At, B0); PG8_MMA(0, 1, At, B1); PG8_BAR; PG8_SCHED;
            PG8_LDA(At, 0, 1); PG8_STAGE(PG8_SB(0, 0), b2, voffB); PG8_STAGE(PG8_SB(0, 1), b2 + hstep, voffB); PG8_STAGE(PG8_SA(0, 0), a2, voffA);
            PG8_WAIT_V(8); PG8_WAIT_L(0); PG8_BAR; PG8_MMA(1, 0, At, B0); PG8_MMA(1, 1, At, B1); PG8_BAR; PG8_SCHED;
            PG8_LDB(B0, 1, 0); PG8_LDB(B1, 1, 1); PG8_SCHED; PG8_LDA(At, 1, 0); PG8_STAGE(PG8_SA(0, 1), a2 + hstep, voffA);
            PG8_WAIT_V(8); PG8_WAIT_L(0); PG8_BAR; PG8_MMA(0, 0, At, B0); PG8_MMA(0, 1, At, B1); PG8_BAR; PG8_SCHED;
            PG8_LDA(At, 1, 1); PG8_STAGE(PG8_SB(1, 0), b3, voffB); PG8_STAGE(PG8_SB(1, 1), b3 + hstep, voffB); PG8_STAGE(PG8_SA(1, 0), a3, voffA);
            PG8_WAIT_V(8); PG8_WAIT_L(0); PG8_BAR; PG8_MMA(1, 0, At, B0); PG8_MMA(1, 1, At, B1); PG8_BAR; PG8_SCHED;
            } else {
            PG8_LDB(B0, 0, 0); PG8_SCHED; PG8_LDA(At, 0, 0); PG8_STAGE(PG8_SA(1, 1), a1 + hstep, voffA);
            PG8_WAIT_L(8); PG8_BAR; PG8_WAIT_L(0); PG8_MMA(0, 0, At, B0); PG8_BAR; PG8_SCHED;
            PG8_LDB(B1, 0, 1); PG8_STAGE(PG8_SB(0, 0), b2, voffB);
            PG8_BAR; PG8_WAIT_L(0); PG8_MMA(0, 1, At, B1); PG8_BAR;
            PG8_LDA(At, 0, 1); PG8_STAGE(PG8_SA(0, 0), a2, voffA);
            PG8_BAR; PG8_WAIT_L(0); PG8_MMA(1, 0, At, B0); PG8_BAR; PG8_SCHED;
            PG8_STAGE(PG8_SB(0, 1), b2 + hstep, voffB);
            PG8_WAIT_V(6); PG8_BAR; PG8_MMA(1, 1, At, B1); PG8_BAR;
            PG8_LDB(B0, 1, 0); PG8_SCHED; PG8_LDA(At, 1, 0); PG8_STAGE(PG8_SA(0, 1), a2 + hstep, voffA);
            PG8_WAIT_L(8); PG8_BAR; PG8_WAIT_L(0); PG8_MMA(0, 0, At, B0); PG8_BAR; PG8_SCHED;
            PG8_LDB(B1, 1, 1); PG8_STAGE(PG8_SB(1, 0), b3, voffB);
            PG8_BAR; PG8_WAIT_L(0); PG8_MMA(0, 1, At, B1); PG8_BAR;
            PG8_LDA(At, 1, 1); PG8_STAGE(PG8_SA(1, 0), a3, voffA);
            PG8_BAR; PG8_WAIT_L(0); PG8_MMA(1, 0, At, B0); PG8_BAR; PG8_SCHED;
            PG8_STAGE(PG8_SB(1, 1), b3 + hstep, voffB);
            PG8_WAIT_V(6); PG8_BAR; PG8_MMA(1, 1, At, B1); PG8_BAR;
            }
        }
        if constexpr (ALIGN_EPI) { if (wr == 0) PG8_BAR; }
        if constexpr (!Epi::AFTER_DRAIN) { E(acc, cur, wr, wc, fr, fq); S.done(cur); }
        if (!has_next) break;
#pragma unroll
        for (int a = 0; a < 2; ++a)
#pragma unroll
            for (int b = 0; b < 2; ++b)
#pragma unroll
                for (int m = 0; m < 4; ++m)
#pragma unroll
                    for (int n = 0; n < 2; ++n) acc[a][b][m][n] = (f32x4){0.f, 0.f, 0.f, 0.f};
        cur = nxt; cA = nA; cB = nB; ++ui;
        if constexpr (ALIGN_EPI) { if (wr == 1) PG8_BAR; }
    }
    PG8_WAIT_V(0);
    if constexpr (!ALIGN_EPI) { if (wr == 0) PG8_BAR; }
    PG8_BAR;
    if constexpr (Epi::AFTER_DRAIN) { E.fused(acc, cur, wr, wc, fr, fq, lds, wid, lane); S.done(cur); }
#undef PG8_SA
#undef PG8_SB
#undef PG8_STAGE
#undef PG8_LDA
#undef PG8_LDB
#undef PG8_MMA
#undef PG8_WAIT_V
#undef PG8_WAIT_L
#undef PG8_BAR
#undef PG8_SCHED
}

template <class Epi, class Sched, bool ALIGN_EPI = false, bool SP2 = false>
__device__ __forceinline__ void gemm_phase_g(PG8_LAS unsigned char* lds, const Gemm g, const Sched& S, const Epi& E, const PG8_LAS unsigned* rowtab) {
    const int tid = threadIdx.x, wid = __builtin_amdgcn_readfirstlane(tid >> 6), lane = tid & 63, wr = wid >> 2, wc = wid & 3, fr = lane & 15, fq = lane >> 4;
    const int K = g.K, nt = K / BK;
    unsigned voffA[2], voffB[2]; int RA[2]; unsigned CA2[2];
#pragma unroll
    for (int i = 0; i < 2; ++i) { int R, C; stage_rc(tid * 16 + i * 8192, R, C); const int Rb = Epi::PERM ? ((R & ~31) + perm32(R & 31)) : R;
        voffA[i] = (unsigned)(R * K + C) * 2u; voffB[i] = (unsigned)(Rb * K + C) * 2u; RA[i] = R; CA2[i] = (unsigned)C * 2u; }
    unsigned vA0[2], vA1[2], nvA0[2], nvA1[2];
#pragma unroll
    for (int i = 0; i < 2; ++i) { vA0[i] = rowtab[RA[i]] + CA2[i]; vA1[i] = rowtab[128 + RA[i]] + CA2[i]; nvA0[i] = vA0[i]; nvA1[i] = vA1[i]; }
    const size_t kstep = (size_t)(BK * 2);
    const size_t hstep = (size_t)HALF * K * 2;
    const size_t tstep = 2 * hstep;
    const unsigned ldsw = (unsigned)wid * 1024u;
    const int aoff = lds_byte(wr * 64 + fr, fq * 8), boff = lds_byte(wc * 32 + fr, fq * 8);
#define PG8_SA(b, h) (((b) * 2 + (h)) * HTB)
#define PG8_SB(b, h) ((4 + (b) * 2 + (h)) * HTB)
#define PG8_STAGE(bufoff, gbase, voff) do { _Pragma("unroll") for (int _i = 0; _i < 2; ++_i) \
        __builtin_amdgcn_global_load_lds((const unsigned*)((const char*)(gbase) + (voff)[_i]), (PG8_LAS unsigned*)(lds + (bufoff) + ldsw + _i * 8192), 16, 0, 0); } while (0)
#define PG8_LDA(dst, b, h) do { _Pragma("unroll") for (int m = 0; m < 4; ++m) _Pragma("unroll") for (int k = 0; k < 2; ++k) dst[m][k] = *(const PG8_LAS bf16x8*)(lds + PG8_SA(b, h) + aoff + m * 2048 + k * 1024); } while (0)
#define PG8_LDB(dst, b, h) do { _Pragma("unroll") for (int n = 0; n < 2; ++n) _Pragma("unroll") for (int k = 0; k < 2; ++k) dst[n][k] = *(const PG8_LAS bf16x8*)(lds + PG8_SB(b, h) + boff + n * 2048 + k * 1024); } while (0)
#define PG8_MMA(ai, bj, At, Bt) do { __builtin_amdgcn_s_setprio(1); _Pragma("unroll") for (int m = 0; m < 4; ++m) _Pragma("unroll") for (int n = 0; n < 2; ++n) _Pragma("unroll") for (int k = 0; k < 2; ++k) \
        acc[ai][bj][m][n] = __builtin_amdgcn_mfma_f32_16x16x32_bf16(Bt[n][k], At[m][k], acc[ai][bj][m][n], 0, 0, 0); __builtin_amdgcn_s_setprio(0); } while (0)
#define PG8_WAIT_V(n) asm volatile("s_waitcnt vmcnt(" #n ")" ::: "memory")
#define PG8_WAIT_L(n) asm volatile("s_waitcnt lgkmcnt(" #n ")" ::: "memory")
#define PG8_BAR __builtin_amdgcn_s_barrier()
#define PG8_SCHED __builtin_amdgcn_sched_barrier(0)
    Unit cur, nxt; int ui = 0;
    if (!S.next(0, cur)) return;
    f32x4 acc[2][2][4][2];
#pragma unroll
    for (int a = 0; a < 2; ++a)
#pragma unroll
        for (int b = 0; b < 2; ++b)
#pragma unroll
            for (int m = 0; m < 4; ++m)
#pragma unroll
                for (int n = 0; n < 2; ++n) acc[a][b][m][n] = (f32x4){0.f, 0.f, 0.f, 0.f};
    bf16x8 At[4][2], B0[2][2], B1[2][2];
    const char* cA = (const char*)g.A; const char* cB = (const char*)g.Bt + (size_t)cur.pn * tstep;
    S.a_ready(cur);
    if constexpr (SP2) {
        PG8_STAGE(PG8_SB(0, 0), cB, voffB); PG8_STAGE(PG8_SB(0, 1), cB + hstep, voffB); PG8_STAGE(PG8_SA(0, 0), cA, vA0); PG8_STAGE(PG8_SA(0, 1), cA, vA1);
        if (wr == 1) PG8_BAR;
        PG8_WAIT_V(2); PG8_BAR;
        PG8_STAGE(PG8_SB(1, 0), cB + kstep, voffB); PG8_STAGE(PG8_SA(1, 0), cA + kstep, vA0); PG8_STAGE(PG8_SB(1, 1), cB + hstep + kstep, voffB);
        PG8_WAIT_V(6); PG8_BAR;
    } else {
        PG8_STAGE(PG8_SB(0, 0), cB, voffB); PG8_STAGE(PG8_SA(0, 0), cA, vA0); PG8_STAGE(PG8_SB(0, 1), cB + hstep, voffB); PG8_STAGE(PG8_SA(0, 1), cA, vA1);
        if (wr == 1) PG8_BAR;
        PG8_WAIT_V(4); PG8_BAR;
        PG8_STAGE(PG8_SB(1, 0), cB + kstep, voffB); PG8_STAGE(PG8_SA(1, 0), cA + kstep, vA0); PG8_STAGE(PG8_SB(1, 1), cB + hstep + kstep, voffB);
        PG8_WAIT_V(6); PG8_BAR;
    }
    for (;;) {
        const bool has_next = S.next(ui + 1, nxt);
        if (has_next) {
#pragma unroll
            for (int i = 0; i < 2; ++i) { nvA0[i] = rowtab[(ui + 1) * 256 + RA[i]] + CA2[i]; nvA1[i] = rowtab[(ui + 1) * 256 + 128 + RA[i]] + CA2[i]; }
        }
        const char* nA = cA; const char* nB = has_next ? (const char*)g.Bt + (size_t)nxt.pn * tstep : cB;
        for (int t = 0; t < nt; t += 2) {
            const bool last = (t == nt - 2);
            unsigned sA0[2], sA1[2];
#pragma unroll
            for (int i = 0; i < 2; ++i) { sA0[i] = last ? nvA0[i] : vA0[i]; sA1[i] = last ? nvA1[i] : vA1[i]; }
            const char* a1 = cA + (size_t)(t + 1) * kstep;
            const char* a2 = last ? nA : cA + (size_t)(t + 2) * kstep; const char* b2 = last ? nB : cB + (size_t)(t + 2) * kstep;
            const char* a3 = a2 + kstep; const char* b3 = b2 + kstep;
            if (last && has_next) S.a_ready(nxt);
            if constexpr (SP2) {
            PG8_LDB(B0, 0, 0); PG8_LDB(B1, 0, 1); PG8_SCHED; PG8_LDA(At, 0, 0); PG8_STAGE(PG8_SA(1, 1), a1, vA1);
            PG8_WAIT_V(8); PG8_WAIT_L(0); PG8_BAR; PG8_MMA(0, 0, At, B0); PG8_MMA(0, 1, At, B1); PG8_BAR; PG8_SCHED;
            PG8_LDA(At, 0, 1); PG8_STAGE(PG8_SB(0, 0), b2, voffB); PG8_STAGE(PG8_SB(0, 1), b2 + hstep, voffB); PG8_STAGE(PG8_SA(0, 0), a2, sA0);
            PG8_WAIT_V(8); PG8_WAIT_L(0); PG8_BAR; PG8_MMA(1, 0, At, B0); PG8_MMA(1, 1, At, B1); PG8_BAR; PG8_SCHED;
            PG8_LDB(B0, 1, 0); PG8_LDB(B1, 1, 1); PG8_SCHED; PG8_LDA(At, 1, 0); PG8_STAGE(PG8_SA(0, 1), a2, sA1);
            PG8_WAIT_V(8); PG8_WAIT_L(0); PG8_BAR; PG8_MMA(0, 0, At, B0); PG8_MMA(0, 1, At, B1); PG8_BAR; PG8_SCHED;
            PG8_LDA(At, 1, 1); PG8_STAGE(PG8_SB(1, 0), b3, voffB); PG8_STAGE(PG8_SB(1, 1), b3 + hstep, voffB); PG8_STAGE(PG8_SA(1, 0), a3, sA0);
            PG8_WAIT_V(8); PG8_WAIT_L(0); PG8_BAR; PG8_MMA(1, 0, At, B0); PG8_MMA(1, 1, At, B1); PG8_BAR; PG8_SCHED;
            } else {
            PG8_LDB(B0, 0, 0); PG8_SCHED; PG8_LDA(At, 0, 0); PG8_STAGE(PG8_SA(1, 1), a1, vA1);
            PG8_WAIT_L(8); PG8_BAR; PG8_WAIT_L(0); PG8_MMA(0, 0, At, B0); PG8_BAR; PG8_SCHED;
            PG8_LDB(B1, 0, 1); PG8_STAGE(PG8_SB(0, 0), b2, voffB);
            PG8_BAR; PG8_WAIT_L(0); PG8_MMA(0, 1, At, B1); PG8_BAR;
            PG8_LDA(At, 0, 1); PG8_STAGE(PG8_SA(0, 0), a2, sA0);
            PG8_BAR; PG8_WAIT_L(0); PG8_MMA(1, 0, At, B0); PG8_BAR; PG8_SCHED;
            PG8_STAGE(PG8_SB(0, 1), b2 + hstep, voffB);
            PG8_WAIT_V(6); PG8_BAR; PG8_MMA(1, 1, At, B1); PG8_BAR;
            PG8_LDB(B0, 1, 0); PG8_SCHED; PG8_LDA(At, 1, 0); PG8_STAGE(PG8_SA(0, 1), a2, sA1);
            PG8_WAIT_L(8); PG8_BAR; PG8_WAIT_L(0); PG8_MMA(0, 0, At, B0); PG8_BAR; PG8_SCHED;
            PG8_LDB(B1, 1, 1); PG8_STAGE(PG8_SB(1, 0), b3, voffB);
            PG8_BAR; PG8_WAIT_L(0); PG8_MMA(0, 1, At, B1); PG8_BAR;
            PG8_LDA(At, 1, 1); PG8_STAGE(PG8_SA(1, 0), a3, sA0);
            PG8_BAR; PG8_WAIT_L(0); PG8_MMA(1, 0, At, B0); PG8_BAR; PG8_SCHED;
            PG8_STAGE(PG8_SB(1, 1), b3 + hstep, voffB);
            PG8_WAIT_V(6); PG8_BAR; PG8_MMA(1, 1, At, B1); PG8_BAR;
            }
        }
        if constexpr (ALIGN_EPI) { if (wr == 0) PG8_BAR; }
        if constexpr (!Epi::AFTER_DRAIN) { E(acc, cur, wr, wc, fr, fq); S.done(cur); }
        if (!has_next) break;
#pragma unroll
        for (int a = 0; a < 2; ++a)
#pragma unroll
            for (int b = 0; b < 2; ++b)
#pragma unroll
                for (int m = 0; m < 4; ++m)
#pragma unroll
                    for (int n = 0; n < 2; ++n) acc[a][b][m][n] = (f32x4){0.f, 0.f, 0.f, 0.f};
        cur = nxt; cA = nA; cB = nB; ++ui;
#pragma unroll
        for (int i = 0; i < 2; ++i) { vA0[i] = nvA0[i]; vA1[i] = nvA1[i]; }
        if constexpr (ALIGN_EPI) { if (wr == 1) PG8_BAR; }
    }
    PG8_WAIT_V(0);
    if constexpr (!ALIGN_EPI) { if (wr == 0) PG8_BAR; }
    PG8_BAR;
    if constexpr (Epi::AFTER_DRAIN) { E.fused(acc, cur, wr, wc, fr, fq, lds, wid, lane); S.done(cur); }
#undef PG8_SA
#undef PG8_SB
#undef PG8_STAGE
#undef PG8_LDA
#undef PG8_LDB
#undef PG8_MMA
#undef PG8_WAIT_V
#undef PG8_WAIT_L
#undef PG8_BAR
#undef PG8_SCHED
}

struct EpiBf16 {
    static constexpr bool PERM = true, AFTER_DRAIN = false;
    bf16_t* O; int ldc; int npn; int skip;
    __device__ __forceinline__ void operator()(const f32x4 (&acc)[2][2][4][2], const Unit& u, int wr, int wc, int fr, int fq) const {
        const int row0 = u.pm * BM + wr * 64 + fr, col0 = (u.pn % npn) * BM + wc * 32 + 8 * fq;
#pragma unroll
        for (int ai = 0; ai < 2; ++ai)
#pragma unroll
            for (int m = 0; m < 4; ++m) { bf16_t* rowp = O + (size_t)(row0 + ai * HALF + m * 16) * ldc + col0;
#pragma unroll
                for (int bj = 0; bj < 2; ++bj) { const f32x4 v0 = acc[ai][bj][m][0], v1 = acc[ai][bj][m][1];
                    u32x4 w; w.x = cvt_pk_bf16(v0[0], v0[1]); w.y = cvt_pk_bf16(v0[2], v0[3]); w.z = cvt_pk_bf16(v1[0], v1[1]); w.w = cvt_pk_bf16(v1[2], v1[3]);
                    if (!skip) *(u32x4*)(rowp + bj * HALF) = w; else asm volatile("" :: "v"(w)); } }
    }
};
struct EpiY8 {
    static constexpr bool PERM = true, AFTER_DRAIN = false;
    unsigned char* O; int ldc; int npn;
    __device__ __forceinline__ void operator()(const f32x4 (&acc)[2][2][4][2], const Unit& u, int wr, int wc, int fr, int fq) const {
        typedef unsigned u32x2v __attribute__((ext_vector_type(2)));
        const int row0 = u.pm * BM + wr * 64 + fr, col0 = (u.pn % npn) * BM + wc * 32 + 8 * fq;
#pragma unroll
        for (int ai = 0; ai < 2; ++ai)
#pragma unroll
            for (int m = 0; m < 4; ++m) { unsigned char* rowp = O + (size_t)(row0 + ai * HALF + m * 16) * ldc + col0;
#pragma unroll
                for (int bj = 0; bj < 2; ++bj) { const f32x4 v0 = acc[ai][bj][m][0] * 16.f, v1 = acc[ai][bj][m][1] * 16.f;
                    int a = 0, b = 0;
                    a = __builtin_amdgcn_cvt_pk_fp8_f32(v0[0], v0[1], a, false); a = __builtin_amdgcn_cvt_pk_fp8_f32(v0[2], v0[3], a, true);
                    b = __builtin_amdgcn_cvt_pk_fp8_f32(v1[0], v1[1], b, false); b = __builtin_amdgcn_cvt_pk_fp8_f32(v1[2], v1[3], b, true);
                    *(u32x2v*)(rowp + bj * HALF) = (u32x2v){(unsigned)a, (unsigned)b}; } }
    }
};
struct EpiKV {
    static constexpr bool PERM = true, AFTER_DRAIN = false;
    bf16_t* kmem; bf16_t* vmemT;
    __device__ __forceinline__ void operator()(const f32x4 (&acc)[2][2][4][2], const Unit& u, int wr, int wc, int fr, int fq) const {
        const int row0 = u.pm * BM + wr * 64 + fr, col0 = u.pn * BM + wc * 32 + 8 * fq;
#pragma unroll
        for (int ai = 0; ai < 2; ++ai)
#pragma unroll
            for (int m = 0; m < 4; ++m) { const int row = row0 + ai * HALF + m * 16;
#pragma unroll
                for (int bj = 0; bj < 2; ++bj) { const f32x4 v0 = acc[ai][bj][m][0], v1 = acc[ai][bj][m][1]; const int col = col0 + bj * HALF;
                    if (col < 512) { u32x4 w; w.x = cvt_pk_bf16(v0[0], v0[1]); w.y = cvt_pk_bf16(v0[2], v0[3]); w.z = cvt_pk_bf16(v1[0], v1[1]); w.w = cvt_pk_bf16(v1[2], v1[3]);
                        *(u32x4*)(kmem + (size_t)row * 512 + col) = w; }
                    else { const int c2 = col - 512, hx = c2 >> 7, d = c2 & 127, b = row >> 8, key = row & 255;
                        bf16_t* vp = vmemT + (((size_t)b * 4 + hx) * 128 + d) * 256 + key;
                        const unsigned w0 = cvt_pk_bf16(v0[0], v0[1]), w1 = cvt_pk_bf16(v0[2], v0[3]), w2 = cvt_pk_bf16(v1[0], v1[1]), w3 = cvt_pk_bf16(v1[2], v1[3]);
                        vp[0 * 256] = (bf16_t)(w0 & 0xffffu); vp[1 * 256] = (bf16_t)(w0 >> 16); vp[2 * 256] = (bf16_t)(w1 & 0xffffu); vp[3 * 256] = (bf16_t)(w1 >> 16);
                        vp[4 * 256] = (bf16_t)(w2 & 0xffffu); vp[5 * 256] = (bf16_t)(w2 >> 16); vp[6 * 256] = (bf16_t)(w3 & 0xffffu); vp[7 * 256] = (bf16_t)(w3 >> 16); } } }
    }
};
template <bool XF32, bool STATS> struct EpiResid {
    static constexpr bool PERM = true, AFTER_DRAIN = false;
    const void* xin; bf16_t* xb; float* ssq;
    __device__ __forceinline__ void operator()(const f32x4 (&acc)[2][2][4][2], const Unit& u, int wr, int wc, int fr, int fq) const {
        const int col0 = u.pn * BM + wc * 32 + 8 * fq;
#pragma unroll
        for (int ai = 0; ai < 2; ++ai) {
            const size_t rowb = (size_t)(u.pm * BM + ai * HALF + wr * 64 + fr);
            f32x4 pf[4][2][2]; u32x4 pb[4][2];
#pragma unroll
            for (int m = 0; m < 4; ++m)
#pragma unroll
                for (int bj = 0; bj < 2; ++bj) { const size_t off = (rowb + m * 16) * 1024 + col0 + bj * HALF;
                    if (XF32) { pf[m][bj][0] = __builtin_nontemporal_load((const f32x4*)((const float*)xin + off)); pf[m][bj][1] = __builtin_nontemporal_load((const f32x4*)((const float*)xin + off + 4)); }
                    else pb[m][bj] = *(const u32x4*)((const bf16_t*)xin + off); }
#pragma unroll
            for (int m = 0; m < 4; ++m) { const size_t row = rowb + m * 16;
                float q = 0.f;
#pragma unroll
                for (int bj = 0; bj < 2; ++bj) { const size_t off = row * 1024 + col0 + bj * HALF;
                    f32x4 b0, b1;
                    if (XF32) { b0 = pf[m][bj][0]; b1 = pf[m][bj][1]; }
                    else { const u32x4 t = pb[m][bj];
                        b0[0] = __uint_as_float(t.x << 16); b0[1] = __uint_as_float(t.x & 0xffff0000u); b0[2] = __uint_as_float(t.y << 16); b0[3] = __uint_as_float(t.y & 0xffff0000u);
                        b1[0] = __uint_as_float(t.z << 16); b1[1] = __uint_as_float(t.z & 0xffff0000u); b1[2] = __uint_as_float(t.w << 16); b1[3] = __uint_as_float(t.w & 0xffff0000u); }
                    const f32x4 o0 = b0 + acc[ai][bj][m][0], o1 = b1 + acc[ai][bj][m][1];
                    u32x4 w; w.x = cvt_pk_bf16(o0[0], o0[1]); w.y = cvt_pk_bf16(o0[2], o0[3]); w.z = cvt_pk_bf16(o1[0], o1[1]); w.w = cvt_pk_bf16(o1[2], o1[3]);
                    *(u32x4*)(xb + off) = w;
                    if (STATS) q += ((o0[0] * o0[0] + o0[1] * o0[1]) + (o0[2] * o0[2] + o0[3] * o0[3])) + ((o1[0] * o1[0] + o1[1] * o1[1]) + (o1[2] * o1[2] + o1[3] * o1[3])); }
                if (STATS) { q += __shfl_xor(q, 16); q += __shfl_xor(q, 32); if (fq == 0) ssq[row * 16 + u.pn * 4 + wc] = q; } }
            asm volatile("" ::: "memory"); }
    }
};
struct EpiQ {
    static constexpr bool PERM = true, AFTER_DRAIN = false;
    bf16_t* O; const float* ssq;
    __device__ __forceinline__ void operator()(const f32x4 (&acc)[2][2][4][2], const Unit& u, int wr, int wc, int fr, int fq) const {
        const int row0 = u.pm * BM + wr * 64 + fr, col0 = u.pn * BM + wc * 32 + 8 * fq;
#pragma unroll
        for (int ai = 0; ai < 2; ++ai)
#pragma unroll
            for (int m = 0; m < 4; ++m) { const size_t row = (size_t)(row0 + ai * HALF + m * 16);
                const f32x4* sp = (const f32x4*)(ssq + row * 16); const f32x4 s0 = sp[0], s1 = sp[1], s2 = sp[2], s3 = sp[3];
                const float s = ((s0[0] + s0[1]) + (s0[2] + s0[3])) + ((s1[0] + s1[1]) + (s1[2] + s1[3])) + ((s2[0] + s2[1]) + (s2[2] + s2[3])) + ((s3[0] + s3[1]) + (s3[2] + s3[3]));
                const float rs = 1.f / sqrtf(s * (1.f / 1024.f) + 1e-5f);
                bf16_t* rowp = O + row * 512 + col0;
#pragma unroll
                for (int bj = 0; bj < 2; ++bj) { const f32x4 v0 = acc[ai][bj][m][0] * rs, v1 = acc[ai][bj][m][1] * rs;
                    u32x4 w; w.x = cvt_pk_bf16(v0[0], v0[1]); w.y = cvt_pk_bf16(v0[2], v0[3]); w.z = cvt_pk_bf16(v1[0], v1[1]); w.w = cvt_pk_bf16(v1[2], v1[3]);
                    *(u32x4*)(rowp + bj * HALF) = w; } }
    }
};
struct EpiGU {
    static constexpr bool PERM = true, AFTER_DRAIN = false;
    bf16_t* hid; const PG8_LAS float* rstab; int G, c;
    __device__ __forceinline__ void operator()(const f32x4 (&acc)[2][2][4][2], const Unit& u, int wr, int wc, int fr, int fq) const {
        const int row0 = u.pm * BM + wr * 64 + fr, j0 = (u.pn & 1) * 128 + wc * 16 + 4 * fq;
        const int ui = (u.pm * 2 + (u.pn & 1) - c) / G;
#pragma unroll
        for (int ai = 0; ai < 2; ++ai)
#pragma unroll
            for (int m = 0; m < 4; ++m) { bf16_t* rowp = hid + (size_t)(row0 + ai * HALF + m * 16) * 256 + j0;
                const float rs = rstab[ui * 256 + ai * HALF + wr * 64 + m * 16 + fr];
#pragma unroll
                for (int bj = 0; bj < 2; ++bj) { const f32x4 v0 = acc[ai][bj][m][0] * rs, v1 = acc[ai][bj][m][1] * rs;
                    const float h0 = v0[0] * __builtin_amdgcn_rcpf(1.f + __expf(-v0[0])) * v0[1], h1 = v0[2] * __builtin_amdgcn_rcpf(1.f + __expf(-v0[2])) * v0[3];
                    const float h2 = v1[0] * __builtin_amdgcn_rcpf(1.f + __expf(-v1[0])) * v1[1], h3 = v1[2] * __builtin_amdgcn_rcpf(1.f + __expf(-v1[2])) * v1[3];
                    typedef unsigned u32x2v __attribute__((ext_vector_type(2))); u32x2v w; w.x = cvt_pk_bf16(h0, h1); w.y = cvt_pk_bf16(h2, h3);
                    *(u32x2v*)(rowp + bj * 64) = w; } }
    }
};
struct SubOrder {
    int nM, nN, nwg, span, c;
    __device__ void init(int M, int N, int span_, int c_) { nM = M / BM; nN = N / BM; nwg = nM * nN; span = span_; c = c_; }
    __device__ bool next(int i, Unit& u) const { if (c < 0 || c >= span) return false; const int L = i * span + c; if (L >= nwg) return false; u.pm = L / nN; u.pn = L % nN; return true; }
    __device__ __forceinline__ void a_ready(const Unit&) const {}
    __device__ __forceinline__ void done(const Unit&) const {}
};
struct MoeOrder {
    const PG8_LAS int* tile_e; int nrt, npn, G, c;
    __device__ bool next(int i, Unit& u) const { const int L = i * G + c; if (L >= nrt * npn) return false; const int rt = L / npn, pnl = L % npn; u.pm = rt; u.pn = tile_e[rt] * npn + pnl; return true; }
    __device__ __forceinline__ void a_ready(const Unit&) const {}
    __device__ __forceinline__ void done(const Unit&) const {}
};
}

#define LAS __attribute__((address_space(3)))
#define XB_TMO      128
#define XB_XCNT(j)  (256  + 64 * (j))
#define XB_XSUB(j)  (1280 + 64 * (j))
#define XB_XGEN(j)  (2304 + 64 * (j))
#define XB_TOP      3328
#define XB_TOPGEN   3392
#define XCD_BAR_WORDS 3456
#define XB_SPIN_CAP (1u << 18)

__device__ __forceinline__ unsigned xb_ld(unsigned* p)              { return __hip_atomic_load(p, __ATOMIC_RELAXED, __HIP_MEMORY_SCOPE_AGENT); }
__device__ __forceinline__ unsigned xb_add(unsigned* p, unsigned v) { return __hip_atomic_fetch_add(p, v, __ATOMIC_RELAXED, __HIP_MEMORY_SCOPE_AGENT); }
__device__ __forceinline__ unsigned xb_xcc_id() { return (unsigned)__builtin_amdgcn_s_getreg((3 << 11) | 20) & 0xFu; }
#define XB_SPIN(cond, bar) do { unsigned _sp = 0; while (cond) { __builtin_amdgcn_s_sleep(1); \
    if ((++_sp & 255u) == 0u) { if (xb_ld(&(bar)[XB_TMO])) break; if (_sp > XB_SPIN_CAP) { atomicAdd(&(bar)[XB_TMO], 1u); break; } } } } while (0)

struct XcdBarrier {
    unsigned* bar; unsigned x;
    volatile LAS unsigned* st;
};

__device__ __forceinline__ XcdBarrier xcd_barrier_post(unsigned* bar, volatile LAS unsigned* st) {
    XcdBarrier b; b.bar = bar; b.x = xb_xcc_id(); b.st = st;
    if (threadIdx.x == 0) (void)xb_add(&bar[XB_XCNT(b.x)], 1u);
    return b;
}
__device__ __forceinline__ void xcd_barrier_complete(unsigned* bar, unsigned x, unsigned& nloc, unsigned& nx) {
    const unsigned G = gridDim.x * gridDim.y * gridDim.z;
    unsigned sum, cnt, mine, sp = 0u;
    for (;;) {
        sum = 0u; cnt = 0u; mine = 0u;
#pragma unroll
        for (unsigned j = 0; j < 16; ++j) { const unsigned c = xb_ld(&bar[XB_XCNT(j)]); sum += c; cnt += (c > 0u) ? 1u : 0u; mine = (j == x) ? c : mine; }
        if (sum == G) break;
        __builtin_amdgcn_s_sleep(1);
        if ((++sp & 255u) == 0u) { if (xb_ld(&bar[XB_TMO])) break; if (sp > XB_SPIN_CAP) { atomicAdd(&bar[XB_TMO], 1u); break; } }
    }
    nloc = mine > 0u ? mine : 1u; nx = cnt > 0u ? cnt : 1u;
}

__device__ __forceinline__ void xcd_barrier(const XcdBarrier& b) {
    asm volatile("s_waitcnt vmcnt(0)" ::: "memory");
    __syncthreads();
    if (threadIdx.x == 0) {
        unsigned* bar = b.bar;
        __builtin_amdgcn_s_waitcnt(0);
        unsigned nloc = b.st[0], nx = b.st[1];
        if (nloc == 0u) { xcd_barrier_complete(bar, b.x, nloc, nx); b.st[0] = nloc; b.st[1] = nx; }
        const unsigned old = xb_add(&bar[XB_XSUB(b.x)], 1u);
        const unsigned gen = old / nloc;
        if (old + 1u == (gen + 1u) * nloc) {
            __builtin_amdgcn_fence(__ATOMIC_RELEASE, "agent");
            asm volatile("s_waitcnt vmcnt(0)" ::: "memory");
            const unsigned og = xb_add(&bar[XB_TOP], 1u);
            const unsigned tg = og / nx;
            if (og + 1u == (tg + 1u) * nx) xb_add(&bar[XB_TOPGEN], 1u);
            else XB_SPIN(xb_ld(&bar[XB_TOPGEN]) == tg, bar);
            __builtin_amdgcn_fence(__ATOMIC_ACQUIRE, "agent");
            xb_add(&bar[XB_XGEN(b.x)], 1u);
            asm volatile("s_waitcnt vmcnt(0)" ::: "memory");
        } else {
            XB_SPIN(xb_ld(&bar[XB_XGEN(b.x)]) == gen, bar);
            __builtin_amdgcn_fence(__ATOMIC_ACQUIRE, "agent");
            asm volatile("s_waitcnt vmcnt(0)" ::: "memory");
        }
    }
    __syncthreads();
}

__device__ __forceinline__ void gemm128(unsigned char* lds, const bf16_t* arow, const bf16_t* brow, int K, f32x16& acc0, f32x16& acc1) {
    const int tid = opaque_tid(), lane = tid & 63, w = tid >> 6;
    bf16_t* sA = (bf16_t*)lds;
    bf16_t* sB = sA + 128 * 72;
    const int srow = tid >> 2, skc = (tid & 3) * 16;
    const bf16_t* ap = arow + skc;
    const bf16_t* bp = brow + skc;
    const int wm = w >> 1, wn = w & 1, r = lane & 31, h = lane >> 5;
    acc0 = zero16(); acc1 = zero16();
    for (int k0 = 0; k0 < K; k0 += 64) {
        const u32x4 a0 = *(const u32x4*)(ap + k0), a1 = *(const u32x4*)(ap + k0 + 8);
        const u32x4 b0 = *(const u32x4*)(bp + k0), b1 = *(const u32x4*)(bp + k0 + 8);
        __syncthreads();
        *(u32x4*)(sA + srow * 72 + skc) = a0; *(u32x4*)(sA + srow * 72 + skc + 8) = a1;
        *(u32x4*)(sB + srow * 72 + skc) = b0; *(u32x4*)(sB + srow * 72 + skc + 8) = b1;
        __syncthreads();
#pragma unroll
        for (int kk = 0; kk < 64; kk += 16) {
            const bf16x8 a = *(const bf16x8*)(sA + (wm * 32 + r) * 72 + kk + 8 * h);
            const bf16x8 bA = *(const bf16x8*)(sB + (wn * 64 + r) * 72 + kk + 8 * h);
            const bf16x8 bB = *(const bf16x8*)(sB + (wn * 64 + 32 + r) * 72 + kk + 8 * h);
            acc0 = mfma32(a, bA, acc0); acc1 = mfma32(a, bB, acc1);
        }
    }
    __syncthreads();
}

__device__ __forceinline__ void p0_transpose64(const float* W, int ldw, int K, int nblk, const float* scale, bf16_t* WT, int row_off, int row_mul, float* scr, int item, int lane) {
    const int kb = item / nblk, nb = item % nblk, k0 = 64 * kb, n0 = 64 * nb;
    f32x4 v[16];
    const float* wp = W + (size_t)(k0 + (lane >> 4)) * ldw + n0 + 4 * (lane & 15);
#pragma unroll
    for (int i = 0; i < 16; ++i) v[i] = __builtin_nontemporal_load((const f32x4*)(wp + (size_t)(4 * i) * ldw));
#pragma unroll
    for (int i = 0; i < 16; ++i) { const int kk = (lane >> 4) + 4 * i; const float sc = scale ? scale[k0 + kk] : 1.f; float* d = scr + kk * 65 + 4 * (lane & 15);
        d[0] = v[i].x * sc; d[1] = v[i].y * sc; d[2] = v[i].z * sc; d[3] = v[i].w * sc; }
    LDS_WAIT();
    const int c = lane & 7;
#pragma unroll
    for (int j = 0; j < 8; ++j) { const int n = (lane >> 3) + 8 * j; const float* sp = scr + (8 * c) * 65 + n;
        u32x4 o; o.x = pk2(sp[0 * 65], sp[1 * 65]); o.y = pk2(sp[2 * 65], sp[3 * 65]); o.z = pk2(sp[4 * 65], sp[5 * 65]); o.w = pk2(sp[6 * 65], sp[7 * 65]);
        *(u32x4*)(WT + (size_t)(row_off + (n0 + n) * row_mul) * K + k0 + 8 * c) = o; }
    LDS_WAIT();
}

__device__ __forceinline__ void phase0(const Params& p, unsigned char* lds) {
    const int tid = opaque_tid(), lane = tid & 63, w = tid >> 6;
    unsigned char* ws = p.ws;
    const int gw = blockIdx.x * NWAVES + w, NGW = gridDim.x * NWAVES;
    {
        bf16_t* WR = (bf16_t*)(ws + WS_WR);
        const float* w3 = p.in[19]; const float* wg = p.in[20]; const float* we = p.in[22];
        for (int i = blockIdx.x * NTHREADS + tid; i < 36 * 1024; i += gridDim.x * NTHREADS) {
            const int n = i >> 10, k = i & 1023;
            float v;
            if (n >= 32) v = wg[k * 4 + (n - 32)];
            else { const int hh = (n >> 2) & 1, ii = (n & 3) + 4 * (n >> 3), e = (2 * hh + (ii >> 3)) * 8 + (ii & 7); v = we[k * 32 + e]; }
            WR[i] = (bf16_t)f2bf(v * w3[k]);
        }
    }
    {
        float* scr = (float*)lds + w * (64 * 65);
        constexpr int I_IN = 16 * 36, I_OUT = 16 * 16, I_Q = 16 * 8, I_KV = 16 * 16, I_O = 8 * 16;
        constexpr int NITEMS = I_IN + I_OUT + I_Q + I_KV + I_O;
#pragma unroll 1
        for (int it = gw; it < NITEMS; it += NGW) {
            int r = it;
            if (r < I_IN) { p0_transpose64(p.in[4], LDWIN, 1024, 36, nullptr, (bf16_t*)(ws + WS_WIN), 0, 1, scr, r, lane); continue; } r -= I_IN;
            if (r < I_OUT) { p0_transpose64(p.in[13], 1024, 1024, 16, nullptr, (bf16_t*)(ws + WS_WOUT), 0, 1, scr, r, lane); continue; } r -= I_OUT;
            if (r < I_Q) { p0_transpose64(p.in[16], 512, 1024, 8, p.in[14], (bf16_t*)(ws + WS_WQ), 0, 1, scr, r, lane); continue; } r -= I_Q;
            if (r < I_KV) { p0_transpose64(p.in[17], 1024, 1024, 16, nullptr, (bf16_t*)(ws + WS_WKV), 0, 1, scr, r, lane); continue; } r -= I_KV;
            p0_transpose64(p.in[18], 1024, 512, 16, nullptr, (bf16_t*)(ws + WS_WO), 0, 1, scr, r, lane);
        }
    }
    __syncthreads();
    float* wdt = (float*)lds;
    {
        const float* win = p.in[4]; const float* w1 = p.in[3];
        for (int i = tid; i < 8192; i += NTHREADS) { const int k = i >> 3, n = i & 7; wdt[n * 1024 + k] = win[(size_t)k * LDWIN + 2304 + n] * w1[k]; }
    }
    __syncthreads();
    {
        const float* x = p.in[0]; const float* w1 = p.in[3];
        bf16_t* h1 = (bf16_t*)(ws + WS_H1); float* dtraw = (float*)(ws + WS_DTRAW);
        f32x4 wv[4];
#pragma unroll
        for (int j = 0; j < 4; ++j) wv[j] = *(const f32x4*)(w1 + 4 * lane + 256 * j);
        f32x4 nx[4];
        if (gw < NT) {
#pragma unroll
            for (int j = 0; j < 4; ++j) nx[j] = __builtin_nontemporal_load((const f32x4*)(x + (size_t)gw * DM) + lane + 64 * j);
        }
#pragma unroll 1
        for (int m = gw; m < NT; m += NGW) {
            f32x4 v[4];
#pragma unroll
            for (int j = 0; j < 4; ++j) v[j] = nx[j];
            if (m + NGW < NT) {
#pragma unroll
                for (int j = 0; j < 4; ++j) nx[j] = __builtin_nontemporal_load((const f32x4*)(x + (size_t)(m + NGW) * DM) + lane + 64 * j);
            }
            float a[16];
#pragma unroll
            for (int q = 0; q < 16; ++q) a[q] = 0.f;
#pragma unroll
            for (int j = 0; j < 4; ++j) a[0] += (v[j].x * v[j].x + v[j].y * v[j].y) + (v[j].z * v[j].z + v[j].w * v[j].w);
#pragma unroll
            for (int n = 0; n < 8; ++n)
#pragma unroll
                for (int j = 0; j < 4; ++j) { const f32x4 ww = *(const f32x4*)(wdt + n * 1024 + 4 * lane + 256 * j); a[1 + n] += (v[j].x * ww.x + v[j].y * ww.y) + (v[j].z * ww.z + v[j].w * ww.w); }
            float b8[8], b4[4], b2[2], b1;
            { const bool hi = (lane & 32) != 0;
#pragma unroll
              for (int q = 0; q < 8; ++q) { const float send = hi ? a[q] : a[q + 8], keep = hi ? a[q + 8] : a[q]; b8[q] = keep + __shfl_xor(send, 32); } }
            { const bool hi = (lane & 16) != 0;
#pragma unroll
              for (int q = 0; q < 4; ++q) { const float send = hi ? b8[q] : b8[q + 4], keep = hi ? b8[q + 4] : b8[q]; b4[q] = keep + __shfl_xor(send, 16); } }
            { const bool hi = (lane & 8) != 0;
#pragma unroll
              for (int q = 0; q < 2; ++q) { const float send = hi ? b4[q] : b4[q + 2], keep = hi ? b4[q + 2] : b4[q]; b2[q] = keep + __shfl_xor(send, 8); } }
            { const bool hi = (lane & 4) != 0; const float send = hi ? b2[0] : b2[1], keep = hi ? b2[1] : b2[0]; b1 = keep + __shfl_xor(send, 4); }
            b1 += __shfl_xor(b1, 2); b1 += __shfl_xor(b1, 1);
            const float rstd = 1.f / sqrtf(__shfl(b1, 0) * (1.f / DM) + EPS);
            const int slot = (lane >> 2) & 15;
            if ((lane & 3) == 0 && slot >= 1 && slot <= 8) dtraw[(size_t)m * 8 + (slot - 1)] = b1 * rstd;
            u32x2* o8 = (u32x2*)(h1 + (size_t)m * DM) + lane;
#pragma unroll
            for (int j = 0; j < 4; ++j) { u32x2 o; o.x = pk2(v[j].x * rstd * wv[j].x, v[j].y * rstd * wv[j].y); o.y = pk2(v[j].z * rstd * wv[j].z, v[j].w * rstd * wv[j].w); o8[64 * j] = o; }
        }
    }
    {
        const float* mem = p.in[1]; const float* wm = p.in[15];
        bf16_t* memh = (bf16_t*)(ws + WS_MEMH);
        f32x4 wv[4];
#pragma unroll
        for (int j = 0; j < 4; ++j) wv[j] = *(const f32x4*)(wm + 4 * lane + 256 * j);
        for (int m = gw; m < NMEM; m += NGW) {
            const f32x4* xr = (const f32x4*)(mem + (size_t)m * DM) + lane;
            f32x4 v[4]; float s = 0.f;
#pragma unroll
            for (int j = 0; j < 4; ++j) { v[j] = xr[64 * j]; s += (v[j].x * v[j].x + v[j].y * v[j].y) + (v[j].z * v[j].z + v[j].w * v[j].w); }
            const float rstd = 1.f / sqrtf(wave_sum(s) * (1.f / DM) + EPS);
            u32x2* o8 = (u32x2*)(memh + (size_t)m * DM) + lane;
#pragma unroll
            for (int j = 0; j < 4; ++j) { u32x2 o; o.x = pk2(v[j].x * rstd * wv[j].x, v[j].y * rstd * wv[j].y); o.y = pk2(v[j].z * rstd * wv[j].z, v[j].w * rstd * wv[j].w); o8[64 * j] = o; }
        }
    }
    __syncthreads();
}

__device__ __forceinline__ void expert_transposes(const Params& p, unsigned char* lds, int vw, int nvw) {
    const int lane = opaque_tid() & 63, w = (opaque_tid() >> 6);
    unsigned char* ws = p.ws;
    float* scr = (float*)lds + w * (64 * 65);
    constexpr int I_G = 32 * 16 * 4, I_D = 32 * 4 * 16;
#pragma unroll 1
    for (int it = vw; it < 2 * I_G + I_D; it += nvw) {
        int r = it;
        if (r < I_G) { const int e = r / 64, ri = r % 64; p0_transpose64(p.in[24] + (size_t)e * 1024 * 256, 256, 1024, 4, p.in[19], (bf16_t*)(ws + WS_WGU) + (size_t)e * 512 * 1024, 0, 2, scr, ri, lane); continue; } r -= I_G;
        if (r < I_G) { const int e = r / 64, ri = r % 64; p0_transpose64(p.in[25] + (size_t)e * 1024 * 256, 256, 1024, 4, p.in[19], (bf16_t*)(ws + WS_WGU) + (size_t)e * 512 * 1024, 1, 2, scr, ri, lane); continue; } r -= I_G;
        { const int e = r / 64, ri = r % 64; p0_transpose64(p.in[26] + (size_t)e * 256 * 1024, 1024, 256, 16, nullptr, (bf16_t*)(ws + WS_WD) + (size_t)e * 1024 * 256, 0, 1, scr, ri, lane); }
    }
}

#define LDS3(p) ((__attribute__((address_space(3))) unsigned char*)(p))
__device__ __forceinline__ void phase1(const Params& p, unsigned char* lds) {
    unsigned char* ws = p.ws;
    {
        const int w = opaque_tid() >> 6;
        if (gridDim.x == 256) { if (blockIdx.x >= 160) expert_transposes(p, lds, ((int)blockIdx.x - 160) * NWAVES + w, 96 * NWAVES); }
        else expert_transposes(p, lds, (int)blockIdx.x * NWAVES + w, (int)gridDim.x * NWAVES);
        __syncthreads();
    }
    {
        pg8::Gemm g{(const bf16_t*)(ws + WS_H1), (const bf16_t*)(ws + WS_WIN), NT, NPROJ, DM};
        pg8::StaticOrder S; S.init(NT, NPROJ, (int)gridDim.x, (int)blockIdx.x);
        pg8::EpiBf16 E{(bf16_t*)(ws + WS_PROJ), NPROJ, NPROJ / 256, p.pad & 1};
        pg8::gemm_phase<pg8::EpiBf16, pg8::StaticOrder, true, true>(LDS3(lds), g, S, E);
    }
    {
        pg8::Gemm g{(const bf16_t*)(ws + WS_MEMH), (const bf16_t*)(ws + WS_WKV), NMEM, 1024, DM};
        pg8::SubOrder S; S.init(NMEM, 1024, 128, (int)blockIdx.x - 128);
        pg8::EpiKV E{(bf16_t*)(ws + WS_KMEM), (bf16_t*)(ws + WS_VMEMT)};
        pg8::gemm_phase<pg8::EpiKV, pg8::SubOrder, true, true>(LDS3(lds), g, S, E);
    }
}

__device__ __forceinline__ float bfel(const u32x4& v, int ci) { const unsigned wv = (ci >> 1) == 0 ? v.x : (ci >> 1) == 1 ? v.y : (ci >> 1) == 2 ? v.z : v.w; return (ci & 1) ? bfhi(wv) : bflo(wv); }
__device__ __forceinline__ void conv8_load(const Params& p, int b, int c, int l0, int ch0, u32x4 (&in)[11]) {
    const bf16_t* proj = (const bf16_t*)(p.ws + WS_PROJ);
    const int t0 = c * 128 + l0 - 3;
    const bf16_t* rp = proj + ((long)(b * SEQ) + t0) * NPROJ + C_X + ch0;
    asm volatile("" : "+v"(rp));
#pragma unroll
    for (int i = 0; i < 11; ++i) {
        const int t = t0 + i;
        in[i] = (u32x4){0u, 0u, 0u, 0u};
        if (t >= 0) in[i] = *(const u32x4*)(rp + (size_t)i * NPROJ);
    }
}
template <bool TRANS>
__device__ __forceinline__ void conv8_math(const Params& p, int ch0, const u32x4 (&in)[11], const float (&f)[8], u32x4 (&res)[8]) {
    const float* cw = p.in[6]; const float* cb = p.in[7];
    float wgt[4][8], bias[8];
#pragma unroll
    for (int j = 0; j < 4; ++j) { const f32x4 a = *(const f32x4*)(cw + j * 1024 + ch0), b2 = *(const f32x4*)(cw + j * 1024 + ch0 + 4);
        wgt[j][0] = a.x; wgt[j][1] = a.y; wgt[j][2] = a.z; wgt[j][3] = a.w; wgt[j][4] = b2.x; wgt[j][5] = b2.y; wgt[j][6] = b2.z; wgt[j][7] = b2.w; }
    { const f32x4 a = *(const f32x4*)(cb + ch0), b2 = *(const f32x4*)(cb + ch0 + 4); bias[0] = a.x; bias[1] = a.y; bias[2] = a.z; bias[3] = a.w; bias[4] = b2.x; bias[5] = b2.y; bias[6] = b2.z; bias[7] = b2.w; }
    if (TRANS) {
#pragma unroll
        for (int ci = 0; ci < 8; ++ci) {
            float o[8];
#pragma unroll
            for (int li = 0; li < 8; ++li) { float a = bias[ci];
#pragma unroll
                for (int j = 0; j < 4; ++j) a += wgt[j][ci] * bfel(in[li + j], ci);
                o[li] = siluf(a) * f[li]; }
            res[ci] = (u32x4){pk2(o[0], o[1]), pk2(o[2], o[3]), pk2(o[4], o[5]), pk2(o[6], o[7])};
        }
    } else {
#pragma unroll
        for (int li = 0; li < 8; ++li) {
            float o[8];
#pragma unroll
            for (int ci = 0; ci < 8; ++ci) { float a = bias[ci];
#pragma unroll
                for (int j = 0; j < 4; ++j) a += wgt[j][ci] * bfel(in[li + j], ci);
                o[ci] = siluf(a) * f[li]; }
            res[li] = (u32x4){pk2(o[0], o[1]), pk2(o[2], o[3]), pk2(o[4], o[5]), pk2(o[6], o[7])};
        }
    }
}
template <bool TRANS>
__device__ __forceinline__ void conv8x8(const Params& p, int b, int c, int l0, int ch0, const float (&f)[8], u32x4 (&res)[8]) {
    u32x4 in[11];
    conv8_load(p, b, c, l0, ch0, in);
    conv8_math<TRANS>(p, ch0, in, f, res);
}

__device__ __forceinline__ void conv2_load(const Params& p, int b, int c, int l0, int ch0, unsigned (&in)[11]) {
    const bf16_t* proj = (const bf16_t*)(p.ws + WS_PROJ);
    const int t0 = c * 128 + l0 - 3;
    const bf16_t* rp = proj + ((long)(b * SEQ) + t0) * NPROJ + C_X + ch0;
    asm volatile("" : "+v"(rp));
#pragma unroll
    for (int i = 0; i < 11; ++i) { const int t = t0 + i; in[i] = 0u; if (t >= 0) in[i] = *(const unsigned*)(rp + (size_t)i * NPROJ); }
}
__device__ __forceinline__ void conv2_math(const Params& p, int ch0, const unsigned (&in)[11], u32x4 (&res)[2]) {
    const float* cw = p.in[6]; const float* cb = p.in[7];
    float wgt[4][2], bias[2];
#pragma unroll
    for (int j = 0; j < 4; ++j) { wgt[j][0] = cw[j * 1024 + ch0]; wgt[j][1] = cw[j * 1024 + ch0 + 1]; }
    bias[0] = cb[ch0]; bias[1] = cb[ch0 + 1];
#pragma unroll
    for (int ci = 0; ci < 2; ++ci) {
        float o[8];
#pragma unroll
        for (int li = 0; li < 8; ++li) { float a = bias[ci];
#pragma unroll
            for (int j = 0; j < 4; ++j) a += wgt[j][ci] * (ci ? bfhi(in[li + j]) : bflo(in[li + j]));
            o[li] = siluf(a); }
        res[ci] = (u32x4){pk2(o[0], o[1]), pk2(o[2], o[3]), pk2(o[4], o[5]), pk2(o[6], o[7])};
    }
}

__device__ __forceinline__ void ssd_dt_cum(const Params& p, int b, int c, float* dts, float* cums) {
    const int tid = opaque_tid(), lane = tid & 63, w = tid >> 6;
    const float* dtraw = (const float*)(p.ws + WS_DTRAW);
    const float bias = p.in[8][w], a = -__expf(p.in[9][w]);
    const size_t row0 = (size_t)b * SEQ + c * 128;
    float x0 = dtraw[(row0 + 2 * lane) * 8 + w] + bias, x1 = dtraw[(row0 + 2 * lane + 1) * 8 + w] + bias;
    const float d0 = fmaxf(x0, 0.f) + log1pf(__expf(-fabsf(x0))), d1 = fmaxf(x1, 0.f) + log1pf(__expf(-fabsf(x1)));
    const float a0 = d0 * a, a1 = d1 * a;
    float s = a0 + a1;
#pragma unroll
    for (int o = 1; o < 64; o <<= 1) { const float t = __shfl_up(s, o); if (lane >= o) s += t; }
    dts[w * 128 + 2 * lane] = d0; dts[w * 128 + 2 * lane + 1] = d1;
    cums[w * 128 + 2 * lane] = s - a1; cums[w * 128 + 2 * lane + 1] = s;
}

__device__ __forceinline__ void attn_unit(const Params& p, const bf16_t* sK, const bf16_t* sV, const float* cs, const float* sn, float* ssq, int b, int blk, int hq, int rg, int lane, u32x2 (&oh)[8]) {
    const int r = lane & 31, h = lane >> 5;
    const bf16_t* proj = (const bf16_t*)(p.ws + WS_PROJ);
    const int tband0 = blk * 128 - 128;
    const bf16_t* qp = proj + (size_t)(b * SEQ + blk * 128 + rg * 32 + r) * NPROJ + hq * 64 + 8 * h;
    u32x4 qv[4];
#pragma unroll
    for (int kk = 0; kk < 4; ++kk) qv[kk] = *(const u32x4*)(qp + kk * 16);
    {
        u32x4 ot; ot.x = __shfl_xor(qv[0].x, 32); ot.y = __shfl_xor(qv[0].y, 32); ot.z = __shfl_xor(qv[0].z, 32); ot.w = __shfl_xor(qv[0].w, 32);
        const float* cp = cs + (128 + rg * 32 + r) * 8; const float* sp = sn + (128 + rg * 32 + r) * 8;
        float o[8];
#pragma unroll
        for (int f = 0; f < 8; ++f) {
            const float mine = bfel(qv[0], f), oth = bfel(ot, f), c = cp[f], sv = sp[f];
            o[f] = h ? (mine * c + oth * sv) : (mine * c - oth * sv);
        }
        qv[0] = (u32x4){pk2(o[0], o[1]), pk2(o[2], o[3]), pk2(o[4], o[5]), pk2(o[6], o[7])};
    }
    f32x16 S[5];
#pragma unroll
    for (int jt = 0; jt < 5; ++jt) S[jt] = zero16();
    const bf16_t* kp = sK + (rg * 32 + r) * 72 + 8 * h;
#pragma unroll
    for (int kk = 0; kk < 4; ++kk) {
        const bf16x8 qf = __builtin_bit_cast(bf16x8, qv[kk]);
#pragma unroll
        for (int jt = 0; jt < 5; ++jt) { const bf16x8 a = *(const bf16x8*)(kp + jt * (32 * 72) + kk * 16); S[jt] = mfma32(a, qf, S[jt]); }
    }
    const float sink = p.in[5][hq] * 8.f;
    float m = sink;
    const bool noprev = (blk == 0);
#pragma unroll
    for (int jt = 0; jt < 5; ++jt)
#pragma unroll
        for (int i = 0; i < 16; ++i) {
            const int cr = (i & 3) + 8 * (i >> 2) + 4 * h;
            bool ok = true;
            if (jt == 0) ok = cr > r;
            if (jt == 4) ok = cr <= r;
            if (noprev && (rg + jt) < 4) ok = false;
            const float v = ok ? S[jt][i] : -INFINITY; S[jt][i] = v; m = fmaxf(m, v);
        }
    m = fmaxf(m, __shfl_xor(m, 32));
    const float sc = 0.125f * 1.4426950408889634f;
    float sum = 0.f;
    bf16x8 P[10];
#pragma unroll
    for (int jt = 0; jt < 5; ++jt) {
        float e[16];
#pragma unroll
        for (int i = 0; i < 16; ++i) { e[i] = __builtin_amdgcn_exp2f((S[jt][i] - m) * sc); sum += e[i]; }
        P[2 * jt] = pack8(e[0], e[1], e[2], e[3], e[4], e[5], e[6], e[7]);
        P[2 * jt + 1] = pack8(e[8], e[9], e[10], e[11], e[12], e[13], e[14], e[15]);
    }
    sum += __shfl_xor(sum, 32);
    sum += __builtin_amdgcn_exp2f((sink - m) * sc);
    const float inv = 1.f / sum;
    f32x16 O0 = zero16(), O1 = zero16();
    const bf16_t* vp0 = sV + r * 260 + rg * 32 + 4 * h;
#pragma unroll
    for (int ts = 0; ts < 10; ++ts) {
        const bf16_t* vp = vp0 + 16 * ts;
        const u32x2 lo0 = *(const u32x2*)vp, hi0 = *(const u32x2*)(vp + 8);
        const u32x2 lo1 = *(const u32x2*)(vp + 32 * 260), hi1 = *(const u32x2*)(vp + 32 * 260 + 8);
        O0 = mfma32(__builtin_bit_cast(bf16x8, (u32x4){lo0.x, lo0.y, hi0.x, hi0.y}), P[ts], O0);
        O1 = mfma32(__builtin_bit_cast(bf16x8, (u32x4){lo1.x, lo1.y, hi1.x, hi1.y}), P[ts], O1);
    }
    float q = 0.f;
#pragma unroll
    for (int g = 0; g < 4; ++g) {
        const unsigned a0 = pk2(O0[4 * g] * inv, O0[4 * g + 1] * inv), a1 = pk2(O0[4 * g + 2] * inv, O0[4 * g + 3] * inv);
        const unsigned b0 = pk2(O1[4 * g] * inv, O1[4 * g + 1] * inv), b1 = pk2(O1[4 * g + 2] * inv, O1[4 * g + 3] * inv);
        oh[g] = (u32x2){a0, a1}; oh[4 + g] = (u32x2){b0, b1};
        q += (bflo(a0) * bflo(a0) + bfhi(a0) * bfhi(a0)) + (bflo(a1) * bflo(a1) + bfhi(a1) * bfhi(a1)) + (bflo(b0) * bflo(b0) + bfhi(b0) * bfhi(b0)) + (bflo(b1) * bflo(b1) + bfhi(b1) * bfhi(b1));
    }
    q += __shfl_xor(q, 32);
    if (h == 0) ssq[(rg * 32 + r) * 8 + hq] = q;
}

__device__ __forceinline__ void phase2_attn(const Params& p, unsigned char* lds, int b, int blk) {
    const int tid = opaque_tid(), lane = tid & 63, w = tid >> 6, r = lane & 31, h = lane >> 5;
    const bf16_t* proj = (const bf16_t*)(p.ws + WS_PROJ);
    const int* positions = (const int*)p.in[2];
    float* cs = (float*)lds;
    float* sn = cs + 2048;
    float* ssq = sn + 2048;
    bf16_t* sK = (bf16_t*)(lds + 20480);
    bf16_t* sV = sK + 256 * 72;
    const int tband0 = blk * 128 - 128;
    for (int i = tid; i < 2048; i += NTHREADS) {
        const int kb = i >> 3, f = i & 7, t = tband0 + kb;
        float c = 1.f, sv = 0.f;
        if (t >= 0) { const float ang = (float)positions[b * SEQ + t] * p.inv_freq[f]; const double rev = (double)ang * 0.15915494309189535; const float fr = (float)(rev - floor(rev));
            c = __builtin_amdgcn_cosf(fr); sv = __builtin_amdgcn_sinf(fr); }
        cs[i] = c; sn[i] = sv;
    }
    u32x2 oh[4][8];
#pragma unroll
    for (int g = 0; g < 2; ++g) {
        __syncthreads();
        {
            const int key = tid >> 1, half = tid & 1, t = tband0 + key;
            u32x4 kv[4];
#pragma unroll
            for (int q = 0; q < 4; ++q) kv[q] = (u32x4){0u, 0u, 0u, 0u};
            if (t >= 0) { const bf16_t* kp = proj + (size_t)(b * SEQ + t) * NPROJ + C_K + g * 64 + half * 32;
#pragma unroll
                for (int q = 0; q < 4; ++q) kv[q] = *(const u32x4*)(kp + 8 * q); }
            if (half == 0) {
                float o1[8], o2[8];
#pragma unroll
                for (int f = 0; f < 8; ++f) { const float x1 = bfel(kv[0], f), x2 = bfel(kv[1], f), c = cs[key * 8 + f], sv = sn[key * 8 + f]; o1[f] = x1 * c - x2 * sv; o2[f] = x2 * c + x1 * sv; }
                kv[0] = (u32x4){pk2(o1[0], o1[1]), pk2(o1[2], o1[3]), pk2(o1[4], o1[5]), pk2(o1[6], o1[7])};
                kv[1] = (u32x4){pk2(o2[0], o2[1]), pk2(o2[2], o2[3]), pk2(o2[4], o2[5]), pk2(o2[6], o2[7])};
            }
#pragma unroll
            for (int q = 0; q < 4; ++q) *(u32x4*)(sK + key * 72 + half * 32 + 8 * q) = kv[q];
        }
        {
            const int kg = tid >> 3, dc = tid & 7;
            u32x4 v[4];
#pragma unroll
            for (int i = 0; i < 4; ++i) { const int t = tband0 + 4 * kg + i; v[i] = (u32x4){0u, 0u, 0u, 0u};
                if (t >= 0) v[i] = *(const u32x4*)(proj + (size_t)(b * SEQ + t) * NPROJ + C_V + g * 64 + dc * 8); }
            bf16_t* vd = sV + (dc * 8) * 260 + 4 * kg;
#define VT_ROW(j, W) { const unsigned e0 = ((j) & 1) ? (v[0].W >> 16) : (v[0].W & 0xffffu), e1 = ((j) & 1) ? (v[1].W >> 16) : (v[1].W & 0xffffu), e2 = ((j) & 1) ? (v[2].W >> 16) : (v[2].W & 0xffffu), e3 = ((j) & 1) ? (v[3].W >> 16) : (v[3].W & 0xffffu); \
                *(u32x2*)(vd + (j) * 260) = (u32x2){e0 | (e1 << 16), e2 | (e3 << 16)}; }
            VT_ROW(0, x) VT_ROW(1, x) VT_ROW(2, y) VT_ROW(3, y) VT_ROW(4, z) VT_ROW(5, z) VT_ROW(6, w) VT_ROW(7, w)
#undef VT_ROW
        }
        __syncthreads();
#pragma unroll
        for (int uu = 0; uu < 2; ++uu) {
            const int u = w + 8 * uu;
            attn_unit(p, sK, sV, cs, sn, ssq, b, blk, g * 4 + (u >> 2), u & 3, lane, oh[g * 2 + uu]);
            __builtin_amdgcn_sched_barrier(0);
        }
    }
    __syncthreads();
    {
        bf16_t* A2 = (bf16_t*)(p.ws + WS_A2);
        const float* wa = p.in[11];
#pragma unroll
        for (int k = 0; k < 4; ++k) {
            const int u = w + 8 * (k & 1), hq = (k >> 1) * 4 + (u >> 2), rg = u & 3, ql = rg * 32 + r;
            const f32x4 s0 = *(const f32x4*)(ssq + ql * 8), s1 = *(const f32x4*)(ssq + ql * 8 + 4);
            const float rstd = 1.f / sqrtf((((s0.x + s0.y) + (s0.z + s0.w)) + ((s1.x + s1.y) + (s1.z + s1.w))) * (1.f / 512.f) + EPS);
            bf16_t* op = A2 + (size_t)(b * SEQ + blk * 128 + ql) * 1024 + hq * 64 + 4 * h;
#pragma unroll
            for (int j = 0; j < 8; ++j) {
                const int d0 = 32 * (j >> 2) + 8 * (j & 3);
                const f32x4 wv = *(const f32x4*)(wa + hq * 64 + d0 + 4 * h);
                const u32x2 t = oh[k][j];
                u32x2 o; o.x = pk2(bflo(t.x) * rstd * wv.x, bfhi(t.x) * rstd * wv.y); o.y = pk2(bflo(t.y) * rstd * wv.z, bfhi(t.y) * rstd * wv.w);
                *(u32x2*)(op + d0) = o;
            }
        }
    }
    __syncthreads();
}

__device__ __forceinline__ void phase2_states(const Params& p, unsigned char* lds, int b, int c) {
    const int tid = opaque_tid(), lane = tid & 63, w = tid >> 6, r = lane & 31, h = lane >> 5;
    float* dts = (float*)lds;
    float* cums = dts + 1024;
    bf16_t* sBT = (bf16_t*)(lds + 8192);
    bf16_t* sXT = sBT + 128 * 136;
    ssd_dt_cum(p, b, c, dts, cums);
    __syncthreads();
    bf16_t* states = (bf16_t*)(p.ws + WS_START);
    if (tid < 8) ((float*)(p.ws + WS_CDEC))[(b * NCH + c) * 8 + tid] = __expf(cums[tid * 128 + 127]);
#pragma unroll 1
    for (int g = 0; g < 2; ++g) {
        if (tid < 256) {
            const int cg8 = tid & 15, lr = tid >> 4;
            const float one[8] = {1.f, 1.f, 1.f, 1.f, 1.f, 1.f, 1.f, 1.f};
            u32x4 res[8];
            conv8x8<true>(p, b, c, lr * 8, 512 + g * 128 + cg8 * 8, one, res);
#pragma unroll
            for (int ci = 0; ci < 8; ++ci) *(u32x4*)(sBT + (cg8 * 8 + ci) * 136 + lr * 8) = res[ci];
        }
        {
            const int cg8 = tid & 31, lr = tid >> 5, hh = cg8 >> 3, hd = g * 4 + hh;
            float f[8];
            const float cl = cums[hd * 128 + 127];
#pragma unroll
            for (int li = 0; li < 8; ++li) f[li] = dts[hd * 128 + lr * 8 + li] * __expf(cl - cums[hd * 128 + lr * 8 + li]);
            u32x4 res[8];
            conv8x8<true>(p, b, c, lr * 8, g * 256 + cg8 * 8, f, res);
#pragma unroll
            for (int ci = 0; ci < 8; ++ci) *(u32x4*)(sXT + (cg8 * 8 + ci) * 136 + lr * 8) = res[ci];
        }
        __syncthreads();
        {
            f32x16 acc[4];
#pragma unroll
            for (int j = 0; j < 4; ++j) acc[j] = zero16();
#pragma unroll
            for (int kk = 0; kk < 128; kk += 16) {
                const bf16x8 a = *(const bf16x8*)(sXT + (w * 32 + r) * 136 + kk + 8 * h);
#pragma unroll
                for (int j = 0; j < 4; ++j) { const bf16x8 bb = *(const bf16x8*)(sBT + (j * 32 + r) * 136 + kk + 8 * h); acc[j] = mfma32(a, bb, acc[j]); }
            }
            const int hd = g * 4 + (w >> 1), p0 = (w & 1) * 32;
            bf16_t* sp = states + ((size_t)((b * NCH + c) * 8 + hd) * 64) * 128;
#pragma unroll
            for (int j = 0; j < 4; ++j)
#pragma unroll
                for (int i = 0; i < 16; ++i) sp[(size_t)(p0 + crow(i, h)) * 128 + j * 32 + r] = (bf16_t)f2bf(acc[j][i]);
        }
        __syncthreads();
    }
}

__device__ __forceinline__ void phase3(const Params& p) {
    const float* cdec = (const float*)(p.ws + WS_CDEC);
    bf16_t* start = (bf16_t*)(p.ws + WS_START);
    const int tid3 = opaque_tid();
#pragma unroll 1
    for (int u = blockIdx.x * NTHREADS + tid3; u < 131072; u += gridDim.x * NTHREADS) {
        const int n4 = u & 31, pp = (u >> 5) & 63, hd = (u >> 11) & 7, b = u >> 14;
        bf16_t* base = start + ((size_t)((b * NCH) * 8 + hd) * 64 + pp) * 128 + n4 * 4;
        constexpr size_t CSTRIDE = (size_t)8 * 64 * 128;
        f32x4 s = (f32x4){0.f, 0.f, 0.f, 0.f};
#pragma unroll 1
        for (int c0 = 0; c0 < NCH; c0 += 16) {
            bf16_t* bp = base + c0 * CSTRIDE; const float* dp = cdec + (b * NCH + c0) * 8 + hd;
            asm volatile("" : "+v"(bp));
            u32x2 t[16]; float d[16];
#pragma unroll
            for (int c = 0; c < 16; ++c) { t[c] = *(const u32x2*)(bp + c * CSTRIDE); d[c] = dp[c * 8]; }
#pragma unroll
            for (int c = 0; c < 16; ++c) {
                u32x2 o; o.x = pk2(s.x, s.y); o.y = pk2(s.z, s.w);
                *(u32x2*)(bp + c * CSTRIDE) = o;
                const f32x4 st = (f32x4){bflo(t[c].x), bfhi(t[c].x), bflo(t[c].y), bfhi(t[c].y)};
                s = s * d[c] + st;
            }
        }
    }
}

__device__ __forceinline__ void phase4(const Params& p, unsigned char* lds, int b, int c) {
    const int tid = opaque_tid(), lane = tid & 63, w = tid >> 6, r = lane & 31, h = lane >> 5;
    float* dts = (float*)lds;
    float* cums = dts + 1024;
    float* gsq = cums + 1024;
    bf16_t* sC = (bf16_t*)(lds + 12288);
    bf16_t* sB = sC + 128 * 136;
    bf16_t* sM = sB + 128 * 136;
    bf16_t* sXT = sM + 128 * 136;
    const bf16_t* proj = (const bf16_t*)(p.ws + WS_PROJ);
    const bf16_t* start = (const bf16_t*)(p.ws + WS_START);
    bf16_t* A2 = (bf16_t*)(p.ws + WS_A2);
    ssd_dt_cum(p, b, c, dts, cums);
    __syncthreads();
    const size_t row0 = (size_t)b * SEQ + c * 128;
#pragma unroll 1
    for (int g = 0; g < 2; ++g) {
        {
            const int which = tid >> 8, cg8 = tid & 15, lr = (tid >> 4) & 15;
            const float one[8] = {1.f, 1.f, 1.f, 1.f, 1.f, 1.f, 1.f, 1.f};
            u32x4 res[8];
            conv8x8<false>(p, b, c, lr * 8, (which ? 768 : 512) + g * 128 + cg8 * 8, one, res);
            bf16_t* dst = which ? sC : sB;
#pragma unroll
            for (int li = 0; li < 8; ++li) *(u32x4*)(dst + (lr * 8 + li) * 136 + cg8 * 8) = res[li];
        }
        __syncthreads();
        f32x16 cb0 = zero16(), cb1 = zero16();
        const int lt = w >> 1, st0 = 2 * (w & 1);
#pragma unroll 2
        for (int kk = 0; kk < 128; kk += 16) {
            const bf16x8 a = *(const bf16x8*)(sC + (lt * 32 + r) * 136 + kk + 8 * h);
            const bf16x8 b0 = *(const bf16x8*)(sB + (st0 * 32 + r) * 136 + kk + 8 * h);
            const bf16x8 b1 = *(const bf16x8*)(sB + ((st0 + 1) * 32 + r) * 136 + kk + 8 * h);
            cb0 = mfma32(a, b0, cb0); cb1 = mfma32(a, b1, cb1);
        }
        __syncthreads();
        bf16_t* sS = sB;
        const int lt2 = w >> 1, pt = w & 1;
        const int lme = lt2 * 32 + r;
        const int cp = tid & 31, lr = tid >> 5;
        u32x4 stv[2]; unsigned xin[11]; u32x2 zrn[4];
#define P4_PREFETCH(HD) { const bf16_t* stb_ = start + ((size_t)((b * NCH + c) * 8 + (HD)) * 64) * 128; \
            _Pragma("unroll") for (int i_ = 0; i_ < 2; ++i_) { const int id_ = tid + 512 * i_; stv[i_] = *(const u32x4*)(stb_ + (id_ >> 4) * 128 + (id_ & 15) * 8); } \
            conv2_load(p, b, c, lr * 8, (HD) * 64 + cp * 2, xin); \
            const bf16_t* zp_ = proj + (row0 + lme) * NPROJ + C_Z + (HD) * 64 + 32 * pt + 4 * h; \
            _Pragma("unroll") for (int g4_ = 0; g4_ < 4; ++g4_) zrn[g4_] = *(const u32x2*)(zp_ + 8 * g4_); }
        P4_PREFETCH(g * 4);
        u32x2 yh[4][4];
#pragma unroll
        for (int hh = 0; hh < 4; ++hh) {
            const int hd = g * 4 + hh;
            u32x2 zr[4];
#pragma unroll
            for (int g4 = 0; g4 < 4; ++g4) zr[g4] = zrn[g4];
#pragma unroll
            for (int q = 0; q < 2; ++q) {
                const int st = st0 + q;
                if (st <= lt) {
                    const int sme = st * 32 + r; const float cs_ = cums[hd * 128 + sme], ds_ = dts[hd * 128 + sme];
#pragma unroll
                    for (int i = 0; i < 16; ++i) {
                        const int l = lt * 32 + crow(i, h);
                        const float cbv = q ? cb1[i] : cb0[i];
                        const float v = (sme <= l) ? cbv * __expf(cums[hd * 128 + l] - cs_) * ds_ : 0.f;
                        sM[l * 136 + sme] = (bf16_t)f2bf(v);
                    }
                }
            }
            {
                u32x4 res[2];
                conv2_math(p, hd * 64 + cp * 2, xin, res);
                *(u32x4*)(sXT + (cp * 2) * 136 + lr * 8) = res[0];
                *(u32x4*)(sXT + (cp * 2 + 1) * 136 + lr * 8) = res[1];
            }
#pragma unroll
            for (int i = 0; i < 2; ++i) { const int id = tid + 512 * i; *(u32x4*)(sS + (id >> 4) * 136 + (id & 15) * 8) = stv[i]; }
            __syncthreads();
            if (hh < 3) P4_PREFETCH(hd + 1);
            {
                f32x16 yd = zero16(), yo = zero16();
                const int kend = 32 * (lt2 + 1);
#pragma unroll 2
                for (int kk = 0; kk < kend; kk += 16) {
                    const bf16x8 a = *(const bf16x8*)(sXT + (pt * 32 + r) * 136 + kk + 8 * h);
                    const bf16x8 bb = *(const bf16x8*)(sM + (lt2 * 32 + r) * 136 + kk + 8 * h);
                    yd = mfma32(a, bb, yd);
                }
#pragma unroll 2
                for (int kk = 0; kk < 128; kk += 16) {
                    const bf16x8 a = *(const bf16x8*)(sS + (pt * 32 + r) * 136 + kk + 8 * h);
                    const bf16x8 bb = *(const bf16x8*)(sC + (lt2 * 32 + r) * 136 + kk + 8 * h);
                    yo = mfma32(a, bb, yo);
                }
                const float dsk = p.in[10][hd];
                const float el = __expf(cums[hd * 128 + lme]);
                float q = 0.f;
#pragma unroll
                for (int g4 = 0; g4 < 4; ++g4) {
                    float gv[4];
#pragma unroll
                    for (int e = 0; e < 4; ++e) {
                        const int i = 4 * g4 + e, pl = 32 * pt + 8 * g4 + 4 * h + e;
                        const float xs = bf2f((unsigned)sXT[pl * 136 + lme]);
                        const float y = yd[i] + el * yo[i] + dsk * xs;
                        const unsigned zw = (e >> 1) ? zr[g4].y : zr[g4].x;
                        const float z = (e & 1) ? bfhi(zw) : bflo(zw);
                        gv[e] = y * siluf(z);
                    }
                    const unsigned w0 = pk2(gv[0], gv[1]), w1 = pk2(gv[2], gv[3]);
                    yh[hh][g4] = (u32x2){w0, w1};
                    q += (bflo(w0) * bflo(w0) + bfhi(w0) * bfhi(w0)) + (bflo(w1) * bflo(w1) + bfhi(w1) * bfhi(w1));
                }
                q += __shfl_xor(q, 32);
                if (h == 0) gsq[lme * 8 + hh * 2 + pt] = q;
            }
            __syncthreads();
        }
#undef P4_PREFETCH
        {
            const float* wsn = p.in[12];
            float sq = 0.f;
#pragma unroll
            for (int q = 0; q < 8; ++q) sq += gsq[lme * 8 + q];
            const float rstd = 1.f / sqrtf(sq * (1.f / 256.f) + EPS);
            bf16_t* op = A2 + (row0 + lme) * 1024 + 512 + g * 256 + 32 * pt + 4 * h;
#pragma unroll
            for (int hh = 0; hh < 4; ++hh)
#pragma unroll
                for (int g4 = 0; g4 < 4; ++g4) {
                    const f32x4 wv = *(const f32x4*)(wsn + g * 256 + hh * 64 + 32 * pt + 8 * g4 + 4 * h);
                    const u32x2 t = yh[hh][g4];
                    u32x2 o; o.x = pk2(bflo(t.x) * rstd * wv.x, bfhi(t.x) * rstd * wv.y); o.y = pk2(bflo(t.y) * rstd * wv.z, bfhi(t.y) * rstd * wv.w);
                    *(u32x2*)(op + hh * 64 + 8 * g4) = o;
                }
        }
        __syncthreads();
    }
}

__device__ __forceinline__ void phase5(const Params& p, unsigned char* lds) {
    unsigned char* ws = p.ws;
    pg8::Gemm g{(const bf16_t*)(ws + WS_A2), (const bf16_t*)(ws + WS_WOUT), NT, DM, DM};
    pg8::StaticOrder S; S.init(NT, DM, (int)gridDim.x, (int)blockIdx.x);
    pg8::EpiResid<true, true> E{p.in[0], (bf16_t*)(ws + WS_XB), (float*)(ws + WS_SSQ)};
    pg8::gemm_phase<pg8::EpiResid<true, true>, pg8::StaticOrder, true, true>(LDS3(lds), g, S, E);
}
__device__ __forceinline__ void phase6(const Params& p, unsigned char* lds) {
    unsigned char* ws = p.ws;
    pg8::Gemm g{(const bf16_t*)(ws + WS_XB), (const bf16_t*)(ws + WS_WQ), NT, 512, DM};
    pg8::StaticOrder S; S.init(NT, 512, (int)gridDim.x, (int)blockIdx.x);
    pg8::EpiQ E{(bf16_t*)(ws + WS_Q2), (const float*)(ws + WS_SSQ)};
    pg8::gemm_phase<pg8::EpiQ, pg8::StaticOrder, true, true>(LDS3(lds), g, S, E);
}
__device__ __forceinline__ void phase8(const Params& p, unsigned char* lds) {
    unsigned char* ws = p.ws;
    pg8::Gemm g{(const bf16_t*)(ws + WS_XO), (const bf16_t*)(ws + WS_WO), NT, DM, 512};
    pg8::StaticOrder S; S.init(NT, DM, (int)gridDim.x, (int)blockIdx.x);
    pg8::EpiResid<false, false> E{(const void*)(ws + WS_XB), (bf16_t*)(ws + WS_XB), nullptr};
    pg8::gemm_phase<pg8::EpiResid<false, false>, pg8::StaticOrder, true, true>(LDS3(lds), g, S, E);
}

__device__ __forceinline__ void phase7(const Params& p, unsigned char* lds) {
    const int tid = opaque_tid(), lane = tid & 63, w = tid >> 6, r = lane & 31, h = lane >> 5;
    const bf16_t* q2 = (const bf16_t*)(p.ws + WS_Q2); const bf16_t* kmem = (const bf16_t*)(p.ws + WS_KMEM); const bf16_t* vmemT = (const bf16_t*)(p.ws + WS_VMEMT);
    bf16_t* xo = (bf16_t*)(p.ws + WS_XO);
    bf16_t* sK = (bf16_t*)lds;
    bf16_t* sV = sK + 256 * 136;
    const float sc = 0.08838834764831845f * 1.4426950408889634f;
    for (int pr = blockIdx.x; pr < 256; pr += gridDim.x) {
        const int bh = pr >> 3, rp = pr & 7, b = bh >> 2, hx = bh & 3;
        __syncthreads();
        for (int i = tid; i < 4096; i += NTHREADS) { const int key = i >> 4, ch = i & 15;
            *(u32x4*)(sK + key * 136 + ch * 8) = *(const u32x4*)(kmem + ((size_t)b * 256 + key) * 512 + hx * 128 + ch * 8); }
        for (int i = tid; i < 4096; i += NTHREADS) { const int d = i >> 5, ch = i & 31;
            const u32x4 v = *(const u32x4*)(vmemT + (((size_t)b * 4 + hx) * 128 + d) * 256 + ch * 8);
            *(u32x2*)(sV + d * 260 + ch * 8) = (u32x2){v.x, v.y}; *(u32x2*)(sV + d * 260 + ch * 8 + 4) = (u32x2){v.z, v.w}; }
        __syncthreads();
#pragma unroll 1
        for (int ib = 0; ib < 2; ++ib) {
            const size_t row0 = (size_t)b * SEQ + (size_t)(2 * rp + ib) * 256 + w * 32;
            bf16x8 qf[8];
            const bf16_t* qp = q2 + (row0 + r) * 512 + hx * 128 + 8 * h;
#pragma unroll
            for (int kk = 0; kk < 8; ++kk) qf[kk] = *(const bf16x8*)(qp + kk * 16);
            f32x16 S[8];
#pragma unroll
            for (int t = 0; t < 8; ++t) S[t] = zero16();
            const bf16_t* kp = sK + r * 136 + 8 * h;
#pragma unroll
            for (int kk = 0; kk < 8; ++kk) {
#pragma unroll
                for (int t = 0; t < 8; ++t) { const bf16x8 a = *(const bf16x8*)(kp + t * (32 * 136) + kk * 16); S[t] = mfma32(a, qf[kk], S[t]); }
                __builtin_amdgcn_sched_barrier(0);
            }
            float m = -INFINITY;
#pragma unroll
            for (int t = 0; t < 8; ++t)
#pragma unroll
                for (int i = 0; i < 16; ++i) m = fmaxf(m, S[t][i]);
            m = fmaxf(m, __shfl_xor(m, 32));
            float sum = 0.f;
            bf16x8 P[16];
#pragma unroll
            for (int t = 0; t < 8; ++t) {
                float e[16];
#pragma unroll
                for (int i = 0; i < 16; ++i) { e[i] = __builtin_amdgcn_exp2f((S[t][i] - m) * sc); sum += e[i]; }
                P[2 * t] = pack8(e[0], e[1], e[2], e[3], e[4], e[5], e[6], e[7]);
                P[2 * t + 1] = pack8(e[8], e[9], e[10], e[11], e[12], e[13], e[14], e[15]);
            }
            sum += __shfl_xor(sum, 32);
            const float inv = 1.f / sum;
            f32x16 O[4];
#pragma unroll
            for (int dt = 0; dt < 4; ++dt) O[dt] = zero16();
            const bf16_t* vp0 = sV + r * 260 + 4 * h;
#pragma unroll
            for (int ts = 0; ts < 16; ++ts) {
#pragma unroll
                for (int dt = 0; dt < 4; ++dt) {
                    const bf16_t* vp = vp0 + dt * (32 * 260) + 16 * ts;
                    const u32x2 lo = *(const u32x2*)vp, hi = *(const u32x2*)(vp + 8);
                    const bf16x8 a = __builtin_bit_cast(bf16x8, (u32x4){lo.x, lo.y, hi.x, hi.y});
                    O[dt] = mfma32(a, P[ts], O[dt]);
                }
                if (ts & 1) __builtin_amdgcn_sched_barrier(0);
            }
            bf16_t* op = xo + (row0 + r) * 512 + hx * 128 + 4 * h;
#pragma unroll
            for (int dt = 0; dt < 4; ++dt)
#pragma unroll
                for (int g = 0; g < 4; ++g) { u32x2 o; o.x = pk2(O[dt][4 * g] * inv, O[dt][4 * g + 1] * inv); o.y = pk2(O[dt][4 * g + 2] * inv, O[dt][4 * g + 3] * inv);
                    *(u32x2*)(op + 32 * dt + 8 * g) = o; }
        }
    }
}

typedef __bf16 bf16x2_t __attribute__((ext_vector_type(2)));
__device__ __forceinline__ float dot2bf(unsigned a, unsigned b, float acc) { return __builtin_amdgcn_fdot2_f32_bf16(__builtin_bit_cast(bf16x2_t, a), __builtin_bit_cast(bf16x2_t, b), acc, false); }
__device__ __forceinline__ void phase9(const Params& p, unsigned char* lds) {
    const int tid = opaque_tid(), lane = tid & 63, w = tid >> 6, r = lane & 31, h = lane >> 5;
    const bf16_t* x2 = (const bf16_t*)(p.ws + WS_XB);
    int* cnt = (int*)(p.ws + WS_CTL);
    int* list = (int*)(p.ws + WS_LIST);
    float* route = (float*)(p.ws + WS_ROUTE);
    const float* bg = p.in[21]; const float* be = p.in[23];
    bf16_t* sW = (bf16_t*)lds;
    int* lcnt = (int*)(lds + 74752);
    float* lrec = (float*)(lds + 74752 + 256);
    for (int i = tid; i < 36 * 128; i += NTHREADS) { const int n = i >> 7, ch = i & 127; *(u32x4*)(sW + n * 1032 + ch * 8) = *(const u32x4*)((const bf16_t*)(p.ws + WS_WR) + n * 1024 + ch * 8); }
    if (tid < 64) lcnt[tid] = 0;
    __syncthreads();
    const int njobs = NT / 32, jstride = gridDim.x * 4;
    int nrec = 0;
    for (int job0 = blockIdx.x * 4; job0 < njobs; job0 += jstride, ++nrec) {
        const int job = job0 + w;
        if (w < 4 && job < njobs) {
            const int m0 = job * 32;
            f32x16 acc0 = zero16(), acc1 = zero16();
            float ss = 0.f;
            const bf16_t* xp = x2 + (size_t)(m0 + r) * DM + 8 * h;
            const bf16_t* w0p = sW + r * 1032 + 8 * h;
            const bf16_t* w1p = sW + (32 + (r & 3)) * 1032 + 8 * h;
#pragma unroll 1
            for (int kb = 0; kb < 4; ++kb) {
                u32x4 xf[16];
#pragma unroll
                for (int q = 0; q < 16; ++q) xf[q] = *(const u32x4*)(xp + (kb * 16 + q) * 16);
#pragma unroll
                for (int q = 0; q < 16; ++q) {
                    const bf16x8 a0 = *(const bf16x8*)(w0p + (kb * 16 + q) * 16), a1 = *(const bf16x8*)(w1p + (kb * 16 + q) * 16);
                    const bf16x8 xb = __builtin_bit_cast(bf16x8, xf[q]);
                    acc0 = mfma32(a0, xb, acc0); acc1 = mfma32(a1, xb, acc1);
                    ss = dot2bf(xf[q].x, xf[q].x, ss); ss = dot2bf(xf[q].y, xf[q].y, ss); ss = dot2bf(xf[q].z, xf[q].z, ss); ss = dot2bf(xf[q].w, xf[q].w, ss);
                }
            }
            ss += __shfl_xor(ss, 32);
            const float rstd = 1.f / sqrtf(ss * (1.f / DM) + EPS);
            const float g0 = __shfl(acc1[0], r) * rstd + bg[0], g1 = __shfl(acc1[1], r) * rstd + bg[1], g2 = __shfl(acc1[2], r) * rstd + bg[2], g3 = __shfl(acc1[3], r) * rstd + bg[3];
            int gi = 0; float gm = g0;
            if (g1 > gm) { gm = g1; gi = 1; }
            if (g2 > gm) { gm = g2; gi = 2; }
            if (g3 > gm) { gm = g3; gi = 3; }
            const float gden = __expf(g0 - gm) + __expf(g1 - gm) + __expf(g2 - gm) + __expf(g3 - gm);
            const float ggate = 1.f / gden;
            const bool up = (gi & 1) != 0;
            const int gme = 2 * h + (gi & 1);
            float ev[8];
#pragma unroll
            for (int j = 0; j < 8; ++j) ev[j] = (up ? acc0[8 + j] : acc0[j]) * rstd + be[gme * 8 + j];
            int i1 = 0; float v1 = ev[0];
#pragma unroll
            for (int j = 1; j < 8; ++j) if (ev[j] > v1) { v1 = ev[j]; i1 = j; }
            int i2 = -1; float v2 = -INFINITY;
#pragma unroll
            for (int j = 0; j < 8; ++j) if (j != i1 && ev[j] > v2) { v2 = ev[j]; i2 = j; }
            const float e2 = __expf(v2 - v1);
            const float w1 = ggate / (1.f + e2), w2 = ggate * e2 / (1.f + e2);
            if (h == (gi >> 1)) {
                const int ea = gi * 8 + i1, eb = gi * 8 + i2;
                const int la = atomicAdd(lcnt + ea, 1), lb = atomicAdd(lcnt + eb, 1);
                float* rc = lrec + (size_t)(nrec * 128 + w * 32 + r) * 8;
                ((int*)rc)[0] = ea; ((int*)rc)[1] = eb; ((int*)rc)[2] = la; ((int*)rc)[3] = lb; rc[4] = w1; rc[5] = w2; rc[6] = rstd; ((int*)rc)[7] = m0 + r;
            }
        }
    }
    __syncthreads();
    if (tid < 32) lcnt[32 + tid] = lcnt[tid] ? atomicAdd(cnt + tid * 64, lcnt[tid]) : 0;
    __syncthreads();
    {
        int rd = 0;
        for (int job0 = blockIdx.x * 4; job0 < njobs; job0 += jstride, ++rd) {
            if (tid < 128 && job0 + (tid >> 5) < njobs) {
                const float* rc = lrec + (size_t)(rd * 128 + tid) * 8;
                const int ea = ((const int*)rc)[0], eb = ((const int*)rc)[1], m = ((const int*)rc)[7];
                const int pa = lcnt[32 + ea] + ((const int*)rc)[2], pb = lcnt[32 + eb] + ((const int*)rc)[3];
                list[ea * NT + pa] = m; list[eb * NT + pb] = m;
                int* ri = (int*)(route + (size_t)m * 8);
                ri[0] = ea; ri[1] = eb; ri[2] = pa; ri[3] = pb;
                route[(size_t)m * 8 + 4] = rc[4]; route[(size_t)m * 8 + 5] = rc[5]; route[(size_t)m * 8 + 6] = rc[6]; route[(size_t)m * 8 + 7] = 0.f;
            }
        }
    }
}

__device__ __forceinline__ int* moe_tables(const Params& p, unsigned char* lds) {
    int* off = (int*)(lds + 131072);
    const int* cnt = (const int*)(p.ws + WS_CTL);
    if (threadIdx.x < 64) {
        const int l = threadIdx.x & 63;
        const int cv = (l < NEXP) ? cnt[l * 64] : 0;
        int pad = ((cv + 255) >> 8) << 8, incl = pad;
#pragma unroll
        for (int o = 1; o < 32; o <<= 1) { const int t = __shfl_up(incl, o); if (l >= o) incl += t; }
        if (l < NEXP) { off[l] = incl - pad; off[40 + l] = cv; }
        if (l == NEXP - 1) off[NEXP] = incl;
    }
    __syncthreads();
    const int nrt = off[NEXP] >> 8;
    for (int rt = threadIdx.x; rt < nrt; rt += NTHREADS) { int e = 0; for (int q = 1; q < NEXP; ++q) if (off[q] <= rt * 256) e = q; off[128 + rt] = e; }
    __syncthreads();
    return off;
}

__device__ __forceinline__ void phase10(const Params& p, unsigned char* lds) {
    const int tid = opaque_tid(), lane = tid & 63, w = tid >> 6;
    const int* off = moe_tables(p, lds);
    const int gw = blockIdx.x * NWAVES + w, NGW = gridDim.x * NWAVES;
    const bf16_t* x2 = (const bf16_t*)(p.ws + WS_XB); const float* route = (const float*)(p.ws + WS_ROUTE);
    bf16_t* xg = (bf16_t*)(p.ws + WS_XG);
    for (int m = gw; m < NT; m += NGW) {
        const int* ri = (const int*)(route + (size_t)m * 8);
        const int ea = ri[0], eb = ri[1], pa = ri[2], pb = ri[3];
        const float rs = route[(size_t)m * 8 + 6];
        const size_t sa = (size_t)off[ea] + pa, sb = (size_t)off[eb] + pb;
        const u32x2* xr = (const u32x2*)(x2 + (size_t)m * DM) + lane;
        u32x2* oa = (u32x2*)(xg + sa * DM) + lane; u32x2* ob = (u32x2*)(xg + sb * DM) + lane;
#pragma unroll
        for (int j = 0; j < 4; ++j) { const u32x2 t = xr[64 * j]; u32x2 o; o.x = pk2(bflo(t.x) * rs, bfhi(t.x) * rs); o.y = pk2(bflo(t.y) * rs, bfhi(t.y) * rs); oa[64 * j] = o; ob[64 * j] = o; }
    }
}

__device__ __forceinline__ void phase11(const Params& p, unsigned char* lds) {
    const int tid = opaque_tid();
    const int* off = moe_tables(p, lds);
    const int nrt = off[NEXP] >> 8, G = (int)gridDim.x, c = (int)blockIdx.x;
    unsigned* rowtab = (unsigned*)(lds + 131072 + 2048);
    float* rstab = (float*)(lds + 131072 + 2048 + 3072);
    {
        const int* list = (const int*)(p.ws + WS_LIST); const float* route = (const float*)(p.ws + WS_ROUTE);
        for (int i = 0; i < 3; ++i) {
            const int L = i * G + c; if (L >= nrt * 2) break;
            const int rt = L >> 1, e = off[128 + rt], cnt_e = off[40 + e], pos0 = rt * 256 - off[e];
            if (tid < 256) { const int pos = pos0 + tid; int tok = 0; float rs = 0.f;
                if (pos < cnt_e) { tok = list[e * NT + pos]; rs = route[(size_t)tok * 8 + 6]; }
                rowtab[i * 256 + tid] = (unsigned)tok * (unsigned)(DM * 2); rstab[i * 256 + tid] = rs; }
        }
    }
    __syncthreads();
    pg8::Gemm g{(const bf16_t*)(p.ws + WS_XB), (const bf16_t*)(p.ws + WS_WGU), 0, 0, DM};
    pg8::MoeOrder S{(const __attribute__((address_space(3))) int*)(off + 128), nrt, 2, G, c};
    pg8::EpiGU E{(bf16_t*)(p.ws + WS_HID), (const __attribute__((address_space(3))) float*)rstab, G, c};
    pg8::gemm_phase_g<pg8::EpiGU, pg8::MoeOrder, true, true>(LDS3(lds), g, S, E, (const __attribute__((address_space(3))) unsigned*)rowtab);
}
__device__ __forceinline__ void phase12(const Params& p, unsigned char* lds) {
    const int* off = moe_tables(p, lds);
    int kdim = EFF; asm volatile("" : "+s"(kdim));
    pg8::Gemm g{(const bf16_t*)(p.ws + WS_HID), (const bf16_t*)(p.ws + WS_WD), 0, 0, kdim};
    pg8::MoeOrder S{(const __attribute__((address_space(3))) int*)(off + 128), off[NEXP] >> 8, 4, (int)gridDim.x, (int)blockIdx.x};
    pg8::EpiY8 E{(unsigned char*)(p.ws + WS_Y), DM, 4};
    pg8::gemm_phase<pg8::EpiY8, pg8::MoeOrder, true, true>(LDS3(lds), g, S, E);
}

__device__ __forceinline__ void phase13(const Params& p, unsigned char* lds) {
    const int tid = opaque_tid(), lane = tid & 63, w = tid >> 6;
    const int* off = moe_tables(p, lds);
    const int gw = blockIdx.x * NWAVES + w, NGW = gridDim.x * NWAVES;
    const bf16_t* x2 = (const bf16_t*)(p.ws + WS_XB); const unsigned char* yb = (const unsigned char*)(p.ws + WS_Y);
    const float* route = (const float*)(p.ws + WS_ROUTE); const float* wf = p.in[27];
    f32x4 wv[2][2];
#pragma unroll
    for (int j = 0; j < 2; ++j) { wv[j][0] = *(const f32x4*)(wf + 8 * lane + 512 * j); wv[j][1] = *(const f32x4*)(wf + 8 * lane + 512 * j + 4); }
    struct Rows { u32x4 x[2]; u32x2 ya[2], yb[2]; float w1, w2; };
    Rows R0, R1, R2;
    u32x4 recN; u32x2 wN;
#define LOAD_REC(m_, REC, WW) { REC = *(const u32x4*)(route + (size_t)(m_) * 8); WW = *(const u32x2*)(route + (size_t)(m_) * 8 + 4); }
#define ISSUE_ROWS(m_, REC, WW, R) { const size_t sa_ = (size_t)off[(int)(REC).x] + (REC).z, sb_ = (size_t)off[(int)(REC).y] + (REC).w; \
        const u32x4* xr_ = (const u32x4*)(x2 + (size_t)(m_) * DM) + lane; const u32x2* ya_ = (const u32x2*)(yb + sa_ * DM) + lane; const u32x2* yb_ = (const u32x2*)(yb + sb_ * DM) + lane; \
        _Pragma("unroll") for (int j = 0; j < 2; ++j) { R.x[j] = xr_[64 * j]; R.ya[j] = ya_[64 * j]; R.yb[j] = yb_[64 * j]; } \
        R.w1 = __uint_as_float((WW).x) * 0.0625f; R.w2 = __uint_as_float((WW).y) * 0.0625f; }
    {
        u32x4 rc; u32x2 ww;
        if (gw < NT) { LOAD_REC(gw, rc, ww); ISSUE_ROWS(gw, rc, ww, R0); }
        if (gw + NGW < NT) { LOAD_REC(gw + NGW, rc, ww); ISSUE_ROWS(gw + NGW, rc, ww, R1); }
        if (gw + 2 * NGW < NT) LOAD_REC(gw + 2 * NGW, recN, wN);
    }
#pragma unroll 1
    for (int m = gw; m < NT; m += NGW) {
        if (m + 2 * NGW < NT) ISSUE_ROWS(m + 2 * NGW, recN, wN, R2);
        if (m + 3 * NGW < NT) LOAD_REC(m + 3 * NGW, recN, wN);
        f32x4 v[2][2]; float s = 0.f;
#pragma unroll
        for (int j = 0; j < 2; ++j) {
            typedef float f32x2v __attribute__((ext_vector_type(2)));
            const u32x4 t = R0.x[j]; const u32x2 a = R0.ya[j], bq = R0.yb[j]; const float w1 = R0.w1, w2 = R0.w2;
            const f32x2v a0 = __builtin_amdgcn_cvt_pk_f32_fp8((int)a.x, false), a1 = __builtin_amdgcn_cvt_pk_f32_fp8((int)a.x, true), a2 = __builtin_amdgcn_cvt_pk_f32_fp8((int)a.y, false), a3 = __builtin_amdgcn_cvt_pk_f32_fp8((int)a.y, true);
            const f32x2v b0 = __builtin_amdgcn_cvt_pk_f32_fp8((int)bq.x, false), b1 = __builtin_amdgcn_cvt_pk_f32_fp8((int)bq.x, true), b2 = __builtin_amdgcn_cvt_pk_f32_fp8((int)bq.y, false), b3 = __builtin_amdgcn_cvt_pk_f32_fp8((int)bq.y, true);
            v[j][0] = (f32x4){bflo(t.x) + w1 * a0.x + w2 * b0.x, bfhi(t.x) + w1 * a0.y + w2 * b0.y, bflo(t.y) + w1 * a1.x + w2 * b1.x, bfhi(t.y) + w1 * a1.y + w2 * b1.y};
            v[j][1] = (f32x4){bflo(t.z) + w1 * a2.x + w2 * b2.x, bfhi(t.z) + w1 * a2.y + w2 * b2.y, bflo(t.w) + w1 * a3.x + w2 * b3.x, bfhi(t.w) + w1 * a3.y + w2 * b3.y};
#pragma unroll
            for (int q = 0; q < 2; ++q) s += (v[j][q].x * v[j][q].x + v[j][q].y * v[j][q].y) + (v[j][q].z * v[j][q].z + v[j][q].w * v[j][q].w);
        }
        const float rstd = 1.f / sqrtf(wave_sum(s) * (1.f / DM) + EPS);
        float* o = p.out + (size_t)m * DM + 8 * lane;
#pragma unroll
        for (int j = 0; j < 2; ++j) { *(f32x4*)(o + 512 * j) = v[j][0] * rstd * wv[j][0]; *(f32x4*)(o + 512 * j + 4) = v[j][1] * rstd * wv[j][1]; }
        R0 = R1; R1 = R2;
    }
#undef ISSUE_ROWS
#undef LOAD_REC
}

constexpr int NPHASE = 14;
__global__ void __launch_bounds__(NTHREADS, 2) fwd_kernel(Params p) {
    extern __shared__ __attribute__((aligned(16))) unsigned char lds[];
#if MK_ONE_LAUNCH
    cg::grid_group grid = cg::this_grid();
    volatile LAS unsigned* bst = (volatile LAS unsigned*)(LDS3(lds) + LDS_BYTES - 16);
    if (threadIdx.x < 2) bst[threadIdx.x] = 0u;
    __syncthreads();
    const XcdBarrier xbar = xcd_barrier_post((unsigned*)(p.ws + WS_BAR), bst);
    if (p.ph_hi > NPHASE) grid.sync();
#define SEAM(k) do { if (p.ph_lo <= (k) && (k) + 1 < p.ph_hi) xcd_barrier(xbar); } while (0)
#else
#define SEAM(k) do { } while (0)
#endif
#ifndef PROBE_PHASE
#define PROBE_PHASE -1
#endif
#define IN(k) (p.ph_lo <= (k) && (k) < p.ph_hi && (k) != p.skip)
#define REPS(k) (((k) == PROBE_PHASE) ? 2 : 1)
    if (IN(0)) { _Pragma("unroll 1") for (int rep = 0; rep < REPS(0); ++rep) { phase0(p, lds); } } SEAM(0);
    if (IN(1)) { _Pragma("unroll 1") for (int rep = 0; rep < REPS(1); ++rep) { phase1(p, lds); } } SEAM(1);
    if (IN(2)) { _Pragma("unroll 1") for (int rep = 0; rep < REPS(2); ++rep) for (int it = blockIdx.x; it < NB * NCH; it += gridDim.x) { const int b = it / NCH, c = it % NCH; phase2_attn(p, lds, b, c); phase2_states(p, lds, b, c); } } SEAM(2);
    if (IN(3)) { _Pragma("unroll 1") for (int rep = 0; rep < REPS(3); ++rep) { phase3(p); } } SEAM(3);
    if (IN(4)) { _Pragma("unroll 1") for (int rep = 0; rep < REPS(4); ++rep) for (int it = blockIdx.x; it < NB * NCH; it += gridDim.x) { const int b = it / NCH, c = it % NCH; phase4(p, lds, b, c); } } SEAM(4);
    if (IN(5)) { _Pragma("unroll 1") for (int rep = 0; rep < REPS(5); ++rep) { phase5(p, lds); } } SEAM(5);
    if (IN(6)) { _Pragma("unroll 1") for (int rep = 0; rep < REPS(6); ++rep) { phase6(p, lds); } } SEAM(6);
    if (IN(7)) { _Pragma("unroll 1") for (int rep = 0; rep < REPS(7); ++rep) { phase7(p, lds); } } SEAM(7);
    if (IN(8)) { phase8(p, lds); } SEAM(8);
    if (IN(9)) { phase9(p, lds); } SEAM(9);
    if (IN(11)) { _Pragma("unroll 1") for (int rep = 0; rep < REPS(11); ++rep) { phase11(p, lds); } } SEAM(11);
    if (IN(12)) { _Pragma("unroll 1") for (int rep = 0; rep < REPS(12); ++rep) { phase12(p, lds); } } SEAM(12);
    if (IN(13)) { _Pragma("unroll 1") for (int rep = 0; rep < REPS(13); ++rep) { phase13(p, lds); } }
#undef IN
#undef SEAM
}

extern "C" void kernel_launch(void* const* d_in, const int* in_sizes, int n_in, void* d_out, int out_size, void* d_ws, size_t ws_size, hipStream_t stream) {
    static int grid = 0;
    if (grid == 0) {
        if (n_in != 28 || out_size != NT * DM || ws_size < WS_NEED) { fprintf(stderr, "kernel_launch: unexpected sizes n_in %d out %d ws %zu\n", n_in, out_size, ws_size); grid = -1; return; }
        int dev = 0, cus = 0, per_cu = 0;
        hipGetDevice(&dev);
        hipDeviceGetAttribute(&cus, hipDeviceAttributeMultiprocessorCount, dev);
        if (hipFuncSetAttribute((const void*)fwd_kernel, hipFuncAttributeMaxDynamicSharedMemorySize, LDS_BYTES) != hipSuccess) { fprintf(stderr, "kernel_launch: hipFuncSetAttribute failed\n"); grid = -1; return; }
        if (hipOccupancyMaxActiveBlocksPerMultiprocessor(&per_cu, (const void*)fwd_kernel, NTHREADS, LDS_BYTES) != hipSuccess || per_cu < 1) { fprintf(stderr, "kernel_launch: occupancy query says %d\n", per_cu); per_cu = 1; }
        (void)hipGetLastError();
        grid = cus;
    }
    if (grid < 0) return;
    Params prm{};
    for (int i = 0; i < 28; ++i) prm.in[i] = (const float*)d_in[i];
    prm.out = (float*)d_out; prm.ws = (unsigned char*)d_ws;
    for (int i = 0; i < 8; ++i) prm.inv_freq[i] = powf(500000.0f, -(float)(2 * i) / 16.0f);
    prm.skip = -1;
#ifndef PROBE_SKIP
#define PROBE_SKIP -2
#endif
#if MK_ONE_LAUNCH
    for (int twice = 0; twice < ((PROBE_SKIP >= -1) ? 2 : 1); ++twice) {
    if (hipMemsetAsync((char*)d_ws + WS_CTL, 0, CTL_ZERO_BYTES, stream) != hipSuccess) { fprintf(stderr, "kernel_launch: memset failed\n"); return; }
#ifndef PROBE_TRUNC
#define PROBE_TRUNC NPHASE
#endif
#ifndef PROBE_VARIANT
#define PROBE_VARIANT 0
#endif
    prm.ph_lo = 0; prm.ph_hi = twice ? PROBE_TRUNC : NPHASE; prm.skip = twice ? PROBE_SKIP : -1; prm.pad = twice ? PROBE_VARIANT : 0;
    void* args[] = {&prm};
    hipError_t e = hipLaunchCooperativeKernel((const void*)fwd_kernel, dim3(grid), dim3(NTHREADS), args, LDS_BYTES, stream);
    if (e != hipSuccess) fprintf(stderr, "cooperative launch failed: %s (grid %d)\n", hipGetErrorString(e), grid);
    }
#else
    if (hipMemsetAsync((char*)d_ws + WS_CTL, 0, CTL_ZERO_BYTES, stream) != hipSuccess) { fprintf(stderr, "kernel_launch: memset failed\n"); return; }
#ifndef PROBE_DUP
#define PROBE_DUP -1
#endif
    for (int ph = 0; ph < NPHASE; ++ph) {
        prm.ph_lo = ph; prm.ph_hi = ph + 1;
        hipLaunchKernelGGL(fwd_kernel, dim3(grid), dim3(NTHREADS), LDS_BYTES, stream, prm);
        if (ph == PROBE_DUP) hipLaunchKernelGGL(fwd_kernel, dim3(grid), dim3(NTHREADS), LDS_BYTES, stream, prm);
    }
#endif
}
```

```cpp
#include <hip/hip_runtime.h>
#include <hip/hip_cooperative_groups.h>
#include <cstdio>
#include <cmath>
namespace cg = cooperative_groups;

#ifndef MK_ONE_LAUNCH
#define MK_ONE_LAUNCH 1
#endif

typedef unsigned short bf16_t;
typedef short bf16x8 __attribute__((ext_vector_type(8)));
typedef float f32x4 __attribute__((ext_vector_type(4)));
typedef float f32x16 __attribute__((ext_vector_type(16)));
typedef unsigned u32x4 __attribute__((ext_vector_type(4)));
typedef unsigned u32x2 __attribute__((ext_vector_type(2)));

constexpr int NB = 8, SEQ = 4096, DM = 1024, NT = NB * SEQ;
constexpr int NPROJ = 2304, LDWIN = 2312;
constexpr int C_K = 512, C_V = 640, C_Z = 768, C_X = 1280, C_B = 1792, C_C = 2048;
constexpr int MEMT = 256, NMEM = NB * MEMT;
constexpr int NEXP = 32, EFF = 256;
constexpr int NCH = SEQ / 128;
constexpr float EPS = 1e-5f;
constexpr int NTHREADS = 512, NWAVES = 8;
constexpr int LDS_BYTES = 147456;

constexpr size_t MiB = (size_t)1 << 20;
constexpr size_t WS_CTL = 0, WS_BAR = 65536, CTL_ZERO_BYTES = 131072;
constexpr size_t WS_WIN = 1 * MiB, WS_WOUT = 6 * MiB, WS_WQ = 8 * MiB, WS_WKV = 9 * MiB, WS_WO = 11 * MiB, WS_WR = 12 * MiB;
constexpr size_t WS_WGU = 16 * MiB, WS_WD = 48 * MiB;
constexpr size_t WS_MEMH = 64 * MiB, WS_KMEM = 68 * MiB, WS_VMEMT = 70 * MiB, WS_DTRAW = 72 * MiB, WS_CDEC = 73 * MiB, WS_ROUTE = 74 * MiB;
constexpr size_t WS_LIST = 76 * MiB, WS_SSQ = 80 * MiB, WS_RS1 = 84 * MiB;
constexpr size_t WS_PROJ = 96 * MiB, WS_A2 = 240 * MiB, WS_STATES = 304 * MiB, WS_START = 368 * MiB;
constexpr size_t WS_X1 = 96 * MiB, WS_XB = 304 * MiB, WS_Q2 = 368 * MiB, WS_XO = 224 * MiB, WS_XG = 96 * MiB, WS_HID = 368 * MiB, WS_Y = 96 * MiB;
constexpr size_t WS_H1 = 416 * MiB;
constexpr size_t WS_NEED = 512 * MiB;

struct Params {
    const float* in[28];
    float* out;
    unsigned char* ws;
    float inv_freq[8];
    int ph_lo, ph_hi, skip, pad;
};

__device__ __forceinline__ unsigned f2bf(float f) { unsigned u = __float_as_uint(f); return (u + 0x7fffu + ((u >> 16) & 1u)) >> 16; }
__device__ __forceinline__ float bf2f(unsigned h) { return __uint_as_float(h << 16); }
__device__ __forceinline__ unsigned pk2(float lo, float hi) { return f2bf(lo) | (f2bf(hi) << 16); }
__device__ __forceinline__ float bflo(unsigned u) { return __uint_as_float(u << 16); }
__device__ __forceinline__ float bfhi(unsigned u) { return __uint_as_float(u & 0xffff0000u); }
__device__ __forceinline__ float wave_sum(float v) {
#pragma unroll
    for (int o = 32; o >= 1; o >>= 1) v += __shfl_xor(v, o);
    return v;
}
#define LDS_WAIT() asm volatile("s_waitcnt lgkmcnt(0)" ::: "memory")
__device__ __forceinline__ int opaque_tid() { int t = threadIdx.x; asm volatile("" : "+v"(t)); return t; }
__device__ __forceinline__ float siluf(float v) { return v * __builtin_amdgcn_rcpf(1.f + __expf(-v)); }
__device__ __forceinline__ f32x16 mfma32(bf16x8 a, bf16x8 b, f32x16 c) { return __builtin_amdgcn_mfma_f32_32x32x16_bf16(a, b, c, 0, 0, 0); }
__device__ __forceinline__ f32x16 zero16() { f32x16 z;
#pragma unroll
    for (int i = 0; i < 16; ++i) z[i] = 0.f;
    return z; }
__device__ __forceinline__ bf16x8 pack8(float a0, float a1, float a2, float a3, float a4, float a5, float a6, float a7) {
    u32x4 t; t.x = pk2(a0, a1); t.y = pk2(a2, a3); t.z = pk2(a4, a5); t.w = pk2(a6, a7);
    return __builtin_bit_cast(bf16x8, t);
}
__device__ __forceinline__ int crow(int i, int h) { return (i & 3) + 8 * (i >> 2) + 4 * h; }

namespace pg8 {
#define PG8_LAS __attribute__((address_space(3)))
typedef unsigned short bf16_t;
typedef short bf16x8 __attribute__((ext_vector_type(8)));
typedef float f32x4 __attribute__((ext_vector_type(4)));
typedef unsigned u32x4 __attribute__((ext_vector_type(4)));
constexpr int BM = 256, BK = 64, HALF = 128, HTB = HALF * BK * 2  , STAGE_BYTES = 8 * HTB, NXCD = 8, WGM = 8;

__host__ __device__ __forceinline__ int lds_byte(int r, int c) { const int st = (r >> 4) * 2 + (c >> 5), rr = r & 15, cc = c & 31, ob = rr * 64 + cc * 2; return st * 1024 + (ob ^ (((ob >> 9) & 1) << 5)); }
__host__ __device__ __forceinline__ void stage_rc(int b, int& R, int& C) { const int st = b / 1024, sb = b % 1024, swz = sb ^ (((sb >> 9) & 1) << 5); R = (st >> 1) * 16 + swz / 64; C = (st & 1) * 32 + (swz % 64) / 2; }
__host__ __device__ __forceinline__ int perm32(int rho) { const int n = rho >> 4, i = rho & 15; return 8 * (i >> 2) + 4 * n + (i & 3); }

struct Unit { int pm, pn; };
struct Gemm { const bf16_t* A; const bf16_t* Bt; int M, N, K; };

struct StaticOrder {
    int nM, nN, nwg, G, c;
    __host__ __device__ void init(int M, int N, int G_, int c_) { nM = M / BM; nN = N / BM; nwg = nM * nN; G = G_; c = c_; }
    __host__ __device__ bool next(int i, Unit& u) const {
        const long L = (long)i * G + c; if (L >= nwg) return false;
        int wgid = (int)L; { const int q = nwg / NXCD, r = nwg % NXCD, xcd = wgid % NXCD, off = wgid / NXCD; wgid = (xcd < r ? xcd * (q + 1) : r * (q + 1) + (xcd - r) * q) + off; }
        const int nig = WGM * nN, gid = wgid / nig, fm = gid * WGM, gsz = (nM - fm) < WGM ? (nM - fm) : WGM;
        u.pm = fm + ((wgid % nig) % gsz); u.pn = (wgid % nig) / gsz; return true;
    }
    __device__ __forceinline__ void a_ready(const Unit&) const {}
    __device__ __forceinline__ void done(const Unit&) const {}
};
__device__ __forceinline__ unsigned cvt_pk_bf16(float lo, float hi) { unsigned r; asm volatile("v_cvt_pk_bf16_f32 %0, %1, %2" : "=v"(r) : "v"(lo), "v"(hi)); return r; }
typedef float f32x2 __attribute__((ext_vector_type(2)));
template <class Epi, class Sched, bool ALIGN_EPI = false, bool SP2 = false>
__device__ __forceinline__ void gemm_phase(PG8_LAS unsigned char* lds, const Gemm g, const Sched& S, const Epi& E) {
    const int tid = threadIdx.x, wid = __builtin_amdgcn_readfirstlane(tid >> 6), lane = tid & 63, wr = wid >> 2, wc = wid & 3, fr = lane & 15, fq = lane >> 4;
    const int K = g.K, nt = K / BK;
    unsigned voffA[2], voffB[2];
#pragma unroll
    for (int i = 0; i < 2; ++i) { int R, C; stage_rc(tid * 16 + i * 8192, R, C); const int Rb = Epi::PERM ? ((R & ~31) + perm32(R & 31)) : R;
        voffA[i] = (unsigned)(R * K + C) * 2u; voffB[i] = (unsigned)(Rb * K + C) * 2u; }
    const size_t kstep = (size_t)(BK * 2);
    const size_t hstep = (size_t)HALF * K * 2;
    const size_t tstep = 2 * hstep;
    const unsigned ldsw = (unsigned)wid * 1024u;
    const int aoff = lds_byte(wr * 64 + fr, fq * 8), boff = lds_byte(wc * 32 + fr, fq * 8);
#define PG8_SA(b, h) (((b) * 2 + (h)) * HTB)
#define PG8_SB(b, h) ((4 + (b) * 2 + (h)) * HTB)
#define PG8_STAGE(bufoff, gbase, voff) do { _Pragma("unroll") for (int _i = 0; _i < 2; ++_i) \
        __builtin_amdgcn_global_load_lds((const unsigned*)((const char*)(gbase) + (voff)[_i]), (PG8_LAS unsigned*)(lds + (bufoff) + ldsw + _i * 8192), 16, 0, 0); } while (0)
#define PG8_LDA(dst, b, h) do { _Pragma("unroll") for (int m = 0; m < 4; ++m) _Pragma("unroll") for (int k = 0; k < 2; ++k) dst[m][k] = *(const PG8_LAS bf16x8*)(lds + PG8_SA(b, h) + aoff + m * 2048 + k * 1024); } while (0)
#define PG8_LDB(dst, b, h) do { _Pragma("unroll") for (int n = 0; n < 2; ++n) _Pragma("unroll") for (int k = 0; k < 2; ++k) dst[n][k] = *(const PG8_LAS bf16x8*)(lds + PG8_SB(b, h) + boff + n * 2048 + k * 1024); } while (0)
#define PG8_MMA(ai, bj, At, Bt) do { __builtin_amdgcn_s_setprio(1); _Pragma("unroll") for (int m = 0; m < 4; ++m) _Pragma("unroll") for (int n = 0; n < 2; ++n) _Pragma("unroll") for (int k = 0; k < 2; ++k) \
        acc[ai][bj][m][n] = __builtin_amdgcn_mfma_f32_16x16x32_bf16(Bt[n][k], At[m][k], acc[ai][bj][m][n], 0, 0, 0); __builtin_amdgcn_s_setprio(0); } while (0)
#define PG8_WAIT_V(n) asm volatile("s_waitcnt vmcnt(" #n ")" ::: "memory")
#define PG8_WAIT_L(n) asm volatile("s_waitcnt lgkmcnt(" #n ")" ::: "memory")
#define PG8_BAR __builtin_amdgcn_s_barrier()
#define PG8_SCHED __builtin_amdgcn_sched_barrier(0)
    Unit cur, nxt; int ui = 0;
    if (!S.next(0, cur)) return;
    f32x4 acc[2][2][4][2];
#pragma unroll
    for (int a = 0; a < 2; ++a)
#pragma unroll
        for (int b = 0; b < 2; ++b)
#pragma unroll
            for (int m = 0; m < 4; ++m)
#pragma unroll
                for (int n = 0; n < 2; ++n) acc[a][b][m][n] = (f32x4){0.f, 0.f, 0.f, 0.f};
    bf16x8 At[4][2], B0[2][2], B1[2][2];
    const char* cA = (const char*)g.A + (size_t)cur.pm * tstep; const char* cB = (const char*)g.Bt + (size_t)cur.pn * tstep;
    S.a_ready(cur);
    if constexpr (SP2) {
        PG8_STAGE(PG8_SB(0, 0), cB, voffB); PG8_STAGE(PG8_SB(0, 1), cB + hstep, voffB); PG8_STAGE(PG8_SA(0, 0), cA, voffA); PG8_STAGE(PG8_SA(0, 1), cA + hstep, voffA);
        if (wr == 1) PG8_BAR;
        PG8_WAIT_V(2); PG8_BAR;
        PG8_STAGE(PG8_SB(1, 0), cB + kstep, voffB); PG8_STAGE(PG8_SA(1, 0), cA + kstep, voffA); PG8_STAGE(PG8_SB(1, 1), cB + hstep + kstep, voffB);
        PG8_WAIT_V(6); PG8_BAR;
    } else {
        PG8_STAGE(PG8_SB(0, 0), cB, voffB); PG8_STAGE(PG8_SA(0, 0), cA, voffA); PG8_STAGE(PG8_SB(0, 1), cB + hstep, voffB); PG8_STAGE(PG8_SA(0, 1), cA + hstep, voffA);
        if (wr == 1) PG8_BAR;
        PG8_WAIT_V(4); PG8_BAR;
        PG8_STAGE(PG8_SB(1, 0), cB + kstep, voffB); PG8_STAGE(PG8_SA(1, 0), cA + kstep, voffA); PG8_STAGE(PG8_SB(1, 1), cB + hstep + kstep, voffB);
        PG8_WAIT_V(6); PG8_BAR;
    }
    for (;;) {
        const bool has_next = S.next(ui + 1, nxt);
        const char* nA = has_next ? (const char*)g.A + (size_t)nxt.pm * tstep : cA; const char* nB = has_next ? (const char*)g.Bt + (size_t)nxt.pn * tstep : cB;
        for (int t = 0; t < nt; t += 2) {
            const bool last = (t == nt - 2);
            const char* a1 = cA + (size_t)(t + 1) * kstep;
            const char* a2 = last ? nA : cA + (size_t)(t + 2) * kstep; const char* b2 = last ? nB : cB + (size_t)(t + 2) * kstep;
            const char* a3 = a2 + kstep; const char* b3 = b2 + kstep;
            if (last && has_next) S.a_ready(nxt);
            if constexpr (SP2) {
            PG8_LDB(B0, 0, 0); PG8_LDB(B1, 0, 1); PG8_SCHED; PG8_LDA(At, 0, 0); PG8_STAGE(PG8_SA(1, 1), a1 + hstep, voffA);
            PG8_WAIT_V(8); PG8_WAIT_L(0); PG8_BAR; PG8_MMA(0, 0, At, B0); PG8_MMA(0, 1, At, B1); PG8_BAR; PG8_SCHED;
            PG8_LDA(At, 0, 1); PG8_STAGE(PG8_SB(0, 0), b2, voffB); PG8_STAGE(PG8_SB(0, 1), b2 + hstep, voffB); PG8_STAGE(PG8_SA(0, 0), a2, voffA);
            PG8_WAIT_V(8); PG8_WAIT_L(0); PG8_BAR; PG8_MMA(1, 0, At, B0); PG8_MMA(1, 1, At, B1); PG8_BAR; PG8_SCHED;
            PG8_LDB(B0, 1, 0); PG8_LDB(B1, 1, 1); PG8_SCHED; PG8_LDA(At, 1, 0); PG8_STAGE(PG8_SA(0, 1), a2 + hstep, voffA);
            PG8_WAIT_V(8); PG8_WAIT_L(0); PG8_BAR; PG8_MMA(0, 0, At, B0); PG8_MMA(0, 1, At, B1); PG8_BAR; PG8_SCHED;
            PG8_LDA(At, 1, 1); PG8_STAGE(PG8_SB(1, 0), b3, voffB); PG8_STAGE(PG8_SB(1, 1), b3 + hstep, voffB); PG8_STAGE(PG8_SA(1, 0), a3, voffA);
            PG8_WAIT_V(8); PG8_WAIT_L(0); PG8_BAR; PG8_MMA(1, 0, At, B0); PG8_MMA(1, 1, At, B1); PG8_BAR; PG8_SCHED;
            } else {
            PG8_LDB(B0, 0, 0); PG8_SCHED; PG8_LDA(At, 0, 0); PG8_STAGE(PG8_SA(1, 1), a1 + hstep, voffA);
            PG8_WAIT_L(8); PG8_BAR; PG8_WAIT_L(0); PG8_MMA(0, 0, At, B0); PG8_BAR; PG8_SCHED;
            PG8_LDB(B1, 0, 1); PG8_STAGE(PG8_SB(0, 0), b2, voffB);
            PG8_BAR; PG8_WAIT_L(0); PG8_MMA(0, 1, At, B1); PG8_BAR;
            PG8_LDA(At, 0, 1); PG8_STAGE(PG8_SA(0, 0), a2, voffA);
            PG8_BAR; PG8_WAIT_L(0); PG8_MMA(1, 0, At, B0); PG8_BAR; PG8_SCHED;
            PG8_STAGE(PG8_SB(0, 1), b2 + hstep, voffB);
            PG8_WAIT_V(6); PG8_BAR; PG8_MMA(1, 1, At, B1); PG8_BAR;
            PG8_LDB(B0, 1, 0); PG8_SCHED; PG8_LDA(At, 1, 0); PG8_STAGE(PG8_SA(0, 1), a2 + hstep, voffA);
            PG8_WAIT_L(8); PG8_BAR; PG8_WAIT_L(0); PG8_MMA(0, 0, At, B0); PG8_BAR; PG8_SCHED;
            PG8_LDB(B1, 1, 1); PG8_STAGE(PG8_SB(1, 0), b3, voffB);
            PG8_BAR; PG8_WAIT_L(0); PG8_MMA(0, 1, At, B1); PG8_BAR;
            PG8_LDA(At, 1, 1); PG8_STAGE(PG8_SA(1, 0), a3, voffA);
            PG8_BAR; PG8_WAIT_L(0); PG8_MMA(1, 0, At, B0); PG8_BAR; PG8_SCHED;
            PG8_STAGE(PG8_SB(1, 1), b3 + hstep, voffB);
            PG8_WAIT_V(6); PG8_BAR; PG8_MMA(1, 1, At, B1); PG8_BAR;
            }
        }
        if constexpr (ALIGN_EPI) { if (wr == 0) PG8_BAR; }
        if constexpr (!Epi::AFTER_DRAIN) { E(acc, cur, wr, wc, fr, fq); S.done(cur); }
        if (!has_next) break;
#pragma unroll
        for (int a = 0; a < 2; ++a)
#pragma unroll
            for (int b = 0; b < 2; ++b)
#pragma unroll
                for (int m = 0; m < 4; ++m)
#pragma unroll
                    for (int n = 0; n < 2; ++n) acc[a][b][m][n] = (f32x4){0.f, 0.f, 0.f, 0.f};
        cur = nxt; cA = nA; cB = nB; ++ui;
        if constexpr (ALIGN_EPI) { if (wr == 1) PG8_BAR; }
    }
    PG8_WAIT_V(0);
    if constexpr (!ALIGN_EPI) { if (wr == 0) PG8_BAR; }
    PG8_BAR;
    if constexpr (Epi::AFTER_DRAIN) { E.fused(acc, cur, wr, wc, fr, fq, lds, wid, lane); S.done(cur); }
#undef PG8_SA
#undef PG8_SB
#undef PG8_STAGE
#undef PG8_LDA
#undef PG8_LDB
#undef PG8_MMA
#undef PG8_WAIT_V
#undef PG8_WAIT_L
#undef PG8_BAR
#undef PG8_SCHED
}

template <class Epi, class Sched, bool ALIGN_EPI = false, bool SP2 = false>
__device__ __forceinline__ void gemm_phase_g(PG8_LAS unsigned char* lds, const Gemm g, const Sched& S, const Epi& E, const PG8_LAS unsigned* rowtab) {
    const int tid = threadIdx.x, wid = __builtin_amdgcn_readfirstlane(tid >> 6), lane = tid & 63, wr = wid >> 2, wc = wid & 3, fr = lane & 15, fq = lane >> 4;
    const int K = g.K, nt = K / BK;
    unsigned voffA[2], voffB[2]; int RA[2]; unsigned CA2[2];
#pragma unroll
    for (int i = 0; i < 2; ++i) { int R, C; stage_rc(tid * 16 + i * 8192, R, C); const int Rb = Epi::PERM ? ((R & ~31) + perm32(R & 31)) : R;
        voffA[i] = (unsigned)(R * K + C) * 2u; voffB[i] = (unsigned)(Rb * K + C) * 2u; RA[i] = R; CA2[i] = (unsigned)C * 2u; }
    unsigned vA0[2], vA1[2], nvA0[2], nvA1[2];
#pragma unroll
    for (int i = 0; i < 2; ++i) { vA0[i] = rowtab[RA[i]] + CA2[i]; vA1[i] = rowtab[128 + RA[i]] + CA2[i]; nvA0[i] = vA0[i]; nvA1[i] = vA1[i]; }
    const size_t kstep = (size_t)(BK * 2);
    const size_t hstep = (size_t)HALF * K * 2;
    const size_t tstep = 2 * hstep;
    const unsigned ldsw = (unsigned)wid * 1024u;
    const int aoff = lds_byte(wr * 64 + fr, fq * 8), boff = lds_byte(wc * 32 + fr, fq * 8);
#define PG8_SA(b, h) (((b) * 2 + (h)) * HTB)
#define PG8_SB(b, h) ((4 + (b) * 2 + (h)) * HTB)
#define PG8_STAGE(bufoff, gbase, voff) do { _Pragma("unroll") for (int _i = 0; _i < 2; ++_i) \
        __builtin_amdgcn_global_load_lds((const unsigned*)((const char*)(gbase) + (voff)[_i]), (PG8_LAS unsigned*)(lds + (bufoff) + ldsw + _i * 8192), 16, 0, 0); } while (0)
#define PG8_LDA(dst, b, h) do { _Pragma("unroll") for (int m = 0; m < 4; ++m) _Pragma("unroll") for (int k = 0; k < 2; ++k) dst[m][k] = *(const PG8_LAS bf16x8*)(lds + PG8_SA(b, h) + aoff + m * 2048 + k * 1024); } while (0)
#define PG8_LDB(dst, b, h) do { _Pragma("unroll") for (int n = 0; n < 2; ++n) _Pragma("unroll") for (int k = 0; k < 2; ++k) dst[n][k] = *(const PG8_LAS bf16x8*)(lds + PG8_SB(b, h) + boff + n * 2048 + k * 1024); } while (0)
#define PG8_MMA(ai, bj, At, Bt) do { __builtin_amdgcn_s_setprio(1); _Pragma("unroll") for (int m = 0; m < 4; ++m) _Pragma("unroll") for (int n = 0; n < 2; ++n) _Pragma("unroll") for (int k = 0; k < 2; ++k) \
        acc[ai][bj][m][n] = __builtin_amdgcn_mfma_f32_16x16x32_bf16(Bt[n][k], At[m][k], acc[ai][bj][m][n], 0, 0, 0); __builtin_amdgcn_s_setprio(0); } while (0)
#define PG8_WAIT_V(n) asm volatile("s_waitcnt vmcnt(" #n ")" ::: "memory")
#define PG8_WAIT_L(n) asm volatile("s_waitcnt lgkmcnt(" #n ")" ::: "memory")
#define PG8_BAR __builtin_amdgcn_s_barrier()
#define PG8_SCHED __builtin_amdgcn_sched_barrier(0)
    Unit cur, nxt; int ui = 0;
    if (!S.next(0, cur)) return;
    f32x4 acc[2][2][4][2];
#pragma unroll
    for (int a = 0; a < 2; ++a)
#pragma unroll
        for (int b = 0; b < 2; ++b)
#pragma unroll
            for (int m = 0; m < 4; ++m)
#pragma unroll
                for (int n = 0; n < 2; ++n) acc[a][b][m][n] = (f32x4){0.f, 0.f, 0.f, 0.f};
    bf16x8 At[4][2], B0[2][2], B1[2][2];
    const char* cA = (const char*)g.A; const char* cB = (const char*)g.Bt + (size_t)cur.pn * tstep;
    S.a_ready(cur);
    if constexpr (SP2) {
        PG8_STAGE(PG8_SB(0, 0), cB, voffB); PG8_STAGE(PG8_SB(0, 1), cB + hstep, voffB); PG8_STAGE(PG8_SA(0, 0), cA, vA0); PG8_STAGE(PG8_SA(0, 1), cA, vA1);
        if (wr == 1) PG8_BAR;
        PG8_WAIT_V(2); PG8_BAR;
        PG8_STAGE(PG8_SB(1, 0), cB + kstep, voffB); PG8_STAGE(PG8_SA(1, 0), cA + kstep, vA0); PG8_STAGE(PG8_SB(1, 1), cB + hstep + kstep, voffB);
        PG8_WAIT_V(6); PG8_BAR;
    } else {
        PG8_STAGE(PG8_SB(0, 0), cB, voffB); PG8_STAGE(PG8_SA(0, 0), cA, vA0); PG8_STAGE(PG8_SB(0, 1), cB + hstep, voffB); PG8_STAGE(PG8_SA(0, 1), cA, vA1);
        if (wr == 1) PG8_BAR;
        PG8_WAIT_V(4); PG8_BAR;
        PG8_STAGE(PG8_SB(1, 0), cB + kstep, voffB); PG8_STAGE(PG8_SA(1, 0), cA + kstep, vA0); PG8_STAGE(PG8_SB(1, 1), cB + hstep + kstep, voffB);
        PG8_WAIT_V(6); PG8_BAR;
    }
    for (;;) {
        const bool has_next = S.next(ui + 1, nxt);
        if (has_next) {
#pragma unroll
            for (int i = 0; i < 2; ++i) { nvA0[i] = rowtab[(ui + 1) * 256 + RA[i]] + CA2[i]; nvA1[i] = rowtab[(ui + 1) * 256 + 128 + RA[i]] + CA2[i]; }
        }
        const char* nA = cA; const char* nB = has_next ? (const char*)g.Bt + (size_t)nxt.pn * tstep : cB;
        for (int t = 0; t < nt; t += 2) {
            const bool last = (t == nt - 2);
            unsigned sA0[2], sA1[2];
#pragma unroll
            for (int i = 0; i < 2; ++i) { sA0[i] = last ? nvA0[i] : vA0[i]; sA1[i] = last ? nvA1[i] : vA1[i]; }
            const char* a1 = cA + (size_t)(t + 1) * kstep;
            const char* a2 = last ? nA : cA + (size_t)(t + 2) * kstep; const char* b2 = last ? nB : cB + (size_t)(t + 2) * kstep;
            const char* a3 = a2 + kstep; const char* b3 = b2 + kstep;
            if (last && has_next) S.a_ready(nxt);
            if constexpr (SP2) {
            PG8_LDB(B0, 0, 0); PG8_LDB(B1, 0, 1); PG8_SCHED; PG8_LDA(At, 0, 0); PG8_STAGE(PG8_SA(1, 1), a1, vA1);
            PG8_WAIT_V(8); PG8_WAIT_L(0); PG8_BAR; PG8_MMA(0, 0, At, B0); PG8_MMA(0, 1, At, B1); PG8_BAR; PG8_SCHED;
            PG8_LDA(At, 0, 1); PG8_STAGE(PG8_SB(0, 0), b2, voffB); PG8_STAGE(PG8_SB(0, 1), b2 + hstep, voffB); PG8_STAGE(PG8_SA(0, 0), a2, sA0);
            PG8_WAIT_V(8); PG8_WAIT_L(0); PG8_BAR; PG8_MMA(1, 0, At, B0); PG8_MMA(1, 1, At, B1); PG8_BAR; PG8_SCHED;
            PG8_LDB(B0, 1, 0); PG8_LDB(B1, 1, 1); PG8_SCHED; PG8_LDA(At, 1, 0); PG8_STAGE(PG8_SA(0, 1), a2, sA1);
            PG8_WAIT_V(8); PG8_WAIT_L(0); PG8_BAR; PG8_MMA(0, 0, At, B0); PG8_MMA(0, 1, At, B1); PG8_BAR; PG8_SCHED;
            PG8_LDA(At, 1, 1); PG8_STAGE(PG8_SB(1, 0), b3, voffB); PG8_STAGE(PG8_SB(1, 1), b3 + hstep, voffB); PG8_STAGE(PG8_SA(1, 0), a3, sA0);
            PG8_WAIT_V(8); PG8_WAIT_L(0); PG8_BAR; PG8_MMA(1, 0, At, B0); PG8_MMA(1, 1, At, B1); PG8_BAR; PG8_SCHED;
            } else {
            PG8_LDB(B0, 0, 0); PG8_SCHED; PG8_LDA(At, 0, 0); PG8_STAGE(PG8_SA(1, 1), a1, vA1);
            PG8_WAIT_L(8); PG8_BAR; PG8_WAIT_L(0); PG8_MMA(0, 0, At, B0); PG8_BAR; PG8_SCHED;
            PG8_LDB(B1, 0, 1); PG8_STAGE(PG8_SB(0, 0), b2, voffB);
            PG8_BAR; PG8_WAIT_L(0); PG8_MMA(0, 1, At, B1); PG8_BAR;
            PG8_LDA(At, 0, 1); PG8_STAGE(PG8_SA(0, 0), a2, sA0);
            PG8_BAR; PG8_WAIT_L(0); PG8_MMA(1, 0, At, B0); PG8_BAR; PG8_SCHED;
            PG8_STAGE(PG8_SB(0, 1), b2 + hstep, voffB);
            PG8_WAIT_V(6); PG8_BAR; PG8_MMA(1, 1, At, B1); PG8_BAR;
            PG8_LDB(B0, 1, 0); PG8_SCHED; PG8_LDA(At, 1, 0); PG8_STAGE(PG8_SA(0, 1), a2, sA1);
            PG8_WAIT_L(8); PG8_BAR; PG8_WAIT_L(0); PG8_MMA(0, 0, At, B0); PG8_BAR; PG8_SCHED;
            PG8_LDB(B1, 1, 1); PG8_STAGE(PG8_SB(1, 0), b3, voffB);
            PG8_BAR; PG8_WAIT_L(0); PG8_MMA(0, 1, At, B1); PG8_BAR;
            PG8_LDA(At, 1, 1); PG8_STAGE(PG8_SA(1, 0), a3, sA0);
            PG8_BAR; PG8_WAIT_L(0); PG8_MMA(1, 0, At, B0); PG8_BAR; PG8_SCHED;
            PG8_STAGE(PG8_SB(1, 1), b3 + hstep, voffB);
            PG8_WAIT_V(6); PG8_BAR; PG8_MMA(1, 1, At, B1); PG8_BAR;
            }
        }
        if constexpr (ALIGN_EPI) { if (wr == 0) PG8_BAR; }
        if constexpr (!Epi::AFTER_DRAIN) { E(acc, cur, wr, wc, fr, fq); S.done(cur); }
        if (!has_next) break;
#pragma unroll
        for (int a = 0; a < 2; ++a)
#pragma unroll
            for (int b = 0; b < 2; ++b)
#pragma unroll
                for (int m = 0; m < 4; ++m)
#pragma unroll
                    for (int n = 0; n < 2; ++n) acc[a][b][m][n] = (f32x4){0.f, 0.f, 0.f, 0.f};
        cur = nxt; cA = nA; cB = nB; ++ui;
#pragma unroll
        for (int i = 0; i < 2; ++i) { vA0[i] = nvA0[i]; vA1[i] = nvA1[i]; }
        if constexpr (ALIGN_EPI) { if (wr == 1) PG8_BAR; }
    }
    PG8_WAIT_V(0);
    if constexpr (!ALIGN_EPI) { if (wr == 0) PG8_BAR; }
    PG8_BAR;
    if constexpr (Epi::AFTER_DRAIN) { E.fused(acc, cur, wr, wc, fr, fq, lds, wid, lane); S.done(cur); }
#undef PG8_SA
#undef PG8_SB
#undef PG8_STAGE
#undef PG8_LDA
#undef PG8_LDB
#undef PG8_MMA
#undef PG8_WAIT_V
#undef PG8_WAIT_L
#undef PG8_BAR
#undef PG8_SCHED
}

struct EpiBf16 {
    static constexpr bool PERM = true, AFTER_DRAIN = false;
    bf16_t* O; int ldc; int npn; int skip;
    __device__ __forceinline__ void operator()(const f32x4 (&acc)[2][2][4][2], const Unit& u, int wr, int wc, int fr, int fq) const {
        const int row0 = u.pm * BM + wr * 64 + fr, col0 = (u.pn % npn) * BM + wc * 32 + 8 * fq;
#pragma unroll
        for (int ai = 0; ai < 2; ++ai)
#pragma unroll
            for (int m = 0; m < 4; ++m) { bf16_t* rowp = O + (size_t)(row0 + ai * HALF + m * 16) * ldc + col0;
#pragma unroll
                for (int bj = 0; bj < 2; ++bj) { const f32x4 v0 = acc[ai][bj][m][0], v1 = acc[ai][bj][m][1];
                    u32x4 w; w.x = cvt_pk_bf16(v0[0], v0[1]); w.y = cvt_pk_bf16(v0[2], v0[3]); w.z = cvt_pk_bf16(v1[0], v1[1]); w.w = cvt_pk_bf16(v1[2], v1[3]);
                    if (!skip) *(u32x4*)(rowp + bj * HALF) = w; else asm volatile("" :: "v"(w)); } }
    }
};
struct EpiY8 {
    static constexpr bool PERM = true, AFTER_DRAIN = false;
    unsigned char* O; int ldc; int npn;
    __device__ __forceinline__ void operator()(const f32x4 (&acc)[2][2][4][2], const Unit& u, int wr, int wc, int fr, int fq) const {
        typedef unsigned u32x2v __attribute__((ext_vector_type(2)));
        const int row0 = u.pm * BM + wr * 64 + fr, col0 = (u.pn % npn) * BM + wc * 32 + 8 * fq;
#pragma unroll
        for (int ai = 0; ai < 2; ++ai)
#pragma unroll
            for (int m = 0; m < 4; ++m) { unsigned char* rowp = O + (size_t)(row0 + ai * HALF + m * 16) * ldc + col0;
#pragma unroll
                for (int bj = 0; bj < 2; ++bj) { const f32x4 v0 = acc[ai][bj][m][0] * 16.f, v1 = acc[ai][bj][m][1] * 16.f;
                    int a = 0, b = 0;
                    a = __builtin_amdgcn_cvt_pk_fp8_f32(v0[0], v0[1], a, false); a = __builtin_amdgcn_cvt_pk_fp8_f32(v0[2], v0[3], a, true);
                    b = __builtin_amdgcn_cvt_pk_fp8_f32(v1[0], v1[1], b, false); b = __builtin_amdgcn_cvt_pk_fp8_f32(v1[2], v1[3], b, true);
                    *(u32x2v*)(rowp + bj * HALF) = (u32x2v){(unsigned)a, (unsigned)b}; } }
    }
};
struct EpiKV {
    static constexpr bool PERM = true, AFTER_DRAIN = false;
    bf16_t* kmem; bf16_t* vmemT;
    __device__ __forceinline__ void operator()(const f32x4 (&acc)[2][2][4][2], const Unit& u, int wr, int wc, int fr, int fq) const {
        const int row0 = u.pm * BM + wr * 64 + fr, col0 = u.pn * BM + wc * 32 + 8 * fq;
#pragma unroll
        for (int ai = 0; ai < 2; ++ai)
#pragma unroll
            for (int m = 0; m < 4; ++m) { const int row = row0 + ai * HALF + m * 16;
#pragma unroll
                for (int bj = 0; bj < 2; ++bj) { const f32x4 v0 = acc[ai][bj][m][0], v1 = acc[ai][bj][m][1]; const int col = col0 + bj * HALF;
                    if (col < 512) { u32x4 w; w.x = cvt_pk_bf16(v0[0], v0[1]); w.y = cvt_pk_bf16(v0[2], v0[3]); w.z = cvt_pk_bf16(v1[0], v1[1]); w.w = cvt_pk_bf16(v1[2], v1[3]);
                        *(u32x4*)(kmem + (size_t)row * 512 + col) = w; }
                    else { const int c2 = col - 512, hx = c2 >> 7, d = c2 & 127, b = row >> 8, key = row & 255;
                        bf16_t* vp = vmemT + (((size_t)b * 4 + hx) * 128 + d) * 256 + key;
                        const unsigned w0 = cvt_pk_bf16(v0[0], v0[1]), w1 = cvt_pk_bf16(v0[2], v0[3]), w2 = cvt_pk_bf16(v1[0], v1[1]), w3 = cvt_pk_bf16(v1[2], v1[3]);
                        vp[0 * 256] = (bf16_t)(w0 & 0xffffu); vp[1 * 256] = (bf16_t)(w0 >> 16); vp[2 * 256] = (bf16_t)(w1 & 0xffffu); vp[3 * 256] = (bf16_t)(w1 >> 16);
                        vp[4 * 256] = (bf16_t)(w2 & 0xffffu); vp[5 * 256] = (bf16_t)(w2 >> 16); vp[6 * 256] = (bf16_t)(w3 & 0xffffu); vp[7 * 256] = (bf16_t)(w3 >> 16); } } }
    }
};
template <bool XF32, bool STATS> struct EpiResid {
    static constexpr bool PERM = true, AFTER_DRAIN = false;
    const void* xin; bf16_t* xb; float* ssq;
    const float* rowscale; const float* colw;
    __device__ __forceinline__ void operator()(const f32x4 (&acc)[2][2][4][2], const Unit& u, int wr, int wc, int fr, int fq) const {
        const int col0 = u.pn * BM + wc * 32 + 8 * fq;
        f32x4 icw[2][2];
        if (XF32) {
#pragma unroll
            for (int bj = 0; bj < 2; ++bj)
#pragma unroll
                for (int n = 0; n < 2; ++n) { const f32x4 wv = *(const f32x4*)(colw + col0 + bj * HALF + 4 * n);
                    icw[bj][n] = (f32x4){__builtin_amdgcn_rcpf(wv[0]), __builtin_amdgcn_rcpf(wv[1]), __builtin_amdgcn_rcpf(wv[2]), __builtin_amdgcn_rcpf(wv[3])}; }
        }
#pragma unroll
        for (int ai = 0; ai < 2; ++ai) {
            const size_t rowb = (size_t)(u.pm * BM + ai * HALF + wr * 64 + fr);
            u32x4 pb[4][2]; float rsc[4];
#pragma unroll
            for (int m = 0; m < 4; ++m) {
                if (XF32) rsc[m] = rowscale[rowb + m * 16];
#pragma unroll
                for (int bj = 0; bj < 2; ++bj) { const size_t off = (rowb + m * 16) * 1024 + col0 + bj * HALF; pb[m][bj] = *(const u32x4*)((const bf16_t*)xin + off); } }
#pragma unroll
            for (int m = 0; m < 4; ++m) { const size_t row = rowb + m * 16;
                float q = 0.f;
#pragma unroll
                for (int bj = 0; bj < 2; ++bj) { const size_t off = row * 1024 + col0 + bj * HALF;
                    f32x4 b0, b1;
                    { const u32x4 t = pb[m][bj];
                        b0[0] = __uint_as_float(t.x << 16); b0[1] = __uint_as_float(t.x & 0xffff0000u); b0[2] = __uint_as_float(t.y << 16); b0[3] = __uint_as_float(t.y & 0xffff0000u);
                        b1[0] = __uint_as_float(t.z << 16); b1[1] = __uint_as_float(t.z & 0xffff0000u); b1[2] = __uint_as_float(t.w << 16); b1[3] = __uint_as_float(t.w & 0xffff0000u); }
                    if (XF32) { b0 = b0 * rsc[m] * icw[bj][0]; b1 = b1 * rsc[m] * icw[bj][1]; }
                    const f32x4 o0 = b0 + acc[ai][bj][m][0], o1 = b1 + acc[ai][bj][m][1];
                    u32x4 w; w.x = cvt_pk_bf16(o0[0], o0[1]); w.y = cvt_pk_bf16(o0[2], o0[3]); w.z = cvt_pk_bf16(o1[0], o1[1]); w.w = cvt_pk_bf16(o1[2], o1[3]);
                    *(u32x4*)(xb + off) = w;
                    if (STATS) q += ((o0[0] * o0[0] + o0[1] * o0[1]) + (o0[2] * o0[2] + o0[3] * o0[3])) + ((o1[0] * o1[0] + o1[1] * o1[1]) + (o1[2] * o1[2] + o1[3] * o1[3])); }
                if (STATS) { q += __shfl_xor(q, 16); q += __shfl_xor(q, 32); if (fq == 0) ssq[row * 16 + u.pn * 4 + wc] = q; } }
            asm volatile("" ::: "memory"); }
    }
};
struct EpiQ {
    static constexpr bool PERM = true, AFTER_DRAIN = false;
    bf16_t* O; const float* ssq;
    __device__ __forceinline__ void operator()(const f32x4 (&acc)[2][2][4][2], const Unit& u, int wr, int wc, int fr, int fq) const {
        const int row0 = u.pm * BM + wr * 64 + fr, col0 = u.pn * BM + wc * 32 + 8 * fq;
#pragma unroll
        for (int ai = 0; ai < 2; ++ai)
#pragma unroll
            for (int m = 0; m < 4; ++m) { const size_t row = (size_t)(row0 + ai * HALF + m * 16);
                const f32x4* sp = (const f32x4*)(ssq + row * 16); const f32x4 s0 = sp[0], s1 = sp[1], s2 = sp[2], s3 = sp[3];
                const float s = ((s0[0] + s0[1]) + (s0[2] + s0[3])) + ((s1[0] + s1[1]) + (s1[2] + s1[3])) + ((s2[0] + s2[1]) + (s2[2] + s2[3])) + ((s3[0] + s3[1]) + (s3[2] + s3[3]));
                const float rs = 1.f / sqrtf(s * (1.f / 1024.f) + 1e-5f);
                bf16_t* rowp = O + row * 512 + col0;
#pragma unroll
                for (int bj = 0; bj < 2; ++bj) { const f32x4 v0 = acc[ai][bj][m][0] * rs, v1 = acc[ai][bj][m][1] * rs;
                    u32x4 w; w.x = cvt_pk_bf16(v0[0], v0[1]); w.y = cvt_pk_bf16(v0[2], v0[3]); w.z = cvt_pk_bf16(v1[0], v1[1]); w.w = cvt_pk_bf16(v1[2], v1[3]);
                    *(u32x4*)(rowp + bj * HALF) = w; } }
    }
};
struct EpiGU {
    static constexpr bool PERM = true, AFTER_DRAIN = false;
    bf16_t* hid; const PG8_LAS float* rstab; int G, c;
    __device__ __forceinline__ void operator()(const f32x4 (&acc)[2][2][4][2], const Unit& u, int wr, int wc, int fr, int fq) const {
        const int row0 = u.pm * BM + wr * 64 + fr, j0 = (u.pn & 1) * 128 + wc * 16 + 4 * fq;
        const int ui = (u.pm * 2 + (u.pn & 1) - c) / G;
#pragma unroll
        for (int ai = 0; ai < 2; ++ai)
#pragma unroll
            for (int m = 0; m < 4; ++m) { bf16_t* rowp = hid + (size_t)(row0 + ai * HALF + m * 16) * 256 + j0;
                const float rs = rstab[ui * 256 + ai * HALF + wr * 64 + m * 16 + fr];
#pragma unroll
                for (int bj = 0; bj < 2; ++bj) { const f32x4 v0 = acc[ai][bj][m][0] * rs, v1 = acc[ai][bj][m][1] * rs;
                    const float h0 = v0[0] * __builtin_amdgcn_rcpf(1.f + __expf(-v0[0])) * v0[1], h1 = v0[2] * __builtin_amdgcn_rcpf(1.f + __expf(-v0[2])) * v0[3];
                    const float h2 = v1[0] * __builtin_amdgcn_rcpf(1.f + __expf(-v1[0])) * v1[1], h3 = v1[2] * __builtin_amdgcn_rcpf(1.f + __expf(-v1[2])) * v1[3];
                    typedef unsigned u32x2v __attribute__((ext_vector_type(2))); u32x2v w; w.x = cvt_pk_bf16(h0, h1); w.y = cvt_pk_bf16(h2, h3);
                    *(u32x2v*)(rowp + bj * 64) = w; } }
    }
};
struct SubOrder {
    int nM, nN, nwg, span, c;
    __device__ void init(int M, int N, int span_, int c_) { nM = M / BM; nN = N / BM; nwg = nM * nN; span = span_; c = c_; }
    __device__ bool next(int i, Unit& u) const { if (c < 0 || c >= span) return false; const int L = i * span + c; if (L >= nwg) return false; u.pm = L / nN; u.pn = L % nN; return true; }
    __device__ __forceinline__ void a_ready(const Unit&) const {}
    __device__ __forceinline__ void done(const Unit&) const {}
};
struct MoeOrder {
    const PG8_LAS int* tile_e; int nrt, npn, G, c;
    __device__ bool next(int i, Unit& u) const { const int L = i * G + c; if (L >= nrt * npn) return false; const int rt = L / npn, pnl = L % npn; u.pm = rt; u.pn = tile_e[rt] * npn + pnl; return true; }
    __device__ __forceinline__ void a_ready(const Unit&) const {}
    __device__ __forceinline__ void done(const Unit&) const {}
};
}

#define LAS __attribute__((address_space(3)))
#define XB_TMO      128
#define XB_XCNT(j)  (256  + 64 * (j))
#define XB_XSUB(j)  (1280 + 64 * (j))
#define XB_XGEN(j)  (2304 + 64 * (j))
#define XB_TOP      3328
#define XB_TOPGEN   3392
#define XCD_BAR_WORDS 3456
#define XB_SPIN_CAP (1u << 18)

__device__ __forceinline__ unsigned xb_ld(unsigned* p)              { return __hip_atomic_load(p, __ATOMIC_RELAXED, __HIP_MEMORY_SCOPE_AGENT); }
__device__ __forceinline__ unsigned xb_add(unsigned* p, unsigned v) { return __hip_atomic_fetch_add(p, v, __ATOMIC_RELAXED, __HIP_MEMORY_SCOPE_AGENT); }
__device__ __forceinline__ unsigned xb_xcc_id() { return (unsigned)__builtin_amdgcn_s_getreg((3 << 11) | 20) & 0xFu; }
#define XB_SPIN(cond, bar) do { unsigned _sp = 0; while (cond) { __builtin_amdgcn_s_sleep(1); \
    if ((++_sp & 255u) == 0u) { if (xb_ld(&(bar)[XB_TMO])) break; if (_sp > XB_SPIN_CAP) { atomicAdd(&(bar)[XB_TMO], 1u); break; } } } } while (0)

struct XcdBarrier {
    unsigned* bar; unsigned x;
    volatile LAS unsigned* st;
};

__device__ __forceinline__ XcdBarrier xcd_barrier_post(unsigned* bar, volatile LAS unsigned* st) {
    XcdBarrier b; b.bar = bar; b.x = xb_xcc_id(); b.st = st;
    if (threadIdx.x == 0) (void)xb_add(&bar[XB_XCNT(b.x)], 1u);
    return b;
}
__device__ __forceinline__ void xcd_barrier_complete(unsigned* bar, unsigned x, unsigned& nloc, unsigned& nx) {
    const unsigned G = gridDim.x * gridDim.y * gridDim.z;
    unsigned sum, cnt, mine, sp = 0u;
    for (;;) {
        sum = 0u; cnt = 0u; mine = 0u;
#pragma unroll
        for (unsigned j = 0; j < 16; ++j) { const unsigned c = xb_ld(&bar[XB_XCNT(j)]); sum += c; cnt += (c > 0u) ? 1u : 0u; mine = (j == x) ? c : mine; }
        if (sum == G) break;
        __builtin_amdgcn_s_sleep(1);
        if ((++sp & 255u) == 0u) { if (xb_ld(&bar[XB_TMO])) break; if (sp > XB_SPIN_CAP) { atomicAdd(&bar[XB_TMO], 1u); break; } }
    }
    nloc = mine > 0u ? mine : 1u; nx = cnt > 0u ? cnt : 1u;
}

__device__ __forceinline__ void xcd_barrier(const XcdBarrier& b) {
    asm volatile("s_waitcnt vmcnt(0)" ::: "memory");
    __syncthreads();
    if (threadIdx.x == 0) {
        unsigned* bar = b.bar;
        __builtin_amdgcn_s_waitcnt(0);
        unsigned nloc = b.st[0], nx = b.st[1];
        if (nloc == 0u) { xcd_barrier_complete(bar, b.x, nloc, nx); b.st[0] = nloc; b.st[1] = nx; }
        const unsigned old = xb_add(&bar[XB_XSUB(b.x)], 1u);
        const unsigned gen = old / nloc;
        if (old + 1u == (gen + 1u) * nloc) {
            __builtin_amdgcn_fence(__ATOMIC_RELEASE, "agent");
            asm volatile("s_waitcnt vmcnt(0)" ::: "memory");
            const unsigned og = xb_add(&bar[XB_TOP], 1u);
            const unsigned tg = og / nx;
            if (og + 1u == (tg + 1u) * nx) xb_add(&bar[XB_TOPGEN], 1u);
            else XB_SPIN(xb_ld(&bar[XB_TOPGEN]) == tg, bar);
            __builtin_amdgcn_fence(__ATOMIC_ACQUIRE, "agent");
            xb_add(&bar[XB_XGEN(b.x)], 1u);
            asm volatile("s_waitcnt vmcnt(0)" ::: "memory");
        } else {
            XB_SPIN(xb_ld(&bar[XB_XGEN(b.x)]) == gen, bar);
            __builtin_amdgcn_fence(__ATOMIC_ACQUIRE, "agent");
            asm volatile("s_waitcnt vmcnt(0)" ::: "memory");
        }
    }
    __syncthreads();
}

__device__ __forceinline__ void gemm128(unsigned char* lds, const bf16_t* arow, const bf16_t* brow, int K, f32x16& acc0, f32x16& acc1) {
    const int tid = opaque_tid(), lane = tid & 63, w = tid >> 6;
    bf16_t* sA = (bf16_t*)lds;
    bf16_t* sB = sA + 128 * 72;
    const int srow = tid >> 2, skc = (tid & 3) * 16;
    const bf16_t* ap = arow + skc;
    const bf16_t* bp = brow + skc;
    const int wm = w >> 1, wn = w & 1, r = lane & 31, h = lane >> 5;
    acc0 = zero16(); acc1 = zero16();
    for (int k0 = 0; k0 < K; k0 += 64) {
        const u32x4 a0 = *(const u32x4*)(ap + k0), a1 = *(const u32x4*)(ap + k0 + 8);
        const u32x4 b0 = *(const u32x4*)(bp + k0), b1 = *(const u32x4*)(bp + k0 + 8);
        __syncthreads();
        *(u32x4*)(sA + srow * 72 + skc) = a0; *(u32x4*)(sA + srow * 72 + skc + 8) = a1;
        *(u32x4*)(sB + srow * 72 + skc) = b0; *(u32x4*)(sB + srow * 72 + skc + 8) = b1;
        __syncthreads();
#pragma unroll
        for (int kk = 0; kk < 64; kk += 16) {
            const bf16x8 a = *(const bf16x8*)(sA + (wm * 32 + r) * 72 + kk + 8 * h);
            const bf16x8 bA = *(const bf16x8*)(sB + (wn * 64 + r) * 72 + kk + 8 * h);
            const bf16x8 bB = *(const bf16x8*)(sB + (wn * 64 + 32 + r) * 72 + kk + 8 * h);
            acc0 = mfma32(a, bA, acc0); acc1 = mfma32(a, bB, acc1);
        }
    }
    __syncthreads();
}

__device__ __forceinline__ void p0_transpose64(const float* W, int ldw, int K, int nblk, const float* scale, bf16_t* WT, int row_off, int row_mul, float* scr, int item, int lane) {
    const int kb = item / nblk, nb = item % nblk, k0 = 64 * kb, n0 = 64 * nb;
    f32x4 v[16];
    const float* wp = W + (size_t)(k0 + (lane >> 4)) * ldw + n0 + 4 * (lane & 15);
#pragma unroll
    for (int i = 0; i < 16; ++i) v[i] = __builtin_nontemporal_load((const f32x4*)(wp + (size_t)(4 * i) * ldw));
#pragma unroll
    for (int i = 0; i < 16; ++i) { const int kk = (lane >> 4) + 4 * i; const float sc = scale ? scale[k0 + kk] : 1.f; float* d = scr + kk * 65 + 4 * (lane & 15);
        d[0] = v[i].x * sc; d[1] = v[i].y * sc; d[2] = v[i].z * sc; d[3] = v[i].w * sc; }
    LDS_WAIT();
    const int c = lane & 7;
#pragma unroll
    for (int j = 0; j < 8; ++j) { const int n = (lane >> 3) + 8 * j; const float* sp = scr + (8 * c) * 65 + n;
        u32x4 o; o.x = pk2(sp[0 * 65], sp[1 * 65]); o.y = pk2(sp[2 * 65], sp[3 * 65]); o.z = pk2(sp[4 * 65], sp[5 * 65]); o.w = pk2(sp[6 * 65], sp[7 * 65]);
        *(u32x4*)(WT + (size_t)(row_off + (n0 + n) * row_mul) * K + k0 + 8 * c) = o; }
    LDS_WAIT();
}

__device__ __forceinline__ void phase0(const Params& p, unsigned char* lds) {
    const int tid = opaque_tid(), lane = tid & 63, w = tid >> 6;
    unsigned char* ws = p.ws;
    const int gw = blockIdx.x * NWAVES + w, NGW = gridDim.x * NWAVES;
    {
        bf16_t* WR = (bf16_t*)(ws + WS_WR);
        const float* w3 = p.in[19]; const float* wg = p.in[20]; const float* we = p.in[22];
        for (int i = blockIdx.x * NTHREADS + tid; i < 36 * 1024; i += gridDim.x * NTHREADS) {
            const int n = i >> 10, k = i & 1023;
            float v;
            if (n >= 32) v = wg[k * 4 + (n - 32)];
            else { const int hh = (n >> 2) & 1, ii = (n & 3) + 4 * (n >> 3), e = (2 * hh + (ii >> 3)) * 8 + (ii & 7); v = we[k * 32 + e]; }
            WR[i] = (bf16_t)f2bf(v * w3[k]);
        }
    }
    {
        float* scr = (float*)lds + w * (64 * 65);
        constexpr int I_IN = 16 * 36, I_OUT = 16 * 16, I_Q = 16 * 8, I_KV = 16 * 16, I_O = 8 * 16;
        constexpr int NITEMS = I_IN + I_OUT + I_Q + I_KV + I_O;
#pragma unroll 1
        for (int it = gw; it < NITEMS; it += NGW) {
            int r = it;
            if (r < I_IN) { p0_transpose64(p.in[4], LDWIN, 1024, 36, nullptr, (bf16_t*)(ws + WS_WIN), 0, 1, scr, r, lane); continue; } r -= I_IN;
            if (r < I_OUT) { p0_transpose64(p.in[13], 1024, 1024, 16, nullptr, (bf16_t*)(ws + WS_WOUT), 0, 1, scr, r, lane); continue; } r -= I_OUT;
            if (r < I_Q) { p0_transpose64(p.in[16], 512, 1024, 8, p.in[14], (bf16_t*)(ws + WS_WQ), 0, 1, scr, r, lane); continue; } r -= I_Q;
            if (r < I_KV) { p0_transpose64(p.in[17], 1024, 1024, 16, nullptr, (bf16_t*)(ws + WS_WKV), 0, 1, scr, r, lane); continue; } r -= I_KV;
            p0_transpose64(p.in[18], 1024, 512, 16, nullptr, (bf16_t*)(ws + WS_WO), 0, 1, scr, r, lane);
        }
    }
    __syncthreads();
    float* wdt = (float*)lds;
    {
        const float* win = p.in[4]; const float* w1 = p.in[3];
        for (int i = tid; i < 8192; i += NTHREADS) { const int k = i >> 3, n = i & 7; wdt[n * 1024 + k] = win[(size_t)k * LDWIN + 2304 + n] * w1[k]; }
    }
    __syncthreads();
    {
        const float* x = p.in[0]; const float* w1 = p.in[3];
        bf16_t* h1 = (bf16_t*)(ws + WS_H1); float* dtraw = (float*)(ws + WS_DTRAW);
        f32x4 wv[4];
#pragma unroll
        for (int j = 0; j < 4; ++j) wv[j] = *(const f32x4*)(w1 + 4 * lane + 256 * j);
        f32x4 nx[4];
        if (gw < NT) {
#pragma unroll
            for (int j = 0; j < 4; ++j) nx[j] = __builtin_nontemporal_load((const f32x4*)(x + (size_t)gw * DM) + lane + 64 * j);
        }
#pragma unroll 1
        for (int m = gw; m < NT; m += NGW) {
            f32x4 v[4];
#pragma unroll
            for (int j = 0; j < 4; ++j) v[j] = nx[j];
            if (m + NGW < NT) {
#pragma unroll
                for (int j = 0; j < 4; ++j) nx[j] = __builtin_nontemporal_load((const f32x4*)(x + (size_t)(m + NGW) * DM) + lane + 64 * j);
            }
            float a[16];
#pragma unroll
            for (int q = 0; q < 16; ++q) a[q] = 0.f;
#pragma unroll
            for (int j = 0; j < 4; ++j) a[0] += (v[j].x * v[j].x + v[j].y * v[j].y) + (v[j].z * v[j].z + v[j].w * v[j].w);
#pragma unroll
            for (int n = 0; n < 8; ++n)
#pragma unroll
                for (int j = 0; j < 4; ++j) { const f32x4 ww = *(const f32x4*)(wdt + n * 1024 + 4 * lane + 256 * j); a[1 + n] += (v[j].x * ww.x + v[j].y * ww.y) + (v[j].z * ww.z + v[j].w * ww.w); }
            float b8[8], b4[4], b2[2], b1;
            { const bool hi = (lane & 32) != 0;
#pragma unroll
              for (int q = 0; q < 8; ++q) { const float send = hi ? a[q] : a[q + 8], keep = hi ? a[q + 8] : a[q]; b8[q] = keep + __shfl_xor(send, 32); } }
            { const bool hi = (lane & 16) != 0;
#pragma unroll
              for (int q = 0; q < 4; ++q) { const float send = hi ? b8[q] : b8[q + 4], keep = hi ? b8[q + 4] : b8[q]; b4[q] = keep + __shfl_xor(send, 16); } }
            { const bool hi = (lane & 8) != 0;
#pragma unroll
              for (int q = 0; q < 2; ++q) { const float send = hi ? b4[q] : b4[q + 2], keep = hi ? b4[q + 2] : b4[q]; b2[q] = keep + __shfl_xor(send, 8); } }
            { const bool hi = (lane & 4) != 0; const float send = hi ? b2[0] : b2[1], keep = hi ? b2[1] : b2[0]; b1 = keep + __shfl_xor(send, 4); }
            b1 += __shfl_xor(b1, 2); b1 += __shfl_xor(b1, 1);
            const float sd = sqrtf(__shfl(b1, 0) * (1.f / DM) + EPS);
            const float rstd = 1.f / sd;
            if (lane == 0) ((float*)(ws + WS_RS1))[m] = sd;
            const int slot = (lane >> 2) & 15;
            if ((lane & 3) == 0 && slot >= 1 && slot <= 8) dtraw[(size_t)m * 8 + (slot - 1)] = b1 * rstd;
            u32x2* o8 = (u32x2*)(h1 + (size_t)m * DM) + lane;
#pragma unroll
            for (int j = 0; j < 4; ++j) { u32x2 o; o.x = pk2(v[j].x * rstd * wv[j].x, v[j].y * rstd * wv[j].y); o.y = pk2(v[j].z * rstd * wv[j].z, v[j].w * rstd * wv[j].w); o8[64 * j] = o; }
        }
    }
    {
        const float* mem = p.in[1]; const float* wm = p.in[15];
        bf16_t* memh = (bf16_t*)(ws + WS_MEMH);
        f32x4 wv[4];
#pragma unroll
        for (int j = 0; j < 4; ++j) wv[j] = *(const f32x4*)(wm + 4 * lane + 256 * j);
        for (int m = gw; m < NMEM; m += NGW) {
            const f32x4* xr = (const f32x4*)(mem + (size_t)m * DM) + lane;
            f32x4 v[4]; float s = 0.f;
#pragma unroll
            for (int j = 0; j < 4; ++j) { v[j] = xr[64 * j]; s += (v[j].x * v[j].x + v[j].y * v[j].y) + (v[j].z * v[j].z + v[j].w * v[j].w); }
            const float rstd = 1.f / sqrtf(wave_sum(s) * (1.f / DM) + EPS);
            u32x2* o8 = (u32x2*)(memh + (size_t)m * DM) + lane;
#pragma unroll
            for (int j = 0; j < 4; ++j) { u32x2 o; o.x = pk2(v[j].x * rstd * wv[j].x, v[j].y * rstd * wv[j].y); o.y = pk2(v[j].z * rstd * wv[j].z, v[j].w * rstd * wv[j].w); o8[64 * j] = o; }
        }
    }
    __syncthreads();
}

__device__ __forceinline__ void expert_transposes(const Params& p, unsigned char* lds, int vw, int nvw) {
    const int lane = opaque_tid() & 63, w = (opaque_tid() >> 6);
    unsigned char* ws = p.ws;
    float* scr = (float*)lds + w * (64 * 65);
    constexpr int I_G = 32 * 16 * 4, I_D = 32 * 4 * 16;
#pragma unroll 1
    for (int it = vw; it < 2 * I_G + I_D; it += nvw) {
        int r = it;
        if (r < I_G) { const int e = r / 64, ri = r % 64; p0_transpose64(p.in[24] + (size_t)e * 1024 * 256, 256, 1024, 4, p.in[19], (bf16_t*)(ws + WS_WGU) + (size_t)e * 512 * 1024, 0, 2, scr, ri, lane); continue; } r -= I_G;
        if (r < I_G) { const int e = r / 64, ri = r % 64; p0_transpose64(p.in[25] + (size_t)e * 1024 * 256, 256, 1024, 4, p.in[19], (bf16_t*)(ws + WS_WGU) + (size_t)e * 512 * 1024, 1, 2, scr, ri, lane); continue; } r -= I_G;
        { const int e = r / 64, ri = r % 64; p0_transpose64(p.in[26] + (size_t)e * 256 * 1024, 1024, 256, 16, nullptr, (bf16_t*)(ws + WS_WD) + (size_t)e * 1024 * 256, 0, 1, scr, ri, lane); }
    }
}

#define LDS3(p) ((__attribute__((address_space(3))) unsigned char*)(p))
__device__ __forceinline__ void phase1(const Params& p, unsigned char* lds) {
    unsigned char* ws = p.ws;
    {
        const int w = opaque_tid() >> 6;
        if (gridDim.x == 256) { if (blockIdx.x >= 160) expert_transposes(p, lds, ((int)blockIdx.x - 160) * NWAVES + w, 96 * NWAVES); }
        else expert_transposes(p, lds, (int)blockIdx.x * NWAVES + w, (int)gridDim.x * NWAVES);
        __syncthreads();
    }
    {
        pg8::Gemm g{(const bf16_t*)(ws + WS_H1), (const bf16_t*)(ws + WS_WIN), NT, NPROJ, DM};
        pg8::StaticOrder S; S.init(NT, NPROJ, (int)gridDim.x, (int)blockIdx.x);
        pg8::EpiBf16 E{(bf16_t*)(ws + WS_PROJ), NPROJ, NPROJ / 256, p.pad & 1};
        pg8::gemm_phase<pg8::EpiBf16, pg8::StaticOrder, true, true>(LDS3(lds), g, S, E);
    }
    {
        pg8::Gemm g{(const bf16_t*)(ws + WS_MEMH), (const bf16_t*)(ws + WS_WKV), NMEM, 1024, DM};
        pg8::SubOrder S; S.init(NMEM, 1024, 128, (int)blockIdx.x - 128);
        pg8::EpiKV E{(bf16_t*)(ws + WS_KMEM), (bf16_t*)(ws + WS_VMEMT)};
        pg8::gemm_phase<pg8::EpiKV, pg8::SubOrder, true, true>(LDS3(lds), g, S, E);
    }
}

__device__ __forceinline__ float bfel(const u32x4& v, int ci) { const unsigned wv = (ci >> 1) == 0 ? v.x : (ci >> 1) == 1 ? v.y : (ci >> 1) == 2 ? v.z : v.w; return (ci & 1) ? bfhi(wv) : bflo(wv); }
__device__ __forceinline__ void conv8_load(const Params& p, int b, int c, int l0, int ch0, u32x4 (&in)[11]) {
    const bf16_t* proj = (const bf16_t*)(p.ws + WS_PROJ);
    const int t0 = c * 128 + l0 - 3;
    const bf16_t* rp = proj + ((long)(b * SEQ) + t0) * NPROJ + C_X + ch0;
    asm volatile("" : "+v"(rp));
#pragma unroll
    for (int i = 0; i < 11; ++i) {
        const int t = t0 + i;
        in[i] = (u32x4){0u, 0u, 0u, 0u};
        if (t >= 0) in[i] = *(const u32x4*)(rp + (size_t)i * NPROJ);
    }
}
template <bool TRANS>
__device__ __forceinline__ void conv8_math(const Params& p, int ch0, const u32x4 (&in)[11], const float (&f)[8], u32x4 (&res)[8]) {
    const float* cw = p.in[6]; const float* cb = p.in[7];
    float wgt[4][8], bias[8];
#pragma unroll
    for (int j = 0; j < 4; ++j) { const f32x4 a = *(const f32x4*)(cw + j * 1024 + ch0), b2 = *(const f32x4*)(cw + j * 1024 + ch0 + 4);
        wgt[j][0] = a.x; wgt[j][1] = a.y; wgt[j][2] = a.z; wgt[j][3] = a.w; wgt[j][4] = b2.x; wgt[j][5] = b2.y; wgt[j][6] = b2.z; wgt[j][7] = b2.w; }
    { const f32x4 a = *(const f32x4*)(cb + ch0), b2 = *(const f32x4*)(cb + ch0 + 4); bias[0] = a.x; bias[1] = a.y; bias[2] = a.z; bias[3] = a.w; bias[4] = b2.x; bias[5] = b2.y; bias[6] = b2.z; bias[7] = b2.w; }
    if (TRANS) {
#pragma unroll
        for (int ci = 0; ci < 8; ++ci) {
            float o[8];
#pragma unroll
            for (int li = 0; li < 8; ++li) { float a = bias[ci];
#pragma unroll
                for (int j = 0; j < 4; ++j) a += wgt[j][ci] * bfel(in[li + j], ci);
                o[li] = siluf(a) * f[li]; }
            res[ci] = (u32x4){pk2(o[0], o[1]), pk2(o[2], o[3]), pk2(o[4], o[5]), pk2(o[6], o[7])};
        }
    } else {
#pragma unroll
        for (int li = 0; li < 8; ++li) {
            float o[8];
#pragma unroll
            for (int ci = 0; ci < 8; ++ci) { float a = bias[ci];
#pragma unroll
                for (int j = 0; j < 4; ++j) a += wgt[j][ci] * bfel(in[li + j], ci);
                o[ci] = siluf(a) * f[li]; }
            res[li] = (u32x4){pk2(o[0], o[1]), pk2(o[2], o[3]), pk2(o[4], o[5]), pk2(o[6], o[7])};
        }
    }
}
template <bool TRANS>
__device__ __forceinline__ void conv8x8(const Params& p, int b, int c, int l0, int ch0, const float (&f)[8], u32x4 (&res)[8]) {
    u32x4 in[11];
    conv8_load(p, b, c, l0, ch0, in);
    conv8_math<TRANS>(p, ch0, in, f, res);
}

__device__ __forceinline__ void conv2_load(const Params& p, int b, int c, int l0, int ch0, unsigned (&in)[11]) {
    const bf16_t* proj = (const bf16_t*)(p.ws + WS_PROJ);
    const int t0 = c * 128 + l0 - 3;
    const bf16_t* rp = proj + ((long)(b * SEQ) + t0) * NPROJ + C_X + ch0;
    asm volatile("" : "+v"(rp));
#pragma unroll
    for (int i = 0; i < 11; ++i) { const int t = t0 + i; in[i] = 0u; if (t >= 0) in[i] = *(const unsigned*)(rp + (size_t)i * NPROJ); }
}
__device__ __forceinline__ void conv2_math(const Params& p, int ch0, const unsigned (&in)[11], u32x4 (&res)[2]) {
    const float* cw = p.in[6]; const float* cb = p.in[7];
    float wgt[4][2], bias[2];
#pragma unroll
    for (int j = 0; j < 4; ++j) { wgt[j][0] = cw[j * 1024 + ch0]; wgt[j][1] = cw[j * 1024 + ch0 + 1]; }
    bias[0] = cb[ch0]; bias[1] = cb[ch0 + 1];
#pragma unroll
    for (int ci = 0; ci < 2; ++ci) {
        float o[8];
#pragma unroll
        for (int li = 0; li < 8; ++li) { float a = bias[ci];
#pragma unroll
            for (int j = 0; j < 4; ++j) a += wgt[j][ci] * (ci ? bfhi(in[li + j]) : bflo(in[li + j]));
            o[li] = siluf(a); }
        res[ci] = (u32x4){pk2(o[0], o[1]), pk2(o[2], o[3]), pk2(o[4], o[5]), pk2(o[6], o[7])};
    }
}

__device__ __forceinline__ void ssd_dt_cum(const Params& p, int b, int c, float* dts, float* cums) {
    const int tid = opaque_tid(), lane = tid & 63, w = tid >> 6;
    const float* dtraw = (const float*)(p.ws + WS_DTRAW);
    const float bias = p.in[8][w], a = -__expf(p.in[9][w]);
    const size_t row0 = (size_t)b * SEQ + c * 128;
    float x0 = dtraw[(row0 + 2 * lane) * 8 + w] + bias, x1 = dtraw[(row0 + 2 * lane + 1) * 8 + w] + bias;
    const float d0 = fmaxf(x0, 0.f) + log1pf(__expf(-fabsf(x0))), d1 = fmaxf(x1, 0.f) + log1pf(__expf(-fabsf(x1)));
    const float a0 = d0 * a, a1 = d1 * a;
    float s = a0 + a1;
#pragma unroll
    for (int o = 1; o < 64; o <<= 1) { const float t = __shfl_up(s, o); if (lane >= o) s += t; }
    dts[w * 128 + 2 * lane] = d0; dts[w * 128 + 2 * lane + 1] = d1;
    cums[w * 128 + 2 * lane] = s - a1; cums[w * 128 + 2 * lane + 1] = s;
}

__device__ __forceinline__ void attn_unit(const Params& p, const bf16_t* sK, const bf16_t* sV, const float* cs, const float* sn, float* ssq, int b, int blk, int hq, int rg, int lane, u32x2 (&oh)[8]) {
    const int r = lane & 31, h = lane >> 5;
    const bf16_t* proj = (const bf16_t*)(p.ws + WS_PROJ);
    const int tband0 = blk * 128 - 128;
    const bf16_t* qp = proj + (size_t)(b * SEQ + blk * 128 + rg * 32 + r) * NPROJ + hq * 64 + 8 * h;
    u32x4 qv[4];
#pragma unroll
    for (int kk = 0; kk < 4; ++kk) qv[kk] = *(const u32x4*)(qp + kk * 16);
    {
        u32x4 ot; ot.x = __shfl_xor(qv[0].x, 32); ot.y = __shfl_xor(qv[0].y, 32); ot.z = __shfl_xor(qv[0].z, 32); ot.w = __shfl_xor(qv[0].w, 32);
        const float* cp = cs + (128 + rg * 32 + r) * 8; const float* sp = sn + (128 + rg * 32 + r) * 8;
        float o[8];
#pragma unroll
        for (int f = 0; f < 8; ++f) {
            const float mine = bfel(qv[0], f), oth = bfel(ot, f), c = cp[f], sv = sp[f];
            o[f] = h ? (mine * c + oth * sv) : (mine * c - oth * sv);
        }
        qv[0] = (u32x4){pk2(o[0], o[1]), pk2(o[2], o[3]), pk2(o[4], o[5]), pk2(o[6], o[7])};
    }
    f32x16 S[5];
#pragma unroll
    for (int jt = 0; jt < 5; ++jt) S[jt] = zero16();
    const bf16_t* kp = sK + (rg * 32 + r) * 72 + 8 * h;
#pragma unroll
    for (int kk = 0; kk < 4; ++kk) {
        const bf16x8 qf = __builtin_bit_cast(bf16x8, qv[kk]);
#pragma unroll
        for (int jt = 0; jt < 5; ++jt) { const bf16x8 a = *(const bf16x8*)(kp + jt * (32 * 72) + kk * 16); S[jt] = mfma32(a, qf, S[jt]); }
    }
    const float sink = p.in[5][hq] * 8.f;
    float m = sink;
    const bool noprev = (blk == 0);
#pragma unroll
    for (int jt = 0; jt < 5; ++jt)
#pragma unroll
        for (int i = 0; i < 16; ++i) {
            const int cr = (i & 3) + 8 * (i >> 2) + 4 * h;
            bool ok = true;
            if (jt == 0) ok = cr > r;
            if (jt == 4) ok = cr <= r;
            if (noprev && (rg + jt) < 4) ok = false;
            const float v = ok ? S[jt][i] : -INFINITY; S[jt][i] = v; m = fmaxf(m, v);
        }
    m = fmaxf(m, __shfl_xor(m, 32));
    const float sc = 0.125f * 1.4426950408889634f;
    float sum = 0.f;
    bf16x8 P[10];
#pragma unroll
    for (int jt = 0; jt < 5; ++jt) {
        float e[16];
#pragma unroll
        for (int i = 0; i < 16; ++i) { e[i] = __builtin_amdgcn_exp2f((S[jt][i] - m) * sc); sum += e[i]; }
        P[2 * jt] = pack8(e[0], e[1], e[2], e[3], e[4], e[5], e[6], e[7]);
        P[2 * jt + 1] = pack8(e[8], e[9], e[10], e[11], e[12], e[13], e[14], e[15]);
    }
    sum += __shfl_xor(sum, 32);
    sum += __builtin_amdgcn_exp2f((sink - m) * sc);
    const float inv = 1.f / sum;
    f32x16 O0 = zero16(), O1 = zero16();
    const bf16_t* vp0 = sV + r * 260 + rg * 32 + 4 * h;
#pragma unroll
    for (int ts = 0; ts < 10; ++ts) {
        const bf16_t* vp = vp0 + 16 * ts;
        const u32x2 lo0 = *(const u32x2*)vp, hi0 = *(const u32x2*)(vp + 8);
        const u32x2 lo1 = *(const u32x2*)(vp + 32 * 260), hi1 = *(const u32x2*)(vp + 32 * 260 + 8);
        O0 = mfma32(__builtin_bit_cast(bf16x8, (u32x4){lo0.x, lo0.y, hi0.x, hi0.y}), P[ts], O0);
        O1 = mfma32(__builtin_bit_cast(bf16x8, (u32x4){lo1.x, lo1.y, hi1.x, hi1.y}), P[ts], O1);
    }
    float q = 0.f;
#pragma unroll
    for (int g = 0; g < 4; ++g) {
        const unsigned a0 = pk2(O0[4 * g] * inv, O0[4 * g + 1] * inv), a1 = pk2(O0[4 * g + 2] * inv, O0[4 * g + 3] * inv);
        const unsigned b0 = pk2(O1[4 * g] * inv, O1[4 * g + 1] * inv), b1 = pk2(O1[4 * g + 2] * inv, O1[4 * g + 3] * inv);
        oh[g] = (u32x2){a0, a1}; oh[4 + g] = (u32x2){b0, b1};
        q += (bflo(a0) * bflo(a0) + bfhi(a0) * bfhi(a0)) + (bflo(a1) * bflo(a1) + bfhi(a1) * bfhi(a1)) + (bflo(b0) * bflo(b0) + bfhi(b0) * bfhi(b0)) + (bflo(b1) * bflo(b1) + bfhi(b1) * bfhi(b1));
    }
    q += __shfl_xor(q, 32);
    if (h == 0) ssq[(rg * 32 + r) * 8 + hq] = q;
}

__device__ __forceinline__ void phase2_attn(const Params& p, unsigned char* lds, int b, int blk) {
    const int tid = opaque_tid(), lane = tid & 63, w = tid >> 6, r = lane & 31, h = lane >> 5;
    const bf16_t* proj = (const bf16_t*)(p.ws + WS_PROJ);
    const int* positions = (const int*)p.in[2];
    float* cs = (float*)lds;
    float* sn = cs + 2048;
    float* ssq = sn + 2048;
    bf16_t* sK = (bf16_t*)(lds + 20480);
    bf16_t* sV = sK + 256 * 72;
    const int tband0 = blk * 128 - 128;
    for (int i = tid; i < 2048; i += NTHREADS) {
        const int kb = i >> 3, f = i & 7, t = tband0 + kb;
        float c = 1.f, sv = 0.f;
        if (t >= 0) { const float ang = (float)positions[b * SEQ + t] * p.inv_freq[f]; const double rev = (double)ang * 0.15915494309189535; const float fr = (float)(rev - floor(rev));
            c = __builtin_amdgcn_cosf(fr); sv = __builtin_amdgcn_sinf(fr); }
        cs[i] = c; sn[i] = sv;
    }
    u32x2 oh[4][8];
#pragma unroll
    for (int g = 0; g < 2; ++g) {
        __syncthreads();
        {
            const int key = tid >> 1, half = tid & 1, t = tband0 + key;
            u32x4 kv[4];
#pragma unroll
            for (int q = 0; q < 4; ++q) kv[q] = (u32x4){0u, 0u, 0u, 0u};
            if (t >= 0) { const bf16_t* kp = proj + (size_t)(b * SEQ + t) * NPROJ + C_K + g * 64 + half * 32;
#pragma unroll
                for (int q = 0; q < 4; ++q) kv[q] = *(const u32x4*)(kp + 8 * q); }
            if (half == 0) {
                float o1[8], o2[8];
#pragma unroll
                for (int f = 0; f < 8; ++f) { const float x1 = bfel(kv[0], f), x2 = bfel(kv[1], f), c = cs[key * 8 + f], sv = sn[key * 8 + f]; o1[f] = x1 * c - x2 * sv; o2[f] = x2 * c + x1 * sv; }
                kv[0] = (u32x4){pk2(o1[0], o1[1]), pk2(o1[2], o1[3]), pk2(o1[4], o1[5]), pk2(o1[6], o1[7])};
                kv[1] = (u32x4){pk2(o2[0], o2[1]), pk2(o2[2], o2[3]), pk2(o2[4], o2[5]), pk2(o2[6], o2[7])};
            }
#pragma unroll
            for (int q = 0; q < 4; ++q) *(u32x4*)(sK + key * 72 + half * 32 + 8 * q) = kv[q];
        }
        {
            const int kg = tid >> 3, dc = tid & 7;
            u32x4 v[4];
#pragma unroll
            for (int i = 0; i < 4; ++i) { const int t = tband0 + 4 * kg + i; v[i] = (u32x4){0u, 0u, 0u, 0u};
                if (t >= 0) v[i] = *(const u32x4*)(proj + (size_t)(b * SEQ + t) * NPROJ + C_V + g * 64 + dc * 8); }
            bf16_t* vd = sV + (dc * 8) * 260 + 4 * kg;
#define VT_ROW(j, W) { const unsigned e0 = ((j) & 1) ? (v[0].W >> 16) : (v[0].W & 0xffffu), e1 = ((j) & 1) ? (v[1].W >> 16) : (v[1].W & 0xffffu), e2 = ((j) & 1) ? (v[2].W >> 16) : (v[2].W & 0xffffu), e3 = ((j) & 1) ? (v[3].W >> 16) : (v[3].W & 0xffffu); \
                *(u32x2*)(vd + (j) * 260) = (u32x2){e0 | (e1 << 16), e2 | (e3 << 16)}; }
            VT_ROW(0, x) VT_ROW(1, x) VT_ROW(2, y) VT_ROW(3, y) VT_ROW(4, z) VT_ROW(5, z) VT_ROW(6, w) VT_ROW(7, w)
#undef VT_ROW
        }
        __syncthreads();
#pragma unroll
        for (int uu = 0; uu < 2; ++uu) {
            const int u = w + 8 * uu;
            attn_unit(p, sK, sV, cs, sn, ssq, b, blk, g * 4 + (u >> 2), u & 3, lane, oh[g * 2 + uu]);
            __builtin_amdgcn_sched_barrier(0);
        }
    }
    __syncthreads();
    {
        bf16_t* A2 = (bf16_t*)(p.ws + WS_A2);
        const float* wa = p.in[11];
#pragma unroll
        for (int k = 0; k < 4; ++k) {
            const int u = w + 8 * (k & 1), hq = (k >> 1) * 4 + (u >> 2), rg = u & 3, ql = rg * 32 + r;
            const f32x4 s0 = *(const f32x4*)(ssq + ql * 8), s1 = *(const f32x4*)(ssq + ql * 8 + 4);
            const float rstd = 1.f / sqrtf((((s0.x + s0.y) + (s0.z + s0.w)) + ((s1.x + s1.y) + (s1.z + s1.w))) * (1.f / 512.f) + EPS);
            bf16_t* op = A2 + (size_t)(b * SEQ + blk * 128 + ql) * 1024 + hq * 64 + 4 * h;
#pragma unroll
            for (int j = 0; j < 8; ++j) {
                const int d0 = 32 * (j >> 2) + 8 * (j & 3);
                const f32x4 wv = *(const f32x4*)(wa + hq * 64 + d0 + 4 * h);
                const u32x2 t = oh[k][j];
                u32x2 o; o.x = pk2(bflo(t.x) * rstd * wv.x, bfhi(t.x) * rstd * wv.y); o.y = pk2(bflo(t.y) * rstd * wv.z, bfhi(t.y) * rstd * wv.w);
                *(u32x2*)(op + d0) = o;
            }
        }
    }
    __syncthreads();
}

__device__ __forceinline__ void phase2_states(const Params& p, unsigned char* lds, int b, int c) {
    const int tid = opaque_tid(), lane = tid & 63, w = tid >> 6, r = lane & 31, h = lane >> 5;
    float* dts = (float*)lds;
    float* cums = dts + 1024;
    bf16_t* sBT = (bf16_t*)(lds + 8192);
    bf16_t* sXT = sBT + 128 * 136;
    ssd_dt_cum(p, b, c, dts, cums);
    __syncthreads();
    bf16_t* states = (bf16_t*)(p.ws + WS_START);
    if (tid < 8) ((float*)(p.ws + WS_CDEC))[(b * NCH + c) * 8 + tid] = __expf(cums[tid * 128 + 127]);
#pragma unroll 1
    for (int g = 0; g < 2; ++g) {
        if (tid < 256) {
            const int cg8 = tid & 15, lr = tid >> 4;
            const float one[8] = {1.f, 1.f, 1.f, 1.f, 1.f, 1.f, 1.f, 1.f};
            u32x4 res[8];
            conv8x8<true>(p, b, c, lr * 8, 512 + g * 128 + cg8 * 8, one, res);
#pragma unroll
            for (int ci = 0; ci < 8; ++ci) *(u32x4*)(sBT + (cg8 * 8 + ci) * 136 + lr * 8) = res[ci];
        }
        {
            const int cg8 = tid & 31, lr = tid >> 5, hh = cg8 >> 3, hd = g * 4 + hh;
            float f[8];
            const float cl = cums[hd * 128 + 127];
#pragma unroll
            for (int li = 0; li < 8; ++li) f[li] = dts[hd * 128 + lr * 8 + li] * __expf(cl - cums[hd * 128 + lr * 8 + li]);
            u32x4 res[8];
            conv8x8<true>(p, b, c, lr * 8, g * 256 + cg8 * 8, f, res);
#pragma unroll
            for (int ci = 0; ci < 8; ++ci) *(u32x4*)(sXT + (cg8 * 8 + ci) * 136 + lr * 8) = res[ci];
        }
        __syncthreads();
        {
            f32x16 acc[4];
#pragma unroll
            for (int j = 0; j < 4; ++j) acc[j] = zero16();
#pragma unroll
            for (int kk = 0; kk < 128; kk += 16) {
                const bf16x8 a = *(const bf16x8*)(sXT + (w * 32 + r) * 136 + kk + 8 * h);
#pragma unroll
                for (int j = 0; j < 4; ++j) { const bf16x8 bb = *(const bf16x8*)(sBT + (j * 32 + r) * 136 + kk + 8 * h); acc[j] = mfma32(a, bb, acc[j]); }
            }
            const int hd = g * 4 + (w >> 1), p0 = (w & 1) * 32;
            bf16_t* sp = states + ((size_t)((b * NCH + c) * 8 + hd) * 64) * 128;
#pragma unroll
            for (int j = 0; j < 4; ++j)
#pragma unroll
                for (int i = 0; i < 16; ++i) sp[(size_t)(p0 + crow(i, h)) * 128 + j * 32 + r] = (bf16_t)f2bf(acc[j][i]);
        }
        __syncthreads();
    }
}

__device__ __forceinline__ void phase3(const Params& p) {
    const float* cdec = (const float*)(p.ws + WS_CDEC);
    bf16_t* start = (bf16_t*)(p.ws + WS_START);
    const int tid3 = opaque_tid();
#pragma unroll 1
    for (int u = blockIdx.x * NTHREADS + tid3; u < 131072; u += gridDim.x * NTHREADS) {
        const int n4 = u & 31, pp = (u >> 5) & 63, hd = (u >> 11) & 7, b = u >> 14;
        bf16_t* base = start + ((size_t)((b * NCH) * 8 + hd) * 64 + pp) * 128 + n4 * 4;
        constexpr size_t CSTRIDE = (size_t)8 * 64 * 128;
        f32x4 s = (f32x4){0.f, 0.f, 0.f, 0.f};
#pragma unroll 1
        for (int c0 = 0; c0 < NCH; c0 += 16) {
            bf16_t* bp = base + c0 * CSTRIDE; const float* dp = cdec + (b * NCH + c0) * 8 + hd;
            asm volatile("" : "+v"(bp));
            u32x2 t[16]; float d[16];
#pragma unroll
            for (int c = 0; c < 16; ++c) { t[c] = *(const u32x2*)(bp + c * CSTRIDE); d[c] = dp[c * 8]; }
#pragma unroll
            for (int c = 0; c < 16; ++c) {
                u32x2 o; o.x = pk2(s.x, s.y); o.y = pk2(s.z, s.w);
                *(u32x2*)(bp + c * CSTRIDE) = o;
                const f32x4 st = (f32x4){bflo(t[c].x), bfhi(t[c].x), bflo(t[c].y), bfhi(t[c].y)};
                s = s * d[c] + st;
            }
        }
    }
}

__device__ __forceinline__ void phase4(const Params& p, unsigned char* lds, int b, int c) {
    const int tid = opaque_tid(), lane = tid & 63, w = tid >> 6, r = lane & 31, h = lane >> 5;
    float* dts = (float*)lds;
    float* cums = dts + 1024;
    float* gsq = cums + 1024;
    bf16_t* sC = (bf16_t*)(lds + 12288);
    bf16_t* sB = sC + 128 * 136;
    bf16_t* sM = sB + 128 * 136;
    bf16_t* sXT = sM + 128 * 136;
    const bf16_t* proj = (const bf16_t*)(p.ws + WS_PROJ);
    const bf16_t* start = (const bf16_t*)(p.ws + WS_START);
    bf16_t* A2 = (bf16_t*)(p.ws + WS_A2);
    ssd_dt_cum(p, b, c, dts, cums);
    __syncthreads();
    const size_t row0 = (size_t)b * SEQ + c * 128;
#pragma unroll 1
    for (int g = 0; g < 2; ++g) {
        {
            const int which = tid >> 8, cg8 = tid & 15, lr = (tid >> 4) & 15;
            const float one[8] = {1.f, 1.f, 1.f, 1.f, 1.f, 1.f, 1.f, 1.f};
            u32x4 res[8];
            conv8x8<false>(p, b, c, lr * 8, (which ? 768 : 512) + g * 128 + cg8 * 8, one, res);
            bf16_t* dst = which ? sC : sB;
#pragma unroll
            for (int li = 0; li < 8; ++li) *(u32x4*)(dst + (lr * 8 + li) * 136 + cg8 * 8) = res[li];
        }
        __syncthreads();
        f32x16 cb0 = zero16(), cb1 = zero16();
        const int lt = w >> 1, st0 = 2 * (w & 1);
#pragma unroll 2
        for (int kk = 0; kk < 128; kk += 16) {
            const bf16x8 a = *(const bf16x8*)(sC + (lt * 32 + r) * 136 + kk + 8 * h);
            const bf16x8 b0 = *(const bf16x8*)(sB + (st0 * 32 + r) * 136 + kk + 8 * h);
            const bf16x8 b1 = *(const bf16x8*)(sB + ((st0 + 1) * 32 + r) * 136 + kk + 8 * h);
            cb0 = mfma32(a, b0, cb0); cb1 = mfma32(a, b1, cb1);
        }
        __syncthreads();
        bf16_t* sS = sB;
        const int lt2 = w >> 1, pt = w & 1;
        const int lme = lt2 * 32 + r;
        const int cp = tid & 31, lr = tid >> 5;
        u32x4 stv[2]; unsigned xin[11]; u32x2 zrn[4];
#define P4_PREFETCH(HD) { const bf16_t* stb_ = start + ((size_t)((b * NCH + c) * 8 + (HD)) * 64) * 128; \
            _Pragma("unroll") for (int i_ = 0; i_ < 2; ++i_) { const int id_ = tid + 512 * i_; stv[i_] = *(const u32x4*)(stb_ + (id_ >> 4) * 128 + (id_ & 15) * 8); } \
            conv2_load(p, b, c, lr * 8, (HD) * 64 + cp * 2, xin); \
            const bf16_t* zp_ = proj + (row0 + lme) * NPROJ + C_Z + (HD) * 64 + 32 * pt + 4 * h; \
            _Pragma("unroll") for (int g4_ = 0; g4_ < 4; ++g4_) zrn[g4_] = *(const u32x2*)(zp_ + 8 * g4_); }
        P4_PREFETCH(g * 4);
        u32x2 yh[4][4];
#pragma unroll
        for (int hh = 0; hh < 4; ++hh) {
            const int hd = g * 4 + hh;
            u32x2 zr[4];
#pragma unroll
            for (int g4 = 0; g4 < 4; ++g4) zr[g4] = zrn[g4];
#pragma unroll
            for (int q = 0; q < 2; ++q) {
                const int st = st0 + q;
                if (st <= lt) {
                    const int sme = st * 32 + r; const float cs_ = cums[hd * 128 + sme], ds_ = dts[hd * 128 + sme];
#pragma unroll
                    for (int i = 0; i < 16; ++i) {
                        const int l = lt * 32 + crow(i, h);
                        const float cbv = q ? cb1[i] : cb0[i];
                        const float v = (sme <= l) ? cbv * __expf(cums[hd * 128 + l] - cs_) * ds_ : 0.f;
                        sM[l * 136 + sme] = (bf16_t)f2bf(v);
                    }
                }
            }
            {
                u32x4 res[2];
                conv2_math(p, hd * 64 + cp * 2, xin, res);
                *(u32x4*)(sXT + (cp * 2) * 136 + lr * 8) = res[0];
                *(u32x4*)(sXT + (cp * 2 + 1) * 136 + lr * 8) = res[1];
            }
#pragma unroll
            for (int i = 0; i < 2; ++i) { const int id = tid + 512 * i; *(u32x4*)(sS + (id >> 4) * 136 + (id & 15) * 8) = stv[i]; }
            __syncthreads();
            if (hh < 3) P4_PREFETCH(hd + 1);
            {
                f32x16 yd = zero16(), yo = zero16();
                const int kend = 32 * (lt2 + 1);
#pragma unroll 2
                for (int kk = 0; kk < kend; kk += 16) {
                    const bf16x8 a = *(const bf16x8*)(sXT + (pt * 32 + r) * 136 + kk + 8 * h);
                    const bf16x8 bb = *(const bf16x8*)(sM + (lt2 * 32 + r) * 136 + kk + 8 * h);
                    yd = mfma32(a, bb, yd);
                }
#pragma unroll 2
                for (int kk = 0; kk < 128; kk += 16) {
                    const bf16x8 a = *(const bf16x8*)(sS + (pt * 32 + r) * 136 + kk + 8 * h);
                    const bf16x8 bb = *(const bf16x8*)(sC + (lt2 * 32 + r) * 136 + kk + 8 * h);
                    yo = mfma32(a, bb, yo);
                }
                const float dsk = p.in[10][hd];
                const float el = __expf(cums[hd * 128 + lme]);
                float q = 0.f;
#pragma unroll
                for (int g4 = 0; g4 < 4; ++g4) {
                    float gv[4];
#pragma unroll
                    for (int e = 0; e < 4; ++e) {
                        const int i = 4 * g4 + e, pl = 32 * pt + 8 * g4 + 4 * h + e;
                        const float xs = bf2f((unsigned)sXT[pl * 136 + lme]);
                        const float y = yd[i] + el * yo[i] + dsk * xs;
                        const unsigned zw = (e >> 1) ? zr[g4].y : zr[g4].x;
                        const float z = (e & 1) ? bfhi(zw) : bflo(zw);
                        gv[e] = y * siluf(z);
                    }
                    const unsigned w0 = pk2(gv[0], gv[1]), w1 = pk2(gv[2], gv[3]);
                    yh[hh][g4] = (u32x2){w0, w1};
                    q += (bflo(w0) * bflo(w0) + bfhi(w0) * bfhi(w0)) + (bflo(w1) * bflo(w1) + bfhi(w1) * bfhi(w1));
                }
                q += __shfl_xor(q, 32);
                if (h == 0) gsq[lme * 8 + hh * 2 + pt] = q;
            }
            __syncthreads();
        }
#undef P4_PREFETCH
        {
            const float* wsn = p.in[12];
            float sq = 0.f;
#pragma unroll
            for (int q = 0; q < 8; ++q) sq += gsq[lme * 8 + q];
            const float rstd = 1.f / sqrtf(sq * (1.f / 256.f) + EPS);
            bf16_t* op = A2 + (row0 + lme) * 1024 + 512 + g * 256 + 32 * pt + 4 * h;
#pragma unroll
            for (int hh = 0; hh < 4; ++hh)
#pragma unroll
                for (int g4 = 0; g4 < 4; ++g4) {
                    const f32x4 wv = *(const f32x4*)(wsn + g * 256 + hh * 64 + 32 * pt + 8 * g4 + 4 * h);
                    const u32x2 t = yh[hh][g4];
                    u32x2 o; o.x = pk2(bflo(t.x) * rstd * wv.x, bfhi(t.x) * rstd * wv.y); o.y = pk2(bflo(t.y) * rstd * wv.z, bfhi(t.y) * rstd * wv.w);
                    *(u32x2*)(op + hh * 64 + 8 * g4) = o;
                }
        }
        __syncthreads();
    }
}

__device__ __forceinline__ void phase5(const Params& p, unsigned char* lds) {
    unsigned char* ws = p.ws;
    pg8::Gemm g{(const bf16_t*)(ws + WS_A2), (const bf16_t*)(ws + WS_WOUT), NT, DM, DM};
    pg8::StaticOrder S; S.init(NT, DM, (int)gridDim.x, (int)blockIdx.x);
    pg8::EpiResid<true, true> E{(const void*)(ws + WS_H1), (bf16_t*)(ws + WS_XB), (float*)(ws + WS_SSQ), (const float*)(ws + WS_RS1), p.in[3]};
    pg8::gemm_phase<pg8::EpiResid<true, true>, pg8::StaticOrder, true, true>(LDS3(lds), g, S, E);
}
__device__ __forceinline__ void phase6(const Params& p, unsigned char* lds) {
    unsigned char* ws = p.ws;
    pg8::Gemm g{(const bf16_t*)(ws + WS_XB), (const bf16_t*)(ws + WS_WQ), NT, 512, DM};
    pg8::StaticOrder S; S.init(NT, 512, (int)gridDim.x, (int)blockIdx.x);
    pg8::EpiQ E{(bf16_t*)(ws + WS_Q2), (const float*)(ws + WS_SSQ)};
    pg8::gemm_phase<pg8::EpiQ, pg8::StaticOrder, true, true>(LDS3(lds), g, S, E);
}
__device__ __forceinline__ void phase8(const Params& p, unsigned char* lds) {
    unsigned char* ws = p.ws;
    pg8::Gemm g{(const bf16_t*)(ws + WS_XO), (const bf16_t*)(ws + WS_WO), NT, DM, 512};
    pg8::StaticOrder S; S.init(NT, DM, (int)gridDim.x, (int)blockIdx.x);
    pg8::EpiResid<false, false> E{(const void*)(ws + WS_XB), (bf16_t*)(ws + WS_XB), nullptr, nullptr, nullptr};
    pg8::gemm_phase<pg8::EpiResid<false, false>, pg8::StaticOrder, true, true>(LDS3(lds), g, S, E);
}

__device__ __forceinline__ void phase7(const Params& p, unsigned char* lds) {
    const int tid = opaque_tid(), lane = tid & 63, w = tid >> 6, r = lane & 31, h = lane >> 5;
    const bf16_t* q2 = (const bf16_t*)(p.ws + WS_Q2); const bf16_t* kmem = (const bf16_t*)(p.ws + WS_KMEM); const bf16_t* vmemT = (const bf16_t*)(p.ws + WS_VMEMT);
    bf16_t* xo = (bf16_t*)(p.ws + WS_XO);
    bf16_t* sK = (bf16_t*)lds;
    bf16_t* sV = sK + 256 * 136;
    const float sc = 0.08838834764831845f * 1.4426950408889634f;
    for (int pr = blockIdx.x; pr < 256; pr += gridDim.x) {
        const int bh = pr >> 3, rp = pr & 7, b = bh >> 2, hx = bh & 3;
        __syncthreads();
        for (int i = tid; i < 4096; i += NTHREADS) { const int key = i >> 4, ch = i & 15;
            *(u32x4*)(sK + key * 136 + ch * 8) = *(const u32x4*)(kmem + ((size_t)b * 256 + key) * 512 + hx * 128 + ch * 8); }
        for (int i = tid; i < 4096; i += NTHREADS) { const int d = i >> 5, ch = i & 31;
            const u32x4 v = *(const u32x4*)(vmemT + (((size_t)b * 4 + hx) * 128 + d) * 256 + ch * 8);
            *(u32x2*)(sV + d * 260 + ch * 8) = (u32x2){v.x, v.y}; *(u32x2*)(sV + d * 260 + ch * 8 + 4) = (u32x2){v.z, v.w}; }
        __syncthreads();
#pragma unroll 1
        for (int ib = 0; ib < 2; ++ib) {
            const size_t row0 = (size_t)b * SEQ + (size_t)(2 * rp + ib) * 256 + w * 32;
            bf16x8 qf[8];
            const bf16_t* qp = q2 + (row0 + r) * 512 + hx * 128 + 8 * h;
#pragma unroll
            for (int kk = 0; kk < 8; ++kk) qf[kk] = *(const bf16x8*)(qp + kk * 16);
            f32x16 S[8];
#pragma unroll
            for (int t = 0; t < 8; ++t) S[t] = zero16();
            const bf16_t* kp = sK + r * 136 + 8 * h;
#pragma unroll
            for (int kk = 0; kk < 8; ++kk) {
#pragma unroll
                for (int t = 0; t < 8; ++t) { const bf16x8 a = *(const bf16x8*)(kp + t * (32 * 136) + kk * 16); S[t] = mfma32(a, qf[kk], S[t]); }
                __builtin_amdgcn_sched_barrier(0);
            }
            float m = -INFINITY;
#pragma unroll
            for (int t = 0; t < 8; ++t)
#pragma unroll
                for (int i = 0; i < 16; ++i) m = fmaxf(m, S[t][i]);
            m = fmaxf(m, __shfl_xor(m, 32));
            float sum = 0.f;
            bf16x8 P[16];
#pragma unroll
            for (int t = 0; t < 8; ++t) {
                float e[16];
#pragma unroll
                for (int i = 0; i < 16; ++i) { e[i] = __builtin_amdgcn_exp2f((S[t][i] - m) * sc); sum += e[i]; }
                P[2 * t] = pack8(e[0], e[1], e[2], e[3], e[4], e[5], e[6], e[7]);
                P[2 * t + 1] = pack8(e[8], e[9], e[10], e[11], e[12], e[13], e[14], e[15]);
            }
            sum += __shfl_xor(sum, 32);
            const float inv = 1.f / sum;
            f32x16 O[4];
#pragma unroll
            for (int dt = 0; dt < 4; ++dt) O[dt] = zero16();
            const bf16_t* vp0 = sV + r * 260 + 4 * h;
#pragma unroll
            for (int ts = 0; ts < 16; ++ts) {
#pragma unroll
                for (int dt = 0; dt < 4; ++dt) {
                    const bf16_t* vp = vp0 + dt * (32 * 260) + 16 * ts;
                    const u32x2 lo = *(const u32x2*)vp, hi = *(const u32x2*)(vp + 8);
                    const bf16x8 a = __builtin_bit_cast(bf16x8, (u32x4){lo.x, lo.y, hi.x, hi.y});
                    O[dt] = mfma32(a, P[ts], O[dt]);
                }
                if (ts & 1) __builtin_amdgcn_sched_barrier(0);
            }
            bf16_t* op = xo + (row0 + r) * 512 + hx * 128 + 4 * h;
#pragma unroll
            for (int dt = 0; dt < 4; ++dt)
#pragma unroll
                for (int g = 0; g < 4; ++g) { u32x2 o; o.x = pk2(O[dt][4 * g] * inv, O[dt][4 * g + 1] * inv); o.y = pk2(O[dt][4 * g + 2] * inv, O[dt][4 * g + 3] * inv);
                    *(u32x2*)(op + 32 * dt + 8 * g) = o; }
        }
    }
}

typedef __bf16 bf16x2_t __attribute__((ext_vector_type(2)));
__device__ __forceinline__ float dot2bf(unsigned a, unsigned b, float acc) { return __builtin_amdgcn_fdot2_f32_bf16(__builtin_bit_cast(bf16x2_t, a), __builtin_bit_cast(bf16x2_t, b), acc, false); }
__device__ __forceinline__ void phase9(const Params& p, unsigned char* lds) {
    const int tid = opaque_tid(), lane = tid & 63, w = tid >> 6, r = lane & 31, h = lane >> 5;
    const bf16_t* x2 = (const bf16_t*)(p.ws + WS_XB);
    int* cnt = (int*)(p.ws + WS_CTL);
    int* list = (int*)(p.ws + WS_LIST);
    float* route = (float*)(p.ws + WS_ROUTE);
    const float* bg = p.in[21]; const float* be = p.in[23];
    bf16_t* sW = (bf16_t*)lds;
    int* lcnt = (int*)(lds + 74752);
    float* lrec = (float*)(lds + 74752 + 256);
    for (int i = tid; i < 36 * 128; i += NTHREADS) { const int n = i >> 7, ch = i & 127; *(u32x4*)(sW + n * 1032 + ch * 8) = *(const u32x4*)((const bf16_t*)(p.ws + WS_WR) + n * 1024 + ch * 8); }
    if (tid < 64) lcnt[tid] = 0;
    __syncthreads();
    const int njobs = NT / 32, jstride = gridDim.x * 4;
    int nrec = 0;
    for (int job0 = blockIdx.x * 4; job0 < njobs; job0 += jstride, ++nrec) {
        const int job = job0 + w;
        if (w < 4 && job < njobs) {
            const int m0 = job * 32;
            f32x16 acc0 = zero16(), acc1 = zero16();
            float ss = 0.f;
            const bf16_t* xp = x2 + (size_t)(m0 + r) * DM + 8 * h;
            const bf16_t* w0p = sW + r * 1032 + 8 * h;
            const bf16_t* w1p = sW + (32 + (r & 3)) * 1032 + 8 * h;
#pragma unroll 1
            for (int kb = 0; kb < 4; ++kb) {
                u32x4 xf[16];
#pragma unroll
                for (int q = 0; q < 16; ++q) xf[q] = *(const u32x4*)(xp + (kb * 16 + q) * 16);
#pragma unroll
                for (int q = 0; q < 16; ++q) {
                    const bf16x8 a0 = *(const bf16x8*)(w0p + (kb * 16 + q) * 16), a1 = *(const bf16x8*)(w1p + (kb * 16 + q) * 16);
                    const bf16x8 xb = __builtin_bit_cast(bf16x8, xf[q]);
                    acc0 = mfma32(a0, xb, acc0); acc1 = mfma32(a1, xb, acc1);
                    ss = dot2bf(xf[q].x, xf[q].x, ss); ss = dot2bf(xf[q].y, xf[q].y, ss); ss = dot2bf(xf[q].z, xf[q].z, ss); ss = dot2bf(xf[q].w, xf[q].w, ss);
                }
            }
            ss += __shfl_xor(ss, 32);
            const float rstd = 1.f / sqrtf(ss * (1.f / DM) + EPS);
            const float g0 = __shfl(acc1[0], r) * rstd + bg[0], g1 = __shfl(acc1[1], r) * rstd + bg[1], g2 = __shfl(acc1[2], r) * rstd + bg[2], g3 = __shfl(acc1[3], r) * rstd + bg[3];
            int gi = 0; float gm = g0;
            if (g1 > gm) { gm = g1; gi = 1; }
            if (g2 > gm) { gm = g2; gi = 2; }
            if (g3 > gm) { gm = g3; gi = 3; }
            const float gden = __expf(g0 - gm) + __expf(g1 - gm) + __expf(g2 - gm) + __expf(g3 - gm);
            const float ggate = 1.f / gden;
            const bool up = (gi & 1) != 0;
            const int gme = 2 * h + (gi & 1);
            float ev[8];
#pragma unroll
            for (int j = 0; j < 8; ++j) ev[j] = (up ? acc0[8 + j] : acc0[j]) * rstd + be[gme * 8 + j];
            int i1 = 0; float v1 = ev[0];
#pragma unroll
            for (int j = 1; j < 8; ++j) if (ev[j] > v1) { v1 = ev[j]; i1 = j; }
            int i2 = -1; float v2 = -INFINITY;
#pragma unroll
            for (int j = 0; j < 8; ++j) if (j != i1 && ev[j] > v2) { v2 = ev[j]; i2 = j; }
            const float e2 = __expf(v2 - v1);
            const float w1 = ggate / (1.f + e2), w2 = ggate * e2 / (1.f + e2);
            if (h == (gi >> 1)) {
                const int ea = gi * 8 + i1, eb = gi * 8 + i2;
                const int la = atomicAdd(lcnt + ea, 1), lb = atomicAdd(lcnt + eb, 1);
                float* rc = lrec + (size_t)(nrec * 128 + w * 32 + r) * 8;
                ((int*)rc)[0] = ea; ((int*)rc)[1] = eb; ((int*)rc)[2] = la; ((int*)rc)[3] = lb; rc[4] = w1; rc[5] = w2; rc[6] = rstd; ((int*)rc)[7] = m0 + r;
            }
        }
    }
    __syncthreads();
    if (tid < 32) lcnt[32 + tid] = lcnt[tid] ? atomicAdd(cnt + tid * 64, lcnt[tid]) : 0;
    __syncthreads();
    {
        int rd = 0;
        for (int job0 = blockIdx.x * 4; job0 < njobs; job0 += jstride, ++rd) {
            if (tid < 128 && job0 + (tid >> 5) < njobs) {
                const float* rc = lrec + (size_t)(rd * 128 + tid) * 8;
                const int ea = ((const int*)rc)[0], eb = ((const int*)rc)[1], m = ((const int*)rc)[7];
                const int pa = lcnt[32 + ea] + ((const int*)rc)[2], pb = lcnt[32 + eb] + ((const int*)rc)[3];
                list[ea * NT + pa] = m; list[eb * NT + pb] = m;
                int* ri = (int*)(route + (size_t)m * 8);
                ri[0] = ea; ri[1] = eb; ri[2] = pa; ri[3] = pb;
                route[(size_t)m * 8 + 4] = rc[4]; route[(size_t)m * 8 + 5] = rc[5]; route[(size_t)m * 8 + 6] = rc[6]; route[(size_t)m * 8 + 7] = 0.f;
            }
        }
    }
}

__device__ __forceinline__ int* moe_tables(const Params& p, unsigned char* lds) {
    int* off = (int*)(lds + 131072);
    const int* cnt = (const int*)(p.ws + WS_CTL);
    if (threadIdx.x < 64) {
        const int l = threadIdx.x & 63;
        const int cv = (l < NEXP) ? cnt[l * 64] : 0;
        int pad = ((cv + 255) >> 8) << 8, incl = pad;
#pragma unroll
        for (int o = 1; o < 32; o <<= 1) { const int t = __shfl_up(incl, o); if (l >= o) incl += t; }
        if (l < NEXP) { off[l] = incl - pad; off[40 + l] = cv; }
        if (l == NEXP - 1) off[NEXP] = incl;
    }
    __syncthreads();
    const int nrt = off[NEXP] >> 8;
    for (int rt = threadIdx.x; rt < nrt; rt += NTHREADS) { int e = 0; for (int q = 1; q < NEXP; ++q) if (off[q] <= rt * 256) e = q; off[128 + rt] = e; }
    __syncthreads();
    return off;
}

__device__ __forceinline__ void phase10(const Params& p, unsigned char* lds) {
    const int tid = opaque_tid(), lane = tid & 63, w = tid >> 6;
    const int* off = moe_tables(p, lds);
    const int gw = blockIdx.x * NWAVES + w, NGW = gridDim.x * NWAVES;
    const bf16_t* x2 = (const bf16_t*)(p.ws + WS_XB); const float* route = (const float*)(p.ws + WS_ROUTE);
    bf16_t* xg = (bf16_t*)(p.ws + WS_XG);
    for (int m = gw; m < NT; m += NGW) {
        const int* ri = (const int*)(route + (size_t)m * 8);
        const int ea = ri[0], eb = ri[1], pa = ri[2], pb = ri[3];
        const float rs = route[(size_t)m * 8 + 6];
        const size_t sa = (size_t)off[ea] + pa, sb = (size_t)off[eb] + pb;
        const u32x2* xr = (const u32x2*)(x2 + (size_t)m * DM) + lane;
        u32x2* oa = (u32x2*)(xg + sa * DM) + lane; u32x2* ob = (u32x2*)(xg + sb * DM) + lane;
#pragma unroll
        for (int j = 0; j < 4; ++j) { const u32x2 t = xr[64 * j]; u32x2 o; o.x = pk2(bflo(t.x) * rs, bfhi(t.x) * rs); o.y = pk2(bflo(t.y) * rs, bfhi(t.y) * rs); oa[64 * j] = o; ob[64 * j] = o; }
    }
}

__device__ __forceinline__ void phase11(const Params& p, unsigned char* lds) {
    const int tid = opaque_tid();
    const int* off = moe_tables(p, lds);
    const int nrt = off[NEXP] >> 8, G = (int)gridDim.x, c = (int)blockIdx.x;
    unsigned* rowtab = (unsigned*)(lds + 131072 + 2048);
    float* rstab = (float*)(lds + 131072 + 2048 + 3072);
    {
        const int* list = (const int*)(p.ws + WS_LIST); const float* route = (const float*)(p.ws + WS_ROUTE);
        for (int i = 0; i < 3; ++i) {
            const int L = i * G + c; if (L >= nrt * 2) break;
            const int rt = L >> 1, e = off[128 + rt], cnt_e = off[40 + e], pos0 = rt * 256 - off[e];
            if (tid < 256) { const int pos = pos0 + tid; int tok = 0; float rs = 0.f;
                if (pos < cnt_e) { tok = list[e * NT + pos]; rs = route[(size_t)tok * 8 + 6]; }
                rowtab[i * 256 + tid] = (unsigned)tok * (unsigned)(DM * 2); rstab[i * 256 + tid] = rs; }
        }
    }
    __syncthreads();
    pg8::Gemm g{(const bf16_t*)(p.ws + WS_XB), (const bf16_t*)(p.ws + WS_WGU), 0, 0, DM};
    pg8::MoeOrder S{(const __attribute__((address_space(3))) int*)(off + 128), nrt, 2, G, c};
    pg8::EpiGU E{(bf16_t*)(p.ws + WS_HID), (const __attribute__((address_space(3))) float*)rstab, G, c};
    pg8::gemm_phase_g<pg8::EpiGU, pg8::MoeOrder, true, true>(LDS3(lds), g, S, E, (const __attribute__((address_space(3))) unsigned*)rowtab);
}
__device__ __forceinline__ void phase12(const Params& p, unsigned char* lds) {
    const int* off = moe_tables(p, lds);
    int kdim = EFF; asm volatile("" : "+s"(kdim));
    pg8::Gemm g{(const bf16_t*)(p.ws + WS_HID), (const bf16_t*)(p.ws + WS_WD), 0, 0, kdim};
    pg8::MoeOrder S{(const __attribute__((address_space(3))) int*)(off + 128), off[NEXP] >> 8, 4, (int)gridDim.x, (int)blockIdx.x};
    pg8::EpiY8 E{(unsigned char*)(p.ws + WS_Y), DM, 4};
    pg8::gemm_phase<pg8::EpiY8, pg8::MoeOrder, true, true>(LDS3(lds), g, S, E);
}

__device__ __forceinline__ void phase13(const Params& p, unsigned char* lds) {
    const int tid = opaque_tid(), lane = tid & 63, w = tid >> 6;
    const int* off = moe_tables(p, lds);
    const int gw = blockIdx.x * NWAVES + w, NGW = gridDim.x * NWAVES;
    const bf16_t* x2 = (const bf16_t*)(p.ws + WS_XB); const unsigned char* yb = (const unsigned char*)(p.ws + WS_Y);
    const float* route = (const float*)(p.ws + WS_ROUTE); const float* wf = p.in[27];
    f32x4 wv[2][2];
#pragma unroll
    for (int j = 0; j < 2; ++j) { wv[j][0] = *(const f32x4*)(wf + 8 * lane + 512 * j); wv[j][1] = *(const f32x4*)(wf + 8 * lane + 512 * j + 4); }
    struct Rows { u32x4 x[2]; u32x2 ya[2], yb[2]; float w1, w2; };
    Rows R0, R1, R2;
    u32x4 recN; u32x2 wN;
#define LOAD_REC(m_, REC, WW) { REC = *(const u32x4*)(route + (size_t)(m_) * 8); WW = *(const u32x2*)(route + (size_t)(m_) * 8 + 4); }
#define ISSUE_ROWS(m_, REC, WW, R) { const size_t sa_ = (size_t)off[(int)(REC).x] + (REC).z, sb_ = (size_t)off[(int)(REC).y] + (REC).w; \
        const u32x4* xr_ = (const u32x4*)(x2 + (size_t)(m_) * DM) + lane; const u32x2* ya_ = (const u32x2*)(yb + sa_ * DM) + lane; const u32x2* yb_ = (const u32x2*)(yb + sb_ * DM) + lane; \
        _Pragma("unroll") for (int j = 0; j < 2; ++j) { R.x[j] = xr_[64 * j]; R.ya[j] = ya_[64 * j]; R.yb[j] = yb_[64 * j]; } \
        R.w1 = __uint_as_float((WW).x) * 0.0625f; R.w2 = __uint_as_float((WW).y) * 0.0625f; }
    {
        u32x4 rc; u32x2 ww;
        if (gw < NT) { LOAD_REC(gw, rc, ww); ISSUE_ROWS(gw, rc, ww, R0); }
        if (gw + NGW < NT) { LOAD_REC(gw + NGW, rc, ww); ISSUE_ROWS(gw + NGW, rc, ww, R1); }
        if (gw + 2 * NGW < NT) LOAD_REC(gw + 2 * NGW, recN, wN);
    }
#pragma unroll 1
    for (int m = gw; m < NT; m += NGW) {
        if (m + 2 * NGW < NT) ISSUE_ROWS(m + 2 * NGW, recN, wN, R2);
        if (m + 3 * NGW < NT) LOAD_REC(m + 3 * NGW, recN, wN);
        f32x4 v[2][2]; float s = 0.f;
#pragma unroll
        for (int j = 0; j < 2; ++j) {
            typedef float f32x2v __attribute__((ext_vector_type(2)));
            const u32x4 t = R0.x[j]; const u32x2 a = R0.ya[j], bq = R0.yb[j]; const float w1 = R0.w1, w2 = R0.w2;
            const f32x2v a0 = __builtin_amdgcn_cvt_pk_f32_fp8((int)a.x, false), a1 = __builtin_amdgcn_cvt_pk_f32_fp8((int)a.x, true), a2 = __builtin_amdgcn_cvt_pk_f32_fp8((int)a.y, false), a3 = __builtin_amdgcn_cvt_pk_f32_fp8((int)a.y, true);
            const f32x2v b0 = __builtin_amdgcn_cvt_pk_f32_fp8((int)bq.x, false), b1 = __builtin_amdgcn_cvt_pk_f32_fp8((int)bq.x, true), b2 = __builtin_amdgcn_cvt_pk_f32_fp8((int)bq.y, false), b3 = __builtin_amdgcn_cvt_pk_f32_fp8((int)bq.y, true);
            v[j][0] = (f32x4){bflo(t.x) + w1 * a0.x + w2 * b0.x, bfhi(t.x) + w1 * a0.y + w2 * b0.y, bflo(t.y) + w1 * a1.x + w2 * b1.x, bfhi(t.y) + w1 * a1.y + w2 * b1.y};
            v[j][1] = (f32x4){bflo(t.z) + w1 * a2.x + w2 * b2.x, bfhi(t.z) + w1 * a2.y + w2 * b2.y, bflo(t.w) + w1 * a3.x + w2 * b3.x, bfhi(t.w) + w1 * a3.y + w2 * b3.y};
#pragma unroll
            for (int q = 0; q < 2; ++q) s += (v[j][q].x * v[j][q].x + v[j][q].y * v[j][q].y) + (v[j][q].z * v[j][q].z + v[j][q].w * v[j][q].w);
        }
        const float rstd = 1.f / sqrtf(wave_sum(s) * (1.f / DM) + EPS);
        float* o = p.out + (size_t)m * DM + 8 * lane;
#pragma unroll
        for (int j = 0; j < 2; ++j) { *(f32x4*)(o + 512 * j) = v[j][0] * rstd * wv[j][0]; *(f32x4*)(o + 512 * j + 4) = v[j][1] * rstd * wv[j][1]; }
        R0 = R1; R1 = R2;
    }
#undef ISSUE_ROWS
#undef LOAD_REC
}

constexpr int NPHASE = 14;
__global__ void __launch_bounds__(NTHREADS, 2) fwd_kernel(Params p) {
    extern __shared__ __attribute__((aligned(16))) unsigned char lds[];
#if MK_ONE_LAUNCH
    cg::grid_group grid = cg::this_grid();
    volatile LAS unsigned* bst = (volatile LAS unsigned*)(LDS3(lds) + LDS_BYTES - 16);
    if (threadIdx.x < 2) bst[threadIdx.x] = 0u;
    __syncthreads();
    const XcdBarrier xbar = xcd_barrier_post((unsigned*)(p.ws + WS_BAR), bst);
    if (p.ph_hi > NPHASE) grid.sync();
#define SEAM(k) do { if (p.ph_lo <= (k) && (k) + 1 < p.ph_hi) xcd_barrier(xbar); } while (0)
#else
#define SEAM(k) do { } while (0)
#endif
#ifndef PROBE_PHASE
#define PROBE_PHASE -1
#endif
#define IN(k) (p.ph_lo <= (k) && (k) < p.ph_hi && (k) != p.skip)
#define REPS(k) (((k) == PROBE_PHASE) ? 2 : 1)
    if (IN(0)) { _Pragma("unroll 1") for (int rep = 0; rep < REPS(0); ++rep) { phase0(p, lds); } } SEAM(0);
    if (IN(1)) { _Pragma("unroll 1") for (int rep = 0; rep < REPS(1); ++rep) { phase1(p, lds); } } SEAM(1);
    if (IN(2)) { _Pragma("unroll 1") for (int rep = 0; rep < REPS(2); ++rep) for (int it = blockIdx.x; it < NB * NCH; it += gridDim.x) { const int b = it / NCH, c = it % NCH; phase2_attn(p, lds, b, c); phase2_states(p, lds, b, c); } } SEAM(2);
    if (IN(3)) { _Pragma("unroll 1") for (int rep = 0; rep < REPS(3); ++rep) { phase3(p); } } SEAM(3);
    if (IN(4)) { _Pragma("unroll 1") for (int rep = 0; rep < REPS(4); ++rep) for (int it = blockIdx.x; it < NB * NCH; it += gridDim.x) { const int b = it / NCH, c = it % NCH; phase4(p, lds, b, c); } } SEAM(4);
    if (IN(5)) { _Pragma("unroll 1") for (int rep = 0; rep < REPS(5); ++rep) { phase5(p, lds); } } SEAM(5);
    if (IN(6)) { _Pragma("unroll 1") for (int rep = 0; rep < REPS(6); ++rep) { phase6(p, lds); } } SEAM(6);
    if (IN(7)) { _Pragma("unroll 1") for (int rep = 0; rep < REPS(7); ++rep) { phase7(p, lds); } } SEAM(7);
    if (IN(8)) { phase8(p, lds); } SEAM(8);
    if (IN(9)) { phase9(p, lds); } SEAM(9);
    if (IN(11)) { _Pragma("unroll 1") for (int rep = 0; rep < REPS(11); ++rep) { phase11(p, lds); } } SEAM(11);
    if (IN(12)) { _Pragma("unroll 1") for (int rep = 0; rep < REPS(12); ++rep) { phase12(p, lds); } } SEAM(12);
    if (IN(13)) { _Pragma("unroll 1") for (int rep = 0; rep < REPS(13); ++rep) { phase13(p, lds); } }
#undef IN
#undef SEAM
}

extern "C" void kernel_launch(void* const* d_in, const int* in_sizes, int n_in, void* d_out, int out_size, void* d_ws, size_t ws_size, hipStream_t stream) {
    static int grid = 0;
    if (grid == 0) {
        if (n_in != 28 || out_size != NT * DM || ws_size < WS_NEED) { fprintf(stderr, "kernel_launch: unexpected sizes n_in %d out %d ws %zu\n", n_in, out_size, ws_size); grid = -1; return; }
        int dev = 0, cus = 0, per_cu = 0;
        hipGetDevice(&dev);
        hipDeviceGetAttribute(&cus, hipDeviceAttributeMultiprocessorCount, dev);
        if (hipFuncSetAttribute((const void*)fwd_kernel, hipFuncAttributeMaxDynamicSharedMemorySize, LDS_BYTES) != hipSuccess) { fprintf(stderr, "kernel_launch: hipFuncSetAttribute failed\n"); grid = -1; return; }
        if (hipOccupancyMaxActiveBlocksPerMultiprocessor(&per_cu, (const void*)fwd_kernel, NTHREADS, LDS_BYTES) != hipSuccess || per_cu < 1) { fprintf(stderr, "kernel_launch: occupancy query says %d\n", per_cu); per_cu = 1; }
        (void)hipGetLastError();
        grid = cus;
    }
    if (grid < 0) return;
    Params prm{};
    for (int i = 0; i < 28; ++i) prm.in[i] = (const float*)d_in[i];
    prm.out = (float*)d_out; prm.ws = (unsigned char*)d_ws;
    for (int i = 0; i < 8; ++i) prm.inv_freq[i] = powf(500000.0f, -(float)(2 * i) / 16.0f);
    prm.skip = -1;
#ifndef PROBE_SKIP
#define PROBE_SKIP -2
#endif
#if MK_ONE_LAUNCH
    for (int twice = 0; twice < ((PROBE_SKIP >= -1) ? 2 : 1); ++twice) {
    if (hipMemsetAsync((char*)d_ws + WS_CTL, 0, CTL_ZERO_BYTES, stream) != hipSuccess) { fprintf(stderr, "kernel_launch: memset failed\n"); return; }
#ifndef PROBE_TRUNC
#define PROBE_TRUNC NPHASE
#endif
#ifndef PROBE_VARIANT
#define PROBE_VARIANT 0
#endif
    prm.ph_lo = 0; prm.ph_hi = twice ? PROBE_TRUNC : NPHASE; prm.skip = twice ? PROBE_SKIP : -1; prm.pad = twice ? PROBE_VARIANT : 0;
    void* args[] = {&prm};
    hipError_t e = hipLaunchCooperativeKernel((const void*)fwd_kernel, dim3(grid), dim3(NTHREADS), args, LDS_BYTES, stream);
    if (e != hipSuccess) fprintf(stderr, "cooperative launch failed: %s (grid %d)\n", hipGetErrorString(e), grid);
    }
#else
    if (hipMemsetAsync((char*)d_ws + WS_CTL, 0, CTL_ZERO_BYTES, stream) != hipSuccess) { fprintf(stderr, "kernel_launch: memset failed\n"); return; }
#ifndef PROBE_DUP
#define PROBE_DUP -1
#endif
    for (int ph = 0; ph < NPHASE; ++ph) {
        prm.ph_lo = ph; prm.ph_hi = ph + 1;
        hipLaunchKernelGGL(fwd_kernel, dim3(grid), dim3(NTHREADS), LDS_BYTES, stream, prm);
        if (ph == PROBE_DUP) hipLaunchKernelGGL(fwd_kernel, dim3(grid), dim3(NTHREADS), LDS_BYTES, stream, prm);
    }
#endif
}
```
